# Optimizing an MI355X kernel written in HIP

```python
import jax, jax.numpy as jnp
from jax import lax
import numpy as np

D_MODEL = 2048
BATCH = 4
SEQ = 2048
DEPTH = 4
DEC_BATCH = 128
DEC_SEQ = 1
PAST_LEN = 16384
PAGE_SIZE = 128

H_M = 4
DH_M = 256
W_M = H_M * DH_M
H_R = 4
DH_R = 256
W_R = H_R * DH_R
CONV_W = 4
CHUNK = 128
ROPE_BASE = 10000.0
EPS = 1e-6
NEG = -1e30
N_IN = 3 * W_M + 2 * H_M + 4 * W_R

kernel_name = "hybrid_mlstm_retention_gated_decoder_step"

f32 = jnp.float32


def rmsnorm(x, g):
    xf = x.astype(f32)
    return xf * lax.rsqrt(jnp.mean(xf * xf, axis=-1, keepdims=True) + EPS) * g.astype(f32)


def head_norm(h, g):
    mu = jnp.mean(h, axis=-1, keepdims=True)
    var = jnp.mean(jnp.square(h - mu), axis=-1, keepdims=True)
    hn = (h - mu) * lax.rsqrt(var + EPS)
    B, T = h.shape[:2]
    return hn.reshape(B, T, -1) * g.astype(f32)


def to_chunks(a, L):
    B, T = a.shape[:2]
    return jnp.moveaxis(a.reshape((B, T // L, L) + a.shape[2:]), 1, 0)


def from_chunks(a):
    nc, B, L = a.shape[:3]
    return jnp.moveaxis(a, 0, 1).reshape((B, nc * L) + a.shape[3:])


def causal_conv(u, buf, w, b):
    T = u.shape[1]
    up = jnp.concatenate([buf.astype(f32), u], axis=1)
    out = b.astype(f32)
    for i in range(CONV_W):
        out = out + up[:, i:i + T] * w[i].astype(f32)
    return out, up[:, -(CONV_W - 1):]


def rope(x, pos):
    dh = x.shape[-1]
    half = dh // 2
    inv = ROPE_BASE ** (-jnp.arange(0, half, dtype=f32) / half)
    ang = pos.astype(f32)[:, None] * inv[None, :]
    cos = jnp.cos(ang)[None, :, None, :]
    sin = jnp.sin(ang)[None, :, None, :]
    x1, x2 = x[..., :half], x[..., half:]
    return jnp.concatenate([x1 * cos - x2 * sin, x1 * sin + x2 * cos], axis=-1)


def mlstm_chunkwise(q, k, v, i_pre, logf, C0, n0, m0):
    T = q.shape[1]
    L = min(CHUNK, T)
    causal = jnp.tril(jnp.ones((L, L), dtype=bool))

    def step(carry, xs):
        C, n, m = carry
        qc, kc, vc, ic, fc = xs
        b = jnp.cumsum(fc, axis=1).transpose(0, 2, 1)
        ih = ic.transpose(0, 2, 1)
        dlog = jnp.where(causal, b[..., :, None] - b[..., None, :] + ih[..., None, :], NEG)
        inter = b + m[..., None]
        m_t = jnp.maximum(inter, jnp.max(dlog, axis=-1))
        w = jnp.exp(dlog - m_t[..., None])
        a = jnp.exp(inter - m_t)
        ws = w * jnp.einsum('blhd,bshd->bhls', qc, kc)
        num = (jnp.einsum('bhls,bshe->blhe', ws, vc)
               + a.transpose(0, 2, 1)[..., None] * jnp.einsum('bhed,blhd->blhe', C, qc))
        den = jnp.sum(ws, axis=-1) + a * jnp.einsum('bhd,blhd->bhl', n, qc)
        den = jnp.maximum(jnp.abs(den), jnp.exp(-m_t))
        hc = num / den.transpose(0, 2, 1)[..., None]
        m_new = m_t[..., -1]
        wk = jnp.exp(b[..., -1:] - b + ih - m_new[..., None])
        dec = jnp.exp(b[..., -1] + m - m_new)
        C_new = dec[..., None, None] * C + jnp.einsum('bhs,bshe,bshd->bhed', wk, vc, kc)
        n_new = dec[..., None] * n + jnp.einsum('bhs,bshd->bhd', wk, kc)
        return (C_new, n_new, m_new), hc

    xs = (to_chunks(q, L), to_chunks(k, L), to_chunks(v, L), to_chunks(i_pre, L), to_chunks(logf, L))
    (C, n, m), hs = lax.scan(step, (C0, n0, m0), xs)
    return from_chunks(hs), C, n, m


def retention_chunkwise(q, k, v, log_gamma, S0):
    T = q.shape[1]
    L = min(CHUNK, T)
    j = jnp.arange(L, dtype=f32)
    causal = jnp.tril(jnp.ones((L, L), dtype=bool))
    intra = jnp.where(causal[None], jnp.exp((j[:, None] - j[None, :])[None] * log_gamma[:, None, None]), 0.0)
    q_dec = jnp.exp((j + 1.0)[:, None] * log_gamma[None, :])
    k_dec = jnp.exp((L - 1.0 - j)[:, None] * log_gamma[None, :])
    s_dec = jnp.exp(L * log_gamma)

    def step(S, xs):
        qc, kc, vc = xs
        sc = jnp.einsum('blhd,bshd->bhls', qc, kc) * intra[None]
        o = (jnp.einsum('bhls,bshe->blhe', sc, vc)
             + q_dec[None, :, :, None] * jnp.einsum('blhd,bhde->blhe', qc, S))
        S_new = s_dec[None, :, None, None] * S + jnp.einsum('bshd,bshe,sh->bhde', kc, vc, k_dec)
        return S_new, o

    S, os_ = lax.scan(step, S0, (to_chunks(q, L), to_chunks(k, L), to_chunks(v, L)))
    return from_chunks(os_), S


def layer(x, C, n, m, conv_buf, S, pos0,
          norm_g, w_in, conv_w, conv_b, w_qm, w_km, b_i, b_f,
          hn_m_g, skip_m, hn_r_g, w_pm, w_pr, w_gate, b_gate, w_o):
    B, T, _ = x.shape
    h = rmsnorm(x, norm_g)
    proj = jnp.matmul(h, w_in.astype(f32))
    idx = [W_M, 2 * W_M, 3 * W_M, 3 * W_M + H_M, 3 * W_M + 2 * H_M,
           3 * W_M + 2 * H_M + W_R, 3 * W_M + 2 * H_M + 2 * W_R, 3 * W_M + 2 * H_M + 3 * W_R]
    u_m, v_m, z_m, i_pre, f_pre, q_r, k_r, v_r, z_r = jnp.split(proj, idx, axis=-1)

    c_m, conv_new = causal_conv(u_m, conv_buf, conv_w, conv_b)
    c_m = jax.nn.silu(c_m)
    ch = c_m.reshape(B, T, H_M, DH_M)
    q_m = jnp.einsum('bthd,hde->bthe', ch, w_qm.astype(f32)) * (DH_M ** -0.5)
    k_m = jnp.einsum('bthd,hde->bthe', ch, w_km.astype(f32))
    vh = v_m.reshape(B, T, H_M, DH_M)
    i_g = i_pre + b_i.astype(f32)
    logf = jax.nn.log_sigmoid(f_pre + b_f.astype(f32))
    hm, C_new, n_new, m_new = mlstm_chunkwise(q_m, k_m, vh, i_g, logf,
                                              C.astype(f32), n.astype(f32), m.astype(f32))
    o_m = (head_norm(hm, hn_m_g) + skip_m.astype(f32) * c_m) * jax.nn.silu(z_m)

    pos = pos0 + jnp.arange(T)
    qr = rope(q_r.reshape(B, T, H_R, DH_R), pos)
    kr = rope(k_r.reshape(B, T, H_R, DH_R), pos) * (DH_R ** -0.5)
    vr = v_r.reshape(B, T, H_R, DH_R)
    log_gamma = jnp.log(1.0 - jnp.exp2(-5.0 - jnp.arange(H_R, dtype=f32)))
    hr, S_new = retention_chunkwise(qr, kr, vr, log_gamma, S.astype(f32))
    o_r = head_norm(hr, hn_r_g) * jax.nn.silu(z_r)

    gates = jax.nn.sigmoid(jnp.matmul(h, w_gate.astype(f32)) + b_gate.astype(f32))
    g_m, g_r = jnp.split(gates, 2, axis=-1)
    merged = g_m * jnp.matmul(o_m, w_pm.astype(f32)) + g_r * jnp.matmul(o_r, w_pr.astype(f32))
    y = jnp.matmul(merged, w_o.astype(f32))
    x_new = (x.astype(f32) + y).astype(x.dtype)
    return x_new, C_new, n_new, m_new, conv_new, S_new


def setup_inputs(seed: int = 0) -> dict:
    key = jax.random.key(seed)
    ks = jax.random.split(key, 24)

    def nrm(k, shape, s):
        return jax.random.normal(k, shape, f32) * s

    return {
        "x_prompt": nrm(ks[0], (BATCH, SEQ, D_MODEL), 1.0),
        "x_sample": nrm(ks[1], (DEC_BATCH, DEC_SEQ, D_MODEL), 1.0),
        "state_mlstm_C": nrm(ks[2], (DEPTH, DEC_BATCH, H_M, DH_M, DH_M), 0.05),
        "state_mlstm_n": nrm(ks[3], (DEPTH, DEC_BATCH, H_M, DH_M), 0.5),
        "state_mlstm_m": jax.random.uniform(ks[4], (DEPTH, DEC_BATCH, H_M), f32, 0.0, 2.0),
        "state_mlstm_conv": nrm(ks[5], (DEPTH, DEC_BATCH, CONV_W - 1, W_M), 1.0),
        "state_ret_S": nrm(ks[6], (DEPTH, DEC_BATCH, H_R, DH_R, DH_R), 0.3),
        "norm_g": 1.0 + nrm(ks[7], (DEPTH, D_MODEL), 0.02),
        "w_in": nrm(ks[8], (DEPTH, D_MODEL, N_IN), D_MODEL ** -0.5),
        "conv_w": nrm(ks[9], (DEPTH, CONV_W, W_M), CONV_W ** -0.5),
        "conv_b": nrm(ks[10], (DEPTH, W_M), 0.02),
        "w_qm": nrm(ks[11], (DEPTH, H_M, DH_M, DH_M), DH_M ** -0.5),
        "w_km": nrm(ks[12], (DEPTH, H_M, DH_M, DH_M), DH_M ** -0.5),
        "b_i": nrm(ks[13], (DEPTH, H_M), 0.1),
        "b_f": jnp.linspace(3.0, 6.0, H_M, dtype=f32)[None, :] + nrm(ks[14], (DEPTH, H_M), 0.1),
        "hn_m_g": 1.0 + nrm(ks[15], (DEPTH, W_M), 0.02),
        "skip_m": 1.0 + nrm(ks[16], (DEPTH, W_M), 0.02),
        "hn_r_g": 1.0 + nrm(ks[17], (DEPTH, W_R), 0.02),
        "w_pm": nrm(ks[18], (DEPTH, W_M, D_MODEL), W_M ** -0.5),
        "w_pr": nrm(ks[19], (DEPTH, W_R, D_MODEL), W_R ** -0.5),
        "w_gate": nrm(ks[20], (DEPTH, D_MODEL, 2 * D_MODEL), D_MODEL ** -0.5),
        "b_gate": nrm(ks[21], (DEPTH, 2 * D_MODEL), 0.02),
        "w_o": nrm(ks[22], (DEPTH, D_MODEL, D_MODEL), 0.5 * D_MODEL ** -0.5),
        "final_g": 1.0 + nrm(ks[23], (D_MODEL,), 0.02),
    }


def reference(x_prompt, x_sample, state_mlstm_C, state_mlstm_n, state_mlstm_m, state_mlstm_conv, state_ret_S,
              norm_g, w_in, conv_w, conv_b, w_qm, w_km, b_i, b_f, hn_m_g, skip_m, hn_r_g,
              w_pm, w_pr, w_gate, b_gate, w_o, final_g):
    xp = x_prompt
    xs = x_sample
    Bp = x_prompt.shape[0]
    Cp0 = jnp.zeros((Bp, H_M, DH_M, DH_M), f32)
    np0 = jnp.zeros((Bp, H_M, DH_M), f32)
    mp0 = jnp.full((Bp, H_M), NEG, f32)
    convp0 = jnp.zeros((Bp, CONV_W - 1, W_M), f32)
    Sp0 = jnp.zeros((Bp, H_R, DH_R, DH_R), f32)
    outs_p = [[], [], [], [], []]
    outs_s = [[], [], [], [], []]
    for l in range(DEPTH):
        lw = (norm_g[l], w_in[l], conv_w[l], conv_b[l], w_qm[l], w_km[l], b_i[l], b_f[l],
              hn_m_g[l], skip_m[l], hn_r_g[l], w_pm[l], w_pr[l], w_gate[l], b_gate[l], w_o[l])
        xp, *st_p = layer(xp, Cp0, np0, mp0, convp0, Sp0, 0, *lw)
        xs, *st_s = layer(xs, state_mlstm_C[l], state_mlstm_n[l], state_mlstm_m[l],
                          state_mlstm_conv[l], state_ret_S[l], PAST_LEN, *lw)
        for j in range(5):
            outs_p[j].append(st_p[j])
            outs_s[j].append(st_s[j])
    y_prompt = rmsnorm(xp, final_g).astype(x_prompt.dtype)
    y_sample = rmsnorm(xs, final_g).astype(x_sample.dtype)
    new_C_p = jnp.stack(outs_p[0])
    new_n_p = jnp.stack(outs_p[1])
    new_m_p = jnp.stack(outs_p[2])
    new_conv_p = jnp.stack(outs_p[3])
    new_S_p = jnp.stack(outs_p[4])
    new_C_s = jnp.stack(outs_s[0])
    new_n_s = jnp.stack(outs_s[1])
    new_m_s = jnp.stack(outs_s[2])
    new_conv_s = jnp.stack(outs_s[3])
    new_S_s = jnp.stack(outs_s[4])
    return (y_prompt, y_sample, new_C_p, new_n_p, new_m_p, new_conv_p, new_S_p,
            new_C_s, new_n_s, new_m_s, new_conv_s, new_S_s)
```

```cpp
#include <hip/hip_runtime.h>
#include <stdint.h>
#include <stdio.h>

#ifndef MK_SINGLE
#define MK_SINGLE 0
#endif

#define LAS __attribute__((address_space(3)))
typedef unsigned short bf16_t;
typedef short bf16x8 __attribute__((ext_vector_type(8)));
typedef float f32x4 __attribute__((ext_vector_type(4)));
typedef unsigned u32x4 __attribute__((ext_vector_type(4)));
typedef unsigned u32x2 __attribute__((ext_vector_type(2)));

constexpr int D = 2048, SEQ = 2048, BP = 4, BS = 128, DEPTH = 4, HM = 4, DH = 256, WM = 1024, NIN = 7176;
constexpr int MP = BP * SEQ, MT = MP + BS, MPAD = 8448;
constexpr int N1 = 11264;
constexpr int C_U = 0, C_VM = 1024, C_ZM = 2048, C_QR = 3072, C_KR = 4096, C_VR = 5120, C_ZR = 6144, C_GM = 7168, C_GR = 9216;
constexpr float EPS = 1e-6f;
constexpr size_t SZ = 65536;
constexpr size_t O_YP = 0, O_YS = O_YP + 16777216, O_CP = O_YS + 262144, O_NP = O_CP + 4194304, O_MP = O_NP + 16384, O_CVP = O_MP + 64,
                 O_SP = O_CVP + 49152, O_CS = O_SP + 4194304, O_NS = O_CS + 134217728, O_MS = O_NS + 524288, O_CVS = O_MS + 2048, O_SS = O_CVS + 1572864;
constexpr size_t W1_OFF = 0, W2_OFF = W1_OFF + (size_t)N1 * D, W3_OFF = W2_OFF + (size_t)2048 * 256, W4_OFF = W3_OFF + (size_t)D * D, WL = W4_OFF + (size_t)D * D;
constexpr int LDS_BYTES = 147456;

struct Params {
    const float *x_prompt, *x_sample, *st_C, *st_n, *st_m, *st_conv, *st_S, *norm_g, *w_in, *conv_w, *conv_b, *w_qm, *w_km, *b_i, *b_f,
                *hn_m_g, *skip_m, *hn_r_g, *w_pm, *w_pr, *w_gate, *b_gate, *w_o, *final_g;
    float* out;
    unsigned* bar;
    float* X; bf16_t* H; bf16_t* P; float* IF; bf16_t* CM; bf16_t* QK; bf16_t* OC; float* T3; bf16_t* MG;
    float* U; bf16_t* CS; float* NU; float* NS; bf16_t* W; float* WIF; float* BIAS1; float* ROPE;
};

__device__ __forceinline__ int opaque_tid() { int t = threadIdx.x; asm volatile("" : "+v"(t)); return t; }
__device__ __forceinline__ float bf2f(bf16_t v) { return __uint_as_float((unsigned)v << 16); }
__device__ __forceinline__ bf16_t f2bf(float f) { unsigned u = __float_as_uint(f); u += 0x7fffu + ((u >> 16) & 1u); return (bf16_t)(u >> 16); }
__device__ __forceinline__ unsigned pk2(float lo, float hi) { return (unsigned)f2bf(lo) | ((unsigned)f2bf(hi) << 16); }
__device__ __forceinline__ float wave_sum(float v) {
#pragma unroll
    for (int o = 32; o >= 1; o >>= 1) v += __shfl_xor(v, o);
    return v;
}
__device__ __forceinline__ float wave_max(float v) {
#pragma unroll
    for (int o = 32; o >= 1; o >>= 1) v = fmaxf(v, __shfl_xor(v, o));
    return v;
}
__device__ __forceinline__ float sigmoidf_(float x) { return 1.0f / (1.0f + __expf(-x)); }
__device__ __forceinline__ float siluf_(float x) { return x / (1.0f + __expf(-x)); }
__device__ __forceinline__ float logsigf_(float x) { return x < 0.f ? x - log1pf(expf(x)) : -log1pf(expf(-x)); }
__device__ __forceinline__ void block_sum2(float& a, float& b, LAS float* red) {
    a = wave_sum(a); b = wave_sum(b);
    __syncthreads();
    if ((threadIdx.x & 63) == 0) { red[threadIdx.x >> 6] = a; red[8 + (threadIdx.x >> 6)] = b; }
    __syncthreads();
    float sa = 0.f, sb = 0.f;
#pragma unroll
    for (int i = 0; i < 8; ++i) { sa += red[i]; sb += red[8 + i]; }
    a = sa; b = sb;
}

#define XB_TMO      128
#define XB_XCNT(j)  (256  + 64 * (j))
#define XB_XSUB(j)  (1280 + 64 * (j))
#define XB_XGEN(j)  (2304 + 64 * (j))
#define XB_TOP      3328
#define XB_TOPGEN   3392
#define XCD_BAR_WORDS 3456
#define XB_SPIN_CAP (1u << 22)

__device__ __forceinline__ unsigned xb_ld(unsigned* p)              { return __hip_atomic_load(p, __ATOMIC_RELAXED, __HIP_MEMORY_SCOPE_AGENT); }
__device__ __forceinline__ unsigned xb_add(unsigned* p, unsigned v) { return __hip_atomic_fetch_add(p, v, __ATOMIC_RELAXED, __HIP_MEMORY_SCOPE_AGENT); }
__device__ __forceinline__ unsigned xb_xcc_id() { return (unsigned)__builtin_amdgcn_s_getreg((3 << 11) | 20) & 0xFu; }
#define XB_SPIN(cond, bar) do { unsigned _sp = 0; while (cond) { __builtin_amdgcn_s_sleep(1); \
    if ((++_sp & 255u) == 0u) { if (xb_ld(&(bar)[XB_TMO])) break; if (_sp > XB_SPIN_CAP) { atomicAdd(&(bar)[XB_TMO], 1u); break; } } } } while (0)

struct XcdBarrier { unsigned* bar; unsigned x; volatile LAS unsigned* st; };

__device__ __forceinline__ XcdBarrier xcd_barrier_post(unsigned* bar, volatile LAS unsigned* st) {
    XcdBarrier b; b.bar = bar; b.x = xb_xcc_id(); b.st = st;
    if (threadIdx.x == 0) (void)xb_add(&bar[XB_XCNT(b.x)], 1u);
    return b;
}
__device__ __forceinline__ void xcd_barrier_complete(unsigned* bar, unsigned x, unsigned& nloc, unsigned& nx) {
    const unsigned G = gridDim.x * gridDim.y * gridDim.z;
    unsigned sum, cnt, mine, sp = 0u;
    for (;;) {
        sum = 0u; cnt = 0u; mine = 0u;
#pragma unroll
        for (unsigned j = 0; j < 16; ++j) { const unsigned c = xb_ld(&bar[XB_XCNT(j)]); sum += c; cnt += (c > 0u) ? 1u : 0u; mine = (j == x) ? c : mine; }
        if (sum == G) break;
        __builtin_amdgcn_s_sleep(1);
        if ((++sp & 255u) == 0u) { if (xb_ld(&bar[XB_TMO])) break; if (sp > XB_SPIN_CAP) { atomicAdd(&bar[XB_TMO], 1u); break; } }
    }
    nloc = mine > 0u ? mine : 1u; nx = cnt > 0u ? cnt : 1u;
}
__device__ __forceinline__ void xcd_barrier(const XcdBarrier& b) {
    asm volatile("s_waitcnt vmcnt(0)" ::: "memory");
    __syncthreads();
    if (threadIdx.x == 0) {
        unsigned* bar = b.bar;
        __builtin_amdgcn_s_waitcnt(0);
        unsigned nloc = b.st[0], nx = b.st[1];
        if (nloc == 0u) { xcd_barrier_complete(bar, b.x, nloc, nx); b.st[0] = nloc; b.st[1] = nx; }
        const unsigned old = xb_add(&bar[XB_XSUB(b.x)], 1u);
        const unsigned gen = old / nloc;
        if (old + 1u == (gen + 1u) * nloc) {
            __builtin_amdgcn_fence(__ATOMIC_RELEASE, "agent");
            asm volatile("s_waitcnt vmcnt(0)" ::: "memory");
            const unsigned og = xb_add(&bar[XB_TOP], 1u);
            const unsigned tg = og / nx;
            if (og + 1u == (tg + 1u) * nx) xb_add(&bar[XB_TOPGEN], 1u);
            else XB_SPIN(xb_ld(&bar[XB_TOPGEN]) == tg, bar);
            __builtin_amdgcn_fence(__ATOMIC_ACQUIRE, "agent");
            xb_add(&bar[XB_XGEN(b.x)], 1u);
            asm volatile("s_waitcnt vmcnt(0)" ::: "memory");
        } else {
            XB_SPIN(xb_ld(&bar[XB_XGEN(b.x)]) == gen, bar);
            __builtin_amdgcn_fence(__ATOMIC_ACQUIRE, "agent");
            asm volatile("s_waitcnt vmcnt(0)" ::: "memory");
        }
    }
    __syncthreads();
}

namespace pg8 {
constexpr int BM = 256, BK = 64, HALF = 128, HTB = HALF * BK * 2, STAGE_BYTES = 8 * HTB, NXCD = 8, WGM = 8;
__host__ __device__ __forceinline__ int lds_byte(int r, int c) { const int st = (r >> 4) * 2 + (c >> 5), rr = r & 15, cc = c & 31, ob = rr * 64 + cc * 2; return st * 1024 + (ob ^ (((ob >> 9) & 1) << 5)); }
__host__ __device__ __forceinline__ void stage_rc(int b, int& R, int& C) { const int st = b / 1024, sb = b % 1024, swz = sb ^ (((sb >> 9) & 1) << 5); R = (st >> 1) * 16 + swz / 64; C = (st & 1) * 32 + (swz % 64) / 2; }
__host__ __device__ __forceinline__ int perm32(int rho) { const int n = rho >> 4, i = rho & 15; return 8 * (i >> 2) + 4 * n + (i & 3); }

struct Unit { int pm, pn; };
struct Gemm { const bf16_t* A; const bf16_t* Bt; int K, lda, ldb, a_pn_shift, a_pn_stride; };

struct StaticOrder {
    int nM, nN, nwg, G, c;
    __device__ void init(int M, int N, int G_, int c_) { nM = M / BM; nN = N / BM; nwg = nM * nN; G = G_; c = c_; }
    __device__ bool next(int i, Unit& u) const {
        const long L = (long)i * G + c; if (L >= nwg) return false;
        int wgid = (int)L; { const int q = nwg / NXCD, r = nwg % NXCD, xcd = wgid % NXCD, off = wgid / NXCD; wgid = (xcd < r ? xcd * (q + 1) : r * (q + 1) + (xcd - r) * q) + off; }
        const int nig = WGM * nN, gid = wgid / nig, fm = gid * WGM, gsz = (nM - fm) < WGM ? (nM - fm) : WGM;
        u.pm = fm + ((wgid % nig) % gsz); u.pn = (wgid % nig) / gsz; return true;
    }
};
__device__ __forceinline__ unsigned cvt_pk_bf16(float lo, float hi) { unsigned r; asm volatile("v_cvt_pk_bf16_f32 %0, %1, %2" : "=v"(r) : "v"(lo), "v"(hi)); return r; }

struct EpiBf16 {
    static constexpr bool PERM = true;
    bf16_t* O; int ldc; const float* bias;
    __device__ __forceinline__ void operator()(const f32x4 (&acc)[2][2][4][2], const Unit& u, int wr, int wc, int fr, int fq) const {
        const int row0 = u.pm * BM + wr * 64 + fr, col0 = u.pn * BM + wc * 32 + 8 * fq;
        f32x4 bv[2][2];
#pragma unroll
        for (int bj = 0; bj < 2; ++bj)
#pragma unroll
            for (int n = 0; n < 2; ++n) bv[bj][n] = bias ? *(const f32x4*)(bias + col0 + bj * HALF + 4 * n) : (f32x4){0.f, 0.f, 0.f, 0.f};
#pragma unroll
        for (int ai = 0; ai < 2; ++ai)
#pragma unroll
            for (int m = 0; m < 4; ++m) { bf16_t* rowp = O + (size_t)(row0 + ai * HALF + m * 16) * ldc + col0;
#pragma unroll
                for (int bj = 0; bj < 2; ++bj) { const f32x4 v0 = acc[ai][bj][m][0] + bv[bj][0], v1 = acc[ai][bj][m][1] + bv[bj][1];
                    u32x4 w; w.x = cvt_pk_bf16(v0[0], v0[1]); w.y = cvt_pk_bf16(v0[2], v0[3]); w.z = cvt_pk_bf16(v1[0], v1[1]); w.w = cvt_pk_bf16(v1[2], v1[3]);
                    *(u32x4*)(rowp + bj * HALF) = w; } }
    }
};
struct EpiGateF32 {
    static constexpr bool PERM = false;
    float* T; const bf16_t* G; int ldg;
    __device__ __forceinline__ void operator()(const f32x4 (&acc)[2][2][4][2], const Unit& u, int wr, int wc, int fr, int fq) const {
        const int row0 = u.pm * BM + wr * 64 + fr, col0 = u.pn * BM + wc * 32 + 4 * fq;
#pragma unroll
        for (int ai = 0; ai < 2; ++ai)
#pragma unroll
            for (int m = 0; m < 4; ++m) { const size_t row = (size_t)(row0 + ai * HALF + m * 16);
#pragma unroll
                for (int bj = 0; bj < 2; ++bj)
#pragma unroll
                    for (int n = 0; n < 2; ++n) { const int col = col0 + bj * HALF + n * 16;
                        const u32x2 gb = *(const u32x2*)(G + row * ldg + col);
                        f32x4 gt; gt[0] = sigmoidf_(__uint_as_float(gb.x << 16)); gt[1] = sigmoidf_(__uint_as_float(gb.x & 0xffff0000u));
                        gt[2] = sigmoidf_(__uint_as_float(gb.y << 16)); gt[3] = sigmoidf_(__uint_as_float(gb.y & 0xffff0000u));
                        *(f32x4*)(T + row * 2048 + col) = acc[ai][bj][m][n] * gt; } }
    }
};
struct EpiGateAddBf16 {
    static constexpr bool PERM = true;
    bf16_t* O; const float* T; const bf16_t* G; int ldg;
    __device__ __forceinline__ void operator()(const f32x4 (&acc)[2][2][4][2], const Unit& u, int wr, int wc, int fr, int fq) const {
        const int row0 = u.pm * BM + wr * 64 + fr, col0 = u.pn * BM + wc * 32 + 8 * fq;
#pragma unroll
        for (int ai = 0; ai < 2; ++ai)
#pragma unroll
            for (int m = 0; m < 4; ++m) { const size_t row = (size_t)(row0 + ai * HALF + m * 16);
#pragma unroll
                for (int bj = 0; bj < 2; ++bj) { const int col = col0 + bj * HALF;
                    const u32x4 gb = *(const u32x4*)(G + row * ldg + col);
                    const f32x4 t0 = *(const f32x4*)(T + row * 2048 + col), t1 = *(const f32x4*)(T + row * 2048 + col + 4);
                    f32x4 g0, g1;
                    g0[0] = sigmoidf_(__uint_as_float(gb.x << 16)); g0[1] = sigmoidf_(__uint_as_float(gb.x & 0xffff0000u));
                    g0[2] = sigmoidf_(__uint_as_float(gb.y << 16)); g0[3] = sigmoidf_(__uint_as_float(gb.y & 0xffff0000u));
                    g1[0] = sigmoidf_(__uint_as_float(gb.z << 16)); g1[1] = sigmoidf_(__uint_as_float(gb.z & 0xffff0000u));
                    g1[2] = sigmoidf_(__uint_as_float(gb.w << 16)); g1[3] = sigmoidf_(__uint_as_float(gb.w & 0xffff0000u));
                    const f32x4 v0 = t0 + acc[ai][bj][m][0] * g0, v1 = t1 + acc[ai][bj][m][1] * g1;
                    u32x4 w; w.x = cvt_pk_bf16(v0[0], v0[1]); w.y = cvt_pk_bf16(v0[2], v0[3]); w.z = cvt_pk_bf16(v1[0], v1[1]); w.w = cvt_pk_bf16(v1[2], v1[3]);
                    *(u32x4*)(O + row * 2048 + col) = w; } }
    }
};
struct EpiResidual {
    static constexpr bool PERM = false;
    float* X;
    __device__ __forceinline__ void operator()(const f32x4 (&acc)[2][2][4][2], const Unit& u, int wr, int wc, int fr, int fq) const {
        const int row0 = u.pm * BM + wr * 64 + fr, col0 = u.pn * BM + wc * 32 + 4 * fq;
#pragma unroll
        for (int ai = 0; ai < 2; ++ai)
#pragma unroll
            for (int m = 0; m < 4; ++m) { float* rowp = X + (size_t)(row0 + ai * HALF + m * 16) * 2048 + col0;
#pragma unroll
                for (int bj = 0; bj < 2; ++bj)
#pragma unroll
                    for (int n = 0; n < 2; ++n) { f32x4* q = (f32x4*)(rowp + bj * HALF + n * 16); *q = *q + acc[ai][bj][m][n]; } }
    }
};

template <class Epi, class Sched>
__device__ __forceinline__ void gemm_phase(LAS unsigned char* lds, const Gemm g, const Sched& S, const Epi& E) {
    const int tid = opaque_tid(), wid = __builtin_amdgcn_readfirstlane(tid >> 6), lane = tid & 63, wr = wid >> 2, wc = wid & 3, fr = lane & 15, fq = lane >> 4;
    const int K = g.K, nt = K / BK;
    unsigned voffA[2], voffB[2];
#pragma unroll
    for (int i = 0; i < 2; ++i) { int R, C; stage_rc(tid * 16 + i * 8192, R, C); const int Rb = Epi::PERM ? ((R & ~31) + perm32(R & 31)) : R;
        voffA[i] = (unsigned)(R * g.lda + C) * 2u; voffB[i] = (unsigned)(Rb * g.ldb + C) * 2u; }
    const size_t kstep = (size_t)(BK * 2);
    const size_t hstepA = (size_t)HALF * g.lda * 2, hstepB = (size_t)HALF * g.ldb * 2;
    const size_t tstepA = 2 * hstepA, tstepB = 2 * hstepB;
    const unsigned ldsw = (unsigned)wid * 1024u;
    const int aoff = lds_byte(wr * 64 + fr, fq * 8), boff = lds_byte(wc * 32 + fr, fq * 8);
#define PG8_SA(b, h) (((b) * 2 + (h)) * HTB)
#define PG8_SB(b, h) ((4 + (b) * 2 + (h)) * HTB)
#define PG8_STAGE(bufoff, gbase, voff) do { _Pragma("unroll") for (int _i = 0; _i < 2; ++_i) \
        __builtin_amdgcn_global_load_lds((const unsigned*)((const char*)(gbase) + (voff)[_i]), (LAS unsigned*)(lds + (bufoff) + ldsw + _i * 8192), 16, 0, 0); } while (0)
#define PG8_LDA(dst, b, h) do { _Pragma("unroll") for (int m = 0; m < 4; ++m) _Pragma("unroll") for (int k = 0; k < 2; ++k) dst[m][k] = *(const LAS bf16x8*)(lds + PG8_SA(b, h) + aoff + m * 2048 + k * 1024); } while (0)
#define PG8_LDB(dst, b, h) do { _Pragma("unroll") for (int n = 0; n < 2; ++n) _Pragma("unroll") for (int k = 0; k < 2; ++k) dst[n][k] = *(const LAS bf16x8*)(lds + PG8_SB(b, h) + boff + n * 2048 + k * 1024); } while (0)
#define PG8_MMA(ai, bj, At, Bt) do { __builtin_amdgcn_s_setprio(1); _Pragma("unroll") for (int m = 0; m < 4; ++m) _Pragma("unroll") for (int n = 0; n < 2; ++n) _Pragma("unroll") for (int k = 0; k < 2; ++k) \
        acc[ai][bj][m][n] = __builtin_amdgcn_mfma_f32_16x16x32_bf16(Bt[n][k], At[m][k], acc[ai][bj][m][n], 0, 0, 0); __builtin_amdgcn_s_setprio(0); } while (0)
#define PG8_WAIT_V(n) asm volatile("s_waitcnt vmcnt(" #n ")" ::: "memory")
#define PG8_WAIT_L(n) asm volatile("s_waitcnt lgkmcnt(" #n ")" ::: "memory")
#define PG8_BAR __builtin_amdgcn_s_barrier()
#define PG8_SCHED __builtin_amdgcn_sched_barrier(0)
#define PG8_APTR(u) ((const char*)g.A + (size_t)(u).pm * tstepA + (size_t)((u).pn >> g.a_pn_shift) * (size_t)g.a_pn_stride)
    Unit cur, nxt; int ui = 0;
    if (!S.next(0, cur)) return;
    f32x4 acc[2][2][4][2];
#pragma unroll
    for (int a = 0; a < 2; ++a)
#pragma unroll
        for (int b = 0; b < 2; ++b)
#pragma unroll
            for (int m = 0; m < 4; ++m)
#pragma unroll
                for (int n = 0; n < 2; ++n) acc[a][b][m][n] = (f32x4){0.f, 0.f, 0.f, 0.f};
    bf16x8 At[4][2], B0[2][2], B1[2][2];
    const char* cA = PG8_APTR(cur); const char* cB = (const char*)g.Bt + (size_t)cur.pn * tstepB;
    PG8_STAGE(PG8_SB(0, 0), cB, voffB); PG8_STAGE(PG8_SA(0, 0), cA, voffA); PG8_STAGE(PG8_SB(0, 1), cB + hstepB, voffB); PG8_STAGE(PG8_SA(0, 1), cA + hstepA, voffA);
    if (wr == 1) PG8_BAR;
    PG8_WAIT_V(4); PG8_BAR;
    PG8_STAGE(PG8_SB(1, 0), cB + kstep, voffB); PG8_STAGE(PG8_SA(1, 0), cA + kstep, voffA); PG8_STAGE(PG8_SB(1, 1), cB + hstepB + kstep, voffB);
    PG8_WAIT_V(6); PG8_BAR;
    for (;;) {
        const bool has_next = S.next(ui + 1, nxt);
        const char* nA = has_next ? PG8_APTR(nxt) : cA; const char* nB = has_next ? (const char*)g.Bt + (size_t)nxt.pn * tstepB : cB;
        for (int t = 0; t < nt; t += 2) {
            const bool last = (t == nt - 2);
            const char* a1 = cA + (size_t)(t + 1) * kstep;
            const char* a2 = last ? nA : cA + (size_t)(t + 2) * kstep; const char* b2 = last ? nB : cB + (size_t)(t + 2) * kstep;
            const char* a3 = a2 + kstep; const char* b3 = b2 + kstep;
            PG8_LDB(B0, 0, 0); PG8_SCHED; PG8_LDA(At, 0, 0); PG8_STAGE(PG8_SA(1, 1), a1 + hstepA, voffA);
            PG8_WAIT_L(8); PG8_BAR; PG8_WAIT_L(0); PG8_MMA(0, 0, At, B0); PG8_BAR; PG8_SCHED;
            PG8_LDB(B1, 0, 1); PG8_STAGE(PG8_SB(0, 0), b2, voffB);
            PG8_BAR; PG8_WAIT_L(0); PG8_MMA(0, 1, At, B1); PG8_BAR;
            PG8_LDA(At, 0, 1); PG8_STAGE(PG8_SA(0, 0), a2, voffA);
            PG8_BAR; PG8_WAIT_L(0); PG8_MMA(1, 0, At, B0); PG8_BAR; PG8_SCHED;
            PG8_STAGE(PG8_SB(0, 1), b2 + hstepB, voffB);
            PG8_WAIT_V(6); PG8_BAR; PG8_MMA(1, 1, At, B1); PG8_BAR;
            PG8_LDB(B0, 1, 0); PG8_SCHED; PG8_LDA(At, 1, 0); PG8_STAGE(PG8_SA(0, 1), a2 + hstepA, voffA);
            PG8_WAIT_L(8); PG8_BAR; PG8_WAIT_L(0); PG8_MMA(0, 0, At, B0); PG8_BAR; PG8_SCHED;
            PG8_LDB(B1, 1, 1); PG8_STAGE(PG8_SB(1, 0), b3, voffB);
            PG8_BAR; PG8_WAIT_L(0); PG8_MMA(0, 1, At, B1); PG8_BAR;
            PG8_LDA(At, 1, 1); PG8_STAGE(PG8_SA(1, 0), a3, voffA);
            PG8_BAR; PG8_WAIT_L(0); PG8_MMA(1, 0, At, B0); PG8_BAR; PG8_SCHED;
            PG8_STAGE(PG8_SB(1, 1), b3 + hstepB, voffB);
            PG8_WAIT_V(6); PG8_BAR; PG8_MMA(1, 1, At, B1); PG8_BAR;
        }
        E(acc, cur, wr, wc, fr, fq);
        if (!has_next) break;
#pragma unroll
        for (int a = 0; a < 2; ++a)
#pragma unroll
            for (int b = 0; b < 2; ++b)
#pragma unroll
                for (int m = 0; m < 4; ++m)
#pragma unroll
                    for (int n = 0; n < 2; ++n) acc[a][b][m][n] = (f32x4){0.f, 0.f, 0.f, 0.f};
        cur = nxt; cA = nA; cB = nB; ++ui;
    }
    PG8_WAIT_V(0);
    if (wr == 0) PG8_BAR;
    PG8_BAR;
#undef PG8_SA
#undef PG8_SB
#undef PG8_STAGE
#undef PG8_LDA
#undef PG8_LDB
#undef PG8_MMA
#undef PG8_WAIT_V
#undef PG8_WAIT_L
#undef PG8_BAR
#undef PG8_SCHED
#undef PG8_APTR
}
}

__device__ __forceinline__ void tr_tile(const float* src, int ldsrc, int k0, int c0, bf16_t* dst, int ldd, int r0, int kd0, float scale, LAS float* t) {
    const int tid = opaque_tid(), lo = tid & 63, hi = tid >> 6;
#pragma unroll
    for (int i = 0; i < 8; ++i) { const int k = hi + 8 * i; t[k * 65 + lo] = src[(size_t)(k0 + k) * ldsrc + c0 + lo]; }
    __syncthreads();
#pragma unroll
    for (int i = 0; i < 8; ++i) { const int n = hi + 8 * i; dst[(size_t)(r0 + n) * ldd + kd0 + lo] = f2bf(scale * t[lo * 65 + n]); }
    __syncthreads();
}
__device__ __forceinline__ void prep_phase(const Params& p, int wg, int nwg, LAS unsigned char* lds) {
    const int tid = opaque_tid();
    for (size_t i = (size_t)wg * 512 + tid; i < (size_t)MPAD * D / 4; i += (size_t)nwg * 512) {
        const size_t row = (i * 4) / D;
        f32x4 v = (f32x4){0.f, 0.f, 0.f, 0.f};
        if (row < (size_t)MP) v = ((const f32x4*)p.x_prompt)[i];
        else if (row < (size_t)MT) v = ((const f32x4*)p.x_sample)[i - (size_t)MP * D / 4];
        ((f32x4*)p.X)[i] = v;
    }
    for (int i = wg * 512 + tid; i < 2049 * 128; i += nwg * 512) {
        const int pi = i >> 7, j = i & 127;
        const float pos = pi < 2048 ? (float)pi : 16384.0f;
        const float inv = powf(10000.0f, -((float)j / 128.0f));
        const float ang = pos * inv;
        p.ROPE[2 * i] = (float)cos((double)ang); p.ROPE[2 * i + 1] = (float)sin((double)ang);
    }
    for (int i = wg * 512 + tid; i < DEPTH * 8 * D; i += nwg * 512) {
        const int l = i / (8 * D), r = i % (8 * D), j = r / D, k = r % D;
        p.WIF[i] = p.w_in[((size_t)l * D + k) * NIN + 3072 + j];
    }
    for (int i = wg * 512 + tid; i < DEPTH * N1; i += nwg * 512) {
        const int l = i / N1, n = i % N1;
        p.BIAS1[i] = n < C_GM ? 0.f : p.b_gate[l * 4096 + (n - C_GM)];
    }
    LAS float* t = (LAS float*)lds;
    constexpr int T0 = 1536, T1 = T0 + 2048, T2 = T1 + 2048, T3 = T2 + 512, T4 = T3 + 512, T5 = T4 + 1024, T6 = T5 + 64, T7 = T6 + 64;
    for (int it = wg; it < DEPTH * T7; it += nwg) {
        const int l = it / T7, r = it % T7;
        bf16_t* Wl = p.W + (size_t)l * WL;
        if (r < T0)      { const int q = r;      tr_tile(p.w_in + (size_t)l * D * NIN, NIN, (q & 31) * 64, (q >> 5) * 64, Wl + W1_OFF, D, (q >> 5) * 64, (q & 31) * 64, 1.f, t); }
        else if (r < T1) { const int q = r - T0; tr_tile(p.w_in + (size_t)l * D * NIN, NIN, (q & 31) * 64, 3080 + (q >> 5) * 64, Wl + W1_OFF, D, 3072 + (q >> 5) * 64, (q & 31) * 64, 1.f, t); }
        else if (r < T2) { const int q = r - T1; tr_tile(p.w_gate + (size_t)l * D * 4096, 4096, (q & 31) * 64, (q >> 5) * 64, Wl + W1_OFF, D, C_GM + (q >> 5) * 64, (q & 31) * 64, 1.f, t); }
        else if (r < T3) { const int q = r - T2; tr_tile(p.w_pm + (size_t)l * WM * D, D, (q & 15) * 64, (q >> 4) * 64, Wl + W3_OFF, D, (q >> 4) * 64, (q & 15) * 64, 1.f, t); }
        else if (r < T4) { const int q = r - T3; tr_tile(p.w_pr + (size_t)l * WM * D, D, (q & 15) * 64, (q >> 4) * 64, Wl + W3_OFF, D, (q >> 4) * 64, 1024 + (q & 15) * 64, 1.f, t); }
        else if (r < T5) { const int q = r - T4; tr_tile(p.w_o + (size_t)l * D * D, D, (q & 31) * 64, (q >> 5) * 64, Wl + W4_OFF, D, (q >> 5) * 64, (q & 31) * 64, 1.f, t); }
        else if (r < T6) { const int q = r - T5, h = q >> 4, qq = q & 15; tr_tile(p.w_qm + ((size_t)l * HM + h) * SZ, DH, (qq & 3) * 64, (qq >> 2) * 64, Wl + W2_OFF, DH, h * 512 + (qq >> 2) * 64, (qq & 3) * 64, 0.0625f, t); }
        else             { const int q = r - T6, h = q >> 4, qq = q & 15; tr_tile(p.w_km + ((size_t)l * HM + h) * SZ, DH, (qq & 3) * 64, (qq >> 2) * 64, Wl + W2_OFF, DH, h * 512 + 256 + (qq >> 2) * 64, (qq & 3) * 64, 1.f, t); }
    }
}

__device__ __forceinline__ void norm_phase(const Params& p, int layer, int wg, int nwg) {
    const int tid_ = opaque_tid(), lane = tid_ & 63, wid = tid_ >> 6;
    const f32x4* g4 = (const f32x4*)(p.norm_g + (size_t)layer * D);
    const float* wif = p.WIF + (size_t)layer * 8 * D;
    for (int row = wg * 8 + wid; row < MPAD; row += nwg * 8) {
        u32x2* hrow = (u32x2*)(p.H + (size_t)row * D);
        if (row >= MT) {
#pragma unroll
            for (int i = 0; i < 8; ++i) hrow[lane + 64 * i] = (u32x2){0u, 0u};
            continue;
        }
        const f32x4* xr = (const f32x4*)(p.X + (size_t)row * D);
        f32x4 v[8]; float ss = 0.f;
#pragma unroll
        for (int i = 0; i < 8; ++i) { v[i] = xr[lane + 64 * i]; ss += (v[i][0] * v[i][0] + v[i][1] * v[i][1]) + (v[i][2] * v[i][2] + v[i][3] * v[i][3]); }
        ss = wave_sum(ss);
        const float rstd = rsqrtf(ss * (1.0f / D) + EPS);
#pragma unroll
        for (int i = 0; i < 8; ++i) {
            v[i] = v[i] * rstd * g4[lane + 64 * i];
            hrow[lane + 64 * i] = (u32x2){pk2(v[i][0], v[i][1]), pk2(v[i][2], v[i][3])};
        }
#pragma unroll 1
        for (int j = 0; j < 8; ++j) {
            float s = 0.f;
#pragma unroll
            for (int i = 0; i < 8; ++i) { const f32x4 w = ((const f32x4*)(wif + (size_t)j * D))[lane + 64 * i]; s += (v[i][0] * w[0] + v[i][1] * w[1]) + (v[i][2] * w[2] + v[i][3] * w[3]); }
            s = wave_sum(s);
            if (lane == 0) p.IF[(size_t)row * 8 + j] = s;
        }
    }
}
__device__ __forceinline__ void final_phase(const Params& p, int wg, int nwg) {
    const int tid_ = opaque_tid(), lane = tid_ & 63, wid = tid_ >> 6;
    const f32x4* g4 = (const f32x4*)p.final_g;
    for (int row = wg * 8 + wid; row < MT; row += nwg * 8) {
        const f32x4* xr = (const f32x4*)(p.X + (size_t)row * D);
        f32x4* yr = (f32x4*)(p.out + (row < MP ? O_YP + (size_t)row * D : O_YS + (size_t)(row - MP) * D));
        f32x4 v[8]; float ss = 0.f;
#pragma unroll
        for (int i = 0; i < 8; ++i) { v[i] = xr[lane + 64 * i]; ss += (v[i][0] * v[i][0] + v[i][1] * v[i][1]) + (v[i][2] * v[i][2] + v[i][3] * v[i][3]); }
        ss = wave_sum(ss);
        const float rstd = rsqrtf(ss * (1.0f / D) + EPS);
#pragma unroll
        for (int i = 0; i < 8; ++i) yr[lane + 64 * i] = v[i] * rstd * g4[lane + 64 * i];
    }
}

__device__ __forceinline__ void unpack8(const u32x4 v, float (&f)[8]) {
    f[0] = __uint_as_float(v.x << 16); f[1] = __uint_as_float(v.x & 0xffff0000u); f[2] = __uint_as_float(v.y << 16); f[3] = __uint_as_float(v.y & 0xffff0000u);
    f[4] = __uint_as_float(v.z << 16); f[5] = __uint_as_float(v.z & 0xffff0000u); f[6] = __uint_as_float(v.w << 16); f[7] = __uint_as_float(v.w & 0xffff0000u);
}
__device__ __forceinline__ u32x4 pack8(const float (&f)[8]) { u32x4 w; w.x = pk2(f[0], f[1]); w.y = pk2(f[2], f[3]); w.z = pk2(f[4], f[5]); w.w = pk2(f[6], f[7]); return w; }

__device__ __forceinline__ void conv_phase(const Params& p, int layer, int wg, int nwg) {
    const int tid = opaque_tid();
    const float* cw = p.conv_w + (size_t)layer * 4 * WM;
    const float* cb = p.conv_b + (size_t)layer * WM;
    for (int it = wg * 512 + tid; it < MT * 128; it += nwg * 512) {
        const int row = it >> 7, ch = (it & 127) * 8;
        float up[4][8];
        if (row < MP) {
            const int t = row & (SEQ - 1);
#pragma unroll
            for (int i = 0; i < 4; ++i) {
                if (t - 3 + i >= 0) unpack8(*(const u32x4*)(p.P + (size_t)(row - 3 + i) * N1 + C_U + ch), up[i]);
                else {
#pragma unroll
                    for (int j = 0; j < 8; ++j) up[i][j] = 0.f;
                }
            }
            if (t >= SEQ - 3) {
                const int b = row >> 11;
                float* o = p.out + O_CVP + (((size_t)layer * BP + b) * 3 + (t - (SEQ - 3))) * WM + ch;
                *(f32x4*)o = (f32x4){up[3][0], up[3][1], up[3][2], up[3][3]}; *(f32x4*)(o + 4) = (f32x4){up[3][4], up[3][5], up[3][6], up[3][7]};
            }
        } else {
            const int b = row - MP;
            const float* hist = p.st_conv + ((size_t)layer * BS + b) * 3 * WM + ch;
#pragma unroll
            for (int i = 0; i < 3; ++i) { const f32x4 a = *(const f32x4*)(hist + (size_t)i * WM), c = *(const f32x4*)(hist + (size_t)i * WM + 4);
                up[i][0] = a[0]; up[i][1] = a[1]; up[i][2] = a[2]; up[i][3] = a[3]; up[i][4] = c[0]; up[i][5] = c[1]; up[i][6] = c[2]; up[i][7] = c[3]; }
            unpack8(*(const u32x4*)(p.P + (size_t)row * N1 + C_U + ch), up[3]);
            float* o = p.out + O_CVS + ((size_t)layer * BS + b) * 3 * WM + ch;
#pragma unroll
            for (int i = 0; i < 3; ++i) { *(f32x4*)(o + (size_t)i * WM) = (f32x4){up[i + 1][0], up[i + 1][1], up[i + 1][2], up[i + 1][3]};
                *(f32x4*)(o + (size_t)i * WM + 4) = (f32x4){up[i + 1][4], up[i + 1][5], up[i + 1][6], up[i + 1][7]}; }
        }
        float r[8];
#pragma unroll
        for (int j = 0; j < 8; ++j) r[j] = cb[ch + j];
#pragma unroll
        for (int i = 0; i < 4; ++i)
#pragma unroll
            for (int j = 0; j < 8; ++j) r[j] += up[i][j] * cw[i * WM + ch + j];
#pragma unroll
        for (int j = 0; j < 8; ++j) r[j] = siluf_(r[j]);
        *(u32x4*)(p.CM + (size_t)row * WM + ch) = pack8(r);
    }
    for (int it = wg * 512 + tid; it < MT * 128; it += nwg * 512) {
        const int row = it >> 7, r2 = it & 127, which = r2 >> 6, h = (r2 >> 4) & 3, d0 = (r2 & 15) * 8;
        const int pi = row < MP ? (row & (SEQ - 1)) : 2048;
        bf16_t* base = p.P + (size_t)row * N1 + (which ? C_KR : C_QR) + h * 256 + d0;
        float x1[8], x2[8], o1[8], o2[8];
        unpack8(*(const u32x4*)base, x1); unpack8(*(const u32x4*)(base + 128), x2);
        const float* cs = p.ROPE + ((size_t)pi * 128 + d0) * 2;
        const float sc = which ? 0.0625f : 1.0f;
#pragma unroll
        for (int j = 0; j < 8; ++j) { const float c = cs[2 * j], s = cs[2 * j + 1]; o1[j] = (x1[j] * c - x2[j] * s) * sc; o2[j] = (x1[j] * s + x2[j] * c) * sc; }
        *(u32x4*)base = pack8(o1); *(u32x4*)(base + 128) = pack8(o2);
    }
}

__device__ __forceinline__ void gate_scan(const Params& p, int layer, int b, int h, int c_own, LAS float* G) {
    const int tid = opaque_tid(), lane = tid & 63, wid = tid >> 6;
    const float bi = p.b_i[layer * HM + h], bfv = p.b_f[layer * HM + h];
#pragma unroll
    for (int q = 0; q < 2; ++q) {
        const int cc = wid + 8 * q;
        const size_t r0 = (size_t)b * SEQ + cc * 128 + 2 * lane;
        const float i0 = p.IF[r0 * 8 + h] + bi, i1 = p.IF[(r0 + 1) * 8 + h] + bi;
        const float l0 = logsigf_(p.IF[r0 * 8 + 4 + h] + bfv), l1 = logsigf_(p.IF[(r0 + 1) * 8 + 4 + h] + bfv);
        float inc = l0 + l1;
#pragma unroll
        for (int o = 1; o < 64; o <<= 1) { const float t = __shfl_up(inc, o); if (lane >= o) inc += t; }
        const float exc = inc - (l0 + l1);
        const float b0 = exc + l0, b1 = inc;
        const float g0 = i0 - b0, g1 = i1 - b1;
        const float gm = wave_max(fmaxf(g0, g1));
        const float Bc = __shfl(inc, 63);
        if (lane == 0) { G[cc] = Bc; G[16 + cc] = gm; }
        if (cc == c_own) {
            float rm = fmaxf(g0, g1);
#pragma unroll
            for (int o = 1; o < 64; o <<= 1) { const float t = __shfl_up(rm, o); if (lane >= o) rm = fmaxf(rm, t); }
            float ex = __shfl_up(rm, 1); if (lane == 0) ex = -3.0e38f;
            const float c0 = fmaxf(ex, g0), c1 = fmaxf(c0, g1);
            G[64 + 2 * lane] = b0; G[65 + 2 * lane] = b1; G[192 + 2 * lane] = g0; G[193 + 2 * lane] = g1; G[320 + 2 * lane] = c0; G[321 + 2 * lane] = c1;
        }
    }
    __syncthreads();
    if (tid == 0) { float m = -1e30f; for (int cc = 0; cc < 16; ++cc) { G[32 + cc] = m; m = G[cc] + fmaxf(m, G[16 + cc]); } G[48] = m; }
    __syncthreads();
    if (c_own >= 0 && tid < 128) G[320 + tid] = fmaxf(G[320 + tid], G[32 + c_own]);
    __syncthreads();
}

template <int NR, int NC, bool WEIGHT>
__device__ __forceinline__ void stage_T(LAS unsigned char* dst, int ldd_bytes, const bf16_t* src, int ld_src, LAS const float* w) {
    const int tid_ = opaque_tid(), lane = tid_ & 63, wid = tid_ >> 6;
    constexpr int PB = NR / 128, CG = NC / 8;
#pragma unroll 1
    for (int task = wid; task < PB * CG; task += 8) {
        const int pb = task % PB, cg = task / PB, r = pb * 128 + 2 * lane;
        float a[8], c[8];
        unpack8(*(const u32x4*)(src + (size_t)r * ld_src + cg * 8), a); unpack8(*(const u32x4*)(src + (size_t)(r + 1) * ld_src + cg * 8), c);
        float w0 = 1.f, w1 = 1.f; if (WEIGHT) { w0 = w[r]; w1 = w[r + 1]; }
#pragma unroll
        for (int j = 0; j < 8; ++j) *(LAS unsigned*)(dst + (cg * 8 + j) * ldd_bytes + r * 2) = pk2(a[j] * w0, c[j] * w1);
    }
}
__device__ __forceinline__ void stage_rows(LAS unsigned char* dst, const bf16_t* src, int ld_src) {
    const int tid_ = opaque_tid();
#pragma unroll
    for (int i = 0; i < 8; ++i) { const int id = tid_ + 512 * i, row = id >> 5, ch = id & 31;
        *(LAS u32x4*)(dst + row * 528 + ch * 16) = *(const u32x4*)(src + (size_t)row * ld_src + ch * 8); }
}
__device__ __forceinline__ bf16x8 lds_frag(LAS const unsigned char* base, int row, int ld_bytes, int kbyte) { return *(LAS const bf16x8*)(base + row * ld_bytes + kbyte); }
__device__ __forceinline__ float ret_lg(int h) { return logf(1.0f - exp2f(-5.0f - (float)h)); }

template <int BR>
__device__ __forceinline__ void chunk_passA(const Params& p, int layer, int b, int h, int c, LAS unsigned char* lds) {
    LAS unsigned char* At = lds; LAS unsigned char* Bt = lds + 69632; LAS float* G = (LAS float*)(lds + 139264); LAS float* wk = G + 512;
    const int tid = opaque_tid(), lane = tid & 63, w = __builtin_amdgcn_readfirstlane(tid >> 6), g = lane >> 4, lr = lane & 15;
    const size_t row0 = (size_t)b * SEQ + c * 128;
    const int pi = BR * 16 + b * 4 + h;
    if (BR == 0) { gate_scan(p, layer, b, h, c, G); if (tid < 128) wk[tid] = expf(G[192 + tid] - G[320 + 127]); }
    else { if (tid < 128) wk[tid] = expf((float)(127 - tid) * ret_lg(h)); }
    __syncthreads();
    const bf16_t* srcA = BR == 0 ? p.P + row0 * N1 + C_VM + h * 256 : p.P + row0 * N1 + C_KR + h * 256;
    const bf16_t* srcB = BR == 0 ? p.QK + row0 * 2048 + h * 512 + 256 : p.P + row0 * N1 + C_VR + h * 256;
    stage_T<128, 256, true>(At, 272, srcA, N1, wk);
    stage_T<128, 256, false>(Bt, 272, srcB, BR == 0 ? 2048 : N1, wk);
    __syncthreads();
    float* Uo = p.U + ((size_t)pi * 16 + c) * SZ;
#pragma unroll 1
    for (int rt = 0; rt < 2; ++rt) {
        f32x4 acc[16];
#pragma unroll
        for (int j = 0; j < 16; ++j) acc[j] = (f32x4){0.f, 0.f, 0.f, 0.f};
#pragma unroll
        for (int ks = 0; ks < 4; ++ks) {
            const bf16x8 a0 = lds_frag(At, 32 * w + 16 * rt + lr, 272, (32 * ks + 8 * g) * 2);
#pragma unroll
            for (int ct = 0; ct < 16; ++ct) acc[ct] = __builtin_amdgcn_mfma_f32_16x16x32_bf16(a0, lds_frag(Bt, 16 * ct + lr, 272, (32 * ks + 8 * g) * 2), acc[ct], 0, 0, 0);
            __builtin_amdgcn_sched_barrier(0);
        }
#pragma unroll
        for (int ct = 0; ct < 16; ++ct)
#pragma unroll
            for (int r = 0; r < 4; ++r) Uo[(size_t)(32 * w + 16 * rt + 4 * g + r) * 256 + 16 * ct + lr] = acc[ct][r];
    }
    if (BR == 0 && tid < 256) {
        float s = 0.f;
        for (int ss = 0; ss < 128; ++ss) s += wk[ss] * bf2f(*(LAS const bf16_t*)(Bt + tid * 272 + ss * 2));
        p.NU[((size_t)(b * 4 + h) * 16 + c) * 256 + tid] = s;
    }
    __syncthreads();
}

__device__ __forceinline__ void scan_item(const Params& p, int layer, int pi, int slice, LAS unsigned char* lds) {
    LAS float* G = (LAS float*)lds; LAS float* dec = G + 512;
    const int tid = opaque_tid(), br = pi >> 4, bh = pi & 15, b = bh >> 2, h = bh & 3;
    if (br == 0) { gate_scan(p, layer, b, h, -1, G); if (tid < 16) dec[tid] = expf(G[32 + tid] - fmaxf(G[32 + tid], G[16 + tid])); }
    else if (tid < 16) dec[tid] = expf(128.0f * ret_lg(h));
    __syncthreads();
    f32x4 st[4];
#pragma unroll
    for (int j = 0; j < 4; ++j) st[j] = (f32x4){0.f, 0.f, 0.f, 0.f};
    for (int c = 0; c < 16; ++c) {
        const float dc = dec[c];
#pragma unroll
        for (int j = 0; j < 4; ++j) { const size_t idx = (size_t)slice * 8192 + j * 2048 + tid * 4;
            const f32x4 u = *(const f32x4*)(p.U + ((size_t)pi * 16 + c) * SZ + idx);
            *(u32x2*)(p.CS + ((size_t)pi * 16 + c) * SZ + idx) = (u32x2){pk2(st[j][0], st[j][1]), pk2(st[j][2], st[j][3])};
            st[j] = st[j] * dc + u; }
    }
    float* fo = p.out + (br == 0 ? O_CP : O_SP) + (((size_t)layer * BP + b) * HM + h) * SZ;
#pragma unroll
    for (int j = 0; j < 4; ++j) *(f32x4*)(fo + (size_t)slice * 8192 + j * 2048 + tid * 4) = st[j];
    if (br == 0 && slice == 0) {
        if (tid < 256) { float n = 0.f;
            for (int c = 0; c < 16; ++c) { p.NS[((size_t)bh * 16 + c) * 256 + tid] = n; n = dec[c] * n + p.NU[((size_t)bh * 16 + c) * 256 + tid]; }
            p.out[O_NP + (((size_t)layer * BP + b) * HM + h) * 256 + tid] = n; }
        if (tid == 0) p.out[O_MP + ((size_t)layer * BP + b) * HM + h] = G[48];
    }
    __syncthreads();
}

template <int BR>
__device__ __forceinline__ void chunk_passC(const Params& p, int layer, int b, int h, int c, LAS unsigned char* lds) {
    LAS unsigned char* BufB = lds; LAS unsigned char* Sw = lds + 69632; LAS float* G = (LAS float*)(lds + 104448);
    LAS float* av = G + 512; LAS float* fl = G + 640; LAS bf16_t* nbf = (LAS bf16_t*)(G + 768);
    const int tid = opaque_tid(), lane = tid & 63, w = __builtin_amdgcn_readfirstlane(tid >> 6), g = lane >> 4, lr = lane & 15;
    const size_t row0 = (size_t)b * SEQ + c * 128;
    const int pi = BR * 16 + b * 4 + h;
    const float lg = ret_lg(h);
    if (BR == 0) {
        gate_scan(p, layer, b, h, c, G);
        if (tid < 128) { av[tid] = expf(G[32 + c] - G[320 + tid]); fl[tid] = expf(-(G[64 + tid] + G[320 + tid])); }
        if (tid < 256) nbf[tid] = f2bf(p.NS[((size_t)(b * 4 + h) * 16 + c) * 256 + tid]);
    } else { if (tid < 128) av[tid] = expf((float)(tid + 1) * lg); }
    const bf16_t* Qp = BR == 0 ? p.QK + (row0 + 16 * w + lr) * 2048 + h * 512 : p.P + (row0 + 16 * w + lr) * N1 + C_QR + h * 256;
    bf16x8 qf[8];
#pragma unroll
    for (int ks = 0; ks < 8; ++ks) qf[ks] = *(const bf16x8*)(Qp + 32 * ks + 8 * g);
    stage_rows(BufB, BR == 0 ? p.QK + row0 * 2048 + h * 512 + 256 : p.P + row0 * N1 + C_KR + h * 256, BR == 0 ? 2048 : N1);
    __syncthreads();
    float rs[4] = {0.f, 0.f, 0.f, 0.f};
#pragma unroll
    for (int j = 0; j < 8; ++j) {
        f32x4 a = (f32x4){0.f, 0.f, 0.f, 0.f};
        if (j <= w) {
#pragma unroll
            for (int ks = 0; ks < 8; ++ks) a = __builtin_amdgcn_mfma_f32_16x16x32_bf16(qf[ks], lds_frag(BufB, 16 * j + lr, 528, (32 * ks + 8 * g) * 2), a, 0, 0, 0);
        }
#pragma unroll
        for (int r = 0; r < 4; ++r) {
            const int l = 16 * w + 4 * g + r, s = 16 * j + lr;
            float d = 0.f;
            if (s <= l) d = BR == 0 ? expf(G[192 + s] - G[320 + l]) : expf((float)(l - s) * lg);
            const float v = a[r] * d;
            rs[r] += v;
            *(LAS bf16_t*)(Sw + (l * 136 + s) * 2) = f2bf(v);
        }
        __builtin_amdgcn_sched_barrier(0);
    }
#pragma unroll
    for (int r = 0; r < 4; ++r) { rs[r] += __shfl_xor(rs[r], 1); rs[r] += __shfl_xor(rs[r], 2); rs[r] += __shfl_xor(rs[r], 4); rs[r] += __shfl_xor(rs[r], 8); }
    __syncthreads();
    f32x4 accN[16];
#pragma unroll
    for (int t = 0; t < 16; ++t) accN[t] = (f32x4){0.f, 0.f, 0.f, 0.f};
    const bf16_t* CSp = p.CS + ((size_t)pi * 16 + c) * SZ;
#pragma unroll
    for (int half = 0; half < 2; ++half) {
        if (BR == 0) stage_rows(BufB, CSp + (size_t)half * 128 * 256, 256);
        else stage_T<256, 128, false>(BufB, 528, CSp + half * 128, 256, av);
        __syncthreads();
#pragma unroll
        for (int t = 0; t < 8; ++t) {
#pragma unroll
            for (int ks = 0; ks < 8; ++ks)
                accN[half * 8 + t] = __builtin_amdgcn_mfma_f32_16x16x32_bf16(qf[ks], lds_frag(BufB, 16 * t + lr, 528, (32 * ks + 8 * g) * 2), accN[half * 8 + t], 0, 0, 0);
            __builtin_amdgcn_sched_barrier(0); }
        __syncthreads();
    }
    float nq[4] = {0.f, 0.f, 0.f, 0.f};
    if (BR == 0) {
        f32x4 ad = (f32x4){0.f, 0.f, 0.f, 0.f};
#pragma unroll
        for (int ks = 0; ks < 8; ++ks) {
            bf16x8 nf = *(LAS const bf16x8*)(nbf + 32 * ks + 8 * g);
            if (lr != 0) nf = (bf16x8){0, 0, 0, 0, 0, 0, 0, 0};
            ad = __builtin_amdgcn_mfma_f32_16x16x32_bf16(qf[ks], nf, ad, 0, 0, 0);
        }
#pragma unroll
        for (int r = 0; r < 4; ++r) nq[r] = __shfl(ad[r], lane & 48);
    }
    float ar[4];
#pragma unroll
    for (int r = 0; r < 4; ++r) ar[r] = av[16 * w + 4 * g + r];
#pragma unroll
    for (int t = 0; t < 16; ++t)
#pragma unroll
        for (int r = 0; r < 4; ++r) accN[t][r] *= ar[r];
    stage_T<128, 256, false>(BufB, 272, p.P + row0 * N1 + (BR == 0 ? C_VM : C_VR) + h * 256, N1, av);
    __syncthreads();
#pragma unroll
    for (int ks = 0; ks < 4; ++ks) {
        const bf16x8 af = lds_frag(Sw, 16 * w + lr, 272, (32 * ks + 8 * g) * 2);
#pragma unroll
        for (int t = 0; t < 16; ++t) accN[t] = __builtin_amdgcn_mfma_f32_16x16x32_bf16(af, lds_frag(BufB, 16 * t + lr, 272, (32 * ks + 8 * g) * 2), accN[t], 0, 0, 0);
        __builtin_amdgcn_sched_barrier(0);
    }
    float inv[4];
#pragma unroll
    for (int r = 0; r < 4; ++r) {
        if (BR == 0) { const float den = fmaxf(fabsf(rs[r] + ar[r] * nq[r]), fl[16 * w + 4 * g + r]); inv[r] = 1.0f / den; }
        else inv[r] = 1.0f;
    }
    float mu[4], rstd[4];
#pragma unroll
    for (int r = 0; r < 4; ++r) {
        float s = 0.f;
#pragma unroll
        for (int t = 0; t < 16; ++t) { accN[t][r] *= inv[r]; s += accN[t][r]; }
        s += __shfl_xor(s, 1); s += __shfl_xor(s, 2); s += __shfl_xor(s, 4); s += __shfl_xor(s, 8);
        mu[r] = s * (1.0f / 256.0f);
        float q = 0.f;
#pragma unroll
        for (int t = 0; t < 16; ++t) { const float d = accN[t][r] - mu[r]; q += d * d; }
        q += __shfl_xor(q, 1); q += __shfl_xor(q, 2); q += __shfl_xor(q, 4); q += __shfl_xor(q, 8);
        rstd[r] = rsqrtf(q * (1.0f / 256.0f) + EPS);
    }
    const float* gain = (BR == 0 ? p.hn_m_g : p.hn_r_g) + (size_t)layer * WM + h * 256;
    const float* skip = p.skip_m + (size_t)layer * WM + h * 256;
#pragma unroll
    for (int t = 0; t < 16; ++t) {
        const int e = 16 * t + lr;
        const float ge = gain[e], sk = BR == 0 ? skip[e] : 0.f;
#pragma unroll
        for (int r = 0; r < 4; ++r) {
            const size_t row = row0 + 16 * w + 4 * g + r;
            float v = (accN[t][r] - mu[r]) * rstd[r] * ge;
            const float z = bf2f(p.P[row * N1 + (BR == 0 ? C_ZM : C_ZR) + h * 256 + e]);
            if (BR == 0) v += sk * bf2f(p.CM[row * WM + h * 256 + e]);
            p.OC[row * 2048 + BR * 1024 + h * 256 + e] = f2bf(v * siluf_(z));
        }
        __builtin_amdgcn_sched_barrier(0);
    }
    __syncthreads();
}

template <int BR>
__device__ __forceinline__ void sample_item(const Params& p, int layer, int b, int h, LAS unsigned char* lds) {
    LAS float* sq = (LAS float*)lds; LAS float* sk = sq + 256; LAS float* sv = sk + 256; LAS float* sn = sv + 256; LAS float* sr = sn + 256; LAS float* red = sr + 256;
    LAS float* part = red + 64;
    const int tid = opaque_tid(), lane = tid & 63, wid = tid >> 6;
    const size_t R = (size_t)MP + b;
    const size_t sidx = ((size_t)layer * BS + b) * HM + h;
    if (tid < 256) {
        if (BR == 0) { sq[tid] = bf2f(p.QK[R * 2048 + h * 512 + tid]); sk[tid] = bf2f(p.QK[R * 2048 + h * 512 + 256 + tid]); sv[tid] = bf2f(p.P[R * N1 + C_VM + h * 256 + tid]); sn[tid] = p.st_n[sidx * 256 + tid]; }
        else { sq[tid] = bf2f(p.P[R * N1 + C_QR + h * 256 + tid]); sk[tid] = bf2f(p.P[R * N1 + C_KR + h * 256 + tid]); sv[tid] = bf2f(p.P[R * N1 + C_VR + h * 256 + tid]); sn[tid] = 0.f; }
    }
    __syncthreads();
    float pq = 0.f, pn = 0.f;
    if (tid < 256) { pq = sq[tid] * sk[tid]; pn = sn[tid] * sq[tid]; }
    block_sum2(pq, pn, red);
    const float qk = pq, nq = pn;
    float wgt = 1.f, a = 1.f, mt = 0.f;
    if (BR == 0) {
        const float ig = p.IF[R * 8 + h] + p.b_i[layer * HM + h];
        const float lf = logsigf_(p.IF[R * 8 + 4 + h] + p.b_f[layer * HM + h]);
        const float inter = lf + p.st_m[sidx];
        mt = fmaxf(inter, ig); wgt = expf(ig - mt); a = expf(inter - mt);
    } else { a = 1.0f - exp2f(-5.0f - (float)h); }
    const float* S0 = (BR == 0 ? p.st_C : p.st_S) + sidx * SZ;
    float* S1 = p.out + (BR == 0 ? O_CS : O_SS) + sidx * SZ;
    if (BR == 0) {
        const f32x4 q4 = *(LAS const f32x4*)(sq + 4 * lane), k4 = *(LAS const f32x4*)(sk + 4 * lane);
        for (int i0 = 0; i0 < 32; i0 += 8) {
            f32x4 cc[8];
#pragma unroll
            for (int j = 0; j < 8; ++j) cc[j] = *(const f32x4*)(S0 + (size_t)(wid + 8 * (i0 + j)) * 256 + 4 * lane);
#pragma unroll
            for (int j = 0; j < 8; ++j) { const int e = wid + 8 * (i0 + j);
                float pt = (cc[j][0] * q4[0] + cc[j][1] * q4[1]) + (cc[j][2] * q4[2] + cc[j][3] * q4[3]);
                const float wv = wgt * sv[e];
                *(f32x4*)(S1 + (size_t)e * 256 + 4 * lane) = cc[j] * a + k4 * wv;
                pt = wave_sum(pt);
                if (lane == 0) sr[e] = pt; }
        }
    } else {
        const f32x4 v4 = *(LAS const f32x4*)(sv + 4 * lane);
        f32x4 ac = (f32x4){0.f, 0.f, 0.f, 0.f};
        for (int i0 = 0; i0 < 32; i0 += 8) {
            f32x4 cc[8];
#pragma unroll
            for (int j = 0; j < 8; ++j) cc[j] = *(const f32x4*)(S0 + (size_t)(wid + 8 * (i0 + j)) * 256 + 4 * lane);
#pragma unroll
            for (int j = 0; j < 8; ++j) { const int d = wid + 8 * (i0 + j);
                ac = ac + cc[j] * sq[d];
                *(f32x4*)(S1 + (size_t)d * 256 + 4 * lane) = cc[j] * a + v4 * sk[d]; }
        }
        *(LAS f32x4*)(part + wid * 256 + 4 * lane) = ac;
    }
    __syncthreads();
    float hv = 0.f;
    if (tid < 256) {
        if (BR == 0) {
            const float ws = wgt * qk;
            const float den = fmaxf(fabsf(ws + a * nq), expf(-mt));
            hv = (ws * sv[tid] + a * sr[tid]) / den;
            p.out[O_NS + sidx * 256 + tid] = a * sn[tid] + wgt * sk[tid];
            if (tid == 0) p.out[O_MS + sidx] = mt;
        } else {
            float s = 0.f;
#pragma unroll
            for (int i = 0; i < 8; ++i) s += part[i * 256 + tid];
            hv = qk * sv[tid] + a * s;
        }
    }
    float s1 = hv, s2 = 0.f;
    block_sum2(s1, s2, red);
    const float mean = s1 * (1.0f / 256.0f);
    float dv = tid < 256 ? hv - mean : 0.f;
    float q1 = dv * dv, q2 = 0.f;
    block_sum2(q1, q2, red);
    const float rstd = rsqrtf(q1 * (1.0f / 256.0f) + EPS);
    if (tid < 256) {
        const float ge = (BR == 0 ? p.hn_m_g : p.hn_r_g)[(size_t)layer * WM + h * 256 + tid];
        float v = dv * rstd * ge;
        const float z = bf2f(p.P[R * N1 + (BR == 0 ? C_ZM : C_ZR) + h * 256 + tid]);
        if (BR == 0) v += p.skip_m[(size_t)layer * WM + h * 256 + tid] * bf2f(p.CM[R * WM + h * 256 + tid]);
        p.OC[R * 2048 + BR * 1024 + h * 256 + tid] = f2bf(v * siluf_(z));
    }
    __syncthreads();
}

__device__ __forceinline__ void phaseA(const Params& p, int layer, int wg, int nwg, LAS unsigned char* lds) {
    for (int it = wg; it < 1536; it += nwg) {
        if (it < 512) {
            const int br = it >> 8, rest = it & 255, b = rest >> 6, h = (rest >> 4) & 3, c = rest & 15;
            if (br == 0) chunk_passA<0>(p, layer, b, h, c, lds); else chunk_passA<1>(p, layer, b, h, c, lds);
        } else {
            const int s = it - 512, br = s >> 9, b = (s >> 2) & 127, h = s & 3;
            if (br == 0) sample_item<0>(p, layer, b, h, lds); else sample_item<1>(p, layer, b, h, lds);
        }
    }
}
__device__ __forceinline__ void phaseScan(const Params& p, int layer, int wg, int nwg, LAS unsigned char* lds) {
    for (int it = wg; it < 256; it += nwg) scan_item(p, layer, it >> 3, it & 7, lds);
}
__device__ __forceinline__ void phaseC(const Params& p, int layer, int wg, int nwg, LAS unsigned char* lds) {
    for (int it = wg; it < 512; it += nwg) {
        const int br = it >> 8, rest = it & 255, b = rest >> 6, h = (rest >> 4) & 3, c = rest & 15;
        if (br == 0) chunk_passC<0>(p, layer, b, h, c, lds); else chunk_passC<1>(p, layer, b, h, c, lds);
    }
}

template <int ONLY>
__device__ __forceinline__ void run_phases(const Params& p, int ph_lo, int ph_hi) {
    extern __shared__ __attribute__((aligned(16))) unsigned char smem_raw[];
    LAS unsigned char* lds = (LAS unsigned char*)smem_raw;
    volatile LAS unsigned* xbw = (volatile LAS unsigned*)(lds + LDS_BYTES - 16);
    const int wg = blockIdx.x, nwg = gridDim.x;
    const bool multi = (ph_hi - ph_lo) > 1;
    XcdBarrier bar; bar.bar = p.bar; bar.x = 0; bar.st = xbw;
    if (multi) {
        if (threadIdx.x == 0) { xbw[0] = 0u; xbw[1] = 0u; xbw[2] = 0u; xbw[3] = 0u; }
        __syncthreads();
        bar = xcd_barrier_post(p.bar, xbw);
    }
    int ph = 0;
#define PHASE(KIND, ...) { if constexpr (ONLY < 0 || ONLY == KIND) { if (ph >= ph_lo && ph < ph_hi) { __VA_ARGS__; if (ph + 1 < ph_hi) xcd_barrier(bar); } } ++ph; }
    PHASE(0, prep_phase(p, wg, nwg, lds))
    for (int layer = 0; layer < DEPTH; ++layer) {
        const bf16_t* Wl = p.W + (size_t)layer * WL;
        PHASE(1, norm_phase(p, layer, wg, nwg))
        PHASE(2, { pg8::StaticOrder S; S.init(MPAD, N1, nwg, wg); pg8::Gemm g{p.H, Wl + W1_OFF, D, D, D, 31, 0};
                pg8::EpiBf16 E{p.P, N1, p.BIAS1 + (size_t)layer * N1}; pg8::gemm_phase(lds, g, S, E); })
        PHASE(3, conv_phase(p, layer, wg, nwg))
        PHASE(4, { pg8::StaticOrder S; S.init(MPAD, 2048, nwg, wg); pg8::Gemm g{p.CM, Wl + W2_OFF, 256, WM, 256, 1, 512};
                pg8::EpiBf16 E{p.QK, 2048, nullptr}; pg8::gemm_phase(lds, g, S, E); })
        PHASE(5, phaseA(p, layer, wg, nwg, lds))
        PHASE(6, phaseScan(p, layer, wg, nwg, lds))
        PHASE(7, phaseC(p, layer, wg, nwg, lds))
        PHASE(8, { pg8::StaticOrder S; S.init(MPAD, 2048, nwg, wg); pg8::Gemm g{p.OC, Wl + W3_OFF, 1024, 2048, 2048, 31, 0};
                pg8::EpiGateF32 E{p.T3, p.P + C_GM, N1}; pg8::gemm_phase(lds, g, S, E); })
        PHASE(9, { pg8::StaticOrder S; S.init(MPAD, 2048, nwg, wg); pg8::Gemm g{p.OC + 1024, Wl + W3_OFF + 1024, 1024, 2048, 2048, 31, 0};
                pg8::EpiGateAddBf16 E{p.MG, p.T3, p.P + C_GR, N1}; pg8::gemm_phase(lds, g, S, E); })
        PHASE(10, { pg8::StaticOrder S; S.init(MPAD, 2048, nwg, wg); pg8::Gemm g{p.MG, Wl + W4_OFF, 2048, 2048, 2048, 31, 0};
                pg8::EpiResidual E{p.X}; pg8::gemm_phase(lds, g, S, E); })
    }
    PHASE(11, final_phase(p, wg, nwg))
#undef PHASE
}
__global__ void __launch_bounds__(512, 2) mega(Params p, int ph_lo, int ph_hi) { run_phases<-1>(p, ph_lo, ph_hi); }
#ifdef DIAG
template <int K> __global__ void __launch_bounds__(512, 2) mega_k(Params p, int ph_lo, int ph_hi) { run_phases<K>(p, ph_lo, ph_hi); }
template __global__ void mega_k<0>(Params, int, int); template __global__ void mega_k<1>(Params, int, int); template __global__ void mega_k<2>(Params, int, int);
template __global__ void mega_k<3>(Params, int, int); template __global__ void mega_k<4>(Params, int, int); template __global__ void mega_k<5>(Params, int, int);
template __global__ void mega_k<6>(Params, int, int); template __global__ void mega_k<7>(Params, int, int); template __global__ void mega_k<8>(Params, int, int);
template __global__ void mega_k<9>(Params, int, int); template __global__ void mega_k<10>(Params, int, int); template __global__ void mega_k<11>(Params, int, int);
#endif
constexpr int N_PHASES = 2 + DEPTH * 10;

extern "C" void kernel_launch(void* const* d_in, const int* in_sizes, int n_in, void* d_out, int out_size, void* d_ws, size_t ws_size, hipStream_t stream) {
    (void)in_sizes; (void)n_in; (void)out_size; (void)ws_size;
    static int grid = 0;
    if (grid == 0) {
        int dev = 0, cus = 0;
        hipGetDevice(&dev);
        hipDeviceGetAttribute(&cus, hipDeviceAttributeMultiprocessorCount, dev);
        if (hipFuncSetAttribute((const void*)mega, hipFuncAttributeMaxDynamicSharedMemorySize, LDS_BYTES) != hipSuccess) fprintf(stderr, "hipFuncSetAttribute failed\n");
        (void)hipGetLastError();
        grid = cus > 0 ? cus : 256;
    }
    Params p{};
    const float** in = (const float**)&p;
    for (int i = 0; i < 24; ++i) in[i] = (const float*)d_in[i];
    p.out = (float*)d_out;
    unsigned char* ws = (unsigned char*)d_ws;
    size_t off = 0;
    auto take = [&](size_t bytes) { unsigned char* r = ws + off; off += (bytes + 255) & ~(size_t)255; return r; };
    p.bar = (unsigned*)take(16384);
    p.X = (float*)take((size_t)MPAD * D * 4);
    p.H = (bf16_t*)take((size_t)MPAD * D * 2);
    p.P = (bf16_t*)take((size_t)MPAD * N1 * 2);
    p.IF = (float*)take((size_t)MPAD * 8 * 4);
    p.CM = (bf16_t*)take((size_t)MPAD * WM * 2);
    p.QK = (bf16_t*)take((size_t)MPAD * 2048 * 2);
    p.OC = (bf16_t*)take((size_t)MPAD * 2048 * 2);
    p.T3 = (float*)take((size_t)MPAD * 2048 * 4);
    p.MG = (bf16_t*)take((size_t)MPAD * 2048 * 2);
    p.U = (float*)take((size_t)32 * 16 * SZ * 4);
    p.CS = (bf16_t*)take((size_t)32 * 16 * SZ * 2);
    p.NU = (float*)take((size_t)16 * 16 * 256 * 4);
    p.NS = (float*)take((size_t)16 * 16 * 256 * 4);
    p.W = (bf16_t*)take((size_t)DEPTH * WL * 2);
    p.WIF = (float*)take((size_t)DEPTH * 8 * D * 4);
    p.BIAS1 = (float*)take((size_t)DEPTH * N1 * 4);
    p.ROPE = (float*)take((size_t)2049 * 128 * 2 * 4);
    hipMemsetAsync(p.bar, 0, 16384, stream);
#if MK_SINGLE
    hipLaunchKernelGGL(mega, dim3(grid), dim3(512), LDS_BYTES, stream, p, 0, N_PHASES);
#else
    for (int ph = 0; ph < N_PHASES; ++ph) hipLaunchKernelGGL(mega, dim3(grid), dim3(512), LDS_BYTES, stream, p, ph, ph + 1);
#endif
}
```

```cpp
#include <hip/hip_runtime.h>
#include <stdint.h>
#include <stdio.h>

#ifndef MK_SINGLE
#define MK_SINGLE 1
#endif

#define LAS __attribute__((address_space(3)))
typedef unsigned short bf16_t;
typedef short bf16x8 __attribute__((ext_vector_type(8)));
typedef float f32x4 __attribute__((ext_vector_type(4)));
typedef unsigned u32x4 __attribute__((ext_vector_type(4)));
typedef unsigned u32x2 __attribute__((ext_vector_type(2)));

constexpr int D = 2048, SEQ = 2048, BP = 4, BS = 128, DEPTH = 4, HM = 4, DH = 256, WM = 1024, NIN = 7176;
constexpr int MP = BP * SEQ, MT = MP + BS, MPAD = 8448;
constexpr int N1 = 11264;
constexpr int C_U = 0, C_VM = 1024, C_ZM = 2048, C_QR = 3072, C_KR = 4096, C_VR = 5120, C_ZR = 6144, C_GM = 7168, C_GR = 9216;
constexpr float EPS = 1e-6f;
constexpr size_t SZ = 65536;
constexpr size_t O_YP = 0, O_YS = O_YP + 16777216, O_CP = O_YS + 262144, O_NP = O_CP + 4194304, O_MP = O_NP + 16384, O_CVP = O_MP + 64,
                 O_SP = O_CVP + 49152, O_CS = O_SP + 4194304, O_NS = O_CS + 134217728, O_MS = O_NS + 524288, O_CVS = O_MS + 2048, O_SS = O_CVS + 1572864;
constexpr size_t W1_OFF = 0, W2_OFF = W1_OFF + (size_t)N1 * D, W3_OFF = W2_OFF + (size_t)2048 * 256, W4_OFF = W3_OFF + (size_t)D * D, WL = W4_OFF + (size_t)D * D;
constexpr int LDS_BYTES = 147456;

struct Params {
    const float *x_prompt, *x_sample, *st_C, *st_n, *st_m, *st_conv, *st_S, *norm_g, *w_in, *conv_w, *conv_b, *w_qm, *w_km, *b_i, *b_f,
                *hn_m_g, *skip_m, *hn_r_g, *w_pm, *w_pr, *w_gate, *b_gate, *w_o, *final_g;
    float* out;
    unsigned* bar;
    float* X; bf16_t* H; bf16_t* P; float* IF; bf16_t* CM; bf16_t* QK; bf16_t* OC; float* T3; bf16_t* MG;
    float* U; bf16_t* CS; float* NU; float* NS; bf16_t* W; float* WIF; float* BIAS1; float* ROPE;
};

__device__ __forceinline__ int opaque_tid() { int t = threadIdx.x; asm volatile("" : "+v"(t)); return t; }
__device__ __forceinline__ float bf2f(bf16_t v) { return __uint_as_float((unsigned)v << 16); }
__device__ __forceinline__ bf16_t f2bf(float f) { unsigned u = __float_as_uint(f); u += 0x7fffu + ((u >> 16) & 1u); return (bf16_t)(u >> 16); }
__device__ __forceinline__ unsigned pk2(float lo, float hi) { return (unsigned)f2bf(lo) | ((unsigned)f2bf(hi) << 16); }
__device__ __forceinline__ float wave_sum(float v) {
#pragma unroll
    for (int o = 32; o >= 1; o >>= 1) v += __shfl_xor(v, o);
    return v;
}
__device__ __forceinline__ float wave_max(float v) {
#pragma unroll
    for (int o = 32; o >= 1; o >>= 1) v = fmaxf(v, __shfl_xor(v, o));
    return v;
}
__device__ __forceinline__ float sigmoidf_(float x) { return 1.0f / (1.0f + __expf(-x)); }
__device__ __forceinline__ float siluf_(float x) { return x / (1.0f + __expf(-x)); }
__device__ __forceinline__ float logsigf_(float x) { return x < 0.f ? x - log1pf(expf(x)) : -log1pf(expf(-x)); }
__device__ __forceinline__ void block_sum2(float& a, float& b, LAS float* red) {
    a = wave_sum(a); b = wave_sum(b);
    __syncthreads();
    if ((threadIdx.x & 63) == 0) { red[threadIdx.x >> 6] = a; red[8 + (threadIdx.x >> 6)] = b; }
    __syncthreads();
    float sa = 0.f, sb = 0.f;
#pragma unroll
    for (int i = 0; i < 8; ++i) { sa += red[i]; sb += red[8 + i]; }
    a = sa; b = sb;
}

#define XB_TMO      128
#define XB_XCNT(j)  (256  + 64 * (j))
#define XB_XSUB(j)  (1280 + 64 * (j))
#define XB_XGEN(j)  (2304 + 64 * (j))
#define XB_TOP      3328
#define XB_TOPGEN   3392
#define XCD_BAR_WORDS 3456
#define XB_SPIN_CAP (1u << 22)

__device__ __forceinline__ unsigned xb_ld(unsigned* p)              { return __hip_atomic_load(p, __ATOMIC_RELAXED, __HIP_MEMORY_SCOPE_AGENT); }
__device__ __forceinline__ unsigned xb_add(unsigned* p, unsigned v) { return __hip_atomic_fetch_add(p, v, __ATOMIC_RELAXED, __HIP_MEMORY_SCOPE_AGENT); }
__device__ __forceinline__ unsigned xb_xcc_id() { return (unsigned)__builtin_amdgcn_s_getreg((3 << 11) | 20) & 0xFu; }
#define XB_SPIN(cond, bar) do { unsigned _sp = 0; while (cond) { __builtin_amdgcn_s_sleep(1); \
    if ((++_sp & 255u) == 0u) { if (xb_ld(&(bar)[XB_TMO])) break; if (_sp > XB_SPIN_CAP) { atomicAdd(&(bar)[XB_TMO], 1u); break; } } } } while (0)

struct XcdBarrier { unsigned* bar; unsigned x; volatile LAS unsigned* st; };

__device__ __forceinline__ XcdBarrier xcd_barrier_post(unsigned* bar, volatile LAS unsigned* st) {
    XcdBarrier b; b.bar = bar; b.x = xb_xcc_id(); b.st = st;
    if (threadIdx.x == 0) (void)xb_add(&bar[XB_XCNT(b.x)], 1u);
    return b;
}
__device__ __forceinline__ void xcd_barrier_complete(unsigned* bar, unsigned x, unsigned& nloc, unsigned& nx) {
    const unsigned G = gridDim.x * gridDim.y * gridDim.z;
    unsigned sum, cnt, mine, sp = 0u;
    for (;;) {
        sum = 0u; cnt = 0u; mine = 0u;
#pragma unroll
        for (unsigned j = 0; j < 16; ++j) { const unsigned c = xb_ld(&bar[XB_XCNT(j)]); sum += c; cnt += (c > 0u) ? 1u : 0u; mine = (j == x) ? c : mine; }
        if (sum == G) break;
        __builtin_amdgcn_s_sleep(1);
        if ((++sp & 255u) == 0u) { if (xb_ld(&bar[XB_TMO])) break; if (sp > XB_SPIN_CAP) { atomicAdd(&bar[XB_TMO], 1u); break; } }
    }
    nloc = mine > 0u ? mine : 1u; nx = cnt > 0u ? cnt : 1u;
}
__device__ __forceinline__ void xcd_barrier(const XcdBarrier& b) {
    asm volatile("s_waitcnt vmcnt(0)" ::: "memory");
    __syncthreads();
    if (threadIdx.x == 0) {
        unsigned* bar = b.bar;
        __builtin_amdgcn_s_waitcnt(0);
        unsigned nloc = b.st[0], nx = b.st[1];
        if (nloc == 0u) { xcd_barrier_complete(bar, b.x, nloc, nx); b.st[0] = nloc; b.st[1] = nx; }
        const unsigned old = xb_add(&bar[XB_XSUB(b.x)], 1u);
        const unsigned gen = old / nloc;
        if (old + 1u == (gen + 1u) * nloc) {
            __builtin_amdgcn_fence(__ATOMIC_RELEASE, "agent");
            asm volatile("s_waitcnt vmcnt(0)" ::: "memory");
            const unsigned og = xb_add(&bar[XB_TOP], 1u);
            const unsigned tg = og / nx;
            if (og + 1u == (tg + 1u) * nx) xb_add(&bar[XB_TOPGEN], 1u);
            else XB_SPIN(xb_ld(&bar[XB_TOPGEN]) == tg, bar);
            __builtin_amdgcn_fence(__ATOMIC_ACQUIRE, "agent");
            xb_add(&bar[XB_XGEN(b.x)], 1u);
            asm volatile("s_waitcnt vmcnt(0)" ::: "memory");
        } else {
            XB_SPIN(xb_ld(&bar[XB_XGEN(b.x)]) == gen, bar);
            __builtin_amdgcn_fence(__ATOMIC_ACQUIRE, "agent");
            asm volatile("s_waitcnt vmcnt(0)" ::: "memory");
        }
    }
    __syncthreads();
}

namespace pg8 {
constexpr int BM = 256, BK = 64, HALF = 128, HTB = HALF * BK * 2, STAGE_BYTES = 8 * HTB, NXCD = 8, WGM = 8;
__host__ __device__ __forceinline__ int lds_byte(int r, int c) { const int st = (r >> 4) * 2 + (c >> 5), rr = r & 15, cc = c & 31, ob = rr * 64 + cc * 2; return st * 1024 + (ob ^ (((ob >> 9) & 1) << 5)); }
__host__ __device__ __forceinline__ void stage_rc(int b, int& R, int& C) { const int st = b / 1024, sb = b % 1024, swz = sb ^ (((sb >> 9) & 1) << 5); R = (st >> 1) * 16 + swz / 64; C = (st & 1) * 32 + (swz % 64) / 2; }
__host__ __device__ __forceinline__ int perm32(int rho) { const int n = rho >> 4, i = rho & 15; return 8 * (i >> 2) + 4 * n + (i & 3); }

struct Unit { int pm, pn; };
struct Gemm { const bf16_t* A; const bf16_t* Bt; int K, lda, ldb, a_pn_shift, a_pn_stride; };

struct StaticOrder {
    int nM, nN, nwg, G, c;
    __device__ void init(int M, int N, int G_, int c_) { nM = M / BM; nN = N / BM; nwg = nM * nN; G = G_; c = c_; }
    __device__ bool next(int i, Unit& u) const {
        const long L = (long)i * G + c; if (L >= nwg) return false;
        int wgid = (int)L; { const int q = nwg / NXCD, r = nwg % NXCD, xcd = wgid % NXCD, off = wgid / NXCD; wgid = (xcd < r ? xcd * (q + 1) : r * (q + 1) + (xcd - r) * q) + off; }
        const int nig = WGM * nN, gid = wgid / nig, fm = gid * WGM, gsz = (nM - fm) < WGM ? (nM - fm) : WGM;
        u.pm = fm + ((wgid % nig) % gsz); u.pn = (wgid % nig) / gsz; return true;
    }
};
__device__ __forceinline__ unsigned cvt_pk_bf16(float lo, float hi) { unsigned r; asm volatile("v_cvt_pk_bf16_f32 %0, %1, %2" : "=v"(r) : "v"(lo), "v"(hi)); return r; }

struct EpiBf16 {
    static constexpr bool PERM = true;
    bf16_t* O; int ldc; const float* bias;
    __device__ __forceinline__ void operator()(const f32x4 (&acc)[2][2][4][2], const Unit& u, int wr, int wc, int fr, int fq) const {
        const int row0 = u.pm * BM + wr * 64 + fr, col0 = u.pn * BM + wc * 32 + 8 * fq;
        f32x4 bv[2][2];
#pragma unroll
        for (int bj = 0; bj < 2; ++bj)
#pragma unroll
            for (int n = 0; n < 2; ++n) bv[bj][n] = bias ? *(const f32x4*)(bias + col0 + bj * HALF + 4 * n) : (f32x4){0.f, 0.f, 0.f, 0.f};
#pragma unroll
        for (int ai = 0; ai < 2; ++ai)
#pragma unroll
            for (int m = 0; m < 4; ++m) { bf16_t* rowp = O + (size_t)(row0 + ai * HALF + m * 16) * ldc + col0;
#pragma unroll
                for (int bj = 0; bj < 2; ++bj) { const f32x4 v0 = acc[ai][bj][m][0] + bv[bj][0], v1 = acc[ai][bj][m][1] + bv[bj][1];
                    u32x4 w; w.x = cvt_pk_bf16(v0[0], v0[1]); w.y = cvt_pk_bf16(v0[2], v0[3]); w.z = cvt_pk_bf16(v1[0], v1[1]); w.w = cvt_pk_bf16(v1[2], v1[3]);
                    *(u32x4*)(rowp + bj * HALF) = w; } }
    }
};
struct EpiGateF32 {
    static constexpr bool PERM = false;
    float* T; const bf16_t* G; int ldg;
    __device__ __forceinline__ void operator()(const f32x4 (&acc)[2][2][4][2], const Unit& u, int wr, int wc, int fr, int fq) const {
        const int row0 = u.pm * BM + wr * 64 + fr, col0 = u.pn * BM + wc * 32 + 4 * fq;
#pragma unroll
        for (int ai = 0; ai < 2; ++ai)
#pragma unroll
            for (int m = 0; m < 4; ++m) { const size_t row = (size_t)(row0 + ai * HALF + m * 16);
#pragma unroll
                for (int bj = 0; bj < 2; ++bj)
#pragma unroll
                    for (int n = 0; n < 2; ++n) { const int col = col0 + bj * HALF + n * 16;
                        const u32x2 gb = *(const u32x2*)(G + row * ldg + col);
                        f32x4 gt; gt[0] = sigmoidf_(__uint_as_float(gb.x << 16)); gt[1] = sigmoidf_(__uint_as_float(gb.x & 0xffff0000u));
                        gt[2] = sigmoidf_(__uint_as_float(gb.y << 16)); gt[3] = sigmoidf_(__uint_as_float(gb.y & 0xffff0000u));
                        *(f32x4*)(T + row * 2048 + col) = acc[ai][bj][m][n] * gt; } }
    }
};
struct EpiGateAddBf16 {
    static constexpr bool PERM = true;
    bf16_t* O; const float* T; const bf16_t* G; int ldg;
    __device__ __forceinline__ void operator()(const f32x4 (&acc)[2][2][4][2], const Unit& u, int wr, int wc, int fr, int fq) const {
        const int row0 = u.pm * BM + wr * 64 + fr, col0 = u.pn * BM + wc * 32 + 8 * fq;
#pragma unroll
        for (int ai = 0; ai < 2; ++ai)
#pragma unroll
            for (int m = 0; m < 4; ++m) { const size_t row = (size_t)(row0 + ai * HALF + m * 16);
#pragma unroll
                for (int bj = 0; bj < 2; ++bj) { const int col = col0 + bj * HALF;
                    const u32x4 gb = *(const u32x4*)(G + row * ldg + col);
                    const f32x4 t0 = *(const f32x4*)(T + row * 2048 + col), t1 = *(const f32x4*)(T + row * 2048 + col + 4);
                    f32x4 g0, g1;
                    g0[0] = sigmoidf_(__uint_as_float(gb.x << 16)); g0[1] = sigmoidf_(__uint_as_float(gb.x & 0xffff0000u));
                    g0[2] = sigmoidf_(__uint_as_float(gb.y << 16)); g0[3] = sigmoidf_(__uint_as_float(gb.y & 0xffff0000u));
                    g1[0] = sigmoidf_(__uint_as_float(gb.z << 16)); g1[1] = sigmoidf_(__uint_as_float(gb.z & 0xffff0000u));
                    g1[2] = sigmoidf_(__uint_as_float(gb.w << 16)); g1[3] = sigmoidf_(__uint_as_float(gb.w & 0xffff0000u));
                    const f32x4 v0 = t0 + acc[ai][bj][m][0] * g0, v1 = t1 + acc[ai][bj][m][1] * g1;
                    u32x4 w; w.x = cvt_pk_bf16(v0[0], v0[1]); w.y = cvt_pk_bf16(v0[2], v0[3]); w.z = cvt_pk_bf16(v1[0], v1[1]); w.w = cvt_pk_bf16(v1[2], v1[3]);
                    *(u32x4*)(O + row * 2048 + col) = w; } }
    }
};
struct EpiResidual {
    static constexpr bool PERM = false;
    float* X;
    __device__ __forceinline__ void operator()(const f32x4 (&acc)[2][2][4][2], const Unit& u, int wr, int wc, int fr, int fq) const {
        const int row0 = u.pm * BM + wr * 64 + fr, col0 = u.pn * BM + wc * 32 + 4 * fq;
#pragma unroll
        for (int ai = 0; ai < 2; ++ai)
#pragma unroll
            for (int m = 0; m < 4; ++m) { float* rowp = X + (size_t)(row0 + ai * HALF + m * 16) * 2048 + col0;
#pragma unroll
                for (int bj = 0; bj < 2; ++bj)
#pragma unroll
                    for (int n = 0; n < 2; ++n) { f32x4* q = (f32x4*)(rowp + bj * HALF + n * 16); *q = *q + acc[ai][bj][m][n]; } }
    }
};

template <class Epi, class Sched>
__device__ __forceinline__ void gemm_phase(LAS unsigned char* lds, const Gemm g, const Sched& S, const Epi& E) {
    const int tid = opaque_tid(), wid = __builtin_amdgcn_readfirstlane(tid >> 6), lane = tid & 63, wr = wid >> 2, wc = wid & 3, fr = lane & 15, fq = lane >> 4;
    const int K = g.K, nt = K / BK;
    unsigned voffA[2], voffB[2];
#pragma unroll
    for (int i = 0; i < 2; ++i) { int R, C; stage_rc(tid * 16 + i * 8192, R, C); const int Rb = Epi::PERM ? ((R & ~31) + perm32(R & 31)) : R;
        voffA[i] = (unsigned)(R * g.lda + C) * 2u; voffB[i] = (unsigned)(Rb * g.ldb + C) * 2u; }
    const size_t kstep = (size_t)(BK * 2);
    const size_t hstepA = (size_t)HALF * g.lda * 2, hstepB = (size_t)HALF * g.ldb * 2;
    const size_t tstepA = 2 * hstepA, tstepB = 2 * hstepB;
    const unsigned ldsw = (unsigned)wid * 1024u;
    const int aoff = lds_byte(wr * 64 + fr, fq * 8), boff = lds_byte(wc * 32 + fr, fq * 8);
#define PG8_SA(b, h) (((b) * 2 + (h)) * HTB)
#define PG8_SB(b, h) ((4 + (b) * 2 + (h)) * HTB)
#define PG8_STAGE(bufoff, gbase, voff) do { _Pragma("unroll") for (int _i = 0; _i < 2; ++_i) \
        __builtin_amdgcn_global_load_lds((const unsigned*)((const char*)(gbase) + (voff)[_i]), (LAS unsigned*)(lds + (bufoff) + ldsw + _i * 8192), 16, 0, 0); } while (0)
#define PG8_LDA(dst, b, h) do { _Pragma("unroll") for (int m = 0; m < 4; ++m) _Pragma("unroll") for (int k = 0; k < 2; ++k) dst[m][k] = *(const LAS bf16x8*)(lds + PG8_SA(b, h) + aoff + m * 2048 + k * 1024); } while (0)
#define PG8_LDB(dst, b, h) do { _Pragma("unroll") for (int n = 0; n < 2; ++n) _Pragma("unroll") for (int k = 0; k < 2; ++k) dst[n][k] = *(const LAS bf16x8*)(lds + PG8_SB(b, h) + boff + n * 2048 + k * 1024); } while (0)
#define PG8_MMA(ai, bj, At, Bt) do { __builtin_amdgcn_s_setprio(1); _Pragma("unroll") for (int m = 0; m < 4; ++m) _Pragma("unroll") for (int n = 0; n < 2; ++n) _Pragma("unroll") for (int k = 0; k < 2; ++k) \
        acc[ai][bj][m][n] = __builtin_amdgcn_mfma_f32_16x16x32_bf16(Bt[n][k], At[m][k], acc[ai][bj][m][n], 0, 0, 0); __builtin_amdgcn_s_setprio(0); } while (0)
#define PG8_WAIT_V(n) asm volatile("s_waitcnt vmcnt(" #n ")" ::: "memory")
#define PG8_WAIT_L(n) asm volatile("s_waitcnt lgkmcnt(" #n ")" ::: "memory")
#define PG8_BAR __builtin_amdgcn_s_barrier()
#define PG8_SCHED __builtin_amdgcn_sched_barrier(0)
#define PG8_APTR(u) ((const char*)g.A + (size_t)(u).pm * tstepA + (size_t)((u).pn >> g.a_pn_shift) * (size_t)g.a_pn_stride)
    Unit cur, nxt; int ui = 0;
    if (!S.next(0, cur)) return;
    f32x4 acc[2][2][4][2];
#pragma unroll
    for (int a = 0; a < 2; ++a)
#pragma unroll
        for (int b = 0; b < 2; ++b)
#pragma unroll
            for (int m = 0; m < 4; ++m)
#pragma unroll
                for (int n = 0; n < 2; ++n) acc[a][b][m][n] = (f32x4){0.f, 0.f, 0.f, 0.f};
    bf16x8 At[4][2], B0[2][2], B1[2][2];
    const char* cA = PG8_APTR(cur); const char* cB = (const char*)g.Bt + (size_t)cur.pn * tstepB;
    PG8_STAGE(PG8_SB(0, 0), cB, voffB); PG8_STAGE(PG8_SA(0, 0), cA, voffA); PG8_STAGE(PG8_SB(0, 1), cB + hstepB, voffB); PG8_STAGE(PG8_SA(0, 1), cA + hstepA, voffA);
    if (wr == 1) PG8_BAR;
    PG8_WAIT_V(4); PG8_BAR;
    PG8_STAGE(PG8_SB(1, 0), cB + kstep, voffB); PG8_STAGE(PG8_SA(1, 0), cA + kstep, voffA); PG8_STAGE(PG8_SB(1, 1), cB + hstepB + kstep, voffB);
    PG8_WAIT_V(6); PG8_BAR;
    for (;;) {
        const bool has_next = S.next(ui + 1, nxt);
        const char* nA = has_next ? PG8_APTR(nxt) : cA; const char* nB = has_next ? (const char*)g.Bt + (size_t)nxt.pn * tstepB : cB;
        for (int t = 0; t < nt; t += 2) {
            const bool last = (t == nt - 2);
            const char* a1 = cA + (size_t)(t + 1) * kstep;
            const char* a2 = last ? nA : cA + (size_t)(t + 2) * kstep; const char* b2 = last ? nB : cB + (size_t)(t + 2) * kstep;
            const char* a3 = a2 + kstep; const char* b3 = b2 + kstep;
            PG8_LDB(B0, 0, 0); PG8_SCHED; PG8_LDA(At, 0, 0); PG8_STAGE(PG8_SA(1, 1), a1 + hstepA, voffA);
            PG8_WAIT_L(8); PG8_BAR; PG8_WAIT_L(0); PG8_MMA(0, 0, At, B0); PG8_BAR; PG8_SCHED;
            PG8_LDB(B1, 0, 1); PG8_STAGE(PG8_SB(0, 0), b2, voffB);
            PG8_BAR; PG8_WAIT_L(0); PG8_MMA(0, 1, At, B1); PG8_BAR;
            PG8_LDA(At, 0, 1); PG8_STAGE(PG8_SA(0, 0), a2, voffA);
            PG8_BAR; PG8_WAIT_L(0); PG8_MMA(1, 0, At, B0); PG8_BAR; PG8_SCHED;
            PG8_STAGE(PG8_SB(0, 1), b2 + hstepB, voffB);
            PG8_WAIT_V(6); PG8_BAR; PG8_MMA(1, 1, At, B1); PG8_BAR;
            PG8_LDB(B0, 1, 0); PG8_SCHED; PG8_LDA(At, 1, 0); PG8_STAGE(PG8_SA(0, 1), a2 + hstepA, voffA);
            PG8_WAIT_L(8); PG8_BAR; PG8_WAIT_L(0); PG8_MMA(0, 0, At, B0); PG8_BAR; PG8_SCHED;
            PG8_LDB(B1, 1, 1); PG8_STAGE(PG8_SB(1, 0), b3, voffB);
            PG8_BAR; PG8_WAIT_L(0); PG8_MMA(0, 1, At, B1); PG8_BAR;
            PG8_LDA(At, 1, 1); PG8_STAGE(PG8_SA(1, 0), a3, voffA);
            PG8_BAR; PG8_WAIT_L(0); PG8_MMA(1, 0, At, B0); PG8_BAR; PG8_SCHED;
            PG8_STAGE(PG8_SB(1, 1), b3 + hstepB, voffB);
            PG8_WAIT_V(6); PG8_BAR; PG8_MMA(1, 1, At, B1); PG8_BAR;
        }
        E(acc, cur, wr, wc, fr, fq);
        if (!has_next) break;
#pragma unroll
        for (int a = 0; a < 2; ++a)
#pragma unroll
            for (int b = 0; b < 2; ++b)
#pragma unroll
                for (int m = 0; m < 4; ++m)
#pragma unroll
                    for (int n = 0; n < 2; ++n) acc[a][b][m][n] = (f32x4){0.f, 0.f, 0.f, 0.f};
        cur = nxt; cA = nA; cB = nB; ++ui;
    }
    PG8_WAIT_V(0);
    if (wr == 0) PG8_BAR;
    PG8_BAR;
#undef PG8_SA
#undef PG8_SB
#undef PG8_STAGE
#undef PG8_LDA
#undef PG8_LDB
#undef PG8_MMA
#undef PG8_WAIT_V
#undef PG8_WAIT_L
#undef PG8_BAR
#undef PG8_SCHED
#undef PG8_APTR
}
}

__device__ __forceinline__ void tr_tile(const float* src, int ldsrc, int k0, int c0, bf16_t* dst, int ldd, int r0, int kd0, float scale, LAS float* t) {
    const int tid = opaque_tid(), lo = tid & 63, hi = tid >> 6;
#pragma unroll
    for (int i = 0; i < 8; ++i) { const int k = hi + 8 * i; t[k * 65 + lo] = src[(size_t)(k0 + k) * ldsrc + c0 + lo]; }
    __syncthreads();
#pragma unroll
    for (int i = 0; i < 8; ++i) { const int n = hi + 8 * i; dst[(size_t)(r0 + n) * ldd + kd0 + lo] = f2bf(scale * t[lo * 65 + n]); }
    __syncthreads();
}
__device__ __forceinline__ void prep_phase(const Params& p, int wg, int nwg, LAS unsigned char* lds) {
    const int tid = opaque_tid();
    for (size_t i = (size_t)wg * 512 + tid; i < (size_t)MPAD * D / 4; i += (size_t)nwg * 512) {
        const size_t row = (i * 4) / D;
        f32x4 v = (f32x4){0.f, 0.f, 0.f, 0.f};
        if (row < (size_t)MP) v = ((const f32x4*)p.x_prompt)[i];
        else if (row < (size_t)MT) v = ((const f32x4*)p.x_sample)[i - (size_t)MP * D / 4];
        ((f32x4*)p.X)[i] = v;
    }
    for (int i = wg * 512 + tid; i < 2049 * 128; i += nwg * 512) {
        const int pi = i >> 7, j = i & 127;
        const float pos = pi < 2048 ? (float)pi : 16384.0f;
        const float inv = powf(10000.0f, -((float)j / 128.0f));
        const float ang = pos * inv;
        p.ROPE[2 * i] = (float)cos((double)ang); p.ROPE[2 * i + 1] = (float)sin((double)ang);
    }
    for (int i = wg * 512 + tid; i < DEPTH * 8 * D; i += nwg * 512) {
        const int l = i / (8 * D), r = i % (8 * D), j = r / D, k = r % D;
        p.WIF[i] = p.w_in[((size_t)l * D + k) * NIN + 3072 + j];
    }
    for (int i = wg * 512 + tid; i < DEPTH * N1; i += nwg * 512) {
        const int l = i / N1, n = i % N1;
        p.BIAS1[i] = n < C_GM ? 0.f : p.b_gate[l * 4096 + (n - C_GM)];
    }
    LAS float* t = (LAS float*)lds;
    constexpr int T0 = 1536, T1 = T0 + 2048, T2 = T1 + 2048, T3 = T2 + 512, T4 = T3 + 512, T5 = T4 + 1024, T6 = T5 + 64, T7 = T6 + 64;
    for (int it = wg; it < DEPTH * T7; it += nwg) {
        const int l = it / T7, r = it % T7;
        bf16_t* Wl = p.W + (size_t)l * WL;
        if (r < T0)      { const int q = r;      tr_tile(p.w_in + (size_t)l * D * NIN, NIN, (q & 31) * 64, (q >> 5) * 64, Wl + W1_OFF, D, (q >> 5) * 64, (q & 31) * 64, 1.f, t); }
        else if (r < T1) { const int q = r - T0; tr_tile(p.w_in + (size_t)l * D * NIN, NIN, (q & 31) * 64, 3080 + (q >> 5) * 64, Wl + W1_OFF, D, 3072 + (q >> 5) * 64, (q & 31) * 64, 1.f, t); }
        else if (r < T2) { const int q = r - T1; tr_tile(p.w_gate + (size_t)l * D * 4096, 4096, (q & 31) * 64, (q >> 5) * 64, Wl + W1_OFF, D, C_GM + (q >> 5) * 64, (q & 31) * 64, 1.f, t); }
        else if (r < T3) { const int q = r - T2; tr_tile(p.w_pm + (size_t)l * WM * D, D, (q & 15) * 64, (q >> 4) * 64, Wl + W3_OFF, D, (q >> 4) * 64, (q & 15) * 64, 1.f, t); }
        else if (r < T4) { const int q = r - T3; tr_tile(p.w_pr + (size_t)l * WM * D, D, (q & 15) * 64, (q >> 4) * 64, Wl + W3_OFF, D, (q >> 4) * 64, 1024 + (q & 15) * 64, 1.f, t); }
        else if (r < T5) { const int q = r - T4; tr_tile(p.w_o + (size_t)l * D * D, D, (q & 31) * 64, (q >> 5) * 64, Wl + W4_OFF, D, (q >> 5) * 64, (q & 31) * 64, 1.f, t); }
        else if (r < T6) { const int q = r - T5, h = q >> 4, qq = q & 15; tr_tile(p.w_qm + ((size_t)l * HM + h) * SZ, DH, (qq & 3) * 64, (qq >> 2) * 64, Wl + W2_OFF, DH, h * 512 + (qq >> 2) * 64, (qq & 3) * 64, 0.0625f, t); }
        else             { const int q = r - T6, h = q >> 4, qq = q & 15; tr_tile(p.w_km + ((size_t)l * HM + h) * SZ, DH, (qq & 3) * 64, (qq >> 2) * 64, Wl + W2_OFF, DH, h * 512 + 256 + (qq >> 2) * 64, (qq & 3) * 64, 1.f, t); }
    }
}

__device__ __forceinline__ void norm_phase(const Params& p, int layer, int wg, int nwg) {
    const int tid_ = opaque_tid(), lane = tid_ & 63, wid = tid_ >> 6;
    const f32x4* g4 = (const f32x4*)(p.norm_g + (size_t)layer * D);
    const float* wif = p.WIF + (size_t)layer * 8 * D;
    for (int row = wg * 8 + wid; row < MPAD; row += nwg * 8) {
        u32x2* hrow = (u32x2*)(p.H + (size_t)row * D);
        if (row >= MT) {
#pragma unroll
            for (int i = 0; i < 8; ++i) hrow[lane + 64 * i] = (u32x2){0u, 0u};
            continue;
        }
        const f32x4* xr = (const f32x4*)(p.X + (size_t)row * D);
        f32x4 v[8]; float ss = 0.f;
#pragma unroll
        for (int i = 0; i < 8; ++i) { v[i] = xr[lane + 64 * i]; ss += (v[i][0] * v[i][0] + v[i][1] * v[i][1]) + (v[i][2] * v[i][2] + v[i][3] * v[i][3]); }
        ss = wave_sum(ss);
        const float rstd = rsqrtf(ss * (1.0f / D) + EPS);
#pragma unroll
        for (int i = 0; i < 8; ++i) {
            v[i] = v[i] * rstd * g4[lane + 64 * i];
            hrow[lane + 64 * i] = (u32x2){pk2(v[i][0], v[i][1]), pk2(v[i][2], v[i][3])};
        }
#pragma unroll 1
        for (int j = 0; j < 8; ++j) {
            float s = 0.f;
#pragma unroll
            for (int i = 0; i < 8; ++i) { const f32x4 w = ((const f32x4*)(wif + (size_t)j * D))[lane + 64 * i]; s += (v[i][0] * w[0] + v[i][1] * w[1]) + (v[i][2] * w[2] + v[i][3] * w[3]); }
            s = wave_sum(s);
            if (lane == 0) p.IF[(size_t)row * 8 + j] = s;
        }
    }
}
__device__ __forceinline__ void final_phase(const Params& p, int wg, int nwg) {
    const int tid_ = opaque_tid(), lane = tid_ & 63, wid = tid_ >> 6;
    const f32x4* g4 = (const f32x4*)p.final_g;
    for (int row = wg * 8 + wid; row < MT; row += nwg * 8) {
        const f32x4* xr = (const f32x4*)(p.X + (size_t)row * D);
        f32x4* yr = (f32x4*)(p.out + (row < MP ? O_YP + (size_t)row * D : O_YS + (size_t)(row - MP) * D));
        f32x4 v[8]; float ss = 0.f;
#pragma unroll
        for (int i = 0; i < 8; ++i) { v[i] = xr[lane + 64 * i]; ss += (v[i][0] * v[i][0] + v[i][1] * v[i][1]) + (v[i][2] * v[i][2] + v[i][3] * v[i][3]); }
        ss = wave_sum(ss);
        const float rstd = rsqrtf(ss * (1.0f / D) + EPS);
#pragma unroll
        for (int i = 0; i < 8; ++i) yr[lane + 64 * i] = v[i] * rstd * g4[lane + 64 * i];
    }
}

__device__ __forceinline__ void unpack8(const u32x4 v, float (&f)[8]) {
    f[0] = __uint_as_float(v.x << 16); f[1] = __uint_as_float(v.x & 0xffff0000u); f[2] = __uint_as_float(v.y << 16); f[3] = __uint_as_float(v.y & 0xffff0000u);
    f[4] = __uint_as_float(v.z << 16); f[5] = __uint_as_float(v.z & 0xffff0000u); f[6] = __uint_as_float(v.w << 16); f[7] = __uint_as_float(v.w & 0xffff0000u);
}
__device__ __forceinline__ u32x4 pack8(const float (&f)[8]) { u32x4 w; w.x = pk2(f[0], f[1]); w.y = pk2(f[2], f[3]); w.z = pk2(f[4], f[5]); w.w = pk2(f[6], f[7]); return w; }

__device__ __forceinline__ void conv_phase(const Params& p, int layer, int wg, int nwg) {
    const int tid = opaque_tid();
    const float* cw = p.conv_w + (size_t)layer * 4 * WM;
    const float* cb = p.conv_b + (size_t)layer * WM;
    for (int it = wg * 512 + tid; it < MT * 128; it += nwg * 512) {
        const int row = it >> 7, ch = (it & 127) * 8;
        float up[4][8];
        if (row < MP) {
            const int t = row & (SEQ - 1);
#pragma unroll
            for (int i = 0; i < 4; ++i) {
                if (t - 3 + i >= 0) unpack8(*(const u32x4*)(p.P + (size_t)(row - 3 + i) * N1 + C_U + ch), up[i]);
                else {
#pragma unroll
                    for (int j = 0; j < 8; ++j) up[i][j] = 0.f;
                }
            }
            if (t >= SEQ - 3) {
                const int b = row >> 11;
                float* o = p.out + O_CVP + (((size_t)layer * BP + b) * 3 + (t - (SEQ - 3))) * WM + ch;
                *(f32x4*)o = (f32x4){up[3][0], up[3][1], up[3][2], up[3][3]}; *(f32x4*)(o + 4) = (f32x4){up[3][4], up[3][5], up[3][6], up[3][7]};
            }
        } else {
            const int b = row - MP;
            const float* hist = p.st_conv + ((size_t)layer * BS + b) * 3 * WM + ch;
#pragma unroll
            for (int i = 0; i < 3; ++i) { const f32x4 a = *(const f32x4*)(hist + (size_t)i * WM), c = *(const f32x4*)(hist + (size_t)i * WM + 4);
                up[i][0] = a[0]; up[i][1] = a[1]; up[i][2] = a[2]; up[i][3] = a[3]; up[i][4] = c[0]; up[i][5] = c[1]; up[i][6] = c[2]; up[i][7] = c[3]; }
            unpack8(*(const u32x4*)(p.P + (size_t)row * N1 + C_U + ch), up[3]);
            float* o = p.out + O_CVS + ((size_t)layer * BS + b) * 3 * WM + ch;
#pragma unroll
            for (int i = 0; i < 3; ++i) { *(f32x4*)(o + (size_t)i * WM) = (f32x4){up[i + 1][0], up[i + 1][1], up[i + 1][2], up[i + 1][3]};
                *(f32x4*)(o + (size_t)i * WM + 4) = (f32x4){up[i + 1][4], up[i + 1][5], up[i + 1][6], up[i + 1][7]}; }
        }
        float r[8];
#pragma unroll
        for (int j = 0; j < 8; ++j) r[j] = cb[ch + j];
#pragma unroll
        for (int i = 0; i < 4; ++i)
#pragma unroll
            for (int j = 0; j < 8; ++j) r[j] += up[i][j] * cw[i * WM + ch + j];
#pragma unroll
        for (int j = 0; j < 8; ++j) r[j] = siluf_(r[j]);
        *(u32x4*)(p.CM + (size_t)row * WM + ch) = pack8(r);
    }
    for (int it = wg * 512 + tid; it < MT * 128; it += nwg * 512) {
        const int row = it >> 7, r2 = it & 127, which = r2 >> 6, h = (r2 >> 4) & 3, d0 = (r2 & 15) * 8;
        const int pi = row < MP ? (row & (SEQ - 1)) : 2048;
        bf16_t* base = p.P + (size_t)row * N1 + (which ? C_KR : C_QR) + h * 256 + d0;
        float x1[8], x2[8], o1[8], o2[8];
        unpack8(*(const u32x4*)base, x1); unpack8(*(const u32x4*)(base + 128), x2);
        const float* cs = p.ROPE + ((size_t)pi * 128 + d0) * 2;
        const float sc = which ? 0.0625f : 1.0f;
#pragma unroll
        for (int j = 0; j < 8; ++j) { const float c = cs[2 * j], s = cs[2 * j + 1]; o1[j] = (x1[j] * c - x2[j] * s) * sc; o2[j] = (x1[j] * s + x2[j] * c) * sc; }
        *(u32x4*)base = pack8(o1); *(u32x4*)(base + 128) = pack8(o2);
    }
}

__device__ __forceinline__ void gate_scan(const Params& p, int layer, int b, int h, int c_own, LAS float* G) {
    const int tid = opaque_tid(), lane = tid & 63, wid = tid >> 6;
    const float bi = p.b_i[layer * HM + h], bfv = p.b_f[layer * HM + h];
#pragma unroll
    for (int q = 0; q < 2; ++q) {
        const int cc = wid + 8 * q;
        const size_t r0 = (size_t)b * SEQ + cc * 128 + 2 * lane;
        const float i0 = p.IF[r0 * 8 + h] + bi, i1 = p.IF[(r0 + 1) * 8 + h] + bi;
        const float l0 = logsigf_(p.IF[r0 * 8 + 4 + h] + bfv), l1 = logsigf_(p.IF[(r0 + 1) * 8 + 4 + h] + bfv);
        float inc = l0 + l1;
#pragma unroll
        for (int o = 1; o < 64; o <<= 1) { const float t = __shfl_up(inc, o); if (lane >= o) inc += t; }
        const float exc = inc - (l0 + l1);
        const float b0 = exc + l0, b1 = inc;
        const float g0 = i0 - b0, g1 = i1 - b1;
        const float gm = wave_max(fmaxf(g0, g1));
        const float Bc = __shfl(inc, 63);
        if (lane == 0) { G[cc] = Bc; G[16 + cc] = gm; }
        if (cc == c_own) {
            float rm = fmaxf(g0, g1);
#pragma unroll
            for (int o = 1; o < 64; o <<= 1) { const float t = __shfl_up(rm, o); if (lane >= o) rm = fmaxf(rm, t); }
            float ex = __shfl_up(rm, 1); if (lane == 0) ex = -3.0e38f;
            const float c0 = fmaxf(ex, g0), c1 = fmaxf(c0, g1);
            G[64 + 2 * lane] = b0; G[65 + 2 * lane] = b1; G[192 + 2 * lane] = g0; G[193 + 2 * lane] = g1; G[320 + 2 * lane] = c0; G[321 + 2 * lane] = c1;
        }
    }
    __syncthreads();
    if (tid == 0) { float m = -1e30f; for (int cc = 0; cc < 16; ++cc) { G[32 + cc] = m; m = G[cc] + fmaxf(m, G[16 + cc]); } G[48] = m; }
    __syncthreads();
    if (c_own >= 0 && tid < 128) G[320 + tid] = fmaxf(G[320 + tid], G[32 + c_own]);
    __syncthreads();
}

template <int NR, int NC, bool WEIGHT>
__device__ __forceinline__ void stage_T(LAS unsigned char* dst, int ldd_bytes, const bf16_t* src, int ld_src, LAS const float* w) {
    const int tid_ = opaque_tid(), lane = tid_ & 63, wid = tid_ >> 6;
    constexpr int PB = NR / 128, CG = NC / 8;
#pragma unroll 1
    for (int task = wid; task < PB * CG; task += 8) {
        const int pb = task % PB, cg = task / PB, r = pb * 128 + 2 * lane;
        float a[8], c[8];
        unpack8(*(const u32x4*)(src + (size_t)r * ld_src + cg * 8), a); unpack8(*(const u32x4*)(src + (size_t)(r + 1) * ld_src + cg * 8), c);
        float w0 = 1.f, w1 = 1.f; if (WEIGHT) { w0 = w[r]; w1 = w[r + 1]; }
#pragma unroll
        for (int j = 0; j < 8; ++j) *(LAS unsigned*)(dst + (cg * 8 + j) * ldd_bytes + r * 2) = pk2(a[j] * w0, c[j] * w1);
    }
}
__device__ __forceinline__ void stage_rows(LAS unsigned char* dst, const bf16_t* src, int ld_src) {
    const int tid_ = opaque_tid();
#pragma unroll
    for (int i = 0; i < 8; ++i) { const int id = tid_ + 512 * i, row = id >> 5, ch = id & 31;
        *(LAS u32x4*)(dst + row * 528 + ch * 16) = *(const u32x4*)(src + (size_t)row * ld_src + ch * 8); }
}
__device__ __forceinline__ bf16x8 lds_frag(LAS const unsigned char* base, int row, int ld_bytes, int kbyte) { return *(LAS const bf16x8*)(base + row * ld_bytes + kbyte); }
__device__ __forceinline__ float ret_lg(int h) { return logf(1.0f - exp2f(-5.0f - (float)h)); }

template <int BR>
__device__ __forceinline__ void chunk_passA(const Params& p, int layer, int b, int h, int c, LAS unsigned char* lds) {
    LAS unsigned char* At = lds; LAS unsigned char* Bt = lds + 69632; LAS float* G = (LAS float*)(lds + 139264); LAS float* wk = G + 512;
    const int tid = opaque_tid(), lane = tid & 63, w = __builtin_amdgcn_readfirstlane(tid >> 6), g = lane >> 4, lr = lane & 15;
    const size_t row0 = (size_t)b * SEQ + c * 128;
    const int pi = BR * 16 + b * 4 + h;
    if (BR == 0) { gate_scan(p, layer, b, h, c, G); if (tid < 128) wk[tid] = expf(G[192 + tid] - G[320 + 127]); }
    else { if (tid < 128) wk[tid] = expf((float)(127 - tid) * ret_lg(h)); }
    __syncthreads();
    const bf16_t* srcA = BR == 0 ? p.P + row0 * N1 + C_VM + h * 256 : p.P + row0 * N1 + C_KR + h * 256;
    const bf16_t* srcB = BR == 0 ? p.QK + row0 * 2048 + h * 512 + 256 : p.P + row0 * N1 + C_VR + h * 256;
    stage_T<128, 256, true>(At, 272, srcA, N1, wk);
    stage_T<128, 256, false>(Bt, 272, srcB, BR == 0 ? 2048 : N1, wk);
    __syncthreads();
    float* Uo = p.U + ((size_t)pi * 16 + c) * SZ;
#pragma unroll 1
    for (int rt = 0; rt < 2; ++rt) {
        f32x4 acc[16];
#pragma unroll
        for (int j = 0; j < 16; ++j) acc[j] = (f32x4){0.f, 0.f, 0.f, 0.f};
#pragma unroll
        for (int ks = 0; ks < 4; ++ks) {
            const bf16x8 a0 = lds_frag(At, 32 * w + 16 * rt + lr, 272, (32 * ks + 8 * g) * 2);
#pragma unroll
            for (int ct = 0; ct < 16; ++ct) acc[ct] = __builtin_amdgcn_mfma_f32_16x16x32_bf16(a0, lds_frag(Bt, 16 * ct + lr, 272, (32 * ks + 8 * g) * 2), acc[ct], 0, 0, 0);
            __builtin_amdgcn_sched_barrier(0);
        }
#pragma unroll
        for (int ct = 0; ct < 16; ++ct)
#pragma unroll
            for (int r = 0; r < 4; ++r) Uo[(size_t)(32 * w + 16 * rt + 4 * g + r) * 256 + 16 * ct + lr] = acc[ct][r];
    }
    if (BR == 0 && tid < 256) {
        float s = 0.f;
        for (int ss = 0; ss < 128; ++ss) s += wk[ss] * bf2f(*(LAS const bf16_t*)(Bt + tid * 272 + ss * 2));
        p.NU[((size_t)(b * 4 + h) * 16 + c) * 256 + tid] = s;
    }
    __syncthreads();
}

__device__ __forceinline__ void scan_item(const Params& p, int layer, int pi, int slice, LAS unsigned char* lds) {
    LAS float* G = (LAS float*)lds; LAS float* dec = G + 512;
    const int tid = opaque_tid(), br = pi >> 4, bh = pi & 15, b = bh >> 2, h = bh & 3;
    if (br == 0) { gate_scan(p, layer, b, h, -1, G); if (tid < 16) dec[tid] = expf(G[32 + tid] - fmaxf(G[32 + tid], G[16 + tid])); }
    else if (tid < 16) dec[tid] = expf(128.0f * ret_lg(h));
    __syncthreads();
    f32x4 st[4];
#pragma unroll
    for (int j = 0; j < 4; ++j) st[j] = (f32x4){0.f, 0.f, 0.f, 0.f};
    for (int c = 0; c < 16; ++c) {
        const float dc = dec[c];
#pragma unroll
        for (int j = 0; j < 4; ++j) { const size_t idx = (size_t)slice * 8192 + j * 2048 + tid * 4;
            const f32x4 u = *(const f32x4*)(p.U + ((size_t)pi * 16 + c) * SZ + idx);
            *(u32x2*)(p.CS + ((size_t)pi * 16 + c) * SZ + idx) = (u32x2){pk2(st[j][0], st[j][1]), pk2(st[j][2], st[j][3])};
            st[j] = st[j] * dc + u; }
    }
    float* fo = p.out + (br == 0 ? O_CP : O_SP) + (((size_t)layer * BP + b) * HM + h) * SZ;
#pragma unroll
    for (int j = 0; j < 4; ++j) *(f32x4*)(fo + (size_t)slice * 8192 + j * 2048 + tid * 4) = st[j];
    if (br == 0 && slice == 0) {
        if (tid < 256) { float n = 0.f;
            for (int c = 0; c < 16; ++c) { p.NS[((size_t)bh * 16 + c) * 256 + tid] = n; n = dec[c] * n + p.NU[((size_t)bh * 16 + c) * 256 + tid]; }
            p.out[O_NP + (((size_t)layer * BP + b) * HM + h) * 256 + tid] = n; }
        if (tid == 0) p.out[O_MP + ((size_t)layer * BP + b) * HM + h] = G[48];
    }
    __syncthreads();
}

template <int BR>
__device__ __forceinline__ void chunk_passC(const Params& p, int layer, int b, int h, int c, LAS unsigned char* lds) {
    LAS unsigned char* BufB = lds; LAS unsigned char* Sw = lds + 69632; LAS float* G = (LAS float*)(lds + 104448);
    LAS float* av = G + 512; LAS float* fl = G + 640; LAS bf16_t* nbf = (LAS bf16_t*)(G + 768);
    const int tid = opaque_tid(), lane = tid & 63, w = __builtin_amdgcn_readfirstlane(tid >> 6), g = lane >> 4, lr = lane & 15;
    const size_t row0 = (size_t)b * SEQ + c * 128;
    const int pi = BR * 16 + b * 4 + h;
    const float lg = ret_lg(h);
    if (BR == 0) {
        gate_scan(p, layer, b, h, c, G);
        if (tid < 128) { av[tid] = expf(G[32 + c] - G[320 + tid]); fl[tid] = expf(-(G[64 + tid] + G[320 + tid])); }
        if (tid < 256) nbf[tid] = f2bf(p.NS[((size_t)(b * 4 + h) * 16 + c) * 256 + tid]);
    } else { if (tid < 128) av[tid] = expf((float)(tid + 1) * lg); }
    const bf16_t* Qp = BR == 0 ? p.QK + (row0 + 16 * w + lr) * 2048 + h * 512 : p.P + (row0 + 16 * w + lr) * N1 + C_QR + h * 256;
    bf16x8 qf[8];
#pragma unroll
    for (int ks = 0; ks < 8; ++ks) qf[ks] = *(const bf16x8*)(Qp + 32 * ks + 8 * g);
    stage_rows(BufB, BR == 0 ? p.QK + row0 * 2048 + h * 512 + 256 : p.P + row0 * N1 + C_KR + h * 256, BR == 0 ? 2048 : N1);
    __syncthreads();
    float rs[4] = {0.f, 0.f, 0.f, 0.f};
#pragma unroll
    for (int j = 0; j < 8; ++j) {
        f32x4 a = (f32x4){0.f, 0.f, 0.f, 0.f};
        if (j <= w) {
#pragma unroll
            for (int ks = 0; ks < 8; ++ks) a = __builtin_amdgcn_mfma_f32_16x16x32_bf16(qf[ks], lds_frag(BufB, 16 * j + lr, 528, (32 * ks + 8 * g) * 2), a, 0, 0, 0);
        }
#pragma unroll
        for (int r = 0; r < 4; ++r) {
            const int l = 16 * w + 4 * g + r, s = 16 * j + lr;
            float d = 0.f;
            if (s <= l) d = BR == 0 ? expf(G[192 + s] - G[320 + l]) : expf((float)(l - s) * lg);
            const float v = a[r] * d;
            rs[r] += v;
            *(LAS bf16_t*)(Sw + (l * 136 + s) * 2) = f2bf(v);
        }
        __builtin_amdgcn_sched_barrier(0);
    }
#pragma unroll
    for (int r = 0; r < 4; ++r) { rs[r] += __shfl_xor(rs[r], 1); rs[r] += __shfl_xor(rs[r], 2); rs[r] += __shfl_xor(rs[r], 4); rs[r] += __shfl_xor(rs[r], 8); }
    __syncthreads();
    f32x4 accN[16];
#pragma unroll
    for (int t = 0; t < 16; ++t) accN[t] = (f32x4){0.f, 0.f, 0.f, 0.f};
    const bf16_t* CSp = p.CS + ((size_t)pi * 16 + c) * SZ;
#pragma unroll
    for (int half = 0; half < 2; ++half) {
        if (BR == 0) stage_rows(BufB, CSp + (size_t)half * 128 * 256, 256);
        else stage_T<256, 128, false>(BufB, 528, CSp + half * 128, 256, av);
        __syncthreads();
#pragma unroll
        for (int t = 0; t < 8; ++t) {
#pragma unroll
            for (int ks = 0; ks < 8; ++ks)
                accN[half * 8 + t] = __builtin_amdgcn_mfma_f32_16x16x32_bf16(qf[ks], lds_frag(BufB, 16 * t + lr, 528, (32 * ks + 8 * g) * 2), accN[half * 8 + t], 0, 0, 0);
            __builtin_amdgcn_sched_barrier(0); }
        __syncthreads();
    }
    float nq[4] = {0.f, 0.f, 0.f, 0.f};
    if (BR == 0) {
        f32x4 ad = (f32x4){0.f, 0.f, 0.f, 0.f};
#pragma unroll
        for (int ks = 0; ks < 8; ++ks) {
            bf16x8 nf = *(LAS const bf16x8*)(nbf + 32 * ks + 8 * g);
            if (lr != 0) nf = (bf16x8){0, 0, 0, 0, 0, 0, 0, 0};
            ad = __builtin_amdgcn_mfma_f32_16x16x32_bf16(qf[ks], nf, ad, 0, 0, 0);
        }
#pragma unroll
        for (int r = 0; r < 4; ++r) nq[r] = __shfl(ad[r], lane & 48);
    }
    float ar[4];
#pragma unroll
    for (int r = 0; r < 4; ++r) ar[r] = av[16 * w + 4 * g + r];
#pragma unroll
    for (int t = 0; t < 16; ++t)
#pragma unroll
        for (int r = 0; r < 4; ++r) accN[t][r] *= ar[r];
    stage_T<128, 256, false>(BufB, 272, p.P + row0 * N1 + (BR == 0 ? C_VM : C_VR) + h * 256, N1, av);
    __syncthreads();
#pragma unroll
    for (int ks = 0; ks < 4; ++ks) {
        const bf16x8 af = lds_frag(Sw, 16 * w + lr, 272, (32 * ks + 8 * g) * 2);
#pragma unroll
        for (int t = 0; t < 16; ++t) accN[t] = __builtin_amdgcn_mfma_f32_16x16x32_bf16(af, lds_frag(BufB, 16 * t + lr, 272, (32 * ks + 8 * g) * 2), accN[t], 0, 0, 0);
        __builtin_amdgcn_sched_barrier(0);
    }
    float inv[4];
#pragma unroll
    for (int r = 0; r < 4; ++r) {
        if (BR == 0) { const float den = fmaxf(fabsf(rs[r] + ar[r] * nq[r]), fl[16 * w + 4 * g + r]); inv[r] = 1.0f / den; }
        else inv[r] = 1.0f;
    }
    float mu[4], rstd[4];
#pragma unroll
    for (int r = 0; r < 4; ++r) {
        float s = 0.f;
#pragma unroll
        for (int t = 0; t < 16; ++t) { accN[t][r] *= inv[r]; s += accN[t][r]; }
        s += __shfl_xor(s, 1); s += __shfl_xor(s, 2); s += __shfl_xor(s, 4); s += __shfl_xor(s, 8);
        mu[r] = s * (1.0f / 256.0f);
        float q = 0.f;
#pragma unroll
        for (int t = 0; t < 16; ++t) { const float d = accN[t][r] - mu[r]; q += d * d; }
        q += __shfl_xor(q, 1); q += __shfl_xor(q, 2); q += __shfl_xor(q, 4); q += __shfl_xor(q, 8);
        rstd[r] = rsqrtf(q * (1.0f / 256.0f) + EPS);
    }
    const float* gain = (BR == 0 ? p.hn_m_g : p.hn_r_g) + (size_t)layer * WM + h * 256;
    const float* skip = p.skip_m + (size_t)layer * WM + h * 256;
#pragma unroll
    for (int t = 0; t < 16; ++t) {
        const int e = 16 * t + lr;
        const float ge = gain[e], sk = BR == 0 ? skip[e] : 0.f;
#pragma unroll
        for (int r = 0; r < 4; ++r) {
            const size_t row = row0 + 16 * w + 4 * g + r;
            float v = (accN[t][r] - mu[r]) * rstd[r] * ge;
            const float z = bf2f(p.P[row * N1 + (BR == 0 ? C_ZM : C_ZR) + h * 256 + e]);
            if (BR == 0) v += sk * bf2f(p.CM[row * WM + h * 256 + e]);
            p.OC[row * 2048 + BR * 1024 + h * 256 + e] = f2bf(v * siluf_(z));
        }
        __builtin_amdgcn_sched_barrier(0);
    }
    __syncthreads();
}

template <int BR>
__device__ __forceinline__ void sample_item(const Params& p, int layer, int b, int h, LAS unsigned char* lds) {
    LAS float* sq = (LAS float*)lds; LAS float* sk = sq + 256; LAS float* sv = sk + 256; LAS float* sn = sv + 256; LAS float* sr = sn + 256; LAS float* red = sr + 256;
    LAS float* part = red + 64;
    const int tid = opaque_tid(), lane = tid & 63, wid = tid >> 6;
    const size_t R = (size_t)MP + b;
    const size_t sidx = ((size_t)layer * BS + b) * HM + h;
    if (tid < 256) {
        if (BR == 0) { sq[tid] = bf2f(p.QK[R * 2048 + h * 512 + tid]); sk[tid] = bf2f(p.QK[R * 2048 + h * 512 + 256 + tid]); sv[tid] = bf2f(p.P[R * N1 + C_VM + h * 256 + tid]); sn[tid] = p.st_n[sidx * 256 + tid]; }
        else { sq[tid] = bf2f(p.P[R * N1 + C_QR + h * 256 + tid]); sk[tid] = bf2f(p.P[R * N1 + C_KR + h * 256 + tid]); sv[tid] = bf2f(p.P[R * N1 + C_VR + h * 256 + tid]); sn[tid] = 0.f; }
    }
    __syncthreads();
    float pq = 0.f, pn = 0.f;
    if (tid < 256) { pq = sq[tid] * sk[tid]; pn = sn[tid] * sq[tid]; }
    block_sum2(pq, pn, red);
    const float qk = pq, nq = pn;
    float wgt = 1.f, a = 1.f, mt = 0.f;
    if (BR == 0) {
        const float ig = p.IF[R * 8 + h] + p.b_i[layer * HM + h];
        const float lf = logsigf_(p.IF[R * 8 + 4 + h] + p.b_f[layer * HM + h]);
        const float inter = lf + p.st_m[sidx];
        mt = fmaxf(inter, ig); wgt = expf(ig - mt); a = expf(inter - mt);
    } else { a = 1.0f - exp2f(-5.0f - (float)h); }
    const float* S0 = (BR == 0 ? p.st_C : p.st_S) + sidx * SZ;
    float* S1 = p.out + (BR == 0 ? O_CS : O_SS) + sidx * SZ;
    if (BR == 0) {
        const f32x4 q4 = *(LAS const f32x4*)(sq + 4 * lane), k4 = *(LAS const f32x4*)(sk + 4 * lane);
        for (int i0 = 0; i0 < 32; i0 += 8) {
            f32x4 cc[8];
#pragma unroll
            for (int j = 0; j < 8; ++j) cc[j] = *(const f32x4*)(S0 + (size_t)(wid + 8 * (i0 + j)) * 256 + 4 * lane);
#pragma unroll
            for (int j = 0; j < 8; ++j) { const int e = wid + 8 * (i0 + j);
                float pt = (cc[j][0] * q4[0] + cc[j][1] * q4[1]) + (cc[j][2] * q4[2] + cc[j][3] * q4[3]);
                const float wv = wgt * sv[e];
                *(f32x4*)(S1 + (size_t)e * 256 + 4 * lane) = cc[j] * a + k4 * wv;
                pt = wave_sum(pt);
                if (lane == 0) sr[e] = pt; }
        }
    } else {
        const f32x4 v4 = *(LAS const f32x4*)(sv + 4 * lane);
        f32x4 ac = (f32x4){0.f, 0.f, 0.f, 0.f};
        for (int i0 = 0; i0 < 32; i0 += 8) {
            f32x4 cc[8];
#pragma unroll
            for (int j = 0; j < 8; ++j) cc[j] = *(const f32x4*)(S0 + (size_t)(wid + 8 * (i0 + j)) * 256 + 4 * lane);
#pragma unroll
            for (int j = 0; j < 8; ++j) { const int d = wid + 8 * (i0 + j);
                ac = ac + cc[j] * sq[d];
                *(f32x4*)(S1 + (size_t)d * 256 + 4 * lane) = cc[j] * a + v4 * sk[d]; }
        }
        *(LAS f32x4*)(part + wid * 256 + 4 * lane) = ac;
    }
    __syncthreads();
    float hv = 0.f;
    if (tid < 256) {
        if (BR == 0) {
            const float ws = wgt * qk;
            const float den = fmaxf(fabsf(ws + a * nq), expf(-mt));
            hv = (ws * sv[tid] + a * sr[tid]) / den;
            p.out[O_NS + sidx * 256 + tid] = a * sn[tid] + wgt * sk[tid];
            if (tid == 0) p.out[O_MS + sidx] = mt;
        } else {
            float s = 0.f;
#pragma unroll
            for (int i = 0; i < 8; ++i) s += part[i * 256 + tid];
            hv = qk * sv[tid] + a * s;
        }
    }
    float s1 = hv, s2 = 0.f;
    block_sum2(s1, s2, red);
    const float mean = s1 * (1.0f / 256.0f);
    float dv = tid < 256 ? hv - mean : 0.f;
    float q1 = dv * dv, q2 = 0.f;
    block_sum2(q1, q2, red);
    const float rstd = rsqrtf(q1 * (1.0f / 256.0f) + EPS);
    if (tid < 256) {
        const float ge = (BR == 0 ? p.hn_m_g : p.hn_r_g)[(size_t)layer * WM + h * 256 + tid];
        float v = dv * rstd * ge;
        const float z = bf2f(p.P[R * N1 + (BR == 0 ? C_ZM : C_ZR) + h * 256 + tid]);
        if (BR == 0) v += p.skip_m[(size_t)layer * WM + h * 256 + tid] * bf2f(p.CM[R * WM + h * 256 + tid]);
        p.OC[R * 2048 + BR * 1024 + h * 256 + tid] = f2bf(v * siluf_(z));
    }
    __syncthreads();
}

__device__ __forceinline__ void phaseA(const Params& p, int layer, int wg, int nwg, LAS unsigned char* lds) {
    for (int it = wg; it < 1536; it += nwg) {
        if (it < 512) {
            const int br = it >> 8, rest = it & 255, b = rest >> 6, h = (rest >> 4) & 3, c = rest & 15;
            if (br == 0) chunk_passA<0>(p, layer, b, h, c, lds); else chunk_passA<1>(p, layer, b, h, c, lds);
        } else {
            const int s = it - 512, br = s >> 9, b = (s >> 2) & 127, h = s & 3;
            if (br == 0) sample_item<0>(p, layer, b, h, lds); else sample_item<1>(p, layer, b, h, lds);
        }
    }
}
__device__ __forceinline__ void phaseScan(const Params& p, int layer, int wg, int nwg, LAS unsigned char* lds) {
    for (int it = wg; it < 256; it += nwg) scan_item(p, layer, it >> 3, it & 7, lds);
}
__device__ __forceinline__ void phaseC(const Params& p, int layer, int wg, int nwg, LAS unsigned char* lds) {
    for (int it = wg; it < 512; it += nwg) {
        const int br = it >> 8, rest = it & 255, b = rest >> 6, h = (rest >> 4) & 3, c = rest & 15;
        if (br == 0) chunk_passC<0>(p, layer, b, h, c, lds); else chunk_passC<1>(p, layer, b, h, c, lds);
    }
}

template <int ONLY>
__device__ __forceinline__ void run_phases(const Params& p, int ph_lo, int ph_hi) {
    extern __shared__ __attribute__((aligned(16))) unsigned char smem_raw[];
    LAS unsigned char* lds = (LAS unsigned char*)smem_raw;
    volatile LAS unsigned* xbw = (volatile LAS unsigned*)(lds + LDS_BYTES - 16);
    const int wg = blockIdx.x, nwg = gridDim.x;
    const bool multi = (ph_hi - ph_lo) > 1;
    XcdBarrier bar; bar.bar = p.bar; bar.x = 0; bar.st = xbw;
    if (multi) {
        if (threadIdx.x == 0) { xbw[0] = 0u; xbw[1] = 0u; xbw[2] = 0u; xbw[3] = 0u; }
        __syncthreads();
        bar = xcd_barrier_post(p.bar, xbw);
    }
    int ph = 0;
#define PHASE(KIND, ...) { if constexpr (ONLY < 0 || ONLY == KIND) { if (ph >= ph_lo && ph < ph_hi) { __VA_ARGS__; if (ph + 1 < ph_hi) xcd_barrier(bar); } } ++ph; }
    PHASE(0, prep_phase(p, wg, nwg, lds))
    for (int layer = 0; layer < DEPTH; ++layer) {
        const bf16_t* Wl = p.W + (size_t)layer * WL;
        PHASE(1, norm_phase(p, layer, wg, nwg))
        PHASE(2, { pg8::StaticOrder S; S.init(MPAD, N1, nwg, wg); pg8::Gemm g{p.H, Wl + W1_OFF, D, D, D, 31, 0};
                pg8::EpiBf16 E{p.P, N1, p.BIAS1 + (size_t)layer * N1}; pg8::gemm_phase(lds, g, S, E); })
        PHASE(3, conv_phase(p, layer, wg, nwg))
        PHASE(4, { pg8::StaticOrder S; S.init(MPAD, 2048, nwg, wg); pg8::Gemm g{p.CM, Wl + W2_OFF, 256, WM, 256, 1, 512};
                pg8::EpiBf16 E{p.QK, 2048, nullptr}; pg8::gemm_phase(lds, g, S, E); })
        PHASE(5, phaseA(p, layer, wg, nwg, lds))
        PHASE(6, phaseScan(p, layer, wg, nwg, lds))
        PHASE(7, phaseC(p, layer, wg, nwg, lds))
        PHASE(8, { pg8::StaticOrder S; S.init(MPAD, 2048, nwg, wg); pg8::Gemm g{p.OC, Wl + W3_OFF, 1024, 2048, 2048, 31, 0};
                pg8::EpiGateF32 E{p.T3, p.P + C_GM, N1}; pg8::gemm_phase(lds, g, S, E); })
        PHASE(9, { pg8::StaticOrder S; S.init(MPAD, 2048, nwg, wg); pg8::Gemm g{p.OC + 1024, Wl + W3_OFF + 1024, 1024, 2048, 2048, 31, 0};
                pg8::EpiGateAddBf16 E{p.MG, p.T3, p.P + C_GR, N1}; pg8::gemm_phase(lds, g, S, E); })
        PHASE(10, { pg8::StaticOrder S; S.init(MPAD, 2048, nwg, wg); pg8::Gemm g{p.MG, Wl + W4_OFF, 2048, 2048, 2048, 31, 0};
                pg8::EpiResidual E{p.X}; pg8::gemm_phase(lds, g, S, E); })
    }
    PHASE(11, final_phase(p, wg, nwg))
#undef PHASE
}
__global__ void __launch_bounds__(512, 2) mega(Params p, int ph_lo, int ph_hi) { run_phases<-1>(p, ph_lo, ph_hi); }
#ifdef DIAG
template <int K> __global__ void __launch_bounds__(512, 2) mega_k(Params p, int ph_lo, int ph_hi) { run_phases<K>(p, ph_lo, ph_hi); }
template __global__ void mega_k<0>(Params, int, int); template __global__ void mega_k<1>(Params, int, int); template __global__ void mega_k<2>(Params, int, int);
template __global__ void mega_k<3>(Params, int, int); template __global__ void mega_k<4>(Params, int, int); template __global__ void mega_k<5>(Params, int, int);
template __global__ void mega_k<6>(Params, int, int); template __global__ void mega_k<7>(Params, int, int); template __global__ void mega_k<8>(Params, int, int);
template __global__ void mega_k<9>(Params, int, int); template __global__ void mega_k<10>(Params, int, int); template __global__ void mega_k<11>(Params, int, int);
#endif
constexpr int N_PHASES = 2 + DEPTH * 10;

extern "C" void kernel_launch(void* const* d_in, const int* in_sizes, int n_in, void* d_out, int out_size, void* d_ws, size_t ws_size, hipStream_t stream) {
    (void)in_sizes; (void)n_in; (void)out_size; (void)ws_size;
    static int grid = 0;
    if (grid == 0) {
        int dev = 0, cus = 0;
        hipGetDevice(&dev);
        hipDeviceGetAttribute(&cus, hipDeviceAttributeMultiprocessorCount, dev);
        if (hipFuncSetAttribute((const void*)mega, hipFuncAttributeMaxDynamicSharedMemorySize, LDS_BYTES) != hipSuccess) fprintf(stderr, "hipFuncSetAttribute failed\n");
        (void)hipGetLastError();
        grid = cus > 0 ? cus : 256;
    }
    Params p{};
    const float** in = (const float**)&p;
    for (int i = 0; i < 24; ++i) in[i] = (const float*)d_in[i];
    p.out = (float*)d_out;
    unsigned char* ws = (unsigned char*)d_ws;
    size_t off = 0;
    auto take = [&](size_t bytes) { unsigned char* r = ws + off; off += (bytes + 255) & ~(size_t)255; return r; };
    p.bar = (unsigned*)take(16384);
    p.X = (float*)take((size_t)MPAD * D * 4);
    p.H = (bf16_t*)take((size_t)MPAD * D * 2);
    p.P = (bf16_t*)take((size_t)MPAD * N1 * 2);
    p.IF = (float*)take((size_t)MPAD * 8 * 4);
    p.CM = (bf16_t*)take((size_t)MPAD * WM * 2);
    p.QK = (bf16_t*)take((size_t)MPAD * 2048 * 2);
    p.OC = (bf16_t*)take((size_t)MPAD * 2048 * 2);
    p.T3 = (float*)take((size_t)MPAD * 2048 * 4);
    p.MG = (bf16_t*)take((size_t)MPAD * 2048 * 2);
    p.U = (float*)take((size_t)32 * 16 * SZ * 4);
    p.CS = (bf16_t*)take((size_t)32 * 16 * SZ * 2);
    p.NU = (float*)take((size_t)16 * 16 * 256 * 4);
    p.NS = (float*)take((size_t)16 * 16 * 256 * 4);
    p.W = (bf16_t*)take((size_t)DEPTH * WL * 2);
    p.WIF = (float*)take((size_t)DEPTH * 8 * D * 4);
    p.BIAS1 = (float*)take((size_t)DEPTH * N1 * 4);
    p.ROPE = (float*)take((size_t)2049 * 128 * 2 * 4);
    hipMemsetAsync(p.bar, 0, 16384, stream);
#if MK_SINGLE
    hipLaunchKernelGGL(mega, dim3(grid), dim3(512), LDS_BYTES, stream, p, 0, N_PHASES);
#else
    for (int ph = 0; ph < N_PHASES; ++ph) hipLaunchKernelGGL(mega, dim3(grid), dim3(512), LDS_BYTES, stream, p, ph, ph + 1);
#endif
}
```

```cpp
#include <hip/hip_runtime.h>
#include <stdint.h>
#include <stdio.h>

#ifndef MK_SINGLE
#define MK_SINGLE 1
#endif

#define LAS __attribute__((address_space(3)))
typedef unsigned short bf16_t;
typedef short bf16x8 __attribute__((ext_vector_type(8)));
typedef float f32x4 __attribute__((ext_vector_type(4)));
typedef unsigned u32x4 __attribute__((ext_vector_type(4)));
typedef unsigned u32x2 __attribute__((ext_vector_type(2)));

constexpr int D = 2048, SEQ = 2048, BP = 4, BS = 128, DEPTH = 4, HM = 4, DH = 256, WM = 1024, NIN = 7176;
constexpr int MP = BP * SEQ, MT = MP + BS, MPAD = 8448;
constexpr int N1 = 11264;
constexpr int C_U = 0, C_VM = 1024, C_ZM = 2048, C_QR = 3072, C_KR = 4096, C_VR = 5120, C_ZR = 6144, C_GM = 7168, C_GR = 9216;
constexpr float EPS = 1e-6f;
constexpr size_t SZ = 65536;
constexpr size_t O_YP = 0, O_YS = O_YP + 16777216, O_CP = O_YS + 262144, O_NP = O_CP + 4194304, O_MP = O_NP + 16384, O_CVP = O_MP + 64,
                 O_SP = O_CVP + 49152, O_CS = O_SP + 4194304, O_NS = O_CS + 134217728, O_MS = O_NS + 524288, O_CVS = O_MS + 2048, O_SS = O_CVS + 1572864;
constexpr size_t W1_OFF = 0, W2_OFF = W1_OFF + (size_t)N1 * D, W3_OFF = W2_OFF + (size_t)2048 * 256, W4_OFF = W3_OFF + (size_t)D * D, WL = W4_OFF + (size_t)D * D;
constexpr int LDS_BYTES = 147456;

struct Params {
    const float *x_prompt, *x_sample, *st_C, *st_n, *st_m, *st_conv, *st_S, *norm_g, *w_in, *conv_w, *conv_b, *w_qm, *w_km, *b_i, *b_f,
                *hn_m_g, *skip_m, *hn_r_g, *w_pm, *w_pr, *w_gate, *b_gate, *w_o, *final_g;
    float* out;
    unsigned* bar;
    float* X; bf16_t* H; bf16_t* P; float* IF; bf16_t* CM; bf16_t* QK; bf16_t* OC; float* T3; bf16_t* MG;
    float* U; bf16_t* CS; float* NU; float* NS; bf16_t* W; float* WIF; float* BIAS1; float* ROPE;
};

__device__ __forceinline__ int opaque_tid() { int t = threadIdx.x; asm volatile("" : "+v"(t)); return t; }
__device__ __forceinline__ float bf2f(bf16_t v) { return __uint_as_float((unsigned)v << 16); }
__device__ __forceinline__ bf16_t f2bf(float f) { unsigned u = __float_as_uint(f); u += 0x7fffu + ((u >> 16) & 1u); return (bf16_t)(u >> 16); }
__device__ __forceinline__ unsigned pk2(float lo, float hi) { return (unsigned)f2bf(lo) | ((unsigned)f2bf(hi) << 16); }
__device__ __forceinline__ float wave_sum(float v) {
#pragma unroll
    for (int o = 32; o >= 1; o >>= 1) v += __shfl_xor(v, o);
    return v;
}
__device__ __forceinline__ float wave_max(float v) {
#pragma unroll
    for (int o = 32; o >= 1; o >>= 1) v = fmaxf(v, __shfl_xor(v, o));
    return v;
}
__device__ __forceinline__ float sigmoidf_(float x) { return 1.0f / (1.0f + __expf(-x)); }
__device__ __forceinline__ float siluf_(float x) { return x / (1.0f + __expf(-x)); }
__device__ __forceinline__ float logsigf_(float x) { return x < 0.f ? x - log1pf(expf(x)) : -log1pf(expf(-x)); }
__device__ __forceinline__ void block_sum2(float& a, float& b, LAS float* red) {
    a = wave_sum(a); b = wave_sum(b);
    __syncthreads();
    if ((threadIdx.x & 63) == 0) { red[threadIdx.x >> 6] = a; red[8 + (threadIdx.x >> 6)] = b; }
    __syncthreads();
    float sa = 0.f, sb = 0.f;
#pragma unroll
    for (int i = 0; i < 8; ++i) { sa += red[i]; sb += red[8 + i]; }
    a = sa; b = sb;
}

#define XB_TMO      128
#define XB_XCNT(j)  (256  + 64 * (j))
#define XB_XSUB(j)  (1280 + 64 * (j))
#define XB_XGEN(j)  (2304 + 64 * (j))
#define XB_TOP      3328
#define XB_TOPGEN   3392
#define XCD_BAR_WORDS 3456
#define XB_SPIN_CAP (1u << 22)

__device__ __forceinline__ unsigned xb_ld(unsigned* p)              { return __hip_atomic_load(p, __ATOMIC_RELAXED, __HIP_MEMORY_SCOPE_AGENT); }
__device__ __forceinline__ unsigned xb_add(unsigned* p, unsigned v) { return __hip_atomic_fetch_add(p, v, __ATOMIC_RELAXED, __HIP_MEMORY_SCOPE_AGENT); }
__device__ __forceinline__ unsigned xb_xcc_id() { return (unsigned)__builtin_amdgcn_s_getreg((3 << 11) | 20) & 0xFu; }
#define XB_SPIN(cond, bar) do { unsigned _sp = 0; while (cond) { __builtin_amdgcn_s_sleep(1); \
    if ((++_sp & 255u) == 0u) { if (xb_ld(&(bar)[XB_TMO])) break; if (_sp > XB_SPIN_CAP) { atomicAdd(&(bar)[XB_TMO], 1u); break; } } } } while (0)

struct XcdBarrier { unsigned* bar; unsigned x; volatile LAS unsigned* st; };

__device__ __forceinline__ XcdBarrier xcd_barrier_post(unsigned* bar, volatile LAS unsigned* st) {
    XcdBarrier b; b.bar = bar; b.x = xb_xcc_id(); b.st = st;
    if (threadIdx.x == 0) (void)xb_add(&bar[XB_XCNT(b.x)], 1u);
    return b;
}
__device__ __forceinline__ void xcd_barrier_complete(unsigned* bar, unsigned x, unsigned& nloc, unsigned& nx) {
    const unsigned G = gridDim.x * gridDim.y * gridDim.z;
    unsigned sum, cnt, mine, sp = 0u;
    for (;;) {
        sum = 0u; cnt = 0u; mine = 0u;
#pragma unroll
        for (unsigned j = 0; j < 16; ++j) { const unsigned c = xb_ld(&bar[XB_XCNT(j)]); sum += c; cnt += (c > 0u) ? 1u : 0u; mine = (j == x) ? c : mine; }
        if (sum == G) break;
        __builtin_amdgcn_s_sleep(1);
        if ((++sp & 255u) == 0u) { if (xb_ld(&bar[XB_TMO])) break; if (sp > XB_SPIN_CAP) { atomicAdd(&bar[XB_TMO], 1u); break; } }
    }
    nloc = mine > 0u ? mine : 1u; nx = cnt > 0u ? cnt : 1u;
}
__device__ __forceinline__ void xcd_barrier(const XcdBarrier& b) {
    asm volatile("s_waitcnt vmcnt(0)" ::: "memory");
    __syncthreads();
    if (threadIdx.x == 0) {
        unsigned* bar = b.bar;
        __builtin_amdgcn_s_waitcnt(0);
        unsigned nloc = b.st[0], nx = b.st[1];
        if (nloc == 0u) { xcd_barrier_complete(bar, b.x, nloc, nx); b.st[0] = nloc; b.st[1] = nx; }
        const unsigned old = xb_add(&bar[XB_XSUB(b.x)], 1u);
        const unsigned gen = old / nloc;
        if (old + 1u == (gen + 1u) * nloc) {
            __builtin_amdgcn_fence(__ATOMIC_RELEASE, "agent");
            asm volatile("s_waitcnt vmcnt(0)" ::: "memory");
            const unsigned og = xb_add(&bar[XB_TOP], 1u);
            const unsigned tg = og / nx;
            if (og + 1u == (tg + 1u) * nx) xb_add(&bar[XB_TOPGEN], 1u);
            else XB_SPIN(xb_ld(&bar[XB_TOPGEN]) == tg, bar);
            __builtin_amdgcn_fence(__ATOMIC_ACQUIRE, "agent");
            xb_add(&bar[XB_XGEN(b.x)], 1u);
            asm volatile("s_waitcnt vmcnt(0)" ::: "memory");
        } else {
            XB_SPIN(xb_ld(&bar[XB_XGEN(b.x)]) == gen, bar);
            __builtin_amdgcn_fence(__ATOMIC_ACQUIRE, "agent");
            asm volatile("s_waitcnt vmcnt(0)" ::: "memory");
        }
    }
    __syncthreads();
}

namespace pg8 {
constexpr int BM = 256, BK = 64, HALF = 128, HTB = HALF * BK * 2, STAGE_BYTES = 8 * HTB, NXCD = 8, WGM = 8;
__host__ __device__ __forceinline__ int lds_byte(int r, int c) { const int st = (r >> 4) * 2 + (c >> 5), rr = r & 15, cc = c & 31, ob = rr * 64 + cc * 2; return st * 1024 + (ob ^ (((ob >> 9) & 1) << 5)); }
__host__ __device__ __forceinline__ void stage_rc(int b, int& R, int& C) { const int st = b / 1024, sb = b % 1024, swz = sb ^ (((sb >> 9) & 1) << 5); R = (st >> 1) * 16 + swz / 64; C = (st & 1) * 32 + (swz % 64) / 2; }
__host__ __device__ __forceinline__ int perm32(int rho) { const int n = rho >> 4, i = rho & 15; return 8 * (i >> 2) + 4 * n + (i & 3); }

struct Unit { int pm, pn; };
struct Gemm { const bf16_t* A; const bf16_t* Bt; int K, lda, ldb, a_pn_shift, a_pn_stride, mid_t; };

struct StaticOrder {
    int nM, nN, nwg, G, c;
    __device__ void init(int M, int N, int G_, int c_) { nM = M / BM; nN = N / BM; nwg = nM * nN; G = G_; c = c_; }
    __device__ bool next(int i, Unit& u) const {
        const long L = (long)i * G + c; if (L >= nwg) return false;
        int wgid = (int)L; { const int q = nwg / NXCD, r = nwg % NXCD, xcd = wgid % NXCD, off = wgid / NXCD; wgid = (xcd < r ? xcd * (q + 1) : r * (q + 1) + (xcd - r) * q) + off; }
        const int nig = WGM * nN, gid = wgid / nig, fm = gid * WGM, gsz = (nM - fm) < WGM ? (nM - fm) : WGM;
        u.pm = fm + ((wgid % nig) % gsz); u.pn = (wgid % nig) / gsz; return true;
    }
};
__device__ __forceinline__ unsigned cvt_pk_bf16(float lo, float hi) { unsigned r; asm volatile("v_cvt_pk_bf16_f32 %0, %1, %2" : "=v"(r) : "v"(lo), "v"(hi)); return r; }

struct EpiBf16 {
    static constexpr bool PERM = true;
    bf16_t* O; int ldc; const float* bias;
    __device__ __forceinline__ void operator()(const f32x4 (&acc)[2][2][4][2], const Unit& u, int wr, int wc, int fr, int fq) const {
        const int row0 = u.pm * BM + wr * 64 + fr, col0 = u.pn * BM + wc * 32 + 8 * fq;
        f32x4 bv[2][2];
#pragma unroll
        for (int bj = 0; bj < 2; ++bj)
#pragma unroll
            for (int n = 0; n < 2; ++n) bv[bj][n] = bias ? *(const f32x4*)(bias + col0 + bj * HALF + 4 * n) : (f32x4){0.f, 0.f, 0.f, 0.f};
#pragma unroll
        for (int ai = 0; ai < 2; ++ai)
#pragma unroll
            for (int m = 0; m < 4; ++m) { bf16_t* rowp = O + (size_t)(row0 + ai * HALF + m * 16) * ldc + col0;
#pragma unroll
                for (int bj = 0; bj < 2; ++bj) { const f32x4 v0 = acc[ai][bj][m][0] + bv[bj][0], v1 = acc[ai][bj][m][1] + bv[bj][1];
                    u32x4 w; w.x = cvt_pk_bf16(v0[0], v0[1]); w.y = cvt_pk_bf16(v0[2], v0[3]); w.z = cvt_pk_bf16(v1[0], v1[1]); w.w = cvt_pk_bf16(v1[2], v1[3]);
                    *(u32x4*)(rowp + bj * HALF) = w; } }
    }
};
struct EpiMerged {
    static constexpr bool PERM = true;
    bf16_t* O; const bf16_t* GM; const bf16_t* GR; int ldg;
    __device__ __forceinline__ void mid(f32x4 (&acc)[2][2][4][2], const Unit& u, int wr, int wc, int fr, int fq) const {
        asm volatile("" : "+v"(fr), "+v"(fq));
        const int row0 = u.pm * BM + wr * 64 + fr, col0 = u.pn * BM + wc * 32 + 8 * fq;
#pragma unroll
        for (int ai = 0; ai < 2; ++ai)
#pragma unroll
            for (int m = 0; m < 4; ++m) { const size_t row = (size_t)(row0 + ai * HALF + m * 16);
#pragma unroll
                for (int bj = 0; bj < 2; ++bj) { const int col = col0 + bj * HALF;
                    const u32x4 a = *(const u32x4*)(GM + row * ldg + col), b = *(const u32x4*)(GR + row * ldg + col);
                    const unsigned aw[4] = {a.x, a.y, a.z, a.w}, bw[4] = {b.x, b.y, b.z, b.w};
#pragma unroll
                    for (int q = 0; q < 4; ++q) {
                        const float r0 = (1.0f + __expf(-__uint_as_float(bw[q] << 16))) / (1.0f + __expf(-__uint_as_float(aw[q] << 16)));
                        const float r1 = (1.0f + __expf(-__uint_as_float(bw[q] & 0xffff0000u))) / (1.0f + __expf(-__uint_as_float(aw[q] & 0xffff0000u)));
                        acc[ai][bj][m][q >> 1][(q & 1) * 2] *= r0; acc[ai][bj][m][q >> 1][(q & 1) * 2 + 1] *= r1; }
                }
                __builtin_amdgcn_sched_barrier(0); }
    }
    __device__ __forceinline__ void operator()(const f32x4 (&acc)[2][2][4][2], const Unit& u, int wr, int wc, int fr, int fq) const {
        const int row0 = u.pm * BM + wr * 64 + fr, col0 = u.pn * BM + wc * 32 + 8 * fq;
#pragma unroll
        for (int ai = 0; ai < 2; ++ai)
#pragma unroll
            for (int m = 0; m < 4; ++m) { const size_t row = (size_t)(row0 + ai * HALF + m * 16);
#pragma unroll
                for (int bj = 0; bj < 2; ++bj) { const int col = col0 + bj * HALF;
                    const u32x4 gb = *(const u32x4*)(GR + row * ldg + col);
                    f32x4 g0, g1;
                    g0[0] = sigmoidf_(__uint_as_float(gb.x << 16)); g0[1] = sigmoidf_(__uint_as_float(gb.x & 0xffff0000u));
                    g0[2] = sigmoidf_(__uint_as_float(gb.y << 16)); g0[3] = sigmoidf_(__uint_as_float(gb.y & 0xffff0000u));
                    g1[0] = sigmoidf_(__uint_as_float(gb.z << 16)); g1[1] = sigmoidf_(__uint_as_float(gb.z & 0xffff0000u));
                    g1[2] = sigmoidf_(__uint_as_float(gb.w << 16)); g1[3] = sigmoidf_(__uint_as_float(gb.w & 0xffff0000u));
                    const f32x4 v0 = acc[ai][bj][m][0] * g0, v1 = acc[ai][bj][m][1] * g1;
                    u32x4 w; w.x = cvt_pk_bf16(v0[0], v0[1]); w.y = cvt_pk_bf16(v0[2], v0[3]); w.z = cvt_pk_bf16(v1[0], v1[1]); w.w = cvt_pk_bf16(v1[2], v1[3]);
                    *(u32x4*)(O + row * 2048 + col) = w; } }
    }
};
struct EpiResidual {
    static constexpr bool PERM = false;
    float* X;
    __device__ __forceinline__ void operator()(const f32x4 (&acc)[2][2][4][2], const Unit& u, int wr, int wc, int fr, int fq) const {
        const int row0 = u.pm * BM + wr * 64 + fr, col0 = u.pn * BM + wc * 32 + 4 * fq;
#pragma unroll
        for (int ai = 0; ai < 2; ++ai)
#pragma unroll
            for (int m = 0; m < 4; ++m) { float* rowp = X + (size_t)(row0 + ai * HALF + m * 16) * 2048 + col0;
#pragma unroll
                for (int bj = 0; bj < 2; ++bj)
#pragma unroll
                    for (int n = 0; n < 2; ++n) { f32x4* q = (f32x4*)(rowp + bj * HALF + n * 16); *q = *q + acc[ai][bj][m][n]; } }
    }
};

template <bool MID, class Epi, class Sched>
__device__ __forceinline__ void gemm_phase(LAS unsigned char* lds, const Gemm g, const Sched& S, const Epi& E) {
    const int tid = opaque_tid(), wid = __builtin_amdgcn_readfirstlane(tid >> 6), lane = tid & 63, wr = wid >> 2, wc = wid & 3, fr = lane & 15, fq = lane >> 4;
    const int K = g.K, nt = K / BK;
    unsigned voffA[2], voffB[2];
#pragma unroll
    for (int i = 0; i < 2; ++i) { int R, C; stage_rc(tid * 16 + i * 8192, R, C); const int Rb = Epi::PERM ? ((R & ~31) + perm32(R & 31)) : R;
        voffA[i] = (unsigned)(R * g.lda + C) * 2u; voffB[i] = (unsigned)(Rb * g.ldb + C) * 2u; }
    const size_t kstep = (size_t)(BK * 2);
    const size_t hstepA = (size_t)HALF * g.lda * 2, hstepB = (size_t)HALF * g.ldb * 2;
    const size_t tstepA = 2 * hstepA, tstepB = 2 * hstepB;
    const unsigned ldsw = (unsigned)wid * 1024u;
    const int aoff = lds_byte(wr * 64 + fr, fq * 8), boff = lds_byte(wc * 32 + fr, fq * 8);
#define PG8_SA(b, h) (((b) * 2 + (h)) * HTB)
#define PG8_SB(b, h) ((4 + (b) * 2 + (h)) * HTB)
#define PG8_STAGE(bufoff, gbase, voff) do { _Pragma("unroll") for (int _i = 0; _i < 2; ++_i) \
        __builtin_amdgcn_global_load_lds((const unsigned*)((const char*)(gbase) + (voff)[_i]), (LAS unsigned*)(lds + (bufoff) + ldsw + _i * 8192), 16, 0, 0); } while (0)
#define PG8_LDA(dst, b, h) do { _Pragma("unroll") for (int m = 0; m < 4; ++m) _Pragma("unroll") for (int k = 0; k < 2; ++k) dst[m][k] = *(const LAS bf16x8*)(lds + PG8_SA(b, h) + aoff + m * 2048 + k * 1024); } while (0)
#define PG8_LDB(dst, b, h) do { _Pragma("unroll") for (int n = 0; n < 2; ++n) _Pragma("unroll") for (int k = 0; k < 2; ++k) dst[n][k] = *(const LAS bf16x8*)(lds + PG8_SB(b, h) + boff + n * 2048 + k * 1024); } while (0)
#define PG8_MMA(ai, bj, At, Bt) do { __builtin_amdgcn_s_setprio(1); _Pragma("unroll") for (int m = 0; m < 4; ++m) _Pragma("unroll") for (int n = 0; n < 2; ++n) _Pragma("unroll") for (int k = 0; k < 2; ++k) \
        acc[ai][bj][m][n] = __builtin_amdgcn_mfma_f32_16x16x32_bf16(Bt[n][k], At[m][k], acc[ai][bj][m][n], 0, 0, 0); __builtin_amdgcn_s_setprio(0); } while (0)
#define PG8_WAIT_V(n) asm volatile("s_waitcnt vmcnt(" #n ")" ::: "memory")
#define PG8_WAIT_L(n) asm volatile("s_waitcnt lgkmcnt(" #n ")" ::: "memory")
#define PG8_BAR __builtin_amdgcn_s_barrier()
#define PG8_SCHED __builtin_amdgcn_sched_barrier(0)
#define PG8_APTR(u) ((const char*)g.A + (size_t)(u).pm * tstepA + (size_t)((u).pn >> g.a_pn_shift) * (size_t)g.a_pn_stride)
    Unit cur, nxt; int ui = 0;
    if (!S.next(0, cur)) return;
    f32x4 acc[2][2][4][2];
#pragma unroll
    for (int a = 0; a < 2; ++a)
#pragma unroll
        for (int b = 0; b < 2; ++b)
#pragma unroll
            for (int m = 0; m < 4; ++m)
#pragma unroll
                for (int n = 0; n < 2; ++n) acc[a][b][m][n] = (f32x4){0.f, 0.f, 0.f, 0.f};
    bf16x8 At[4][2], B0[2][2], B1[2][2];
    const char* cA = PG8_APTR(cur); const char* cB = (const char*)g.Bt + (size_t)cur.pn * tstepB;
    PG8_STAGE(PG8_SB(0, 0), cB, voffB); PG8_STAGE(PG8_SA(0, 0), cA, voffA); PG8_STAGE(PG8_SB(0, 1), cB + hstepB, voffB); PG8_STAGE(PG8_SA(0, 1), cA + hstepA, voffA);
    if (wr == 1) PG8_BAR;
    PG8_WAIT_V(4); PG8_BAR;
    PG8_STAGE(PG8_SB(1, 0), cB + kstep, voffB); PG8_STAGE(PG8_SA(1, 0), cA + kstep, voffA); PG8_STAGE(PG8_SB(1, 1), cB + hstepB + kstep, voffB);
    PG8_WAIT_V(6); PG8_BAR;
    for (;;) {
        const bool has_next = S.next(ui + 1, nxt);
        const char* nA = has_next ? PG8_APTR(nxt) : cA; const char* nB = has_next ? (const char*)g.Bt + (size_t)nxt.pn * tstepB : cB;
        for (int t = 0; t < nt; t += 2) {
            const bool last = (t == nt - 2);
            const char* a1 = cA + (size_t)(t + 1) * kstep;
            const char* a2 = last ? nA : cA + (size_t)(t + 2) * kstep; const char* b2 = last ? nB : cB + (size_t)(t + 2) * kstep;
            const char* a3 = a2 + kstep; const char* b3 = b2 + kstep;
            if constexpr (MID) { if (t == g.mid_t) E.mid(acc, cur, wr, wc, fr, fq); }
            PG8_LDB(B0, 0, 0); PG8_SCHED; PG8_LDA(At, 0, 0); PG8_STAGE(PG8_SA(1, 1), a1 + hstepA, voffA);
            PG8_WAIT_L(8); PG8_BAR; PG8_WAIT_L(0); PG8_MMA(0, 0, At, B0); PG8_BAR; PG8_SCHED;
            PG8_LDB(B1, 0, 1); PG8_STAGE(PG8_SB(0, 0), b2, voffB);
            PG8_BAR; PG8_WAIT_L(0); PG8_MMA(0, 1, At, B1); PG8_BAR;
            PG8_LDA(At, 0, 1); PG8_STAGE(PG8_SA(0, 0), a2, voffA);
            PG8_BAR; PG8_WAIT_L(0); PG8_MMA(1, 0, At, B0); PG8_BAR; PG8_SCHED;
            PG8_STAGE(PG8_SB(0, 1), b2 + hstepB, voffB);
            PG8_WAIT_V(6); PG8_BAR; PG8_MMA(1, 1, At, B1); PG8_BAR;
            PG8_LDB(B0, 1, 0); PG8_SCHED; PG8_LDA(At, 1, 0); PG8_STAGE(PG8_SA(0, 1), a2 + hstepA, voffA);
            PG8_WAIT_L(8); PG8_BAR; PG8_WAIT_L(0); PG8_MMA(0, 0, At, B0); PG8_BAR; PG8_SCHED;
            PG8_LDB(B1, 1, 1); PG8_STAGE(PG8_SB(1, 0), b3, voffB);
            PG8_BAR; PG8_WAIT_L(0); PG8_MMA(0, 1, At, B1); PG8_BAR;
            PG8_LDA(At, 1, 1); PG8_STAGE(PG8_SA(1, 0), a3, voffA);
            PG8_BAR; PG8_WAIT_L(0); PG8_MMA(1, 0, At, B0); PG8_BAR; PG8_SCHED;
            PG8_STAGE(PG8_SB(1, 1), b3 + hstepB, voffB);
            PG8_WAIT_V(6); PG8_BAR; PG8_MMA(1, 1, At, B1); PG8_BAR;
        }
        E(acc, cur, wr, wc, fr, fq);
        if (!has_next) break;
#pragma unroll
        for (int a = 0; a < 2; ++a)
#pragma unroll
            for (int b = 0; b < 2; ++b)
#pragma unroll
                for (int m = 0; m < 4; ++m)
#pragma unroll
                    for (int n = 0; n < 2; ++n) acc[a][b][m][n] = (f32x4){0.f, 0.f, 0.f, 0.f};
        cur = nxt; cA = nA; cB = nB; ++ui;
    }
    PG8_WAIT_V(0);
    if (wr == 0) PG8_BAR;
    PG8_BAR;
#undef PG8_SA
#undef PG8_SB
#undef PG8_STAGE
#undef PG8_LDA
#undef PG8_LDB
#undef PG8_MMA
#undef PG8_WAIT_V
#undef PG8_WAIT_L
#undef PG8_BAR
#undef PG8_SCHED
#undef PG8_APTR
}
}

__device__ __forceinline__ void tr_tile(const float* src, int ldsrc, int k0, int c0, bf16_t* dst, int ldd, int r0, int kd0, float scale, LAS float* t, int lane) {
    f32x4 v[16];
#pragma unroll
    for (int i = 0; i < 16; ++i) v[i] = __builtin_nontemporal_load((const f32x4*)(src + (size_t)(k0 + (lane >> 4) + 4 * i) * ldsrc + c0 + 4 * (lane & 15)));
#pragma unroll
    for (int i = 0; i < 16; ++i)
#pragma unroll
        for (int j = 0; j < 4; ++j) t[((lane >> 4) + 4 * i) * 65 + 4 * (lane & 15) + j] = v[i][j];
    const int c = lane & 7;
#pragma unroll
    for (int j = 0; j < 8; ++j) { const int n = (lane >> 3) + 8 * j; const LAS float* q = t + (8 * c) * 65 + n;
        u32x4 o; o.x = pk2(scale * q[0], scale * q[65]); o.y = pk2(scale * q[130], scale * q[195]); o.z = pk2(scale * q[260], scale * q[325]); o.w = pk2(scale * q[390], scale * q[455]);
        *(u32x4*)(dst + (size_t)(r0 + n) * ldd + kd0 + 8 * c) = o; }
}
__device__ __forceinline__ void prep_phase(const Params& p, int wg, int nwg, LAS unsigned char* lds) {
    const int tid = opaque_tid();
    for (size_t i = (size_t)wg * 512 + tid; i < (size_t)MPAD * D / 4; i += (size_t)nwg * 512) {
        const size_t row = (i * 4) / D;
        f32x4 v = (f32x4){0.f, 0.f, 0.f, 0.f};
        if (row < (size_t)MP) v = ((const f32x4*)p.x_prompt)[i];
        else if (row < (size_t)MT) v = ((const f32x4*)p.x_sample)[i - (size_t)MP * D / 4];
        ((f32x4*)p.X)[i] = v;
    }
    for (int i = wg * 512 + tid; i < 2049 * 128; i += nwg * 512) {
        const int pi = i >> 7, j = i & 127;
        const float pos = pi < 2048 ? (float)pi : 16384.0f;
        const float inv = powf(10000.0f, -((float)j / 128.0f));
        const float ang = pos * inv;
        p.ROPE[2 * i] = (float)cos((double)ang); p.ROPE[2 * i + 1] = (float)sin((double)ang);
    }
    for (int i = wg * 512 + tid; i < DEPTH * 8 * D; i += nwg * 512) {
        const int l = i / (8 * D), r = i % (8 * D), j = r / D, k = r % D;
        p.WIF[i] = p.w_in[((size_t)l * D + k) * NIN + 3072 + j];
    }
    for (int i = wg * 512 + tid; i < DEPTH * N1; i += nwg * 512) {
        const int l = i / N1, n = i % N1;
        p.BIAS1[i] = n < C_GM ? 0.f : p.b_gate[l * 4096 + (n - C_GM)];
    }
    const int lane = tid & 63, wid = tid >> 6;
    LAS float* t = (LAS float*)lds + wid * (64 * 65);
    constexpr int T0 = 1536, T1 = T0 + 2048, T2 = T1 + 2048, T3 = T2 + 512, T4 = T3 + 512, T5 = T4 + 1024, T6 = T5 + 64, T7 = T6 + 64;
    for (int it = wg * 8 + wid; it < DEPTH * T7; it += nwg * 8) {
        const int l = it / T7, r = it % T7;
        bf16_t* Wl = p.W + (size_t)l * WL;
        if (r < T0)      { const int q = r;      tr_tile(p.w_in + (size_t)l * D * NIN, NIN, (q & 31) * 64, (q >> 5) * 64, Wl + W1_OFF, D, (q >> 5) * 64, (q & 31) * 64, 1.f, t, lane); }
        else if (r < T1) { const int q = r - T0; tr_tile(p.w_in + (size_t)l * D * NIN, NIN, (q & 31) * 64, 3080 + (q >> 5) * 64, Wl + W1_OFF, D, 3072 + (q >> 5) * 64, (q & 31) * 64, 1.f, t, lane); }
        else if (r < T2) { const int q = r - T1; tr_tile(p.w_gate + (size_t)l * D * 4096, 4096, (q & 31) * 64, (q >> 5) * 64, Wl + W1_OFF, D, C_GM + (q >> 5) * 64, (q & 31) * 64, 1.f, t, lane); }
        else if (r < T3) { const int q = r - T2; tr_tile(p.w_pm + (size_t)l * WM * D, D, (q & 15) * 64, (q >> 4) * 64, Wl + W3_OFF, D, (q >> 4) * 64, (q & 15) * 64, 1.f, t, lane); }
        else if (r < T4) { const int q = r - T3; tr_tile(p.w_pr + (size_t)l * WM * D, D, (q & 15) * 64, (q >> 4) * 64, Wl + W3_OFF, D, (q >> 4) * 64, 1024 + (q & 15) * 64, 1.f, t, lane); }
        else if (r < T5) { const int q = r - T4; tr_tile(p.w_o + (size_t)l * D * D, D, (q & 31) * 64, (q >> 5) * 64, Wl + W4_OFF, D, (q >> 5) * 64, (q & 31) * 64, 1.f, t, lane); }
        else if (r < T6) { const int q = r - T5, h = q >> 4, qq = q & 15; tr_tile(p.w_qm + ((size_t)l * HM + h) * SZ, DH, (qq & 3) * 64, (qq >> 2) * 64, Wl + W2_OFF, DH, h * 512 + (qq >> 2) * 64, (qq & 3) * 64, 0.0625f, t, lane); }
        else             { const int q = r - T6, h = q >> 4, qq = q & 15; tr_tile(p.w_km + ((size_t)l * HM + h) * SZ, DH, (qq & 3) * 64, (qq >> 2) * 64, Wl + W2_OFF, DH, h * 512 + 256 + (qq >> 2) * 64, (qq & 3) * 64, 1.f, t, lane); }
    }
}

__device__ __forceinline__ void norm_phase(const Params& p, int layer, int wg, int nwg) {
    const int tid_ = opaque_tid(), lane = tid_ & 63, wid = tid_ >> 6;
    const f32x4* g4 = (const f32x4*)(p.norm_g + (size_t)layer * D);
    const float* wif = p.WIF + (size_t)layer * 8 * D;
    for (int row = wg * 8 + wid; row < MPAD; row += nwg * 8) {
        u32x2* hrow = (u32x2*)(p.H + (size_t)row * D);
        if (row >= MT) {
#pragma unroll
            for (int i = 0; i < 8; ++i) hrow[lane + 64 * i] = (u32x2){0u, 0u};
            continue;
        }
        const f32x4* xr = (const f32x4*)(p.X + (size_t)row * D);
        f32x4 v[8]; float ss = 0.f;
#pragma unroll
        for (int i = 0; i < 8; ++i) { v[i] = xr[lane + 64 * i]; ss += (v[i][0] * v[i][0] + v[i][1] * v[i][1]) + (v[i][2] * v[i][2] + v[i][3] * v[i][3]); }
        ss = wave_sum(ss);
        const float rstd = rsqrtf(ss * (1.0f / D) + EPS);
#pragma unroll
        for (int i = 0; i < 8; ++i) {
            v[i] = v[i] * rstd * g4[lane + 64 * i];
            hrow[lane + 64 * i] = (u32x2){pk2(v[i][0], v[i][1]), pk2(v[i][2], v[i][3])};
        }
#pragma unroll 1
        for (int j = 0; j < 8; ++j) {
            float s = 0.f;
#pragma unroll
            for (int i = 0; i < 8; ++i) { const f32x4 w = ((const f32x4*)(wif + (size_t)j * D))[lane + 64 * i]; s += (v[i][0] * w[0] + v[i][1] * w[1]) + (v[i][2] * w[2] + v[i][3] * w[3]); }
            s = wave_sum(s);
            if (lane == 0) p.IF[(size_t)row * 8 + j] = s;
        }
    }
}
__device__ __forceinline__ void final_phase(const Params& p, int wg, int nwg) {
    const int tid_ = opaque_tid(), lane = tid_ & 63, wid = tid_ >> 6;
    const f32x4* g4 = (const f32x4*)p.final_g;
    for (int row = wg * 8 + wid; row < MT; row += nwg * 8) {
        const f32x4* xr = (const f32x4*)(p.X + (size_t)row * D);
        f32x4* yr = (f32x4*)(p.out + (row < MP ? O_YP + (size_t)row * D : O_YS + (size_t)(row - MP) * D));
        f32x4 v[8]; float ss = 0.f;
#pragma unroll
        for (int i = 0; i < 8; ++i) { v[i] = xr[lane + 64 * i]; ss += (v[i][0] * v[i][0] + v[i][1] * v[i][1]) + (v[i][2] * v[i][2] + v[i][3] * v[i][3]); }
        ss = wave_sum(ss);
        const float rstd = rsqrtf(ss * (1.0f / D) + EPS);
#pragma unroll
        for (int i = 0; i < 8; ++i) yr[lane + 64 * i] = v[i] * rstd * g4[lane + 64 * i];
    }
}

__device__ __forceinline__ void unpack8(const u32x4 v, float (&f)[8]) {
    f[0] = __uint_as_float(v.x << 16); f[1] = __uint_as_float(v.x & 0xffff0000u); f[2] = __uint_as_float(v.y << 16); f[3] = __uint_as_float(v.y & 0xffff0000u);
    f[4] = __uint_as_float(v.z << 16); f[5] = __uint_as_float(v.z & 0xffff0000u); f[6] = __uint_as_float(v.w << 16); f[7] = __uint_as_float(v.w & 0xffff0000u);
}
__device__ __forceinline__ u32x4 pack8(const float (&f)[8]) { u32x4 w; w.x = pk2(f[0], f[1]); w.y = pk2(f[2], f[3]); w.z = pk2(f[4], f[5]); w.w = pk2(f[6], f[7]); return w; }

__device__ __forceinline__ void conv_phase(const Params& p, int layer, int wg, int nwg) {
    const int tid = opaque_tid();
    const float* cw = p.conv_w + (size_t)layer * 4 * WM;
    const float* cb = p.conv_b + (size_t)layer * WM;
    for (int it = wg * 512 + tid; it < MT * 128; it += nwg * 512) {
        const int row = it >> 7, ch = (it & 127) * 8;
        float up[4][8];
        if (row < MP) {
            const int t = row & (SEQ - 1);
#pragma unroll
            for (int i = 0; i < 4; ++i) {
                if (t - 3 + i >= 0) unpack8(*(const u32x4*)(p.P + (size_t)(row - 3 + i) * N1 + C_U + ch), up[i]);
                else {
#pragma unroll
                    for (int j = 0; j < 8; ++j) up[i][j] = 0.f;
                }
            }
            if (t >= SEQ - 3) {
                const int b = row >> 11;
                float* o = p.out + O_CVP + (((size_t)layer * BP + b) * 3 + (t - (SEQ - 3))) * WM + ch;
                *(f32x4*)o = (f32x4){up[3][0], up[3][1], up[3][2], up[3][3]}; *(f32x4*)(o + 4) = (f32x4){up[3][4], up[3][5], up[3][6], up[3][7]};
            }
        } else {
            const int b = row - MP;
            const float* hist = p.st_conv + ((size_t)layer * BS + b) * 3 * WM + ch;
#pragma unroll
            for (int i = 0; i < 3; ++i) { const f32x4 a = *(const f32x4*)(hist + (size_t)i * WM), c = *(const f32x4*)(hist + (size_t)i * WM + 4);
                up[i][0] = a[0]; up[i][1] = a[1]; up[i][2] = a[2]; up[i][3] = a[3]; up[i][4] = c[0]; up[i][5] = c[1]; up[i][6] = c[2]; up[i][7] = c[3]; }
            unpack8(*(const u32x4*)(p.P + (size_t)row * N1 + C_U + ch), up[3]);
            float* o = p.out + O_CVS + ((size_t)layer * BS + b) * 3 * WM + ch;
#pragma unroll
            for (int i = 0; i < 3; ++i) { *(f32x4*)(o + (size_t)i * WM) = (f32x4){up[i + 1][0], up[i + 1][1], up[i + 1][2], up[i + 1][3]};
                *(f32x4*)(o + (size_t)i * WM + 4) = (f32x4){up[i + 1][4], up[i + 1][5], up[i + 1][6], up[i + 1][7]}; }
        }
        float r[8];
#pragma unroll
        for (int j = 0; j < 8; ++j) r[j] = cb[ch + j];
#pragma unroll
        for (int i = 0; i < 4; ++i)
#pragma unroll
            for (int j = 0; j < 8; ++j) r[j] += up[i][j] * cw[i * WM + ch + j];
#pragma unroll
        for (int j = 0; j < 8; ++j) r[j] = siluf_(r[j]);
        *(u32x4*)(p.CM + (size_t)row * WM + ch) = pack8(r);
    }
    for (int it = wg * 512 + tid; it < MT * 128; it += nwg * 512) {
        const int row = it >> 7, r2 = it & 127, which = r2 >> 6, h = (r2 >> 4) & 3, d0 = (r2 & 15) * 8;
        const int pi = row < MP ? (row & (SEQ - 1)) : 2048;
        bf16_t* base = p.P + (size_t)row * N1 + (which ? C_KR : C_QR) + h * 256 + d0;
        float x1[8], x2[8], o1[8], o2[8];
        unpack8(*(const u32x4*)base, x1); unpack8(*(const u32x4*)(base + 128), x2);
        const float* cs = p.ROPE + ((size_t)pi * 128 + d0) * 2;
        const float sc = which ? 0.0625f : 1.0f;
#pragma unroll
        for (int j = 0; j < 8; ++j) { const float c = cs[2 * j], s = cs[2 * j + 1]; o1[j] = (x1[j] * c - x2[j] * s) * sc; o2[j] = (x1[j] * s + x2[j] * c) * sc; }
        *(u32x4*)base = pack8(o1); *(u32x4*)(base + 128) = pack8(o2);
    }
}

__device__ __forceinline__ void gate_scan(const Params& p, int layer, int b, int h, int c_own, LAS float* G) {
    const int tid = opaque_tid(), lane = tid & 63, wid = tid >> 6;
    const float bi = p.b_i[layer * HM + h], bfv = p.b_f[layer * HM + h];
#pragma unroll
    for (int q = 0; q < 2; ++q) {
        const int cc = wid + 8 * q;
        const size_t r0 = (size_t)b * SEQ + cc * 128 + 2 * lane;
        const float i0 = p.IF[r0 * 8 + h] + bi, i1 = p.IF[(r0 + 1) * 8 + h] + bi;
        const float l0 = logsigf_(p.IF[r0 * 8 + 4 + h] + bfv), l1 = logsigf_(p.IF[(r0 + 1) * 8 + 4 + h] + bfv);
        float inc = l0 + l1;
#pragma unroll
        for (int o = 1; o < 64; o <<= 1) { const float t = __shfl_up(inc, o); if (lane >= o) inc += t; }
        const float exc = inc - (l0 + l1);
        const float b0 = exc + l0, b1 = inc;
        const float g0 = i0 - b0, g1 = i1 - b1;
        const float gm = wave_max(fmaxf(g0, g1));
        const float Bc = __shfl(inc, 63);
        if (lane == 0) { G[cc] = Bc; G[16 + cc] = gm; }
        if (cc == c_own) {
            float rm = fmaxf(g0, g1);
#pragma unroll
            for (int o = 1; o < 64; o <<= 1) { const float t = __shfl_up(rm, o); if (lane >= o) rm = fmaxf(rm, t); }
            float ex = __shfl_up(rm, 1); if (lane == 0) ex = -3.0e38f;
            const float c0 = fmaxf(ex, g0), c1 = fmaxf(c0, g1);
            G[64 + 2 * lane] = b0; G[65 + 2 * lane] = b1; G[192 + 2 * lane] = g0; G[193 + 2 * lane] = g1; G[320 + 2 * lane] = c0; G[321 + 2 * lane] = c1;
        }
    }
    __syncthreads();
    if (tid == 0) { float m = -1e30f; for (int cc = 0; cc < 16; ++cc) { G[32 + cc] = m; m = G[cc] + fmaxf(m, G[16 + cc]); } G[48] = m; }
    __syncthreads();
    if (c_own >= 0 && tid < 128) G[320 + tid] = fmaxf(G[320 + tid], G[32 + c_own]);
    __syncthreads();
}

template <int NR, int NC, bool WEIGHT>
__device__ __forceinline__ void stage_T(LAS unsigned char* dst, int ldd_bytes, const bf16_t* src, int ld_src, LAS const float* w) {
    const int tid_ = opaque_tid(), lane = tid_ & 63, wid = tid_ >> 6;
    constexpr int PB = NR / 128, CG = NC / 8;
#pragma unroll 1
    for (int task = wid; task < PB * CG; task += 8) {
        const int pb = task % PB, cg = task / PB, r = pb * 128 + 2 * lane;
        float a[8], c[8];
        unpack8(*(const u32x4*)(src + (size_t)r * ld_src + cg * 8), a); unpack8(*(const u32x4*)(src + (size_t)(r + 1) * ld_src + cg * 8), c);
        float w0 = 1.f, w1 = 1.f; if (WEIGHT) { w0 = w[r]; w1 = w[r + 1]; }
#pragma unroll
        for (int j = 0; j < 8; ++j) *(LAS unsigned*)(dst + (cg * 8 + j) * ldd_bytes + r * 2) = pk2(a[j] * w0, c[j] * w1);
    }
}
__device__ __forceinline__ void stage_rows(LAS unsigned char* dst, const bf16_t* src, int ld_src) {
    const int tid_ = opaque_tid();
#pragma unroll
    for (int i = 0; i < 8; ++i) { const int id = tid_ + 512 * i, row = id >> 5, ch = id & 31;
        *(LAS u32x4*)(dst + row * 528 + ch * 16) = *(const u32x4*)(src + (size_t)row * ld_src + ch * 8); }
}
__device__ __forceinline__ bf16x8 lds_frag(LAS const unsigned char* base, int row, int ld_bytes, int kbyte) { return *(LAS const bf16x8*)(base + row * ld_bytes + kbyte); }
__device__ __forceinline__ float ret_lg(int h) { return logf(1.0f - exp2f(-5.0f - (float)h)); }

template <int BR>
__device__ __forceinline__ void chunk_passA(const Params& p, int layer, int b, int h, int c, LAS unsigned char* lds) {
    LAS unsigned char* At = lds; LAS unsigned char* Bt = lds + 69632; LAS float* G = (LAS float*)(lds + 139264); LAS float* wk = G + 512;
    const int tid = opaque_tid(), lane = tid & 63, w = __builtin_amdgcn_readfirstlane(tid >> 6), g = lane >> 4, lr = lane & 15;
    const size_t row0 = (size_t)b * SEQ + c * 128;
    const int pi = BR * 16 + b * 4 + h;
    if (BR == 0) { gate_scan(p, layer, b, h, c, G); if (tid < 128) wk[tid] = expf(G[192 + tid] - G[320 + 127]); }
    else { if (tid < 128) wk[tid] = expf((float)(127 - tid) * ret_lg(h)); }
    __syncthreads();
    const bf16_t* srcA = BR == 0 ? p.P + row0 * N1 + C_VM + h * 256 : p.P + row0 * N1 + C_KR + h * 256;
    const bf16_t* srcB = BR == 0 ? p.QK + row0 * 2048 + h * 512 + 256 : p.P + row0 * N1 + C_VR + h * 256;
    stage_T<128, 256, true>(At, 272, srcA, N1, wk);
    stage_T<128, 256, false>(Bt, 272, srcB, BR == 0 ? 2048 : N1, wk);
    __syncthreads();
    float* Uo = p.U + ((size_t)pi * 16 + c) * SZ;
#pragma unroll 1
    for (int rt = 0; rt < 2; ++rt) {
        f32x4 acc[16];
#pragma unroll
        for (int j = 0; j < 16; ++j) acc[j] = (f32x4){0.f, 0.f, 0.f, 0.f};
#pragma unroll
        for (int ks = 0; ks < 4; ++ks) {
            const bf16x8 a0 = lds_frag(At, 32 * w + 16 * rt + lr, 272, (32 * ks + 8 * g) * 2);
#pragma unroll
            for (int ct = 0; ct < 16; ++ct) acc[ct] = __builtin_amdgcn_mfma_f32_16x16x32_bf16(a0, lds_frag(Bt, 16 * ct + lr, 272, (32 * ks + 8 * g) * 2), acc[ct], 0, 0, 0);
            __builtin_amdgcn_sched_barrier(0);
        }
#pragma unroll
        for (int ct = 0; ct < 16; ++ct)
#pragma unroll
            for (int r = 0; r < 4; ++r) Uo[(size_t)(32 * w + 16 * rt + 4 * g + r) * 256 + 16 * ct + lr] = acc[ct][r];
    }
    if (BR == 0 && tid < 256) {
        float s = 0.f;
        for (int ss = 0; ss < 128; ++ss) s += wk[ss] * bf2f(*(LAS const bf16_t*)(Bt + tid * 272 + ss * 2));
        p.NU[((size_t)(b * 4 + h) * 16 + c) * 256 + tid] = s;
    }
    __syncthreads();
}

__device__ __forceinline__ void scan_item(const Params& p, int layer, int pi, int slice, LAS unsigned char* lds) {
    LAS float* G = (LAS float*)lds; LAS float* dec = G + 512;
    const int tid = opaque_tid(), br = pi >> 4, bh = pi & 15, b = bh >> 2, h = bh & 3;
    if (br == 0) { gate_scan(p, layer, b, h, -1, G); if (tid < 16) dec[tid] = expf(G[32 + tid] - fmaxf(G[32 + tid], G[16 + tid])); }
    else if (tid < 16) dec[tid] = expf(128.0f * ret_lg(h));
    __syncthreads();
    f32x4 st[4];
#pragma unroll
    for (int j = 0; j < 4; ++j) st[j] = (f32x4){0.f, 0.f, 0.f, 0.f};
    for (int c = 0; c < 16; ++c) {
        const float dc = dec[c];
#pragma unroll
        for (int j = 0; j < 4; ++j) { const size_t idx = (size_t)slice * 8192 + j * 2048 + tid * 4;
            const f32x4 u = *(const f32x4*)(p.U + ((size_t)pi * 16 + c) * SZ + idx);
            *(u32x2*)(p.CS + ((size_t)pi * 16 + c) * SZ + idx) = (u32x2){pk2(st[j][0], st[j][1]), pk2(st[j][2], st[j][3])};
            st[j] = st[j] * dc + u; }
    }
    float* fo = p.out + (br == 0 ? O_CP : O_SP) + (((size_t)layer * BP + b) * HM + h) * SZ;
#pragma unroll
    for (int j = 0; j < 4; ++j) *(f32x4*)(fo + (size_t)slice * 8192 + j * 2048 + tid * 4) = st[j];
    if (br == 0 && slice == 0) {
        if (tid < 256) { float n = 0.f;
            for (int c = 0; c < 16; ++c) { p.NS[((size_t)bh * 16 + c) * 256 + tid] = n; n = dec[c] * n + p.NU[((size_t)bh * 16 + c) * 256 + tid]; }
            p.out[O_NP + (((size_t)layer * BP + b) * HM + h) * 256 + tid] = n; }
        if (tid == 0) p.out[O_MP + ((size_t)layer * BP + b) * HM + h] = G[48];
    }
    __syncthreads();
}

template <int BR>
__device__ __forceinline__ void chunk_passC(const Params& p, int layer, int b, int h, int c, LAS unsigned char* lds) {
    LAS unsigned char* BufB = lds; LAS unsigned char* Sw = lds + 69632; LAS float* G = (LAS float*)(lds + 104448);
    LAS float* av = G + 512; LAS float* fl = G + 640; LAS bf16_t* nbf = (LAS bf16_t*)(G + 768);
    const int tid = opaque_tid(), lane = tid & 63, w = __builtin_amdgcn_readfirstlane(tid >> 6), g = lane >> 4, lr = lane & 15;
    const size_t row0 = (size_t)b * SEQ + c * 128;
    const int pi = BR * 16 + b * 4 + h;
    const float lg = ret_lg(h);
    if (BR == 0) {
        gate_scan(p, layer, b, h, c, G);
        if (tid < 128) { av[tid] = expf(G[32 + c] - G[320 + tid]); fl[tid] = expf(-(G[64 + tid] + G[320 + tid])); }
        if (tid < 256) nbf[tid] = f2bf(p.NS[((size_t)(b * 4 + h) * 16 + c) * 256 + tid]);
    } else { if (tid < 128) av[tid] = expf((float)(tid + 1) * lg); }
    const bf16_t* Qp = BR == 0 ? p.QK + (row0 + 16 * w + lr) * 2048 + h * 512 : p.P + (row0 + 16 * w + lr) * N1 + C_QR + h * 256;
    bf16x8 qf[8];
#pragma unroll
    for (int ks = 0; ks < 8; ++ks) qf[ks] = *(const bf16x8*)(Qp + 32 * ks + 8 * g);
    stage_rows(BufB, BR == 0 ? p.QK + row0 * 2048 + h * 512 + 256 : p.P + row0 * N1 + C_KR + h * 256, BR == 0 ? 2048 : N1);
    __syncthreads();
    float rs[4] = {0.f, 0.f, 0.f, 0.f};
#pragma unroll
    for (int j = 0; j < 8; ++j) {
        f32x4 a = (f32x4){0.f, 0.f, 0.f, 0.f};
        if (j <= w) {
#pragma unroll
            for (int ks = 0; ks < 8; ++ks) a = __builtin_amdgcn_mfma_f32_16x16x32_bf16(qf[ks], lds_frag(BufB, 16 * j + lr, 528, (32 * ks + 8 * g) * 2), a, 0, 0, 0);
        }
#pragma unroll
        for (int r = 0; r < 4; ++r) {
            const int l = 16 * w + 4 * g + r, s = 16 * j + lr;
            float d = 0.f;
            if (s <= l) d = BR == 0 ? expf(G[192 + s] - G[320 + l]) : expf((float)(l - s) * lg);
            const float v = a[r] * d;
            rs[r] += v;
            *(LAS bf16_t*)(Sw + (l * 136 + s) * 2) = f2bf(v);
        }
        __builtin_amdgcn_sched_barrier(0);
    }
#pragma unroll
    for (int r = 0; r < 4; ++r) { rs[r] += __shfl_xor(rs[r], 1); rs[r] += __shfl_xor(rs[r], 2); rs[r] += __shfl_xor(rs[r], 4); rs[r] += __shfl_xor(rs[r], 8); }
    __syncthreads();
    f32x4 accN[16];
#pragma unroll
    for (int t = 0; t < 16; ++t) accN[t] = (f32x4){0.f, 0.f, 0.f, 0.f};
    const bf16_t* CSp = p.CS + ((size_t)pi * 16 + c) * SZ;
#pragma unroll
    for (int half = 0; half < 2; ++half) {
        if (BR == 0) stage_rows(BufB, CSp + (size_t)half * 128 * 256, 256);
        else stage_T<256, 128, false>(BufB, 528, CSp + half * 128, 256, av);
        __syncthreads();
#pragma unroll
        for (int t = 0; t < 8; ++t) {
#pragma unroll
            for (int ks = 0; ks < 8; ++ks)
                accN[half * 8 + t] = __builtin_amdgcn_mfma_f32_16x16x32_bf16(qf[ks], lds_frag(BufB, 16 * t + lr, 528, (32 * ks + 8 * g) * 2), accN[half * 8 + t], 0, 0, 0);
            __builtin_amdgcn_sched_barrier(0); }
        __syncthreads();
    }
    float nq[4] = {0.f, 0.f, 0.f, 0.f};
    if (BR == 0) {
        f32x4 ad = (f32x4){0.f, 0.f, 0.f, 0.f};
#pragma unroll
        for (int ks = 0; ks < 8; ++ks) {
            bf16x8 nf = *(LAS const bf16x8*)(nbf + 32 * ks + 8 * g);
            if (lr != 0) nf = (bf16x8){0, 0, 0, 0, 0, 0, 0, 0};
            ad = __builtin_amdgcn_mfma_f32_16x16x32_bf16(qf[ks], nf, ad, 0, 0, 0);
        }
#pragma unroll
        for (int r = 0; r < 4; ++r) nq[r] = __shfl(ad[r], lane & 48);
    }
    float ar[4];
#pragma unroll
    for (int r = 0; r < 4; ++r) ar[r] = av[16 * w + 4 * g + r];
#pragma unroll
    for (int t = 0; t < 16; ++t)
#pragma unroll
        for (int r = 0; r < 4; ++r) accN[t][r] *= ar[r];
    stage_T<128, 256, false>(BufB, 272, p.P + row0 * N1 + (BR == 0 ? C_VM : C_VR) + h * 256, N1, av);
    __syncthreads();
#pragma unroll
    for (int ks = 0; ks < 4; ++ks) {
        const bf16x8 af = lds_frag(Sw, 16 * w + lr, 272, (32 * ks + 8 * g) * 2);
#pragma unroll
        for (int t = 0; t < 16; ++t) accN[t] = __builtin_amdgcn_mfma_f32_16x16x32_bf16(af, lds_frag(BufB, 16 * t + lr, 272, (32 * ks + 8 * g) * 2), accN[t], 0, 0, 0);
        __builtin_amdgcn_sched_barrier(0);
    }
    float inv[4];
#pragma unroll
    for (int r = 0; r < 4; ++r) {
        if (BR == 0) { const float den = fmaxf(fabsf(rs[r] + ar[r] * nq[r]), fl[16 * w + 4 * g + r]); inv[r] = 1.0f / den; }
        else inv[r] = 1.0f;
    }
    float mu[4], rstd[4];
#pragma unroll
    for (int r = 0; r < 4; ++r) {
        float s = 0.f;
#pragma unroll
        for (int t = 0; t < 16; ++t) { accN[t][r] *= inv[r]; s += accN[t][r]; }
        s += __shfl_xor(s, 1); s += __shfl_xor(s, 2); s += __shfl_xor(s, 4); s += __shfl_xor(s, 8);
        mu[r] = s * (1.0f / 256.0f);
        float q = 0.f;
#pragma unroll
        for (int t = 0; t < 16; ++t) { const float d = accN[t][r] - mu[r]; q += d * d; }
        q += __shfl_xor(q, 1); q += __shfl_xor(q, 2); q += __shfl_xor(q, 4); q += __shfl_xor(q, 8);
        rstd[r] = rsqrtf(q * (1.0f / 256.0f) + EPS);
    }
    const float* gain = (BR == 0 ? p.hn_m_g : p.hn_r_g) + (size_t)layer * WM + h * 256;
    const float* skip = p.skip_m + (size_t)layer * WM + h * 256;
#pragma unroll
    for (int t = 0; t < 16; ++t) {
        const int e = 16 * t + lr;
        const float ge = gain[e], sk = BR == 0 ? skip[e] : 0.f;
#pragma unroll
        for (int r = 0; r < 4; ++r) {
            const size_t row = row0 + 16 * w + 4 * g + r;
            float v = (accN[t][r] - mu[r]) * rstd[r] * ge;
            const float z = bf2f(p.P[row * N1 + (BR == 0 ? C_ZM : C_ZR) + h * 256 + e]);
            if (BR == 0) v += sk * bf2f(p.CM[row * WM + h * 256 + e]);
            p.OC[row * 2048 + BR * 1024 + h * 256 + e] = f2bf(v * siluf_(z));
        }
        __builtin_amdgcn_sched_barrier(0);
    }
    __syncthreads();
}

template <int BR>
__device__ __forceinline__ void sample_item(const Params& p, int layer, int b, int h, LAS unsigned char* lds) {
    LAS float* sq = (LAS float*)lds; LAS float* sk = sq + 256; LAS float* sv = sk + 256; LAS float* sn = sv + 256; LAS float* sr = sn + 256; LAS float* red = sr + 256;
    LAS float* part = red + 64;
    const int tid = opaque_tid(), lane = tid & 63, wid = tid >> 6;
    const size_t R = (size_t)MP + b;
    const size_t sidx = ((size_t)layer * BS + b) * HM + h;
    if (tid < 256) {
        if (BR == 0) { sq[tid] = bf2f(p.QK[R * 2048 + h * 512 + tid]); sk[tid] = bf2f(p.QK[R * 2048 + h * 512 + 256 + tid]); sv[tid] = bf2f(p.P[R * N1 + C_VM + h * 256 + tid]); sn[tid] = p.st_n[sidx * 256 + tid]; }
        else { sq[tid] = bf2f(p.P[R * N1 + C_QR + h * 256 + tid]); sk[tid] = bf2f(p.P[R * N1 + C_KR + h * 256 + tid]); sv[tid] = bf2f(p.P[R * N1 + C_VR + h * 256 + tid]); sn[tid] = 0.f; }
    }
    __syncthreads();
    float pq = 0.f, pn = 0.f;
    if (tid < 256) { pq = sq[tid] * sk[tid]; pn = sn[tid] * sq[tid]; }
    block_sum2(pq, pn, red);
    const float qk = pq, nq = pn;
    float wgt = 1.f, a = 1.f, mt = 0.f;
    if (BR == 0) {
        const float ig = p.IF[R * 8 + h] + p.b_i[layer * HM + h];
        const float lf = logsigf_(p.IF[R * 8 + 4 + h] + p.b_f[layer * HM + h]);
        const float inter = lf + p.st_m[sidx];
        mt = fmaxf(inter, ig); wgt = expf(ig - mt); a = expf(inter - mt);
    } else { a = 1.0f - exp2f(-5.0f - (float)h); }
    const float* S0 = (BR == 0 ? p.st_C : p.st_S) + sidx * SZ;
    float* S1 = p.out + (BR == 0 ? O_CS : O_SS) + sidx * SZ;
    const f32x4* S0v = (const f32x4*)S0 + lane; f32x4* S1v = (f32x4*)S1 + lane;
    f32x4 cc[8], cn[8];
#pragma unroll
    for (int j = 0; j < 8; ++j) cc[j] = __builtin_nontemporal_load(S0v + 64 * (wid + 8 * j));
    if (BR == 0) {
        const f32x4 q4 = *(LAS const f32x4*)(sq + 4 * lane), k4 = *(LAS const f32x4*)(sk + 4 * lane);
#pragma unroll
        for (int i0 = 0; i0 < 32; i0 += 8) {
            if (i0 + 8 < 32) {
#pragma unroll
                for (int j = 0; j < 8; ++j) cn[j] = __builtin_nontemporal_load(S0v + 64 * (wid + 8 * (i0 + 8 + j)));
            }
#pragma unroll
            for (int j = 0; j < 8; ++j) { const int e = wid + 8 * (i0 + j);
                float pt = (cc[j][0] * q4[0] + cc[j][1] * q4[1]) + (cc[j][2] * q4[2] + cc[j][3] * q4[3]);
                const float wv = wgt * sv[e];
                __builtin_nontemporal_store(cc[j] * a + k4 * wv, S1v + 64 * e);
                pt = wave_sum(pt);
                if (lane == 0) sr[e] = pt; }
#pragma unroll
            for (int j = 0; j < 8; ++j) cc[j] = cn[j];
        }
    } else {
        const f32x4 v4 = *(LAS const f32x4*)(sv + 4 * lane);
        f32x4 ac = (f32x4){0.f, 0.f, 0.f, 0.f};
#pragma unroll
        for (int i0 = 0; i0 < 32; i0 += 8) {
            if (i0 + 8 < 32) {
#pragma unroll
                for (int j = 0; j < 8; ++j) cn[j] = __builtin_nontemporal_load(S0v + 64 * (wid + 8 * (i0 + 8 + j)));
            }
#pragma unroll
            for (int j = 0; j < 8; ++j) { const int d = wid + 8 * (i0 + j);
                ac = ac + cc[j] * sq[d];
                __builtin_nontemporal_store(cc[j] * a + v4 * sk[d], S1v + 64 * d); }
#pragma unroll
            for (int j = 0; j < 8; ++j) cc[j] = cn[j];
        }
        *(LAS f32x4*)(part + wid * 256 + 4 * lane) = ac;
    }
    __syncthreads();
    float hv = 0.f;
    if (tid < 256) {
        if (BR == 0) {
            const float ws = wgt * qk;
            const float den = fmaxf(fabsf(ws + a * nq), expf(-mt));
            hv = (ws * sv[tid] + a * sr[tid]) / den;
            p.out[O_NS + sidx * 256 + tid] = a * sn[tid] + wgt * sk[tid];
            if (tid == 0) p.out[O_MS + sidx] = mt;
        } else {
            float s = 0.f;
#pragma unroll
            for (int i = 0; i < 8; ++i) s += part[i * 256 + tid];
            hv = qk * sv[tid] + a * s;
        }
    }
    float s1 = hv, s2 = 0.f;
    block_sum2(s1, s2, red);
    const float mean = s1 * (1.0f / 256.0f);
    float dv = tid < 256 ? hv - mean : 0.f;
    float q1 = dv * dv, q2 = 0.f;
    block_sum2(q1, q2, red);
    const float rstd = rsqrtf(q1 * (1.0f / 256.0f) + EPS);
    if (tid < 256) {
        const float ge = (BR == 0 ? p.hn_m_g : p.hn_r_g)[(size_t)layer * WM + h * 256 + tid];
        float v = dv * rstd * ge;
        const float z = bf2f(p.P[R * N1 + (BR == 0 ? C_ZM : C_ZR) + h * 256 + tid]);
        if (BR == 0) v += p.skip_m[(size_t)layer * WM + h * 256 + tid] * bf2f(p.CM[R * WM + h * 256 + tid]);
        p.OC[R * 2048 + BR * 1024 + h * 256 + tid] = f2bf(v * siluf_(z));
    }
    __syncthreads();
}

template <int MODE>
__device__ __forceinline__ void sample_gemm(const Params& p, const bf16_t* Wl, int wg) {
    if (wg >= 128) return;
    const int tid = opaque_tid(), lane = tid & 63, w = tid >> 6, g = lane >> 4, lr = lane & 15;
    const bf16_t* A = (MODE == 0 ? p.OC : p.MG) + (size_t)(MP + 16 * w + lr) * 2048 + 8 * g;
    const bf16_t* B = Wl + (MODE == 0 ? W3_OFF : W4_OFF) + (size_t)(16 * wg + lr) * 2048 + 8 * g;
    f32x4 acc[2];
#pragma unroll
    for (int hf = 0; hf < 2; ++hf) {
        acc[hf] = (f32x4){0.f, 0.f, 0.f, 0.f};
#pragma unroll 1
        for (int k0 = 0; k0 < 1024; k0 += 256) {
            bf16x8 af[8], bf[8];
#pragma unroll
            for (int i = 0; i < 8; ++i) { af[i] = *(const bf16x8*)(A + hf * 1024 + k0 + 32 * i); bf[i] = *(const bf16x8*)(B + hf * 1024 + k0 + 32 * i); }
#pragma unroll
            for (int i = 0; i < 8; ++i) acc[hf] = __builtin_amdgcn_mfma_f32_16x16x32_bf16(af[i], bf[i], acc[hf], 0, 0, 0);
        }
    }
    const int col = 16 * wg + lr;
#pragma unroll
    for (int r = 0; r < 4; ++r) {
        const size_t row = (size_t)MP + 16 * w + 4 * g + r;
        if (MODE == 0) {
            const float gm = sigmoidf_(bf2f(p.P[row * N1 + C_GM + col])), gr = sigmoidf_(bf2f(p.P[row * N1 + C_GR + col]));
            p.MG[row * 2048 + col] = f2bf(gm * acc[0][r] + gr * acc[1][r]);
        } else p.X[row * 2048 + col] += acc[0][r] + acc[1][r];
    }
}

__device__ __forceinline__ void phaseA(const Params& p, int layer, int wg, int nwg, LAS unsigned char* lds) {
    for (int it0 = wg; it0 < 1536; it0 += nwg) {
        const int it = (wg & 1) ? (it0 < 1024 ? it0 + 512 : it0 - 1024) : it0;
        if (it < 512) {
            const int br = it >> 8, rest = it & 255, b = rest >> 6, h = (rest >> 4) & 3, c = rest & 15;
            if (br == 0) chunk_passA<0>(p, layer, b, h, c, lds); else chunk_passA<1>(p, layer, b, h, c, lds);
        } else {
            const int s = it - 512, br = s >> 9, b = (s >> 2) & 127, h = s & 3;
            if (br == 0) sample_item<0>(p, layer, b, h, lds); else sample_item<1>(p, layer, b, h, lds);
        }
    }
}
__device__ __forceinline__ void phaseScan(const Params& p, int layer, int wg, int nwg, LAS unsigned char* lds) {
    for (int it = wg; it < 256; it += nwg) scan_item(p, layer, it >> 3, it & 7, lds);
}
__device__ __forceinline__ void phaseC(const Params& p, int layer, int wg, int nwg, LAS unsigned char* lds) {
    for (int it = wg; it < 512; it += nwg) {
        const int br = it >> 8, rest = it & 255, b = rest >> 6, h = (rest >> 4) & 3, c = rest & 15;
        if (br == 0) chunk_passC<0>(p, layer, b, h, c, lds); else chunk_passC<1>(p, layer, b, h, c, lds);
    }
}

template <int ONLY>
__device__ __forceinline__ void run_phases(const Params& p, int ph_lo, int ph_hi) {
    extern __shared__ __attribute__((aligned(16))) unsigned char smem_raw[];
    LAS unsigned char* lds = (LAS unsigned char*)smem_raw;
    volatile LAS unsigned* xbw = (volatile LAS unsigned*)(lds + LDS_BYTES - 16);
    const int wg = blockIdx.x, nwg = gridDim.x;
    const bool multi = (ph_hi - ph_lo) > 1;
    XcdBarrier bar; bar.bar = p.bar; bar.x = 0; bar.st = xbw;
    if (multi) {
        if (threadIdx.x == 0) { xbw[0] = 0u; xbw[1] = 0u; xbw[2] = 0u; xbw[3] = 0u; }
        __syncthreads();
        bar = xcd_barrier_post(p.bar, xbw);
    }
    int ph = 0;
#define PHASE(KIND, ...) { if constexpr (ONLY < 0 || ONLY == KIND) { if (ph >= ph_lo && ph < ph_hi) { __VA_ARGS__; if (ph + 1 < ph_hi) xcd_barrier(bar); } } ++ph; }
    PHASE(0, prep_phase(p, wg, nwg, lds))
    for (int layer = 0; layer < DEPTH; ++layer) {
        const bf16_t* Wl = p.W + (size_t)layer * WL;
        PHASE(1, norm_phase(p, layer, wg, nwg))
        PHASE(2, { pg8::StaticOrder S; S.init(MPAD, N1, nwg, wg); pg8::Gemm g{p.H, Wl + W1_OFF, D, D, D, 31, 0, 0};
                pg8::EpiBf16 E{p.P, N1, p.BIAS1 + (size_t)layer * N1}; pg8::gemm_phase<false>(lds, g, S, E); })
        PHASE(3, conv_phase(p, layer, wg, nwg))
        PHASE(4, { pg8::StaticOrder S; S.init(MPAD, 2048, nwg, wg); pg8::Gemm g{p.CM, Wl + W2_OFF, 256, WM, 256, 1, 512, 0};
                pg8::EpiBf16 E{p.QK, 2048, nullptr}; pg8::gemm_phase<false>(lds, g, S, E); })
        PHASE(5, phaseA(p, layer, wg, nwg, lds))
        PHASE(6, phaseScan(p, layer, wg, nwg, lds))
        PHASE(7, phaseC(p, layer, wg, nwg, lds))
        PHASE(8, { pg8::StaticOrder S; S.init(MP, 2048, nwg, wg); pg8::Gemm g{p.OC, Wl + W3_OFF, 2048, 2048, 2048, 31, 0, 16};
                pg8::EpiMerged E{p.MG, p.P + C_GM, p.P + C_GR, N1}; pg8::gemm_phase<true>(lds, g, S, E); sample_gemm<0>(p, Wl, wg); })
        PHASE(10, { pg8::StaticOrder S; S.init(MP, 2048, nwg, wg); pg8::Gemm g{p.MG, Wl + W4_OFF, 2048, 2048, 2048, 31, 0, 0};
                pg8::EpiResidual E{p.X}; pg8::gemm_phase<false>(lds, g, S, E); sample_gemm<1>(p, Wl, wg); })
    }
    PHASE(11, final_phase(p, wg, nwg))
#undef PHASE
}
__global__ void __launch_bounds__(512, 2) mega(Params p, int ph_lo, int ph_hi) { run_phases<-1>(p, ph_lo, ph_hi); }
#ifdef DIAG
template <int K> __global__ void __launch_bounds__(512, 2) mega_k(Params p, int ph_lo, int ph_hi) { run_phases<K>(p, ph_lo, ph_hi); }
template __global__ void mega_k<0>(Params, int, int); template __global__ void mega_k<1>(Params, int, int); template __global__ void mega_k<2>(Params, int, int);
template __global__ void mega_k<3>(Params, int, int); template __global__ void mega_k<4>(Params, int, int); template __global__ void mega_k<5>(Params, int, int);
template __global__ void mega_k<6>(Params, int, int); template __global__ void mega_k<7>(Params, int, int); template __global__ void mega_k<8>(Params, int, int);
template __global__ void mega_k<10>(Params, int, int); template __global__ void mega_k<11>(Params, int, int);
#endif
constexpr int N_PHASES = 2 + DEPTH * 9;

extern "C" void kernel_launch(void* const* d_in, const int* in_sizes, int n_in, void* d_out, int out_size, void* d_ws, size_t ws_size, hipStream_t stream) {
    (void)in_sizes; (void)n_in; (void)out_size; (void)ws_size;
    static int grid = 0;
    if (grid == 0) {
        int dev = 0, cus = 0;
        hipGetDevice(&dev);
        hipDeviceGetAttribute(&cus, hipDeviceAttributeMultiprocessorCount, dev);
        if (hipFuncSetAttribute((const void*)mega, hipFuncAttributeMaxDynamicSharedMemorySize, LDS_BYTES) != hipSuccess) fprintf(stderr, "hipFuncSetAttribute failed\n");
        (void)hipGetLastError();
        grid = cus > 0 ? cus : 256;
    }
    Params p{};
    const float** in = (const float**)&p;
    for (int i = 0; i < 24; ++i) in[i] = (const float*)d_in[i];
    p.out = (float*)d_out;
    unsigned char* ws = (unsigned char*)d_ws;
    size_t off = 0;
    auto take = [&](size_t bytes) { unsigned char* r = ws + off; off += (bytes + 255) & ~(size_t)255; return r; };
    p.bar = (unsigned*)take(16384);
    p.X = (float*)take((size_t)MPAD * D * 4);
    p.H = (bf16_t*)take((size_t)MPAD * D * 2);
    p.P = (bf16_t*)take((size_t)MPAD * N1 * 2);
    p.IF = (float*)take((size_t)MPAD * 8 * 4);
    p.CM = (bf16_t*)take((size_t)MPAD * WM * 2);
    p.QK = (bf16_t*)take((size_t)MPAD * 2048 * 2);
    p.OC = (bf16_t*)take((size_t)MPAD * 2048 * 2);
    p.T3 = (float*)take((size_t)MPAD * 2048 * 4);
    p.MG = (bf16_t*)take((size_t)MPAD * 2048 * 2);
    p.U = (float*)take((size_t)32 * 16 * SZ * 4);
    p.CS = (bf16_t*)take((size_t)32 * 16 * SZ * 2);
    p.NU = (float*)take((size_t)16 * 16 * 256 * 4);
    p.NS = (float*)take((size_t)16 * 16 * 256 * 4);
    p.W = (bf16_t*)take((size_t)DEPTH * WL * 2);
    p.WIF = (float*)take((size_t)DEPTH * 8 * D * 4);
    p.BIAS1 = (float*)take((size_t)DEPTH * N1 * 4);
    p.ROPE = (float*)take((size_t)2049 * 128 * 2 * 4);
    hipMemsetAsync(p.bar, 0, 16384, stream);
#if MK_SINGLE
    hipLaunchKernelGGL(mega, dim3(grid), dim3(512), LDS_BYTES, stream, p, 0, N_PHASES);
#else
    for (int ph = 0; ph < N_PHASES; ++ph) hipLaunchKernelGGL(mega, dim3(grid), dim3(512), LDS_BYTES, stream, p, ph, ph + 1);
#endif
}
```

```cpp
#include <hip/hip_runtime.h>
#include <stdint.h>
#include <stdio.h>

#ifndef MK_SINGLE
#define MK_SINGLE 1
#endif

#define LAS __attribute__((address_space(3)))
typedef unsigned short bf16_t;
typedef short bf16x8 __attribute__((ext_vector_type(8)));
typedef float f32x4 __attribute__((ext_vector_type(4)));
typedef unsigned u32x4 __attribute__((ext_vector_type(4)));
typedef unsigned u32x2 __attribute__((ext_vector_type(2)));

constexpr int D = 2048, SEQ = 2048, BP = 4, BS = 128, DEPTH = 4, HM = 4, DH = 256, WM = 1024, NIN = 7176;
constexpr int MP = BP * SEQ, MT = MP + BS, MPAD = 8448;
constexpr int N1 = 11264;
constexpr int C_U = 0, C_VM = 1024, C_ZM = 2048, C_QR = 3072, C_KR = 4096, C_VR = 5120, C_ZR = 6144, C_GM = 7168, C_GR = 9216;
constexpr float EPS = 1e-6f;
constexpr size_t SZ = 65536;
constexpr size_t O_YP = 0, O_YS = O_YP + 16777216, O_CP = O_YS + 262144, O_NP = O_CP + 4194304, O_MP = O_NP + 16384, O_CVP = O_MP + 64,
                 O_SP = O_CVP + 49152, O_CS = O_SP + 4194304, O_NS = O_CS + 134217728, O_MS = O_NS + 524288, O_CVS = O_MS + 2048, O_SS = O_CVS + 1572864;
constexpr size_t W1_OFF = 0, W2_OFF = W1_OFF + (size_t)N1 * D, W3_OFF = W2_OFF + (size_t)2048 * 256, W4_OFF = W3_OFF + (size_t)D * D, WL = W4_OFF + (size_t)D * D;
constexpr int LDS_BYTES = 147456;

struct Params {
    const float *x_prompt, *x_sample, *st_C, *st_n, *st_m, *st_conv, *st_S, *norm_g, *w_in, *conv_w, *conv_b, *w_qm, *w_km, *b_i, *b_f,
                *hn_m_g, *skip_m, *hn_r_g, *w_pm, *w_pr, *w_gate, *b_gate, *w_o, *final_g;
    float* out;
    unsigned* bar;
    float* X; bf16_t* H; bf16_t* P; float* IF; bf16_t* CM; bf16_t* QK; bf16_t* OC; float* T3; bf16_t* MG;
    float* U; bf16_t* CS; float* NU; float* NS; bf16_t* W; float* WIF; float* BIAS1; float* ROPE;
};

__device__ __forceinline__ int opaque_tid() { int t = threadIdx.x; asm volatile("" : "+v"(t)); return t; }
__device__ __forceinline__ float bf2f(bf16_t v) { return __uint_as_float((unsigned)v << 16); }
__device__ __forceinline__ bf16_t f2bf(float f) { unsigned u = __float_as_uint(f); u += 0x7fffu + ((u >> 16) & 1u); return (bf16_t)(u >> 16); }
__device__ __forceinline__ unsigned pk2(float lo, float hi) { return (unsigned)f2bf(lo) | ((unsigned)f2bf(hi) << 16); }
__device__ __forceinline__ float wave_sum(float v) {
#pragma unroll
    for (int o = 32; o >= 1; o >>= 1) v += __shfl_xor(v, o);
    return v;
}
__device__ __forceinline__ float wave_max(float v) {
#pragma unroll
    for (int o = 32; o >= 1; o >>= 1) v = fmaxf(v, __shfl_xor(v, o));
    return v;
}
__device__ __forceinline__ float sigmoidf_(float x) { return __builtin_amdgcn_rcpf(1.0f + __expf(-x)); }
__device__ __forceinline__ float siluf_(float x) { return x * __builtin_amdgcn_rcpf(1.0f + __expf(-x)); }
__device__ __forceinline__ float logsigf_(float x) { return x < 0.f ? x - log1pf(expf(x)) : -log1pf(expf(-x)); }
__device__ __forceinline__ void block_sum2(float& a, float& b, LAS float* red) {
    a = wave_sum(a); b = wave_sum(b);
    __syncthreads();
    if ((threadIdx.x & 63) == 0) { red[threadIdx.x >> 6] = a; red[8 + (threadIdx.x >> 6)] = b; }
    __syncthreads();
    float sa = 0.f, sb = 0.f;
#pragma unroll
    for (int i = 0; i < 8; ++i) { sa += red[i]; sb += red[8 + i]; }
    a = sa; b = sb;
}

#define XB_TMO      128
#define XB_XCNT(j)  (256  + 64 * (j))
#define XB_XSUB(j)  (1280 + 64 * (j))
#define XB_XGEN(j)  (2304 + 64 * (j))
#define XB_TOP      3328
#define XB_TOPGEN   3392
#define XCD_BAR_WORDS 3456
#define XB_SPIN_CAP (1u << 22)

__device__ __forceinline__ unsigned xb_ld(unsigned* p)              { return __hip_atomic_load(p, __ATOMIC_RELAXED, __HIP_MEMORY_SCOPE_AGENT); }
__device__ __forceinline__ unsigned xb_add(unsigned* p, unsigned v) { return __hip_atomic_fetch_add(p, v, __ATOMIC_RELAXED, __HIP_MEMORY_SCOPE_AGENT); }
__device__ __forceinline__ unsigned xb_xcc_id() { return (unsigned)__builtin_amdgcn_s_getreg((3 << 11) | 20) & 0xFu; }
#define XB_SPIN(cond, bar) do { unsigned _sp = 0; while (cond) { __builtin_amdgcn_s_sleep(1); \
    if ((++_sp & 255u) == 0u) { if (xb_ld(&(bar)[XB_TMO])) break; if (_sp > XB_SPIN_CAP) { atomicAdd(&(bar)[XB_TMO], 1u); break; } } } } while (0)

struct XcdBarrier { unsigned* bar; unsigned x; volatile LAS unsigned* st; };

__device__ __forceinline__ XcdBarrier xcd_barrier_post(unsigned* bar, volatile LAS unsigned* st) {
    XcdBarrier b; b.bar = bar; b.x = xb_xcc_id(); b.st = st;
    if (threadIdx.x == 0) (void)xb_add(&bar[XB_XCNT(b.x)], 1u);
    return b;
}
__device__ __forceinline__ void xcd_barrier_complete(unsigned* bar, unsigned x, unsigned& nloc, unsigned& nx) {
    const unsigned G = gridDim.x * gridDim.y * gridDim.z;
    unsigned sum, cnt, mine, sp = 0u;
    for (;;) {
        sum = 0u; cnt = 0u; mine = 0u;
#pragma unroll
        for (unsigned j = 0; j < 16; ++j) { const unsigned c = xb_ld(&bar[XB_XCNT(j)]); sum += c; cnt += (c > 0u) ? 1u : 0u; mine = (j == x) ? c : mine; }
        if (sum == G) break;
        __builtin_amdgcn_s_sleep(1);
        if ((++sp & 255u) == 0u) { if (xb_ld(&bar[XB_TMO])) break; if (sp > XB_SPIN_CAP) { atomicAdd(&bar[XB_TMO], 1u); break; } }
    }
    nloc = mine > 0u ? mine : 1u; nx = cnt > 0u ? cnt : 1u;
}
__device__ __forceinline__ void xcd_barrier(const XcdBarrier& b) {
    asm volatile("s_waitcnt vmcnt(0)" ::: "memory");
    __syncthreads();
    if (threadIdx.x == 0) {
        unsigned* bar = b.bar;
        __builtin_amdgcn_s_waitcnt(0);
        unsigned nloc = b.st[0], nx = b.st[1];
        if (nloc == 0u) { xcd_barrier_complete(bar, b.x, nloc, nx); b.st[0] = nloc; b.st[1] = nx; }
        const unsigned old = xb_add(&bar[XB_XSUB(b.x)], 1u);
        const unsigned gen = old / nloc;
        if (old + 1u == (gen + 1u) * nloc) {
            __builtin_amdgcn_fence(__ATOMIC_RELEASE, "agent");
            asm volatile("s_waitcnt vmcnt(0)" ::: "memory");
            const unsigned og = xb_add(&bar[XB_TOP], 1u);
            const unsigned tg = og / nx;
            if (og + 1u == (tg + 1u) * nx) xb_add(&bar[XB_TOPGEN], 1u);
            else XB_SPIN(xb_ld(&bar[XB_TOPGEN]) == tg, bar);
            __builtin_amdgcn_fence(__ATOMIC_ACQUIRE, "agent");
            xb_add(&bar[XB_XGEN(b.x)], 1u);
            asm volatile("s_waitcnt vmcnt(0)" ::: "memory");
        } else {
            XB_SPIN(xb_ld(&bar[XB_XGEN(b.x)]) == gen, bar);
            __builtin_amdgcn_fence(__ATOMIC_ACQUIRE, "agent");
            asm volatile("s_waitcnt vmcnt(0)" ::: "memory");
        }
    }
    __syncthreads();
}

namespace pg8 {
constexpr int BM = 256, BK = 64, HALF = 128, HTB = HALF * BK * 2, STAGE_BYTES = 8 * HTB, NXCD = 8, WGM = 8;
__host__ __device__ __forceinline__ int lds_byte(int r, int c) { const int st = (r >> 4) * 2 + (c >> 5), rr = r & 15, cc = c & 31, ob = rr * 64 + cc * 2; return st * 1024 + (ob ^ (((ob >> 9) & 1) << 5)); }
__host__ __device__ __forceinline__ void stage_rc(int b, int& R, int& C) { const int st = b / 1024, sb = b % 1024, swz = sb ^ (((sb >> 9) & 1) << 5); R = (st >> 1) * 16 + swz / 64; C = (st & 1) * 32 + (swz % 64) / 2; }
__host__ __device__ __forceinline__ int perm32(int rho) { const int n = rho >> 4, i = rho & 15; return 8 * (i >> 2) + 4 * n + (i & 3); }

struct Unit { int pm, pn; };
struct Gemm { const bf16_t* A; const bf16_t* Bt; int K, lda, ldb, a_pn_shift, a_pn_stride, mid_t; };

struct StaticOrder {
    int nM, nN, nwg, G, c;
    __device__ void init(int M, int N, int G_, int c_) { nM = M / BM; nN = N / BM; nwg = nM * nN; G = G_; c = c_; }
    __device__ bool next(int i, Unit& u) const {
        const long L = (long)i * G + c; if (L >= nwg) return false;
        int wgid = (int)L; { const int q = nwg / NXCD, r = nwg % NXCD, xcd = wgid % NXCD, off = wgid / NXCD; wgid = (xcd < r ? xcd * (q + 1) : r * (q + 1) + (xcd - r) * q) + off; }
        const int nig = WGM * nN, gid = wgid / nig, fm = gid * WGM, gsz = (nM - fm) < WGM ? (nM - fm) : WGM;
        u.pm = fm + ((wgid % nig) % gsz); u.pn = (wgid % nig) / gsz; return true;
    }
};
__device__ __forceinline__ unsigned cvt_pk_bf16(float lo, float hi) { unsigned r; asm volatile("v_cvt_pk_bf16_f32 %0, %1, %2" : "=v"(r) : "v"(lo), "v"(hi)); return r; }

struct EpiBf16 {
    static constexpr bool PERM = true;
    bf16_t* O; int ldc; const float* bias;
    __device__ __forceinline__ void operator()(const f32x4 (&acc)[2][2][4][2], const Unit& u, int wr, int wc, int fr, int fq) const {
        const int row0 = u.pm * BM + wr * 64 + fr, col0 = u.pn * BM + wc * 32 + 8 * fq;
        f32x4 bv[2][2];
#pragma unroll
        for (int bj = 0; bj < 2; ++bj)
#pragma unroll
            for (int n = 0; n < 2; ++n) bv[bj][n] = bias ? *(const f32x4*)(bias + col0 + bj * HALF + 4 * n) : (f32x4){0.f, 0.f, 0.f, 0.f};
#pragma unroll
        for (int ai = 0; ai < 2; ++ai)
#pragma unroll
            for (int m = 0; m < 4; ++m) { bf16_t* rowp = O + (size_t)(row0 + ai * HALF + m * 16) * ldc + col0;
#pragma unroll
                for (int bj = 0; bj < 2; ++bj) { const f32x4 v0 = acc[ai][bj][m][0] + bv[bj][0], v1 = acc[ai][bj][m][1] + bv[bj][1];
                    u32x4 w; w.x = cvt_pk_bf16(v0[0], v0[1]); w.y = cvt_pk_bf16(v0[2], v0[3]); w.z = cvt_pk_bf16(v1[0], v1[1]); w.w = cvt_pk_bf16(v1[2], v1[3]);
                    *(u32x4*)(rowp + bj * HALF) = w; } }
    }
};
struct EpiMerged {
    static constexpr bool PERM = true;
    bf16_t* O; const bf16_t* GM; const bf16_t* GR; int ldg;
    __device__ __forceinline__ void mid(f32x4 (&acc)[2][2][4][2], const Unit& u, int wr, int wc, int fr, int fq) const {
        asm volatile("" : "+v"(fr), "+v"(fq));
        const int row0 = u.pm * BM + wr * 64 + fr, col0 = u.pn * BM + wc * 32 + 8 * fq;
#pragma unroll
        for (int ai = 0; ai < 2; ++ai)
#pragma unroll
            for (int m = 0; m < 4; ++m) { const size_t row = (size_t)(row0 + ai * HALF + m * 16);
#pragma unroll
                for (int bj = 0; bj < 2; ++bj) { const int col = col0 + bj * HALF;
                    const u32x4 a = *(const u32x4*)(GM + row * ldg + col), b = *(const u32x4*)(GR + row * ldg + col);
                    const unsigned aw[4] = {a.x, a.y, a.z, a.w}, bw[4] = {b.x, b.y, b.z, b.w};
#pragma unroll
                    for (int q = 0; q < 4; ++q) {
                        const float r0 = (1.0f + __expf(-__uint_as_float(bw[q] << 16))) * __builtin_amdgcn_rcpf(1.0f + __expf(-__uint_as_float(aw[q] << 16)));
                        const float r1 = (1.0f + __expf(-__uint_as_float(bw[q] & 0xffff0000u))) * __builtin_amdgcn_rcpf(1.0f + __expf(-__uint_as_float(aw[q] & 0xffff0000u)));
                        acc[ai][bj][m][q >> 1][(q & 1) * 2] *= r0; acc[ai][bj][m][q >> 1][(q & 1) * 2 + 1] *= r1; }
                }
                __builtin_amdgcn_sched_barrier(0); }
    }
    __device__ __forceinline__ void operator()(const f32x4 (&acc)[2][2][4][2], const Unit& u, int wr, int wc, int fr, int fq) const {
        const int row0 = u.pm * BM + wr * 64 + fr, col0 = u.pn * BM + wc * 32 + 8 * fq;
#pragma unroll
        for (int ai = 0; ai < 2; ++ai)
#pragma unroll
            for (int m = 0; m < 4; ++m) { const size_t row = (size_t)(row0 + ai * HALF + m * 16);
#pragma unroll
                for (int bj = 0; bj < 2; ++bj) { const int col = col0 + bj * HALF;
                    const u32x4 gb = *(const u32x4*)(GR + row * ldg + col);
                    f32x4 g0, g1;
                    g0[0] = sigmoidf_(__uint_as_float(gb.x << 16)); g0[1] = sigmoidf_(__uint_as_float(gb.x & 0xffff0000u));
                    g0[2] = sigmoidf_(__uint_as_float(gb.y << 16)); g0[3] = sigmoidf_(__uint_as_float(gb.y & 0xffff0000u));
                    g1[0] = sigmoidf_(__uint_as_float(gb.z << 16)); g1[1] = sigmoidf_(__uint_as_float(gb.z & 0xffff0000u));
                    g1[2] = sigmoidf_(__uint_as_float(gb.w << 16)); g1[3] = sigmoidf_(__uint_as_float(gb.w & 0xffff0000u));
                    const f32x4 v0 = acc[ai][bj][m][0] * g0, v1 = acc[ai][bj][m][1] * g1;
                    u32x4 w; w.x = cvt_pk_bf16(v0[0], v0[1]); w.y = cvt_pk_bf16(v0[2], v0[3]); w.z = cvt_pk_bf16(v1[0], v1[1]); w.w = cvt_pk_bf16(v1[2], v1[3]);
                    *(u32x4*)(O + row * 2048 + col) = w; } }
    }
};
struct EpiResidual {
    static constexpr bool PERM = false;
    float* X;
    __device__ __forceinline__ void operator()(const f32x4 (&acc)[2][2][4][2], const Unit& u, int wr, int wc, int fr, int fq) const {
        const int row0 = u.pm * BM + wr * 64 + fr, col0 = u.pn * BM + wc * 32 + 4 * fq;
#pragma unroll
        for (int ai = 0; ai < 2; ++ai)
#pragma unroll
            for (int m = 0; m < 4; ++m) { float* rowp = X + (size_t)(row0 + ai * HALF + m * 16) * 2048 + col0;
#pragma unroll
                for (int bj = 0; bj < 2; ++bj)
#pragma unroll
                    for (int n = 0; n < 2; ++n) { f32x4* q = (f32x4*)(rowp + bj * HALF + n * 16); *q = *q + acc[ai][bj][m][n]; } }
    }
};

template <bool MID, class Epi, class Sched>
__device__ __forceinline__ void gemm_phase(LAS unsigned char* lds, const Gemm g, const Sched& S, const Epi& E) {
    const int tid = opaque_tid(), wid = __builtin_amdgcn_readfirstlane(tid >> 6), lane = tid & 63, wr = wid >> 2, wc = wid & 3, fr = lane & 15, fq = lane >> 4;
    const int K = g.K, nt = K / BK;
    unsigned voffA[2], voffB[2];
#pragma unroll
    for (int i = 0; i < 2; ++i) { int R, C; stage_rc(tid * 16 + i * 8192, R, C); const int Rb = Epi::PERM ? ((R & ~31) + perm32(R & 31)) : R;
        voffA[i] = (unsigned)(R * g.lda + C) * 2u; voffB[i] = (unsigned)(Rb * g.ldb + C) * 2u; }
    const size_t kstep = (size_t)(BK * 2);
    const size_t hstepA = (size_t)HALF * g.lda * 2, hstepB = (size_t)HALF * g.ldb * 2;
    const size_t tstepA = 2 * hstepA, tstepB = 2 * hstepB;
    const unsigned ldsw = (unsigned)wid * 1024u;
    const int aoff = lds_byte(wr * 64 + fr, fq * 8), boff = lds_byte(wc * 32 + fr, fq * 8);
#define PG8_SA(b, h) (((b) * 2 + (h)) * HTB)
#define PG8_SB(b, h) ((4 + (b) * 2 + (h)) * HTB)
#define PG8_STAGE(bufoff, gbase, voff) do { _Pragma("unroll") for (int _i = 0; _i < 2; ++_i) \
        __builtin_amdgcn_global_load_lds((const unsigned*)((const char*)(gbase) + (voff)[_i]), (LAS unsigned*)(lds + (bufoff) + ldsw + _i * 8192), 16, 0, 0); } while (0)
#define PG8_LDA(dst, b, h) do { _Pragma("unroll") for (int m = 0; m < 4; ++m) _Pragma("unroll") for (int k = 0; k < 2; ++k) dst[m][k] = *(const LAS bf16x8*)(lds + PG8_SA(b, h) + aoff + m * 2048 + k * 1024); } while (0)
#define PG8_LDB(dst, b, h) do { _Pragma("unroll") for (int n = 0; n < 2; ++n) _Pragma("unroll") for (int k = 0; k < 2; ++k) dst[n][k] = *(const LAS bf16x8*)(lds + PG8_SB(b, h) + boff + n * 2048 + k * 1024); } while (0)
#define PG8_MMA(ai, bj, At, Bt) do { __builtin_amdgcn_s_setprio(1); _Pragma("unroll") for (int m = 0; m < 4; ++m) _Pragma("unroll") for (int n = 0; n < 2; ++n) _Pragma("unroll") for (int k = 0; k < 2; ++k) \
        acc[ai][bj][m][n] = __builtin_amdgcn_mfma_f32_16x16x32_bf16(Bt[n][k], At[m][k], acc[ai][bj][m][n], 0, 0, 0); __builtin_amdgcn_s_setprio(0); } while (0)
#define PG8_WAIT_V(n) asm volatile("s_waitcnt vmcnt(" #n ")" ::: "memory")
#define PG8_WAIT_L(n) asm volatile("s_waitcnt lgkmcnt(" #n ")" ::: "memory")
#define PG8_BAR __builtin_amdgcn_s_barrier()
#define PG8_SCHED __builtin_amdgcn_sched_barrier(0)
#define PG8_APTR(u) ((const char*)g.A + (size_t)(u).pm * tstepA + (size_t)((u).pn >> g.a_pn_shift) * (size_t)g.a_pn_stride)
    Unit cur, nxt; int ui = 0;
    if (!S.next(0, cur)) return;
    f32x4 acc[2][2][4][2];
#pragma unroll
    for (int a = 0; a < 2; ++a)
#pragma unroll
        for (int b = 0; b < 2; ++b)
#pragma unroll
            for (int m = 0; m < 4; ++m)
#pragma unroll
                for (int n = 0; n < 2; ++n) acc[a][b][m][n] = (f32x4){0.f, 0.f, 0.f, 0.f};
    bf16x8 At[4][2], B0[2][2], B1[2][2];
    const char* cA = PG8_APTR(cur); const char* cB = (const char*)g.Bt + (size_t)cur.pn * tstepB;
    PG8_STAGE(PG8_SB(0, 0), cB, voffB); PG8_STAGE(PG8_SA(0, 0), cA, voffA); PG8_STAGE(PG8_SB(0, 1), cB + hstepB, voffB); PG8_STAGE(PG8_SA(0, 1), cA + hstepA, voffA);
    if (wr == 1) PG8_BAR;
    PG8_WAIT_V(4); PG8_BAR;
    PG8_STAGE(PG8_SB(1, 0), cB + kstep, voffB); PG8_STAGE(PG8_SA(1, 0), cA + kstep, voffA); PG8_STAGE(PG8_SB(1, 1), cB + hstepB + kstep, voffB);
    PG8_WAIT_V(6); PG8_BAR;
    for (;;) {
        const bool has_next = S.next(ui + 1, nxt);
        const char* nA = has_next ? PG8_APTR(nxt) : cA; const char* nB = has_next ? (const char*)g.Bt + (size_t)nxt.pn * tstepB : cB;
        for (int t = 0; t < nt; t += 2) {
            const bool last = (t == nt - 2);
            const char* a1 = cA + (size_t)(t + 1) * kstep;
            const char* a2 = last ? nA : cA + (size_t)(t + 2) * kstep; const char* b2 = last ? nB : cB + (size_t)(t + 2) * kstep;
            const char* a3 = a2 + kstep; const char* b3 = b2 + kstep;
            if constexpr (MID) { if (t == g.mid_t) E.mid(acc, cur, wr, wc, fr, fq); }
            PG8_LDB(B0, 0, 0); PG8_SCHED; PG8_LDA(At, 0, 0); PG8_STAGE(PG8_SA(1, 1), a1 + hstepA, voffA);
            PG8_WAIT_L(8); PG8_BAR; PG8_WAIT_L(0); PG8_MMA(0, 0, At, B0); PG8_BAR; PG8_SCHED;
            PG8_LDB(B1, 0, 1); PG8_STAGE(PG8_SB(0, 0), b2, voffB);
            PG8_BAR; PG8_WAIT_L(0); PG8_MMA(0, 1, At, B1); PG8_BAR;
            PG8_LDA(At, 0, 1); PG8_STAGE(PG8_SA(0, 0), a2, voffA);
            PG8_BAR; PG8_WAIT_L(0); PG8_MMA(1, 0, At, B0); PG8_BAR; PG8_SCHED;
            PG8_STAGE(PG8_SB(0, 1), b2 + hstepB, voffB);
            PG8_WAIT_V(6); PG8_BAR; PG8_MMA(1, 1, At, B1); PG8_BAR;
            PG8_LDB(B0, 1, 0); PG8_SCHED; PG8_LDA(At, 1, 0); PG8_STAGE(PG8_SA(0, 1), a2 + hstepA, voffA);
            PG8_WAIT_L(8); PG8_BAR; PG8_WAIT_L(0); PG8_MMA(0, 0, At, B0); PG8_BAR; PG8_SCHED;
            PG8_LDB(B1, 1, 1); PG8_STAGE(PG8_SB(1, 0), b3, voffB);
            PG8_BAR; PG8_WAIT_L(0); PG8_MMA(0, 1, At, B1); PG8_BAR;
            PG8_LDA(At, 1, 1); PG8_STAGE(PG8_SA(1, 0), a3, voffA);
            PG8_BAR; PG8_WAIT_L(0); PG8_MMA(1, 0, At, B0); PG8_BAR; PG8_SCHED;
            PG8_STAGE(PG8_SB(1, 1), b3 + hstepB, voffB);
            PG8_WAIT_V(6); PG8_BAR; PG8_MMA(1, 1, At, B1); PG8_BAR;
        }
        E(acc, cur, wr, wc, fr, fq);
        if (!has_next) break;
#pragma unroll
        for (int a = 0; a < 2; ++a)
#pragma unroll
            for (int b = 0; b < 2; ++b)
#pragma unroll
                for (int m = 0; m < 4; ++m)
#pragma unroll
                    for (int n = 0; n < 2; ++n) acc[a][b][m][n] = (f32x4){0.f, 0.f, 0.f, 0.f};
        cur = nxt; cA = nA; cB = nB; ++ui;
    }
    PG8_WAIT_V(0);
    if (wr == 0) PG8_BAR;
    PG8_BAR;
#undef PG8_SA
#undef PG8_SB
#undef PG8_STAGE
#undef PG8_LDA
#undef PG8_LDB
#undef PG8_MMA
#undef PG8_WAIT_V
#undef PG8_WAIT_L
#undef PG8_BAR
#undef PG8_SCHED
#undef PG8_APTR
}
}

__device__ __forceinline__ void tr_tile(const float* src, int ldsrc, int k0, int c0, bf16_t* dst, int ldd, int r0, int kd0, float scale, LAS float* t, int lane) {
    f32x4 v[16];
#pragma unroll
    for (int i = 0; i < 16; ++i) v[i] = __builtin_nontemporal_load((const f32x4*)(src + (size_t)(k0 + (lane >> 4) + 4 * i) * ldsrc + c0 + 4 * (lane & 15)));
#pragma unroll
    for (int i = 0; i < 16; ++i)
#pragma unroll
        for (int j = 0; j < 4; ++j) t[((lane >> 4) + 4 * i) * 65 + 4 * (lane & 15) + j] = v[i][j];
    const int c = lane & 7;
#pragma unroll
    for (int j = 0; j < 8; ++j) { const int n = (lane >> 3) + 8 * j; const LAS float* q = t + (8 * c) * 65 + n;
        u32x4 o; o.x = pk2(scale * q[0], scale * q[65]); o.y = pk2(scale * q[130], scale * q[195]); o.z = pk2(scale * q[260], scale * q[325]); o.w = pk2(scale * q[390], scale * q[455]);
        *(u32x4*)(dst + (size_t)(r0 + n) * ldd + kd0 + 8 * c) = o; }
}
__device__ __forceinline__ void prep_phase(const Params& p, int wg, int nwg, LAS unsigned char* lds) {
    const int tid = opaque_tid();
    for (size_t i = (size_t)wg * 512 + tid; i < (size_t)MPAD * D / 4; i += (size_t)nwg * 512) {
        const size_t row = (i * 4) / D;
        f32x4 v = (f32x4){0.f, 0.f, 0.f, 0.f};
        if (row < (size_t)MP) v = ((const f32x4*)p.x_prompt)[i];
        else if (row < (size_t)MT) v = ((const f32x4*)p.x_sample)[i - (size_t)MP * D / 4];
        ((f32x4*)p.X)[i] = v;
    }
    for (int i = wg * 512 + tid; i < 2049 * 128; i += nwg * 512) {
        const int pi = i >> 7, j = i & 127;
        const float pos = pi < 2048 ? (float)pi : 16384.0f;
        const float inv = powf(10000.0f, -((float)j / 128.0f));
        const float ang = pos * inv;
        p.ROPE[2 * i] = (float)cos((double)ang); p.ROPE[2 * i + 1] = (float)sin((double)ang);
    }
    for (int i = wg * 512 + tid; i < DEPTH * 8 * D; i += nwg * 512) {
        const int l = i / (8 * D), r = i % (8 * D), j = r / D, k = r % D;
        p.WIF[i] = p.w_in[((size_t)l * D + k) * NIN + 3072 + j];
    }
    for (int i = wg * 512 + tid; i < DEPTH * N1; i += nwg * 512) {
        const int l = i / N1, n = i % N1;
        p.BIAS1[i] = n < C_GM ? 0.f : p.b_gate[l * 4096 + (n - C_GM)];
    }
    const int lane = tid & 63, wid = tid >> 6;
    LAS float* t = (LAS float*)lds + wid * (64 * 65);
    constexpr int T0 = 1536, T1 = T0 + 2048, T2 = T1 + 2048, T3 = T2 + 512, T4 = T3 + 512, T5 = T4 + 1024, T6 = T5 + 64, T7 = T6 + 64;
    for (int it = wg * 8 + wid; it < DEPTH * T7; it += nwg * 8) {
        const int l = it / T7, r = it % T7;
        bf16_t* Wl = p.W + (size_t)l * WL;
        if (r < T0)      { const int q = r;      tr_tile(p.w_in + (size_t)l * D * NIN, NIN, (q & 31) * 64, (q >> 5) * 64, Wl + W1_OFF, D, (q >> 5) * 64, (q & 31) * 64, 1.f, t, lane); }
        else if (r < T1) { const int q = r - T0; tr_tile(p.w_in + (size_t)l * D * NIN, NIN, (q & 31) * 64, 3080 + (q >> 5) * 64, Wl + W1_OFF, D, 3072 + (q >> 5) * 64, (q & 31) * 64, 1.f, t, lane); }
        else if (r < T2) { const int q = r - T1; tr_tile(p.w_gate + (size_t)l * D * 4096, 4096, (q & 31) * 64, (q >> 5) * 64, Wl + W1_OFF, D, C_GM + (q >> 5) * 64, (q & 31) * 64, 1.f, t, lane); }
        else if (r < T3) { const int q = r - T2; tr_tile(p.w_pm + (size_t)l * WM * D, D, (q & 15) * 64, (q >> 4) * 64, Wl + W3_OFF, D, (q >> 4) * 64, (q & 15) * 64, 1.f, t, lane); }
        else if (r < T4) { const int q = r - T3; tr_tile(p.w_pr + (size_t)l * WM * D, D, (q & 15) * 64, (q >> 4) * 64, Wl + W3_OFF, D, (q >> 4) * 64, 1024 + (q & 15) * 64, 1.f, t, lane); }
        else if (r < T5) { const int q = r - T4; tr_tile(p.w_o + (size_t)l * D * D, D, (q & 31) * 64, (q >> 5) * 64, Wl + W4_OFF, D, (q >> 5) * 64, (q & 31) * 64, 1.f, t, lane); }
        else if (r < T6) { const int q = r - T5, h = q >> 4, qq = q & 15; tr_tile(p.w_qm + ((size_t)l * HM + h) * SZ, DH, (qq & 3) * 64, (qq >> 2) * 64, Wl + W2_OFF, DH, h * 512 + (qq >> 2) * 64, (qq & 3) * 64, 0.0625f, t, lane); }
        else             { const int q = r - T6, h = q >> 4, qq = q & 15; tr_tile(p.w_km + ((size_t)l * HM + h) * SZ, DH, (qq & 3) * 64, (qq >> 2) * 64, Wl + W2_OFF, DH, h * 512 + 256 + (qq >> 2) * 64, (qq & 3) * 64, 1.f, t, lane); }
    }
}

__device__ __forceinline__ void norm_phase(const Params& p, int layer, int wg, int nwg, LAS unsigned char* lds) {
    const int tid_ = opaque_tid(), lane = tid_ & 63, wid = tid_ >> 6;
    const f32x4* g4 = (const f32x4*)(p.norm_g + (size_t)layer * D);
    const float* wif = p.WIF + (size_t)layer * 8 * D;
    LAS f32x4* wl = (LAS f32x4*)lds;
#pragma unroll
    for (int i = 0; i < 8; ++i) wl[tid_ + 512 * i] = ((const f32x4*)wif)[tid_ + 512 * i];
    __syncthreads();
    for (int row = wg * 8 + wid; row < MPAD; row += nwg * 8) {
        u32x2* hrow = (u32x2*)(p.H + (size_t)row * D);
        if (row >= MT) {
#pragma unroll
            for (int i = 0; i < 8; ++i) hrow[lane + 64 * i] = (u32x2){0u, 0u};
            continue;
        }
        const f32x4* xr = (const f32x4*)(p.X + (size_t)row * D);
        f32x4 v[8]; float ss = 0.f;
#pragma unroll
        for (int i = 0; i < 8; ++i) { v[i] = xr[lane + 64 * i]; ss += (v[i][0] * v[i][0] + v[i][1] * v[i][1]) + (v[i][2] * v[i][2] + v[i][3] * v[i][3]); }
        ss = wave_sum(ss);
        const float rstd = rsqrtf(ss * (1.0f / D) + EPS);
#pragma unroll
        for (int i = 0; i < 8; ++i) {
            v[i] = v[i] * rstd * g4[lane + 64 * i];
            hrow[lane + 64 * i] = (u32x2){pk2(v[i][0], v[i][1]), pk2(v[i][2], v[i][3])};
        }
#pragma unroll 1
        for (int j = 0; j < 8; ++j) {
            float s = 0.f;
#pragma unroll
            for (int i = 0; i < 8; ++i) { const f32x4 w = wl[j * 512 + lane + 64 * i]; s += (v[i][0] * w[0] + v[i][1] * w[1]) + (v[i][2] * w[2] + v[i][3] * w[3]); }
            s = wave_sum(s);
            if (lane == 0) p.IF[(size_t)row * 8 + j] = s;
        }
    }
}
__device__ __forceinline__ void final_phase(const Params& p, int wg, int nwg) {
    const int tid_ = opaque_tid(), lane = tid_ & 63, wid = tid_ >> 6;
    const f32x4* g4 = (const f32x4*)p.final_g;
    for (int row = wg * 8 + wid; row < MT; row += nwg * 8) {
        const f32x4* xr = (const f32x4*)(p.X + (size_t)row * D);
        f32x4* yr = (f32x4*)(p.out + (row < MP ? O_YP + (size_t)row * D : O_YS + (size_t)(row - MP) * D));
        f32x4 v[8]; float ss = 0.f;
#pragma unroll
        for (int i = 0; i < 8; ++i) { v[i] = xr[lane + 64 * i]; ss += (v[i][0] * v[i][0] + v[i][1] * v[i][1]) + (v[i][2] * v[i][2] + v[i][3] * v[i][3]); }
        ss = wave_sum(ss);
        const float rstd = rsqrtf(ss * (1.0f / D) + EPS);
#pragma unroll
        for (int i = 0; i < 8; ++i) yr[lane + 64 * i] = v[i] * rstd * g4[lane + 64 * i];
    }
}

__device__ __forceinline__ void unpack8(const u32x4 v, float (&f)[8]) {
    f[0] = __uint_as_float(v.x << 16); f[1] = __uint_as_float(v.x & 0xffff0000u); f[2] = __uint_as_float(v.y << 16); f[3] = __uint_as_float(v.y & 0xffff0000u);
    f[4] = __uint_as_float(v.z << 16); f[5] = __uint_as_float(v.z & 0xffff0000u); f[6] = __uint_as_float(v.w << 16); f[7] = __uint_as_float(v.w & 0xffff0000u);
}
__device__ __forceinline__ u32x4 pack8(const float (&f)[8]) { u32x4 w; w.x = pk2(f[0], f[1]); w.y = pk2(f[2], f[3]); w.z = pk2(f[4], f[5]); w.w = pk2(f[6], f[7]); return w; }

__device__ __forceinline__ void conv_phase(const Params& p, int layer, int wg, int nwg) {
    const int tid = opaque_tid();
    const float* cw = p.conv_w + (size_t)layer * 4 * WM;
    const float* cb = p.conv_b + (size_t)layer * WM;
    for (int it = wg * 512 + tid; it < MT * 128; it += nwg * 512) {
        const int row = it >> 7, ch = (it & 127) * 8;
        float up[4][8];
        if (row < MP) {
            const int t = row & (SEQ - 1);
#pragma unroll
            for (int i = 0; i < 4; ++i) {
                if (t - 3 + i >= 0) unpack8(*(const u32x4*)(p.P + (size_t)(row - 3 + i) * N1 + C_U + ch), up[i]);
                else {
#pragma unroll
                    for (int j = 0; j < 8; ++j) up[i][j] = 0.f;
                }
            }
            if (t >= SEQ - 3) {
                const int b = row >> 11;
                float* o = p.out + O_CVP + (((size_t)layer * BP + b) * 3 + (t - (SEQ - 3))) * WM + ch;
                *(f32x4*)o = (f32x4){up[3][0], up[3][1], up[3][2], up[3][3]}; *(f32x4*)(o + 4) = (f32x4){up[3][4], up[3][5], up[3][6], up[3][7]};
            }
        } else {
            const int b = row - MP;
            const float* hist = p.st_conv + ((size_t)layer * BS + b) * 3 * WM + ch;
#pragma unroll
            for (int i = 0; i < 3; ++i) { const f32x4 a = *(const f32x4*)(hist + (size_t)i * WM), c = *(const f32x4*)(hist + (size_t)i * WM + 4);
                up[i][0] = a[0]; up[i][1] = a[1]; up[i][2] = a[2]; up[i][3] = a[3]; up[i][4] = c[0]; up[i][5] = c[1]; up[i][6] = c[2]; up[i][7] = c[3]; }
            unpack8(*(const u32x4*)(p.P + (size_t)row * N1 + C_U + ch), up[3]);
            float* o = p.out + O_CVS + ((size_t)layer * BS + b) * 3 * WM + ch;
#pragma unroll
            for (int i = 0; i < 3; ++i) { *(f32x4*)(o + (size_t)i * WM) = (f32x4){up[i + 1][0], up[i + 1][1], up[i + 1][2], up[i + 1][3]};
                *(f32x4*)(o + (size_t)i * WM + 4) = (f32x4){up[i + 1][4], up[i + 1][5], up[i + 1][6], up[i + 1][7]}; }
        }
        float r[8];
#pragma unroll
        for (int j = 0; j < 8; ++j) r[j] = cb[ch + j];
#pragma unroll
        for (int i = 0; i < 4; ++i)
#pragma unroll
            for (int j = 0; j < 8; ++j) r[j] += up[i][j] * cw[i * WM + ch + j];
#pragma unroll
        for (int j = 0; j < 8; ++j) r[j] = siluf_(r[j]);
        *(u32x4*)(p.CM + (size_t)row * WM + ch) = pack8(r);
    }
    for (int it = wg * 512 + tid; it < MT * 128; it += nwg * 512) {
        const int row = it >> 7, r2 = it & 127, which = r2 >> 6, h = (r2 >> 4) & 3, d0 = (r2 & 15) * 8;
        const int pi = row < MP ? (row & (SEQ - 1)) : 2048;
        bf16_t* base = p.P + (size_t)row * N1 + (which ? C_KR : C_QR) + h * 256 + d0;
        float x1[8], x2[8], o1[8], o2[8];
        unpack8(*(const u32x4*)base, x1); unpack8(*(const u32x4*)(base + 128), x2);
        const float* cs = p.ROPE + ((size_t)pi * 128 + d0) * 2;
        const float sc = which ? 0.0625f : 1.0f;
#pragma unroll
        for (int j = 0; j < 8; ++j) { const float c = cs[2 * j], s = cs[2 * j + 1]; o1[j] = (x1[j] * c - x2[j] * s) * sc; o2[j] = (x1[j] * s + x2[j] * c) * sc; }
        *(u32x4*)base = pack8(o1); *(u32x4*)(base + 128) = pack8(o2);
    }
}

__device__ __forceinline__ void gate_scan(const Params& p, int layer, int b, int h, int c_own, LAS float* G) {
    const int tid = opaque_tid(), lane = tid & 63, wid = tid >> 6;
    const float bi = p.b_i[layer * HM + h], bfv = p.b_f[layer * HM + h];
#pragma unroll
    for (int q = 0; q < 2; ++q) {
        const int cc = wid + 8 * q;
        const size_t r0 = (size_t)b * SEQ + cc * 128 + 2 * lane;
        const float i0 = p.IF[r0 * 8 + h] + bi, i1 = p.IF[(r0 + 1) * 8 + h] + bi;
        const float l0 = logsigf_(p.IF[r0 * 8 + 4 + h] + bfv), l1 = logsigf_(p.IF[(r0 + 1) * 8 + 4 + h] + bfv);
        float inc = l0 + l1;
#pragma unroll
        for (int o = 1; o < 64; o <<= 1) { const float t = __shfl_up(inc, o); if (lane >= o) inc += t; }
        const float exc = inc - (l0 + l1);
        const float b0 = exc + l0, b1 = inc;
        const float g0 = i0 - b0, g1 = i1 - b1;
        const float gm = wave_max(fmaxf(g0, g1));
        const float Bc = __shfl(inc, 63);
        if (lane == 0) { G[cc] = Bc; G[16 + cc] = gm; }
        if (cc == c_own) {
            float rm = fmaxf(g0, g1);
#pragma unroll
            for (int o = 1; o < 64; o <<= 1) { const float t = __shfl_up(rm, o); if (lane >= o) rm = fmaxf(rm, t); }
            float ex = __shfl_up(rm, 1); if (lane == 0) ex = -3.0e38f;
            const float c0 = fmaxf(ex, g0), c1 = fmaxf(c0, g1);
            G[64 + 2 * lane] = b0; G[65 + 2 * lane] = b1; G[192 + 2 * lane] = g0; G[193 + 2 * lane] = g1; G[320 + 2 * lane] = c0; G[321 + 2 * lane] = c1;
        }
    }
    __syncthreads();
    if (tid == 0) { float m = -1e30f; for (int cc = 0; cc < 16; ++cc) { G[32 + cc] = m; m = G[cc] + fmaxf(m, G[16 + cc]); } G[48] = m; }
    __syncthreads();
    if (c_own >= 0 && tid < 128) G[320 + tid] = fmaxf(G[320 + tid], G[32 + c_own]);
    __syncthreads();
}

template <int NR, int NC, bool WEIGHT>
__device__ __forceinline__ void stage_T(LAS unsigned char* dst, int ldd_bytes, const bf16_t* src, int ld_src, LAS const float* w) {
    const int tid_ = opaque_tid(), lane = tid_ & 63, wid = tid_ >> 6;
    constexpr int PB = NR / 128, CG = NC / 8;
#pragma unroll 1
    for (int task = wid; task < PB * CG; task += 8) {
        const int pb = task % PB, cg = task / PB, r = pb * 128 + 2 * lane;
        float a[8], c[8];
        unpack8(*(const u32x4*)(src + (size_t)r * ld_src + cg * 8), a); unpack8(*(const u32x4*)(src + (size_t)(r + 1) * ld_src + cg * 8), c);
        float w0 = 1.f, w1 = 1.f; if (WEIGHT) { w0 = w[r]; w1 = w[r + 1]; }
#pragma unroll
        for (int j = 0; j < 8; ++j) *(LAS unsigned*)(dst + (cg * 8 + j) * ldd_bytes + r * 2) = pk2(a[j] * w0, c[j] * w1);
    }
}
__device__ __forceinline__ void stage_rows(LAS unsigned char* dst, const bf16_t* src, int ld_src) {
    const int tid_ = opaque_tid();
#pragma unroll
    for (int i = 0; i < 8; ++i) { const int id = tid_ + 512 * i, row = id >> 5, ch = id & 31;
        *(LAS u32x4*)(dst + row * 528 + ch * 16) = *(const u32x4*)(src + (size_t)row * ld_src + ch * 8); }
}
__device__ __forceinline__ bf16x8 lds_frag(LAS const unsigned char* base, int row, int ld_bytes, int kbyte) { return *(LAS const bf16x8*)(base + row * ld_bytes + kbyte); }
__device__ __forceinline__ float ret_lg(int h) { return logf(1.0f - exp2f(-5.0f - (float)h)); }

template <int BR>
__device__ __forceinline__ void chunk_passA(const Params& p, int layer, int b, int h, int c, LAS unsigned char* lds) {
    LAS unsigned char* At = lds; LAS unsigned char* Bt = lds + 69632; LAS float* G = (LAS float*)(lds + 139264); LAS float* wk = G + 512;
    const int tid = opaque_tid(), lane = tid & 63, w = __builtin_amdgcn_readfirstlane(tid >> 6), g = lane >> 4, lr = lane & 15;
    const size_t row0 = (size_t)b * SEQ + c * 128;
    const int pi = BR * 16 + b * 4 + h;
    if (BR == 0) { gate_scan(p, layer, b, h, c, G); if (tid < 128) wk[tid] = expf(G[192 + tid] - G[320 + 127]); }
    else { if (tid < 128) wk[tid] = expf((float)(127 - tid) * ret_lg(h)); }
    __syncthreads();
    const bf16_t* srcA = BR == 0 ? p.P + row0 * N1 + C_VM + h * 256 : p.P + row0 * N1 + C_KR + h * 256;
    const bf16_t* srcB = BR == 0 ? p.QK + row0 * 2048 + h * 512 + 256 : p.P + row0 * N1 + C_VR + h * 256;
    stage_T<128, 256, true>(At, 272, srcA, N1, wk);
    stage_T<128, 256, false>(Bt, 272, srcB, BR == 0 ? 2048 : N1, wk);
    __syncthreads();
    float* Uo = p.U + ((size_t)pi * 16 + c) * SZ;
#pragma unroll 1
    for (int rt = 0; rt < 2; ++rt) {
        f32x4 acc[16];
#pragma unroll
        for (int j = 0; j < 16; ++j) acc[j] = (f32x4){0.f, 0.f, 0.f, 0.f};
#pragma unroll
        for (int ks = 0; ks < 4; ++ks) {
            const bf16x8 a0 = lds_frag(At, 32 * w + 16 * rt + lr, 272, (32 * ks + 8 * g) * 2);
#pragma unroll
            for (int ct = 0; ct < 16; ++ct) acc[ct] = __builtin_amdgcn_mfma_f32_16x16x32_bf16(a0, lds_frag(Bt, 16 * ct + lr, 272, (32 * ks + 8 * g) * 2), acc[ct], 0, 0, 0);
            __builtin_amdgcn_sched_barrier(0);
        }
#pragma unroll
        for (int ct = 0; ct < 16; ++ct)
#pragma unroll
            for (int r = 0; r < 4; ++r) Uo[(size_t)(32 * w + 16 * rt + 4 * g + r) * 256 + 16 * ct + lr] = acc[ct][r];
    }
    if (BR == 0 && tid < 256) {
        float s = 0.f;
        for (int ss = 0; ss < 128; ++ss) s += wk[ss] * bf2f(*(LAS const bf16_t*)(Bt + tid * 272 + ss * 2));
        p.NU[((size_t)(b * 4 + h) * 16 + c) * 256 + tid] = s;
    }
    __syncthreads();
}

__device__ __forceinline__ void scan_item(const Params& p, int layer, int pi, int slice, LAS unsigned char* lds) {
    LAS float* G = (LAS float*)lds; LAS float* dec = G + 512;
    const int tid = opaque_tid(), br = pi >> 4, bh = pi & 15, b = bh >> 2, h = bh & 3;
    if (br == 0) { gate_scan(p, layer, b, h, -1, G); if (tid < 16) dec[tid] = expf(G[32 + tid] - fmaxf(G[32 + tid], G[16 + tid])); }
    else if (tid < 16) dec[tid] = expf(128.0f * ret_lg(h));
    __syncthreads();
    f32x4 st[4];
#pragma unroll
    for (int j = 0; j < 4; ++j) st[j] = (f32x4){0.f, 0.f, 0.f, 0.f};
    for (int c = 0; c < 16; ++c) {
        const float dc = dec[c];
#pragma unroll
        for (int j = 0; j < 4; ++j) { const size_t idx = (size_t)slice * 8192 + j * 2048 + tid * 4;
            const f32x4 u = *(const f32x4*)(p.U + ((size_t)pi * 16 + c) * SZ + idx);
            *(u32x2*)(p.CS + ((size_t)pi * 16 + c) * SZ + idx) = (u32x2){pk2(st[j][0], st[j][1]), pk2(st[j][2], st[j][3])};
            st[j] = st[j] * dc + u; }
    }
    float* fo = p.out + (br == 0 ? O_CP : O_SP) + (((size_t)layer * BP + b) * HM + h) * SZ;
#pragma unroll
    for (int j = 0; j < 4; ++j) *(f32x4*)(fo + (size_t)slice * 8192 + j * 2048 + tid * 4) = st[j];
    if (br == 0 && slice == 0) {
        if (tid < 256) { float n = 0.f;
            for (int c = 0; c < 16; ++c) { p.NS[((size_t)bh * 16 + c) * 256 + tid] = n; n = dec[c] * n + p.NU[((size_t)bh * 16 + c) * 256 + tid]; }
            p.out[O_NP + (((size_t)layer * BP + b) * HM + h) * 256 + tid] = n; }
        if (tid == 0) p.out[O_MP + ((size_t)layer * BP + b) * HM + h] = G[48];
    }
    __syncthreads();
}

template <int BR>
__device__ __forceinline__ void chunk_passC(const Params& p, int layer, int b, int h, int c, LAS unsigned char* lds) {
    LAS unsigned char* BufB = lds; LAS unsigned char* Sw = lds + 69632; LAS float* G = (LAS float*)(lds + 104448);
    LAS float* av = G + 512; LAS float* fl = G + 640; LAS bf16_t* nbf = (LAS bf16_t*)(G + 768);
    const int tid = opaque_tid(), lane = tid & 63, w = __builtin_amdgcn_readfirstlane(tid >> 6), g = lane >> 4, lr = lane & 15;
    const size_t row0 = (size_t)b * SEQ + c * 128;
    const int pi = BR * 16 + b * 4 + h;
    const float lg = ret_lg(h);
    if (BR == 0) {
        gate_scan(p, layer, b, h, c, G);
        if (tid < 128) { av[tid] = expf(G[32 + c] - G[320 + tid]); fl[tid] = expf(-(G[64 + tid] + G[320 + tid])); }
        if (tid < 256) nbf[tid] = f2bf(p.NS[((size_t)(b * 4 + h) * 16 + c) * 256 + tid]);
    } else { if (tid < 128) av[tid] = expf((float)(tid + 1) * lg); }
    const bf16_t* Qp = BR == 0 ? p.QK + (row0 + 16 * w + lr) * 2048 + h * 512 : p.P + (row0 + 16 * w + lr) * N1 + C_QR + h * 256;
    bf16x8 qf[8];
#pragma unroll
    for (int ks = 0; ks < 8; ++ks) qf[ks] = *(const bf16x8*)(Qp + 32 * ks + 8 * g);
    stage_rows(BufB, BR == 0 ? p.QK + row0 * 2048 + h * 512 + 256 : p.P + row0 * N1 + C_KR + h * 256, BR == 0 ? 2048 : N1);
    __syncthreads();
    float rs[4] = {0.f, 0.f, 0.f, 0.f};
#pragma unroll
    for (int j = 0; j < 8; ++j) {
        f32x4 a = (f32x4){0.f, 0.f, 0.f, 0.f};
        if (j <= w) {
#pragma unroll
            for (int ks = 0; ks < 8; ++ks) a = __builtin_amdgcn_mfma_f32_16x16x32_bf16(qf[ks], lds_frag(BufB, 16 * j + lr, 528, (32 * ks + 8 * g) * 2), a, 0, 0, 0);
        }
#pragma unroll
        for (int r = 0; r < 4; ++r) {
            const int l = 16 * w + 4 * g + r, s = 16 * j + lr;
            float d = 0.f;
            if (s <= l) d = BR == 0 ? expf(G[192 + s] - G[320 + l]) : expf((float)(l - s) * lg);
            const float v = a[r] * d;
            rs[r] += v;
            *(LAS bf16_t*)(Sw + (l * 136 + s) * 2) = f2bf(v);
        }
        __builtin_amdgcn_sched_barrier(0);
    }
#pragma unroll
    for (int r = 0; r < 4; ++r) { rs[r] += __shfl_xor(rs[r], 1); rs[r] += __shfl_xor(rs[r], 2); rs[r] += __shfl_xor(rs[r], 4); rs[r] += __shfl_xor(rs[r], 8); }
    __syncthreads();
    f32x4 accN[16];
#pragma unroll
    for (int t = 0; t < 16; ++t) accN[t] = (f32x4){0.f, 0.f, 0.f, 0.f};
    const bf16_t* CSp = p.CS + ((size_t)pi * 16 + c) * SZ;
#pragma unroll
    for (int half = 0; half < 2; ++half) {
        if (BR == 0) stage_rows(BufB, CSp + (size_t)half * 128 * 256, 256);
        else stage_T<256, 128, false>(BufB, 528, CSp + half * 128, 256, av);
        __syncthreads();
#pragma unroll
        for (int t = 0; t < 8; ++t) {
#pragma unroll
            for (int ks = 0; ks < 8; ++ks)
                accN[half * 8 + t] = __builtin_amdgcn_mfma_f32_16x16x32_bf16(qf[ks], lds_frag(BufB, 16 * t + lr, 528, (32 * ks + 8 * g) * 2), accN[half * 8 + t], 0, 0, 0);
            __builtin_amdgcn_sched_barrier(0); }
        __syncthreads();
    }
    float nq[4] = {0.f, 0.f, 0.f, 0.f};
    if (BR == 0) {
        f32x4 ad = (f32x4){0.f, 0.f, 0.f, 0.f};
#pragma unroll
        for (int ks = 0; ks < 8; ++ks) {
            bf16x8 nf = *(LAS const bf16x8*)(nbf + 32 * ks + 8 * g);
            if (lr != 0) nf = (bf16x8){0, 0, 0, 0, 0, 0, 0, 0};
            ad = __builtin_amdgcn_mfma_f32_16x16x32_bf16(qf[ks], nf, ad, 0, 0, 0);
        }
#pragma unroll
        for (int r = 0; r < 4; ++r) nq[r] = __shfl(ad[r], lane & 48);
    }
    float ar[4];
#pragma unroll
    for (int r = 0; r < 4; ++r) ar[r] = av[16 * w + 4 * g + r];
#pragma unroll
    for (int t = 0; t < 16; ++t)
#pragma unroll
        for (int r = 0; r < 4; ++r) accN[t][r] *= ar[r];
    stage_T<128, 256, false>(BufB, 272, p.P + row0 * N1 + (BR == 0 ? C_VM : C_VR) + h * 256, N1, av);
    __syncthreads();
#pragma unroll
    for (int ks = 0; ks < 4; ++ks) {
        const bf16x8 af = lds_frag(Sw, 16 * w + lr, 272, (32 * ks + 8 * g) * 2);
#pragma unroll
        for (int t = 0; t < 16; ++t) accN[t] = __builtin_amdgcn_mfma_f32_16x16x32_bf16(af, lds_frag(BufB, 16 * t + lr, 272, (32 * ks + 8 * g) * 2), accN[t], 0, 0, 0);
        __builtin_amdgcn_sched_barrier(0);
    }
    float inv[4];
#pragma unroll
    for (int r = 0; r < 4; ++r) {
        if (BR == 0) { const float den = fmaxf(fabsf(rs[r] + ar[r] * nq[r]), fl[16 * w + 4 * g + r]); inv[r] = 1.0f / den; }
        else inv[r] = 1.0f;
    }
    float mu[4], rstd[4];
#pragma unroll
    for (int r = 0; r < 4; ++r) {
        float s = 0.f;
#pragma unroll
        for (int t = 0; t < 16; ++t) { accN[t][r] *= inv[r]; s += accN[t][r]; }
        s += __shfl_xor(s, 1); s += __shfl_xor(s, 2); s += __shfl_xor(s, 4); s += __shfl_xor(s, 8);
        mu[r] = s * (1.0f / 256.0f);
        float q = 0.f;
#pragma unroll
        for (int t = 0; t < 16; ++t) { const float d = accN[t][r] - mu[r]; q += d * d; }
        q += __shfl_xor(q, 1); q += __shfl_xor(q, 2); q += __shfl_xor(q, 4); q += __shfl_xor(q, 8);
        rstd[r] = rsqrtf(q * (1.0f / 256.0f) + EPS);
    }
    const float* gain = (BR == 0 ? p.hn_m_g : p.hn_r_g) + (size_t)layer * WM + h * 256;
    const float* skip = p.skip_m + (size_t)layer * WM + h * 256;
#pragma unroll
    for (int t = 0; t < 16; ++t) {
        const int e = 16 * t + lr;
        const float ge = gain[e], sk = BR == 0 ? skip[e] : 0.f;
#pragma unroll
        for (int r = 0; r < 4; ++r) {
            const size_t row = row0 + 16 * w + 4 * g + r;
            float v = (accN[t][r] - mu[r]) * rstd[r] * ge;
            const float z = bf2f(p.P[row * N1 + (BR == 0 ? C_ZM : C_ZR) + h * 256 + e]);
            if (BR == 0) v += sk * bf2f(p.CM[row * WM + h * 256 + e]);
            p.OC[row * 2048 + BR * 1024 + h * 256 + e] = f2bf(v * siluf_(z));
        }
        __builtin_amdgcn_sched_barrier(0);
    }
    __syncthreads();
}

template <int BR>
__device__ __forceinline__ void sample_item(const Params& p, int layer, int b, int h, LAS unsigned char* lds) {
    LAS float* sq = (LAS float*)lds; LAS float* sk = sq + 256; LAS float* sv = sk + 256; LAS float* sn = sv + 256; LAS float* sr = sn + 256; LAS float* red = sr + 256;
    LAS float* part = red + 64;
    const int tid = opaque_tid(), lane = tid & 63, wid = tid >> 6;
    const size_t R = (size_t)MP + b;
    const size_t sidx = ((size_t)layer * BS + b) * HM + h;
    if (tid < 256) {
        if (BR == 0) { sq[tid] = bf2f(p.QK[R * 2048 + h * 512 + tid]); sk[tid] = bf2f(p.QK[R * 2048 + h * 512 + 256 + tid]); sv[tid] = bf2f(p.P[R * N1 + C_VM + h * 256 + tid]); sn[tid] = p.st_n[sidx * 256 + tid]; }
        else { sq[tid] = bf2f(p.P[R * N1 + C_QR + h * 256 + tid]); sk[tid] = bf2f(p.P[R * N1 + C_KR + h * 256 + tid]); sv[tid] = bf2f(p.P[R * N1 + C_VR + h * 256 + tid]); sn[tid] = 0.f; }
    }
    __syncthreads();
    float pq = 0.f, pn = 0.f;
    if (tid < 256) { pq = sq[tid] * sk[tid]; pn = sn[tid] * sq[tid]; }
    block_sum2(pq, pn, red);
    const float qk = pq, nq = pn;
    float wgt = 1.f, a = 1.f, mt = 0.f;
    if (BR == 0) {
        const float ig = p.IF[R * 8 + h] + p.b_i[layer * HM + h];
        const float lf = logsigf_(p.IF[R * 8 + 4 + h] + p.b_f[layer * HM + h]);
        const float inter = lf + p.st_m[sidx];
        mt = fmaxf(inter, ig); wgt = expf(ig - mt); a = expf(inter - mt);
    } else { a = 1.0f - exp2f(-5.0f - (float)h); }
    const float* S0 = (BR == 0 ? p.st_C : p.st_S) + sidx * SZ;
    float* S1 = p.out + (BR == 0 ? O_CS : O_SS) + sidx * SZ;
    const f32x4* S0v = (const f32x4*)S0 + lane; f32x4* S1v = (f32x4*)S1 + lane;
    f32x4 cc[8], cn[8];
#pragma unroll
    for (int j = 0; j < 8; ++j) cc[j] = __builtin_nontemporal_load(S0v + 64 * (wid + 8 * j));
    if (BR == 0) {
        const f32x4 q4 = *(LAS const f32x4*)(sq + 4 * lane), k4 = *(LAS const f32x4*)(sk + 4 * lane);
#pragma unroll
        for (int i0 = 0; i0 < 32; i0 += 8) {
            if (i0 + 8 < 32) {
#pragma unroll
                for (int j = 0; j < 8; ++j) cn[j] = __builtin_nontemporal_load(S0v + 64 * (wid + 8 * (i0 + 8 + j)));
            }
#pragma unroll
            for (int j = 0; j < 8; ++j) { const int e = wid + 8 * (i0 + j);
                float pt = (cc[j][0] * q4[0] + cc[j][1] * q4[1]) + (cc[j][2] * q4[2] + cc[j][3] * q4[3]);
                const float wv = wgt * sv[e];
                __builtin_nontemporal_store(cc[j] * a + k4 * wv, S1v + 64 * e);
                pt = wave_sum(pt);
                if (lane == 0) sr[e] = pt; }
#pragma unroll
            for (int j = 0; j < 8; ++j) cc[j] = cn[j];
        }
    } else {
        const f32x4 v4 = *(LAS const f32x4*)(sv + 4 * lane);
        f32x4 ac = (f32x4){0.f, 0.f, 0.f, 0.f};
#pragma unroll
        for (int i0 = 0; i0 < 32; i0 += 8) {
            if (i0 + 8 < 32) {
#pragma unroll
                for (int j = 0; j < 8; ++j) cn[j] = __builtin_nontemporal_load(S0v + 64 * (wid + 8 * (i0 + 8 + j)));
            }
#pragma unroll
            for (int j = 0; j < 8; ++j) { const int d = wid + 8 * (i0 + j);
                ac = ac + cc[j] * sq[d];
                __builtin_nontemporal_store(cc[j] * a + v4 * sk[d], S1v + 64 * d); }
#pragma unroll
            for (int j = 0; j < 8; ++j) cc[j] = cn[j];
        }
        *(LAS f32x4*)(part + wid * 256 + 4 * lane) = ac;
    }
    __syncthreads();
    float hv = 0.f;
    if (tid < 256) {
        if (BR == 0) {
            const float ws = wgt * qk;
            const float den = fmaxf(fabsf(ws + a * nq), expf(-mt));
            hv = (ws * sv[tid] + a * sr[tid]) / den;
            p.out[O_NS + sidx * 256 + tid] = a * sn[tid] + wgt * sk[tid];
            if (tid == 0) p.out[O_MS + sidx] = mt;
        } else {
            float s = 0.f;
#pragma unroll
            for (int i = 0; i < 8; ++i) s += part[i * 256 + tid];
            hv = qk * sv[tid] + a * s;
        }
    }
    float s1 = hv, s2 = 0.f;
    block_sum2(s1, s2, red);
    const float mean = s1 * (1.0f / 256.0f);
    float dv = tid < 256 ? hv - mean : 0.f;
    float q1 = dv * dv, q2 = 0.f;
    block_sum2(q1, q2, red);
    const float rstd = rsqrtf(q1 * (1.0f / 256.0f) + EPS);
    if (tid < 256) {
        const float ge = (BR == 0 ? p.hn_m_g : p.hn_r_g)[(size_t)layer * WM + h * 256 + tid];
        float v = dv * rstd * ge;
        const float z = bf2f(p.P[R * N1 + (BR == 0 ? C_ZM : C_ZR) + h * 256 + tid]);
        if (BR == 0) v += p.skip_m[(size_t)layer * WM + h * 256 + tid] * bf2f(p.CM[R * WM + h * 256 + tid]);
        p.OC[R * 2048 + BR * 1024 + h * 256 + tid] = f2bf(v * siluf_(z));
    }
    __syncthreads();
}

template <int MODE>
__device__ __forceinline__ void sample_gemm(const Params& p, const bf16_t* Wl, int wg, int nwg, LAS unsigned char* lds) {
    const int tid = opaque_tid(), lane = tid & 63, w = tid >> 6, g = lane >> 4, lr = lane & 15, hf = w >> 2;
    LAS f32x4* xch = (LAS f32x4*)lds;
    for (int j = wg; j < 256; j += nwg) {
        const int rbase = MP + 64 * (j & 1) + 16 * (w & 3), cbase = 16 * (j >> 1);
        const bf16_t* A = (MODE == 0 ? p.OC : p.MG) + (size_t)(rbase + lr) * 2048 + hf * 1024 + 8 * g;
        const bf16_t* B = Wl + (MODE == 0 ? W3_OFF : W4_OFF) + (size_t)(cbase + lr) * 2048 + hf * 1024 + 8 * g;
        f32x4 acc = (f32x4){0.f, 0.f, 0.f, 0.f};
#pragma unroll 1
        for (int k0 = 0; k0 < 1024; k0 += 512) {
            bf16x8 af[16], bf[16];
#pragma unroll
            for (int i = 0; i < 16; ++i) { af[i] = *(const bf16x8*)(A + k0 + 32 * i); bf[i] = *(const bf16x8*)(B + k0 + 32 * i); }
#pragma unroll
            for (int i = 0; i < 16; ++i) acc = __builtin_amdgcn_mfma_f32_16x16x32_bf16(af[i], bf[i], acc, 0, 0, 0);
        }
        if (hf == 1) xch[(w & 3) * 64 + lane] = acc;
        __syncthreads();
        if (hf == 0) {
            const f32x4 hi = xch[(w & 3) * 64 + lane];
            const int col = cbase + lr;
#pragma unroll
            for (int r = 0; r < 4; ++r) {
                const size_t row = (size_t)rbase + 4 * g + r;
                if (MODE == 0) {
                    const float gm = sigmoidf_(bf2f(p.P[row * N1 + C_GM + col])), gr = sigmoidf_(bf2f(p.P[row * N1 + C_GR + col]));
                    p.MG[row * 2048 + col] = f2bf(gm * acc[r] + gr * hi[r]);
                } else p.X[row * 2048 + col] += acc[r] + hi[r];
            }
        }
        __syncthreads();
    }
}

__device__ __forceinline__ void phaseA(const Params& p, int layer, int wg, int nwg, LAS unsigned char* lds) {
    for (int it0 = wg; it0 < 1536; it0 += nwg) {
        const int it = (wg & 1) ? (it0 < 1024 ? it0 + 512 : it0 - 1024) : it0;
        if (it < 512) {
            const int br = it >> 8, rest = it & 255, b = rest >> 6, h = (rest >> 4) & 3, c = rest & 15;
            if (br == 0) chunk_passA<0>(p, layer, b, h, c, lds); else chunk_passA<1>(p, layer, b, h, c, lds);
        } else {
            const int s = it - 512, br = s >> 9, b = (s >> 2) & 127, h = s & 3;
            if (br == 0) sample_item<0>(p, layer, b, h, lds); else sample_item<1>(p, layer, b, h, lds);
        }
    }
}
__device__ __forceinline__ void phaseScan(const Params& p, int layer, int wg, int nwg, LAS unsigned char* lds) {
    for (int it = wg; it < 256; it += nwg) scan_item(p, layer, it >> 3, it & 7, lds);
}
__device__ __forceinline__ void phaseC(const Params& p, int layer, int wg, int nwg, LAS unsigned char* lds) {
    for (int it = wg; it < 512; it += nwg) {
        const int br = it >> 8, rest = it & 255, b = rest >> 6, h = (rest >> 4) & 3, c = rest & 15;
        if (br == 0) chunk_passC<0>(p, layer, b, h, c, lds); else chunk_passC<1>(p, layer, b, h, c, lds);
    }
}

template <int ONLY>
__device__ __forceinline__ void run_phases(const Params& p, int ph_lo, int ph_hi) {
    extern __shared__ __attribute__((aligned(16))) unsigned char smem_raw[];
    LAS unsigned char* lds = (LAS unsigned char*)smem_raw;
    volatile LAS unsigned* xbw = (volatile LAS unsigned*)(lds + LDS_BYTES - 16);
    const int wg = blockIdx.x, nwg = gridDim.x;
    const bool multi = (ph_hi - ph_lo) > 1;
    XcdBarrier bar; bar.bar = p.bar; bar.x = 0; bar.st = xbw;
    if (multi) {
        if (threadIdx.x == 0) { xbw[0] = 0u; xbw[1] = 0u; xbw[2] = 0u; xbw[3] = 0u; }
        __syncthreads();
        bar = xcd_barrier_post(p.bar, xbw);
    }
    int ph = 0;
#define PHASE(KIND, ...) { if constexpr (ONLY < 0 || ONLY == KIND) { if (ph >= ph_lo && ph < ph_hi) { __VA_ARGS__; if (ph + 1 < ph_hi) xcd_barrier(bar); } } ++ph; }
    PHASE(0, prep_phase(p, wg, nwg, lds))
    for (int layer = 0; layer < DEPTH; ++layer) {
        const bf16_t* Wl = p.W + (size_t)layer * WL;
        PHASE(1, norm_phase(p, layer, wg, nwg, lds))
        PHASE(2, { pg8::StaticOrder S; S.init(MPAD, N1, nwg, wg); pg8::Gemm g{p.H, Wl + W1_OFF, D, D, D, 31, 0, 0};
                pg8::EpiBf16 E{p.P, N1, p.BIAS1 + (size_t)layer * N1}; pg8::gemm_phase<false>(lds, g, S, E); })
        PHASE(3, conv_phase(p, layer, wg, nwg))
        PHASE(4, { pg8::StaticOrder S; S.init(MPAD, 2048, nwg, wg); pg8::Gemm g{p.CM, Wl + W2_OFF, 256, WM, 256, 1, 512, 0};
                pg8::EpiBf16 E{p.QK, 2048, nullptr}; pg8::gemm_phase<false>(lds, g, S, E); })
        PHASE(5, phaseA(p, layer, wg, nwg, lds))
        PHASE(6, phaseScan(p, layer, wg, nwg, lds))
        PHASE(7, phaseC(p, layer, wg, nwg, lds))
        PHASE(8, { pg8::StaticOrder S; S.init(MP, 2048, nwg, wg); pg8::Gemm g{p.OC, Wl + W3_OFF, 2048, 2048, 2048, 31, 0, 16};
                pg8::EpiMerged E{p.MG, p.P + C_GM, p.P + C_GR, N1}; pg8::gemm_phase<true>(lds, g, S, E); sample_gemm<0>(p, Wl, wg, nwg, lds); })
        PHASE(10, { pg8::StaticOrder S; S.init(MP, 2048, nwg, wg); pg8::Gemm g{p.MG, Wl + W4_OFF, 2048, 2048, 2048, 31, 0, 0};
                pg8::EpiResidual E{p.X}; pg8::gemm_phase<false>(lds, g, S, E); sample_gemm<1>(p, Wl, wg, nwg, lds); })
    }
    PHASE(11, final_phase(p, wg, nwg))
#undef PHASE
}
__global__ void __launch_bounds__(512, 2) mega(Params p, int ph_lo, int ph_hi) { run_phases<-1>(p, ph_lo, ph_hi); }
#ifdef DIAG
template <int K> __global__ void __launch_bounds__(512, 2) mega_k(Params p, int ph_lo, int ph_hi) { run_phases<K>(p, ph_lo, ph_hi); }
template __global__ void mega_k<0>(Params, int, int); template __global__ void mega_k<1>(Params, int, int); template __global__ void mega_k<2>(Params, int, int);
template __global__ void mega_k<3>(Params, int, int); template __global__ void mega_k<4>(Params, int, int); template __global__ void mega_k<5>(Params, int, int);
template __global__ void mega_k<6>(Params, int, int); template __global__ void mega_k<7>(Params, int, int); template __global__ void mega_k<8>(Params, int, int);
template __global__ void mega_k<10>(Params, int, int); template __global__ void mega_k<11>(Params, int, int);
#endif
constexpr int N_PHASES = 2 + DEPTH * 9;

extern "C" void kernel_launch(void* const* d_in, const int* in_sizes, int n_in, void* d_out, int out_size, void* d_ws, size_t ws_size, hipStream_t stream) {
    (void)in_sizes; (void)n_in; (void)out_size; (void)ws_size;
    static int grid = 0;
    if (grid == 0) {
        int dev = 0, cus = 0;
        hipGetDevice(&dev);
        hipDeviceGetAttribute(&cus, hipDeviceAttributeMultiprocessorCount, dev);
        if (hipFuncSetAttribute((const void*)mega, hipFuncAttributeMaxDynamicSharedMemorySize, LDS_BYTES) != hipSuccess) fprintf(stderr, "hipFuncSetAttribute failed\n");
        (void)hipGetLastError();
        grid = cus > 0 ? cus : 256;
    }
    Params p{};
    const float** in = (const float**)&p;
    for (int i = 0; i < 24; ++i) in[i] = (const float*)d_in[i];
    p.out = (float*)d_out;
    unsigned char* ws = (unsigned char*)d_ws;
    size_t off = 0;
    auto take = [&](size_t bytes) { unsigned char* r = ws + off; off += (bytes + 255) & ~(size_t)255; return r; };
    p.bar = (unsigned*)take(16384);
    p.X = (float*)take((size_t)MPAD * D * 4);
    p.H = (bf16_t*)take((size_t)MPAD * D * 2);
    p.P = (bf16_t*)take((size_t)MPAD * N1 * 2);
    p.IF = (float*)take((size_t)MPAD * 8 * 4);
    p.CM = (bf16_t*)take((size_t)MPAD * WM * 2);
    p.QK = (bf16_t*)take((size_t)MPAD * 2048 * 2);
    p.OC = (bf16_t*)take((size_t)MPAD * 2048 * 2);
    p.T3 = (float*)take((size_t)MPAD * 2048 * 4);
    p.MG = (bf16_t*)take((size_t)MPAD * 2048 * 2);
    p.U = (float*)take((size_t)32 * 16 * SZ * 4);
    p.CS = (bf16_t*)take((size_t)32 * 16 * SZ * 2);
    p.NU = (float*)take((size_t)16 * 16 * 256 * 4);
    p.NS = (float*)take((size_t)16 * 16 * 256 * 4);
    p.W = (bf16_t*)take((size_t)DEPTH * WL * 2);
    p.WIF = (float*)take((size_t)DEPTH * 8 * D * 4);
    p.BIAS1 = (float*)take((size_t)DEPTH * N1 * 4);
    p.ROPE = (float*)take((size_t)2049 * 128 * 2 * 4);
    hipMemsetAsync(p.bar, 0, 16384, stream);
#if MK_SINGLE
    hipLaunchKernelGGL(mega, dim3(grid), dim3(512), LDS_BYTES, stream, p, 0, N_PHASES);
#else
    for (int ph = 0; ph < N_PHASES; ++ph) hipLaunchKernelGGL(mega, dim3(grid), dim3(512), LDS_BYTES, stream, p, ph, ph + 1);
#endif
}
```

```cpp
#include <hip/hip_runtime.h>
#include <stdint.h>
#include <stdio.h>

#ifndef MK_SINGLE
#define MK_SINGLE 1
#endif

#define LAS __attribute__((address_space(3)))
typedef unsigned short bf16_t;
typedef short bf16x8 __attribute__((ext_vector_type(8)));
typedef float f32x4 __attribute__((ext_vector_type(4)));
typedef unsigned u32x4 __attribute__((ext_vector_type(4)));
typedef unsigned u32x2 __attribute__((ext_vector_type(2)));

constexpr int D = 2048, SEQ = 2048, BP = 4, BS = 128, DEPTH = 4, HM = 4, DH = 256, WM = 1024, NIN = 7176;
constexpr int MP = BP * SEQ, MT = MP + BS, MPAD = 8448;
constexpr int NP = 7168;
constexpr int N1 = 11264;
constexpr int C_U = 0, C_VM = 1024, C_ZM = 2048, C_QR = 3072, C_KR = 4096, C_VR = 5120, C_ZR = 6144, C_GM = 7168, C_GR = 9216;
constexpr float EPS = 1e-6f;
constexpr size_t SZ = 65536;
constexpr size_t O_YP = 0, O_YS = O_YP + 16777216, O_CP = O_YS + 262144, O_NP = O_CP + 4194304, O_MP = O_NP + 16384, O_CVP = O_MP + 64,
                 O_SP = O_CVP + 49152, O_CS = O_SP + 4194304, O_NS = O_CS + 134217728, O_MS = O_NS + 524288, O_CVS = O_MS + 2048, O_SS = O_CVS + 1572864;
constexpr size_t W1_OFF = 0, W2_OFF = W1_OFF + (size_t)N1 * D, W3_OFF = W2_OFF + (size_t)2048 * 256, W4_OFF = W3_OFF + (size_t)D * D, WL = W4_OFF + (size_t)D * D;
constexpr int LDS_BYTES = 147456;

struct Params {
    const float *x_prompt, *x_sample, *st_C, *st_n, *st_m, *st_conv, *st_S, *norm_g, *w_in, *conv_w, *conv_b, *w_qm, *w_km, *b_i, *b_f,
                *hn_m_g, *skip_m, *hn_r_g, *w_pm, *w_pr, *w_gate, *b_gate, *w_o, *final_g;
    float* out;
    unsigned* bar;
    float* X; bf16_t* H; bf16_t* P; float* IF; bf16_t* CM; bf16_t* QK; bf16_t* OC; float* T3; bf16_t* MG;
    float* U; bf16_t* CS; float* NU; float* NS; bf16_t* W; float* WIF; float* BIAS1; float* ROPE; bf16_t* RT; bf16_t* GRS;
};

__device__ __forceinline__ int opaque_tid() { int t = threadIdx.x; asm volatile("" : "+v"(t)); return t; }
__device__ __forceinline__ float bf2f(bf16_t v) { return __uint_as_float((unsigned)v << 16); }
__device__ __forceinline__ bf16_t f2bf(float f) { unsigned u = __float_as_uint(f); u += 0x7fffu + ((u >> 16) & 1u); return (bf16_t)(u >> 16); }
__device__ __forceinline__ unsigned pk2(float lo, float hi) { return (unsigned)f2bf(lo) | ((unsigned)f2bf(hi) << 16); }
__device__ __forceinline__ float wave_sum(float v) {
#pragma unroll
    for (int o = 32; o >= 1; o >>= 1) v += __shfl_xor(v, o);
    return v;
}
__device__ __forceinline__ float wave_max(float v) {
#pragma unroll
    for (int o = 32; o >= 1; o >>= 1) v = fmaxf(v, __shfl_xor(v, o));
    return v;
}
__device__ __forceinline__ float sigmoidf_(float x) { return __builtin_amdgcn_rcpf(1.0f + __expf(-x)); }
__device__ __forceinline__ float siluf_(float x) { return x * __builtin_amdgcn_rcpf(1.0f + __expf(-x)); }
__device__ __forceinline__ float logsigf_(float x) { return x < 0.f ? x - log1pf(expf(x)) : -log1pf(expf(-x)); }
__device__ __forceinline__ void block_sum2(float& a, float& b, LAS float* red) {
    a = wave_sum(a); b = wave_sum(b);
    __syncthreads();
    if ((threadIdx.x & 63) == 0) { red[threadIdx.x >> 6] = a; red[8 + (threadIdx.x >> 6)] = b; }
    __syncthreads();
    float sa = 0.f, sb = 0.f;
#pragma unroll
    for (int i = 0; i < 8; ++i) { sa += red[i]; sb += red[8 + i]; }
    a = sa; b = sb;
}

#define XB_TMO      128
#define XB_XCNT(j)  (256  + 64 * (j))
#define XB_XSUB(j)  (1280 + 64 * (j))
#define XB_XGEN(j)  (2304 + 64 * (j))
#define XB_TOP      3328
#define XB_TOPGEN   3392
#define XCD_BAR_WORDS 3456
#define XB_SPIN_CAP (1u << 22)

__device__ __forceinline__ unsigned xb_ld(unsigned* p)              { return __hip_atomic_load(p, __ATOMIC_RELAXED, __HIP_MEMORY_SCOPE_AGENT); }
__device__ __forceinline__ unsigned xb_add(unsigned* p, unsigned v) { return __hip_atomic_fetch_add(p, v, __ATOMIC_RELAXED, __HIP_MEMORY_SCOPE_AGENT); }
__device__ __forceinline__ unsigned xb_xcc_id() { return (unsigned)__builtin_amdgcn_s_getreg((3 << 11) | 20) & 0xFu; }
#define XB_SPIN(cond, bar) do { unsigned _sp = 0; while (cond) { __builtin_amdgcn_s_sleep(1); \
    if ((++_sp & 255u) == 0u) { if (xb_ld(&(bar)[XB_TMO])) break; if (_sp > XB_SPIN_CAP) { atomicAdd(&(bar)[XB_TMO], 1u); break; } } } } while (0)

struct XcdBarrier { unsigned* bar; unsigned x; volatile LAS unsigned* st; };

__device__ __forceinline__ XcdBarrier xcd_barrier_post(unsigned* bar, volatile LAS unsigned* st) {
    XcdBarrier b; b.bar = bar; b.x = xb_xcc_id(); b.st = st;
    if (threadIdx.x == 0) (void)xb_add(&bar[XB_XCNT(b.x)], 1u);
    return b;
}
__device__ __forceinline__ void xcd_barrier_complete(unsigned* bar, unsigned x, unsigned& nloc, unsigned& nx) {
    const unsigned G = gridDim.x * gridDim.y * gridDim.z;
    unsigned sum, cnt, mine, sp = 0u;
    for (;;) {
        sum = 0u; cnt = 0u; mine = 0u;
#pragma unroll
        for (unsigned j = 0; j < 16; ++j) { const unsigned c = xb_ld(&bar[XB_XCNT(j)]); sum += c; cnt += (c > 0u) ? 1u : 0u; mine = (j == x) ? c : mine; }
        if (sum == G) break;
        __builtin_amdgcn_s_sleep(1);
        if ((++sp & 255u) == 0u) { if (xb_ld(&bar[XB_TMO])) break; if (sp > XB_SPIN_CAP) { atomicAdd(&bar[XB_TMO], 1u); break; } }
    }
    nloc = mine > 0u ? mine : 1u; nx = cnt > 0u ? cnt : 1u;
}
__device__ __forceinline__ void xcd_barrier(const XcdBarrier& b) {
    asm volatile("s_waitcnt vmcnt(0)" ::: "memory");
    __syncthreads();
    if (threadIdx.x == 0) {
        unsigned* bar = b.bar;
        __builtin_amdgcn_s_waitcnt(0);
        unsigned nloc = b.st[0], nx = b.st[1];
        if (nloc == 0u) { xcd_barrier_complete(bar, b.x, nloc, nx); b.st[0] = nloc; b.st[1] = nx; }
        const unsigned old = xb_add(&bar[XB_XSUB(b.x)], 1u);
        const unsigned gen = old / nloc;
        if (old + 1u == (gen + 1u) * nloc) {
            __builtin_amdgcn_fence(__ATOMIC_RELEASE, "agent");
            asm volatile("s_waitcnt vmcnt(0)" ::: "memory");
            const unsigned og = xb_add(&bar[XB_TOP], 1u);
            const unsigned tg = og / nx;
            if (og + 1u == (tg + 1u) * nx) xb_add(&bar[XB_TOPGEN], 1u);
            else XB_SPIN(xb_ld(&bar[XB_TOPGEN]) == tg, bar);
            __builtin_amdgcn_fence(__ATOMIC_ACQUIRE, "agent");
            xb_add(&bar[XB_XGEN(b.x)], 1u);
            asm volatile("s_waitcnt vmcnt(0)" ::: "memory");
        } else {
            XB_SPIN(xb_ld(&bar[XB_XGEN(b.x)]) == gen, bar);
            __builtin_amdgcn_fence(__ATOMIC_ACQUIRE, "agent");
            asm volatile("s_waitcnt vmcnt(0)" ::: "memory");
        }
    }
    __syncthreads();
}

namespace pg8 {
constexpr int BM = 256, BK = 64, HALF = 128, HTB = HALF * BK * 2, STAGE_BYTES = 8 * HTB, NXCD = 8, WGM = 8;
__host__ __device__ __forceinline__ int lds_byte(int r, int c) { const int st = (r >> 4) * 2 + (c >> 5), rr = r & 15, cc = c & 31, ob = rr * 64 + cc * 2; return st * 1024 + (ob ^ (((ob >> 9) & 1) << 5)); }
__host__ __device__ __forceinline__ void stage_rc(int b, int& R, int& C) { const int st = b / 1024, sb = b % 1024, swz = sb ^ (((sb >> 9) & 1) << 5); R = (st >> 1) * 16 + swz / 64; C = (st & 1) * 32 + (swz % 64) / 2; }
__host__ __device__ __forceinline__ int perm32(int rho) { const int n = rho >> 4, i = rho & 15; return 8 * (i >> 2) + 4 * n + (i & 3); }

struct Unit { int pm, pn; };
struct Gemm { const bf16_t* A; const bf16_t* Bt; int K, lda, ldb, a_pn_shift, a_pn_stride, mid_t; };

struct StaticOrder {
    int nM, nN, nwg, G, c;
    __device__ void init(int M, int N, int G_, int c_) { nM = M / BM; nN = N / BM; nwg = nM * nN; G = G_; c = c_; }
    __device__ bool next(int i, Unit& u) const {
        const long L = (long)i * G + c; if (L >= nwg) return false;
        int wgid = (int)L; { const int q = nwg / NXCD, r = nwg % NXCD, xcd = wgid % NXCD, off = wgid / NXCD; wgid = (xcd < r ? xcd * (q + 1) : r * (q + 1) + (xcd - r) * q) + off; }
        const int nig = WGM * nN, gid = wgid / nig, fm = gid * WGM, gsz = (nM - fm) < WGM ? (nM - fm) : WGM;
        u.pm = fm + ((wgid % nig) % gsz); u.pn = (wgid % nig) / gsz; return true;
    }
};
__device__ __forceinline__ unsigned cvt_pk_bf16(float lo, float hi) { unsigned r; asm volatile("v_cvt_pk_bf16_f32 %0, %1, %2" : "=v"(r) : "v"(lo), "v"(hi)); return r; }

struct EpiBf16 {
    static constexpr bool PERM = true;
    bf16_t* O; int ldc;
    __device__ __forceinline__ void operator()(const f32x4 (&acc)[2][2][4][2], const Unit& u, int wr, int wc, int fr, int fq) const {
        const int row0 = u.pm * BM + wr * 64 + fr, col0 = u.pn * BM + wc * 32 + 8 * fq;
#pragma unroll
        for (int ai = 0; ai < 2; ++ai)
#pragma unroll
            for (int m = 0; m < 4; ++m) { bf16_t* rowp = O + (size_t)(row0 + ai * HALF + m * 16) * ldc + col0;
#pragma unroll
                for (int bj = 0; bj < 2; ++bj) { const f32x4 v0 = acc[ai][bj][m][0], v1 = acc[ai][bj][m][1];
                    u32x4 w; w.x = cvt_pk_bf16(v0[0], v0[1]); w.y = cvt_pk_bf16(v0[2], v0[3]); w.z = cvt_pk_bf16(v1[0], v1[1]); w.w = cvt_pk_bf16(v1[2], v1[3]);
                    *(u32x4*)(rowp + bj * HALF) = w; } }
    }
};
struct EpiG1 {
    static constexpr bool PERM = true;
    bf16_t* P; const float* bg; bf16_t* RT; bf16_t* GRS; const float* rope;
    __device__ __forceinline__ void operator()(const f32x4 (&acc)[2][2][4][2], const Unit& u, int wr, int wc, int fr, int fq) const {
        const int row0 = u.pm * BM + wr * 64 + fr, cw = wc * 32 + 8 * fq;
        if (u.pn >= 28) {
            const int ch = 128 * (u.pn - 28) + cw;
            const f32x4 bm0 = *(const f32x4*)(bg + ch), bm1 = *(const f32x4*)(bg + ch + 4), br0 = *(const f32x4*)(bg + 2048 + ch), br1 = *(const f32x4*)(bg + 2048 + ch + 4);
#pragma unroll
            for (int ai = 0; ai < 2; ++ai)
#pragma unroll
                for (int m = 0; m < 4; ++m) { const size_t row = (size_t)(row0 + ai * HALF + m * 16);
                    const f32x4 vm0 = acc[ai][0][m][0] + bm0, vm1 = acc[ai][0][m][1] + bm1, vr0 = acc[ai][1][m][0] + br0, vr1 = acc[ai][1][m][1] + br1;
                    float rt[8], gr[8];
#pragma unroll
                    for (int j = 0; j < 4; ++j) {
                        const float er0 = 1.0f + __expf(-vr0[j]), er1 = 1.0f + __expf(-vr1[j]);
                        rt[j] = er0 * __builtin_amdgcn_rcpf(1.0f + __expf(-vm0[j])); rt[4 + j] = er1 * __builtin_amdgcn_rcpf(1.0f + __expf(-vm1[j]));
                        gr[j] = __builtin_amdgcn_rcpf(er0); gr[4 + j] = __builtin_amdgcn_rcpf(er1); }
                    u32x4 w; w.x = cvt_pk_bf16(rt[0], rt[1]); w.y = cvt_pk_bf16(rt[2], rt[3]); w.z = cvt_pk_bf16(rt[4], rt[5]); w.w = cvt_pk_bf16(rt[6], rt[7]);
                    *(u32x4*)(RT + row * 2048 + ch) = w;
                    w.x = cvt_pk_bf16(gr[0], gr[1]); w.y = cvt_pk_bf16(gr[2], gr[3]); w.z = cvt_pk_bf16(gr[4], gr[5]); w.w = cvt_pk_bf16(gr[6], gr[7]);
                    *(u32x4*)(GRS + row * 2048 + ch) = w; }
        } else if (u.pn >= 12 && u.pn < 20) {
            const float sc = u.pn >= 16 ? 0.0625f : 1.0f;
#pragma unroll
            for (int ai = 0; ai < 2; ++ai)
#pragma unroll
                for (int m = 0; m < 4; ++m) { const int row = row0 + ai * HALF + m * 16;
                    const int pi = row < MP ? (row & (SEQ - 1)) : 2048;
                    const f32x4* cs = (const f32x4*)(rope + ((size_t)pi * 128 + cw) * 2);
                    const f32x4 t0 = cs[0], t1 = cs[1], t2 = cs[2], t3 = cs[3];
                    const f32x4 a0 = acc[ai][0][m][0], a1 = acc[ai][0][m][1], b0 = acc[ai][1][m][0], b1 = acc[ai][1][m][1];
                    const float c[8] = {t0[0], t0[2], t1[0], t1[2], t2[0], t2[2], t3[0], t3[2]}, sn[8] = {t0[1], t0[3], t1[1], t1[3], t2[1], t2[3], t3[1], t3[3]};
                    const float x1[8] = {a0[0], a0[1], a0[2], a0[3], a1[0], a1[1], a1[2], a1[3]}, x2[8] = {b0[0], b0[1], b0[2], b0[3], b1[0], b1[1], b1[2], b1[3]};
                    float o1[8], o2[8];
#pragma unroll
                    for (int j = 0; j < 8; ++j) { o1[j] = (x1[j] * c[j] - x2[j] * sn[j]) * sc; o2[j] = (x1[j] * sn[j] + x2[j] * c[j]) * sc; }
                    bf16_t* rowp = P + (size_t)row * NP + u.pn * BM + cw;
                    u32x4 w; w.x = cvt_pk_bf16(o1[0], o1[1]); w.y = cvt_pk_bf16(o1[2], o1[3]); w.z = cvt_pk_bf16(o1[4], o1[5]); w.w = cvt_pk_bf16(o1[6], o1[7]);
                    *(u32x4*)rowp = w;
                    w.x = cvt_pk_bf16(o2[0], o2[1]); w.y = cvt_pk_bf16(o2[2], o2[3]); w.z = cvt_pk_bf16(o2[4], o2[5]); w.w = cvt_pk_bf16(o2[6], o2[7]);
                    *(u32x4*)(rowp + HALF) = w; }
        } else {
#pragma unroll
            for (int ai = 0; ai < 2; ++ai)
#pragma unroll
                for (int m = 0; m < 4; ++m) { bf16_t* rowp = P + (size_t)(row0 + ai * HALF + m * 16) * NP + u.pn * BM + cw;
#pragma unroll
                    for (int bj = 0; bj < 2; ++bj) { const f32x4 v0 = acc[ai][bj][m][0], v1 = acc[ai][bj][m][1];
                        u32x4 w; w.x = cvt_pk_bf16(v0[0], v0[1]); w.y = cvt_pk_bf16(v0[2], v0[3]); w.z = cvt_pk_bf16(v1[0], v1[1]); w.w = cvt_pk_bf16(v1[2], v1[3]);
                        *(u32x4*)(rowp + bj * HALF) = w; } }
        }
    }
};
struct EpiMerged {
    static constexpr bool PERM = true;
    bf16_t* O; const bf16_t* RT; const bf16_t* GRS;
    __device__ __forceinline__ void scale(f32x4 (&acc)[2][2][4][2], const bf16_t* S, const Unit& u, int wr, int wc, int fr, int fq) const {
        asm volatile("" : "+v"(fr), "+v"(fq));
        const int row0 = u.pm * BM + wr * 64 + fr, col0 = u.pn * BM + wc * 32 + 8 * fq;
#pragma unroll
        for (int ai = 0; ai < 2; ++ai) {
            u32x4 sv[4][2];
#pragma unroll
            for (int m = 0; m < 4; ++m)
#pragma unroll
                for (int bj = 0; bj < 2; ++bj) sv[m][bj] = *(const u32x4*)(S + (size_t)(row0 + ai * HALF + m * 16) * 2048 + col0 + bj * HALF);
#pragma unroll
            for (int m = 0; m < 4; ++m)
#pragma unroll
                for (int bj = 0; bj < 2; ++bj) { const u32x4 a = sv[m][bj];
                    acc[ai][bj][m][0][0] *= __uint_as_float(a.x << 16); acc[ai][bj][m][0][1] *= __uint_as_float(a.x & 0xffff0000u);
                    acc[ai][bj][m][0][2] *= __uint_as_float(a.y << 16); acc[ai][bj][m][0][3] *= __uint_as_float(a.y & 0xffff0000u);
                    acc[ai][bj][m][1][0] *= __uint_as_float(a.z << 16); acc[ai][bj][m][1][1] *= __uint_as_float(a.z & 0xffff0000u);
                    acc[ai][bj][m][1][2] *= __uint_as_float(a.w << 16); acc[ai][bj][m][1][3] *= __uint_as_float(a.w & 0xffff0000u); }
        }
    }
    __device__ __forceinline__ void mid(f32x4 (&acc)[2][2][4][2], const Unit& u, int wr, int wc, int fr, int fq) const { scale(acc, RT, u, wr, wc, fr, fq); }
    __device__ __forceinline__ void operator()(f32x4 (&acc)[2][2][4][2], const Unit& u, int wr, int wc, int fr, int fq) const {
        scale(acc, GRS, u, wr, wc, fr, fq);
        const int row0 = u.pm * BM + wr * 64 + fr, col0 = u.pn * BM + wc * 32 + 8 * fq;
#pragma unroll
        for (int ai = 0; ai < 2; ++ai)
#pragma unroll
            for (int m = 0; m < 4; ++m) { bf16_t* rowp = O + (size_t)(row0 + ai * HALF + m * 16) * 2048 + col0;
#pragma unroll
                for (int bj = 0; bj < 2; ++bj) { const f32x4 v0 = acc[ai][bj][m][0], v1 = acc[ai][bj][m][1];
                    u32x4 w; w.x = cvt_pk_bf16(v0[0], v0[1]); w.y = cvt_pk_bf16(v0[2], v0[3]); w.z = cvt_pk_bf16(v1[0], v1[1]); w.w = cvt_pk_bf16(v1[2], v1[3]);
                    *(u32x4*)(rowp + bj * HALF) = w; } }
    }
};
struct EpiResidual {
    static constexpr bool PERM = false;
    float* X;
    __device__ __forceinline__ void operator()(f32x4 (&acc)[2][2][4][2], const Unit& u, int wr, int wc, int fr, int fq) const {
        const int row0 = u.pm * BM + wr * 64 + fr, col0 = u.pn * BM + wc * 32 + 4 * fq;
#pragma unroll
        for (int ai = 0; ai < 2; ++ai) {
            f32x4 xv[4][2][2];
#pragma unroll
            for (int m = 0; m < 4; ++m)
#pragma unroll
                for (int bj = 0; bj < 2; ++bj)
#pragma unroll
                    for (int n = 0; n < 2; ++n) xv[m][bj][n] = *(const f32x4*)(X + (size_t)(row0 + ai * HALF + m * 16) * 2048 + col0 + bj * HALF + n * 16);
#pragma unroll
            for (int m = 0; m < 4; ++m)
#pragma unroll
                for (int bj = 0; bj < 2; ++bj)
#pragma unroll
                    for (int n = 0; n < 2; ++n) *(f32x4*)(X + (size_t)(row0 + ai * HALF + m * 16) * 2048 + col0 + bj * HALF + n * 16) = xv[m][bj][n] + acc[ai][bj][m][n];
        }
    }
};

template <bool MID, class Epi, class Sched, bool ALIGN_EPI = true>
__device__ __forceinline__ void gemm_phase(LAS unsigned char* lds, const Gemm g, const Sched& S, const Epi& E) {
    const int tid = opaque_tid(), wid = __builtin_amdgcn_readfirstlane(tid >> 6), lane = tid & 63, wr = wid >> 2, wc = wid & 3, fr = lane & 15, fq = lane >> 4;
    const int K = g.K, nt = K / BK;
    unsigned voffA[2], voffB[2];
#pragma unroll
    for (int i = 0; i < 2; ++i) { int R, C; stage_rc(tid * 16 + i * 8192, R, C); const int Rb = Epi::PERM ? ((R & ~31) + perm32(R & 31)) : R;
        voffA[i] = (unsigned)(R * g.lda + C) * 2u; voffB[i] = (unsigned)(Rb * g.ldb + C) * 2u; }
    const size_t kstep = (size_t)(BK * 2);
    const size_t hstepA = (size_t)HALF * g.lda * 2, hstepB = (size_t)HALF * g.ldb * 2;
    const size_t tstepA = 2 * hstepA, tstepB = 2 * hstepB;
    const unsigned ldsw = (unsigned)wid * 1024u;
    const int aoff = lds_byte(wr * 64 + fr, fq * 8), boff = lds_byte(wc * 32 + fr, fq * 8);
#define PG8_SA(b, h) (((b) * 2 + (h)) * HTB)
#define PG8_SB(b, h) ((4 + (b) * 2 + (h)) * HTB)
#define PG8_STAGE(bufoff, gbase, voff) do { _Pragma("unroll") for (int _i = 0; _i < 2; ++_i) \
        __builtin_amdgcn_global_load_lds((const unsigned*)((const char*)(gbase) + (voff)[_i]), (LAS unsigned*)(lds + (bufoff) + ldsw + _i * 8192), 16, 0, 0); } while (0)
#define PG8_LDA(dst, b, h) do { _Pragma("unroll") for (int m = 0; m < 4; ++m) _Pragma("unroll") for (int k = 0; k < 2; ++k) dst[m][k] = *(const LAS bf16x8*)(lds + PG8_SA(b, h) + aoff + m * 2048 + k * 1024); } while (0)
#define PG8_LDB(dst, b, h) do { _Pragma("unroll") for (int n = 0; n < 2; ++n) _Pragma("unroll") for (int k = 0; k < 2; ++k) dst[n][k] = *(const LAS bf16x8*)(lds + PG8_SB(b, h) + boff + n * 2048 + k * 1024); } while (0)
#define PG8_MMA(ai, bj, At, Bt) do { __builtin_amdgcn_s_setprio(1); _Pragma("unroll") for (int m = 0; m < 4; ++m) _Pragma("unroll") for (int n = 0; n < 2; ++n) _Pragma("unroll") for (int k = 0; k < 2; ++k) \
        acc[ai][bj][m][n] = __builtin_amdgcn_mfma_f32_16x16x32_bf16(Bt[n][k], At[m][k], acc[ai][bj][m][n], 0, 0, 0); __builtin_amdgcn_s_setprio(0); } while (0)
#define PG8_WAIT_V(n) asm volatile("s_waitcnt vmcnt(" #n ")" ::: "memory")
#define PG8_WAIT_L(n) asm volatile("s_waitcnt lgkmcnt(" #n ")" ::: "memory")
#define PG8_BAR __builtin_amdgcn_s_barrier()
#define PG8_SCHED __builtin_amdgcn_sched_barrier(0)
#define PG8_APTR(u) ((const char*)g.A + (size_t)(u).pm * tstepA + (size_t)((u).pn >> g.a_pn_shift) * (size_t)g.a_pn_stride)
    Unit cur, nxt; int ui = 0;
    if (!S.next(0, cur)) return;
    f32x4 acc[2][2][4][2];
#pragma unroll
    for (int a = 0; a < 2; ++a)
#pragma unroll
        for (int b = 0; b < 2; ++b)
#pragma unroll
            for (int m = 0; m < 4; ++m)
#pragma unroll
                for (int n = 0; n < 2; ++n) acc[a][b][m][n] = (f32x4){0.f, 0.f, 0.f, 0.f};
    bf16x8 At[4][2], B0[2][2], B1[2][2];
    const char* cA = PG8_APTR(cur); const char* cB = (const char*)g.Bt + (size_t)cur.pn * tstepB;
    PG8_STAGE(PG8_SB(0, 0), cB, voffB); PG8_STAGE(PG8_SB(0, 1), cB + hstepB, voffB); PG8_STAGE(PG8_SA(0, 0), cA, voffA); PG8_STAGE(PG8_SA(0, 1), cA + hstepA, voffA);
    if (wr == 1) PG8_BAR;
    PG8_WAIT_V(2); PG8_BAR;
    PG8_STAGE(PG8_SB(1, 0), cB + kstep, voffB); PG8_STAGE(PG8_SA(1, 0), cA + kstep, voffA); PG8_STAGE(PG8_SB(1, 1), cB + hstepB + kstep, voffB);
    PG8_WAIT_V(6); PG8_BAR;
    for (;;) {
        const bool has_next = S.next(ui + 1, nxt);
        const char* nA = has_next ? PG8_APTR(nxt) : cA; const char* nB = has_next ? (const char*)g.Bt + (size_t)nxt.pn * tstepB : cB;
#pragma unroll 1
        for (int t = 0; t < nt; t += 2) {
            const bool last = (t == nt - 2);
            const char* a1 = cA + (size_t)(t + 1) * kstep;
            const char* a2 = last ? nA : cA + (size_t)(t + 2) * kstep; const char* b2 = last ? nB : cB + (size_t)(t + 2) * kstep;
            const char* a3 = a2 + kstep; const char* b3 = b2 + kstep;
            if constexpr (MID) { if (t == g.mid_t) E.mid(acc, cur, wr, wc, fr, fq); }
            PG8_LDB(B0, 0, 0); PG8_LDB(B1, 0, 1); PG8_SCHED; PG8_LDA(At, 0, 0); PG8_STAGE(PG8_SA(1, 1), a1 + hstepA, voffA);
            PG8_WAIT_V(8); PG8_WAIT_L(0); PG8_BAR; PG8_MMA(0, 0, At, B0); PG8_MMA(0, 1, At, B1); PG8_BAR; PG8_SCHED;
            PG8_LDA(At, 0, 1); PG8_STAGE(PG8_SB(0, 0), b2, voffB); PG8_STAGE(PG8_SB(0, 1), b2 + hstepB, voffB); PG8_STAGE(PG8_SA(0, 0), a2, voffA);
            PG8_WAIT_V(8); PG8_WAIT_L(0); PG8_BAR; PG8_MMA(1, 0, At, B0); PG8_MMA(1, 1, At, B1); PG8_BAR; PG8_SCHED;
            PG8_LDB(B0, 1, 0); PG8_LDB(B1, 1, 1); PG8_SCHED; PG8_LDA(At, 1, 0); PG8_STAGE(PG8_SA(0, 1), a2 + hstepA, voffA);
            PG8_WAIT_V(8); PG8_WAIT_L(0); PG8_BAR; PG8_MMA(0, 0, At, B0); PG8_MMA(0, 1, At, B1); PG8_BAR; PG8_SCHED;
            PG8_LDA(At, 1, 1); PG8_STAGE(PG8_SB(1, 0), b3, voffB); PG8_STAGE(PG8_SB(1, 1), b3 + hstepB, voffB); PG8_STAGE(PG8_SA(1, 0), a3, voffA);
            PG8_WAIT_V(8); PG8_WAIT_L(0); PG8_BAR; PG8_MMA(1, 0, At, B0); PG8_MMA(1, 1, At, B1); PG8_BAR; PG8_SCHED;
        }
        if constexpr (ALIGN_EPI) { if (wr == 0) PG8_BAR; }
        E(acc, cur, wr, wc, fr, fq);
        if (!has_next) break;
#pragma unroll
        for (int a = 0; a < 2; ++a)
#pragma unroll
            for (int b = 0; b < 2; ++b)
#pragma unroll
                for (int m = 0; m < 4; ++m)
#pragma unroll
                    for (int n = 0; n < 2; ++n) acc[a][b][m][n] = (f32x4){0.f, 0.f, 0.f, 0.f};
        cur = nxt; cA = nA; cB = nB; ++ui;
        if constexpr (ALIGN_EPI) { if (wr == 1) PG8_BAR; }
    }
    PG8_WAIT_V(0);
    if constexpr (!ALIGN_EPI) { if (wr == 0) PG8_BAR; }
    PG8_BAR;
#undef PG8_SA
#undef PG8_SB
#undef PG8_STAGE
#undef PG8_LDA
#undef PG8_LDB
#undef PG8_MMA
#undef PG8_WAIT_V
#undef PG8_WAIT_L
#undef PG8_BAR
#undef PG8_SCHED
#undef PG8_APTR
}
}

__device__ __forceinline__ void tr_tile(const float* src, int ldsrc, int k0, int c0, bf16_t* dst, int ldd, int r0, int kd0, float scale, LAS float* t, int lane) {
    f32x4 v[16];
#pragma unroll
    for (int i = 0; i < 16; ++i) v[i] = __builtin_nontemporal_load((const f32x4*)(src + (size_t)(k0 + (lane >> 4) + 4 * i) * ldsrc + c0 + 4 * (lane & 15)));
#pragma unroll
    for (int i = 0; i < 16; ++i)
#pragma unroll
        for (int j = 0; j < 4; ++j) t[((lane >> 4) + 4 * i) * 65 + 4 * (lane & 15) + j] = v[i][j];
    const int c = lane & 7;
#pragma unroll
    for (int j = 0; j < 8; ++j) { const int n = (lane >> 3) + 8 * j; const LAS float* q = t + (8 * c) * 65 + n;
        u32x4 o; o.x = pk2(scale * q[0], scale * q[65]); o.y = pk2(scale * q[130], scale * q[195]); o.z = pk2(scale * q[260], scale * q[325]); o.w = pk2(scale * q[390], scale * q[455]);
        *(u32x4*)(dst + (size_t)(r0 + n) * ldd + kd0 + 8 * c) = o; }
}
__device__ __forceinline__ void prep_phase(const Params& p, int wg, int nwg, LAS unsigned char* lds) {
    const int tid = opaque_tid();
    for (size_t i = (size_t)wg * 512 + tid; i < (size_t)MPAD * D / 4; i += (size_t)nwg * 512) {
        const size_t row = (i * 4) / D;
        f32x4 v = (f32x4){0.f, 0.f, 0.f, 0.f};
        if (row < (size_t)MP) v = ((const f32x4*)p.x_prompt)[i];
        else if (row < (size_t)MT) v = ((const f32x4*)p.x_sample)[i - (size_t)MP * D / 4];
        ((f32x4*)p.X)[i] = v;
    }
    for (int i = wg * 512 + tid; i < 2049 * 128; i += nwg * 512) {
        const int pi = i >> 7, j = i & 127;
        const float pos = pi < 2048 ? (float)pi : 16384.0f;
        const float inv = powf(10000.0f, -((float)j / 128.0f));
        const float ang = pos * inv;
        p.ROPE[2 * i] = (float)cos((double)ang); p.ROPE[2 * i + 1] = (float)sin((double)ang);
    }
    for (int i = wg * 512 + tid; i < DEPTH * 8 * D; i += nwg * 512) {
        const int l = i / (8 * D), r = i % (8 * D), j = r / D, k = r % D;
        p.WIF[i] = p.w_in[((size_t)l * D + k) * NIN + 3072 + j];
    }
    const int lane = tid & 63, wid = tid >> 6;
    LAS float* t = (LAS float*)lds + wid * (64 * 65);
    constexpr int T0 = 1536, T1 = T0 + 2048, T2 = T1 + 2048, T3 = T2 + 512, T4 = T3 + 512, T5 = T4 + 1024, T6 = T5 + 64, T7 = T6 + 64;
    for (int it = wg * 8 + wid; it < DEPTH * T7; it += nwg * 8) {
        const int l = it / T7, r = it % T7;
        bf16_t* Wl = p.W + (size_t)l * WL;
        if (r < T0)      { const int q = r;      tr_tile(p.w_in + (size_t)l * D * NIN, NIN, (q & 31) * 64, (q >> 5) * 64, Wl + W1_OFF, D, (q >> 5) * 64, (q & 31) * 64, 1.f, t, lane); }
        else if (r < T1) { const int q = r - T0; tr_tile(p.w_in + (size_t)l * D * NIN, NIN, (q & 31) * 64, 3080 + (q >> 5) * 64, Wl + W1_OFF, D, 3072 + (q >> 5) * 64, (q & 31) * 64, 1.f, t, lane); }
        else if (r < T2) { const int q = r - T1; const int ct = q >> 5, c0 = (((ct & 3) < 2) ? 0 : 2048) + 128 * (ct >> 2) + (ct & 1) * 64;
                           tr_tile(p.w_gate + (size_t)l * D * 4096, 4096, (q & 31) * 64, c0, Wl + W1_OFF, D, C_GM + ct * 64, (q & 31) * 64, 1.f, t, lane); }
        else if (r < T3) { const int q = r - T2; tr_tile(p.w_pm + (size_t)l * WM * D, D, (q & 15) * 64, (q >> 4) * 64, Wl + W3_OFF, D, (q >> 4) * 64, (q & 15) * 64, 1.f, t, lane); }
        else if (r < T4) { const int q = r - T3; tr_tile(p.w_pr + (size_t)l * WM * D, D, (q & 15) * 64, (q >> 4) * 64, Wl + W3_OFF, D, (q >> 4) * 64, 1024 + (q & 15) * 64, 1.f, t, lane); }
        else if (r < T5) { const int q = r - T4; tr_tile(p.w_o + (size_t)l * D * D, D, (q & 31) * 64, (q >> 5) * 64, Wl + W4_OFF, D, (q >> 5) * 64, (q & 31) * 64, 1.f, t, lane); }
        else if (r < T6) { const int q = r - T5, h = q >> 4, qq = q & 15; tr_tile(p.w_qm + ((size_t)l * HM + h) * SZ, DH, (qq & 3) * 64, (qq >> 2) * 64, Wl + W2_OFF, DH, h * 512 + (qq >> 2) * 64, (qq & 3) * 64, 0.0625f, t, lane); }
        else             { const int q = r - T6, h = q >> 4, qq = q & 15; tr_tile(p.w_km + ((size_t)l * HM + h) * SZ, DH, (qq & 3) * 64, (qq >> 2) * 64, Wl + W2_OFF, DH, h * 512 + 256 + (qq >> 2) * 64, (qq & 3) * 64, 1.f, t, lane); }
    }
}

__device__ __forceinline__ void norm_phase(const Params& p, int layer, int wg, int nwg, LAS unsigned char* lds) {
    const int tid_ = opaque_tid(), lane = tid_ & 63, wid = tid_ >> 6;
    const f32x4* g4 = (const f32x4*)(p.norm_g + (size_t)layer * D);
    const float* wif = p.WIF + (size_t)layer * 8 * D;
    LAS f32x4* wl = (LAS f32x4*)lds;
#pragma unroll
    for (int i = 0; i < 8; ++i) wl[tid_ + 512 * i] = ((const f32x4*)wif)[tid_ + 512 * i];
    __syncthreads();
    for (int row = wg * 8 + wid; row < MPAD; row += nwg * 8) {
        u32x2* hrow = (u32x2*)(p.H + (size_t)row * D);
        if (row >= MT) {
#pragma unroll
            for (int i = 0; i < 8; ++i) hrow[lane + 64 * i] = (u32x2){0u, 0u};
            continue;
        }
        const f32x4* xr = (const f32x4*)(p.X + (size_t)row * D);
        f32x4 v[8]; float ss = 0.f;
#pragma unroll
        for (int i = 0; i < 8; ++i) { v[i] = xr[lane + 64 * i]; ss += (v[i][0] * v[i][0] + v[i][1] * v[i][1]) + (v[i][2] * v[i][2] + v[i][3] * v[i][3]); }
        ss = wave_sum(ss);
        const float rstd = rsqrtf(ss * (1.0f / D) + EPS);
#pragma unroll
        for (int i = 0; i < 8; ++i) {
            v[i] = v[i] * rstd * g4[lane + 64 * i];
            hrow[lane + 64 * i] = (u32x2){pk2(v[i][0], v[i][1]), pk2(v[i][2], v[i][3])};
        }
#pragma unroll 1
        for (int j = 0; j < 8; ++j) {
            float s = 0.f;
#pragma unroll
            for (int i = 0; i < 8; ++i) { const f32x4 w = wl[j * 512 + lane + 64 * i]; s += (v[i][0] * w[0] + v[i][1] * w[1]) + (v[i][2] * w[2] + v[i][3] * w[3]); }
            s = wave_sum(s);
            if (lane == 0) p.IF[(size_t)row * 8 + j] = s;
        }
    }
}
__device__ __forceinline__ void final_phase(const Params& p, int wg, int nwg) {
    const int tid_ = opaque_tid(), lane = tid_ & 63, wid = tid_ >> 6;
    const f32x4* g4 = (const f32x4*)p.final_g;
    for (int row = wg * 8 + wid; row < MT; row += nwg * 8) {
        const f32x4* xr = (const f32x4*)(p.X + (size_t)row * D);
        f32x4* yr = (f32x4*)(p.out + (row < MP ? O_YP + (size_t)row * D : O_YS + (size_t)(row - MP) * D));
        f32x4 v[8]; float ss = 0.f;
#pragma unroll
        for (int i = 0; i < 8; ++i) { v[i] = xr[lane + 64 * i]; ss += (v[i][0] * v[i][0] + v[i][1] * v[i][1]) + (v[i][2] * v[i][2] + v[i][3] * v[i][3]); }
        ss = wave_sum(ss);
        const float rstd = rsqrtf(ss * (1.0f / D) + EPS);
#pragma unroll
        for (int i = 0; i < 8; ++i) yr[lane + 64 * i] = v[i] * rstd * g4[lane + 64 * i];
    }
}

__device__ __forceinline__ void unpack8(const u32x4 v, float (&f)[8]) {
    f[0] = __uint_as_float(v.x << 16); f[1] = __uint_as_float(v.x & 0xffff0000u); f[2] = __uint_as_float(v.y << 16); f[3] = __uint_as_float(v.y & 0xffff0000u);
    f[4] = __uint_as_float(v.z << 16); f[5] = __uint_as_float(v.z & 0xffff0000u); f[6] = __uint_as_float(v.w << 16); f[7] = __uint_as_float(v.w & 0xffff0000u);
}
__device__ __forceinline__ u32x4 pack8(const float (&f)[8]) { u32x4 w; w.x = pk2(f[0], f[1]); w.y = pk2(f[2], f[3]); w.z = pk2(f[4], f[5]); w.w = pk2(f[6], f[7]); return w; }

__device__ __forceinline__ void conv_phase(const Params& p, int layer, int wg, int nwg) {
    const int tid = opaque_tid();
    const float* cw = p.conv_w + (size_t)layer * 4 * WM;
    const float* cb = p.conv_b + (size_t)layer * WM;
    for (int it = wg * 512 + tid; it < MT * 128; it += nwg * 512) {
        const int row = it >> 7, ch = (it & 127) * 8;
        float up[4][8];
        if (row < MP) {
            const int t = row & (SEQ - 1);
#pragma unroll
            for (int i = 0; i < 4; ++i) {
                if (t - 3 + i >= 0) unpack8(*(const u32x4*)(p.P + (size_t)(row - 3 + i) * NP + C_U + ch), up[i]);
                else {
#pragma unroll
                    for (int j = 0; j < 8; ++j) up[i][j] = 0.f;
                }
            }
            if (t >= SEQ - 3) {
                const int b = row >> 11;
                float* o = p.out + O_CVP + (((size_t)layer * BP + b) * 3 + (t - (SEQ - 3))) * WM + ch;
                *(f32x4*)o = (f32x4){up[3][0], up[3][1], up[3][2], up[3][3]}; *(f32x4*)(o + 4) = (f32x4){up[3][4], up[3][5], up[3][6], up[3][7]};
            }
        } else {
            const int b = row - MP;
            const float* hist = p.st_conv + ((size_t)layer * BS + b) * 3 * WM + ch;
#pragma unroll
            for (int i = 0; i < 3; ++i) { const f32x4 a = *(const f32x4*)(hist + (size_t)i * WM), c = *(const f32x4*)(hist + (size_t)i * WM + 4);
                up[i][0] = a[0]; up[i][1] = a[1]; up[i][2] = a[2]; up[i][3] = a[3]; up[i][4] = c[0]; up[i][5] = c[1]; up[i][6] = c[2]; up[i][7] = c[3]; }
            unpack8(*(const u32x4*)(p.P + (size_t)row * NP + C_U + ch), up[3]);
            float* o = p.out + O_CVS + ((size_t)layer * BS + b) * 3 * WM + ch;
#pragma unroll
            for (int i = 0; i < 3; ++i) { *(f32x4*)(o + (size_t)i * WM) = (f32x4){up[i + 1][0], up[i + 1][1], up[i + 1][2], up[i + 1][3]};
                *(f32x4*)(o + (size_t)i * WM + 4) = (f32x4){up[i + 1][4], up[i + 1][5], up[i + 1][6], up[i + 1][7]}; }
        }
        float r[8];
#pragma unroll
        for (int j = 0; j < 8; ++j) r[j] = cb[ch + j];
#pragma unroll
        for (int i = 0; i < 4; ++i)
#pragma unroll
            for (int j = 0; j < 8; ++j) r[j] += up[i][j] * cw[i * WM + ch + j];
#pragma unroll
        for (int j = 0; j < 8; ++j) r[j] = siluf_(r[j]);
        *(u32x4*)(p.CM + (size_t)row * WM + ch) = pack8(r);
    }
}

__device__ __forceinline__ void gate_scan(const Params& p, int layer, int b, int h, int c_own, LAS float* G) {
    const int tid = opaque_tid(), lane = tid & 63, wid = tid >> 6;
    const float bi = p.b_i[layer * HM + h], bfv = p.b_f[layer * HM + h];
#pragma unroll
    for (int q = 0; q < 2; ++q) {
        const int cc = wid + 8 * q;
        const size_t r0 = (size_t)b * SEQ + cc * 128 + 2 * lane;
        const float i0 = p.IF[r0 * 8 + h] + bi, i1 = p.IF[(r0 + 1) * 8 + h] + bi;
        const float l0 = logsigf_(p.IF[r0 * 8 + 4 + h] + bfv), l1 = logsigf_(p.IF[(r0 + 1) * 8 + 4 + h] + bfv);
        float inc = l0 + l1;
#pragma unroll
        for (int o = 1; o < 64; o <<= 1) { const float t = __shfl_up(inc, o); if (lane >= o) inc += t; }
        const float exc = inc - (l0 + l1);
        const float b0 = exc + l0, b1 = inc;
        const float g0 = i0 - b0, g1 = i1 - b1;
        const float gm = wave_max(fmaxf(g0, g1));
        const float Bc = __shfl(inc, 63);
        if (lane == 0) { G[cc] = Bc; G[16 + cc] = gm; }
        if (cc == c_own) {
            float rm = fmaxf(g0, g1);
#pragma unroll
            for (int o = 1; o < 64; o <<= 1) { const float t = __shfl_up(rm, o); if (lane >= o) rm = fmaxf(rm, t); }
            float ex = __shfl_up(rm, 1); if (lane == 0) ex = -3.0e38f;
            const float c0 = fmaxf(ex, g0), c1 = fmaxf(c0, g1);
            G[64 + 2 * lane] = b0; G[65 + 2 * lane] = b1; G[192 + 2 * lane] = g0; G[193 + 2 * lane] = g1; G[320 + 2 * lane] = c0; G[321 + 2 * lane] = c1;
        }
    }
    __syncthreads();
    if (tid == 0) { float m = -1e30f; for (int cc = 0; cc < 16; ++cc) { G[32 + cc] = m; m = G[cc] + fmaxf(m, G[16 + cc]); } G[48] = m; }
    __syncthreads();
    if (c_own >= 0 && tid < 128) G[320 + tid] = fmaxf(G[320 + tid], G[32 + c_own]);
    __syncthreads();
}

template <int NR, int NC, bool WEIGHT>
__device__ __forceinline__ void stage_T(LAS unsigned char* dst, int ldd_bytes, const bf16_t* src, int ld_src, LAS const float* w) {
    const int tid_ = opaque_tid(), lane = tid_ & 63, wid = tid_ >> 6;
    constexpr int PB = NR / 128, CG = NC / 8;
#pragma unroll 1
    for (int task = wid; task < PB * CG; task += 8) {
        const int pb = task % PB, cg = task / PB, r = pb * 128 + 2 * lane;
        float a[8], c[8];
        unpack8(*(const u32x4*)(src + (size_t)r * ld_src + cg * 8), a); unpack8(*(const u32x4*)(src + (size_t)(r + 1) * ld_src + cg * 8), c);
        float w0 = 1.f, w1 = 1.f; if (WEIGHT) { w0 = w[r]; w1 = w[r + 1]; }
#pragma unroll
        for (int j = 0; j < 8; ++j) *(LAS unsigned*)(dst + (cg * 8 + j) * ldd_bytes + r * 2) = pk2(a[j] * w0, c[j] * w1);
    }
}
__device__ __forceinline__ void stage_rows(LAS unsigned char* dst, const bf16_t* src, int ld_src) {
    const int tid_ = opaque_tid();
#pragma unroll
    for (int i = 0; i < 8; ++i) { const int id = tid_ + 512 * i, row = id >> 5, ch = id & 31;
        *(LAS u32x4*)(dst + row * 528 + ch * 16) = *(const u32x4*)(src + (size_t)row * ld_src + ch * 8); }
}
__device__ __forceinline__ bf16x8 lds_frag(LAS const unsigned char* base, int row, int ld_bytes, int kbyte) { return *(LAS const bf16x8*)(base + row * ld_bytes + kbyte); }
__device__ __forceinline__ float ret_lg(int h) { return logf(1.0f - exp2f(-5.0f - (float)h)); }

template <int BR>
__device__ __forceinline__ void chunk_passA(const Params& p, int layer, int b, int h, int c, LAS unsigned char* lds) {
    LAS unsigned char* At = lds; LAS unsigned char* Bt = lds + 69632; LAS float* G = (LAS float*)(lds + 139264); LAS float* wk = G + 512;
    const int tid = opaque_tid(), lane = tid & 63, w = __builtin_amdgcn_readfirstlane(tid >> 6), g = lane >> 4, lr = lane & 15;
    const size_t row0 = (size_t)b * SEQ + c * 128;
    const int pi = BR * 16 + b * 4 + h;
    if (BR == 0) { gate_scan(p, layer, b, h, c, G); if (tid < 128) wk[tid] = expf(G[192 + tid] - G[320 + 127]); }
    else { if (tid < 128) wk[tid] = expf((float)(127 - tid) * ret_lg(h)); }
    __syncthreads();
    const bf16_t* srcA = BR == 0 ? p.P + row0 * NP + C_VM + h * 256 : p.P + row0 * NP + C_KR + h * 256;
    const bf16_t* srcB = BR == 0 ? p.QK + row0 * 2048 + h * 512 + 256 : p.P + row0 * NP + C_VR + h * 256;
    stage_T<128, 256, true>(At, 272, srcA, NP, wk);
    stage_T<128, 256, false>(Bt, 272, srcB, BR == 0 ? 2048 : NP, wk);
    __syncthreads();
    float* Uo = p.U + ((size_t)pi * 16 + c) * SZ;
#pragma unroll 1
    for (int rt = 0; rt < 2; ++rt) {
        f32x4 acc[16];
#pragma unroll
        for (int j = 0; j < 16; ++j) acc[j] = (f32x4){0.f, 0.f, 0.f, 0.f};
#pragma unroll
        for (int ks = 0; ks < 4; ++ks) {
            const bf16x8 a0 = lds_frag(At, 32 * w + 16 * rt + lr, 272, (32 * ks + 8 * g) * 2);
#pragma unroll
            for (int ct = 0; ct < 16; ++ct) acc[ct] = __builtin_amdgcn_mfma_f32_16x16x32_bf16(a0, lds_frag(Bt, 16 * ct + lr, 272, (32 * ks + 8 * g) * 2), acc[ct], 0, 0, 0);
            __builtin_amdgcn_sched_barrier(0);
        }
#pragma unroll
        for (int ct = 0; ct < 16; ++ct)
#pragma unroll
            for (int r = 0; r < 4; ++r) Uo[(size_t)(32 * w + 16 * rt + 4 * g + r) * 256 + 16 * ct + lr] = acc[ct][r];
    }
    if (BR == 0 && tid < 256) {
        float s = 0.f;
        for (int ss = 0; ss < 128; ++ss) s += wk[ss] * bf2f(*(LAS const bf16_t*)(Bt + tid * 272 + ss * 2));
        p.NU[((size_t)(b * 4 + h) * 16 + c) * 256 + tid] = s;
    }
    __syncthreads();
}

__device__ __forceinline__ void scan_item(const Params& p, int layer, int pi, int slice, LAS unsigned char* lds) {
    LAS float* G = (LAS float*)lds; LAS float* dec = G + 512;
    const int tid = opaque_tid(), br = pi >> 4, bh = pi & 15, b = bh >> 2, h = bh & 3;
    if (br == 0) { gate_scan(p, layer, b, h, -1, G); if (tid < 16) dec[tid] = expf(G[32 + tid] - fmaxf(G[32 + tid], G[16 + tid])); }
    else if (tid < 16) dec[tid] = expf(128.0f * ret_lg(h));
    __syncthreads();
    f32x4 st[4];
#pragma unroll
    for (int j = 0; j < 4; ++j) st[j] = (f32x4){0.f, 0.f, 0.f, 0.f};
    for (int c = 0; c < 16; ++c) {
        const float dc = dec[c];
#pragma unroll
        for (int j = 0; j < 4; ++j) { const size_t idx = (size_t)slice * 8192 + j * 2048 + tid * 4;
            const f32x4 u = *(const f32x4*)(p.U + ((size_t)pi * 16 + c) * SZ + idx);
            *(u32x2*)(p.CS + ((size_t)pi * 16 + c) * SZ + idx) = (u32x2){pk2(st[j][0], st[j][1]), pk2(st[j][2], st[j][3])};
            st[j] = st[j] * dc + u; }
    }
    float* fo = p.out + (br == 0 ? O_CP : O_SP) + (((size_t)layer * BP + b) * HM + h) * SZ;
#pragma unroll
    for (int j = 0; j < 4; ++j) *(f32x4*)(fo + (size_t)slice * 8192 + j * 2048 + tid * 4) = st[j];
    if (br == 0 && slice == 0) {
        if (tid < 256) { float n = 0.f;
            for (int c = 0; c < 16; ++c) { p.NS[((size_t)bh * 16 + c) * 256 + tid] = n; n = dec[c] * n + p.NU[((size_t)bh * 16 + c) * 256 + tid]; }
            p.out[O_NP + (((size_t)layer * BP + b) * HM + h) * 256 + tid] = n; }
        if (tid == 0) p.out[O_MP + ((size_t)layer * BP + b) * HM + h] = G[48];
    }
    __syncthreads();
}

template <int BR>
__device__ __forceinline__ void chunk_passC(const Params& p, int layer, int b, int h, int c, LAS unsigned char* lds) {
    LAS unsigned char* BufB = lds; LAS unsigned char* Sw = lds + 69632; LAS float* G = (LAS float*)(lds + 104448);
    LAS float* av = G + 512; LAS float* fl = G + 640; LAS bf16_t* nbf = (LAS bf16_t*)(G + 768);
    const int tid = opaque_tid(), lane = tid & 63, w = __builtin_amdgcn_readfirstlane(tid >> 6), g = lane >> 4, lr = lane & 15;
    const size_t row0 = (size_t)b * SEQ + c * 128;
    const int pi = BR * 16 + b * 4 + h;
    const float lg = ret_lg(h);
    if (BR == 0) {
        gate_scan(p, layer, b, h, c, G);
        if (tid < 128) { av[tid] = expf(G[32 + c] - G[320 + tid]); fl[tid] = expf(-(G[64 + tid] + G[320 + tid])); }
        if (tid < 256) nbf[tid] = f2bf(p.NS[((size_t)(b * 4 + h) * 16 + c) * 256 + tid]);
    } else { if (tid < 128) av[tid] = expf((float)(tid + 1) * lg); }
    const bf16_t* Qp = BR == 0 ? p.QK + (row0 + 16 * w + lr) * 2048 + h * 512 : p.P + (row0 + 16 * w + lr) * NP + C_QR + h * 256;
    bf16x8 qf[8];
#pragma unroll
    for (int ks = 0; ks < 8; ++ks) qf[ks] = *(const bf16x8*)(Qp + 32 * ks + 8 * g);
    stage_rows(BufB, BR == 0 ? p.QK + row0 * 2048 + h * 512 + 256 : p.P + row0 * NP + C_KR + h * 256, BR == 0 ? 2048 : NP);
    __syncthreads();
    float rs[4] = {0.f, 0.f, 0.f, 0.f};
#pragma unroll
    for (int j = 0; j < 8; ++j) {
        f32x4 a = (f32x4){0.f, 0.f, 0.f, 0.f};
        if (j <= w) {
#pragma unroll
            for (int ks = 0; ks < 8; ++ks) a = __builtin_amdgcn_mfma_f32_16x16x32_bf16(qf[ks], lds_frag(BufB, 16 * j + lr, 528, (32 * ks + 8 * g) * 2), a, 0, 0, 0);
        }
#pragma unroll
        for (int r = 0; r < 4; ++r) {
            const int l = 16 * w + 4 * g + r, s = 16 * j + lr;
            float d = 0.f;
            if (s <= l) d = BR == 0 ? expf(G[192 + s] - G[320 + l]) : expf((float)(l - s) * lg);
            const float v = a[r] * d;
            rs[r] += v;
            *(LAS bf16_t*)(Sw + (l * 136 + s) * 2) = f2bf(v);
        }
        __builtin_amdgcn_sched_barrier(0);
    }
#pragma unroll
    for (int r = 0; r < 4; ++r) { rs[r] += __shfl_xor(rs[r], 1); rs[r] += __shfl_xor(rs[r], 2); rs[r] += __shfl_xor(rs[r], 4); rs[r] += __shfl_xor(rs[r], 8); }
    __syncthreads();
    f32x4 accN[16];
#pragma unroll
    for (int t = 0; t < 16; ++t) accN[t] = (f32x4){0.f, 0.f, 0.f, 0.f};
    const bf16_t* CSp = p.CS + ((size_t)pi * 16 + c) * SZ;
#pragma unroll
    for (int half = 0; half < 2; ++half) {
        if (BR == 0) stage_rows(BufB, CSp + (size_t)half * 128 * 256, 256);
        else stage_T<256, 128, false>(BufB, 528, CSp + half * 128, 256, av);
        __syncthreads();
#pragma unroll
        for (int t = 0; t < 8; ++t) {
#pragma unroll
            for (int ks = 0; ks < 8; ++ks)
                accN[half * 8 + t] = __builtin_amdgcn_mfma_f32_16x16x32_bf16(qf[ks], lds_frag(BufB, 16 * t + lr, 528, (32 * ks + 8 * g) * 2), accN[half * 8 + t], 0, 0, 0);
            __builtin_amdgcn_sched_barrier(0); }
        __syncthreads();
    }
    float nq[4] = {0.f, 0.f, 0.f, 0.f};
    if (BR == 0) {
        f32x4 ad = (f32x4){0.f, 0.f, 0.f, 0.f};
#pragma unroll
        for (int ks = 0; ks < 8; ++ks) {
            bf16x8 nf = *(LAS const bf16x8*)(nbf + 32 * ks + 8 * g);
            if (lr != 0) nf = (bf16x8){0, 0, 0, 0, 0, 0, 0, 0};
            ad = __builtin_amdgcn_mfma_f32_16x16x32_bf16(qf[ks], nf, ad, 0, 0, 0);
        }
#pragma unroll
        for (int r = 0; r < 4; ++r) nq[r] = __shfl(ad[r], lane & 48);
    }
    float ar[4];
#pragma unroll
    for (int r = 0; r < 4; ++r) ar[r] = av[16 * w + 4 * g + r];
#pragma unroll
    for (int t = 0; t < 16; ++t)
#pragma unroll
        for (int r = 0; r < 4; ++r) accN[t][r] *= ar[r];
    stage_T<128, 256, false>(BufB, 272, p.P + row0 * NP + (BR == 0 ? C_VM : C_VR) + h * 256, NP, av);
    __syncthreads();
#pragma unroll
    for (int ks = 0; ks < 4; ++ks) {
        const bf16x8 af = lds_frag(Sw, 16 * w + lr, 272, (32 * ks + 8 * g) * 2);
#pragma unroll
        for (int t = 0; t < 16; ++t) accN[t] = __builtin_amdgcn_mfma_f32_16x16x32_bf16(af, lds_frag(BufB, 16 * t + lr, 272, (32 * ks + 8 * g) * 2), accN[t], 0, 0, 0);
        __builtin_amdgcn_sched_barrier(0);
    }
    float inv[4];
#pragma unroll
    for (int r = 0; r < 4; ++r) {
        if (BR == 0) { const float den = fmaxf(fabsf(rs[r] + ar[r] * nq[r]), fl[16 * w + 4 * g + r]); inv[r] = 1.0f / den; }
        else inv[r] = 1.0f;
    }
    float mu[4], rstd[4];
#pragma unroll
    for (int r = 0; r < 4; ++r) {
        float s = 0.f;
#pragma unroll
        for (int t = 0; t < 16; ++t) { accN[t][r] *= inv[r]; s += accN[t][r]; }
        s += __shfl_xor(s, 1); s += __shfl_xor(s, 2); s += __shfl_xor(s, 4); s += __shfl_xor(s, 8);
        mu[r] = s * (1.0f / 256.0f);
        float q = 0.f;
#pragma unroll
        for (int t = 0; t < 16; ++t) { const float d = accN[t][r] - mu[r]; q += d * d; }
        q += __shfl_xor(q, 1); q += __shfl_xor(q, 2); q += __shfl_xor(q, 4); q += __shfl_xor(q, 8);
        rstd[r] = rsqrtf(q * (1.0f / 256.0f) + EPS);
    }
    const float* gain = (BR == 0 ? p.hn_m_g : p.hn_r_g) + (size_t)layer * WM + h * 256;
    const float* skip = p.skip_m + (size_t)layer * WM + h * 256;
#pragma unroll
    for (int t = 0; t < 16; ++t) {
        const int e = 16 * t + lr;
        const float ge = gain[e], sk = BR == 0 ? skip[e] : 0.f;
#pragma unroll
        for (int r = 0; r < 4; ++r) {
            const size_t row = row0 + 16 * w + 4 * g + r;
            float v = (accN[t][r] - mu[r]) * rstd[r] * ge;
            const float z = bf2f(p.P[row * NP + (BR == 0 ? C_ZM : C_ZR) + h * 256 + e]);
            if (BR == 0) v += sk * bf2f(p.CM[row * WM + h * 256 + e]);
            p.OC[row * 2048 + BR * 1024 + h * 256 + e] = f2bf(v * siluf_(z));
        }
        __builtin_amdgcn_sched_barrier(0);
    }
    __syncthreads();
}

template <int BR>
__device__ __forceinline__ void sample_item(const Params& p, int layer, int b, int h, LAS unsigned char* lds) {
    LAS float* sq = (LAS float*)lds; LAS float* sk = sq + 256; LAS float* sv = sk + 256; LAS float* sn = sv + 256; LAS float* sr = sn + 256; LAS float* red = sr + 256;
    LAS float* part = red + 64;
    const int tid = opaque_tid(), lane = tid & 63, wid = tid >> 6;
    const size_t R = (size_t)MP + b;
    const size_t sidx = ((size_t)layer * BS + b) * HM + h;
    if (tid < 256) {
        if (BR == 0) { sq[tid] = bf2f(p.QK[R * 2048 + h * 512 + tid]); sk[tid] = bf2f(p.QK[R * 2048 + h * 512 + 256 + tid]); sv[tid] = bf2f(p.P[R * NP + C_VM + h * 256 + tid]); sn[tid] = p.st_n[sidx * 256 + tid]; }
        else { sq[tid] = bf2f(p.P[R * NP + C_QR + h * 256 + tid]); sk[tid] = bf2f(p.P[R * NP + C_KR + h * 256 + tid]); sv[tid] = bf2f(p.P[R * NP + C_VR + h * 256 + tid]); sn[tid] = 0.f; }
    }
    __syncthreads();
    float pq = 0.f, pn = 0.f;
    if (tid < 256) { pq = sq[tid] * sk[tid]; pn = sn[tid] * sq[tid]; }
    block_sum2(pq, pn, red);
    const float qk = pq, nq = pn;
    float wgt = 1.f, a = 1.f, mt = 0.f;
    if (BR == 0) {
        const float ig = p.IF[R * 8 + h] + p.b_i[layer * HM + h];
        const float lf = logsigf_(p.IF[R * 8 + 4 + h] + p.b_f[layer * HM + h]);
        const float inter = lf + p.st_m[sidx];
        mt = fmaxf(inter, ig); wgt = expf(ig - mt); a = expf(inter - mt);
    } else { a = 1.0f - exp2f(-5.0f - (float)h); }
    const float* S0 = (BR == 0 ? p.st_C : p.st_S) + sidx * SZ;
    float* S1 = p.out + (BR == 0 ? O_CS : O_SS) + sidx * SZ;
    const f32x4* S0v = (const f32x4*)S0 + lane; f32x4* S1v = (f32x4*)S1 + lane;
    f32x4 cc[8], cn[8];
#pragma unroll
    for (int j = 0; j < 8; ++j) cc[j] = __builtin_nontemporal_load(S0v + 64 * (wid + 8 * j));
    if (BR == 0) {
        const f32x4 q4 = *(LAS const f32x4*)(sq + 4 * lane), k4 = *(LAS const f32x4*)(sk + 4 * lane);
#pragma unroll
        for (int i0 = 0; i0 < 32; i0 += 8) {
            if (i0 + 8 < 32) {
#pragma unroll
                for (int j = 0; j < 8; ++j) cn[j] = __builtin_nontemporal_load(S0v + 64 * (wid + 8 * (i0 + 8 + j)));
            }
#pragma unroll
            for (int j = 0; j < 8; ++j) { const int e = wid + 8 * (i0 + j);
                float pt = (cc[j][0] * q4[0] + cc[j][1] * q4[1]) + (cc[j][2] * q4[2] + cc[j][3] * q4[3]);
                const float wv = wgt * sv[e];
                __builtin_nontemporal_store(cc[j] * a + k4 * wv, S1v + 64 * e);
                pt = wave_sum(pt);
                if (lane == 0) sr[e] = pt; }
#pragma unroll
            for (int j = 0; j < 8; ++j) cc[j] = cn[j];
        }
    } else {
        const f32x4 v4 = *(LAS const f32x4*)(sv + 4 * lane);
        f32x4 ac = (f32x4){0.f, 0.f, 0.f, 0.f};
#pragma unroll
        for (int i0 = 0; i0 < 32; i0 += 8) {
            if (i0 + 8 < 32) {
#pragma unroll
                for (int j = 0; j < 8; ++j) cn[j] = __builtin_nontemporal_load(S0v + 64 * (wid + 8 * (i0 + 8 + j)));
            }
#pragma unroll
            for (int j = 0; j < 8; ++j) { const int d = wid + 8 * (i0 + j);
                ac = ac + cc[j] * sq[d];
                __builtin_nontemporal_store(cc[j] * a + v4 * sk[d], S1v + 64 * d); }
#pragma unroll
            for (int j = 0; j < 8; ++j) cc[j] = cn[j];
        }
        *(LAS f32x4*)(part + wid * 256 + 4 * lane) = ac;
    }
    __syncthreads();
    float hv = 0.f;
    if (tid < 256) {
        if (BR == 0) {
            const float ws = wgt * qk;
            const float den = fmaxf(fabsf(ws + a * nq), expf(-mt));
            hv = (ws * sv[tid] + a * sr[tid]) / den;
            p.out[O_NS + sidx * 256 + tid] = a * sn[tid] + wgt * sk[tid];
            if (tid == 0) p.out[O_MS + sidx] = mt;
        } else {
            float s = 0.f;
#pragma unroll
            for (int i = 0; i < 8; ++i) s += part[i * 256 + tid];
            hv = qk * sv[tid] + a * s;
        }
    }
    float s1 = hv, s2 = 0.f;
    block_sum2(s1, s2, red);
    const float mean = s1 * (1.0f / 256.0f);
    float dv = tid < 256 ? hv - mean : 0.f;
    float q1 = dv * dv, q2 = 0.f;
    block_sum2(q1, q2, red);
    const float rstd = rsqrtf(q1 * (1.0f / 256.0f) + EPS);
    if (tid < 256) {
        const float ge = (BR == 0 ? p.hn_m_g : p.hn_r_g)[(size_t)layer * WM + h * 256 + tid];
        float v = dv * rstd * ge;
        const float z = bf2f(p.P[R * NP + (BR == 0 ? C_ZM : C_ZR) + h * 256 + tid]);
        if (BR == 0) v += p.skip_m[(size_t)layer * WM + h * 256 + tid] * bf2f(p.CM[R * WM + h * 256 + tid]);
        p.OC[R * 2048 + BR * 1024 + h * 256 + tid] = f2bf(v * siluf_(z));
    }
    __syncthreads();
}

template <int MODE>
__device__ __forceinline__ void sample_gemm(const Params& p, const bf16_t* Wl, int wg, int nwg, LAS unsigned char* lds) {
    const int tid = opaque_tid(), lane = tid & 63, w = tid >> 6, g = lane >> 4, lr = lane & 15, hf = w >> 2;
    LAS f32x4* xch = (LAS f32x4*)lds;
    for (int j = wg; j < 256; j += nwg) {
        const int rbase = MP + 64 * (j & 1) + 16 * (w & 3), cbase = 16 * (j >> 1);
        const bf16_t* A = (MODE == 0 ? p.OC : p.MG) + (size_t)(rbase + lr) * 2048 + hf * 1024 + 8 * g;
        const bf16_t* B = Wl + (MODE == 0 ? W3_OFF : W4_OFF) + (size_t)(cbase + lr) * 2048 + hf * 1024 + 8 * g;
        f32x4 acc = (f32x4){0.f, 0.f, 0.f, 0.f};
#pragma unroll 1
        for (int k0 = 0; k0 < 1024; k0 += 512) {
            bf16x8 af[16], bf[16];
#pragma unroll
            for (int i = 0; i < 16; ++i) { af[i] = *(const bf16x8*)(A + k0 + 32 * i); bf[i] = *(const bf16x8*)(B + k0 + 32 * i); }
#pragma unroll
            for (int i = 0; i < 16; ++i) acc = __builtin_amdgcn_mfma_f32_16x16x32_bf16(af[i], bf[i], acc, 0, 0, 0);
        }
        if (hf == 1) xch[(w & 3) * 64 + lane] = acc;
        __syncthreads();
        if (hf == 0) {
            const f32x4 hi = xch[(w & 3) * 64 + lane];
            const int col = cbase + lr;
#pragma unroll
            for (int r = 0; r < 4; ++r) {
                const size_t row = (size_t)rbase + 4 * g + r;
                if (MODE == 0) {
                    const float rt = bf2f(p.RT[row * 2048 + col]), gr = bf2f(p.GRS[row * 2048 + col]);
                    p.MG[row * 2048 + col] = f2bf(gr * (rt * acc[r] + hi[r]));
                } else p.X[row * 2048 + col] += acc[r] + hi[r];
            }
        }
        __syncthreads();
    }
}

__device__ __forceinline__ void phaseA(const Params& p, int layer, int wg, int nwg, LAS unsigned char* lds) {
    for (int it0 = wg; it0 < 1536; it0 += nwg) {
        const int it = (wg & 1) ? (it0 < 1024 ? it0 + 512 : it0 - 1024) : it0;
        if (it < 512) {
            const int br = it >> 8, rest = it & 255, b = rest >> 6, h = (rest >> 4) & 3, c = rest & 15;
            if (br == 0) chunk_passA<0>(p, layer, b, h, c, lds); else chunk_passA<1>(p, layer, b, h, c, lds);
        } else {
            const int s = it - 512, br = s >> 9, b = (s >> 2) & 127, h = s & 3;
            if (br == 0) sample_item<0>(p, layer, b, h, lds); else sample_item<1>(p, layer, b, h, lds);
        }
    }
}
__device__ __forceinline__ void phaseScan(const Params& p, int layer, int wg, int nwg, LAS unsigned char* lds) {
    for (int it = wg; it < 256; it += nwg) scan_item(p, layer, it >> 3, it & 7, lds);
}
__device__ __forceinline__ void phaseC(const Params& p, int layer, int wg, int nwg, LAS unsigned char* lds) {
    for (int it = wg; it < 512; it += nwg) {
        const int br = it >> 8, rest = it & 255, b = rest >> 6, h = (rest >> 4) & 3, c = rest & 15;
        if (br == 0) chunk_passC<0>(p, layer, b, h, c, lds); else chunk_passC<1>(p, layer, b, h, c, lds);
    }
}

template <int ONLY>
__device__ __forceinline__ void run_phases(const Params& p, int ph_lo, int ph_hi) {
    extern __shared__ __attribute__((aligned(16))) unsigned char smem_raw[];
    LAS unsigned char* lds = (LAS unsigned char*)smem_raw;
    volatile LAS unsigned* xbw = (volatile LAS unsigned*)(lds + LDS_BYTES - 16);
    const int wg = blockIdx.x, nwg = gridDim.x;
    const bool multi = (ph_hi - ph_lo) > 1;
    XcdBarrier bar; bar.bar = p.bar; bar.x = 0; bar.st = xbw;
    if (multi) {
        if (threadIdx.x == 0) { xbw[0] = 0u; xbw[1] = 0u; xbw[2] = 0u; xbw[3] = 0u; }
        __syncthreads();
        bar = xcd_barrier_post(p.bar, xbw);
    }
    int ph = 0;
#define PHASE(KIND, ...) { if constexpr (ONLY < 0 || ONLY == KIND) { if (ph >= ph_lo && ph < ph_hi) { __VA_ARGS__; if (ph + 1 < ph_hi) xcd_barrier(bar); } } ++ph; }
    PHASE(0, prep_phase(p, wg, nwg, lds))
    for (int layer = 0; layer < DEPTH; ++layer) {
        const bf16_t* Wl = p.W + (size_t)layer * WL;
        PHASE(1, norm_phase(p, layer, wg, nwg, lds))
        PHASE(2, { pg8::StaticOrder S; S.init(MPAD, N1, nwg, wg); pg8::Gemm g{p.H, Wl + W1_OFF, D, D, D, 31, 0, 0};
                pg8::EpiG1 E{p.P, p.b_gate + (size_t)layer * 4096, p.RT, p.GRS, p.ROPE}; pg8::gemm_phase<false>(lds, g, S, E); })
        PHASE(3, conv_phase(p, layer, wg, nwg))
        PHASE(4, { pg8::StaticOrder S; S.init(MPAD, 2048, nwg, wg); pg8::Gemm g{p.CM, Wl + W2_OFF, 256, WM, 256, 1, 512, 0};
                pg8::EpiBf16 E{p.QK, 2048}; pg8::gemm_phase<false>(lds, g, S, E); })
        PHASE(5, phaseA(p, layer, wg, nwg, lds))
        PHASE(6, phaseScan(p, layer, wg, nwg, lds))
        PHASE(7, phaseC(p, layer, wg, nwg, lds))
        PHASE(8, { pg8::StaticOrder S; S.init(MP, 2048, nwg, wg); pg8::Gemm g{p.OC, Wl + W3_OFF, 2048, 2048, 2048, 31, 0, 16};
                pg8::EpiMerged E{p.MG, p.RT, p.GRS}; pg8::gemm_phase<true>(lds, g, S, E); sample_gemm<0>(p, Wl, wg, nwg, lds); })
        PHASE(10, { pg8::StaticOrder S; S.init(MP, 2048, nwg, wg); pg8::Gemm g{p.MG, Wl + W4_OFF, 2048, 2048, 2048, 31, 0, 0};
                pg8::EpiResidual E{p.X}; pg8::gemm_phase<false>(lds, g, S, E); sample_gemm<1>(p, Wl, wg, nwg, lds); })
    }
    PHASE(11, final_phase(p, wg, nwg))
#undef PHASE
}
__global__ void __launch_bounds__(512, 2) mega(Params p, int ph_lo, int ph_hi) { run_phases<-1>(p, ph_lo, ph_hi); }
#ifdef DIAG
template <int K> __global__ void __launch_bounds__(512, 2) mega_k(Params p, int ph_lo, int ph_hi) { run_phases<K>(p, ph_lo, ph_hi); }
template __global__ void mega_k<0>(Params, int, int); template __global__ void mega_k<1>(Params, int, int); template __global__ void mega_k<2>(Params, int, int);
template __global__ void mega_k<3>(Params, int, int); template __global__ void mega_k<4>(Params, int, int); template __global__ void mega_k<5>(Params, int, int);
template __global__ void mega_k<6>(Params, int, int); template __global__ void mega_k<7>(Params, int, int); template __global__ void mega_k<8>(Params, int, int);
template __global__ void mega_k<10>(Params, int, int); template __global__ void mega_k<11>(Params, int, int);
#endif
constexpr int N_PHASES = 2 + DEPTH * 9;

extern "C" void kernel_launch(void* const* d_in, const int* in_sizes, int n_in, void* d_out, int out_size, void* d_ws, size_t ws_size, hipStream_t stream) {
    (void)in_sizes; (void)n_in; (void)out_size; (void)ws_size;
    static int grid = 0;
    if (grid == 0) {
        int dev = 0, cus = 0;
        hipGetDevice(&dev);
        hipDeviceGetAttribute(&cus, hipDeviceAttributeMultiprocessorCount, dev);
        if (hipFuncSetAttribute((const void*)mega, hipFuncAttributeMaxDynamicSharedMemorySize, LDS_BYTES) != hipSuccess) fprintf(stderr, "hipFuncSetAttribute failed\n");
        (void)hipGetLastError();
        grid = cus > 0 ? cus : 256;
    }
    Params p{};
    const float** in = (const float**)&p;
    for (int i = 0; i < 24; ++i) in[i] = (const float*)d_in[i];
    p.out = (float*)d_out;
    unsigned char* ws = (unsigned char*)d_ws;
    size_t off = 0;
    auto take = [&](size_t bytes) { unsigned char* r = ws + off; off += (bytes + 255) & ~(size_t)255; return r; };
    p.bar = (unsigned*)take(16384);
    p.X = (float*)take((size_t)MPAD * D * 4);
    p.H = (bf16_t*)take((size_t)MPAD * D * 2);
    p.P = (bf16_t*)take((size_t)MPAD * NP * 2);
    p.IF = (float*)take((size_t)MPAD * 8 * 4);
    p.CM = (bf16_t*)take((size_t)MPAD * WM * 2);
    p.QK = (bf16_t*)take((size_t)MPAD * 2048 * 2);
    p.OC = (bf16_t*)take((size_t)MPAD * 2048 * 2);
    p.T3 = (float*)take((size_t)MPAD * 2048 * 4);
    p.MG = (bf16_t*)take((size_t)MPAD * 2048 * 2);
    p.U = (float*)take((size_t)32 * 16 * SZ * 4);
    p.CS = (bf16_t*)take((size_t)32 * 16 * SZ * 2);
    p.NU = (float*)take((size_t)16 * 16 * 256 * 4);
    p.NS = (float*)take((size_t)16 * 16 * 256 * 4);
    p.W = (bf16_t*)take((size_t)DEPTH * WL * 2);
    p.WIF = (float*)take((size_t)DEPTH * 8 * D * 4);
    p.BIAS1 = (float*)take((size_t)DEPTH * N1 * 4);
    p.ROPE = (float*)take((size_t)2049 * 128 * 2 * 4);
    p.RT = (bf16_t*)take((size_t)MPAD * 2048 * 2);
    p.GRS = (bf16_t*)take((size_t)MPAD * 2048 * 2);
    hipMemsetAsync(p.bar, 0, 16384, stream);
#if MK_SINGLE
    hipLaunchKernelGGL(mega, dim3(grid), dim3(512), LDS_BYTES, stream, p, 0, N_PHASES);
#else
    for (int ph = 0; ph < N_PHASES; ++ph) hipLaunchKernelGGL(mega, dim3(grid), dim3(512), LDS_BYTES, stream, p, ph, ph + 1);
#endif
}
```

```cpp
#include <hip/hip_runtime.h>
#include <stdint.h>
#include <stdio.h>

#ifndef MK_SINGLE
#define MK_SINGLE 1
#endif

#define LAS __attribute__((address_space(3)))
typedef unsigned short bf16_t;
typedef short bf16x8 __attribute__((ext_vector_type(8)));
typedef float f32x4 __attribute__((ext_vector_type(4)));
typedef unsigned u32x4 __attribute__((ext_vector_type(4)));
typedef unsigned u32x2 __attribute__((ext_vector_type(2)));

constexpr int D = 2048, SEQ = 2048, BP = 4, BS = 128, DEPTH = 4, HM = 4, DH = 256, WM = 1024, NIN = 7176;
constexpr int MP = BP * SEQ, MT = MP + BS, MPAD = 8448;
constexpr int NP = 7168;
constexpr int N1 = 11264;
constexpr int C_U = 0, C_VM = 1024, C_ZM = 2048, C_QR = 3072, C_KR = 4096, C_VR = 5120, C_ZR = 6144, C_GM = 7168, C_GR = 9216;
constexpr float EPS = 1e-6f;
constexpr size_t SZ = 65536;
constexpr size_t O_YP = 0, O_YS = O_YP + 16777216, O_CP = O_YS + 262144, O_NP = O_CP + 4194304, O_MP = O_NP + 16384, O_CVP = O_MP + 64,
                 O_SP = O_CVP + 49152, O_CS = O_SP + 4194304, O_NS = O_CS + 134217728, O_MS = O_NS + 524288, O_CVS = O_MS + 2048, O_SS = O_CVS + 1572864;
constexpr size_t W1_OFF = 0, W2_OFF = W1_OFF + (size_t)N1 * D, W3_OFF = W2_OFF + (size_t)2048 * 256, W4_OFF = W3_OFF + (size_t)D * D, WL = W4_OFF + (size_t)D * D;
constexpr int LDS_BYTES = 147456;

struct Params {
    const float *x_prompt, *x_sample, *st_C, *st_n, *st_m, *st_conv, *st_S, *norm_g, *w_in, *conv_w, *conv_b, *w_qm, *w_km, *b_i, *b_f,
                *hn_m_g, *skip_m, *hn_r_g, *w_pm, *w_pr, *w_gate, *b_gate, *w_o, *final_g;
    float* out;
    unsigned* bar;
    float* X; bf16_t* H; bf16_t* P; float* IF; bf16_t* CM; bf16_t* QK; bf16_t* OC; float* T3; bf16_t* MG;
    bf16_t* U; bf16_t* CS; float* NU; float* NS; bf16_t* W; float* WIF; float* BIAS1; float* ROPE; bf16_t* RT; bf16_t* GRS;
};

__device__ __forceinline__ int opaque_tid() { int t = threadIdx.x; asm volatile("" : "+v"(t)); return t; }
__device__ __forceinline__ float bf2f(bf16_t v) { return __uint_as_float((unsigned)v << 16); }
__device__ __forceinline__ bf16_t f2bf(float f) { unsigned u = __float_as_uint(f); u += 0x7fffu + ((u >> 16) & 1u); return (bf16_t)(u >> 16); }
__device__ __forceinline__ unsigned pk2(float lo, float hi) { return (unsigned)f2bf(lo) | ((unsigned)f2bf(hi) << 16); }
__device__ __forceinline__ float wave_sum(float v) {
#pragma unroll
    for (int o = 32; o >= 1; o >>= 1) v += __shfl_xor(v, o);
    return v;
}
__device__ __forceinline__ float wave_max(float v) {
#pragma unroll
    for (int o = 32; o >= 1; o >>= 1) v = fmaxf(v, __shfl_xor(v, o));
    return v;
}
__device__ __forceinline__ float sigmoidf_(float x) { return __builtin_amdgcn_rcpf(1.0f + __expf(-x)); }
__device__ __forceinline__ float siluf_(float x) { return x * __builtin_amdgcn_rcpf(1.0f + __expf(-x)); }
__device__ __forceinline__ float logsigf_(float x) { return x < 0.f ? x - log1pf(expf(x)) : -log1pf(expf(-x)); }
__device__ __forceinline__ void block_sum2(float& a, float& b, LAS float* red) {
    a = wave_sum(a); b = wave_sum(b);
    __syncthreads();
    if ((threadIdx.x & 63) == 0) { red[threadIdx.x >> 6] = a; red[8 + (threadIdx.x >> 6)] = b; }
    __syncthreads();
    float sa = 0.f, sb = 0.f;
#pragma unroll
    for (int i = 0; i < 8; ++i) { sa += red[i]; sb += red[8 + i]; }
    a = sa; b = sb;
}

#define XB_TMO      128
#define XB_XCNT(j)  (256  + 64 * (j))
#define XB_XSUB(j)  (1280 + 64 * (j))
#define XB_XGEN(j)  (2304 + 64 * (j))
#define XB_TOP      3328
#define XB_TOPGEN   3392
#define XCD_BAR_WORDS 3456
#define XB_SPIN_CAP (1u << 22)

__device__ __forceinline__ unsigned xb_ld(unsigned* p)              { return __hip_atomic_load(p, __ATOMIC_RELAXED, __HIP_MEMORY_SCOPE_AGENT); }
__device__ __forceinline__ unsigned xb_add(unsigned* p, unsigned v) { return __hip_atomic_fetch_add(p, v, __ATOMIC_RELAXED, __HIP_MEMORY_SCOPE_AGENT); }
__device__ __forceinline__ unsigned xb_xcc_id() { return (unsigned)__builtin_amdgcn_s_getreg((3 << 11) | 20) & 0xFu; }
#define XB_SPIN(cond, bar) do { unsigned _sp = 0; while (cond) { __builtin_amdgcn_s_sleep(1); \
    if ((++_sp & 255u) == 0u) { if (xb_ld(&(bar)[XB_TMO])) break; if (_sp > XB_SPIN_CAP) { atomicAdd(&(bar)[XB_TMO], 1u); break; } } } } while (0)

struct XcdBarrier { unsigned* bar; unsigned x; volatile LAS unsigned* st; };

__device__ __forceinline__ XcdBarrier xcd_barrier_post(unsigned* bar, volatile LAS unsigned* st) {
    XcdBarrier b; b.bar = bar; b.x = xb_xcc_id(); b.st = st;
    if (threadIdx.x == 0) (void)xb_add(&bar[XB_XCNT(b.x)], 1u);
    return b;
}
__device__ __forceinline__ void xcd_barrier_complete(unsigned* bar, unsigned x, unsigned& nloc, unsigned& nx) {
    const unsigned G = gridDim.x * gridDim.y * gridDim.z;
    unsigned sum, cnt, mine, sp = 0u;
    for (;;) {
        sum = 0u; cnt = 0u; mine = 0u;
#pragma unroll
        for (unsigned j = 0; j < 16; ++j) { const unsigned c = xb_ld(&bar[XB_XCNT(j)]); sum += c; cnt += (c > 0u) ? 1u : 0u; mine = (j == x) ? c : mine; }
        if (sum == G) break;
        __builtin_amdgcn_s_sleep(1);
        if ((++sp & 255u) == 0u) { if (xb_ld(&bar[XB_TMO])) break; if (sp > XB_SPIN_CAP) { atomicAdd(&bar[XB_TMO], 1u); break; } }
    }
    nloc = mine > 0u ? mine : 1u; nx = cnt > 0u ? cnt : 1u;
}
__device__ __forceinline__ void xcd_barrier(const XcdBarrier& b) {
    asm volatile("s_waitcnt vmcnt(0)" ::: "memory");
    __syncthreads();
    if (threadIdx.x == 0) {
        unsigned* bar = b.bar;
        __builtin_amdgcn_s_waitcnt(0);
        unsigned nloc = b.st[0], nx = b.st[1];
        if (nloc == 0u) { xcd_barrier_complete(bar, b.x, nloc, nx); b.st[0] = nloc; b.st[1] = nx; }
        const unsigned old = xb_add(&bar[XB_XSUB(b.x)], 1u);
        const unsigned gen = old / nloc;
        if (old + 1u == (gen + 1u) * nloc) {
            __builtin_amdgcn_fence(__ATOMIC_RELEASE, "agent");
            asm volatile("s_waitcnt vmcnt(0)" ::: "memory");
            const unsigned og = xb_add(&bar[XB_TOP], 1u);
            const unsigned tg = og / nx;
            if (og + 1u == (tg + 1u) * nx) xb_add(&bar[XB_TOPGEN], 1u);
            else XB_SPIN(xb_ld(&bar[XB_TOPGEN]) == tg, bar);
            __builtin_amdgcn_fence(__ATOMIC_ACQUIRE, "agent");
            xb_add(&bar[XB_XGEN(b.x)], 1u);
            asm volatile("s_waitcnt vmcnt(0)" ::: "memory");
        } else {
            XB_SPIN(xb_ld(&bar[XB_XGEN(b.x)]) == gen, bar);
            __builtin_amdgcn_fence(__ATOMIC_ACQUIRE, "agent");
            asm volatile("s_waitcnt vmcnt(0)" ::: "memory");
        }
    }
    __syncthreads();
}

namespace pg8 {
constexpr int BM = 256, BK = 64, HALF = 128, HTB = HALF * BK * 2, STAGE_BYTES = 8 * HTB, NXCD = 8, WGM = 8;
__host__ __device__ __forceinline__ int lds_byte(int r, int c) { const int st = (r >> 4) * 2 + (c >> 5), rr = r & 15, cc = c & 31, ob = rr * 64 + cc * 2; return st * 1024 + (ob ^ (((ob >> 9) & 1) << 5)); }
__host__ __device__ __forceinline__ void stage_rc(int b, int& R, int& C) { const int st = b / 1024, sb = b % 1024, swz = sb ^ (((sb >> 9) & 1) << 5); R = (st >> 1) * 16 + swz / 64; C = (st & 1) * 32 + (swz % 64) / 2; }
__host__ __device__ __forceinline__ int perm32(int rho) { const int n = rho >> 4, i = rho & 15; return 8 * (i >> 2) + 4 * n + (i & 3); }

struct Unit { int pm, pn; };
struct Gemm { const bf16_t* A; const bf16_t* Bt; int K, lda, ldb, a_pn_shift, a_pn_stride, mid_t; };

struct StaticOrder {
    int nM, nN, nwg, G, c;
    __device__ void init(int M, int N, int G_, int c_) { nM = M / BM; nN = N / BM; nwg = nM * nN; G = G_; c = c_; }
    __device__ bool next(int i, Unit& u) const {
        const long L = (long)i * G + c; if (L >= nwg) return false;
        int wgid = (int)L; { const int q = nwg / NXCD, r = nwg % NXCD, xcd = wgid % NXCD, off = wgid / NXCD; wgid = (xcd < r ? xcd * (q + 1) : r * (q + 1) + (xcd - r) * q) + off; }
        const int nig = WGM * nN, gid = wgid / nig, fm = gid * WGM, gsz = (nM - fm) < WGM ? (nM - fm) : WGM;
        u.pm = fm + ((wgid % nig) % gsz); u.pn = (wgid % nig) / gsz; return true;
    }
};
__device__ __forceinline__ unsigned cvt_pk_bf16(float lo, float hi) { unsigned r; asm volatile("v_cvt_pk_bf16_f32 %0, %1, %2" : "=v"(r) : "v"(lo), "v"(hi)); return r; }

struct EpiBf16 {
    static constexpr bool PERM = true;
    bf16_t* O; int ldc;
    __device__ __forceinline__ void operator()(const f32x4 (&acc)[2][2][4][2], const Unit& u, int wr, int wc, int fr, int fq) const {
        const int row0 = u.pm * BM + wr * 64 + fr, col0 = u.pn * BM + wc * 32 + 8 * fq;
#pragma unroll
        for (int ai = 0; ai < 2; ++ai)
#pragma unroll
            for (int m = 0; m < 4; ++m) { bf16_t* rowp = O + (size_t)(row0 + ai * HALF + m * 16) * ldc + col0;
#pragma unroll
                for (int bj = 0; bj < 2; ++bj) { const f32x4 v0 = acc[ai][bj][m][0], v1 = acc[ai][bj][m][1];
                    u32x4 w; w.x = cvt_pk_bf16(v0[0], v0[1]); w.y = cvt_pk_bf16(v0[2], v0[3]); w.z = cvt_pk_bf16(v1[0], v1[1]); w.w = cvt_pk_bf16(v1[2], v1[3]);
                    *(u32x4*)(rowp + bj * HALF) = w; } }
    }
};
struct EpiG1 {
    static constexpr bool PERM = true;
    bf16_t* P; const float* bg; bf16_t* RT; bf16_t* GRS; const float* rope;
    __device__ __forceinline__ void operator()(const f32x4 (&acc)[2][2][4][2], const Unit& u, int wr, int wc, int fr, int fq) const {
        const int row0 = u.pm * BM + wr * 64 + fr, cw = wc * 32 + 8 * fq;
        if (u.pn >= 28) {
            const int ch = 128 * (u.pn - 28) + cw;
            const f32x4 bm0 = *(const f32x4*)(bg + ch), bm1 = *(const f32x4*)(bg + ch + 4), br0 = *(const f32x4*)(bg + 2048 + ch), br1 = *(const f32x4*)(bg + 2048 + ch + 4);
#pragma unroll
            for (int ai = 0; ai < 2; ++ai)
#pragma unroll
                for (int m = 0; m < 4; ++m) { const size_t row = (size_t)(row0 + ai * HALF + m * 16);
                    const f32x4 vm0 = acc[ai][0][m][0] + bm0, vm1 = acc[ai][0][m][1] + bm1, vr0 = acc[ai][1][m][0] + br0, vr1 = acc[ai][1][m][1] + br1;
                    float rt[8], gr[8];
#pragma unroll
                    for (int j = 0; j < 4; ++j) {
                        const float er0 = 1.0f + __expf(-vr0[j]), er1 = 1.0f + __expf(-vr1[j]);
                        rt[j] = er0 * __builtin_amdgcn_rcpf(1.0f + __expf(-vm0[j])); rt[4 + j] = er1 * __builtin_amdgcn_rcpf(1.0f + __expf(-vm1[j]));
                        gr[j] = __builtin_amdgcn_rcpf(er0); gr[4 + j] = __builtin_amdgcn_rcpf(er1); }
                    u32x4 w; w.x = cvt_pk_bf16(rt[0], rt[1]); w.y = cvt_pk_bf16(rt[2], rt[3]); w.z = cvt_pk_bf16(rt[4], rt[5]); w.w = cvt_pk_bf16(rt[6], rt[7]);
                    *(u32x4*)(RT + row * 2048 + ch) = w;
                    w.x = cvt_pk_bf16(gr[0], gr[1]); w.y = cvt_pk_bf16(gr[2], gr[3]); w.z = cvt_pk_bf16(gr[4], gr[5]); w.w = cvt_pk_bf16(gr[6], gr[7]);
                    *(u32x4*)(GRS + row * 2048 + ch) = w; }
        } else if (u.pn >= 12 && u.pn < 20) {
            const float sc = u.pn >= 16 ? 0.0625f : 1.0f;
#pragma unroll
            for (int ai = 0; ai < 2; ++ai)
#pragma unroll
                for (int m = 0; m < 4; ++m) { const int row = row0 + ai * HALF + m * 16;
                    const int pi = row < MP ? (row & (SEQ - 1)) : 2048;
                    const f32x4* cs = (const f32x4*)(rope + ((size_t)pi * 128 + cw) * 2);
                    const f32x4 t0 = cs[0], t1 = cs[1], t2 = cs[2], t3 = cs[3];
                    const f32x4 a0 = acc[ai][0][m][0], a1 = acc[ai][0][m][1], b0 = acc[ai][1][m][0], b1 = acc[ai][1][m][1];
                    const float c[8] = {t0[0], t0[2], t1[0], t1[2], t2[0], t2[2], t3[0], t3[2]}, sn[8] = {t0[1], t0[3], t1[1], t1[3], t2[1], t2[3], t3[1], t3[3]};
                    const float x1[8] = {a0[0], a0[1], a0[2], a0[3], a1[0], a1[1], a1[2], a1[3]}, x2[8] = {b0[0], b0[1], b0[2], b0[3], b1[0], b1[1], b1[2], b1[3]};
                    float o1[8], o2[8];
#pragma unroll
                    for (int j = 0; j < 8; ++j) { o1[j] = (x1[j] * c[j] - x2[j] * sn[j]) * sc; o2[j] = (x1[j] * sn[j] + x2[j] * c[j]) * sc; }
                    bf16_t* rowp = P + (size_t)row * NP + u.pn * BM + cw;
                    u32x4 w; w.x = cvt_pk_bf16(o1[0], o1[1]); w.y = cvt_pk_bf16(o1[2], o1[3]); w.z = cvt_pk_bf16(o1[4], o1[5]); w.w = cvt_pk_bf16(o1[6], o1[7]);
                    *(u32x4*)rowp = w;
                    w.x = cvt_pk_bf16(o2[0], o2[1]); w.y = cvt_pk_bf16(o2[2], o2[3]); w.z = cvt_pk_bf16(o2[4], o2[5]); w.w = cvt_pk_bf16(o2[6], o2[7]);
                    *(u32x4*)(rowp + HALF) = w; }
        } else {
#pragma unroll
            for (int ai = 0; ai < 2; ++ai)
#pragma unroll
                for (int m = 0; m < 4; ++m) { bf16_t* rowp = P + (size_t)(row0 + ai * HALF + m * 16) * NP + u.pn * BM + cw;
#pragma unroll
                    for (int bj = 0; bj < 2; ++bj) { const f32x4 v0 = acc[ai][bj][m][0], v1 = acc[ai][bj][m][1];
                        u32x4 w; w.x = cvt_pk_bf16(v0[0], v0[1]); w.y = cvt_pk_bf16(v0[2], v0[3]); w.z = cvt_pk_bf16(v1[0], v1[1]); w.w = cvt_pk_bf16(v1[2], v1[3]);
                        *(u32x4*)(rowp + bj * HALF) = w; } }
        }
    }
};
struct EpiMerged {
    static constexpr bool PERM = true;
    bf16_t* O; const bf16_t* RT; const bf16_t* GRS;
    __device__ __forceinline__ void scale(f32x4 (&acc)[2][2][4][2], const bf16_t* S, const Unit& u, int wr, int wc, int fr, int fq) const {
        asm volatile("" : "+v"(fr), "+v"(fq));
        const int row0 = u.pm * BM + wr * 64 + fr, col0 = u.pn * BM + wc * 32 + 8 * fq;
#pragma unroll
        for (int ai = 0; ai < 2; ++ai) {
            u32x4 sv[4][2];
#pragma unroll
            for (int m = 0; m < 4; ++m)
#pragma unroll
                for (int bj = 0; bj < 2; ++bj) sv[m][bj] = *(const u32x4*)(S + (size_t)(row0 + ai * HALF + m * 16) * 2048 + col0 + bj * HALF);
#pragma unroll
            for (int m = 0; m < 4; ++m)
#pragma unroll
                for (int bj = 0; bj < 2; ++bj) { const u32x4 a = sv[m][bj];
                    acc[ai][bj][m][0][0] *= __uint_as_float(a.x << 16); acc[ai][bj][m][0][1] *= __uint_as_float(a.x & 0xffff0000u);
                    acc[ai][bj][m][0][2] *= __uint_as_float(a.y << 16); acc[ai][bj][m][0][3] *= __uint_as_float(a.y & 0xffff0000u);
                    acc[ai][bj][m][1][0] *= __uint_as_float(a.z << 16); acc[ai][bj][m][1][1] *= __uint_as_float(a.z & 0xffff0000u);
                    acc[ai][bj][m][1][2] *= __uint_as_float(a.w << 16); acc[ai][bj][m][1][3] *= __uint_as_float(a.w & 0xffff0000u); }
        }
    }
    __device__ __forceinline__ void mid(f32x4 (&acc)[2][2][4][2], const Unit& u, int wr, int wc, int fr, int fq) const { scale(acc, RT, u, wr, wc, fr, fq); }
    __device__ __forceinline__ void operator()(f32x4 (&acc)[2][2][4][2], const Unit& u, int wr, int wc, int fr, int fq) const {
        scale(acc, GRS, u, wr, wc, fr, fq);
        const int row0 = u.pm * BM + wr * 64 + fr, col0 = u.pn * BM + wc * 32 + 8 * fq;
#pragma unroll
        for (int ai = 0; ai < 2; ++ai)
#pragma unroll
            for (int m = 0; m < 4; ++m) { bf16_t* rowp = O + (size_t)(row0 + ai * HALF + m * 16) * 2048 + col0;
#pragma unroll
                for (int bj = 0; bj < 2; ++bj) { const f32x4 v0 = acc[ai][bj][m][0], v1 = acc[ai][bj][m][1];
                    u32x4 w; w.x = cvt_pk_bf16(v0[0], v0[1]); w.y = cvt_pk_bf16(v0[2], v0[3]); w.z = cvt_pk_bf16(v1[0], v1[1]); w.w = cvt_pk_bf16(v1[2], v1[3]);
                    *(u32x4*)(rowp + bj * HALF) = w; } }
    }
};
struct EpiResidual {
    static constexpr bool PERM = false;
    float* X;
    __device__ __forceinline__ void operator()(f32x4 (&acc)[2][2][4][2], const Unit& u, int wr, int wc, int fr, int fq) const {
        const int row0 = u.pm * BM + wr * 64 + fr, col0 = u.pn * BM + wc * 32 + 4 * fq;
#pragma unroll
        for (int ai = 0; ai < 2; ++ai) {
            f32x4 xv[4][2][2];
#pragma unroll
            for (int m = 0; m < 4; ++m)
#pragma unroll
                for (int bj = 0; bj < 2; ++bj)
#pragma unroll
                    for (int n = 0; n < 2; ++n) xv[m][bj][n] = *(const f32x4*)(X + (size_t)(row0 + ai * HALF + m * 16) * 2048 + col0 + bj * HALF + n * 16);
#pragma unroll
            for (int m = 0; m < 4; ++m)
#pragma unroll
                for (int bj = 0; bj < 2; ++bj)
#pragma unroll
                    for (int n = 0; n < 2; ++n) *(f32x4*)(X + (size_t)(row0 + ai * HALF + m * 16) * 2048 + col0 + bj * HALF + n * 16) = xv[m][bj][n] + acc[ai][bj][m][n];
        }
    }
};

template <bool MID, class Epi, class Sched, bool ALIGN_EPI = true>
__device__ __forceinline__ void gemm_phase(LAS unsigned char* lds, const Gemm g, const Sched& S, const Epi& E) {
    const int tid = opaque_tid(), wid = __builtin_amdgcn_readfirstlane(tid >> 6), lane = tid & 63, wr = wid >> 2, wc = wid & 3, fr = lane & 15, fq = lane >> 4;
    const int K = g.K, nt = K / BK;
    unsigned voffA[2], voffB[2];
#pragma unroll
    for (int i = 0; i < 2; ++i) { int R, C; stage_rc(tid * 16 + i * 8192, R, C); const int Rb = Epi::PERM ? ((R & ~31) + perm32(R & 31)) : R;
        voffA[i] = (unsigned)(R * g.lda + C) * 2u; voffB[i] = (unsigned)(Rb * g.ldb + C) * 2u; }
    const size_t kstep = (size_t)(BK * 2);
    const size_t hstepA = (size_t)HALF * g.lda * 2, hstepB = (size_t)HALF * g.ldb * 2;
    const size_t tstepA = 2 * hstepA, tstepB = 2 * hstepB;
    const unsigned ldsw = (unsigned)wid * 1024u;
    const int aoff = lds_byte(wr * 64 + fr, fq * 8), boff = lds_byte(wc * 32 + fr, fq * 8);
#define PG8_SA(b, h) (((b) * 2 + (h)) * HTB)
#define PG8_SB(b, h) ((4 + (b) * 2 + (h)) * HTB)
#define PG8_STAGE(bufoff, gbase, voff) do { _Pragma("unroll") for (int _i = 0; _i < 2; ++_i) \
        __builtin_amdgcn_global_load_lds((const unsigned*)((const char*)(gbase) + (voff)[_i]), (LAS unsigned*)(lds + (bufoff) + ldsw + _i * 8192), 16, 0, 0); } while (0)
#define PG8_LDA(dst, b, h) do { _Pragma("unroll") for (int m = 0; m < 4; ++m) _Pragma("unroll") for (int k = 0; k < 2; ++k) dst[m][k] = *(const LAS bf16x8*)(lds + PG8_SA(b, h) + aoff + m * 2048 + k * 1024); } while (0)
#define PG8_LDB(dst, b, h) do { _Pragma("unroll") for (int n = 0; n < 2; ++n) _Pragma("unroll") for (int k = 0; k < 2; ++k) dst[n][k] = *(const LAS bf16x8*)(lds + PG8_SB(b, h) + boff + n * 2048 + k * 1024); } while (0)
#define PG8_MMA(ai, bj, At, Bt) do { __builtin_amdgcn_s_setprio(1); _Pragma("unroll") for (int m = 0; m < 4; ++m) _Pragma("unroll") for (int n = 0; n < 2; ++n) _Pragma("unroll") for (int k = 0; k < 2; ++k) \
        acc[ai][bj][m][n] = __builtin_amdgcn_mfma_f32_16x16x32_bf16(Bt[n][k], At[m][k], acc[ai][bj][m][n], 0, 0, 0); __builtin_amdgcn_s_setprio(0); } while (0)
#define PG8_WAIT_V(n) asm volatile("s_waitcnt vmcnt(" #n ")" ::: "memory")
#define PG8_WAIT_L(n) asm volatile("s_waitcnt lgkmcnt(" #n ")" ::: "memory")
#define PG8_BAR __builtin_amdgcn_s_barrier()
#define PG8_SCHED __builtin_amdgcn_sched_barrier(0)
#define PG8_APTR(u) ((const char*)g.A + (size_t)(u).pm * tstepA + (size_t)((u).pn >> g.a_pn_shift) * (size_t)g.a_pn_stride)
    Unit cur, nxt; int ui = 0;
    if (!S.next(0, cur)) return;
    f32x4 acc[2][2][4][2];
#pragma unroll
    for (int a = 0; a < 2; ++a)
#pragma unroll
        for (int b = 0; b < 2; ++b)
#pragma unroll
            for (int m = 0; m < 4; ++m)
#pragma unroll
                for (int n = 0; n < 2; ++n) acc[a][b][m][n] = (f32x4){0.f, 0.f, 0.f, 0.f};
    bf16x8 At[4][2], B0[2][2], B1[2][2];
    const char* cA = PG8_APTR(cur); const char* cB = (const char*)g.Bt + (size_t)cur.pn * tstepB;
    PG8_STAGE(PG8_SB(0, 0), cB, voffB); PG8_STAGE(PG8_SB(0, 1), cB + hstepB, voffB); PG8_STAGE(PG8_SA(0, 0), cA, voffA); PG8_STAGE(PG8_SA(0, 1), cA + hstepA, voffA);
    if (wr == 1) PG8_BAR;
    PG8_WAIT_V(2); PG8_BAR;
    PG8_STAGE(PG8_SB(1, 0), cB + kstep, voffB); PG8_STAGE(PG8_SA(1, 0), cA + kstep, voffA); PG8_STAGE(PG8_SB(1, 1), cB + hstepB + kstep, voffB);
    PG8_WAIT_V(6); PG8_BAR;
    for (;;) {
        const bool has_next = S.next(ui + 1, nxt);
        const char* nA = has_next ? PG8_APTR(nxt) : cA; const char* nB = has_next ? (const char*)g.Bt + (size_t)nxt.pn * tstepB : cB;
#pragma unroll 1
        for (int t = 0; t < nt; t += 2) {
            const bool last = (t == nt - 2);
            const char* a1 = cA + (size_t)(t + 1) * kstep;
            const char* a2 = last ? nA : cA + (size_t)(t + 2) * kstep; const char* b2 = last ? nB : cB + (size_t)(t + 2) * kstep;
            const char* a3 = a2 + kstep; const char* b3 = b2 + kstep;
            if constexpr (MID) { if (t == g.mid_t) E.mid(acc, cur, wr, wc, fr, fq); }
            PG8_LDB(B0, 0, 0); PG8_LDB(B1, 0, 1); PG8_SCHED; PG8_LDA(At, 0, 0); PG8_STAGE(PG8_SA(1, 1), a1 + hstepA, voffA);
            PG8_WAIT_V(8); PG8_WAIT_L(0); PG8_BAR; PG8_MMA(0, 0, At, B0); PG8_MMA(0, 1, At, B1); PG8_BAR; PG8_SCHED;
            PG8_LDA(At, 0, 1); PG8_STAGE(PG8_SB(0, 0), b2, voffB); PG8_STAGE(PG8_SB(0, 1), b2 + hstepB, voffB); PG8_STAGE(PG8_SA(0, 0), a2, voffA);
            PG8_WAIT_V(8); PG8_WAIT_L(0); PG8_BAR; PG8_MMA(1, 0, At, B0); PG8_MMA(1, 1, At, B1); PG8_BAR; PG8_SCHED;
            PG8_LDB(B0, 1, 0); PG8_LDB(B1, 1, 1); PG8_SCHED; PG8_LDA(At, 1, 0); PG8_STAGE(PG8_SA(0, 1), a2 + hstepA, voffA);
            PG8_WAIT_V(8); PG8_WAIT_L(0); PG8_BAR; PG8_MMA(0, 0, At, B0); PG8_MMA(0, 1, At, B1); PG8_BAR; PG8_SCHED;
            PG8_LDA(At, 1, 1); PG8_STAGE(PG8_SB(1, 0), b3, voffB); PG8_STAGE(PG8_SB(1, 1), b3 + hstepB, voffB); PG8_STAGE(PG8_SA(1, 0), a3, voffA);
            PG8_WAIT_V(8); PG8_WAIT_L(0); PG8_BAR; PG8_MMA(1, 0, At, B0); PG8_MMA(1, 1, At, B1); PG8_BAR; PG8_SCHED;
        }
        if constexpr (ALIGN_EPI) { if (wr == 0) PG8_BAR; }
        E(acc, cur, wr, wc, fr, fq);
        if (!has_next) break;
#pragma unroll
        for (int a = 0; a < 2; ++a)
#pragma unroll
            for (int b = 0; b < 2; ++b)
#pragma unroll
                for (int m = 0; m < 4; ++m)
#pragma unroll
                    for (int n = 0; n < 2; ++n) acc[a][b][m][n] = (f32x4){0.f, 0.f, 0.f, 0.f};
        cur = nxt; cA = nA; cB = nB; ++ui;
        if constexpr (ALIGN_EPI) { if (wr == 1) PG8_BAR; }
    }
    PG8_WAIT_V(0);
    if constexpr (!ALIGN_EPI) { if (wr == 0) PG8_BAR; }
    PG8_BAR;
#undef PG8_SA
#undef PG8_SB
#undef PG8_STAGE
#undef PG8_LDA
#undef PG8_LDB
#undef PG8_MMA
#undef PG8_WAIT_V
#undef PG8_WAIT_L
#undef PG8_BAR
#undef PG8_SCHED
#undef PG8_APTR
}
}

__device__ __forceinline__ void tr_tile(const float* src, int ldsrc, int k0, int c0, bf16_t* dst, int ldd, int r0, int kd0, float scale, LAS float* t, int lane) {
    f32x4 v[16];
#pragma unroll
    for (int i = 0; i < 16; ++i) v[i] = __builtin_nontemporal_load((const f32x4*)(src + (size_t)(k0 + (lane >> 4) + 4 * i) * ldsrc + c0 + 4 * (lane & 15)));
#pragma unroll
    for (int i = 0; i < 16; ++i)
#pragma unroll
        for (int j = 0; j < 4; ++j) t[((lane >> 4) + 4 * i) * 65 + 4 * (lane & 15) + j] = v[i][j];
    const int c = lane & 7;
#pragma unroll
    for (int j = 0; j < 8; ++j) { const int n = (lane >> 3) + 8 * j; const LAS float* q = t + (8 * c) * 65 + n;
        u32x4 o; o.x = pk2(scale * q[0], scale * q[65]); o.y = pk2(scale * q[130], scale * q[195]); o.z = pk2(scale * q[260], scale * q[325]); o.w = pk2(scale * q[390], scale * q[455]);
        *(u32x4*)(dst + (size_t)(r0 + n) * ldd + kd0 + 8 * c) = o; }
}
__device__ __forceinline__ void prep_phase(const Params& p, int wg, int nwg, LAS unsigned char* lds) {
    const int tid = opaque_tid();
    for (size_t i = (size_t)wg * 512 + tid; i < (size_t)MPAD * D / 4; i += (size_t)nwg * 512) {
        const size_t row = (i * 4) / D;
        f32x4 v = (f32x4){0.f, 0.f, 0.f, 0.f};
        if (row < (size_t)MP) v = ((const f32x4*)p.x_prompt)[i];
        else if (row < (size_t)MT) v = ((const f32x4*)p.x_sample)[i - (size_t)MP * D / 4];
        ((f32x4*)p.X)[i] = v;
    }
    for (int i = wg * 512 + tid; i < 2049 * 128; i += nwg * 512) {
        const int pi = i >> 7, j = i & 127;
        const float pos = pi < 2048 ? (float)pi : 16384.0f;
        const float inv = powf(10000.0f, -((float)j / 128.0f));
        const float ang = pos * inv;
        p.ROPE[2 * i] = (float)cos((double)ang); p.ROPE[2 * i + 1] = (float)sin((double)ang);
    }
    for (int i = wg * 512 + tid; i < DEPTH * 8 * D; i += nwg * 512) {
        const int l = i / (8 * D), r = i % (8 * D), j = r / D, k = r % D;
        p.WIF[i] = p.w_in[((size_t)l * D + k) * NIN + 3072 + j];
    }
    const int lane = tid & 63, wid = tid >> 6;
    LAS float* t = (LAS float*)lds + wid * (64 * 65);
    constexpr int T0 = 1536, T1 = T0 + 2048, T2 = T1 + 2048, T3 = T2 + 512, T4 = T3 + 512, T5 = T4 + 1024, T6 = T5 + 64, T7 = T6 + 64;
    for (int it = wg * 8 + wid; it < DEPTH * T7; it += nwg * 8) {
        const int l = it / T7, r = it % T7;
        bf16_t* Wl = p.W + (size_t)l * WL;
        if (r < T0)      { const int q = r;      tr_tile(p.w_in + (size_t)l * D * NIN, NIN, (q & 31) * 64, (q >> 5) * 64, Wl + W1_OFF, D, (q >> 5) * 64, (q & 31) * 64, 1.f, t, lane); }
        else if (r < T1) { const int q = r - T0; tr_tile(p.w_in + (size_t)l * D * NIN, NIN, (q & 31) * 64, 3080 + (q >> 5) * 64, Wl + W1_OFF, D, 3072 + (q >> 5) * 64, (q & 31) * 64, 1.f, t, lane); }
        else if (r < T2) { const int q = r - T1; const int ct = q >> 5, c0 = (((ct & 3) < 2) ? 0 : 2048) + 128 * (ct >> 2) + (ct & 1) * 64;
                           tr_tile(p.w_gate + (size_t)l * D * 4096, 4096, (q & 31) * 64, c0, Wl + W1_OFF, D, C_GM + ct * 64, (q & 31) * 64, 1.f, t, lane); }
        else if (r < T3) { const int q = r - T2; tr_tile(p.w_pm + (size_t)l * WM * D, D, (q & 15) * 64, (q >> 4) * 64, Wl + W3_OFF, D, (q >> 4) * 64, (q & 15) * 64, 1.f, t, lane); }
        else if (r < T4) { const int q = r - T3; tr_tile(p.w_pr + (size_t)l * WM * D, D, (q & 15) * 64, (q >> 4) * 64, Wl + W3_OFF, D, (q >> 4) * 64, 1024 + (q & 15) * 64, 1.f, t, lane); }
        else if (r < T5) { const int q = r - T4; tr_tile(p.w_o + (size_t)l * D * D, D, (q & 31) * 64, (q >> 5) * 64, Wl + W4_OFF, D, (q >> 5) * 64, (q & 31) * 64, 1.f, t, lane); }
        else if (r < T6) { const int q = r - T5, h = q >> 4, qq = q & 15; tr_tile(p.w_qm + ((size_t)l * HM + h) * SZ, DH, (qq & 3) * 64, (qq >> 2) * 64, Wl + W2_OFF, DH, h * 512 + (qq >> 2) * 64, (qq & 3) * 64, 0.0625f, t, lane); }
        else             { const int q = r - T6, h = q >> 4, qq = q & 15; tr_tile(p.w_km + ((size_t)l * HM + h) * SZ, DH, (qq & 3) * 64, (qq >> 2) * 64, Wl + W2_OFF, DH, h * 512 + 256 + (qq >> 2) * 64, (qq & 3) * 64, 1.f, t, lane); }
    }
}

__device__ __forceinline__ void norm_phase(const Params& p, int layer, int wg, int nwg, LAS unsigned char* lds) {
    const int tid_ = opaque_tid(), lane = tid_ & 63, wid = tid_ >> 6;
    const f32x4* g4 = (const f32x4*)(p.norm_g + (size_t)layer * D);
    const float* wif = p.WIF + (size_t)layer * 8 * D;
    LAS f32x4* wl = (LAS f32x4*)lds;
#pragma unroll
    for (int i = 0; i < 8; ++i) wl[tid_ + 512 * i] = ((const f32x4*)wif)[tid_ + 512 * i];
    __syncthreads();
    for (int row = wg * 8 + wid; row < MPAD; row += nwg * 8) {
        u32x2* hrow = (u32x2*)(p.H + (size_t)row * D);
        if (row >= MT) {
#pragma unroll
            for (int i = 0; i < 8; ++i) hrow[lane + 64 * i] = (u32x2){0u, 0u};
            continue;
        }
        const f32x4* xr = (const f32x4*)(p.X + (size_t)row * D);
        f32x4 v[8]; float ss = 0.f;
#pragma unroll
        for (int i = 0; i < 8; ++i) { v[i] = xr[lane + 64 * i]; ss += (v[i][0] * v[i][0] + v[i][1] * v[i][1]) + (v[i][2] * v[i][2] + v[i][3] * v[i][3]); }
        ss = wave_sum(ss);
        const float rstd = rsqrtf(ss * (1.0f / D) + EPS);
#pragma unroll
        for (int i = 0; i < 8; ++i) {
            v[i] = v[i] * rstd * g4[lane + 64 * i];
            hrow[lane + 64 * i] = (u32x2){pk2(v[i][0], v[i][1]), pk2(v[i][2], v[i][3])};
        }
#pragma unroll 1
        for (int j = 0; j < 8; ++j) {
            float s = 0.f;
#pragma unroll
            for (int i = 0; i < 8; ++i) { const f32x4 w = wl[j * 512 + lane + 64 * i]; s += (v[i][0] * w[0] + v[i][1] * w[1]) + (v[i][2] * w[2] + v[i][3] * w[3]); }
            s = wave_sum(s);
            if (lane == 0) p.IF[(size_t)row * 8 + j] = s;
        }
    }
}
__device__ __forceinline__ void final_phase(const Params& p, int wg, int nwg) {
    const int tid_ = opaque_tid(), lane = tid_ & 63, wid = tid_ >> 6;
    const f32x4* g4 = (const f32x4*)p.final_g;
    for (int row = wg * 8 + wid; row < MT; row += nwg * 8) {
        const f32x4* xr = (const f32x4*)(p.X + (size_t)row * D);
        f32x4* yr = (f32x4*)(p.out + (row < MP ? O_YP + (size_t)row * D : O_YS + (size_t)(row - MP) * D));
        f32x4 v[8]; float ss = 0.f;
#pragma unroll
        for (int i = 0; i < 8; ++i) { v[i] = xr[lane + 64 * i]; ss += (v[i][0] * v[i][0] + v[i][1] * v[i][1]) + (v[i][2] * v[i][2] + v[i][3] * v[i][3]); }
        ss = wave_sum(ss);
        const float rstd = rsqrtf(ss * (1.0f / D) + EPS);
#pragma unroll
        for (int i = 0; i < 8; ++i) yr[lane + 64 * i] = v[i] * rstd * g4[lane + 64 * i];
    }
}

__device__ __forceinline__ void unpack8(const u32x4 v, float (&f)[8]) {
    f[0] = __uint_as_float(v.x << 16); f[1] = __uint_as_float(v.x & 0xffff0000u); f[2] = __uint_as_float(v.y << 16); f[3] = __uint_as_float(v.y & 0xffff0000u);
    f[4] = __uint_as_float(v.z << 16); f[5] = __uint_as_float(v.z & 0xffff0000u); f[6] = __uint_as_float(v.w << 16); f[7] = __uint_as_float(v.w & 0xffff0000u);
}
__device__ __forceinline__ u32x4 pack8(const float (&f)[8]) { u32x4 w; w.x = pk2(f[0], f[1]); w.y = pk2(f[2], f[3]); w.z = pk2(f[4], f[5]); w.w = pk2(f[6], f[7]); return w; }

__device__ __forceinline__ void conv_phase(const Params& p, int layer, int wg, int nwg) {
    const int tid = opaque_tid();
    const float* cw = p.conv_w + (size_t)layer * 4 * WM;
    const float* cb = p.conv_b + (size_t)layer * WM;
    for (int it = wg * 512 + tid; it < MT * 128; it += nwg * 512) {
        const int row = it >> 7, ch = (it & 127) * 8;
        float up[4][8];
        if (row < MP) {
            const int t = row & (SEQ - 1);
#pragma unroll
            for (int i = 0; i < 4; ++i) {
                if (t - 3 + i >= 0) unpack8(*(const u32x4*)(p.P + (size_t)(row - 3 + i) * NP + C_U + ch), up[i]);
                else {
#pragma unroll
                    for (int j = 0; j < 8; ++j) up[i][j] = 0.f;
                }
            }
            if (t >= SEQ - 3) {
                const int b = row >> 11;
                float* o = p.out + O_CVP + (((size_t)layer * BP + b) * 3 + (t - (SEQ - 3))) * WM + ch;
                *(f32x4*)o = (f32x4){up[3][0], up[3][1], up[3][2], up[3][3]}; *(f32x4*)(o + 4) = (f32x4){up[3][4], up[3][5], up[3][6], up[3][7]};
            }
        } else {
            const int b = row - MP;
            const float* hist = p.st_conv + ((size_t)layer * BS + b) * 3 * WM + ch;
#pragma unroll
            for (int i = 0; i < 3; ++i) { const f32x4 a = *(const f32x4*)(hist + (size_t)i * WM), c = *(const f32x4*)(hist + (size_t)i * WM + 4);
                up[i][0] = a[0]; up[i][1] = a[1]; up[i][2] = a[2]; up[i][3] = a[3]; up[i][4] = c[0]; up[i][5] = c[1]; up[i][6] = c[2]; up[i][7] = c[3]; }
            unpack8(*(const u32x4*)(p.P + (size_t)row * NP + C_U + ch), up[3]);
            float* o = p.out + O_CVS + ((size_t)layer * BS + b) * 3 * WM + ch;
#pragma unroll
            for (int i = 0; i < 3; ++i) { *(f32x4*)(o + (size_t)i * WM) = (f32x4){up[i + 1][0], up[i + 1][1], up[i + 1][2], up[i + 1][3]};
                *(f32x4*)(o + (size_t)i * WM + 4) = (f32x4){up[i + 1][4], up[i + 1][5], up[i + 1][6], up[i + 1][7]}; }
        }
        float r[8];
#pragma unroll
        for (int j = 0; j < 8; ++j) r[j] = cb[ch + j];
#pragma unroll
        for (int i = 0; i < 4; ++i)
#pragma unroll
            for (int j = 0; j < 8; ++j) r[j] += up[i][j] * cw[i * WM + ch + j];
#pragma unroll
        for (int j = 0; j < 8; ++j) r[j] = siluf_(r[j]);
        *(u32x4*)(p.CM + (size_t)row * WM + ch) = pack8(r);
    }
}

__device__ __forceinline__ void gate_scan(const Params& p, int layer, int b, int h, int c_own, LAS float* G) {
    const int tid = opaque_tid(), lane = tid & 63, wid = tid >> 6;
    const float bi = p.b_i[layer * HM + h], bfv = p.b_f[layer * HM + h];
#pragma unroll
    for (int q = 0; q < 2; ++q) {
        const int cc = wid + 8 * q;
        const size_t r0 = (size_t)b * SEQ + cc * 128 + 2 * lane;
        const float i0 = p.IF[r0 * 8 + h] + bi, i1 = p.IF[(r0 + 1) * 8 + h] + bi;
        const float l0 = logsigf_(p.IF[r0 * 8 + 4 + h] + bfv), l1 = logsigf_(p.IF[(r0 + 1) * 8 + 4 + h] + bfv);
        float inc = l0 + l1;
#pragma unroll
        for (int o = 1; o < 64; o <<= 1) { const float t = __shfl_up(inc, o); if (lane >= o) inc += t; }
        const float exc = inc - (l0 + l1);
        const float b0 = exc + l0, b1 = inc;
        const float g0 = i0 - b0, g1 = i1 - b1;
        const float gm = wave_max(fmaxf(g0, g1));
        const float Bc = __shfl(inc, 63);
        if (lane == 0) { G[cc] = Bc; G[16 + cc] = gm; }
        if (cc == c_own) {
            float rm = fmaxf(g0, g1);
#pragma unroll
            for (int o = 1; o < 64; o <<= 1) { const float t = __shfl_up(rm, o); if (lane >= o) rm = fmaxf(rm, t); }
            float ex = __shfl_up(rm, 1); if (lane == 0) ex = -3.0e38f;
            const float c0 = fmaxf(ex, g0), c1 = fmaxf(c0, g1);
            G[64 + 2 * lane] = b0; G[65 + 2 * lane] = b1; G[192 + 2 * lane] = g0; G[193 + 2 * lane] = g1; G[320 + 2 * lane] = c0; G[321 + 2 * lane] = c1;
        }
    }
    __syncthreads();
    if (tid == 0) { float m = -1e30f; for (int cc = 0; cc < 16; ++cc) { G[32 + cc] = m; m = G[cc] + fmaxf(m, G[16 + cc]); } G[48] = m; }
    __syncthreads();
    if (c_own >= 0 && tid < 128) G[320 + tid] = fmaxf(G[320 + tid], G[32 + c_own]);
    __syncthreads();
}

template <int I> struct IC { static constexpr int value = I; };
template <int I, int N, class F> __device__ __forceinline__ void sfor(F&& f) { if constexpr (I < N) { f(IC<I>{}); sfor<I + 1, N>(f); } }

template <int CPR>
__device__ __forceinline__ void tile_load(u32x4 (&r)[8], const bf16_t* src, int ld_src, int tid) {
#pragma unroll
    for (int i = 0; i < 8; ++i) { const int id = tid + 512 * i, row = id / CPR, ch = id % CPR; r[i] = *(const u32x4*)(src + (size_t)row * ld_src + ch * 8); }
}
template <int CPR, int LDB>
__device__ __forceinline__ void tile_store(LAS unsigned char* dst, const u32x4 (&r)[8], int tid) {
#pragma unroll
    for (int i = 0; i < 8; ++i) { const int id = tid + 512 * i, row = id / CPR, ch = id % CPR; *(LAS u32x4*)(dst + row * LDB + ch * 16) = r[i]; }
}
__device__ __forceinline__ void tile_store_w(LAS unsigned char* dst, const u32x4 (&r)[8], LAS const float* w, int tid) {
#pragma unroll
    for (int i = 0; i < 8; ++i) { const int id = tid + 512 * i, row = id >> 5, ch = id & 31; float f[8]; unpack8(r[i], f); const float ww = w[row];
#pragma unroll
        for (int j = 0; j < 8; ++j) f[j] *= ww;
        *(LAS u32x4*)(dst + row * 544 + ch * 16) = pack8(f); }
}
template <int OFF, int HS>
__device__ __forceinline__ bf16x8 tr_frag1(unsigned base) {
    u32x2 l0, h0;
    asm volatile("ds_read_b64_tr_b16 %0, %2 offset:%3\n\tds_read_b64_tr_b16 %1, %2 offset:%4\n\ts_waitcnt lgkmcnt(0)"
                 : "=&v"(l0), "=&v"(h0) : "v"(base), "i"(OFF), "i"(OFF + HS) : "memory");
    const u32x4 v = (u32x4){l0.x, l0.y, h0.x, h0.y};
    return __builtin_bit_cast(bf16x8, v);
}
template <int OFF, int HS, int TS>
__device__ __forceinline__ void tr_frag4(unsigned base, bf16x8 (&f)[4]) {
    u32x2 l0, l1, l2, l3, h0, h1, h2, h3;
    asm volatile("ds_read_b64_tr_b16 %0, %8 offset:%9\n\tds_read_b64_tr_b16 %4, %8 offset:%10\n\t"
                 "ds_read_b64_tr_b16 %1, %8 offset:%11\n\tds_read_b64_tr_b16 %5, %8 offset:%12\n\t"
                 "ds_read_b64_tr_b16 %2, %8 offset:%13\n\tds_read_b64_tr_b16 %6, %8 offset:%14\n\t"
                 "ds_read_b64_tr_b16 %3, %8 offset:%15\n\tds_read_b64_tr_b16 %7, %8 offset:%16\n\t"
                 "s_waitcnt lgkmcnt(0)"
                 : "=&v"(l0), "=&v"(l1), "=&v"(l2), "=&v"(l3), "=&v"(h0), "=&v"(h1), "=&v"(h2), "=&v"(h3)
                 : "v"(base), "i"(OFF), "i"(OFF + HS), "i"(OFF + TS), "i"(OFF + TS + HS), "i"(OFF + 2 * TS), "i"(OFF + 2 * TS + HS), "i"(OFF + 3 * TS), "i"(OFF + 3 * TS + HS)
                 : "memory");
    f[0] = __builtin_bit_cast(bf16x8, (u32x4){l0.x, l0.y, h0.x, h0.y}); f[1] = __builtin_bit_cast(bf16x8, (u32x4){l1.x, l1.y, h1.x, h1.y});
    f[2] = __builtin_bit_cast(bf16x8, (u32x4){l2.x, l2.y, h2.x, h2.y}); f[3] = __builtin_bit_cast(bf16x8, (u32x4){l3.x, l3.y, h3.x, h3.y});
}
__device__ __forceinline__ unsigned lds_addr(LAS const void* p) { return (unsigned)(size_t)p; }

template <int NR, int NC, bool WEIGHT>
__device__ __forceinline__ void stage_T(LAS unsigned char* dst, int ldd_bytes, const bf16_t* src, int ld_src, LAS const float* w) {
    const int tid_ = opaque_tid(), lane = tid_ & 63, wid = tid_ >> 6;
    constexpr int PB = NR / 128, CG = NC / 8;
#pragma unroll 1
    for (int task = wid; task < PB * CG; task += 8) {
        const int pb = task % PB, cg = task / PB, r = pb * 128 + 2 * lane;
        float a[8], c[8];
        unpack8(*(const u32x4*)(src + (size_t)r * ld_src + cg * 8), a); unpack8(*(const u32x4*)(src + (size_t)(r + 1) * ld_src + cg * 8), c);
        float w0 = 1.f, w1 = 1.f; if (WEIGHT) { w0 = w[r]; w1 = w[r + 1]; }
#pragma unroll
        for (int j = 0; j < 8; ++j) *(LAS unsigned*)(dst + (cg * 8 + j) * ldd_bytes + r * 2) = pk2(a[j] * w0, c[j] * w1);
    }
}
__device__ __forceinline__ void stage_rows(LAS unsigned char* dst, const bf16_t* src, int ld_src) {
    const int tid_ = opaque_tid();
#pragma unroll
    for (int i = 0; i < 8; ++i) { const int id = tid_ + 512 * i, row = id >> 5, ch = id & 31;
        *(LAS u32x4*)(dst + row * 528 + ch * 16) = *(const u32x4*)(src + (size_t)row * ld_src + ch * 8); }
}
__device__ __forceinline__ bf16x8 lds_frag(LAS const unsigned char* base, int row, int ld_bytes, int kbyte) { return *(LAS const bf16x8*)(base + row * ld_bytes + kbyte); }
__device__ __forceinline__ float ret_lg(int h) { return logf(1.0f - exp2f(-5.0f - (float)h)); }

template <int BR>
__device__ __forceinline__ void chunk_passA(const Params& p, int layer, int b, int h, int c, LAS unsigned char* lds) {
    LAS unsigned char* Xt = lds; LAS unsigned char* Yt = lds + 69632; LAS float* G = (LAS float*)(lds + 139264); LAS float* wk = G + 512;
    const int tid = opaque_tid(), lane = tid & 63, w = __builtin_amdgcn_readfirstlane(tid >> 6), g = lane >> 4, lr = lane & 15;
    const size_t row0 = (size_t)b * SEQ + c * 128;
    const int pi = BR * 16 + b * 4 + h;
    const bf16_t* Xp = BR == 0 ? p.QK + row0 * 2048 + h * 512 + 256 : p.P + row0 * NP + C_VR + h * 256;
    const bf16_t* Yp = BR == 0 ? p.P + row0 * NP + C_VM + h * 256 : p.P + row0 * NP + C_KR + h * 256;
    u32x4 xr[8], yr[8];
    tile_load<32>(xr, Xp, BR == 0 ? 2048 : NP, tid); tile_load<32>(yr, Yp, NP, tid);
    if (BR == 0) { gate_scan(p, layer, b, h, c, G); if (tid < 128) wk[tid] = expf(G[192 + tid] - G[320 + 127]); }
    else { if (tid < 128) wk[tid] = expf((float)(127 - tid) * ret_lg(h)); }
    __syncthreads();
    tile_store<32, 544>(Xt, xr, tid); tile_store_w(Yt, yr, wk, tid);
    __syncthreads();
    const unsigned lpart = (unsigned)(((8 * g + (lr >> 2)) * 272 + 4 * (lr & 3)) * 2);
    const unsigned baseX = lds_addr(Xt) + lpart + (unsigned)(32 * w * 2), baseY = lds_addr(Yt) + lpart;
    bf16_t* Uo = p.U + ((size_t)pi * 16 + c) * SZ;
    sfor<0, 2>([&](auto rt_) {
        constexpr int rt = decltype(rt_)::value;
        f32x4 acc[16];
#pragma unroll
        for (int j = 0; j < 16; ++j) acc[j] = (f32x4){0.f, 0.f, 0.f, 0.f};
        sfor<0, 4>([&](auto ks_) {
            constexpr int ks = decltype(ks_)::value;
            const bf16x8 fa = tr_frag1<ks * 32 * 544 + rt * 32, 4 * 544>(baseX);
            sfor<0, 4>([&](auto cq_) {
                constexpr int cq = decltype(cq_)::value;
                bf16x8 fb[4];
                tr_frag4<ks * 32 * 544 + cq * 128, 4 * 544, 32>(baseY, fb);
#pragma unroll
                for (int i = 0; i < 4; ++i) acc[4 * cq + i] = __builtin_amdgcn_mfma_f32_16x16x32_bf16(fa, fb[i], acc[4 * cq + i], 0, 0, 0);
            });
        });
#pragma unroll
        for (int ct = 0; ct < 16; ++ct)
            *(u32x2*)(Uo + (size_t)(16 * ct + lr) * 256 + 32 * w + 16 * rt + 4 * g) = (u32x2){pk2(acc[ct][0], acc[ct][1]), pk2(acc[ct][2], acc[ct][3])};
    });
    if (BR == 0 && tid < 256) {
        float sacc = 0.f;
        for (int ss = 0; ss < 128; ++ss) sacc += wk[ss] * bf2f(*(LAS const bf16_t*)(Xt + ss * 544 + tid * 2));
        p.NU[((size_t)(b * 4 + h) * 16 + c) * 256 + tid] = sacc;
    }
    __syncthreads();
}

__device__ __forceinline__ void scan_item(const Params& p, int layer, int pi, int slice, LAS unsigned char* lds) {
    LAS float* G = (LAS float*)lds; LAS float* dec = G + 512;
    const int tid = opaque_tid(), br = pi >> 4, bh = pi & 15, b = bh >> 2, h = bh & 3;
    if (br == 0) { gate_scan(p, layer, b, h, -1, G); if (tid < 16) dec[tid] = expf(G[32 + tid] - fmaxf(G[32 + tid], G[16 + tid])); }
    else if (tid < 16) dec[tid] = expf(128.0f * ret_lg(h));
    __syncthreads();
    float st[2][8];
#pragma unroll
    for (int j = 0; j < 2; ++j)
#pragma unroll
        for (int k = 0; k < 8; ++k) st[j][k] = 0.f;
    for (int c = 0; c < 16; ++c) {
        const float dc = dec[c];
#pragma unroll
        for (int j = 0; j < 2; ++j) { const size_t idx = (size_t)slice * 8192 + j * 4096 + tid * 8;
            float u[8]; unpack8(*(const u32x4*)(p.U + ((size_t)pi * 16 + c) * SZ + idx), u);
            *(u32x4*)(p.CS + ((size_t)pi * 16 + c) * SZ + idx) = pack8(st[j]);
#pragma unroll
            for (int k = 0; k < 8; ++k) st[j][k] = st[j][k] * dc + u[k]; }
    }
    float* fo = p.out + (br == 0 ? O_CP : O_SP) + (((size_t)layer * BP + b) * HM + h) * SZ;
#pragma unroll
    for (int j = 0; j < 2; ++j) { float* q = fo + (size_t)slice * 8192 + j * 4096 + tid * 8;
        *(f32x4*)q = (f32x4){st[j][0], st[j][1], st[j][2], st[j][3]}; *(f32x4*)(q + 4) = (f32x4){st[j][4], st[j][5], st[j][6], st[j][7]}; }
    if (br == 0 && slice == 0) {
        if (tid < 256) { float n = 0.f;
            for (int c = 0; c < 16; ++c) { p.NS[((size_t)bh * 16 + c) * 256 + tid] = n; n = dec[c] * n + p.NU[((size_t)bh * 16 + c) * 256 + tid]; }
            p.out[O_NP + (((size_t)layer * BP + b) * HM + h) * 256 + tid] = n; }
        if (tid == 0) p.out[O_MP + ((size_t)layer * BP + b) * HM + h] = G[48];
    }
    __syncthreads();
}

template <int BR>
__device__ __forceinline__ void chunk_passC(const Params& p, int layer, int b, int h, int c, LAS unsigned char* lds) {
    LAS unsigned char* BufB = lds; LAS unsigned char* Sw = lds + 69632; LAS float* G = (LAS float*)(lds + 104448);
    LAS float* av = G + 512; LAS float* fl = G + 640; LAS bf16_t* nbf = (LAS bf16_t*)(G + 768);
    const int tid = opaque_tid(), lane = tid & 63, w = __builtin_amdgcn_readfirstlane(tid >> 6), g = lane >> 4, lr = lane & 15;
    const size_t row0 = (size_t)b * SEQ + c * 128;
    const int pi = BR * 16 + b * 4 + h, l = 16 * w + lr;
    const float lg = ret_lg(h);
    u32x4 tr[8];
    tile_load<32>(tr, BR == 0 ? p.QK + row0 * 2048 + h * 512 + 256 : p.P + row0 * NP + C_KR + h * 256, BR == 0 ? 2048 : NP, tid);
    if (BR == 0) {
        gate_scan(p, layer, b, h, c, G);
        if (tid < 128) { av[tid] = expf(G[32 + c] - G[320 + tid]); fl[tid] = expf(-(G[64 + tid] + G[320 + tid])); }
        if (tid < 256) nbf[tid] = f2bf(p.NS[((size_t)(b * 4 + h) * 16 + c) * 256 + tid]);
    } else { if (tid < 128) av[tid] = expf((float)(tid + 1) * lg); }
    const bf16_t* Qp = BR == 0 ? p.QK + (row0 + l) * 2048 + h * 512 : p.P + (row0 + l) * NP + C_QR + h * 256;
    bf16x8 qf[8];
#pragma unroll
    for (int ks = 0; ks < 8; ++ks) qf[ks] = *(const bf16x8*)(Qp + 32 * ks + 8 * g);
    tile_store<32, 544>(BufB, tr, tid);
    __syncthreads();
    const bf16_t* CSp = p.CS + ((size_t)pi * 16 + c) * SZ;
    if (BR == 0) tile_load<32>(tr, CSp, 256, tid); else tile_load<16>(tr, CSp, 256, tid);
    float rs = 0.f;
    const float Gl = BR == 0 ? G[320 + l] : 0.f;
#pragma unroll
    for (int j = 0; j < 8; ++j) {
        f32x4 a = (f32x4){0.f, 0.f, 0.f, 0.f};
        if (j <= w) {
#pragma unroll
            for (int ks = 0; ks < 8; ++ks) a = __builtin_amdgcn_mfma_f32_16x16x32_bf16(lds_frag(BufB, 16 * j + lr, 544, (32 * ks + 8 * g) * 2), qf[ks], a, 0, 0, 0);
        }
        float v[4];
#pragma unroll
        for (int r = 0; r < 4; ++r) {
            const int sidx = 16 * j + 4 * g + r;
            float d = 0.f;
            if (sidx <= l) d = BR == 0 ? expf(G[192 + sidx] - Gl) : expf((float)(l - sidx) * lg);
            v[r] = a[r] * d; rs += v[r];
        }
        *(LAS u32x2*)(Sw + l * 272 + (16 * j + 4 * g) * 2) = (u32x2){pk2(v[0], v[1]), pk2(v[2], v[3])};
        __builtin_amdgcn_sched_barrier(0);
    }
    rs += __shfl_xor(rs, 16); rs += __shfl_xor(rs, 32);
    __syncthreads();
    f32x4 accN[16];
#pragma unroll
    for (int t = 0; t < 16; ++t) accN[t] = (f32x4){0.f, 0.f, 0.f, 0.f};
    const unsigned lq = (unsigned)(8 * g + (lr >> 2)), lp4 = (unsigned)(4 * (lr & 3));
    sfor<0, 2>([&](auto half_) {
        constexpr int half = decltype(half_)::value;
        if (BR == 0) tile_store<32, 544>(BufB, tr, tid); else tile_store<16, 272>(BufB, tr, tid);
        __syncthreads();
        if (half == 0) { if (BR == 0) tile_load<32>(tr, CSp + 128 * 256, 256, tid); else tile_load<16>(tr, CSp + 128, 256, tid); }
        else tile_load<32>(tr, p.P + row0 * NP + (BR == 0 ? C_VM : C_VR) + h * 256, NP, tid);
        if (BR == 0) {
#pragma unroll
            for (int t = 0; t < 8; ++t) {
#pragma unroll
                for (int ks = 0; ks < 8; ++ks)
                    accN[half * 8 + t] = __builtin_amdgcn_mfma_f32_16x16x32_bf16(lds_frag(BufB, 16 * t + lr, 544, (32 * ks + 8 * g) * 2), qf[ks], accN[half * 8 + t], 0, 0, 0);
                __builtin_amdgcn_sched_barrier(0); }
        } else {
            const unsigned base = lds_addr(BufB) + (lq * 136 + lp4) * 2;
            sfor<0, 8>([&](auto ks_) {
                constexpr int ks = decltype(ks_)::value;
                sfor<0, 2>([&](auto tq_) {
                    constexpr int tq = decltype(tq_)::value;
                    bf16x8 f[4];
                    tr_frag4<ks * 32 * 272 + tq * 128, 4 * 272, 32>(base, f);
#pragma unroll
                    for (int i = 0; i < 4; ++i) accN[half * 8 + 4 * tq + i] = __builtin_amdgcn_mfma_f32_16x16x32_bf16(f[i], qf[ks], accN[half * 8 + 4 * tq + i], 0, 0, 0);
                });
            });
        }
        __syncthreads();
    });
    float nq = 0.f;
    if (BR == 0) {
        f32x4 ad = (f32x4){0.f, 0.f, 0.f, 0.f};
#pragma unroll
        for (int ks = 0; ks < 8; ++ks) {
            bf16x8 nf = *(LAS const bf16x8*)(nbf + 32 * ks + 8 * g);
            if (lr != 0) nf = (bf16x8){0, 0, 0, 0, 0, 0, 0, 0};
            ad = __builtin_amdgcn_mfma_f32_16x16x32_bf16(nf, qf[ks], ad, 0, 0, 0);
        }
        nq = __shfl(ad[0], lr);
    }
    const float al = av[l];
#pragma unroll
    for (int t = 0; t < 16; ++t) accN[t] *= al;
    tile_store<32, 544>(BufB, tr, tid);
    __syncthreads();
    {
        const unsigned base = lds_addr(BufB) + (lq * 272 + lp4) * 2;
        sfor<0, 4>([&](auto ks_) {
            constexpr int ks = decltype(ks_)::value;
            const bf16x8 bfr = lds_frag(Sw, l, 272, (32 * ks + 8 * g) * 2);
            sfor<0, 4>([&](auto tq_) {
                constexpr int tq = decltype(tq_)::value;
                bf16x8 f[4];
                tr_frag4<ks * 32 * 544 + tq * 128, 4 * 544, 32>(base, f);
#pragma unroll
                for (int i = 0; i < 4; ++i) accN[4 * tq + i] = __builtin_amdgcn_mfma_f32_16x16x32_bf16(f[i], bfr, accN[4 * tq + i], 0, 0, 0);
            });
        });
    }
    float inv = 1.0f;
    if (BR == 0) inv = 1.0f / fmaxf(fabsf(rs + al * nq), fl[l]);
    float sm = 0.f;
#pragma unroll
    for (int t = 0; t < 16; ++t) { accN[t] *= inv; sm += (accN[t][0] + accN[t][1]) + (accN[t][2] + accN[t][3]); }
    sm += __shfl_xor(sm, 16); sm += __shfl_xor(sm, 32);
    const float mu = sm * (1.0f / 256.0f);
    float qv = 0.f;
#pragma unroll
    for (int t = 0; t < 16; ++t) { const f32x4 d = accN[t] - mu; qv += (d[0] * d[0] + d[1] * d[1]) + (d[2] * d[2] + d[3] * d[3]); }
    qv += __shfl_xor(qv, 16); qv += __shfl_xor(qv, 32);
    const float rstd = rsqrtf(qv * (1.0f / 256.0f) + EPS);
    const float* gain = (BR == 0 ? p.hn_m_g : p.hn_r_g) + (size_t)layer * WM + h * 256 + 4 * g;
    const float* skip = p.skip_m + (size_t)layer * WM + h * 256 + 4 * g;
    const size_t row = row0 + l;
    const bf16_t* zp = p.P + row * NP + (BR == 0 ? C_ZM : C_ZR) + h * 256 + 4 * g;
    const bf16_t* cp = p.CM + row * WM + h * 256 + 4 * g;
    bf16_t* op = p.OC + row * 2048 + BR * 1024 + h * 256 + 4 * g;
#pragma unroll
    for (int t = 0; t < 16; ++t) {
        const f32x4 ge = *(const f32x4*)(gain + 16 * t);
        const u32x2 zb = *(const u32x2*)(zp + 16 * t);
        f32x4 v = (accN[t] - mu) * rstd * ge;
        if (BR == 0) { const f32x4 sk = *(const f32x4*)(skip + 16 * t); const u32x2 cb = *(const u32x2*)(cp + 16 * t);
            v[0] += sk[0] * __uint_as_float(cb.x << 16); v[1] += sk[1] * __uint_as_float(cb.x & 0xffff0000u);
            v[2] += sk[2] * __uint_as_float(cb.y << 16); v[3] += sk[3] * __uint_as_float(cb.y & 0xffff0000u); }
        const float z0 = __uint_as_float(zb.x << 16), z1 = __uint_as_float(zb.x & 0xffff0000u), z2 = __uint_as_float(zb.y << 16), z3 = __uint_as_float(zb.y & 0xffff0000u);
        *(u32x2*)(op + 16 * t) = (u32x2){pk2(v[0] * siluf_(z0), v[1] * siluf_(z1)), pk2(v[2] * siluf_(z2), v[3] * siluf_(z3))};
    }
    __syncthreads();
}

template <int BR>
__device__ __forceinline__ void sample_item(const Params& p, int layer, int b, int h, LAS unsigned char* lds) {
    LAS float* sq = (LAS float*)lds; LAS float* sk = sq + 256; LAS float* sv = sk + 256; LAS float* sn = sv + 256; LAS float* sr = sn + 256; LAS float* red = sr + 256;
    LAS float* part = red + 64;
    const int tid = opaque_tid(), lane = tid & 63, wid = tid >> 6;
    const size_t R = (size_t)MP + b;
    const size_t sidx = ((size_t)layer * BS + b) * HM + h;
    if (tid < 256) {
        if (BR == 0) { sq[tid] = bf2f(p.QK[R * 2048 + h * 512 + tid]); sk[tid] = bf2f(p.QK[R * 2048 + h * 512 + 256 + tid]); sv[tid] = bf2f(p.P[R * NP + C_VM + h * 256 + tid]); sn[tid] = p.st_n[sidx * 256 + tid]; }
        else { sq[tid] = bf2f(p.P[R * NP + C_QR + h * 256 + tid]); sk[tid] = bf2f(p.P[R * NP + C_KR + h * 256 + tid]); sv[tid] = bf2f(p.P[R * NP + C_VR + h * 256 + tid]); sn[tid] = 0.f; }
    }
    __syncthreads();
    float pq = 0.f, pn = 0.f;
    if (tid < 256) { pq = sq[tid] * sk[tid]; pn = sn[tid] * sq[tid]; }
    block_sum2(pq, pn, red);
    const float qk = pq, nq = pn;
    float wgt = 1.f, a = 1.f, mt = 0.f;
    if (BR == 0) {
        const float ig = p.IF[R * 8 + h] + p.b_i[layer * HM + h];
        const float lf = logsigf_(p.IF[R * 8 + 4 + h] + p.b_f[layer * HM + h]);
        const float inter = lf + p.st_m[sidx];
        mt = fmaxf(inter, ig); wgt = expf(ig - mt); a = expf(inter - mt);
    } else { a = 1.0f - exp2f(-5.0f - (float)h); }
    const float* S0 = (BR == 0 ? p.st_C : p.st_S) + sidx * SZ;
    float* S1 = p.out + (BR == 0 ? O_CS : O_SS) + sidx * SZ;
    const f32x4* S0v = (const f32x4*)S0 + lane; f32x4* S1v = (f32x4*)S1 + lane;
    f32x4 cc[8], cn[8];
#pragma unroll
    for (int j = 0; j < 8; ++j) cc[j] = __builtin_nontemporal_load(S0v + 64 * (wid + 8 * j));
    if (BR == 0) {
        const f32x4 q4 = *(LAS const f32x4*)(sq + 4 * lane), k4 = *(LAS const f32x4*)(sk + 4 * lane);
#pragma unroll
        for (int i0 = 0; i0 < 32; i0 += 8) {
            if (i0 + 8 < 32) {
#pragma unroll
                for (int j = 0; j < 8; ++j) cn[j] = __builtin_nontemporal_load(S0v + 64 * (wid + 8 * (i0 + 8 + j)));
            }
#pragma unroll
            for (int j = 0; j < 8; ++j) { const int e = wid + 8 * (i0 + j);
                float pt = (cc[j][0] * q4[0] + cc[j][1] * q4[1]) + (cc[j][2] * q4[2] + cc[j][3] * q4[3]);
                const float wv = wgt * sv[e];
                __builtin_nontemporal_store(cc[j] * a + k4 * wv, S1v + 64 * e);
                pt = wave_sum(pt);
                if (lane == 0) sr[e] = pt; }
#pragma unroll
            for (int j = 0; j < 8; ++j) cc[j] = cn[j];
        }
    } else {
        const f32x4 v4 = *(LAS const f32x4*)(sv + 4 * lane);
        f32x4 ac = (f32x4){0.f, 0.f, 0.f, 0.f};
#pragma unroll
        for (int i0 = 0; i0 < 32; i0 += 8) {
            if (i0 + 8 < 32) {
#pragma unroll
                for (int j = 0; j < 8; ++j) cn[j] = __builtin_nontemporal_load(S0v + 64 * (wid + 8 * (i0 + 8 + j)));
            }
#pragma unroll
            for (int j = 0; j < 8; ++j) { const int d = wid + 8 * (i0 + j);
                ac = ac + cc[j] * sq[d];
                __builtin_nontemporal_store(cc[j] * a + v4 * sk[d], S1v + 64 * d); }
#pragma unroll
            for (int j = 0; j < 8; ++j) cc[j] = cn[j];
        }
        *(LAS f32x4*)(part + wid * 256 + 4 * lane) = ac;
    }
    __syncthreads();
    float hv = 0.f;
    if (tid < 256) {
        if (BR == 0) {
            const float ws = wgt * qk;
            const float den = fmaxf(fabsf(ws + a * nq), expf(-mt));
            hv = (ws * sv[tid] + a * sr[tid]) / den;
            p.out[O_NS + sidx * 256 + tid] = a * sn[tid] + wgt * sk[tid];
            if (tid == 0) p.out[O_MS + sidx] = mt;
        } else {
            float s = 0.f;
#pragma unroll
            for (int i = 0; i < 8; ++i) s += part[i * 256 + tid];
            hv = qk * sv[tid] + a * s;
        }
    }
    float s1 = hv, s2 = 0.f;
    block_sum2(s1, s2, red);
    const float mean = s1 * (1.0f / 256.0f);
    float dv = tid < 256 ? hv - mean : 0.f;
    float q1 = dv * dv, q2 = 0.f;
    block_sum2(q1, q2, red);
    const float rstd = rsqrtf(q1 * (1.0f / 256.0f) + EPS);
    if (tid < 256) {
        const float ge = (BR == 0 ? p.hn_m_g : p.hn_r_g)[(size_t)layer * WM + h * 256 + tid];
        float v = dv * rstd * ge;
        const float z = bf2f(p.P[R * NP + (BR == 0 ? C_ZM : C_ZR) + h * 256 + tid]);
        if (BR == 0) v += p.skip_m[(size_t)layer * WM + h * 256 + tid] * bf2f(p.CM[R * WM + h * 256 + tid]);
        p.OC[R * 2048 + BR * 1024 + h * 256 + tid] = f2bf(v * siluf_(z));
    }
    __syncthreads();
}

template <int MODE>
__device__ __forceinline__ void sample_gemm(const Params& p, const bf16_t* Wl, int wg, int nwg, LAS unsigned char* lds) {
    const int tid = opaque_tid(), lane = tid & 63, w = tid >> 6, g = lane >> 4, lr = lane & 15, hf = w >> 2;
    LAS f32x4* xch = (LAS f32x4*)lds;
    for (int j = wg; j < 256; j += nwg) {
        const int rbase = MP + 64 * (j & 1) + 16 * (w & 3), cbase = 16 * (j >> 1);
        const bf16_t* A = (MODE == 0 ? p.OC : p.MG) + (size_t)(rbase + lr) * 2048 + hf * 1024 + 8 * g;
        const bf16_t* B = Wl + (MODE == 0 ? W3_OFF : W4_OFF) + (size_t)(cbase + lr) * 2048 + hf * 1024 + 8 * g;
        f32x4 acc = (f32x4){0.f, 0.f, 0.f, 0.f};
#pragma unroll 1
        for (int k0 = 0; k0 < 1024; k0 += 512) {
            bf16x8 af[16], bf[16];
#pragma unroll
            for (int i = 0; i < 16; ++i) { af[i] = *(const bf16x8*)(A + k0 + 32 * i); bf[i] = *(const bf16x8*)(B + k0 + 32 * i); }
#pragma unroll
            for (int i = 0; i < 16; ++i) acc = __builtin_amdgcn_mfma_f32_16x16x32_bf16(af[i], bf[i], acc, 0, 0, 0);
        }
        if (hf == 1) xch[(w & 3) * 64 + lane] = acc;
        __syncthreads();
        if (hf == 0) {
            const f32x4 hi = xch[(w & 3) * 64 + lane];
            const int col = cbase + lr;
#pragma unroll
            for (int r = 0; r < 4; ++r) {
                const size_t row = (size_t)rbase + 4 * g + r;
                if (MODE == 0) {
                    const float rt = bf2f(p.RT[row * 2048 + col]), gr = bf2f(p.GRS[row * 2048 + col]);
                    p.MG[row * 2048 + col] = f2bf(gr * (rt * acc[r] + hi[r]));
                } else p.X[row * 2048 + col] += acc[r] + hi[r];
            }
        }
        __syncthreads();
    }
}

__device__ __forceinline__ void phaseA(const Params& p, int layer, int wg, int nwg, LAS unsigned char* lds) {
    for (int it0 = wg; it0 < 1536; it0 += nwg) {
        const int it = (wg & 1) ? (it0 < 1024 ? it0 + 512 : it0 - 1024) : it0;
        if (it < 512) {
            const int br = it >> 8, rest = it & 255, b = rest >> 6, h = (rest >> 4) & 3, c = rest & 15;
            if (br == 0) chunk_passA<0>(p, layer, b, h, c, lds); else chunk_passA<1>(p, layer, b, h, c, lds);
        } else {
            const int s = it - 512, br = s >> 9, b = (s >> 2) & 127, h = s & 3;
            if (br == 0) sample_item<0>(p, layer, b, h, lds); else sample_item<1>(p, layer, b, h, lds);
        }
    }
}
__device__ __forceinline__ void phaseScan(const Params& p, int layer, int wg, int nwg, LAS unsigned char* lds) {
    for (int it = wg; it < 256; it += nwg) scan_item(p, layer, it >> 3, it & 7, lds);
}
__device__ __forceinline__ void phaseC(const Params& p, int layer, int wg, int nwg, LAS unsigned char* lds) {
    for (int it = wg; it < 512; it += nwg) {
        const int br = it >> 8, rest = it & 255, b = rest >> 6, h = (rest >> 4) & 3, c = rest & 15;
        if (br == 0) chunk_passC<0>(p, layer, b, h, c, lds); else chunk_passC<1>(p, layer, b, h, c, lds);
    }
}

template <int ONLY>
__device__ __forceinline__ void run_phases(const Params& p, int ph_lo, int ph_hi) {
    extern __shared__ __attribute__((aligned(16))) unsigned char smem_raw[];
    LAS unsigned char* lds = (LAS unsigned char*)smem_raw;
    volatile LAS unsigned* xbw = (volatile LAS unsigned*)(lds + LDS_BYTES - 16);
    const int wg = blockIdx.x, nwg = gridDim.x;
    const bool multi = (ph_hi - ph_lo) > 1;
    XcdBarrier bar; bar.bar = p.bar; bar.x = 0; bar.st = xbw;
    if (multi) {
        if (threadIdx.x == 0) { xbw[0] = 0u; xbw[1] = 0u; xbw[2] = 0u; xbw[3] = 0u; }
        __syncthreads();
        bar = xcd_barrier_post(p.bar, xbw);
    }
    int ph = 0;
#define PHASE(KIND, ...) { if constexpr (ONLY < 0 || ONLY == KIND) { if (ph >= ph_lo && ph < ph_hi) { __VA_ARGS__; if (ph + 1 < ph_hi) xcd_barrier(bar); } } ++ph; }
    PHASE(0, prep_phase(p, wg, nwg, lds))
    for (int layer = 0; layer < DEPTH; ++layer) {
        const bf16_t* Wl = p.W + (size_t)layer * WL;
        PHASE(1, norm_phase(p, layer, wg, nwg, lds))
        PHASE(2, { pg8::StaticOrder S; S.init(MPAD, N1, nwg, wg); pg8::Gemm g{p.H, Wl + W1_OFF, D, D, D, 31, 0, 0};
                pg8::EpiG1 E{p.P, p.b_gate + (size_t)layer * 4096, p.RT, p.GRS, p.ROPE}; pg8::gemm_phase<false>(lds, g, S, E); })
        PHASE(3, conv_phase(p, layer, wg, nwg))
        PHASE(4, { pg8::StaticOrder S; S.init(MPAD, 2048, nwg, wg); pg8::Gemm g{p.CM, Wl + W2_OFF, 256, WM, 256, 1, 512, 0};
                pg8::EpiBf16 E{p.QK, 2048}; pg8::gemm_phase<false>(lds, g, S, E); })
        PHASE(5, phaseA(p, layer, wg, nwg, lds))
        PHASE(6, phaseScan(p, layer, wg, nwg, lds))
        PHASE(7, phaseC(p, layer, wg, nwg, lds))
        PHASE(8, { pg8::StaticOrder S; S.init(MP, 2048, nwg, wg); pg8::Gemm g{p.OC, Wl + W3_OFF, 2048, 2048, 2048, 31, 0, 16};
                pg8::EpiMerged E{p.MG, p.RT, p.GRS}; pg8::gemm_phase<true>(lds, g, S, E); sample_gemm<0>(p, Wl, wg, nwg, lds); })
        PHASE(10, { pg8::StaticOrder S; S.init(MP, 2048, nwg, wg); pg8::Gemm g{p.MG, Wl + W4_OFF, 2048, 2048, 2048, 31, 0, 0};
                pg8::EpiResidual E{p.X}; pg8::gemm_phase<false>(lds, g, S, E); sample_gemm<1>(p, Wl, wg, nwg, lds); })
    }
    PHASE(11, final_phase(p, wg, nwg))
#undef PHASE
}
__global__ void __launch_bounds__(512, 2) mega(Params p, int ph_lo, int ph_hi) { run_phases<-1>(p, ph_lo, ph_hi); }
#ifdef DIAG
template <int K> __global__ void __launch_bounds__(512, 2) mega_k(Params p, int ph_lo, int ph_hi) { run_phases<K>(p, ph_lo, ph_hi); }
template __global__ void mega_k<0>(Params, int, int); template __global__ void mega_k<1>(Params, int, int); template __global__ void mega_k<2>(Params, int, int);
template __global__ void mega_k<3>(Params, int, int); template __global__ void mega_k<4>(Params, int, int); template __global__ void mega_k<5>(Params, int, int);
template __global__ void mega_k<6>(Params, int, int); template __global__ void mega_k<7>(Params, int, int); template __global__ void mega_k<8>(Params, int, int);
template __global__ void mega_k<10>(Params, int, int); template __global__ void mega_k<11>(Params, int, int);
#endif
constexpr int N_PHASES = 2 + DEPTH * 9;

extern "C" void kernel_launch(void* const* d_in, const int* in_sizes, int n_in, void* d_out, int out_size, void* d_ws, size_t ws_size, hipStream_t stream) {
    (void)in_sizes; (void)n_in; (void)out_size; (void)ws_size;
    static int grid = 0;
    if (grid == 0) {
        int dev = 0, cus = 0;
        hipGetDevice(&dev);
        hipDeviceGetAttribute(&cus, hipDeviceAttributeMultiprocessorCount, dev);
        if (hipFuncSetAttribute((const void*)mega, hipFuncAttributeMaxDynamicSharedMemorySize, LDS_BYTES) != hipSuccess) fprintf(stderr, "hipFuncSetAttribute failed\n");
        (void)hipGetLastError();
        grid = cus > 0 ? cus : 256;
    }
    Params p{};
    const float** in = (const float**)&p;
    for (int i = 0; i < 24; ++i) in[i] = (const float*)d_in[i];
    p.out = (float*)d_out;
    unsigned char* ws = (unsigned char*)d_ws;
    size_t off = 0;
    auto take = [&](size_t bytes) { unsigned char* r = ws + off; off += (bytes + 255) & ~(size_t)255; return r; };
    p.bar = (unsigned*)take(16384);
    p.X = (float*)take((size_t)MPAD * D * 4);
    p.H = (bf16_t*)take((size_t)MPAD * D * 2);
    p.P = (bf16_t*)take((size_t)MPAD * NP * 2);
    p.IF = (float*)take((size_t)MPAD * 8 * 4);
    p.CM = (bf16_t*)take((size_t)MPAD * WM * 2);
    p.QK = (bf16_t*)take((size_t)MPAD * 2048 * 2);
    p.OC = (bf16_t*)take((size_t)MPAD * 2048 * 2);
    p.T3 = (float*)take((size_t)MPAD * 2048 * 4);
    p.MG = (bf16_t*)take((size_t)MPAD * 2048 * 2);
    p.U = (bf16_t*)take((size_t)32 * 16 * SZ * 2);
    p.CS = (bf16_t*)take((size_t)32 * 16 * SZ * 2);
    p.NU = (float*)take((size_t)16 * 16 * 256 * 4);
    p.NS = (float*)take((size_t)16 * 16 * 256 * 4);
    p.W = (bf16_t*)take((size_t)DEPTH * WL * 2);
    p.WIF = (float*)take((size_t)DEPTH * 8 * D * 4);
    p.BIAS1 = (float*)take((size_t)DEPTH * N1 * 4);
    p.ROPE = (float*)take((size_t)2049 * 128 * 2 * 4);
    p.RT = (bf16_t*)take((size_t)MPAD * 2048 * 2);
    p.GRS = (bf16_t*)take((size_t)MPAD * 2048 * 2);
    hipMemsetAsync(p.bar, 0, 16384, stream);
#if MK_SINGLE
    hipLaunchKernelGGL(mega, dim3(grid), dim3(512), LDS_BYTES, stream, p, 0, N_PHASES);
#else
    for (int ph = 0; ph < N_PHASES; ++ph) hipLaunchKernelGGL(mega, dim3(grid), dim3(512), LDS_BYTES, stream, p, ph, ph + 1);
#endif
}
```

```cpp
#include <hip/hip_runtime.h>
#include <stdint.h>
#include <stdio.h>

#ifndef TIMEK
#define TIMEK -1
#define TIMEX 10
#endif
#ifndef MK_SINGLE
#define MK_SINGLE 1
#endif

#define LAS __attribute__((address_space(3)))
typedef unsigned short bf16_t;
typedef short bf16x8 __attribute__((ext_vector_type(8)));
typedef float f32x4 __attribute__((ext_vector_type(4)));
typedef unsigned u32x4 __attribute__((ext_vector_type(4)));
typedef unsigned u32x2 __attribute__((ext_vector_type(2)));

constexpr int D = 2048, SEQ = 2048, BP = 4, BS = 128, DEPTH = 4, HM = 4, DH = 256, WM = 1024, NIN = 7176;
constexpr int MP = BP * SEQ, MT = MP + BS, MPAD = 8448;
constexpr int NP = 7168;
constexpr int N1 = 11520;
constexpr int C_U = 0, C_VM = 1024, C_ZM = 2048, C_QR = 3072, C_KR = 4096, C_VR = 5120, C_ZR = 6144, C_GM = 7168, C_GR = 9216;
constexpr float EPS = 1e-6f;
constexpr size_t SZ = 65536;
constexpr size_t O_YP = 0, O_YS = O_YP + 16777216, O_CP = O_YS + 262144, O_NP = O_CP + 4194304, O_MP = O_NP + 16384, O_CVP = O_MP + 64,
                 O_SP = O_CVP + 49152, O_CS = O_SP + 4194304, O_NS = O_CS + 134217728, O_MS = O_NS + 524288, O_CVS = O_MS + 2048, O_SS = O_CVS + 1572864;
constexpr size_t W1_OFF = 0, W2_OFF = W1_OFF + (size_t)N1 * D, W3_OFF = W2_OFF + (size_t)2048 * 256, W4_OFF = W3_OFF + (size_t)D * D, WL = W4_OFF + (size_t)D * D;
constexpr int LDS_BYTES = 147456;

constexpr size_t al256(size_t x) { return (x + 255) & ~(size_t)255; }
constexpr size_t OFF_BAR = 0, OFF_SS = OFF_BAR + 16384, OFF_SSP = OFF_SS + al256((size_t)5 * MPAD * 8), OFF_XB = OFF_SSP + al256((size_t)8 * MP * 4),
    OFF_P = OFF_XB + al256((size_t)MPAD * D * 2), OFF_IF = OFF_P + al256((size_t)MPAD * NP * 2), OFF_CM = OFF_IF + al256((size_t)MPAD * 8 * 4),
    OFF_QK = OFF_CM + al256((size_t)MPAD * WM * 2), OFF_OC = OFF_QK + al256((size_t)MPAD * 2048 * 2), OFF_MG = OFF_OC + al256((size_t)MPAD * 2048 * 2),
    OFF_U = OFF_MG + al256((size_t)MPAD * 2048 * 2), OFF_CS = OFF_U + al256((size_t)32 * 16 * SZ * 2), OFF_NU = OFF_CS + al256((size_t)32 * 16 * SZ * 2),
    OFF_NS = OFF_NU + al256((size_t)16 * 16 * 256 * 4), OFF_W = OFF_NS + al256((size_t)16 * 16 * 256 * 4), OFF_ROPE = OFF_W + al256((size_t)DEPTH * WL * 2),
    OFF_RT = OFF_ROPE + al256((size_t)2049 * 128 * 2 * 4), OFF_GRS = OFF_RT + al256((size_t)MPAD * 2048 * 2), WS_END = OFF_GRS + al256((size_t)MPAD * 2048 * 2);

struct Params {
    const float *x_prompt, *x_sample, *st_C, *st_n, *st_m, *st_conv, *st_S, *norm_g, *w_in, *conv_w, *conv_b, *w_qm, *w_km, *b_i, *b_f,
                *hn_m_g, *skip_m, *hn_r_g, *w_pm, *w_pr, *w_gate, *b_gate, *w_o, *final_g;
    float* out;
    unsigned char* ws;
#define WSF(name, type, off) __device__ __forceinline__ type* name##_() const { return (type*)(ws + (off)); }
    WSF(bar, unsigned, OFF_BAR) WSF(SS, unsigned long long, OFF_SS) WSF(SSP, float, OFF_SSP) WSF(Xb, bf16_t, OFF_XB) WSF(P, bf16_t, OFF_P) WSF(IF, float, OFF_IF)
    WSF(CM, bf16_t, OFF_CM) WSF(QK, bf16_t, OFF_QK) WSF(OC, bf16_t, OFF_OC) WSF(MG, bf16_t, OFF_MG) WSF(U, bf16_t, OFF_U) WSF(CS, bf16_t, OFF_CS)
    WSF(NU, float, OFF_NU) WSF(NS, float, OFF_NS) WSF(W, bf16_t, OFF_W) WSF(ROPE, float, OFF_ROPE) WSF(RT, bf16_t, OFF_RT) WSF(GRS, bf16_t, OFF_GRS)
#undef WSF
};


__device__ __forceinline__ unsigned long long ss_fix(float v) { return (unsigned long long)(v * 1048576.0f + 0.5f); }
__device__ __forceinline__ float ss_val(unsigned long long v) { return (float)v * (1.0f / 1048576.0f); }
__device__ __forceinline__ float row_ss(const float* ssp, const unsigned long long* ss, int row) {
    if (row < 8192) { const f32x4 a = *(const f32x4*)(ssp + (size_t)row * 8), b = *(const f32x4*)(ssp + (size_t)row * 8 + 4);
        return ((a[0] + a[1]) + (a[2] + a[3])) + ((b[0] + b[1]) + (b[2] + b[3])); }
    return ss_val(ss[row]);
}
__device__ __forceinline__ int opaque_tid() { int t = threadIdx.x; asm volatile("" : "+v"(t)); return t; }
__device__ __forceinline__ float bf2f(bf16_t v) { return __uint_as_float((unsigned)v << 16); }
__device__ __forceinline__ bf16_t f2bf(float f) { unsigned u = __float_as_uint(f); u += 0x7fffu + ((u >> 16) & 1u); return (bf16_t)(u >> 16); }
__device__ __forceinline__ unsigned pk2(float lo, float hi) { return (unsigned)f2bf(lo) | ((unsigned)f2bf(hi) << 16); }
__device__ __forceinline__ float wave_sum(float v) {
#pragma unroll
    for (int o = 32; o >= 1; o >>= 1) v += __shfl_xor(v, o);
    return v;
}
__device__ __forceinline__ float wave_max(float v) {
#pragma unroll
    for (int o = 32; o >= 1; o >>= 1) v = fmaxf(v, __shfl_xor(v, o));
    return v;
}
__device__ __forceinline__ float sigmoidf_(float x) { return __builtin_amdgcn_rcpf(1.0f + __expf(-x)); }
__device__ __forceinline__ float siluf_(float x) { return x * __builtin_amdgcn_rcpf(1.0f + __expf(-x)); }
__device__ __forceinline__ float logsigf_(float x) { return x < 0.f ? x - log1pf(expf(x)) : -log1pf(expf(-x)); }
__device__ __forceinline__ void block_sum2(float& a, float& b, LAS float* red) {
    a = wave_sum(a); b = wave_sum(b);
    __syncthreads();
    if ((threadIdx.x & 63) == 0) { red[threadIdx.x >> 6] = a; red[8 + (threadIdx.x >> 6)] = b; }
    __syncthreads();
    float sa = 0.f, sb = 0.f;
#pragma unroll
    for (int i = 0; i < 8; ++i) { sa += red[i]; sb += red[8 + i]; }
    a = sa; b = sb;
}

#define XB_TMO      128
#define XB_XCNT(j)  (256  + 64 * (j))
#define XB_XSUB(j)  (1280 + 64 * (j))
#define XB_XGEN(j)  (2304 + 64 * (j))
#define XB_TOP      3328
#define XB_TOPGEN   3392
#define XCD_BAR_WORDS 3456
#define XB_SPIN_CAP (1u << 22)

__device__ __forceinline__ unsigned xb_ld(unsigned* p)              { return __hip_atomic_load(p, __ATOMIC_RELAXED, __HIP_MEMORY_SCOPE_AGENT); }
__device__ __forceinline__ unsigned xb_add(unsigned* p, unsigned v) { return __hip_atomic_fetch_add(p, v, __ATOMIC_RELAXED, __HIP_MEMORY_SCOPE_AGENT); }
__device__ __forceinline__ unsigned xb_xcc_id() { return (unsigned)__builtin_amdgcn_s_getreg((3 << 11) | 20) & 0xFu; }
#define XB_SPIN(cond, bar) do { unsigned _sp = 0; while (cond) { __builtin_amdgcn_s_sleep(1); \
    if ((++_sp & 255u) == 0u) { if (xb_ld(&(bar)[XB_TMO])) break; if (_sp > XB_SPIN_CAP) { atomicAdd(&(bar)[XB_TMO], 1u); break; } } } } while (0)

struct XcdBarrier { unsigned* bar; unsigned x; volatile LAS unsigned* st; };

__device__ __forceinline__ XcdBarrier xcd_barrier_post(unsigned* bar, volatile LAS unsigned* st) {
    XcdBarrier b; b.bar = bar; b.x = xb_xcc_id(); b.st = st;
    if (threadIdx.x == 0) (void)xb_add(&bar[XB_XCNT(b.x)], 1u);
    return b;
}
__device__ __forceinline__ void xcd_barrier_complete(unsigned* bar, unsigned x, unsigned& nloc, unsigned& nx) {
    const unsigned G = gridDim.x * gridDim.y * gridDim.z;
    unsigned sum, cnt, mine, sp = 0u;
    for (;;) {
        sum = 0u; cnt = 0u; mine = 0u;
#pragma unroll
        for (unsigned j = 0; j < 16; ++j) { const unsigned c = xb_ld(&bar[XB_XCNT(j)]); sum += c; cnt += (c > 0u) ? 1u : 0u; mine = (j == x) ? c : mine; }
        if (sum == G) break;
        __builtin_amdgcn_s_sleep(1);
        if ((++sp & 255u) == 0u) { if (xb_ld(&bar[XB_TMO])) break; if (sp > XB_SPIN_CAP) { atomicAdd(&bar[XB_TMO], 1u); break; } }
    }
    nloc = mine > 0u ? mine : 1u; nx = cnt > 0u ? cnt : 1u;
}
__device__ __forceinline__ void xcd_barrier(const XcdBarrier& b) {
    asm volatile("s_waitcnt vmcnt(0)" ::: "memory");
    __syncthreads();
    if (threadIdx.x == 0) {
        unsigned* bar = b.bar;
        __builtin_amdgcn_s_waitcnt(0);
        unsigned nloc = b.st[0], nx = b.st[1];
        if (nloc == 0u) { xcd_barrier_complete(bar, b.x, nloc, nx); b.st[0] = nloc; b.st[1] = nx; }
        const unsigned old = xb_add(&bar[XB_XSUB(b.x)], 1u);
        const unsigned gen = old / nloc;
        if (old + 1u == (gen + 1u) * nloc) {
            __builtin_amdgcn_fence(__ATOMIC_RELEASE, "agent");
            asm volatile("s_waitcnt vmcnt(0)" ::: "memory");
            const unsigned og = xb_add(&bar[XB_TOP], 1u);
            const unsigned tg = og / nx;
            if (og + 1u == (tg + 1u) * nx) xb_add(&bar[XB_TOPGEN], 1u);
            else XB_SPIN(xb_ld(&bar[XB_TOPGEN]) == tg, bar);
            __builtin_amdgcn_fence(__ATOMIC_ACQUIRE, "agent");
            xb_add(&bar[XB_XGEN(b.x)], 1u);
            asm volatile("s_waitcnt vmcnt(0)" ::: "memory");
        } else {
            XB_SPIN(xb_ld(&bar[XB_XGEN(b.x)]) == gen, bar);
            __builtin_amdgcn_fence(__ATOMIC_ACQUIRE, "agent");
            asm volatile("s_waitcnt vmcnt(0)" ::: "memory");
        }
    }
    __syncthreads();
}

namespace pg8 {
constexpr int BM = 256, BK = 64, HALF = 128, HTB = HALF * BK * 2, STAGE_BYTES = 8 * HTB, NXCD = 8, WGM = 8;
__host__ __device__ __forceinline__ int lds_byte(int r, int c) { const int st = (r >> 4) * 2 + (c >> 5), rr = r & 15, cc = c & 31, ob = rr * 64 + cc * 2; return st * 1024 + (ob ^ (((ob >> 9) & 1) << 5)); }
__host__ __device__ __forceinline__ void stage_rc(int b, int& R, int& C) { const int st = b / 1024, sb = b % 1024, swz = sb ^ (((sb >> 9) & 1) << 5); R = (st >> 1) * 16 + swz / 64; C = (st & 1) * 32 + (swz % 64) / 2; }
__host__ __device__ __forceinline__ int perm32(int rho) { const int n = rho >> 4, i = rho & 15; return 8 * (i >> 2) + 4 * n + (i & 3); }

struct Unit { int pm, pn; };
struct Gemm { const bf16_t* A; const bf16_t* Bt; int K, lda, ldb, a_pn_shift, a_pn_stride, mid_t; };

struct StaticOrder {
    int nM, nN, nwg, G, c;
    __device__ void init(int M, int N, int G_, int c_) { nM = M / BM; nN = N / BM; nwg = nM * nN; G = G_; c = c_; }
    __device__ bool next(int i, Unit& u) const {
        const long L = (long)i * G + c; if (L >= nwg) return false;
        int wgid = (int)L; { const int q = nwg / NXCD, r = nwg % NXCD, xcd = wgid % NXCD, off = wgid / NXCD; wgid = (xcd < r ? xcd * (q + 1) : r * (q + 1) + (xcd - r) * q) + off; }
        const int nig = WGM * nN, gid = wgid / nig, fm = gid * WGM, gsz = (nM - fm) < WGM ? (nM - fm) : WGM;
        u.pm = fm + ((wgid % nig) % gsz); u.pn = (wgid % nig) / gsz; return true;
    }
};
__device__ __forceinline__ unsigned cvt_pk_bf16(float lo, float hi) { unsigned r; asm volatile("v_cvt_pk_bf16_f32 %0, %1, %2" : "=v"(r) : "v"(lo), "v"(hi)); return r; }

struct EpiBf16 {
    static constexpr bool PERM = true;
    bf16_t* O; int ldc;
    __device__ __forceinline__ void operator()(const f32x4 (&acc)[2][2][4][2], const Unit& u, int wr, int wc, int fr, int fq) const {
        const int row0 = u.pm * BM + wr * 64 + fr, col0 = u.pn * BM + wc * 32 + 8 * fq;
#pragma unroll
        for (int ai = 0; ai < 2; ++ai)
#pragma unroll
            for (int m = 0; m < 4; ++m) { bf16_t* rowp = O + (size_t)(row0 + ai * HALF + m * 16) * ldc + col0;
#pragma unroll
                for (int bj = 0; bj < 2; ++bj) { const f32x4 v0 = acc[ai][bj][m][0], v1 = acc[ai][bj][m][1];
                    u32x4 w; w.x = cvt_pk_bf16(v0[0], v0[1]); w.y = cvt_pk_bf16(v0[2], v0[3]); w.z = cvt_pk_bf16(v1[0], v1[1]); w.w = cvt_pk_bf16(v1[2], v1[3]);
                    *(u32x4*)(rowp + bj * HALF) = w; } }
    }
};
struct EpiG1 {
    static constexpr bool PERM = true;
    bf16_t* P; const float* bg; bf16_t* RT; bf16_t* GRS; const float* rope; const unsigned long long* ss; const float* ssp; float* IFo;
    __device__ __forceinline__ void operator()(f32x4 (&acc)[2][2][4][2], const Unit& u, int wr, int wc, int fr, int fq) const {
        const int row0 = u.pm * BM + wr * 64 + fr, cw = wc * 32 + 8 * fq;
#pragma unroll
        for (int ai = 0; ai < 2; ++ai)
#pragma unroll
            for (int m = 0; m < 4; ++m) { const float rstd = rsqrtf(row_ss(ssp, ss, row0 + ai * HALF + m * 16) * (1.0f / 2048.0f) + 1e-6f);
#pragma unroll
                for (int bj = 0; bj < 2; ++bj) { acc[ai][bj][m][0] *= rstd; acc[ai][bj][m][1] *= rstd; }
                if (m == 1 || m == 3) __builtin_amdgcn_sched_barrier(0); }
        if (u.pn == 44) {
            if (wc == 0 && fq == 0) {
#pragma unroll
                for (int ai = 0; ai < 2; ++ai)
#pragma unroll
                    for (int m = 0; m < 4; ++m) { float* o = IFo + (size_t)(row0 + ai * HALF + m * 16) * 8; *(f32x4*)o = acc[ai][0][m][0]; *(f32x4*)(o + 4) = acc[ai][0][m][1]; }
            }
        } else if (u.pn >= 28) {
            const int ch = 128 * (u.pn - 28) + cw;
            const f32x4 bm0 = *(const f32x4*)(bg + ch), bm1 = *(const f32x4*)(bg + ch + 4), br0 = *(const f32x4*)(bg + 2048 + ch), br1 = *(const f32x4*)(bg + 2048 + ch + 4);
#pragma unroll
            for (int ai = 0; ai < 2; ++ai)
#pragma unroll
                for (int m = 0; m < 4; ++m) { const size_t row = (size_t)(row0 + ai * HALF + m * 16);
                    const f32x4 vm0 = acc[ai][0][m][0] + bm0, vm1 = acc[ai][0][m][1] + bm1, vr0 = acc[ai][1][m][0] + br0, vr1 = acc[ai][1][m][1] + br1;
                    float rt[8], gr[8];
#pragma unroll
                    for (int j = 0; j < 4; ++j) {
                        const float er0 = 1.0f + __expf(-vr0[j]), er1 = 1.0f + __expf(-vr1[j]);
                        rt[j] = er0 * __builtin_amdgcn_rcpf(1.0f + __expf(-vm0[j])); rt[4 + j] = er1 * __builtin_amdgcn_rcpf(1.0f + __expf(-vm1[j]));
                        gr[j] = __builtin_amdgcn_rcpf(er0); gr[4 + j] = __builtin_amdgcn_rcpf(er1); }
                    u32x4 w; w.x = cvt_pk_bf16(rt[0], rt[1]); w.y = cvt_pk_bf16(rt[2], rt[3]); w.z = cvt_pk_bf16(rt[4], rt[5]); w.w = cvt_pk_bf16(rt[6], rt[7]);
                    *(u32x4*)(RT + row * 2048 + ch) = w;
                    w.x = cvt_pk_bf16(gr[0], gr[1]); w.y = cvt_pk_bf16(gr[2], gr[3]); w.z = cvt_pk_bf16(gr[4], gr[5]); w.w = cvt_pk_bf16(gr[6], gr[7]);
                    *(u32x4*)(GRS + row * 2048 + ch) = w; }
        } else if (u.pn >= 12 && u.pn < 20) {
            const float sc = u.pn >= 16 ? 0.0625f : 1.0f;
#pragma unroll
            for (int ai = 0; ai < 2; ++ai)
#pragma unroll
                for (int m = 0; m < 4; ++m) { const int row = row0 + ai * HALF + m * 16;
                    const int pi = row < MP ? (row & (SEQ - 1)) : 2048;
                    const f32x4* cs = (const f32x4*)(rope + ((size_t)pi * 128 + cw) * 2);
                    const f32x4 t0 = cs[0], t1 = cs[1], t2 = cs[2], t3 = cs[3];
                    const f32x4 a0 = acc[ai][0][m][0], a1 = acc[ai][0][m][1], b0 = acc[ai][1][m][0], b1 = acc[ai][1][m][1];
                    const float c[8] = {t0[0], t0[2], t1[0], t1[2], t2[0], t2[2], t3[0], t3[2]}, sn[8] = {t0[1], t0[3], t1[1], t1[3], t2[1], t2[3], t3[1], t3[3]};
                    const float x1[8] = {a0[0], a0[1], a0[2], a0[3], a1[0], a1[1], a1[2], a1[3]}, x2[8] = {b0[0], b0[1], b0[2], b0[3], b1[0], b1[1], b1[2], b1[3]};
                    float o1[8], o2[8];
#pragma unroll
                    for (int j = 0; j < 8; ++j) { o1[j] = (x1[j] * c[j] - x2[j] * sn[j]) * sc; o2[j] = (x1[j] * sn[j] + x2[j] * c[j]) * sc; }
                    bf16_t* rowp = P + (size_t)row * NP + u.pn * BM + cw;
                    u32x4 w; w.x = cvt_pk_bf16(o1[0], o1[1]); w.y = cvt_pk_bf16(o1[2], o1[3]); w.z = cvt_pk_bf16(o1[4], o1[5]); w.w = cvt_pk_bf16(o1[6], o1[7]);
                    *(u32x4*)rowp = w;
                    w.x = cvt_pk_bf16(o2[0], o2[1]); w.y = cvt_pk_bf16(o2[2], o2[3]); w.z = cvt_pk_bf16(o2[4], o2[5]); w.w = cvt_pk_bf16(o2[6], o2[7]);
                    *(u32x4*)(rowp + HALF) = w; }
        } else {
#pragma unroll
            for (int ai = 0; ai < 2; ++ai)
#pragma unroll
                for (int m = 0; m < 4; ++m) { bf16_t* rowp = P + (size_t)(row0 + ai * HALF + m * 16) * NP + u.pn * BM + cw;
#pragma unroll
                    for (int bj = 0; bj < 2; ++bj) { const f32x4 v0 = acc[ai][bj][m][0], v1 = acc[ai][bj][m][1];
                        u32x4 w; w.x = cvt_pk_bf16(v0[0], v0[1]); w.y = cvt_pk_bf16(v0[2], v0[3]); w.z = cvt_pk_bf16(v1[0], v1[1]); w.w = cvt_pk_bf16(v1[2], v1[3]);
                        *(u32x4*)(rowp + bj * HALF) = w; } }
        }
    }
};
struct EpiMerged {
    static constexpr bool PERM = true;
    bf16_t* O; const bf16_t* RT; const bf16_t* GRS;
    __device__ __forceinline__ void scale(f32x4 (&acc)[2][2][4][2], const bf16_t* S, const Unit& u, int wr, int wc, int fr, int fq) const {
        asm volatile("" : "+v"(fr), "+v"(fq));
        const int row0 = u.pm * BM + wr * 64 + fr, col0 = u.pn * BM + wc * 32 + 8 * fq;
#pragma unroll
        for (int ai = 0; ai < 2; ++ai) {
            u32x4 sv[4][2];
#pragma unroll
            for (int m = 0; m < 4; ++m)
#pragma unroll
                for (int bj = 0; bj < 2; ++bj) sv[m][bj] = *(const u32x4*)(S + (size_t)(row0 + ai * HALF + m * 16) * 2048 + col0 + bj * HALF);
#pragma unroll
            for (int m = 0; m < 4; ++m)
#pragma unroll
                for (int bj = 0; bj < 2; ++bj) { const u32x4 a = sv[m][bj];
                    acc[ai][bj][m][0][0] *= __uint_as_float(a.x << 16); acc[ai][bj][m][0][1] *= __uint_as_float(a.x & 0xffff0000u);
                    acc[ai][bj][m][0][2] *= __uint_as_float(a.y << 16); acc[ai][bj][m][0][3] *= __uint_as_float(a.y & 0xffff0000u);
                    acc[ai][bj][m][1][0] *= __uint_as_float(a.z << 16); acc[ai][bj][m][1][1] *= __uint_as_float(a.z & 0xffff0000u);
                    acc[ai][bj][m][1][2] *= __uint_as_float(a.w << 16); acc[ai][bj][m][1][3] *= __uint_as_float(a.w & 0xffff0000u); }
        }
    }
    __device__ __forceinline__ void mid(f32x4 (&acc)[2][2][4][2], const Unit& u, int wr, int wc, int fr, int fq) const { scale(acc, RT, u, wr, wc, fr, fq); }
    __device__ __forceinline__ void operator()(f32x4 (&acc)[2][2][4][2], const Unit& u, int wr, int wc, int fr, int fq) const {
        scale(acc, GRS, u, wr, wc, fr, fq);
        const int row0 = u.pm * BM + wr * 64 + fr, col0 = u.pn * BM + wc * 32 + 8 * fq;
#pragma unroll
        for (int ai = 0; ai < 2; ++ai)
#pragma unroll
            for (int m = 0; m < 4; ++m) { bf16_t* rowp = O + (size_t)(row0 + ai * HALF + m * 16) * 2048 + col0;
#pragma unroll
                for (int bj = 0; bj < 2; ++bj) { const f32x4 v0 = acc[ai][bj][m][0], v1 = acc[ai][bj][m][1];
                    u32x4 w; w.x = cvt_pk_bf16(v0[0], v0[1]); w.y = cvt_pk_bf16(v0[2], v0[3]); w.z = cvt_pk_bf16(v1[0], v1[1]); w.w = cvt_pk_bf16(v1[2], v1[3]);
                    *(u32x4*)(rowp + bj * HALF) = w; } }
    }
};
struct EpiResidual {
    static constexpr bool PERM = true;
    bf16_t* Xb; float* ssp; LAS float* red;
    __device__ __forceinline__ void operator()(f32x4 (&acc)[2][2][4][2], const Unit& u, int wr, int wc, int fr, int fq) const {
        const int row0 = u.pm * BM + wr * 64 + fr, col0 = u.pn * BM + wc * 32 + 8 * fq;
#pragma unroll
        for (int ai = 0; ai < 2; ++ai) {
            u32x4 xv[4][2];
#pragma unroll
            for (int m = 0; m < 4; ++m)
#pragma unroll
                for (int bj = 0; bj < 2; ++bj) xv[m][bj] = *(const u32x4*)(Xb + (size_t)(row0 + ai * HALF + m * 16) * 2048 + col0 + bj * HALF);
#pragma unroll
            for (int m = 0; m < 4; ++m) { float sq = 0.f;
#pragma unroll
                for (int bj = 0; bj < 2; ++bj) { const u32x4 a = xv[m][bj]; const f32x4 v0 = acc[ai][bj][m][0], v1 = acc[ai][bj][m][1];
                    u32x4 w;
                    w.x = cvt_pk_bf16(v0[0] + __uint_as_float(a.x << 16), v0[1] + __uint_as_float(a.x & 0xffff0000u)); w.y = cvt_pk_bf16(v0[2] + __uint_as_float(a.y << 16), v0[3] + __uint_as_float(a.y & 0xffff0000u));
                    w.z = cvt_pk_bf16(v1[0] + __uint_as_float(a.z << 16), v1[1] + __uint_as_float(a.z & 0xffff0000u)); w.w = cvt_pk_bf16(v1[2] + __uint_as_float(a.w << 16), v1[3] + __uint_as_float(a.w & 0xffff0000u));
                    *(u32x4*)(Xb + (size_t)(row0 + ai * HALF + m * 16) * 2048 + col0 + bj * HALF) = w;
                    const unsigned ww[4] = {w.x, w.y, w.z, w.w};
#pragma unroll
                    for (int q = 0; q < 4; ++q) { const float lo = __uint_as_float(ww[q] << 16), hi = __uint_as_float(ww[q] & 0xffff0000u); sq += lo * lo + hi * hi; } }
                sq += __shfl_xor(sq, 16); sq += __shfl_xor(sq, 32);
                if (fq == 0) red[(wr * 64 + fr + ai * HALF + m * 16) * 4 + wc] = sq; }
        }
        asm volatile("s_waitcnt lgkmcnt(0)" ::: "memory"); __builtin_amdgcn_s_barrier(); asm volatile("" ::: "memory");
        int t = threadIdx.x; asm volatile("" : "+v"(t));
        if (t < 256) { const f32x4 q = *(LAS const f32x4*)(red + 4 * t); ssp[(size_t)(u.pm * BM + t) * 8 + u.pn] = (q[0] + q[1]) + (q[2] + q[3]); }
        asm volatile("s_waitcnt lgkmcnt(0)" ::: "memory"); __builtin_amdgcn_s_barrier(); asm volatile("" ::: "memory");
    }
};

template <bool MID, class Epi, class Sched, bool ALIGN_EPI = true>
__device__ __forceinline__ void gemm_phase(LAS unsigned char* lds, const Gemm g, const Sched& S, const Epi& E) {
    const int tid = opaque_tid(), wid = __builtin_amdgcn_readfirstlane(tid >> 6), lane = tid & 63, wr = wid >> 2, wc = wid & 3, fr = lane & 15, fq = lane >> 4;
    const int K = g.K, nt = K / BK;
    unsigned voffA[2], voffB[2];
#pragma unroll
    for (int i = 0; i < 2; ++i) { int R, C; stage_rc(tid * 16 + i * 8192, R, C); const int Rb = Epi::PERM ? ((R & ~31) + perm32(R & 31)) : R;
        voffA[i] = (unsigned)(R * g.lda + C) * 2u; voffB[i] = (unsigned)(Rb * g.ldb + C) * 2u; }
    const size_t kstep = (size_t)(BK * 2);
    const size_t hstepA = (size_t)HALF * g.lda * 2, hstepB = (size_t)HALF * g.ldb * 2;
    const size_t tstepA = 2 * hstepA, tstepB = 2 * hstepB;
    const unsigned ldsw = (unsigned)wid * 1024u;
    const int aoff = lds_byte(wr * 64 + fr, fq * 8), boff = lds_byte(wc * 32 + fr, fq * 8);
#define PG8_SA(b, h) (((b) * 2 + (h)) * HTB)
#define PG8_SB(b, h) ((4 + (b) * 2 + (h)) * HTB)
#define PG8_STAGE(bufoff, gbase, voff) do { _Pragma("unroll") for (int _i = 0; _i < 2; ++_i) \
        __builtin_amdgcn_global_load_lds((const unsigned*)((const char*)(gbase) + (voff)[_i]), (LAS unsigned*)(lds + (bufoff) + ldsw + _i * 8192), 16, 0, 0); } while (0)
#define PG8_LDA(dst, b, h) do { _Pragma("unroll") for (int m = 0; m < 4; ++m) _Pragma("unroll") for (int k = 0; k < 2; ++k) dst[m][k] = *(const LAS bf16x8*)(lds + PG8_SA(b, h) + aoff + m * 2048 + k * 1024); } while (0)
#define PG8_LDB(dst, b, h) do { _Pragma("unroll") for (int n = 0; n < 2; ++n) _Pragma("unroll") for (int k = 0; k < 2; ++k) dst[n][k] = *(const LAS bf16x8*)(lds + PG8_SB(b, h) + boff + n * 2048 + k * 1024); } while (0)
#define PG8_MMA(ai, bj, At, Bt) do { __builtin_amdgcn_s_setprio(1); _Pragma("unroll") for (int m = 0; m < 4; ++m) _Pragma("unroll") for (int n = 0; n < 2; ++n) _Pragma("unroll") for (int k = 0; k < 2; ++k) \
        acc[ai][bj][m][n] = __builtin_amdgcn_mfma_f32_16x16x32_bf16(Bt[n][k], At[m][k], acc[ai][bj][m][n], 0, 0, 0); __builtin_amdgcn_s_setprio(0); } while (0)
#define PG8_WAIT_V(n) asm volatile("s_waitcnt vmcnt(" #n ")" ::: "memory")
#define PG8_WAIT_L(n) asm volatile("s_waitcnt lgkmcnt(" #n ")" ::: "memory")
#define PG8_BAR __builtin_amdgcn_s_barrier()
#define PG8_SCHED __builtin_amdgcn_sched_barrier(0)
#define PG8_APTR(u) ((const char*)g.A + (size_t)(u).pm * tstepA + (size_t)((u).pn >> g.a_pn_shift) * (size_t)g.a_pn_stride)
    Unit cur, nxt; int ui = 0;
    if (!S.next(0, cur)) return;
    f32x4 acc[2][2][4][2];
#pragma unroll
    for (int a = 0; a < 2; ++a)
#pragma unroll
        for (int b = 0; b < 2; ++b)
#pragma unroll
            for (int m = 0; m < 4; ++m)
#pragma unroll
                for (int n = 0; n < 2; ++n) acc[a][b][m][n] = (f32x4){0.f, 0.f, 0.f, 0.f};
    bf16x8 At[4][2], B0[2][2], B1[2][2];
    const char* cA = PG8_APTR(cur); const char* cB = (const char*)g.Bt + (size_t)cur.pn * tstepB;
    PG8_STAGE(PG8_SB(0, 0), cB, voffB); PG8_STAGE(PG8_SB(0, 1), cB + hstepB, voffB); PG8_STAGE(PG8_SA(0, 0), cA, voffA); PG8_STAGE(PG8_SA(0, 1), cA + hstepA, voffA);
    if (wr == 1) PG8_BAR;
    PG8_WAIT_V(2); PG8_BAR;
    PG8_STAGE(PG8_SB(1, 0), cB + kstep, voffB); PG8_STAGE(PG8_SA(1, 0), cA + kstep, voffA); PG8_STAGE(PG8_SB(1, 1), cB + hstepB + kstep, voffB);
    PG8_WAIT_V(6); PG8_BAR;
    for (;;) {
        const bool has_next = S.next(ui + 1, nxt);
        const char* nA = has_next ? PG8_APTR(nxt) : cA; const char* nB = has_next ? (const char*)g.Bt + (size_t)nxt.pn * tstepB : cB;
#pragma unroll 1
        for (int t = 0; t < nt; t += 2) {
            const bool last = (t == nt - 2);
            const char* a1 = cA + (size_t)(t + 1) * kstep;
            const char* a2 = last ? nA : cA + (size_t)(t + 2) * kstep; const char* b2 = last ? nB : cB + (size_t)(t + 2) * kstep;
            const char* a3 = a2 + kstep; const char* b3 = b2 + kstep;
            if constexpr (MID) { if (t == g.mid_t) E.mid(acc, cur, wr, wc, fr, fq); }
            PG8_LDB(B0, 0, 0); PG8_LDB(B1, 0, 1); PG8_SCHED; PG8_LDA(At, 0, 0); PG8_STAGE(PG8_SA(1, 1), a1 + hstepA, voffA);
            PG8_WAIT_V(8); PG8_WAIT_L(0); PG8_BAR; PG8_MMA(0, 0, At, B0); PG8_MMA(0, 1, At, B1); PG8_BAR; PG8_SCHED;
            PG8_LDA(At, 0, 1); PG8_STAGE(PG8_SB(0, 0), b2, voffB); PG8_STAGE(PG8_SB(0, 1), b2 + hstepB, voffB); PG8_STAGE(PG8_SA(0, 0), a2, voffA);
            PG8_WAIT_V(8); PG8_WAIT_L(0); PG8_BAR; PG8_MMA(1, 0, At, B0); PG8_MMA(1, 1, At, B1); PG8_BAR; PG8_SCHED;
            PG8_LDB(B0, 1, 0); PG8_LDB(B1, 1, 1); PG8_SCHED; PG8_LDA(At, 1, 0); PG8_STAGE(PG8_SA(0, 1), a2 + hstepA, voffA);
            PG8_WAIT_V(8); PG8_WAIT_L(0); PG8_BAR; PG8_MMA(0, 0, At, B0); PG8_MMA(0, 1, At, B1); PG8_BAR; PG8_SCHED;
            PG8_LDA(At, 1, 1); PG8_STAGE(PG8_SB(1, 0), b3, voffB); PG8_STAGE(PG8_SB(1, 1), b3 + hstepB, voffB); PG8_STAGE(PG8_SA(1, 0), a3, voffA);
            PG8_WAIT_V(8); PG8_WAIT_L(0); PG8_BAR; PG8_MMA(1, 0, At, B0); PG8_MMA(1, 1, At, B1); PG8_BAR; PG8_SCHED;
        }
        if constexpr (ALIGN_EPI) { if (wr == 0) PG8_BAR; }
        E(acc, cur, wr, wc, fr, fq);
        if (!has_next) break;
#pragma unroll
        for (int a = 0; a < 2; ++a)
#pragma unroll
            for (int b = 0; b < 2; ++b)
#pragma unroll
                for (int m = 0; m < 4; ++m)
#pragma unroll
                    for (int n = 0; n < 2; ++n) acc[a][b][m][n] = (f32x4){0.f, 0.f, 0.f, 0.f};
        cur = nxt; cA = nA; cB = nB; ++ui;
        if constexpr (ALIGN_EPI) { if (wr == 1) PG8_BAR; }
    }
    PG8_WAIT_V(0);
    if constexpr (!ALIGN_EPI) { if (wr == 0) PG8_BAR; }
    PG8_BAR;
#undef PG8_SA
#undef PG8_SB
#undef PG8_STAGE
#undef PG8_LDA
#undef PG8_LDB
#undef PG8_MMA
#undef PG8_WAIT_V
#undef PG8_WAIT_L
#undef PG8_BAR
#undef PG8_SCHED
#undef PG8_APTR
}
}

__device__ __forceinline__ void tr_tile(const float* src, int ldsrc, int k0, int c0, bf16_t* dst, int ldd, int r0, int kd0, float scale, LAS float* t, int lane, const float* kscale = nullptr) {
    f32x4 v[16];
#pragma unroll
    for (int i = 0; i < 16; ++i) v[i] = __builtin_nontemporal_load((const f32x4*)(src + (size_t)(k0 + (lane >> 4) + 4 * i) * ldsrc + c0 + 4 * (lane & 15)));
    if (kscale) {
#pragma unroll
        for (int i = 0; i < 16; ++i) v[i] *= kscale[k0 + (lane >> 4) + 4 * i];
    }
#pragma unroll
    for (int i = 0; i < 16; ++i)
#pragma unroll
        for (int j = 0; j < 4; ++j) t[((lane >> 4) + 4 * i) * 65 + 4 * (lane & 15) + j] = v[i][j];
    const int c = lane & 7;
#pragma unroll
    for (int j = 0; j < 8; ++j) { const int n = (lane >> 3) + 8 * j; const LAS float* q = t + (8 * c) * 65 + n;
        u32x4 o; o.x = pk2(scale * q[0], scale * q[65]); o.y = pk2(scale * q[130], scale * q[195]); o.z = pk2(scale * q[260], scale * q[325]); o.w = pk2(scale * q[390], scale * q[455]);
        *(u32x4*)(dst + (size_t)(r0 + n) * ldd + kd0 + 8 * c) = o; }
}
__device__ __forceinline__ void prep_phase(const Params& p, int wg, int nwg, LAS unsigned char* lds) {
    const int tid = opaque_tid();
    {
        const int lane = tid & 63, wid = tid >> 6;
        for (int row = wg * 8 + wid; row < MPAD; row += nwg * 8) {
            u32x2* hrow = (u32x2*)(p.Xb_() + (size_t)row * D);
            float ss = 0.f;
            if (row < MT) {
                const f32x4* xr = (const f32x4*)(row < MP ? p.x_prompt + (size_t)row * D : p.x_sample + (size_t)(row - MP) * D);
#pragma unroll
                for (int i = 0; i < 8; ++i) { const f32x4 v = xr[lane + 64 * i]; ss += (v[0] * v[0] + v[1] * v[1]) + (v[2] * v[2] + v[3] * v[3]); hrow[lane + 64 * i] = (u32x2){pk2(v[0], v[1]), pk2(v[2], v[3])}; }
                ss = wave_sum(ss);
            } else {
#pragma unroll
                for (int i = 0; i < 8; ++i) hrow[lane + 64 * i] = (u32x2){0u, 0u};
            }
            if (lane < 5) p.SS_()[(size_t)lane * MPAD + row] = lane == 0 ? ss_fix(ss) : 0ull;
            if (row < MP && lane < 8) p.SSP_()[(size_t)row * 8 + lane] = lane == 0 ? ss : 0.f;
        }
    }
    for (int i = wg * 512 + tid; i < 2049 * 128; i += nwg * 512) {
        const int pi = i >> 7, j = i & 127;
        const float pos = pi < 2048 ? (float)pi : 16384.0f;
        const float inv = powf(10000.0f, -((float)j / 128.0f));
        const float ang = pos * inv;
        p.ROPE_()[2 * i] = (float)cos((double)ang); p.ROPE_()[2 * i + 1] = (float)sin((double)ang);
    }
    for (int i = wg * 512 + tid; i < DEPTH * 256 * D; i += nwg * 512) {
        const int l = i / (256 * D), r = i % (256 * D), j = r / D, k = r % D;
        p.W_()[(size_t)l * WL + W1_OFF + (size_t)(11264 + j) * D + k] = j < 8 ? f2bf(p.w_in[((size_t)l * D + k) * NIN + 3072 + j] * p.norm_g[(size_t)l * D + k]) : (bf16_t)0;
    }
    const int lane = tid & 63, wid = tid >> 6;
    LAS float* t = (LAS float*)lds + wid * (64 * 65);
    constexpr int T0 = 1536, T1 = T0 + 2048, T2 = T1 + 2048, T3 = T2 + 512, T4 = T3 + 512, T5 = T4 + 1024, T6 = T5 + 64, T7 = T6 + 64;
    for (int it = wg * 8 + wid; it < DEPTH * T7; it += nwg * 8) {
        const int l = it / T7, r = it % T7;
        bf16_t* Wl = p.W_() + (size_t)l * WL;
        if (r < T0)      { const int q = r;      tr_tile(p.w_in + (size_t)l * D * NIN, NIN, (q & 31) * 64, (q >> 5) * 64, Wl + W1_OFF, D, (q >> 5) * 64, (q & 31) * 64, 1.f, t, lane, p.norm_g + (size_t)l * D); }
        else if (r < T1) { const int q = r - T0; tr_tile(p.w_in + (size_t)l * D * NIN, NIN, (q & 31) * 64, 3080 + (q >> 5) * 64, Wl + W1_OFF, D, 3072 + (q >> 5) * 64, (q & 31) * 64, 1.f, t, lane, p.norm_g + (size_t)l * D); }
        else if (r < T2) { const int q = r - T1; const int ct = q >> 5, c0 = (((ct & 3) < 2) ? 0 : 2048) + 128 * (ct >> 2) + (ct & 1) * 64;
                           tr_tile(p.w_gate + (size_t)l * D * 4096, 4096, (q & 31) * 64, c0, Wl + W1_OFF, D, C_GM + ct * 64, (q & 31) * 64, 1.f, t, lane, p.norm_g + (size_t)l * D); }
        else if (r < T3) { const int q = r - T2; tr_tile(p.w_pm + (size_t)l * WM * D, D, (q & 15) * 64, (q >> 4) * 64, Wl + W3_OFF, D, (q >> 4) * 64, (q & 15) * 64, 1.f, t, lane); }
        else if (r < T4) { const int q = r - T3; tr_tile(p.w_pr + (size_t)l * WM * D, D, (q & 15) * 64, (q >> 4) * 64, Wl + W3_OFF, D, (q >> 4) * 64, 1024 + (q & 15) * 64, 1.f, t, lane); }
        else if (r < T5) { const int q = r - T4; tr_tile(p.w_o + (size_t)l * D * D, D, (q & 31) * 64, (q >> 5) * 64, Wl + W4_OFF, D, (q >> 5) * 64, (q & 31) * 64, 1.f, t, lane); }
        else if (r < T6) { const int q = r - T5, h = q >> 4, qq = q & 15; tr_tile(p.w_qm + ((size_t)l * HM + h) * SZ, DH, (qq & 3) * 64, (qq >> 2) * 64, Wl + W2_OFF, DH, h * 512 + (qq >> 2) * 64, (qq & 3) * 64, 0.0625f, t, lane); }
        else             { const int q = r - T6, h = q >> 4, qq = q & 15; tr_tile(p.w_km + ((size_t)l * HM + h) * SZ, DH, (qq & 3) * 64, (qq >> 2) * 64, Wl + W2_OFF, DH, h * 512 + 256 + (qq >> 2) * 64, (qq & 3) * 64, 1.f, t, lane); }
    }
}

__device__ __forceinline__ void final_phase(const Params& p, int wg, int nwg) {
    const int tid_ = opaque_tid(), lane = tid_ & 63, wid = tid_ >> 6;
    const f32x4* g4 = (const f32x4*)p.final_g;
    for (int row = wg * 8 + wid; row < MT; row += nwg * 8) {
        const u32x2* xr = (const u32x2*)(p.Xb_() + (size_t)row * D);
        f32x4* yr = (f32x4*)(p.out + (row < MP ? O_YP + (size_t)row * D : O_YS + (size_t)(row - MP) * D));
        const float rstd = rsqrtf(row_ss(p.SSP_(), p.SS_() + (size_t)4 * MPAD, row) * (1.0f / D) + EPS);
#pragma unroll
        for (int i = 0; i < 8; ++i) { const u32x2 xb = xr[lane + 64 * i];
            const f32x4 v = (f32x4){__uint_as_float(xb.x << 16), __uint_as_float(xb.x & 0xffff0000u), __uint_as_float(xb.y << 16), __uint_as_float(xb.y & 0xffff0000u)};
            yr[lane + 64 * i] = v * rstd * g4[lane + 64 * i]; }
    }
}

__device__ __forceinline__ void unpack8(const u32x4 v, float (&f)[8]) {
    f[0] = __uint_as_float(v.x << 16); f[1] = __uint_as_float(v.x & 0xffff0000u); f[2] = __uint_as_float(v.y << 16); f[3] = __uint_as_float(v.y & 0xffff0000u);
    f[4] = __uint_as_float(v.z << 16); f[5] = __uint_as_float(v.z & 0xffff0000u); f[6] = __uint_as_float(v.w << 16); f[7] = __uint_as_float(v.w & 0xffff0000u);
}
__device__ __forceinline__ u32x4 pack8(const float (&f)[8]) { u32x4 w; w.x = pk2(f[0], f[1]); w.y = pk2(f[2], f[3]); w.z = pk2(f[4], f[5]); w.w = pk2(f[6], f[7]); return w; }

__device__ __forceinline__ void conv_phase(const Params& p, int layer, int wg, int nwg) {
    const int tid = opaque_tid();
    const float* cw = p.conv_w + (size_t)layer * 4 * WM;
    const float* cb = p.conv_b + (size_t)layer * WM;
    for (int it = wg * 512 + tid; it < MT * 128; it += nwg * 512) {
        const int row = it >> 7, ch = (it & 127) * 8;
        float up[4][8];
        if (row < MP) {
            const int t = row & (SEQ - 1);
#pragma unroll
            for (int i = 0; i < 4; ++i) {
                if (t - 3 + i >= 0) unpack8(*(const u32x4*)(p.P_() + (size_t)(row - 3 + i) * NP + C_U + ch), up[i]);
                else {
#pragma unroll
                    for (int j = 0; j < 8; ++j) up[i][j] = 0.f;
                }
            }
            if (t >= SEQ - 3) {
                const int b = row >> 11;
                float* o = p.out + O_CVP + (((size_t)layer * BP + b) * 3 + (t - (SEQ - 3))) * WM + ch;
                *(f32x4*)o = (f32x4){up[3][0], up[3][1], up[3][2], up[3][3]}; *(f32x4*)(o + 4) = (f32x4){up[3][4], up[3][5], up[3][6], up[3][7]};
            }
        } else {
            const int b = row - MP;
            const float* hist = p.st_conv + ((size_t)layer * BS + b) * 3 * WM + ch;
#pragma unroll
            for (int i = 0; i < 3; ++i) { const f32x4 a = *(const f32x4*)(hist + (size_t)i * WM), c = *(const f32x4*)(hist + (size_t)i * WM + 4);
                up[i][0] = a[0]; up[i][1] = a[1]; up[i][2] = a[2]; up[i][3] = a[3]; up[i][4] = c[0]; up[i][5] = c[1]; up[i][6] = c[2]; up[i][7] = c[3]; }
            unpack8(*(const u32x4*)(p.P_() + (size_t)row * NP + C_U + ch), up[3]);
            float* o = p.out + O_CVS + ((size_t)layer * BS + b) * 3 * WM + ch;
#pragma unroll
            for (int i = 0; i < 3; ++i) { *(f32x4*)(o + (size_t)i * WM) = (f32x4){up[i + 1][0], up[i + 1][1], up[i + 1][2], up[i + 1][3]};
                *(f32x4*)(o + (size_t)i * WM + 4) = (f32x4){up[i + 1][4], up[i + 1][5], up[i + 1][6], up[i + 1][7]}; }
        }
        float r[8];
#pragma unroll
        for (int j = 0; j < 8; ++j) r[j] = cb[ch + j];
#pragma unroll
        for (int i = 0; i < 4; ++i)
#pragma unroll
            for (int j = 0; j < 8; ++j) r[j] += up[i][j] * cw[i * WM + ch + j];
#pragma unroll
        for (int j = 0; j < 8; ++j) r[j] = siluf_(r[j]);
        *(u32x4*)(p.CM_() + (size_t)row * WM + ch) = pack8(r);
    }
}

__device__ __forceinline__ void gate_scan(const Params& p, int layer, int b, int h, int c_own, LAS float* G) {
    const int tid = opaque_tid(), lane = tid & 63, wid = tid >> 6;
    const float bi = p.b_i[layer * HM + h], bfv = p.b_f[layer * HM + h];
#pragma unroll
    for (int q = 0; q < 2; ++q) {
        const int cc = wid + 8 * q;
        const size_t r0 = (size_t)b * SEQ + cc * 128 + 2 * lane;
        const float i0 = p.IF_()[r0 * 8 + h] + bi, i1 = p.IF_()[(r0 + 1) * 8 + h] + bi;
        const float l0 = logsigf_(p.IF_()[r0 * 8 + 4 + h] + bfv), l1 = logsigf_(p.IF_()[(r0 + 1) * 8 + 4 + h] + bfv);
        float inc = l0 + l1;
#pragma unroll
        for (int o = 1; o < 64; o <<= 1) { const float t = __shfl_up(inc, o); if (lane >= o) inc += t; }
        const float exc = inc - (l0 + l1);
        const float b0 = exc + l0, b1 = inc;
        const float g0 = i0 - b0, g1 = i1 - b1;
        const float gm = wave_max(fmaxf(g0, g1));
        const float Bc = __shfl(inc, 63);
        if (lane == 0) { G[cc] = Bc; G[16 + cc] = gm; }
        if (cc == c_own) {
            float rm = fmaxf(g0, g1);
#pragma unroll
            for (int o = 1; o < 64; o <<= 1) { const float t = __shfl_up(rm, o); if (lane >= o) rm = fmaxf(rm, t); }
            float ex = __shfl_up(rm, 1); if (lane == 0) ex = -3.0e38f;
            const float c0 = fmaxf(ex, g0), c1 = fmaxf(c0, g1);
            G[64 + 2 * lane] = b0; G[65 + 2 * lane] = b1; G[192 + 2 * lane] = g0; G[193 + 2 * lane] = g1; G[320 + 2 * lane] = c0; G[321 + 2 * lane] = c1;
        }
    }
    __syncthreads();
    if (tid == 0) { float m = -1e30f; for (int cc = 0; cc < 16; ++cc) { G[32 + cc] = m; m = G[cc] + fmaxf(m, G[16 + cc]); } G[48] = m; }
    __syncthreads();
    if (c_own >= 0 && tid < 128) G[320 + tid] = fmaxf(G[320 + tid], G[32 + c_own]);
    __syncthreads();
}

template <int I> struct IC { static constexpr int value = I; };
template <int I, int N, class F> __device__ __forceinline__ void sfor(F&& f) { if constexpr (I < N) { f(IC<I>{}); sfor<I + 1, N>(f); } }

template <int CPR>
__device__ __forceinline__ void tile_load(u32x4 (&r)[8], const bf16_t* src, int ld_src, int tid) {
#pragma unroll
    for (int i = 0; i < 8; ++i) { const int id = tid + 512 * i, row = id / CPR, ch = id % CPR; r[i] = *(const u32x4*)(src + (size_t)row * ld_src + ch * 8); }
}
template <int CPR, int LDB>
__device__ __forceinline__ void tile_store(LAS unsigned char* dst, const u32x4 (&r)[8], int tid) {
#pragma unroll
    for (int i = 0; i < 8; ++i) { const int id = tid + 512 * i, row = id / CPR, ch = id % CPR; *(LAS u32x4*)(dst + row * LDB + ch * 16) = r[i]; }
}
__device__ __forceinline__ void tile_store_w(LAS unsigned char* dst, const u32x4 (&r)[8], LAS const float* w, int tid) {
#pragma unroll
    for (int i = 0; i < 8; ++i) { const int id = tid + 512 * i, row = id >> 5, ch = id & 31; float f[8]; unpack8(r[i], f); const float ww = w[row];
#pragma unroll
        for (int j = 0; j < 8; ++j) f[j] *= ww;
        *(LAS u32x4*)(dst + row * 544 + ch * 16) = pack8(f); }
}
template <int OFF, int HS>
__device__ __forceinline__ bf16x8 tr_frag1(unsigned base) {
    u32x2 l0, h0;
    asm volatile("ds_read_b64_tr_b16 %0, %2 offset:%3\n\tds_read_b64_tr_b16 %1, %2 offset:%4\n\ts_waitcnt lgkmcnt(0)"
                 : "=&v"(l0), "=&v"(h0) : "v"(base), "i"(OFF), "i"(OFF + HS) : "memory");
    const u32x4 v = (u32x4){l0.x, l0.y, h0.x, h0.y};
    return __builtin_bit_cast(bf16x8, v);
}
template <int OFF, int HS, int TS>
__device__ __forceinline__ void tr_frag4(unsigned base, bf16x8 (&f)[4]) {
    u32x2 l0, l1, l2, l3, h0, h1, h2, h3;
    asm volatile("ds_read_b64_tr_b16 %0, %8 offset:%9\n\tds_read_b64_tr_b16 %4, %8 offset:%10\n\t"
                 "ds_read_b64_tr_b16 %1, %8 offset:%11\n\tds_read_b64_tr_b16 %5, %8 offset:%12\n\t"
                 "ds_read_b64_tr_b16 %2, %8 offset:%13\n\tds_read_b64_tr_b16 %6, %8 offset:%14\n\t"
                 "ds_read_b64_tr_b16 %3, %8 offset:%15\n\tds_read_b64_tr_b16 %7, %8 offset:%16\n\t"
                 "s_waitcnt lgkmcnt(0)"
                 : "=&v"(l0), "=&v"(l1), "=&v"(l2), "=&v"(l3), "=&v"(h0), "=&v"(h1), "=&v"(h2), "=&v"(h3)
                 : "v"(base), "i"(OFF), "i"(OFF + HS), "i"(OFF + TS), "i"(OFF + TS + HS), "i"(OFF + 2 * TS), "i"(OFF + 2 * TS + HS), "i"(OFF + 3 * TS), "i"(OFF + 3 * TS + HS)
                 : "memory");
    f[0] = __builtin_bit_cast(bf16x8, (u32x4){l0.x, l0.y, h0.x, h0.y}); f[1] = __builtin_bit_cast(bf16x8, (u32x4){l1.x, l1.y, h1.x, h1.y});
    f[2] = __builtin_bit_cast(bf16x8, (u32x4){l2.x, l2.y, h2.x, h2.y}); f[3] = __builtin_bit_cast(bf16x8, (u32x4){l3.x, l3.y, h3.x, h3.y});
}
__device__ __forceinline__ unsigned lds_addr(LAS const void* p) { return (unsigned)(size_t)p; }

template <int NR, int NC, bool WEIGHT>
__device__ __forceinline__ void stage_T(LAS unsigned char* dst, int ldd_bytes, const bf16_t* src, int ld_src, LAS const float* w) {
    const int tid_ = opaque_tid(), lane = tid_ & 63, wid = tid_ >> 6;
    constexpr int PB = NR / 128, CG = NC / 8;
#pragma unroll 1
    for (int task = wid; task < PB * CG; task += 8) {
        const int pb = task % PB, cg = task / PB, r = pb * 128 + 2 * lane;
        float a[8], c[8];
        unpack8(*(const u32x4*)(src + (size_t)r * ld_src + cg * 8), a); unpack8(*(const u32x4*)(src + (size_t)(r + 1) * ld_src + cg * 8), c);
        float w0 = 1.f, w1 = 1.f; if (WEIGHT) { w0 = w[r]; w1 = w[r + 1]; }
#pragma unroll
        for (int j = 0; j < 8; ++j) *(LAS unsigned*)(dst + (cg * 8 + j) * ldd_bytes + r * 2) = pk2(a[j] * w0, c[j] * w1);
    }
}
__device__ __forceinline__ void stage_rows(LAS unsigned char* dst, const bf16_t* src, int ld_src) {
    const int tid_ = opaque_tid();
#pragma unroll
    for (int i = 0; i < 8; ++i) { const int id = tid_ + 512 * i, row = id >> 5, ch = id & 31;
        *(LAS u32x4*)(dst + row * 528 + ch * 16) = *(const u32x4*)(src + (size_t)row * ld_src + ch * 8); }
}
__device__ __forceinline__ bf16x8 lds_frag(LAS const unsigned char* base, int row, int ld_bytes, int kbyte) { return *(LAS const bf16x8*)(base + row * ld_bytes + kbyte); }
__device__ __forceinline__ float ret_lg(int h) { return logf(1.0f - exp2f(-5.0f - (float)h)); }

template <int BR>
__device__ __forceinline__ void chunk_passA(const Params& p, int layer, int b, int h, int c, LAS unsigned char* lds) {
    LAS unsigned char* Xt = lds; LAS unsigned char* Yt = lds + 69632; LAS float* G = (LAS float*)(lds + 139264); LAS float* wk = G + 512;
    const int tid = opaque_tid(), lane = tid & 63, w = __builtin_amdgcn_readfirstlane(tid >> 6), g = lane >> 4, lr = lane & 15;
    const size_t row0 = (size_t)b * SEQ + c * 128;
    const int pi = BR * 16 + b * 4 + h;
    const bf16_t* Xp = BR == 0 ? p.QK_() + row0 * 2048 + h * 512 + 256 : p.P_() + row0 * NP + C_VR + h * 256;
    const bf16_t* Yp = BR == 0 ? p.P_() + row0 * NP + C_VM + h * 256 : p.P_() + row0 * NP + C_KR + h * 256;
    u32x4 xr[8], yr[8];
    tile_load<32>(xr, Xp, BR == 0 ? 2048 : NP, tid); tile_load<32>(yr, Yp, NP, tid);
    if (BR == 0) { gate_scan(p, layer, b, h, c, G); if (tid < 128) wk[tid] = expf(G[192 + tid] - G[320 + 127]); }
    else { if (tid < 128) wk[tid] = expf((float)(127 - tid) * ret_lg(h)); }
    __syncthreads();
    tile_store<32, 544>(Xt, xr, tid); tile_store_w(Yt, yr, wk, tid);
    __syncthreads();
    const unsigned lpart = (unsigned)(((8 * g + (lr >> 2)) * 272 + 4 * (lr & 3)) * 2);
    const unsigned baseX = lds_addr(Xt) + lpart + (unsigned)(32 * w * 2), baseY = lds_addr(Yt) + lpart;
    bf16_t* Uo = p.U_() + ((size_t)pi * 16 + c) * SZ;
    sfor<0, 2>([&](auto rt_) {
        constexpr int rt = decltype(rt_)::value;
        f32x4 acc[16];
#pragma unroll
        for (int j = 0; j < 16; ++j) acc[j] = (f32x4){0.f, 0.f, 0.f, 0.f};
        sfor<0, 4>([&](auto ks_) {
            constexpr int ks = decltype(ks_)::value;
            const bf16x8 fa = tr_frag1<ks * 32 * 544 + rt * 32, 4 * 544>(baseX);
            sfor<0, 4>([&](auto cq_) {
                constexpr int cq = decltype(cq_)::value;
                bf16x8 fb[4];
                tr_frag4<ks * 32 * 544 + cq * 128, 4 * 544, 32>(baseY, fb);
#pragma unroll
                for (int i = 0; i < 4; ++i) acc[4 * cq + i] = __builtin_amdgcn_mfma_f32_16x16x32_bf16(fa, fb[i], acc[4 * cq + i], 0, 0, 0);
            });
        });
#pragma unroll
        for (int ct = 0; ct < 16; ++ct)
            *(u32x2*)(Uo + (size_t)(16 * ct + lr) * 256 + 32 * w + 16 * rt + 4 * g) = (u32x2){pk2(acc[ct][0], acc[ct][1]), pk2(acc[ct][2], acc[ct][3])};
    });
    if (BR == 0 && tid < 256) {
        float sacc = 0.f;
        for (int ss = 0; ss < 128; ++ss) sacc += wk[ss] * bf2f(*(LAS const bf16_t*)(Xt + ss * 544 + tid * 2));
        p.NU_()[((size_t)(b * 4 + h) * 16 + c) * 256 + tid] = sacc;
    }
    __syncthreads();
}

__device__ __forceinline__ void scan_item(const Params& p, int layer, int pi, int slice, LAS unsigned char* lds) {
    LAS float* G = (LAS float*)lds; LAS float* dec = G + 512;
    const int tid = opaque_tid(), br = pi >> 4, bh = pi & 15, b = bh >> 2, h = bh & 3;
    if (br == 0) { gate_scan(p, layer, b, h, -1, G); if (tid < 16) dec[tid] = expf(G[32 + tid] - fmaxf(G[32 + tid], G[16 + tid])); }
    else if (tid < 16) dec[tid] = expf(128.0f * ret_lg(h));
    __syncthreads();
    float st[2][8];
#pragma unroll
    for (int j = 0; j < 2; ++j)
#pragma unroll
        for (int k = 0; k < 8; ++k) st[j][k] = 0.f;
    for (int c = 0; c < 16; ++c) {
        const float dc = dec[c];
#pragma unroll
        for (int j = 0; j < 2; ++j) { const size_t idx = (size_t)slice * 8192 + j * 4096 + tid * 8;
            float u[8]; unpack8(*(const u32x4*)(p.U_() + ((size_t)pi * 16 + c) * SZ + idx), u);
            *(u32x4*)(p.CS_() + ((size_t)pi * 16 + c) * SZ + idx) = pack8(st[j]);
#pragma unroll
            for (int k = 0; k < 8; ++k) st[j][k] = st[j][k] * dc + u[k]; }
    }
    float* fo = p.out + (br == 0 ? O_CP : O_SP) + (((size_t)layer * BP + b) * HM + h) * SZ;
#pragma unroll
    for (int j = 0; j < 2; ++j) { float* q = fo + (size_t)slice * 8192 + j * 4096 + tid * 8;
        *(f32x4*)q = (f32x4){st[j][0], st[j][1], st[j][2], st[j][3]}; *(f32x4*)(q + 4) = (f32x4){st[j][4], st[j][5], st[j][6], st[j][7]}; }
    if (br == 0 && slice == 0) {
        if (tid < 256) { float n = 0.f;
            for (int c = 0; c < 16; ++c) { p.NS_()[((size_t)bh * 16 + c) * 256 + tid] = n; n = dec[c] * n + p.NU_()[((size_t)bh * 16 + c) * 256 + tid]; }
            p.out[O_NP + (((size_t)layer * BP + b) * HM + h) * 256 + tid] = n; }
        if (tid == 0) p.out[O_MP + ((size_t)layer * BP + b) * HM + h] = G[48];
    }
    __syncthreads();
}

template <int BR>
__device__ __forceinline__ void chunk_passC(const Params& p, int layer, int b, int h, int c, LAS unsigned char* lds) {
    LAS unsigned char* BufB = lds; LAS unsigned char* Sw = lds + 69632; LAS float* G = (LAS float*)(lds + 104448);
    LAS float* av = G + 512; LAS float* fl = G + 640; LAS bf16_t* nbf = (LAS bf16_t*)(G + 768);
    const int tid = opaque_tid(), lane = tid & 63, w = __builtin_amdgcn_readfirstlane(tid >> 6), g = lane >> 4, lr = lane & 15;
    const size_t row0 = (size_t)b * SEQ + c * 128;
    const int pi = BR * 16 + b * 4 + h, l = 16 * w + lr;
    const float lg = ret_lg(h);
    u32x4 tr[8];
    tile_load<32>(tr, BR == 0 ? p.QK_() + row0 * 2048 + h * 512 + 256 : p.P_() + row0 * NP + C_KR + h * 256, BR == 0 ? 2048 : NP, tid);
    if (BR == 0) {
        gate_scan(p, layer, b, h, c, G);
        if (tid < 128) { av[tid] = expf(G[32 + c] - G[320 + tid]); fl[tid] = expf(-(G[64 + tid] + G[320 + tid])); }
        if (tid < 256) nbf[tid] = f2bf(p.NS_()[((size_t)(b * 4 + h) * 16 + c) * 256 + tid]);
    } else { if (tid < 128) av[tid] = expf((float)(tid + 1) * lg); }
    const bf16_t* Qp = BR == 0 ? p.QK_() + (row0 + l) * 2048 + h * 512 : p.P_() + (row0 + l) * NP + C_QR + h * 256;
    bf16x8 qf[8];
#pragma unroll
    for (int ks = 0; ks < 8; ++ks) qf[ks] = *(const bf16x8*)(Qp + 32 * ks + 8 * g);
    tile_store<32, 544>(BufB, tr, tid);
    __syncthreads();
    const bf16_t* CSp = p.CS_() + ((size_t)pi * 16 + c) * SZ;
    if (BR == 0) tile_load<32>(tr, CSp, 256, tid); else tile_load<16>(tr, CSp, 256, tid);
    float rs = 0.f;
    const float Gl = BR == 0 ? G[320 + l] : 0.f;
#pragma unroll
    for (int j = 0; j < 8; ++j) {
        f32x4 a = (f32x4){0.f, 0.f, 0.f, 0.f};
        if (j <= w) {
#pragma unroll
            for (int ks = 0; ks < 8; ++ks) a = __builtin_amdgcn_mfma_f32_16x16x32_bf16(lds_frag(BufB, 16 * j + lr, 544, (32 * ks + 8 * g) * 2), qf[ks], a, 0, 0, 0);
        }
        float v[4];
#pragma unroll
        for (int r = 0; r < 4; ++r) {
            const int sidx = 16 * j + 4 * g + r;
            float d = 0.f;
            if (sidx <= l) d = BR == 0 ? expf(G[192 + sidx] - Gl) : expf((float)(l - sidx) * lg);
            v[r] = a[r] * d; rs += v[r];
        }
        *(LAS u32x2*)(Sw + l * 272 + (16 * j + 4 * g) * 2) = (u32x2){pk2(v[0], v[1]), pk2(v[2], v[3])};
        __builtin_amdgcn_sched_barrier(0);
    }
    rs += __shfl_xor(rs, 16); rs += __shfl_xor(rs, 32);
    __syncthreads();
    f32x4 accN[16];
#pragma unroll
    for (int t = 0; t < 16; ++t) accN[t] = (f32x4){0.f, 0.f, 0.f, 0.f};
    const unsigned lq = (unsigned)(8 * g + (lr >> 2)), lp4 = (unsigned)(4 * (lr & 3));
    sfor<0, 2>([&](auto half_) {
        constexpr int half = decltype(half_)::value;
        if (BR == 0) tile_store<32, 544>(BufB, tr, tid); else tile_store<16, 272>(BufB, tr, tid);
        __syncthreads();
        if (half == 0) { if (BR == 0) tile_load<32>(tr, CSp + 128 * 256, 256, tid); else tile_load<16>(tr, CSp + 128, 256, tid); }
        else tile_load<32>(tr, p.P_() + row0 * NP + (BR == 0 ? C_VM : C_VR) + h * 256, NP, tid);
        if (BR == 0) {
#pragma unroll
            for (int t = 0; t < 8; ++t) {
#pragma unroll
                for (int ks = 0; ks < 8; ++ks)
                    accN[half * 8 + t] = __builtin_amdgcn_mfma_f32_16x16x32_bf16(lds_frag(BufB, 16 * t + lr, 544, (32 * ks + 8 * g) * 2), qf[ks], accN[half * 8 + t], 0, 0, 0);
                __builtin_amdgcn_sched_barrier(0); }
        } else {
            const unsigned base = lds_addr(BufB) + (lq * 136 + lp4) * 2;
            sfor<0, 8>([&](auto ks_) {
                constexpr int ks = decltype(ks_)::value;
                sfor<0, 2>([&](auto tq_) {
                    constexpr int tq = decltype(tq_)::value;
                    bf16x8 f[4];
                    tr_frag4<ks * 32 * 272 + tq * 128, 4 * 272, 32>(base, f);
#pragma unroll
                    for (int i = 0; i < 4; ++i) accN[half * 8 + 4 * tq + i] = __builtin_amdgcn_mfma_f32_16x16x32_bf16(f[i], qf[ks], accN[half * 8 + 4 * tq + i], 0, 0, 0);
                });
            });
        }
        __syncthreads();
    });
    float nq = 0.f;
    if (BR == 0) {
        f32x4 ad = (f32x4){0.f, 0.f, 0.f, 0.f};
#pragma unroll
        for (int ks = 0; ks < 8; ++ks) {
            bf16x8 nf = *(LAS const bf16x8*)(nbf + 32 * ks + 8 * g);
            if (lr != 0) nf = (bf16x8){0, 0, 0, 0, 0, 0, 0, 0};
            ad = __builtin_amdgcn_mfma_f32_16x16x32_bf16(nf, qf[ks], ad, 0, 0, 0);
        }
        nq = __shfl(ad[0], lr);
    }
    const float al = av[l];
#pragma unroll
    for (int t = 0; t < 16; ++t) accN[t] *= al;
    tile_store<32, 544>(BufB, tr, tid);
    __syncthreads();
    {
        const unsigned base = lds_addr(BufB) + (lq * 272 + lp4) * 2;
        sfor<0, 4>([&](auto ks_) {
            constexpr int ks = decltype(ks_)::value;
            const bf16x8 bfr = lds_frag(Sw, l, 272, (32 * ks + 8 * g) * 2);
            sfor<0, 4>([&](auto tq_) {
                constexpr int tq = decltype(tq_)::value;
                bf16x8 f[4];
                tr_frag4<ks * 32 * 544 + tq * 128, 4 * 544, 32>(base, f);
#pragma unroll
                for (int i = 0; i < 4; ++i) accN[4 * tq + i] = __builtin_amdgcn_mfma_f32_16x16x32_bf16(f[i], bfr, accN[4 * tq + i], 0, 0, 0);
            });
        });
    }
    float inv = 1.0f;
    if (BR == 0) inv = 1.0f / fmaxf(fabsf(rs + al * nq), fl[l]);
    float sm = 0.f;
#pragma unroll
    for (int t = 0; t < 16; ++t) { accN[t] *= inv; sm += (accN[t][0] + accN[t][1]) + (accN[t][2] + accN[t][3]); }
    sm += __shfl_xor(sm, 16); sm += __shfl_xor(sm, 32);
    const float mu = sm * (1.0f / 256.0f);
    float qv = 0.f;
#pragma unroll
    for (int t = 0; t < 16; ++t) { const f32x4 d = accN[t] - mu; qv += (d[0] * d[0] + d[1] * d[1]) + (d[2] * d[2] + d[3] * d[3]); }
    qv += __shfl_xor(qv, 16); qv += __shfl_xor(qv, 32);
    const float rstd = rsqrtf(qv * (1.0f / 256.0f) + EPS);
    const float* gain = (BR == 0 ? p.hn_m_g : p.hn_r_g) + (size_t)layer * WM + h * 256 + 4 * g;
    const float* skip = p.skip_m + (size_t)layer * WM + h * 256 + 4 * g;
    const size_t row = row0 + l;
    const bf16_t* zp = p.P_() + row * NP + (BR == 0 ? C_ZM : C_ZR) + h * 256 + 4 * g;
    const bf16_t* cp = p.CM_() + row * WM + h * 256 + 4 * g;
    bf16_t* op = p.OC_() + row * 2048 + BR * 1024 + h * 256 + 4 * g;
#pragma unroll
    for (int t = 0; t < 16; ++t) {
        const f32x4 ge = *(const f32x4*)(gain + 16 * t);
        const u32x2 zb = *(const u32x2*)(zp + 16 * t);
        f32x4 v = (accN[t] - mu) * rstd * ge;
        if (BR == 0) { const f32x4 sk = *(const f32x4*)(skip + 16 * t); const u32x2 cb = *(const u32x2*)(cp + 16 * t);
            v[0] += sk[0] * __uint_as_float(cb.x << 16); v[1] += sk[1] * __uint_as_float(cb.x & 0xffff0000u);
            v[2] += sk[2] * __uint_as_float(cb.y << 16); v[3] += sk[3] * __uint_as_float(cb.y & 0xffff0000u); }
        const float z0 = __uint_as_float(zb.x << 16), z1 = __uint_as_float(zb.x & 0xffff0000u), z2 = __uint_as_float(zb.y << 16), z3 = __uint_as_float(zb.y & 0xffff0000u);
        *(u32x2*)(op + 16 * t) = (u32x2){pk2(v[0] * siluf_(z0), v[1] * siluf_(z1)), pk2(v[2] * siluf_(z2), v[3] * siluf_(z3))};
    }
    __syncthreads();
}

template <int BR>
__device__ __forceinline__ void sample_item(const Params& p, int layer, int b, int h, LAS unsigned char* lds) {
    LAS float* sq = (LAS float*)lds; LAS float* sk = sq + 256; LAS float* sv = sk + 256; LAS float* sn = sv + 256; LAS float* sr = sn + 256; LAS float* red = sr + 256;
    LAS float* part = red + 64;
    const int tid = opaque_tid(), lane = tid & 63, wid = tid >> 6;
    const size_t R = (size_t)MP + b;
    const size_t sidx = ((size_t)layer * BS + b) * HM + h;
    if (tid < 256) {
        if (BR == 0) { sq[tid] = bf2f(p.QK_()[R * 2048 + h * 512 + tid]); sk[tid] = bf2f(p.QK_()[R * 2048 + h * 512 + 256 + tid]); sv[tid] = bf2f(p.P_()[R * NP + C_VM + h * 256 + tid]); sn[tid] = p.st_n[sidx * 256 + tid]; }
        else { sq[tid] = bf2f(p.P_()[R * NP + C_QR + h * 256 + tid]); sk[tid] = bf2f(p.P_()[R * NP + C_KR + h * 256 + tid]); sv[tid] = bf2f(p.P_()[R * NP + C_VR + h * 256 + tid]); sn[tid] = 0.f; }
    }
    __syncthreads();
    float pq = 0.f, pn = 0.f;
    if (tid < 256) { pq = sq[tid] * sk[tid]; pn = sn[tid] * sq[tid]; }
    block_sum2(pq, pn, red);
    const float qk = pq, nq = pn;
    float wgt = 1.f, a = 1.f, mt = 0.f;
    if (BR == 0) {
        const float ig = p.IF_()[R * 8 + h] + p.b_i[layer * HM + h];
        const float lf = logsigf_(p.IF_()[R * 8 + 4 + h] + p.b_f[layer * HM + h]);
        const float inter = lf + p.st_m[sidx];
        mt = fmaxf(inter, ig); wgt = expf(ig - mt); a = expf(inter - mt);
    } else { a = 1.0f - exp2f(-5.0f - (float)h); }
    const float* S0 = (BR == 0 ? p.st_C : p.st_S) + sidx * SZ;
    float* S1 = p.out + (BR == 0 ? O_CS : O_SS) + sidx * SZ;
    const f32x4* S0v = (const f32x4*)S0 + lane; f32x4* S1v = (f32x4*)S1 + lane;
    f32x4 cc[8], cn[8];
#pragma unroll
    for (int j = 0; j < 8; ++j) cc[j] = __builtin_nontemporal_load(S0v + 64 * (wid + 8 * j));
    if (BR == 0) {
        const f32x4 q4 = *(LAS const f32x4*)(sq + 4 * lane), k4 = *(LAS const f32x4*)(sk + 4 * lane);
#pragma unroll
        for (int i0 = 0; i0 < 32; i0 += 8) {
            if (i0 + 8 < 32) {
#pragma unroll
                for (int j = 0; j < 8; ++j) cn[j] = __builtin_nontemporal_load(S0v + 64 * (wid + 8 * (i0 + 8 + j)));
            }
#pragma unroll
            for (int j = 0; j < 8; ++j) { const int e = wid + 8 * (i0 + j);
                float pt = (cc[j][0] * q4[0] + cc[j][1] * q4[1]) + (cc[j][2] * q4[2] + cc[j][3] * q4[3]);
                const float wv = wgt * sv[e];
                __builtin_nontemporal_store(cc[j] * a + k4 * wv, S1v + 64 * e);
                pt = wave_sum(pt);
                if (lane == 0) sr[e] = pt; }
#pragma unroll
            for (int j = 0; j < 8; ++j) cc[j] = cn[j];
        }
    } else {
        const f32x4 v4 = *(LAS const f32x4*)(sv + 4 * lane);
        f32x4 ac = (f32x4){0.f, 0.f, 0.f, 0.f};
#pragma unroll
        for (int i0 = 0; i0 < 32; i0 += 8) {
            if (i0 + 8 < 32) {
#pragma unroll
                for (int j = 0; j < 8; ++j) cn[j] = __builtin_nontemporal_load(S0v + 64 * (wid + 8 * (i0 + 8 + j)));
            }
#pragma unroll
            for (int j = 0; j < 8; ++j) { const int d = wid + 8 * (i0 + j);
                ac = ac + cc[j] * sq[d];
                __builtin_nontemporal_store(cc[j] * a + v4 * sk[d], S1v + 64 * d); }
#pragma unroll
            for (int j = 0; j < 8; ++j) cc[j] = cn[j];
        }
        *(LAS f32x4*)(part + wid * 256 + 4 * lane) = ac;
    }
    __syncthreads();
    float hv = 0.f;
    if (tid < 256) {
        if (BR == 0) {
            const float ws = wgt * qk;
            const float den = fmaxf(fabsf(ws + a * nq), expf(-mt));
            hv = (ws * sv[tid] + a * sr[tid]) / den;
            p.out[O_NS + sidx * 256 + tid] = a * sn[tid] + wgt * sk[tid];
            if (tid == 0) p.out[O_MS + sidx] = mt;
        } else {
            float s = 0.f;
#pragma unroll
            for (int i = 0; i < 8; ++i) s += part[i * 256 + tid];
            hv = qk * sv[tid] + a * s;
        }
    }
    float s1 = hv, s2 = 0.f;
    block_sum2(s1, s2, red);
    const float mean = s1 * (1.0f / 256.0f);
    float dv = tid < 256 ? hv - mean : 0.f;
    float q1 = dv * dv, q2 = 0.f;
    block_sum2(q1, q2, red);
    const float rstd = rsqrtf(q1 * (1.0f / 256.0f) + EPS);
    if (tid < 256) {
        const float ge = (BR == 0 ? p.hn_m_g : p.hn_r_g)[(size_t)layer * WM + h * 256 + tid];
        float v = dv * rstd * ge;
        const float z = bf2f(p.P_()[R * NP + (BR == 0 ? C_ZM : C_ZR) + h * 256 + tid]);
        if (BR == 0) v += p.skip_m[(size_t)layer * WM + h * 256 + tid] * bf2f(p.CM_()[R * WM + h * 256 + tid]);
        p.OC_()[R * 2048 + BR * 1024 + h * 256 + tid] = f2bf(v * siluf_(z));
    }
    __syncthreads();
}

template <int MODE>
__device__ __forceinline__ void sample_gemm(const Params& p, const bf16_t* Wl, int wg, int nwg, LAS unsigned char* lds, unsigned long long* ssn) {
    const int tid = opaque_tid(), lane = tid & 63, w = tid >> 6, g = lane >> 4, lr = lane & 15;
    LAS float* red = (LAS float*)lds;
    for (int j = wg; j < 128; j += nwg) {
        const int rbase = MP + 16 * (j & 7), cbase = 128 * (j >> 3) + 16 * w;
        const bf16_t* A = (MODE == 0 ? p.OC_() : p.MG_()) + (size_t)(rbase + lr) * 2048 + 8 * g;
        const bf16_t* B = Wl + (MODE == 0 ? W3_OFF : W4_OFF) + (size_t)(cbase + lr) * 2048 + 8 * g;
        f32x4 acc[2];
#pragma unroll
        for (int hf = 0; hf < 2; ++hf) {
            acc[hf] = (f32x4){0.f, 0.f, 0.f, 0.f};
#pragma unroll 1
            for (int k0 = 0; k0 < 1024; k0 += 512) {
                bf16x8 af[16], bf[16];
#pragma unroll
                for (int i = 0; i < 16; ++i) { af[i] = *(const bf16x8*)(A + hf * 1024 + k0 + 32 * i); bf[i] = *(const bf16x8*)(B + hf * 1024 + k0 + 32 * i); }
#pragma unroll
                for (int i = 0; i < 16; ++i) acc[hf] = __builtin_amdgcn_mfma_f32_16x16x32_bf16(af[i], bf[i], acc[hf], 0, 0, 0);
            }
        }
        const int col = cbase + lr;
        float sq[4];
#pragma unroll
        for (int r = 0; r < 4; ++r) {
            const size_t row = (size_t)rbase + 4 * g + r;
            if (MODE == 0) {
                const float rt = bf2f(p.RT_()[row * 2048 + col]), gr = bf2f(p.GRS_()[row * 2048 + col]);
                p.MG_()[row * 2048 + col] = f2bf(gr * (rt * acc[0][r] + acc[1][r]));
            } else {
                const bf16_t nb = f2bf(bf2f(p.Xb_()[row * 2048 + col]) + acc[0][r] + acc[1][r]);
                p.Xb_()[row * 2048 + col] = nb;
                float q = bf2f(nb) * bf2f(nb);
                q += __shfl_xor(q, 1); q += __shfl_xor(q, 2); q += __shfl_xor(q, 4); q += __shfl_xor(q, 8);
                sq[r] = q;
            }
        }
        if (MODE == 1) {
            if (lr == 0) { red[w * 16 + 4 * g + 0] = sq[0]; red[w * 16 + 4 * g + 1] = sq[1]; red[w * 16 + 4 * g + 2] = sq[2]; red[w * 16 + 4 * g + 3] = sq[3]; }
            __syncthreads();
            if (tid < 16) { float s = 0.f;
#pragma unroll
                for (int i = 0; i < 8; ++i) s += red[i * 16 + tid];
                atomicAdd(ssn + rbase + tid, ss_fix(s)); }
            __syncthreads();
        }
    }
}

__device__ __forceinline__ void phaseA(const Params& p, int layer, int wg, int nwg, LAS unsigned char* lds) {
    for (int it0 = wg; it0 < 1536; it0 += nwg) {
        const int it = (wg & 1) ? (it0 < 1024 ? it0 + 512 : it0 - 1024) : it0;
        if (it < 512) {
            const int br = it >> 8, rest = it & 255, b = rest >> 6, h = (rest >> 4) & 3, c = rest & 15;
            if (br == 0) chunk_passA<0>(p, layer, b, h, c, lds); else chunk_passA<1>(p, layer, b, h, c, lds);
        } else {
            const int s = it - 512, br = s >> 9, b = (s >> 2) & 127, h = s & 3;
            if (br == 0) sample_item<0>(p, layer, b, h, lds); else sample_item<1>(p, layer, b, h, lds);
        }
    }
}
__device__ __forceinline__ void phaseScan(const Params& p, int layer, int wg, int nwg, LAS unsigned char* lds) {
    for (int it = wg; it < 256; it += nwg) scan_item(p, layer, it >> 3, it & 7, lds);
}
__device__ __forceinline__ void phaseC(const Params& p, int layer, int wg, int nwg, LAS unsigned char* lds) {
    for (int it = wg; it < 512; it += nwg) {
        const int br = it >> 8, rest = it & 255, b = rest >> 6, h = (rest >> 4) & 3, c = rest & 15;
        if (br == 0) chunk_passC<0>(p, layer, b, h, c, lds); else chunk_passC<1>(p, layer, b, h, c, lds);
    }
}

template <int ONLY>
__device__ __forceinline__ void run_phases(const Params& p_in, int ph_lo, int ph_hi) {
    extern __shared__ __attribute__((aligned(16))) unsigned char smem_raw[];
    LAS unsigned char* lds = (LAS unsigned char*)smem_raw;
    volatile LAS unsigned* xbw = (volatile LAS unsigned*)(lds + LDS_BYTES - 16);
    const int wg_in = blockIdx.x, nwg = gridDim.x;
    const bool multi = (ph_hi - ph_lo) > 1;
    XcdBarrier bar; bar.bar = p_in.bar_(); bar.x = 0; bar.st = xbw;
    if (multi) {
        if (threadIdx.x == 0) { xbw[0] = 0u; xbw[1] = 0u; xbw[2] = 0u; xbw[3] = 0u; }
        __syncthreads();
        bar = xcd_barrier_post(p_in.bar_(), xbw);
    }
    int ph = 0; unsigned long long tacc_ = 0;
#define PHASE(KIND, ...) { if constexpr (ONLY < 0 || ONLY == KIND) { if (ph >= ph_lo && ph < ph_hi) { \
    unsigned long long t0_ = 0; if (KIND == TIMEK) t0_ = __builtin_amdgcn_s_memrealtime(); \
    Params p = p_in; int wg = wg_in; asm volatile("" : "+s"(p.ws), "+s"(p.out), "+s"(wg));     \
    __VA_ARGS__; if (ph + 1 < ph_hi) xcd_barrier(bar); \
    if (KIND == TIMEK) tacc_ += __builtin_amdgcn_s_memrealtime() - t0_; } } ++ph; }
    PHASE(0, prep_phase(p, wg, nwg, lds))
    for (int layer = 0; layer < DEPTH; ++layer) {
        PHASE(2, { pg8::StaticOrder S; S.init(MPAD, N1, nwg, wg); pg8::Gemm g{p.Xb_(), p.W_() + (size_t)layer * WL + W1_OFF, D, D, D, 31, 0, 0};
                pg8::EpiG1 E{p.P_(), p.b_gate + (size_t)layer * 4096, p.RT_(), p.GRS_(), p.ROPE_(), p.SS_() + (size_t)layer * MPAD, p.SSP_(), p.IF_()}; pg8::gemm_phase<false>(lds, g, S, E); })
        PHASE(3, conv_phase(p, layer, wg, nwg))
        PHASE(4, { pg8::StaticOrder S; S.init(MPAD, 2048, nwg, wg); pg8::Gemm g{p.CM_(), p.W_() + (size_t)layer * WL + W2_OFF, 256, WM, 256, 1, 512, 0};
                pg8::EpiBf16 E{p.QK_(), 2048}; pg8::gemm_phase<false>(lds, g, S, E); })
        PHASE(5, phaseA(p, layer, wg, nwg, lds))
        PHASE(6, phaseScan(p, layer, wg, nwg, lds))
        PHASE(7, phaseC(p, layer, wg, nwg, lds))
        PHASE(8, { pg8::StaticOrder S; S.init(MP, 2048, nwg, wg); pg8::Gemm g{p.OC_(), p.W_() + (size_t)layer * WL + W3_OFF, 2048, 2048, 2048, 31, 0, 16};
                pg8::EpiMerged E{p.MG_(), p.RT_(), p.GRS_()}; pg8::gemm_phase<true>(lds, g, S, E); sample_gemm<0>(p, p.W_() + (size_t)layer * WL, wg, nwg, lds, nullptr); })
        PHASE(10, { pg8::StaticOrder S; S.init(MP, 2048, nwg, wg); pg8::Gemm g{p.MG_(), p.W_() + (size_t)layer * WL + W4_OFF, 2048, 2048, 2048, 31, 0, 0};
                pg8::EpiResidual E{p.Xb_(), p.SSP_(), (LAS float*)(lds + pg8::STAGE_BYTES)}; pg8::gemm_phase<false>(lds, g, S, E); sample_gemm<1>(p, p.W_() + (size_t)layer * WL, wg, nwg, lds, p.SS_() + (size_t)(layer + 1) * MPAD); })
    }
    PHASE(11, final_phase(p, wg, nwg))
    if (TIMEK >= 0 && blockIdx.x == 0) { const unsigned long long te_ = __builtin_amdgcn_s_memrealtime(); while (__builtin_amdgcn_s_memrealtime() - te_ < TIMEX * tacc_) __builtin_amdgcn_s_sleep(8); }
#undef PHASE
}
__global__ void __launch_bounds__(512, 2) mega(Params p, int ph_lo, int ph_hi) { run_phases<-1>(p, ph_lo, ph_hi); }
#ifdef DIAG
template <int K> __global__ void __launch_bounds__(512, 2) mega_k(Params p, int ph_lo, int ph_hi) { run_phases<K>(p, ph_lo, ph_hi); }
template __global__ void mega_k<0>(Params, int, int); template __global__ void mega_k<2>(Params, int, int);
template __global__ void mega_k<3>(Params, int, int); template __global__ void mega_k<4>(Params, int, int); template __global__ void mega_k<5>(Params, int, int);
template __global__ void mega_k<6>(Params, int, int); template __global__ void mega_k<7>(Params, int, int); template __global__ void mega_k<8>(Params, int, int);
template __global__ void mega_k<10>(Params, int, int); template __global__ void mega_k<11>(Params, int, int);
#endif
constexpr int N_PHASES = 2 + DEPTH * 8;

extern "C" void kernel_launch(void* const* d_in, const int* in_sizes, int n_in, void* d_out, int out_size, void* d_ws, size_t ws_size, hipStream_t stream) {
    (void)in_sizes; (void)n_in; (void)out_size; (void)ws_size;
    static int grid = 0;
    if (grid == 0) {
        int dev = 0, cus = 0;
        hipGetDevice(&dev);
        hipDeviceGetAttribute(&cus, hipDeviceAttributeMultiprocessorCount, dev);
        if (hipFuncSetAttribute((const void*)mega, hipFuncAttributeMaxDynamicSharedMemorySize, LDS_BYTES) != hipSuccess) fprintf(stderr, "hipFuncSetAttribute failed\n");
        (void)hipGetLastError();
        grid = cus > 0 ? cus : 256;
    }
    Params p{};
    const float** in = (const float**)&p;
    for (int i = 0; i < 24; ++i) in[i] = (const float*)d_in[i];
    p.out = (float*)d_out;
    p.ws = (unsigned char*)d_ws;
    if (ws_size < WS_END) { fprintf(stderr, "workspace too small: %zu < %zu\n", ws_size, (size_t)WS_END); return; }
    hipMemsetAsync(d_ws, 0, 16384, stream);
#if MK_SINGLE
    hipLaunchKernelGGL(mega, dim3(grid), dim3(512), LDS_BYTES, stream, p, 0, N_PHASES);
#else
    for (int ph = 0; ph < N_PHASES; ++ph) hipLaunchKernelGGL(mega, dim3(grid), dim3(512), LDS_BYTES, stream, p, ph, ph + 1);
#endif
}
```

```cpp
#include <hip/hip_runtime.h>
#include <stdint.h>
#include <stdio.h>

#ifndef TIMEK
#define TIMEK -1
#define TIMEX 10
#endif
#ifndef MK_SINGLE
#define MK_SINGLE 1
#endif

#define LAS __attribute__((address_space(3)))
typedef unsigned short bf16_t;
typedef short bf16x8 __attribute__((ext_vector_type(8)));
typedef float f32x4 __attribute__((ext_vector_type(4)));
typedef unsigned u32x4 __attribute__((ext_vector_type(4)));
typedef unsigned u32x2 __attribute__((ext_vector_type(2)));

constexpr int D = 2048, SEQ = 2048, BP = 4, BS = 128, DEPTH = 4, HM = 4, DH = 256, WM = 1024, NIN = 7176;
constexpr int MP = BP * SEQ, MT = MP + BS, MPAD = 8448;
constexpr int NP = 7168;
constexpr int N1 = 11520;
constexpr int C_U = 0, C_VM = 1024, C_ZM = 2048, C_QR = 3072, C_KR = 4096, C_VR = 5120, C_ZR = 6144, C_GM = 7168, C_GR = 9216;
constexpr float EPS = 1e-6f;
constexpr size_t SZ = 65536;
constexpr size_t O_YP = 0, O_YS = O_YP + 16777216, O_CP = O_YS + 262144, O_NP = O_CP + 4194304, O_MP = O_NP + 16384, O_CVP = O_MP + 64,
                 O_SP = O_CVP + 49152, O_CS = O_SP + 4194304, O_NS = O_CS + 134217728, O_MS = O_NS + 524288, O_CVS = O_MS + 2048, O_SS = O_CVS + 1572864;
constexpr size_t W1_OFF = 0, W2_OFF = W1_OFF + (size_t)N1 * D, W3_OFF = W2_OFF + (size_t)2048 * 256, W4_OFF = W3_OFF + (size_t)D * D, WL = W4_OFF + (size_t)D * D;
constexpr int LDS_BYTES = 147456;

constexpr size_t al256(size_t x) { return (x + 255) & ~(size_t)255; }
constexpr size_t OFF_BAR = 0, OFF_SS = OFF_BAR + 16384, OFF_SSP = OFF_SS + al256((size_t)5 * MPAD * 8), OFF_XB = OFF_SSP + al256((size_t)8 * MP * 4),
    OFF_P = OFF_XB + al256((size_t)MPAD * D * 2), OFF_IF = OFF_P + al256((size_t)MPAD * NP * 2), OFF_CM = OFF_IF + al256((size_t)MPAD * 8 * 4),
    OFF_QK = OFF_CM + al256((size_t)MPAD * WM * 2), OFF_OC = OFF_QK + al256((size_t)MPAD * 2048 * 2), OFF_MG = OFF_OC + al256((size_t)MPAD * 2048 * 2),
    OFF_U = OFF_MG + al256((size_t)MPAD * 2048 * 2), OFF_CS = OFF_U + al256((size_t)32 * 16 * SZ * 2), OFF_NU = OFF_CS + al256((size_t)32 * 16 * SZ * 2),
    OFF_NS = OFF_NU + al256((size_t)16 * 16 * 256 * 4), OFF_W = OFF_NS + al256((size_t)16 * 16 * 256 * 4), OFF_ROPE = OFF_W + al256((size_t)DEPTH * WL * 2),
    OFF_RT = OFF_ROPE + al256((size_t)2049 * 128 * 2 * 4), OFF_GRS = OFF_RT + al256((size_t)MPAD * 2048 * 2), WS_END = OFF_GRS + al256((size_t)MPAD * 2048 * 2);

struct Params {
    const float *x_prompt, *x_sample, *st_C, *st_n, *st_m, *st_conv, *st_S, *norm_g, *w_in, *conv_w, *conv_b, *w_qm, *w_km, *b_i, *b_f,
                *hn_m_g, *skip_m, *hn_r_g, *w_pm, *w_pr, *w_gate, *b_gate, *w_o, *final_g;
    float* out;
    unsigned char* ws;
#define WSF(name, type, off) __device__ __forceinline__ type* name##_() const { return (type*)(ws + (off)); }
    WSF(bar, unsigned, OFF_BAR) WSF(SS, unsigned long long, OFF_SS) WSF(SSP, float, OFF_SSP) WSF(Xb, bf16_t, OFF_XB) WSF(P, bf16_t, OFF_P) WSF(IF, float, OFF_IF)
    WSF(CM, bf16_t, OFF_CM) WSF(QK, bf16_t, OFF_QK) WSF(OC, bf16_t, OFF_OC) WSF(MG, bf16_t, OFF_MG) WSF(U, bf16_t, OFF_U) WSF(CS, bf16_t, OFF_CS)
    WSF(NU, float, OFF_NU) WSF(NS, float, OFF_NS) WSF(W, bf16_t, OFF_W) WSF(ROPE, float, OFF_ROPE) WSF(RT, bf16_t, OFF_RT) WSF(GRS, bf16_t, OFF_GRS)
#undef WSF
};


__device__ __forceinline__ unsigned long long ss_fix(float v) { return (unsigned long long)(v * 1048576.0f + 0.5f); }
__device__ __forceinline__ float ss_val(unsigned long long v) { return (float)v * (1.0f / 1048576.0f); }
__device__ __forceinline__ float row_ss(const float* ssp, const unsigned long long* ss, int row) {
    if (row < 8192) { const f32x4 a = *(const f32x4*)(ssp + (size_t)row * 8), b = *(const f32x4*)(ssp + (size_t)row * 8 + 4);
        return ((a[0] + a[1]) + (a[2] + a[3])) + ((b[0] + b[1]) + (b[2] + b[3])); }
    return ss_val(ss[row]);
}
__device__ __forceinline__ int opaque_tid() { int t = threadIdx.x; asm volatile("" : "+v"(t)); return t; }
__device__ __forceinline__ float bf2f(bf16_t v) { return __uint_as_float((unsigned)v << 16); }
__device__ __forceinline__ bf16_t f2bf(float f) { unsigned u = __float_as_uint(f); u += 0x7fffu + ((u >> 16) & 1u); return (bf16_t)(u >> 16); }
__device__ __forceinline__ unsigned pk2(float lo, float hi) { return (unsigned)f2bf(lo) | ((unsigned)f2bf(hi) << 16); }
__device__ __forceinline__ float wave_sum(float v) {
#pragma unroll
    for (int o = 32; o >= 1; o >>= 1) v += __shfl_xor(v, o);
    return v;
}
__device__ __forceinline__ float wave_max(float v) {
#pragma unroll
    for (int o = 32; o >= 1; o >>= 1) v = fmaxf(v, __shfl_xor(v, o));
    return v;
}
__device__ __forceinline__ float sigmoidf_(float x) { return __builtin_amdgcn_rcpf(1.0f + __expf(-x)); }
__device__ __forceinline__ float siluf_(float x) { return x * __builtin_amdgcn_rcpf(1.0f + __expf(-x)); }
__device__ __forceinline__ float logsigf_(float x) { return x < 0.f ? x - log1pf(expf(x)) : -log1pf(expf(-x)); }
__device__ __forceinline__ void block_sum2(float& a, float& b, LAS float* red) {
    a = wave_sum(a); b = wave_sum(b);
    __syncthreads();
    if ((threadIdx.x & 63) == 0) { red[threadIdx.x >> 6] = a; red[8 + (threadIdx.x >> 6)] = b; }
    __syncthreads();
    float sa = 0.f, sb = 0.f;
#pragma unroll
    for (int i = 0; i < 8; ++i) { sa += red[i]; sb += red[8 + i]; }
    a = sa; b = sb;
}

#define XB_TMO      128
#define XB_XCNT(j)  (256  + 64 * (j))
#define XB_XSUB(j)  (1280 + 64 * (j))
#define XB_XGEN(j)  (2304 + 64 * (j))
#define XB_TOP      3328
#define XB_TOPGEN   3392
#define XCD_BAR_WORDS 3456
#define XB_SPIN_CAP (1u << 22)

__device__ __forceinline__ unsigned xb_ld(unsigned* p)              { return __hip_atomic_load(p, __ATOMIC_RELAXED, __HIP_MEMORY_SCOPE_AGENT); }
__device__ __forceinline__ unsigned xb_add(unsigned* p, unsigned v) { return __hip_atomic_fetch_add(p, v, __ATOMIC_RELAXED, __HIP_MEMORY_SCOPE_AGENT); }
__device__ __forceinline__ unsigned xb_xcc_id() { return (unsigned)__builtin_amdgcn_s_getreg((3 << 11) | 20) & 0xFu; }
#define XB_SPIN(cond, bar) do { unsigned _sp = 0; while (cond) { __builtin_amdgcn_s_sleep(1); \
    if ((++_sp & 255u) == 0u) { if (xb_ld(&(bar)[XB_TMO])) break; if (_sp > XB_SPIN_CAP) { atomicAdd(&(bar)[XB_TMO], 1u); break; } } } } while (0)

struct XcdBarrier { unsigned* bar; unsigned x; volatile LAS unsigned* st; };

__device__ __forceinline__ XcdBarrier xcd_barrier_post(unsigned* bar, volatile LAS unsigned* st) {
    XcdBarrier b; b.bar = bar; b.x = xb_xcc_id(); b.st = st;
    if (threadIdx.x == 0) (void)xb_add(&bar[XB_XCNT(b.x)], 1u);
    return b;
}
__device__ __forceinline__ void xcd_barrier_complete(unsigned* bar, unsigned x, unsigned& nloc, unsigned& nx) {
    const unsigned G = gridDim.x * gridDim.y * gridDim.z;
    unsigned sum, cnt, mine, sp = 0u;
    for (;;) {
        sum = 0u; cnt = 0u; mine = 0u;
#pragma unroll
        for (unsigned j = 0; j < 16; ++j) { const unsigned c = xb_ld(&bar[XB_XCNT(j)]); sum += c; cnt += (c > 0u) ? 1u : 0u; mine = (j == x) ? c : mine; }
        if (sum == G) break;
        __builtin_amdgcn_s_sleep(1);
        if ((++sp & 255u) == 0u) { if (xb_ld(&bar[XB_TMO])) break; if (sp > XB_SPIN_CAP) { atomicAdd(&bar[XB_TMO], 1u); break; } }
    }
    nloc = mine > 0u ? mine : 1u; nx = cnt > 0u ? cnt : 1u;
}
__device__ __forceinline__ void xcd_barrier(const XcdBarrier& b) {
    asm volatile("s_waitcnt vmcnt(0)" ::: "memory");
    __syncthreads();
    if (threadIdx.x == 0) {
        unsigned* bar = b.bar;
        __builtin_amdgcn_s_waitcnt(0);
        unsigned nloc = b.st[0], nx = b.st[1];
        if (nloc == 0u) { xcd_barrier_complete(bar, b.x, nloc, nx); b.st[0] = nloc; b.st[1] = nx; }
        const unsigned old = xb_add(&bar[XB_XSUB(b.x)], 1u);
        const unsigned gen = old / nloc;
        if (old + 1u == (gen + 1u) * nloc) {
            __builtin_amdgcn_fence(__ATOMIC_RELEASE, "agent");
            asm volatile("s_waitcnt vmcnt(0)" ::: "memory");
            const unsigned og = xb_add(&bar[XB_TOP], 1u);
            const unsigned tg = og / nx;
            if (og + 1u == (tg + 1u) * nx) xb_add(&bar[XB_TOPGEN], 1u);
            else XB_SPIN(xb_ld(&bar[XB_TOPGEN]) == tg, bar);
            __builtin_amdgcn_fence(__ATOMIC_ACQUIRE, "agent");
            xb_add(&bar[XB_XGEN(b.x)], 1u);
            asm volatile("s_waitcnt vmcnt(0)" ::: "memory");
        } else {
            XB_SPIN(xb_ld(&bar[XB_XGEN(b.x)]) == gen, bar);
            __builtin_amdgcn_fence(__ATOMIC_ACQUIRE, "agent");
            asm volatile("s_waitcnt vmcnt(0)" ::: "memory");
        }
    }
    __syncthreads();
}

namespace pg8 {
constexpr int BM = 256, BK = 64, HALF = 128, HTB = HALF * BK * 2, STAGE_BYTES = 8 * HTB, NXCD = 8, WGM = 8;
__host__ __device__ __forceinline__ int lds_byte(int r, int c) { const int st = (r >> 4) * 2 + (c >> 5), rr = r & 15, cc = c & 31, ob = rr * 64 + cc * 2; return st * 1024 + (ob ^ (((ob >> 9) & 1) << 5)); }
__host__ __device__ __forceinline__ void stage_rc(int b, int& R, int& C) { const int st = b / 1024, sb = b % 1024, swz = sb ^ (((sb >> 9) & 1) << 5); R = (st >> 1) * 16 + swz / 64; C = (st & 1) * 32 + (swz % 64) / 2; }
__host__ __device__ __forceinline__ int perm32(int rho) { const int n = rho >> 4, i = rho & 15; return 8 * (i >> 2) + 4 * n + (i & 3); }

struct Unit { int pm, pn; };
struct Gemm { const bf16_t* A; const bf16_t* Bt; int K, lda, ldb, a_pn_shift, a_pn_stride, mid_t; };

struct StaticOrder {
    int nM, nN, nwg, G, c;
    __device__ void init(int M, int N, int G_, int c_) { nM = M / BM; nN = N / BM; nwg = nM * nN; G = G_; c = c_; }
    __device__ bool next(int i, Unit& u) const {
        const long L = (long)i * G + c; if (L >= nwg) return false;
        int wgid = (int)L; { const int q = nwg / NXCD, r = nwg % NXCD, xcd = wgid % NXCD, off = wgid / NXCD; wgid = (xcd < r ? xcd * (q + 1) : r * (q + 1) + (xcd - r) * q) + off; }
        const int nig = WGM * nN, gid = wgid / nig, fm = gid * WGM, gsz = (nM - fm) < WGM ? (nM - fm) : WGM;
        u.pm = fm + ((wgid % nig) % gsz); u.pn = (wgid % nig) / gsz; return true;
    }
};
__device__ __forceinline__ unsigned cvt_pk_bf16(float lo, float hi) { unsigned r; asm volatile("v_cvt_pk_bf16_f32 %0, %1, %2" : "=v"(r) : "v"(lo), "v"(hi)); return r; }

struct EpiBf16 {
    static constexpr bool PERM = true;
    bf16_t* O; int ldc;
    __device__ __forceinline__ void operator()(const f32x4 (&acc)[2][2][4][2], const Unit& u, int wr, int wc, int fr, int fq) const {
        const int row0 = u.pm * BM + wr * 64 + fr, col0 = u.pn * BM + wc * 32 + 8 * fq;
#pragma unroll
        for (int ai = 0; ai < 2; ++ai)
#pragma unroll
            for (int m = 0; m < 4; ++m) { bf16_t* rowp = O + (size_t)(row0 + ai * HALF + m * 16) * ldc + col0;
#pragma unroll
                for (int bj = 0; bj < 2; ++bj) { const f32x4 v0 = acc[ai][bj][m][0], v1 = acc[ai][bj][m][1];
                    u32x4 w; w.x = cvt_pk_bf16(v0[0], v0[1]); w.y = cvt_pk_bf16(v0[2], v0[3]); w.z = cvt_pk_bf16(v1[0], v1[1]); w.w = cvt_pk_bf16(v1[2], v1[3]);
                    *(u32x4*)(rowp + bj * HALF) = w; } }
    }
};
struct EpiG1 {
    static constexpr bool PERM = true;
    bf16_t* P; const float* bg; bf16_t* RT; bf16_t* GRS; const float* rope; const unsigned long long* ss; const float* ssp; float* IFo;
    __device__ __forceinline__ void operator()(f32x4 (&acc)[2][2][4][2], const Unit& u, int wr, int wc, int fr, int fq) const {
        const int row0 = u.pm * BM + wr * 64 + fr, cw = wc * 32 + 8 * fq;
#pragma unroll
        for (int ai = 0; ai < 2; ++ai) {
            float sq[4];
            if (u.pm < 32) {
                f32x4 a[4], b[4];
#pragma unroll
                for (int m = 0; m < 4; ++m) { const float* q = ssp + (size_t)(row0 + ai * HALF + m * 16) * 8; a[m] = *(const f32x4*)q; b[m] = *(const f32x4*)(q + 4); }
#pragma unroll
                for (int m = 0; m < 4; ++m) sq[m] = ((a[m][0] + a[m][1]) + (a[m][2] + a[m][3])) + ((b[m][0] + b[m][1]) + (b[m][2] + b[m][3]));
            } else {
                unsigned long long v[4];
#pragma unroll
                for (int m = 0; m < 4; ++m) v[m] = ss[row0 + ai * HALF + m * 16];
#pragma unroll
                for (int m = 0; m < 4; ++m) sq[m] = ss_val(v[m]);
            }
#pragma unroll
            for (int m = 0; m < 4; ++m) { const float rstd = rsqrtf(sq[m] * (1.0f / 2048.0f) + 1e-6f);
#pragma unroll
                for (int bj = 0; bj < 2; ++bj) { acc[ai][bj][m][0] *= rstd; acc[ai][bj][m][1] *= rstd; } }
            __builtin_amdgcn_sched_barrier(0);
        }
        if (u.pn == 44) {
            if (wc == 0 && fq == 0) {
#pragma unroll
                for (int ai = 0; ai < 2; ++ai)
#pragma unroll
                    for (int m = 0; m < 4; ++m) { float* o = IFo + (size_t)(row0 + ai * HALF + m * 16) * 8; *(f32x4*)o = acc[ai][0][m][0]; *(f32x4*)(o + 4) = acc[ai][0][m][1]; }
            }
        } else if (u.pn >= 28) {
            const int ch = 128 * (u.pn - 28) + cw;
            const f32x4 bm0 = *(const f32x4*)(bg + ch), bm1 = *(const f32x4*)(bg + ch + 4), br0 = *(const f32x4*)(bg + 2048 + ch), br1 = *(const f32x4*)(bg + 2048 + ch + 4);
#pragma unroll
            for (int ai = 0; ai < 2; ++ai)
#pragma unroll
                for (int m = 0; m < 4; ++m) { const size_t row = (size_t)(row0 + ai * HALF + m * 16);
                    const f32x4 vm0 = acc[ai][0][m][0] + bm0, vm1 = acc[ai][0][m][1] + bm1, vr0 = acc[ai][1][m][0] + br0, vr1 = acc[ai][1][m][1] + br1;
                    float rt[8], gr[8];
#pragma unroll
                    for (int j = 0; j < 4; ++j) {
                        const float er0 = 1.0f + __expf(-vr0[j]), er1 = 1.0f + __expf(-vr1[j]);
                        rt[j] = er0 * __builtin_amdgcn_rcpf(1.0f + __expf(-vm0[j])); rt[4 + j] = er1 * __builtin_amdgcn_rcpf(1.0f + __expf(-vm1[j]));
                        gr[j] = __builtin_amdgcn_rcpf(er0); gr[4 + j] = __builtin_amdgcn_rcpf(er1); }
                    u32x4 w; w.x = cvt_pk_bf16(rt[0], rt[1]); w.y = cvt_pk_bf16(rt[2], rt[3]); w.z = cvt_pk_bf16(rt[4], rt[5]); w.w = cvt_pk_bf16(rt[6], rt[7]);
                    *(u32x4*)(RT + row * 2048 + ch) = w;
                    w.x = cvt_pk_bf16(gr[0], gr[1]); w.y = cvt_pk_bf16(gr[2], gr[3]); w.z = cvt_pk_bf16(gr[4], gr[5]); w.w = cvt_pk_bf16(gr[6], gr[7]);
                    *(u32x4*)(GRS + row * 2048 + ch) = w; }
        } else if (u.pn >= 12 && u.pn < 20) {
            const float sc = u.pn >= 16 ? 0.0625f : 1.0f;
#pragma unroll
            for (int ai = 0; ai < 2; ++ai)
#pragma unroll
                for (int m = 0; m < 4; ++m) { const int row = row0 + ai * HALF + m * 16;
                    const int pi = row < MP ? (row & (SEQ - 1)) : 2048;
                    const f32x4* cs = (const f32x4*)(rope + ((size_t)pi * 128 + cw) * 2);
                    const f32x4 t0 = cs[0], t1 = cs[1], t2 = cs[2], t3 = cs[3];
                    const f32x4 a0 = acc[ai][0][m][0], a1 = acc[ai][0][m][1], b0 = acc[ai][1][m][0], b1 = acc[ai][1][m][1];
                    const float c[8] = {t0[0], t0[2], t1[0], t1[2], t2[0], t2[2], t3[0], t3[2]}, sn[8] = {t0[1], t0[3], t1[1], t1[3], t2[1], t2[3], t3[1], t3[3]};
                    const float x1[8] = {a0[0], a0[1], a0[2], a0[3], a1[0], a1[1], a1[2], a1[3]}, x2[8] = {b0[0], b0[1], b0[2], b0[3], b1[0], b1[1], b1[2], b1[3]};
                    float o1[8], o2[8];
#pragma unroll
                    for (int j = 0; j < 8; ++j) { o1[j] = (x1[j] * c[j] - x2[j] * sn[j]) * sc; o2[j] = (x1[j] * sn[j] + x2[j] * c[j]) * sc; }
                    bf16_t* rowp = P + (size_t)row * NP + u.pn * BM + cw;
                    u32x4 w; w.x = cvt_pk_bf16(o1[0], o1[1]); w.y = cvt_pk_bf16(o1[2], o1[3]); w.z = cvt_pk_bf16(o1[4], o1[5]); w.w = cvt_pk_bf16(o1[6], o1[7]);
                    *(u32x4*)rowp = w;
                    w.x = cvt_pk_bf16(o2[0], o2[1]); w.y = cvt_pk_bf16(o2[2], o2[3]); w.z = cvt_pk_bf16(o2[4], o2[5]); w.w = cvt_pk_bf16(o2[6], o2[7]);
                    *(u32x4*)(rowp + HALF) = w; }
        } else {
#pragma unroll
            for (int ai = 0; ai < 2; ++ai)
#pragma unroll
                for (int m = 0; m < 4; ++m) { bf16_t* rowp = P + (size_t)(row0 + ai * HALF + m * 16) * NP + u.pn * BM + cw;
#pragma unroll
                    for (int bj = 0; bj < 2; ++bj) { const f32x4 v0 = acc[ai][bj][m][0], v1 = acc[ai][bj][m][1];
                        u32x4 w; w.x = cvt_pk_bf16(v0[0], v0[1]); w.y = cvt_pk_bf16(v0[2], v0[3]); w.z = cvt_pk_bf16(v1[0], v1[1]); w.w = cvt_pk_bf16(v1[2], v1[3]);
                        *(u32x4*)(rowp + bj * HALF) = w; } }
        }
    }
};
struct EpiMerged {
    static constexpr bool PERM = true;
    bf16_t* O; const bf16_t* RT; const bf16_t* GRS;
    __device__ __forceinline__ void scale(f32x4 (&acc)[2][2][4][2], const bf16_t* S, const Unit& u, int wr, int wc, int fr, int fq) const {
        asm volatile("" : "+v"(fr), "+v"(fq));
        const int row0 = u.pm * BM + wr * 64 + fr, col0 = u.pn * BM + wc * 32 + 8 * fq;
#pragma unroll
        for (int ai = 0; ai < 2; ++ai) {
            u32x4 sv[4][2];
#pragma unroll
            for (int m = 0; m < 4; ++m)
#pragma unroll
                for (int bj = 0; bj < 2; ++bj) sv[m][bj] = *(const u32x4*)(S + (size_t)(row0 + ai * HALF + m * 16) * 2048 + col0 + bj * HALF);
#pragma unroll
            for (int m = 0; m < 4; ++m)
#pragma unroll
                for (int bj = 0; bj < 2; ++bj) { const u32x4 a = sv[m][bj];
                    acc[ai][bj][m][0][0] *= __uint_as_float(a.x << 16); acc[ai][bj][m][0][1] *= __uint_as_float(a.x & 0xffff0000u);
                    acc[ai][bj][m][0][2] *= __uint_as_float(a.y << 16); acc[ai][bj][m][0][3] *= __uint_as_float(a.y & 0xffff0000u);
                    acc[ai][bj][m][1][0] *= __uint_as_float(a.z << 16); acc[ai][bj][m][1][1] *= __uint_as_float(a.z & 0xffff0000u);
                    acc[ai][bj][m][1][2] *= __uint_as_float(a.w << 16); acc[ai][bj][m][1][3] *= __uint_as_float(a.w & 0xffff0000u); }
        }
    }
    __device__ __forceinline__ void mid(f32x4 (&acc)[2][2][4][2], const Unit& u, int wr, int wc, int fr, int fq) const { scale(acc, RT, u, wr, wc, fr, fq); }
    __device__ __forceinline__ void operator()(f32x4 (&acc)[2][2][4][2], const Unit& u, int wr, int wc, int fr, int fq) const {
        scale(acc, GRS, u, wr, wc, fr, fq);
        const int row0 = u.pm * BM + wr * 64 + fr, col0 = u.pn * BM + wc * 32 + 8 * fq;
#pragma unroll
        for (int ai = 0; ai < 2; ++ai)
#pragma unroll
            for (int m = 0; m < 4; ++m) { bf16_t* rowp = O + (size_t)(row0 + ai * HALF + m * 16) * 2048 + col0;
#pragma unroll
                for (int bj = 0; bj < 2; ++bj) { const f32x4 v0 = acc[ai][bj][m][0], v1 = acc[ai][bj][m][1];
                    u32x4 w; w.x = cvt_pk_bf16(v0[0], v0[1]); w.y = cvt_pk_bf16(v0[2], v0[3]); w.z = cvt_pk_bf16(v1[0], v1[1]); w.w = cvt_pk_bf16(v1[2], v1[3]);
                    *(u32x4*)(rowp + bj * HALF) = w; } }
    }
};
struct EpiResidual {
    static constexpr bool PERM = true;
    bf16_t* Xb; float* ssp; LAS float* red;
    __device__ __forceinline__ void operator()(f32x4 (&acc)[2][2][4][2], const Unit& u, int wr, int wc, int fr, int fq) const {
        const int row0 = u.pm * BM + wr * 64 + fr, col0 = u.pn * BM + wc * 32 + 8 * fq;
#pragma unroll
        for (int ai = 0; ai < 2; ++ai) {
            u32x4 xv[4][2];
#pragma unroll
            for (int m = 0; m < 4; ++m)
#pragma unroll
                for (int bj = 0; bj < 2; ++bj) xv[m][bj] = *(const u32x4*)(Xb + (size_t)(row0 + ai * HALF + m * 16) * 2048 + col0 + bj * HALF);
#pragma unroll
            for (int m = 0; m < 4; ++m) { float sq = 0.f;
#pragma unroll
                for (int bj = 0; bj < 2; ++bj) { const u32x4 a = xv[m][bj]; const f32x4 v0 = acc[ai][bj][m][0], v1 = acc[ai][bj][m][1];
                    u32x4 w;
                    w.x = cvt_pk_bf16(v0[0] + __uint_as_float(a.x << 16), v0[1] + __uint_as_float(a.x & 0xffff0000u)); w.y = cvt_pk_bf16(v0[2] + __uint_as_float(a.y << 16), v0[3] + __uint_as_float(a.y & 0xffff0000u));
                    w.z = cvt_pk_bf16(v1[0] + __uint_as_float(a.z << 16), v1[1] + __uint_as_float(a.z & 0xffff0000u)); w.w = cvt_pk_bf16(v1[2] + __uint_as_float(a.w << 16), v1[3] + __uint_as_float(a.w & 0xffff0000u));
                    *(u32x4*)(Xb + (size_t)(row0 + ai * HALF + m * 16) * 2048 + col0 + bj * HALF) = w;
                    const unsigned ww[4] = {w.x, w.y, w.z, w.w};
#pragma unroll
                    for (int q = 0; q < 4; ++q) { const float lo = __uint_as_float(ww[q] << 16), hi = __uint_as_float(ww[q] & 0xffff0000u); sq += lo * lo + hi * hi; } }
                sq += __shfl_xor(sq, 16); sq += __shfl_xor(sq, 32);
                if (fq == 0) red[(wr * 64 + fr + ai * HALF + m * 16) * 4 + wc] = sq; }
        }
        asm volatile("s_waitcnt lgkmcnt(0)" ::: "memory"); __builtin_amdgcn_s_barrier(); asm volatile("" ::: "memory");
        int t = threadIdx.x; asm volatile("" : "+v"(t));
        if (t < 256) { const f32x4 q = *(LAS const f32x4*)(red + 4 * t); ssp[(size_t)(u.pm * BM + t) * 8 + u.pn] = (q[0] + q[1]) + (q[2] + q[3]); }
        asm volatile("s_waitcnt lgkmcnt(0)" ::: "memory"); __builtin_amdgcn_s_barrier(); asm volatile("" ::: "memory");
    }
};

template <bool MID, class Epi, class Sched, bool ALIGN_EPI = true>
__device__ __forceinline__ void gemm_phase(LAS unsigned char* lds, const Gemm g, const Sched& S, const Epi& E) {
    const int tid = opaque_tid(), wid = __builtin_amdgcn_readfirstlane(tid >> 6), lane = tid & 63, wr = wid >> 2, wc = wid & 3, fr = lane & 15, fq = lane >> 4;
    const int K = g.K, nt = K / BK;
    unsigned voffA[2], voffB[2];
#pragma unroll
    for (int i = 0; i < 2; ++i) { int R, C; stage_rc(tid * 16 + i * 8192, R, C); const int Rb = Epi::PERM ? ((R & ~31) + perm32(R & 31)) : R;
        voffA[i] = (unsigned)(R * g.lda + C) * 2u; voffB[i] = (unsigned)(Rb * g.ldb + C) * 2u; }
    const size_t kstep = (size_t)(BK * 2);
    const size_t hstepA = (size_t)HALF * g.lda * 2, hstepB = (size_t)HALF * g.ldb * 2;
    const size_t tstepA = 2 * hstepA, tstepB = 2 * hstepB;
    const unsigned ldsw = (unsigned)wid * 1024u;
    const int aoff = lds_byte(wr * 64 + fr, fq * 8), boff = lds_byte(wc * 32 + fr, fq * 8);
#define PG8_SA(b, h) (((b) * 2 + (h)) * HTB)
#define PG8_SB(b, h) ((4 + (b) * 2 + (h)) * HTB)
#define PG8_STAGE(bufoff, gbase, voff) do { _Pragma("unroll") for (int _i = 0; _i < 2; ++_i) \
        __builtin_amdgcn_global_load_lds((const unsigned*)((const char*)(gbase) + (voff)[_i]), (LAS unsigned*)(lds + (bufoff) + ldsw + _i * 8192), 16, 0, 0); } while (0)
#define PG8_LDA(dst, b, h) do { _Pragma("unroll") for (int m = 0; m < 4; ++m) _Pragma("unroll") for (int k = 0; k < 2; ++k) dst[m][k] = *(const LAS bf16x8*)(lds + PG8_SA(b, h) + aoff + m * 2048 + k * 1024); } while (0)
#define PG8_LDB(dst, b, h) do { _Pragma("unroll") for (int n = 0; n < 2; ++n) _Pragma("unroll") for (int k = 0; k < 2; ++k) dst[n][k] = *(const LAS bf16x8*)(lds + PG8_SB(b, h) + boff + n * 2048 + k * 1024); } while (0)
#define PG8_MMA(ai, bj, At, Bt) do { __builtin_amdgcn_s_setprio(1); _Pragma("unroll") for (int m = 0; m < 4; ++m) _Pragma("unroll") for (int n = 0; n < 2; ++n) _Pragma("unroll") for (int k = 0; k < 2; ++k) \
        acc[ai][bj][m][n] = __builtin_amdgcn_mfma_f32_16x16x32_bf16(Bt[n][k], At[m][k], acc[ai][bj][m][n], 0, 0, 0); __builtin_amdgcn_s_setprio(0); } while (0)
#define PG8_WAIT_V(n) asm volatile("s_waitcnt vmcnt(" #n ")" ::: "memory")
#define PG8_WAIT_L(n) asm volatile("s_waitcnt lgkmcnt(" #n ")" ::: "memory")
#define PG8_BAR __builtin_amdgcn_s_barrier()
#define PG8_SCHED __builtin_amdgcn_sched_barrier(0)
#define PG8_APTR(u) ((const char*)g.A + (size_t)(u).pm * tstepA + (size_t)((u).pn >> g.a_pn_shift) * (size_t)g.a_pn_stride)
    Unit cur, nxt; int ui = 0;
    if (!S.next(0, cur)) return;
    f32x4 acc[2][2][4][2];
#pragma unroll
    for (int a = 0; a < 2; ++a)
#pragma unroll
        for (int b = 0; b < 2; ++b)
#pragma unroll
            for (int m = 0; m < 4; ++m)
#pragma unroll
                for (int n = 0; n < 2; ++n) acc[a][b][m][n] = (f32x4){0.f, 0.f, 0.f, 0.f};
    bf16x8 At[4][2], B0[2][2], B1[2][2];
    const char* cA = PG8_APTR(cur); const char* cB = (const char*)g.Bt + (size_t)cur.pn * tstepB;
    PG8_STAGE(PG8_SB(0, 0), cB, voffB); PG8_STAGE(PG8_SB(0, 1), cB + hstepB, voffB); PG8_STAGE(PG8_SA(0, 0), cA, voffA); PG8_STAGE(PG8_SA(0, 1), cA + hstepA, voffA);
    if (wr == 1) PG8_BAR;
    PG8_WAIT_V(2); PG8_BAR;
    PG8_STAGE(PG8_SB(1, 0), cB + kstep, voffB); PG8_STAGE(PG8_SA(1, 0), cA + kstep, voffA); PG8_STAGE(PG8_SB(1, 1), cB + hstepB + kstep, voffB);
    PG8_WAIT_V(6); PG8_BAR;
    for (;;) {
        const bool has_next = S.next(ui + 1, nxt);
        const char* nA = has_next ? PG8_APTR(nxt) : cA; const char* nB = has_next ? (const char*)g.Bt + (size_t)nxt.pn * tstepB : cB;
#pragma unroll 1
        for (int t = 0; t < nt; t += 2) {
            const bool last = (t == nt - 2);
            const char* a1 = cA + (size_t)(t + 1) * kstep;
            const char* a2 = last ? nA : cA + (size_t)(t + 2) * kstep; const char* b2 = last ? nB : cB + (size_t)(t + 2) * kstep;
            const char* a3 = a2 + kstep; const char* b3 = b2 + kstep;
            if constexpr (MID) { if (t == g.mid_t) E.mid(acc, cur, wr, wc, fr, fq); }
            PG8_LDB(B0, 0, 0); PG8_LDB(B1, 0, 1); PG8_SCHED; PG8_LDA(At, 0, 0); PG8_STAGE(PG8_SA(1, 1), a1 + hstepA, voffA);
            PG8_WAIT_V(8); PG8_WAIT_L(0); PG8_BAR; PG8_MMA(0, 0, At, B0); PG8_MMA(0, 1, At, B1); PG8_BAR; PG8_SCHED;
            PG8_LDA(At, 0, 1); PG8_STAGE(PG8_SB(0, 0), b2, voffB); PG8_STAGE(PG8_SB(0, 1), b2 + hstepB, voffB); PG8_STAGE(PG8_SA(0, 0), a2, voffA);
            PG8_WAIT_V(8); PG8_WAIT_L(0); PG8_BAR; PG8_MMA(1, 0, At, B0); PG8_MMA(1, 1, At, B1); PG8_BAR; PG8_SCHED;
            PG8_LDB(B0, 1, 0); PG8_LDB(B1, 1, 1); PG8_SCHED; PG8_LDA(At, 1, 0); PG8_STAGE(PG8_SA(0, 1), a2 + hstepA, voffA);
            PG8_WAIT_V(8); PG8_WAIT_L(0); PG8_BAR; PG8_MMA(0, 0, At, B0); PG8_MMA(0, 1, At, B1); PG8_BAR; PG8_SCHED;
            PG8_LDA(At, 1, 1); PG8_STAGE(PG8_SB(1, 0), b3, voffB); PG8_STAGE(PG8_SB(1, 1), b3 + hstepB, voffB); PG8_STAGE(PG8_SA(1, 0), a3, voffA);
            PG8_WAIT_V(8); PG8_WAIT_L(0); PG8_BAR; PG8_MMA(1, 0, At, B0); PG8_MMA(1, 1, At, B1); PG8_BAR; PG8_SCHED;
        }
        if constexpr (ALIGN_EPI) { if (wr == 0) PG8_BAR; }
        E(acc, cur, wr, wc, fr, fq);
        if (!has_next) break;
#pragma unroll
        for (int a = 0; a < 2; ++a)
#pragma unroll
            for (int b = 0; b < 2; ++b)
#pragma unroll
                for (int m = 0; m < 4; ++m)
#pragma unroll
                    for (int n = 0; n < 2; ++n) acc[a][b][m][n] = (f32x4){0.f, 0.f, 0.f, 0.f};
        cur = nxt; cA = nA; cB = nB; ++ui;
        if constexpr (ALIGN_EPI) { if (wr == 1) PG8_BAR; }
    }
    PG8_WAIT_V(0);
    if constexpr (!ALIGN_EPI) { if (wr == 0) PG8_BAR; }
    PG8_BAR;
#undef PG8_SA
#undef PG8_SB
#undef PG8_STAGE
#undef PG8_LDA
#undef PG8_LDB
#undef PG8_MMA
#undef PG8_WAIT_V
#undef PG8_WAIT_L
#undef PG8_BAR
#undef PG8_SCHED
#undef PG8_APTR
}
}

struct TrDesc { const float* src; bf16_t* dst; const float* ks; int ldsrc, ldd; float scale; };
__device__ __forceinline__ TrDesc tr_desc(const Params& p, int it) {
    constexpr int T0 = 1536, T1 = T0 + 2048, T2 = T1 + 2048, T3 = T2 + 512, T4 = T3 + 512, T5 = T4 + 1024, T6 = T5 + 64, T7 = T6 + 64;
    const int l = it / T7, r = it % T7;
    bf16_t* Wl = p.W_() + (size_t)l * WL;
    TrDesc d; d.scale = 1.f; d.ks = nullptr;
    int k0, c0, r0, kd0; const float* src; bf16_t* dst;
    if (r < T0)      { const int q = r;      src = p.w_in + (size_t)l * D * NIN; d.ldsrc = NIN; k0 = (q & 31) * 64; c0 = (q >> 5) * 64; dst = Wl + W1_OFF; d.ldd = D; r0 = (q >> 5) * 64; kd0 = k0; d.ks = p.norm_g + (size_t)l * D; }
    else if (r < T1) { const int q = r - T0; src = p.w_in + (size_t)l * D * NIN; d.ldsrc = NIN; k0 = (q & 31) * 64; c0 = 3080 + (q >> 5) * 64; dst = Wl + W1_OFF; d.ldd = D; r0 = 3072 + (q >> 5) * 64; kd0 = k0; d.ks = p.norm_g + (size_t)l * D; }
    else if (r < T2) { const int q = r - T1, ct = q >> 5;
                       src = p.w_gate + (size_t)l * D * 4096; d.ldsrc = 4096; k0 = (q & 31) * 64; c0 = (((ct & 3) < 2) ? 0 : 2048) + 128 * (ct >> 2) + (ct & 1) * 64; dst = Wl + W1_OFF; d.ldd = D; r0 = C_GM + ct * 64; kd0 = k0; d.ks = p.norm_g + (size_t)l * D; }
    else if (r < T3) { const int q = r - T2; src = p.w_pm + (size_t)l * WM * D; d.ldsrc = D; k0 = (q & 15) * 64; c0 = (q >> 4) * 64; dst = Wl + W3_OFF; d.ldd = D; r0 = c0; kd0 = k0; }
    else if (r < T4) { const int q = r - T3; src = p.w_pr + (size_t)l * WM * D; d.ldsrc = D; k0 = (q & 15) * 64; c0 = (q >> 4) * 64; dst = Wl + W3_OFF; d.ldd = D; r0 = c0; kd0 = 1024 + k0; }
    else if (r < T5) { const int q = r - T4; src = p.w_o + (size_t)l * D * D; d.ldsrc = D; k0 = (q & 31) * 64; c0 = (q >> 5) * 64; dst = Wl + W4_OFF; d.ldd = D; r0 = c0; kd0 = k0; }
    else if (r < T6) { const int q = r - T5, h = q >> 4, qq = q & 15; src = p.w_qm + ((size_t)l * HM + h) * SZ; d.ldsrc = DH; k0 = (qq & 3) * 64; c0 = (qq >> 2) * 64; dst = Wl + W2_OFF; d.ldd = DH; r0 = h * 512 + c0; kd0 = k0; d.scale = 0.0625f; }
    else             { const int q = r - T6, h = q >> 4, qq = q & 15; src = p.w_km + ((size_t)l * HM + h) * SZ; d.ldsrc = DH; k0 = (qq & 3) * 64; c0 = (qq >> 2) * 64; dst = Wl + W2_OFF; d.ldd = DH; r0 = h * 512 + 256 + c0; kd0 = k0; }
    d.src = src + (size_t)k0 * d.ldsrc + c0; d.dst = dst + (size_t)r0 * d.ldd + kd0; if (d.ks) d.ks += k0;
    return d;
}
__device__ __forceinline__ void tr_load(const TrDesc& d, f32x4 (&v)[16], f32x4 (&ks)[2], int lane) {
#pragma unroll
    for (int i = 0; i < 16; ++i) v[i] = __builtin_nontemporal_load((const f32x4*)(d.src + (size_t)((lane >> 4) + 4 * i) * d.ldsrc + 4 * (lane & 15)));
    if (d.ks) { ks[0] = *(const f32x4*)(d.ks + 8 * (lane & 7)); ks[1] = *(const f32x4*)(d.ks + 8 * (lane & 7) + 4); }
    else { ks[0] = (f32x4){1.f, 1.f, 1.f, 1.f}; ks[1] = ks[0]; }
}
__device__ __forceinline__ void tr_store(const TrDesc& d, const f32x4 (&v)[16], const f32x4 (&ks)[2], LAS float* t, int lane) {
#pragma unroll
    for (int i = 0; i < 16; ++i)
#pragma unroll
        for (int j = 0; j < 4; ++j) t[((lane >> 4) + 4 * i) * 65 + 4 * (lane & 15) + j] = v[i][j];
    const int c = lane & 7;
    const f32x4 s0 = ks[0] * d.scale, s1 = ks[1] * d.scale;
#pragma unroll
    for (int j = 0; j < 8; ++j) { const int n = (lane >> 3) + 8 * j; const LAS float* q = t + (8 * c) * 65 + n;
        u32x4 o; o.x = pk2(s0[0] * q[0], s0[1] * q[65]); o.y = pk2(s0[2] * q[130], s0[3] * q[195]); o.z = pk2(s1[0] * q[260], s1[1] * q[325]); o.w = pk2(s1[2] * q[390], s1[3] * q[455]);
        *(u32x4*)(d.dst + (size_t)n * d.ldd + 8 * c) = o; }
}
__device__ __forceinline__ void prep_phase(const Params& p, int wg, int nwg, LAS unsigned char* lds) {
    const int tid = opaque_tid();
    {
        const int lane = tid & 63, wid = tid >> 6;
        for (int row = wg * 8 + wid; row < MPAD; row += nwg * 8) {
            u32x2* hrow = (u32x2*)(p.Xb_() + (size_t)row * D);
            float ss = 0.f;
            if (row < MT) {
                const f32x4* xr = (const f32x4*)(row < MP ? p.x_prompt + (size_t)row * D : p.x_sample + (size_t)(row - MP) * D);
#pragma unroll
                for (int i = 0; i < 8; ++i) { const f32x4 v = xr[lane + 64 * i]; ss += (v[0] * v[0] + v[1] * v[1]) + (v[2] * v[2] + v[3] * v[3]); hrow[lane + 64 * i] = (u32x2){pk2(v[0], v[1]), pk2(v[2], v[3])}; }
                ss = wave_sum(ss);
            } else {
#pragma unroll
                for (int i = 0; i < 8; ++i) hrow[lane + 64 * i] = (u32x2){0u, 0u};
            }
            if (lane < 5) p.SS_()[(size_t)lane * MPAD + row] = lane == 0 ? ss_fix(ss) : 0ull;
            if (row < MP && lane < 8) p.SSP_()[(size_t)row * 8 + lane] = lane == 0 ? ss : 0.f;
        }
    }
    for (int i = wg * 512 + tid; i < 2049 * 128; i += nwg * 512) {
        const int pi = i >> 7, j = i & 127;
        const float pos = pi < 2048 ? (float)pi : 16384.0f;
        const float inv = powf(10000.0f, -((float)j / 128.0f));
        const float ang = pos * inv;
        p.ROPE_()[2 * i] = (float)cos((double)ang); p.ROPE_()[2 * i + 1] = (float)sin((double)ang);
    }
    for (int i = wg * 512 + tid; i < DEPTH * 256 * D; i += nwg * 512) {
        const int l = i / (256 * D), r = i % (256 * D), j = r / D, k = r % D;
        p.W_()[(size_t)l * WL + W1_OFF + (size_t)(11264 + j) * D + k] = j < 8 ? f2bf(p.w_in[((size_t)l * D + k) * NIN + 3072 + j] * p.norm_g[(size_t)l * D + k]) : (bf16_t)0;
    }
    const int lane = tid & 63, wid = tid >> 6;
    LAS float* t = (LAS float*)lds + wid * (64 * 65);
    constexpr int NT = DEPTH * 7808;
    int it = wg * 8 + wid;
    if (it < NT) {
        TrDesc d = tr_desc(p, it);
        f32x4 v[16], ks[2];
        tr_load(d, v, ks, lane);
        for (;;) {
            const int it2 = it + nwg * 8;
            const bool has = it2 < NT;
            TrDesc d2 = d; f32x4 v2[16], ks2[2];
            if (has) { d2 = tr_desc(p, it2); tr_load(d2, v2, ks2, lane); }
            tr_store(d, v, ks, t, lane);
            if (!has) break;
#pragma unroll
            for (int i = 0; i < 16; ++i) v[i] = v2[i];
            ks[0] = ks2[0]; ks[1] = ks2[1]; d = d2; it = it2;
        }
    }
}

__device__ __forceinline__ void final_phase(const Params& p, int wg, int nwg) {
    const int tid_ = opaque_tid(), lane = tid_ & 63, wid = tid_ >> 6;
    const f32x4* g4 = (const f32x4*)p.final_g;
    for (int row = wg * 8 + wid; row < MT; row += nwg * 8) {
        const u32x2* xr = (const u32x2*)(p.Xb_() + (size_t)row * D);
        f32x4* yr = (f32x4*)(p.out + (row < MP ? O_YP + (size_t)row * D : O_YS + (size_t)(row - MP) * D));
        const float rstd = rsqrtf(row_ss(p.SSP_(), p.SS_() + (size_t)4 * MPAD, row) * (1.0f / D) + EPS);
#pragma unroll
        for (int i = 0; i < 8; ++i) { const u32x2 xb = xr[lane + 64 * i];
            const f32x4 v = (f32x4){__uint_as_float(xb.x << 16), __uint_as_float(xb.x & 0xffff0000u), __uint_as_float(xb.y << 16), __uint_as_float(xb.y & 0xffff0000u)};
            yr[lane + 64 * i] = v * rstd * g4[lane + 64 * i]; }
    }
}

__device__ __forceinline__ void unpack8(const u32x4 v, float (&f)[8]) {
    f[0] = __uint_as_float(v.x << 16); f[1] = __uint_as_float(v.x & 0xffff0000u); f[2] = __uint_as_float(v.y << 16); f[3] = __uint_as_float(v.y & 0xffff0000u);
    f[4] = __uint_as_float(v.z << 16); f[5] = __uint_as_float(v.z & 0xffff0000u); f[6] = __uint_as_float(v.w << 16); f[7] = __uint_as_float(v.w & 0xffff0000u);
}
__device__ __forceinline__ u32x4 pack8(const float (&f)[8]) { u32x4 w; w.x = pk2(f[0], f[1]); w.y = pk2(f[2], f[3]); w.z = pk2(f[4], f[5]); w.w = pk2(f[6], f[7]); return w; }

__device__ __forceinline__ void conv_phase(const Params& p, int layer, int wg, int nwg) {
    const int tid = opaque_tid();
    const float* cw = p.conv_w + (size_t)layer * 4 * WM;
    const float* cb = p.conv_b + (size_t)layer * WM;
    for (int it = wg * 512 + tid; it < MT * 128; it += nwg * 512) {
        const int row = it >> 7, ch = (it & 127) * 8;
        float up[4][8];
        if (row < MP) {
            const int t = row & (SEQ - 1);
#pragma unroll
            for (int i = 0; i < 4; ++i) {
                if (t - 3 + i >= 0) unpack8(*(const u32x4*)(p.P_() + (size_t)(row - 3 + i) * NP + C_U + ch), up[i]);
                else {
#pragma unroll
                    for (int j = 0; j < 8; ++j) up[i][j] = 0.f;
                }
            }
            if (t >= SEQ - 3) {
                const int b = row >> 11;
                float* o = p.out + O_CVP + (((size_t)layer * BP + b) * 3 + (t - (SEQ - 3))) * WM + ch;
                *(f32x4*)o = (f32x4){up[3][0], up[3][1], up[3][2], up[3][3]}; *(f32x4*)(o + 4) = (f32x4){up[3][4], up[3][5], up[3][6], up[3][7]};
            }
        } else {
            const int b = row - MP;
            const float* hist = p.st_conv + ((size_t)layer * BS + b) * 3 * WM + ch;
#pragma unroll
            for (int i = 0; i < 3; ++i) { const f32x4 a = *(const f32x4*)(hist + (size_t)i * WM), c = *(const f32x4*)(hist + (size_t)i * WM + 4);
                up[i][0] = a[0]; up[i][1] = a[1]; up[i][2] = a[2]; up[i][3] = a[3]; up[i][4] = c[0]; up[i][5] = c[1]; up[i][6] = c[2]; up[i][7] = c[3]; }
            unpack8(*(const u32x4*)(p.P_() + (size_t)row * NP + C_U + ch), up[3]);
            float* o = p.out + O_CVS + ((size_t)layer * BS + b) * 3 * WM + ch;
#pragma unroll
            for (int i = 0; i < 3; ++i) { *(f32x4*)(o + (size_t)i * WM) = (f32x4){up[i + 1][0], up[i + 1][1], up[i + 1][2], up[i + 1][3]};
                *(f32x4*)(o + (size_t)i * WM + 4) = (f32x4){up[i + 1][4], up[i + 1][5], up[i + 1][6], up[i + 1][7]}; }
        }
        float r[8];
#pragma unroll
        for (int j = 0; j < 8; ++j) r[j] = cb[ch + j];
#pragma unroll
        for (int i = 0; i < 4; ++i)
#pragma unroll
            for (int j = 0; j < 8; ++j) r[j] += up[i][j] * cw[i * WM + ch + j];
#pragma unroll
        for (int j = 0; j < 8; ++j) r[j] = siluf_(r[j]);
        *(u32x4*)(p.CM_() + (size_t)row * WM + ch) = pack8(r);
    }
}

__device__ __forceinline__ void gate_scan(const Params& p, int layer, int b, int h, int c_own, LAS float* G) {
    const int tid = opaque_tid(), lane = tid & 63, wid = tid >> 6;
    const float bi = p.b_i[layer * HM + h], bfv = p.b_f[layer * HM + h];
#pragma unroll
    for (int q = 0; q < 2; ++q) {
        const int cc = wid + 8 * q;
        const size_t r0 = (size_t)b * SEQ + cc * 128 + 2 * lane;
        const float i0 = p.IF_()[r0 * 8 + h] + bi, i1 = p.IF_()[(r0 + 1) * 8 + h] + bi;
        const float l0 = logsigf_(p.IF_()[r0 * 8 + 4 + h] + bfv), l1 = logsigf_(p.IF_()[(r0 + 1) * 8 + 4 + h] + bfv);
        float inc = l0 + l1;
#pragma unroll
        for (int o = 1; o < 64; o <<= 1) { const float t = __shfl_up(inc, o); if (lane >= o) inc += t; }
        const float exc = inc - (l0 + l1);
        const float b0 = exc + l0, b1 = inc;
        const float g0 = i0 - b0, g1 = i1 - b1;
        const float gm = wave_max(fmaxf(g0, g1));
        const float Bc = __shfl(inc, 63);
        if (lane == 0) { G[cc] = Bc; G[16 + cc] = gm; }
        if (cc == c_own) {
            float rm = fmaxf(g0, g1);
#pragma unroll
            for (int o = 1; o < 64; o <<= 1) { const float t = __shfl_up(rm, o); if (lane >= o) rm = fmaxf(rm, t); }
            float ex = __shfl_up(rm, 1); if (lane == 0) ex = -3.0e38f;
            const float c0 = fmaxf(ex, g0), c1 = fmaxf(c0, g1);
            G[64 + 2 * lane] = b0; G[65 + 2 * lane] = b1; G[192 + 2 * lane] = g0; G[193 + 2 * lane] = g1; G[320 + 2 * lane] = c0; G[321 + 2 * lane] = c1;
        }
    }
    __syncthreads();
    if (tid == 0) { float m = -1e30f; for (int cc = 0; cc < 16; ++cc) { G[32 + cc] = m; m = G[cc] + fmaxf(m, G[16 + cc]); } G[48] = m; }
    __syncthreads();
    if (c_own >= 0 && tid < 128) G[320 + tid] = fmaxf(G[320 + tid], G[32 + c_own]);
    __syncthreads();
}

template <int I> struct IC { static constexpr int value = I; };
template <int I, int N, class F> __device__ __forceinline__ void sfor(F&& f) { if constexpr (I < N) { f(IC<I>{}); sfor<I + 1, N>(f); } }

template <int CPR>
__device__ __forceinline__ void tile_load(u32x4 (&r)[8], const bf16_t* src, int ld_src, int tid) {
#pragma unroll
    for (int i = 0; i < 8; ++i) { const int id = tid + 512 * i, row = id / CPR, ch = id % CPR; r[i] = *(const u32x4*)(src + (size_t)row * ld_src + ch * 8); }
}
template <int CPR, int LDB>
__device__ __forceinline__ void tile_store(LAS unsigned char* dst, const u32x4 (&r)[8], int tid) {
#pragma unroll
    for (int i = 0; i < 8; ++i) { const int id = tid + 512 * i, row = id / CPR, ch = id % CPR; *(LAS u32x4*)(dst + row * LDB + ch * 16) = r[i]; }
}
__device__ __forceinline__ void tile_store_w(LAS unsigned char* dst, const u32x4 (&r)[8], LAS const float* w, int tid) {
#pragma unroll
    for (int i = 0; i < 8; ++i) { const int id = tid + 512 * i, row = id >> 5, ch = id & 31; float f[8]; unpack8(r[i], f); const float ww = w[row];
#pragma unroll
        for (int j = 0; j < 8; ++j) f[j] *= ww;
        *(LAS u32x4*)(dst + row * 544 + ch * 16) = pack8(f); }
}
template <int OFF, int HS>
__device__ __forceinline__ bf16x8 tr_frag1(unsigned base) {
    u32x2 l0, h0;
    asm volatile("ds_read_b64_tr_b16 %0, %2 offset:%3\n\tds_read_b64_tr_b16 %1, %2 offset:%4\n\ts_waitcnt lgkmcnt(0)"
                 : "=&v"(l0), "=&v"(h0) : "v"(base), "i"(OFF), "i"(OFF + HS) : "memory");
    const u32x4 v = (u32x4){l0.x, l0.y, h0.x, h0.y};
    return __builtin_bit_cast(bf16x8, v);
}
template <int OFF, int HS, int TS>
__device__ __forceinline__ void tr_frag4(unsigned base, bf16x8 (&f)[4]) {
    u32x2 l0, l1, l2, l3, h0, h1, h2, h3;
    asm volatile("ds_read_b64_tr_b16 %0, %8 offset:%9\n\tds_read_b64_tr_b16 %4, %8 offset:%10\n\t"
                 "ds_read_b64_tr_b16 %1, %8 offset:%11\n\tds_read_b64_tr_b16 %5, %8 offset:%12\n\t"
                 "ds_read_b64_tr_b16 %2, %8 offset:%13\n\tds_read_b64_tr_b16 %6, %8 offset:%14\n\t"
                 "ds_read_b64_tr_b16 %3, %8 offset:%15\n\tds_read_b64_tr_b16 %7, %8 offset:%16\n\t"
                 "s_waitcnt lgkmcnt(0)"
                 : "=&v"(l0), "=&v"(l1), "=&v"(l2), "=&v"(l3), "=&v"(h0), "=&v"(h1), "=&v"(h2), "=&v"(h3)
                 : "v"(base), "i"(OFF), "i"(OFF + HS), "i"(OFF + TS), "i"(OFF + TS + HS), "i"(OFF + 2 * TS), "i"(OFF + 2 * TS + HS), "i"(OFF + 3 * TS), "i"(OFF + 3 * TS + HS)
                 : "memory");
    f[0] = __builtin_bit_cast(bf16x8, (u32x4){l0.x, l0.y, h0.x, h0.y}); f[1] = __builtin_bit_cast(bf16x8, (u32x4){l1.x, l1.y, h1.x, h1.y});
    f[2] = __builtin_bit_cast(bf16x8, (u32x4){l2.x, l2.y, h2.x, h2.y}); f[3] = __builtin_bit_cast(bf16x8, (u32x4){l3.x, l3.y, h3.x, h3.y});
}
__device__ __forceinline__ unsigned lds_addr(LAS const void* p) { return (unsigned)(size_t)p; }

template <int NR, int NC, bool WEIGHT>
__device__ __forceinline__ void stage_T(LAS unsigned char* dst, int ldd_bytes, const bf16_t* src, int ld_src, LAS const float* w) {
    const int tid_ = opaque_tid(), lane = tid_ & 63, wid = tid_ >> 6;
    constexpr int PB = NR / 128, CG = NC / 8;
#pragma unroll 1
    for (int task = wid; task < PB * CG; task += 8) {
        const int pb = task % PB, cg = task / PB, r = pb * 128 + 2 * lane;
        float a[8], c[8];
        unpack8(*(const u32x4*)(src + (size_t)r * ld_src + cg * 8), a); unpack8(*(const u32x4*)(src + (size_t)(r + 1) * ld_src + cg * 8), c);
        float w0 = 1.f, w1 = 1.f; if (WEIGHT) { w0 = w[r]; w1 = w[r + 1]; }
#pragma unroll
        for (int j = 0; j < 8; ++j) *(LAS unsigned*)(dst + (cg * 8 + j) * ldd_bytes + r * 2) = pk2(a[j] * w0, c[j] * w1);
    }
}
__device__ __forceinline__ void stage_rows(LAS unsigned char* dst, const bf16_t* src, int ld_src) {
    const int tid_ = opaque_tid();
#pragma unroll
    for (int i = 0; i < 8; ++i) { const int id = tid_ + 512 * i, row = id >> 5, ch = id & 31;
        *(LAS u32x4*)(dst + row * 528 + ch * 16) = *(const u32x4*)(src + (size_t)row * ld_src + ch * 8); }
}
__device__ __forceinline__ bf16x8 lds_frag(LAS const unsigned char* base, int row, int ld_bytes, int kbyte) { return *(LAS const bf16x8*)(base + row * ld_bytes + kbyte); }
__device__ __forceinline__ float ret_lg(int h) { return logf(1.0f - exp2f(-5.0f - (float)h)); }

template <int BR>
__device__ __forceinline__ void chunk_passA(const Params& p, int layer, int b, int h, int c, LAS unsigned char* lds) {
    LAS unsigned char* Xt = lds; LAS unsigned char* Yt = lds + 69632; LAS float* G = (LAS float*)(lds + 139264); LAS float* wk = G + 512;
    const int tid = opaque_tid(), lane = tid & 63, w = __builtin_amdgcn_readfirstlane(tid >> 6), g = lane >> 4, lr = lane & 15;
    const size_t row0 = (size_t)b * SEQ + c * 128;
    const int pi = BR * 16 + b * 4 + h;
    const bf16_t* Xp = BR == 0 ? p.QK_() + row0 * 2048 + h * 512 + 256 : p.P_() + row0 * NP + C_VR + h * 256;
    const bf16_t* Yp = BR == 0 ? p.P_() + row0 * NP + C_VM + h * 256 : p.P_() + row0 * NP + C_KR + h * 256;
    u32x4 xr[8], yr[8];
    tile_load<32>(xr, Xp, BR == 0 ? 2048 : NP, tid); tile_load<32>(yr, Yp, NP, tid);
    if (BR == 0) { gate_scan(p, layer, b, h, c, G); if (tid < 128) wk[tid] = expf(G[192 + tid] - G[320 + 127]); }
    else { if (tid < 128) wk[tid] = expf((float)(127 - tid) * ret_lg(h)); }
    __syncthreads();
    tile_store<32, 544>(Xt, xr, tid); tile_store_w(Yt, yr, wk, tid);
    __syncthreads();
    const unsigned lpart = (unsigned)(((8 * g + (lr >> 2)) * 272 + 4 * (lr & 3)) * 2);
    const unsigned baseX = lds_addr(Xt) + lpart + (unsigned)(32 * w * 2), baseY = lds_addr(Yt) + lpart;
    bf16_t* Uo = p.U_() + ((size_t)pi * 16 + c) * SZ;
    sfor<0, 2>([&](auto rt_) {
        constexpr int rt = decltype(rt_)::value;
        f32x4 acc[16];
#pragma unroll
        for (int j = 0; j < 16; ++j) acc[j] = (f32x4){0.f, 0.f, 0.f, 0.f};
        sfor<0, 4>([&](auto ks_) {
            constexpr int ks = decltype(ks_)::value;
            const bf16x8 fa = tr_frag1<ks * 32 * 544 + rt * 32, 4 * 544>(baseX);
            sfor<0, 4>([&](auto cq_) {
                constexpr int cq = decltype(cq_)::value;
                bf16x8 fb[4];
                tr_frag4<ks * 32 * 544 + cq * 128, 4 * 544, 32>(baseY, fb);
#pragma unroll
                for (int i = 0; i < 4; ++i) acc[4 * cq + i] = __builtin_amdgcn_mfma_f32_16x16x32_bf16(fa, fb[i], acc[4 * cq + i], 0, 0, 0);
            });
        });
#pragma unroll
        for (int ct = 0; ct < 16; ++ct)
            *(u32x2*)(Uo + (size_t)(16 * ct + lr) * 256 + 32 * w + 16 * rt + 4 * g) = (u32x2){pk2(acc[ct][0], acc[ct][1]), pk2(acc[ct][2], acc[ct][3])};
    });
    if (BR == 0 && tid < 256) {
        float sacc = 0.f;
        for (int ss = 0; ss < 128; ++ss) sacc += wk[ss] * bf2f(*(LAS const bf16_t*)(Xt + ss * 544 + tid * 2));
        p.NU_()[((size_t)(b * 4 + h) * 16 + c) * 256 + tid] = sacc;
    }
    __syncthreads();
}

__device__ __forceinline__ void scan_item(const Params& p, int layer, int pi, int slice, LAS unsigned char* lds) {
    LAS float* G = (LAS float*)lds; LAS float* dec = G + 512;
    const int tid = opaque_tid(), br = pi >> 4, bh = pi & 15, b = bh >> 2, h = bh & 3;
    if (br == 0) { gate_scan(p, layer, b, h, -1, G); if (tid < 16) dec[tid] = expf(G[32 + tid] - fmaxf(G[32 + tid], G[16 + tid])); }
    else if (tid < 16) dec[tid] = expf(128.0f * ret_lg(h));
    __syncthreads();
    float st[2][8];
#pragma unroll
    for (int j = 0; j < 2; ++j)
#pragma unroll
        for (int k = 0; k < 8; ++k) st[j][k] = 0.f;
    for (int c = 0; c < 16; ++c) {
        const float dc = dec[c];
#pragma unroll
        for (int j = 0; j < 2; ++j) { const size_t idx = (size_t)slice * 8192 + j * 4096 + tid * 8;
            float u[8]; unpack8(*(const u32x4*)(p.U_() + ((size_t)pi * 16 + c) * SZ + idx), u);
            *(u32x4*)(p.CS_() + ((size_t)pi * 16 + c) * SZ + idx) = pack8(st[j]);
#pragma unroll
            for (int k = 0; k < 8; ++k) st[j][k] = st[j][k] * dc + u[k]; }
    }
    float* fo = p.out + (br == 0 ? O_CP : O_SP) + (((size_t)layer * BP + b) * HM + h) * SZ;
#pragma unroll
    for (int j = 0; j < 2; ++j) { float* q = fo + (size_t)slice * 8192 + j * 4096 + tid * 8;
        *(f32x4*)q = (f32x4){st[j][0], st[j][1], st[j][2], st[j][3]}; *(f32x4*)(q + 4) = (f32x4){st[j][4], st[j][5], st[j][6], st[j][7]}; }
    if (br == 0 && slice == 0) {
        if (tid < 256) { float n = 0.f;
            for (int c = 0; c < 16; ++c) { p.NS_()[((size_t)bh * 16 + c) * 256 + tid] = n; n = dec[c] * n + p.NU_()[((size_t)bh * 16 + c) * 256 + tid]; }
            p.out[O_NP + (((size_t)layer * BP + b) * HM + h) * 256 + tid] = n; }
        if (tid == 0) p.out[O_MP + ((size_t)layer * BP + b) * HM + h] = G[48];
    }
    __syncthreads();
}

template <int BR>
__device__ __forceinline__ void chunk_passC(const Params& p, int layer, int b, int h, int c, LAS unsigned char* lds) {
    LAS unsigned char* BufB = lds; LAS unsigned char* Sw = lds + 69632; LAS float* G = (LAS float*)(lds + 104448);
    LAS float* av = G + 512; LAS float* fl = G + 640; LAS bf16_t* nbf = (LAS bf16_t*)(G + 768);
    const int tid = opaque_tid(), lane = tid & 63, w = __builtin_amdgcn_readfirstlane(tid >> 6), g = lane >> 4, lr = lane & 15;
    const size_t row0 = (size_t)b * SEQ + c * 128;
    const int pi = BR * 16 + b * 4 + h, l = 16 * w + lr;
    const float lg = ret_lg(h);
    u32x4 tr[8];
    tile_load<32>(tr, BR == 0 ? p.QK_() + row0 * 2048 + h * 512 + 256 : p.P_() + row0 * NP + C_KR + h * 256, BR == 0 ? 2048 : NP, tid);
    if (BR == 0) {
        gate_scan(p, layer, b, h, c, G);
        if (tid < 128) { av[tid] = expf(G[32 + c] - G[320 + tid]); fl[tid] = expf(-(G[64 + tid] + G[320 + tid])); }
        if (tid < 256) nbf[tid] = f2bf(p.NS_()[((size_t)(b * 4 + h) * 16 + c) * 256 + tid]);
    } else { if (tid < 128) av[tid] = expf((float)(tid + 1) * lg); }
    const bf16_t* Qp = BR == 0 ? p.QK_() + (row0 + l) * 2048 + h * 512 : p.P_() + (row0 + l) * NP + C_QR + h * 256;
    bf16x8 qf[8];
#pragma unroll
    for (int ks = 0; ks < 8; ++ks) qf[ks] = *(const bf16x8*)(Qp + 32 * ks + 8 * g);
    tile_store<32, 544>(BufB, tr, tid);
    __syncthreads();
    const bf16_t* CSp = p.CS_() + ((size_t)pi * 16 + c) * SZ;
    if (BR == 0) tile_load<32>(tr, CSp, 256, tid); else tile_load<16>(tr, CSp, 256, tid);
    float rs = 0.f;
    const float Gl = BR == 0 ? G[320 + l] : 0.f;
#pragma unroll
    for (int j = 0; j < 8; ++j) {
        f32x4 a = (f32x4){0.f, 0.f, 0.f, 0.f};
        if (j <= w) {
#pragma unroll
            for (int ks = 0; ks < 8; ++ks) a = __builtin_amdgcn_mfma_f32_16x16x32_bf16(lds_frag(BufB, 16 * j + lr, 544, (32 * ks + 8 * g) * 2), qf[ks], a, 0, 0, 0);
        }
        float v[4];
#pragma unroll
        for (int r = 0; r < 4; ++r) {
            const int sidx = 16 * j + 4 * g + r;
            float d = 0.f;
            if (sidx <= l) d = BR == 0 ? expf(G[192 + sidx] - Gl) : expf((float)(l - sidx) * lg);
            v[r] = a[r] * d; rs += v[r];
        }
        *(LAS u32x2*)(Sw + l * 272 + (16 * j + 4 * g) * 2) = (u32x2){pk2(v[0], v[1]), pk2(v[2], v[3])};
        __builtin_amdgcn_sched_barrier(0);
    }
    rs += __shfl_xor(rs, 16); rs += __shfl_xor(rs, 32);
    __syncthreads();
    f32x4 accN[16];
#pragma unroll
    for (int t = 0; t < 16; ++t) accN[t] = (f32x4){0.f, 0.f, 0.f, 0.f};
    const unsigned lq = (unsigned)(8 * g + (lr >> 2)), lp4 = (unsigned)(4 * (lr & 3));
    sfor<0, 2>([&](auto half_) {
        constexpr int half = decltype(half_)::value;
        if (BR == 0) tile_store<32, 544>(BufB, tr, tid); else tile_store<16, 272>(BufB, tr, tid);
        __syncthreads();
        if (half == 0) { if (BR == 0) tile_load<32>(tr, CSp + 128 * 256, 256, tid); else tile_load<16>(tr, CSp + 128, 256, tid); }
        else tile_load<32>(tr, p.P_() + row0 * NP + (BR == 0 ? C_VM : C_VR) + h * 256, NP, tid);
        if (BR == 0) {
#pragma unroll
            for (int t = 0; t < 8; ++t) {
#pragma unroll
                for (int ks = 0; ks < 8; ++ks)
                    accN[half * 8 + t] = __builtin_amdgcn_mfma_f32_16x16x32_bf16(lds_frag(BufB, 16 * t + lr, 544, (32 * ks + 8 * g) * 2), qf[ks], accN[half * 8 + t], 0, 0, 0);
                __builtin_amdgcn_sched_barrier(0); }
        } else {
            const unsigned base = lds_addr(BufB) + (lq * 136 + lp4) * 2;
            sfor<0, 8>([&](auto ks_) {
                constexpr int ks = decltype(ks_)::value;
                sfor<0, 2>([&](auto tq_) {
                    constexpr int tq = decltype(tq_)::value;
                    bf16x8 f[4];
                    tr_frag4<ks * 32 * 272 + tq * 128, 4 * 272, 32>(base, f);
#pragma unroll
                    for (int i = 0; i < 4; ++i) accN[half * 8 + 4 * tq + i] = __builtin_amdgcn_mfma_f32_16x16x32_bf16(f[i], qf[ks], accN[half * 8 + 4 * tq + i], 0, 0, 0);
                });
            });
        }
        __syncthreads();
    });
    float nq = 0.f;
    if (BR == 0) {
        f32x4 ad = (f32x4){0.f, 0.f, 0.f, 0.f};
#pragma unroll
        for (int ks = 0; ks < 8; ++ks) {
            bf16x8 nf = *(LAS const bf16x8*)(nbf + 32 * ks + 8 * g);
            if (lr != 0) nf = (bf16x8){0, 0, 0, 0, 0, 0, 0, 0};
            ad = __builtin_amdgcn_mfma_f32_16x16x32_bf16(nf, qf[ks], ad, 0, 0, 0);
        }
        nq = __shfl(ad[0], lr);
    }
    const float al = av[l];
#pragma unroll
    for (int t = 0; t < 16; ++t) accN[t] *= al;
    tile_store<32, 544>(BufB, tr, tid);
    __syncthreads();
    {
        const unsigned base = lds_addr(BufB) + (lq * 272 + lp4) * 2;
        sfor<0, 4>([&](auto ks_) {
            constexpr int ks = decltype(ks_)::value;
            const bf16x8 bfr = lds_frag(Sw, l, 272, (32 * ks + 8 * g) * 2);
            sfor<0, 4>([&](auto tq_) {
                constexpr int tq = decltype(tq_)::value;
                bf16x8 f[4];
                tr_frag4<ks * 32 * 544 + tq * 128, 4 * 544, 32>(base, f);
#pragma unroll
                for (int i = 0; i < 4; ++i) accN[4 * tq + i] = __builtin_amdgcn_mfma_f32_16x16x32_bf16(f[i], bfr, accN[4 * tq + i], 0, 0, 0);
            });
        });
    }
    float inv = 1.0f;
    if (BR == 0) inv = 1.0f / fmaxf(fabsf(rs + al * nq), fl[l]);
    float sm = 0.f;
#pragma unroll
    for (int t = 0; t < 16; ++t) { accN[t] *= inv; sm += (accN[t][0] + accN[t][1]) + (accN[t][2] + accN[t][3]); }
    sm += __shfl_xor(sm, 16); sm += __shfl_xor(sm, 32);
    const float mu = sm * (1.0f / 256.0f);
    float qv = 0.f;
#pragma unroll
    for (int t = 0; t < 16; ++t) { const f32x4 d = accN[t] - mu; qv += (d[0] * d[0] + d[1] * d[1]) + (d[2] * d[2] + d[3] * d[3]); }
    qv += __shfl_xor(qv, 16); qv += __shfl_xor(qv, 32);
    const float rstd = rsqrtf(qv * (1.0f / 256.0f) + EPS);
    const float* gain = (BR == 0 ? p.hn_m_g : p.hn_r_g) + (size_t)layer * WM + h * 256 + 4 * g;
    const float* skip = p.skip_m + (size_t)layer * WM + h * 256 + 4 * g;
    const size_t row = row0 + l;
    const bf16_t* zp = p.P_() + row * NP + (BR == 0 ? C_ZM : C_ZR) + h * 256 + 4 * g;
    const bf16_t* cp = p.CM_() + row * WM + h * 256 + 4 * g;
    bf16_t* op = p.OC_() + row * 2048 + BR * 1024 + h * 256 + 4 * g;
#pragma unroll
    for (int t = 0; t < 16; ++t) {
        const f32x4 ge = *(const f32x4*)(gain + 16 * t);
        const u32x2 zb = *(const u32x2*)(zp + 16 * t);
        f32x4 v = (accN[t] - mu) * rstd * ge;
        if (BR == 0) { const f32x4 sk = *(const f32x4*)(skip + 16 * t); const u32x2 cb = *(const u32x2*)(cp + 16 * t);
            v[0] += sk[0] * __uint_as_float(cb.x << 16); v[1] += sk[1] * __uint_as_float(cb.x & 0xffff0000u);
            v[2] += sk[2] * __uint_as_float(cb.y << 16); v[3] += sk[3] * __uint_as_float(cb.y & 0xffff0000u); }
        const float z0 = __uint_as_float(zb.x << 16), z1 = __uint_as_float(zb.x & 0xffff0000u), z2 = __uint_as_float(zb.y << 16), z3 = __uint_as_float(zb.y & 0xffff0000u);
        *(u32x2*)(op + 16 * t) = (u32x2){pk2(v[0] * siluf_(z0), v[1] * siluf_(z1)), pk2(v[2] * siluf_(z2), v[3] * siluf_(z3))};
    }
    __syncthreads();
}

template <int BR>
__device__ __forceinline__ void sample_item(const Params& p, int layer, int b, int h, LAS unsigned char* lds) {
    LAS float* sq = (LAS float*)lds; LAS float* sk = sq + 256; LAS float* sv = sk + 256; LAS float* sn = sv + 256; LAS float* sr = sn + 256; LAS float* red = sr + 256;
    LAS float* part = red + 64;
    const int tid = opaque_tid(), lane = tid & 63, wid = tid >> 6;
    const size_t R = (size_t)MP + b;
    const size_t sidx = ((size_t)layer * BS + b) * HM + h;
    if (tid < 256) {
        if (BR == 0) { sq[tid] = bf2f(p.QK_()[R * 2048 + h * 512 + tid]); sk[tid] = bf2f(p.QK_()[R * 2048 + h * 512 + 256 + tid]); sv[tid] = bf2f(p.P_()[R * NP + C_VM + h * 256 + tid]); sn[tid] = p.st_n[sidx * 256 + tid]; }
        else { sq[tid] = bf2f(p.P_()[R * NP + C_QR + h * 256 + tid]); sk[tid] = bf2f(p.P_()[R * NP + C_KR + h * 256 + tid]); sv[tid] = bf2f(p.P_()[R * NP + C_VR + h * 256 + tid]); sn[tid] = 0.f; }
    }
    __syncthreads();
    float pq = 0.f, pn = 0.f;
    if (tid < 256) { pq = sq[tid] * sk[tid]; pn = sn[tid] * sq[tid]; }
    block_sum2(pq, pn, red);
    const float qk = pq, nq = pn;
    float wgt = 1.f, a = 1.f, mt = 0.f;
    if (BR == 0) {
        const float ig = p.IF_()[R * 8 + h] + p.b_i[layer * HM + h];
        const float lf = logsigf_(p.IF_()[R * 8 + 4 + h] + p.b_f[layer * HM + h]);
        const float inter = lf + p.st_m[sidx];
        mt = fmaxf(inter, ig); wgt = expf(ig - mt); a = expf(inter - mt);
    } else { a = 1.0f - exp2f(-5.0f - (float)h); }
    const float* S0 = (BR == 0 ? p.st_C : p.st_S) + sidx * SZ;
    float* S1 = p.out + (BR == 0 ? O_CS : O_SS) + sidx * SZ;
    const f32x4* S0v = (const f32x4*)S0 + lane; f32x4* S1v = (f32x4*)S1 + lane;
    f32x4 cc[8], cn[8];
#pragma unroll
    for (int j = 0; j < 8; ++j) cc[j] = __builtin_nontemporal_load(S0v + 64 * (wid + 8 * j));
    if (BR == 0) {
        const f32x4 q4 = *(LAS const f32x4*)(sq + 4 * lane), k4 = *(LAS const f32x4*)(sk + 4 * lane);
#pragma unroll
        for (int i0 = 0; i0 < 32; i0 += 8) {
            if (i0 + 8 < 32) {
#pragma unroll
                for (int j = 0; j < 8; ++j) cn[j] = __builtin_nontemporal_load(S0v + 64 * (wid + 8 * (i0 + 8 + j)));
            }
#pragma unroll
            for (int j = 0; j < 8; ++j) { const int e = wid + 8 * (i0 + j);
                float pt = (cc[j][0] * q4[0] + cc[j][1] * q4[1]) + (cc[j][2] * q4[2] + cc[j][3] * q4[3]);
                const float wv = wgt * sv[e];
                __builtin_nontemporal_store(cc[j] * a + k4 * wv, S1v + 64 * e);
                pt = wave_sum(pt);
                if (lane == 0) sr[e] = pt; }
#pragma unroll
            for (int j = 0; j < 8; ++j) cc[j] = cn[j];
        }
    } else {
        const f32x4 v4 = *(LAS const f32x4*)(sv + 4 * lane);
        f32x4 ac = (f32x4){0.f, 0.f, 0.f, 0.f};
#pragma unroll
        for (int i0 = 0; i0 < 32; i0 += 8) {
            if (i0 + 8 < 32) {
#pragma unroll
                for (int j = 0; j < 8; ++j) cn[j] = __builtin_nontemporal_load(S0v + 64 * (wid + 8 * (i0 + 8 + j)));
            }
#pragma unroll
            for (int j = 0; j < 8; ++j) { const int d = wid + 8 * (i0 + j);
                ac = ac + cc[j] * sq[d];
                __builtin_nontemporal_store(cc[j] * a + v4 * sk[d], S1v + 64 * d); }
#pragma unroll
            for (int j = 0; j < 8; ++j) cc[j] = cn[j];
        }
        *(LAS f32x4*)(part + wid * 256 + 4 * lane) = ac;
    }
    __syncthreads();
    float hv = 0.f;
    if (tid < 256) {
        if (BR == 0) {
            const float ws = wgt * qk;
            const float den = fmaxf(fabsf(ws + a * nq), expf(-mt));
            hv = (ws * sv[tid] + a * sr[tid]) / den;
            p.out[O_NS + sidx * 256 + tid] = a * sn[tid] + wgt * sk[tid];
            if (tid == 0) p.out[O_MS + sidx] = mt;
        } else {
            float s = 0.f;
#pragma unroll
            for (int i = 0; i < 8; ++i) s += part[i * 256 + tid];
            hv = qk * sv[tid] + a * s;
        }
    }
    float s1 = hv, s2 = 0.f;
    block_sum2(s1, s2, red);
    const float mean = s1 * (1.0f / 256.0f);
    float dv = tid < 256 ? hv - mean : 0.f;
    float q1 = dv * dv, q2 = 0.f;
    block_sum2(q1, q2, red);
    const float rstd = rsqrtf(q1 * (1.0f / 256.0f) + EPS);
    if (tid < 256) {
        const float ge = (BR == 0 ? p.hn_m_g : p.hn_r_g)[(size_t)layer * WM + h * 256 + tid];
        float v = dv * rstd * ge;
        const float z = bf2f(p.P_()[R * NP + (BR == 0 ? C_ZM : C_ZR) + h * 256 + tid]);
        if (BR == 0) v += p.skip_m[(size_t)layer * WM + h * 256 + tid] * bf2f(p.CM_()[R * WM + h * 256 + tid]);
        p.OC_()[R * 2048 + BR * 1024 + h * 256 + tid] = f2bf(v * siluf_(z));
    }
    __syncthreads();
}

template <int MODE>
__device__ __forceinline__ void sample_gemm(const Params& p, const bf16_t* Wl, int wg, int nwg, LAS unsigned char* lds, unsigned long long* ssn) {
    const int tid = opaque_tid(), lane = tid & 63, w = tid >> 6, g = lane >> 4, lr = lane & 15;
    LAS float* red = (LAS float*)lds;
    for (int j = wg; j < 128; j += nwg) {
        const int rbase = MP + 16 * (j & 7), cbase = 128 * (j >> 3) + 16 * w;
        const bf16_t* A = (MODE == 0 ? p.OC_() : p.MG_()) + (size_t)(rbase + lr) * 2048 + 8 * g;
        const bf16_t* B = Wl + (MODE == 0 ? W3_OFF : W4_OFF) + (size_t)(cbase + lr) * 2048 + 8 * g;
        f32x4 acc[2];
#pragma unroll
        for (int hf = 0; hf < 2; ++hf) {
            acc[hf] = (f32x4){0.f, 0.f, 0.f, 0.f};
#pragma unroll 1
            for (int k0 = 0; k0 < 1024; k0 += 512) {
                bf16x8 af[16], bf[16];
#pragma unroll
                for (int i = 0; i < 16; ++i) { af[i] = *(const bf16x8*)(A + hf * 1024 + k0 + 32 * i); bf[i] = *(const bf16x8*)(B + hf * 1024 + k0 + 32 * i); }
#pragma unroll
                for (int i = 0; i < 16; ++i) acc[hf] = __builtin_amdgcn_mfma_f32_16x16x32_bf16(af[i], bf[i], acc[hf], 0, 0, 0);
            }
        }
        const int col = cbase + lr;
        float sq[4];
#pragma unroll
        for (int r = 0; r < 4; ++r) {
            const size_t row = (size_t)rbase + 4 * g + r;
            if (MODE == 0) {
                const float rt = bf2f(p.RT_()[row * 2048 + col]), gr = bf2f(p.GRS_()[row * 2048 + col]);
                p.MG_()[row * 2048 + col] = f2bf(gr * (rt * acc[0][r] + acc[1][r]));
            } else {
                const bf16_t nb = f2bf(bf2f(p.Xb_()[row * 2048 + col]) + acc[0][r] + acc[1][r]);
                p.Xb_()[row * 2048 + col] = nb;
                float q = bf2f(nb) * bf2f(nb);
                q += __shfl_xor(q, 1); q += __shfl_xor(q, 2); q += __shfl_xor(q, 4); q += __shfl_xor(q, 8);
                sq[r] = q;
            }
        }
        if (MODE == 1) {
            if (lr == 0) { red[w * 16 + 4 * g + 0] = sq[0]; red[w * 16 + 4 * g + 1] = sq[1]; red[w * 16 + 4 * g + 2] = sq[2]; red[w * 16 + 4 * g + 3] = sq[3]; }
            __syncthreads();
            if (tid < 16) { float s = 0.f;
#pragma unroll
                for (int i = 0; i < 8; ++i) s += red[i * 16 + tid];
                atomicAdd(ssn + rbase + tid, ss_fix(s)); }
            __syncthreads();
        }
    }
}

__device__ __forceinline__ void sample_gemm2(const Params& p, const bf16_t* W2t, int wg, int nwg) {
    const int tid = opaque_tid(), lane = tid & 63, w = tid >> 6, g = lane >> 4, lr = lane & 15;
    for (int j = wg; j < 128; j += nwg) {
        const int rbase = MP + 16 * (j & 7), cbase = 128 * (j >> 3) + 16 * w, head = cbase >> 9;
        const bf16_t* A = p.CM_() + (size_t)(rbase + lr) * WM + head * 256 + 8 * g;
        const bf16_t* B = W2t + (size_t)(cbase + lr) * 256 + 8 * g;
        bf16x8 af[8], bf[8];
#pragma unroll
        for (int i = 0; i < 8; ++i) { af[i] = *(const bf16x8*)(A + 32 * i); bf[i] = *(const bf16x8*)(B + 32 * i); }
        f32x4 acc = (f32x4){0.f, 0.f, 0.f, 0.f};
#pragma unroll
        for (int i = 0; i < 8; ++i) acc = __builtin_amdgcn_mfma_f32_16x16x32_bf16(af[i], bf[i], acc, 0, 0, 0);
#pragma unroll
        for (int r = 0; r < 4; ++r) p.QK_()[(size_t)(rbase + 4 * g + r) * 2048 + cbase + lr] = f2bf(acc[r]);
    }
}

__device__ __forceinline__ void phaseA(const Params& p, int layer, int wg, int nwg, LAS unsigned char* lds) {
    for (int it0 = wg; it0 < 1536; it0 += nwg) {
        const int it = (wg & 1) ? (it0 < 1024 ? it0 + 512 : it0 - 1024) : it0;
        if (it < 512) {
            const int br = it >> 8, rest = it & 255, b = rest >> 6, h = (rest >> 4) & 3, c = rest & 15;
            if (br == 0) chunk_passA<0>(p, layer, b, h, c, lds); else chunk_passA<1>(p, layer, b, h, c, lds);
        } else {
            const int s = it - 512, br = s >> 9, b = (s >> 2) & 127, h = s & 3;
            if (br == 0) sample_item<0>(p, layer, b, h, lds); else sample_item<1>(p, layer, b, h, lds);
        }
    }
}
__device__ __forceinline__ void phaseScan(const Params& p, int layer, int wg, int nwg, LAS unsigned char* lds) {
    for (int it = wg; it < 256; it += nwg) scan_item(p, layer, it >> 3, it & 7, lds);
}
__device__ __forceinline__ void phaseC(const Params& p, int layer, int wg, int nwg, LAS unsigned char* lds) {
    for (int it = wg; it < 512; it += nwg) {
        const int br = it >> 8, rest = it & 255, b = rest >> 6, h = (rest >> 4) & 3, c = rest & 15;
        if (br == 0) chunk_passC<0>(p, layer, b, h, c, lds); else chunk_passC<1>(p, layer, b, h, c, lds);
    }
}

template <int ONLY>
__device__ __forceinline__ void run_phases(const Params& p_in, int ph_lo, int ph_hi) {
    extern __shared__ __attribute__((aligned(16))) unsigned char smem_raw[];
    LAS unsigned char* lds = (LAS unsigned char*)smem_raw;
    volatile LAS unsigned* xbw = (volatile LAS unsigned*)(lds + LDS_BYTES - 16);
    const int wg_in = blockIdx.x, nwg = gridDim.x;
    const bool multi = (ph_hi - ph_lo) > 1;
    XcdBarrier bar; bar.bar = p_in.bar_(); bar.x = 0; bar.st = xbw;
    if (multi) {
        if (threadIdx.x == 0) { xbw[0] = 0u; xbw[1] = 0u; xbw[2] = 0u; xbw[3] = 0u; }
        __syncthreads();
        bar = xcd_barrier_post(p_in.bar_(), xbw);
    }
    int ph = 0; unsigned long long tacc_ = 0;
#define PHASE(KIND, ...) { if constexpr (ONLY < 0 || ONLY == KIND) { if (ph >= ph_lo && ph < ph_hi) { \
    unsigned long long t0_ = 0; if (KIND == TIMEK) t0_ = __builtin_amdgcn_s_memrealtime(); \
    Params p = p_in; int wg = wg_in; { size_t z_ = 0; asm volatile("" : "+s"(z_), "+s"(wg)); p.ws = p_in.ws + z_; p.out = p_in.out + z_; }     \
    __VA_ARGS__; if (ph + 1 < ph_hi) xcd_barrier(bar); \
    if (KIND == TIMEK) tacc_ += __builtin_amdgcn_s_memrealtime() - t0_; } } ++ph; }
    PHASE(0, prep_phase(p, wg, nwg, lds))
    for (int layer = 0; layer < DEPTH; ++layer) {
        PHASE(2, { pg8::StaticOrder S; S.init(MPAD, N1, nwg, wg); pg8::Gemm g{p.Xb_(), p.W_() + (size_t)layer * WL + W1_OFF, D, D, D, 31, 0, 0};
                pg8::EpiG1 E{p.P_(), p.b_gate + (size_t)layer * 4096, p.RT_(), p.GRS_(), p.ROPE_(), p.SS_() + (size_t)layer * MPAD, p.SSP_(), p.IF_()}; pg8::gemm_phase<false>(lds, g, S, E); })
        PHASE(3, conv_phase(p, layer, wg, nwg))
        PHASE(4, { pg8::StaticOrder S; S.init(MP, 2048, nwg, wg); pg8::Gemm g{p.CM_(), p.W_() + (size_t)layer * WL + W2_OFF, 256, WM, 256, 1, 512, 0};
                pg8::EpiBf16 E{p.QK_(), 2048}; pg8::gemm_phase<false>(lds, g, S, E); sample_gemm2(p, p.W_() + (size_t)layer * WL + W2_OFF, wg, nwg); })
        PHASE(5, phaseA(p, layer, wg, nwg, lds))
        PHASE(6, phaseScan(p, layer, wg, nwg, lds))
        PHASE(7, phaseC(p, layer, wg, nwg, lds))
        PHASE(8, { pg8::StaticOrder S; S.init(MP, 2048, nwg, wg); pg8::Gemm g{p.OC_(), p.W_() + (size_t)layer * WL + W3_OFF, 2048, 2048, 2048, 31, 0, 16};
                pg8::EpiMerged E{p.MG_(), p.RT_(), p.GRS_()}; pg8::gemm_phase<true>(lds, g, S, E); sample_gemm<0>(p, p.W_() + (size_t)layer * WL, wg, nwg, lds, nullptr); })
        PHASE(10, { pg8::StaticOrder S; S.init(MP, 2048, nwg, wg); pg8::Gemm g{p.MG_(), p.W_() + (size_t)layer * WL + W4_OFF, 2048, 2048, 2048, 31, 0, 0};
                pg8::EpiResidual E{p.Xb_(), p.SSP_(), (LAS float*)(lds + pg8::STAGE_BYTES)}; pg8::gemm_phase<false>(lds, g, S, E); sample_gemm<1>(p, p.W_() + (size_t)layer * WL, wg, nwg, lds, p.SS_() + (size_t)(layer + 1) * MPAD); })
    }
    PHASE(11, final_phase(p, wg, nwg))
    if (TIMEK >= 0 && blockIdx.x == 0) { const unsigned long long te_ = __builtin_amdgcn_s_memrealtime(); while (__builtin_amdgcn_s_memrealtime() - te_ < TIMEX * tacc_) __builtin_amdgcn_s_sleep(8); }
#undef PHASE
}
__global__ void __launch_bounds__(512, 2) mega(Params p, int ph_lo, int ph_hi) { run_phases<-1>(p, ph_lo, ph_hi); }
#ifdef DIAG
template <int K> __global__ void __launch_bounds__(512, 2) mega_k(Params p, int ph_lo, int ph_hi) { run_phases<K>(p, ph_lo, ph_hi); }
template __global__ void mega_k<0>(Params, int, int); template __global__ void mega_k<2>(Params, int, int);
template __global__ void mega_k<3>(Params, int, int); template __global__ void mega_k<4>(Params, int, int); template __global__ void mega_k<5>(Params, int, int);
template __global__ void mega_k<6>(Params, int, int); template __global__ void mega_k<7>(Params, int, int); template __global__ void mega_k<8>(Params, int, int);
template __global__ void mega_k<10>(Params, int, int); template __global__ void mega_k<11>(Params, int, int);
#endif
constexpr int N_PHASES = 2 + DEPTH * 8;

extern "C" void kernel_launch(void* const* d_in, const int* in_sizes, int n_in, void* d_out, int out_size, void* d_ws, size_t ws_size, hipStream_t stream) {
    (void)in_sizes; (void)n_in; (void)out_size; (void)ws_size;
    static int grid = 0;
    if (grid == 0) {
        int dev = 0, cus = 0;
        hipGetDevice(&dev);
        hipDeviceGetAttribute(&cus, hipDeviceAttributeMultiprocessorCount, dev);
        if (hipFuncSetAttribute((const void*)mega, hipFuncAttributeMaxDynamicSharedMemorySize, LDS_BYTES) != hipSuccess) fprintf(stderr, "hipFuncSetAttribute failed\n");
        (void)hipGetLastError();
        grid = cus > 0 ? cus : 256;
    }
    Params p{};
    const float** in = (const float**)&p;
    for (int i = 0; i < 24; ++i) in[i] = (const float*)d_in[i];
    p.out = (float*)d_out;
    p.ws = (unsigned char*)d_ws;
    if (ws_size < WS_END) { fprintf(stderr, "workspace too small: %zu < %zu\n", ws_size, (size_t)WS_END); return; }
    hipMemsetAsync(d_ws, 0, 16384, stream);
#if MK_SINGLE
    hipLaunchKernelGGL(mega, dim3(grid), dim3(512), LDS_BYTES, stream, p, 0, N_PHASES);
#else
    for (int ph = 0; ph < N_PHASES; ++ph) hipLaunchKernelGGL(mega, dim3(grid), dim3(512), LDS_BYTES, stream, p, ph, ph + 1);
#endif
}
```

```cpp
#include <hip/hip_runtime.h>
#include <stdint.h>
#include <stdio.h>

#ifndef TIMEK
#define TIMEK -1
#define TIMEX 10
#endif
#ifndef MK_SINGLE
#define MK_SINGLE 1
#endif

#define LAS __attribute__((address_space(3)))
typedef unsigned short bf16_t;
typedef short bf16x8 __attribute__((ext_vector_type(8)));
typedef float f32x4 __attribute__((ext_vector_type(4)));
typedef unsigned u32x4 __attribute__((ext_vector_type(4)));
typedef unsigned u32x2 __attribute__((ext_vector_type(2)));
typedef float f32x2_t __attribute__((ext_vector_type(2)));

constexpr int D = 2048, SEQ = 2048, BP = 4, BS = 128, DEPTH = 4, HM = 4, DH = 256, WM = 1024, NIN = 7176;
constexpr int MP = BP * SEQ, MT = MP + BS, MPAD = 8448;
constexpr int NP = 7168;
constexpr int N1 = 11520;
constexpr int C_U = 0, C_VM = 1024, C_ZM = 2048, C_QR = 3072, C_KR = 4096, C_VR = 5120, C_ZR = 6144, C_GM = 7168, C_GR = 9216;
constexpr float EPS = 1e-6f;
constexpr size_t SZ = 65536;
constexpr size_t O_YP = 0, O_YS = O_YP + 16777216, O_CP = O_YS + 262144, O_NP = O_CP + 4194304, O_MP = O_NP + 16384, O_CVP = O_MP + 64,
                 O_SP = O_CVP + 49152, O_CS = O_SP + 4194304, O_NS = O_CS + 134217728, O_MS = O_NS + 524288, O_CVS = O_MS + 2048, O_SS = O_CVS + 1572864;
constexpr size_t W1_OFF = 0, W2_OFF = W1_OFF + (size_t)N1 * D, W3_OFF = W2_OFF + (size_t)2048 * 256, W4_OFF = W3_OFF + (size_t)D * D, WL = W4_OFF + (size_t)D * D;
constexpr int LDS_BYTES = 147456;

constexpr size_t al256(size_t x) { return (x + 255) & ~(size_t)255; }
constexpr size_t OFF_BAR = 0, OFF_SS = OFF_BAR + 16384, OFF_SSP = OFF_SS + al256((size_t)5 * MPAD * 8), OFF_XB = OFF_SSP + al256((size_t)8 * MP * 4),
    OFF_P = OFF_XB + al256((size_t)MPAD * D * 2), OFF_IF = OFF_P + al256((size_t)MPAD * NP * 2), OFF_CM = OFF_IF + al256((size_t)MPAD * 8 * 4),
    OFF_QK = OFF_CM + al256((size_t)MPAD * WM * 2), OFF_OC = OFF_QK + al256((size_t)MPAD * 2048 * 2), OFF_MG = OFF_OC + al256((size_t)MPAD * 2048 * 2),
    OFF_U = OFF_MG + al256((size_t)MPAD * 2048 * 2), OFF_CS = OFF_U + al256((size_t)32 * 16 * SZ * 2), OFF_NU = OFF_CS + al256((size_t)32 * 16 * SZ * 2),
    OFF_NS = OFF_NU + al256((size_t)16 * 16 * 256 * 4), OFF_W = OFF_NS + al256((size_t)16 * 16 * 256 * 4), OFF_ROPE = OFF_W + al256((size_t)DEPTH * WL * 2),
    OFF_RT = OFF_ROPE + al256((size_t)2049 * 128 * 2 * 4), OFF_GRS = OFF_RT + al256((size_t)MPAD * 2048 * 2), OFF_GT = OFF_GRS + al256((size_t)MPAD * 2048 * 2),
    WS_END = OFF_GT + al256((size_t)16 * 6208 * 4);

struct Params {
    const float *x_prompt, *x_sample, *st_C, *st_n, *st_m, *st_conv, *st_S, *norm_g, *w_in, *conv_w, *conv_b, *w_qm, *w_km, *b_i, *b_f,
                *hn_m_g, *skip_m, *hn_r_g, *w_pm, *w_pr, *w_gate, *b_gate, *w_o, *final_g;
    float* out;
    unsigned char* ws;
#define WSF(name, type, off) __device__ __forceinline__ type* name##_() const { return (type*)(ws + (off)); }
    WSF(bar, unsigned, OFF_BAR) WSF(SS, unsigned long long, OFF_SS) WSF(SSP, float, OFF_SSP) WSF(Xb, bf16_t, OFF_XB) WSF(P, bf16_t, OFF_P) WSF(IF, float, OFF_IF)
    WSF(CM, bf16_t, OFF_CM) WSF(QK, bf16_t, OFF_QK) WSF(OC, bf16_t, OFF_OC) WSF(MG, bf16_t, OFF_MG) WSF(U, bf16_t, OFF_U) WSF(CS, bf16_t, OFF_CS)
    WSF(NU, float, OFF_NU) WSF(NS, float, OFF_NS) WSF(W, bf16_t, OFF_W) WSF(ROPE, float, OFF_ROPE) WSF(RT, bf16_t, OFF_RT) WSF(GRS, bf16_t, OFF_GRS) WSF(GT, float, OFF_GT)
#undef WSF
};


__device__ __forceinline__ unsigned long long ss_fix(float v) { return (unsigned long long)(v * 1048576.0f + 0.5f); }
__device__ __forceinline__ float ss_val(unsigned long long v) { return (float)v * (1.0f / 1048576.0f); }
__device__ __forceinline__ float row_ss(const float* ssp, const unsigned long long* ss, int row) {
    if (row < 8192) { const f32x4 a = *(const f32x4*)(ssp + (size_t)row * 8), b = *(const f32x4*)(ssp + (size_t)row * 8 + 4);
        return ((a[0] + a[1]) + (a[2] + a[3])) + ((b[0] + b[1]) + (b[2] + b[3])); }
    return ss_val(ss[row]);
}
__device__ __forceinline__ int opaque_tid() { int t = threadIdx.x; asm volatile("" : "+v"(t)); return t; }
__device__ __forceinline__ float bf2f(bf16_t v) { return __uint_as_float((unsigned)v << 16); }
__device__ __forceinline__ bf16_t f2bf(float f) { unsigned u = __float_as_uint(f); u += 0x7fffu + ((u >> 16) & 1u); return (bf16_t)(u >> 16); }
__device__ __forceinline__ unsigned pk2(float lo, float hi) { return (unsigned)f2bf(lo) | ((unsigned)f2bf(hi) << 16); }
__device__ __forceinline__ float wave_sum(float v) {
#pragma unroll
    for (int o = 32; o >= 1; o >>= 1) v += __shfl_xor(v, o);
    return v;
}
__device__ __forceinline__ float wave_max(float v) {
#pragma unroll
    for (int o = 32; o >= 1; o >>= 1) v = fmaxf(v, __shfl_xor(v, o));
    return v;
}
__device__ __forceinline__ float sigmoidf_(float x) { return __builtin_amdgcn_rcpf(1.0f + __expf(-x)); }
__device__ __forceinline__ float siluf_(float x) { return x * __builtin_amdgcn_rcpf(1.0f + __expf(-x)); }
__device__ __forceinline__ float logsigf_(float x) { return x < 0.f ? x - log1pf(expf(x)) : -log1pf(expf(-x)); }
__device__ __forceinline__ void block_sum2(float& a, float& b, LAS float* red) {
    a = wave_sum(a); b = wave_sum(b);
    __syncthreads();
    if ((threadIdx.x & 63) == 0) { red[threadIdx.x >> 6] = a; red[8 + (threadIdx.x >> 6)] = b; }
    __syncthreads();
    float sa = 0.f, sb = 0.f;
#pragma unroll
    for (int i = 0; i < 8; ++i) { sa += red[i]; sb += red[8 + i]; }
    a = sa; b = sb;
}

#define XB_TMO      128
#define XB_XCNT(j)  (256  + 64 * (j))
#define XB_XSUB(j)  (1280 + 64 * (j))
#define XB_XGEN(j)  (2304 + 64 * (j))
#define XB_TOP      3328
#define XB_TOPGEN   3392
#define XCD_BAR_WORDS 3456
#define XB_SPIN_CAP (1u << 22)

__device__ __forceinline__ unsigned xb_ld(unsigned* p)              { return __hip_atomic_load(p, __ATOMIC_RELAXED, __HIP_MEMORY_SCOPE_AGENT); }
__device__ __forceinline__ unsigned xb_add(unsigned* p, unsigned v) { return __hip_atomic_fetch_add(p, v, __ATOMIC_RELAXED, __HIP_MEMORY_SCOPE_AGENT); }
__device__ __forceinline__ unsigned xb_xcc_id() { return (unsigned)__builtin_amdgcn_s_getreg((3 << 11) | 20) & 0xFu; }
#define XB_SPIN(cond, bar) do { unsigned _sp = 0; while (cond) { __builtin_amdgcn_s_sleep(1); \
    if ((++_sp & 255u) == 0u) { if (xb_ld(&(bar)[XB_TMO])) break; if (_sp > XB_SPIN_CAP) { atomicAdd(&(bar)[XB_TMO], 1u); break; } } } } while (0)

struct XcdBarrier { unsigned* bar; unsigned x; volatile LAS unsigned* st; };

__device__ __forceinline__ XcdBarrier xcd_barrier_post(unsigned* bar, volatile LAS unsigned* st) {
    XcdBarrier b; b.bar = bar; b.x = xb_xcc_id(); b.st = st;
    if (threadIdx.x == 0) (void)xb_add(&bar[XB_XCNT(b.x)], 1u);
    return b;
}
__device__ __forceinline__ void xcd_barrier_complete(unsigned* bar, unsigned x, unsigned& nloc, unsigned& nx) {
    const unsigned G = gridDim.x * gridDim.y * gridDim.z;
    unsigned sum, cnt, mine, sp = 0u;
    for (;;) {
        sum = 0u; cnt = 0u; mine = 0u;
#pragma unroll
        for (unsigned j = 0; j < 16; ++j) { const unsigned c = xb_ld(&bar[XB_XCNT(j)]); sum += c; cnt += (c > 0u) ? 1u : 0u; mine = (j == x) ? c : mine; }
        if (sum == G) break;
        __builtin_amdgcn_s_sleep(1);
        if ((++sp & 255u) == 0u) { if (xb_ld(&bar[XB_TMO])) break; if (sp > XB_SPIN_CAP) { atomicAdd(&bar[XB_TMO], 1u); break; } }
    }
    nloc = mine > 0u ? mine : 1u; nx = cnt > 0u ? cnt : 1u;
}
__device__ __forceinline__ void xcd_barrier(const XcdBarrier& b) {
    asm volatile("s_waitcnt vmcnt(0)" ::: "memory");
    __syncthreads();
    if (threadIdx.x == 0) {
        unsigned* bar = b.bar;
        __builtin_amdgcn_s_waitcnt(0);
        unsigned nloc = b.st[0], nx = b.st[1];
        if (nloc == 0u) { xcd_barrier_complete(bar, b.x, nloc, nx); b.st[0] = nloc; b.st[1] = nx; }
        const unsigned old = xb_add(&bar[XB_XSUB(b.x)], 1u);
        const unsigned gen = old / nloc;
        if (old + 1u == (gen + 1u) * nloc) {
            __builtin_amdgcn_fence(__ATOMIC_RELEASE, "agent");
            asm volatile("s_waitcnt vmcnt(0)" ::: "memory");
            const unsigned og = xb_add(&bar[XB_TOP], 1u);
            const unsigned tg = og / nx;
            if (og + 1u == (tg + 1u) * nx) xb_add(&bar[XB_TOPGEN], 1u);
            else XB_SPIN(xb_ld(&bar[XB_TOPGEN]) == tg, bar);
            __builtin_amdgcn_fence(__ATOMIC_ACQUIRE, "agent");
            xb_add(&bar[XB_XGEN(b.x)], 1u);
            asm volatile("s_waitcnt vmcnt(0)" ::: "memory");
        } else {
            XB_SPIN(xb_ld(&bar[XB_XGEN(b.x)]) == gen, bar);
            __builtin_amdgcn_fence(__ATOMIC_ACQUIRE, "agent");
            asm volatile("s_waitcnt vmcnt(0)" ::: "memory");
        }
    }
    __syncthreads();
}

namespace pg8 {
constexpr int BM = 256, BK = 64, HALF = 128, HTB = HALF * BK * 2, STAGE_BYTES = 8 * HTB, NXCD = 8, WGM = 8;
__host__ __device__ __forceinline__ int lds_byte(int r, int c) { const int st = (r >> 4) * 2 + (c >> 5), rr = r & 15, cc = c & 31, ob = rr * 64 + cc * 2; return st * 1024 + (ob ^ (((ob >> 9) & 1) << 5)); }
__host__ __device__ __forceinline__ void stage_rc(int b, int& R, int& C) { const int st = b / 1024, sb = b % 1024, swz = sb ^ (((sb >> 9) & 1) << 5); R = (st >> 1) * 16 + swz / 64; C = (st & 1) * 32 + (swz % 64) / 2; }
__host__ __device__ __forceinline__ int perm32(int rho) { const int n = rho >> 4, i = rho & 15; return 8 * (i >> 2) + 4 * n + (i & 3); }

struct Unit { int pm, pn; };
struct Gemm { const bf16_t* A; const bf16_t* Bt; int K, lda, ldb, a_pn_shift, a_pn_stride, mid_t; };

struct StaticOrder {
    int nM, nN, nwg, G, c;
    __device__ void init(int M, int N, int G_, int c_) { nM = M / BM; nN = N / BM; nwg = nM * nN; G = G_; c = c_; }
    __device__ bool next(int i, Unit& u) const {
        const long L = (long)i * G + c; if (L >= nwg) return false;
        int wgid = (int)L; { const int q = nwg / NXCD, r = nwg % NXCD, xcd = wgid % NXCD, off = wgid / NXCD; wgid = (xcd < r ? xcd * (q + 1) : r * (q + 1) + (xcd - r) * q) + off; }
        const int nig = WGM * nN, gid = wgid / nig, fm = gid * WGM, gsz = (nM - fm) < WGM ? (nM - fm) : WGM;
        u.pm = fm + ((wgid % nig) % gsz); u.pn = (wgid % nig) / gsz; return true;
    }
};
__device__ __forceinline__ unsigned cvt_pk_bf16(float lo, float hi) { unsigned r; asm volatile("v_cvt_pk_bf16_f32 %0, %1, %2" : "=v"(r) : "v"(lo), "v"(hi)); return r; }

struct EpiBf16 {
    static constexpr bool PERM = true;
    bf16_t* O; int ldc;
    __device__ __forceinline__ void operator()(const f32x4 (&acc)[2][2][4][2], const Unit& u, int wr, int wc, int fr, int fq) const {
        const int row0 = u.pm * BM + wr * 64 + fr, col0 = u.pn * BM + wc * 32 + 8 * fq;
#pragma unroll
        for (int ai = 0; ai < 2; ++ai)
#pragma unroll
            for (int m = 0; m < 4; ++m) { bf16_t* rowp = O + (size_t)(row0 + ai * HALF + m * 16) * ldc + col0;
#pragma unroll
                for (int bj = 0; bj < 2; ++bj) { const f32x4 v0 = acc[ai][bj][m][0], v1 = acc[ai][bj][m][1];
                    u32x4 w; w.x = cvt_pk_bf16(v0[0], v0[1]); w.y = cvt_pk_bf16(v0[2], v0[3]); w.z = cvt_pk_bf16(v1[0], v1[1]); w.w = cvt_pk_bf16(v1[2], v1[3]);
                    *(u32x4*)(rowp + bj * HALF) = w; } }
    }
};
struct EpiG1 {
    static constexpr bool PERM = true;
    bf16_t* P; const float* bg; bf16_t* RT; bf16_t* GRS; const float* rope; const unsigned long long* ss; const float* ssp; float* IFo;
    __device__ __forceinline__ void operator()(f32x4 (&acc)[2][2][4][2], const Unit& u, int wr, int wc, int fr, int fq) const {
        const int row0 = u.pm * BM + wr * 64 + fr, cw = wc * 32 + 8 * fq;
#pragma unroll
        for (int ai = 0; ai < 2; ++ai) {
            float sq[4];
            if (u.pm < 32) {
                f32x4 a[4], b[4];
#pragma unroll
                for (int m = 0; m < 4; ++m) { const float* q = ssp + (size_t)(row0 + ai * HALF + m * 16) * 8; a[m] = *(const f32x4*)q; b[m] = *(const f32x4*)(q + 4); }
#pragma unroll
                for (int m = 0; m < 4; ++m) sq[m] = ((a[m][0] + a[m][1]) + (a[m][2] + a[m][3])) + ((b[m][0] + b[m][1]) + (b[m][2] + b[m][3]));
            } else {
                unsigned long long v[4];
#pragma unroll
                for (int m = 0; m < 4; ++m) v[m] = ss[row0 + ai * HALF + m * 16];
#pragma unroll
                for (int m = 0; m < 4; ++m) sq[m] = ss_val(v[m]);
            }
#pragma unroll
            for (int m = 0; m < 4; ++m) { const float rstd = rsqrtf(sq[m] * (1.0f / 2048.0f) + 1e-6f);
#pragma unroll
                for (int bj = 0; bj < 2; ++bj) { acc[ai][bj][m][0] *= rstd; acc[ai][bj][m][1] *= rstd; } }
            __builtin_amdgcn_sched_barrier(0);
        }
        if (u.pn == 44) {
            if (wc == 0 && fq == 0) {
#pragma unroll
                for (int ai = 0; ai < 2; ++ai)
#pragma unroll
                    for (int m = 0; m < 4; ++m) { float* o = IFo + (size_t)(row0 + ai * HALF + m * 16) * 8; *(f32x4*)o = acc[ai][0][m][0]; *(f32x4*)(o + 4) = acc[ai][0][m][1]; }
            }
        } else if (u.pn >= 28) {
            const int ch = 128 * (u.pn - 28) + cw;
            const f32x4 bm0 = *(const f32x4*)(bg + ch), bm1 = *(const f32x4*)(bg + ch + 4), br0 = *(const f32x4*)(bg + 2048 + ch), br1 = *(const f32x4*)(bg + 2048 + ch + 4);
#pragma unroll
            for (int ai = 0; ai < 2; ++ai)
#pragma unroll
                for (int m = 0; m < 4; ++m) { const size_t row = (size_t)(row0 + ai * HALF + m * 16);
                    const f32x4 vm0 = acc[ai][0][m][0] + bm0, vm1 = acc[ai][0][m][1] + bm1, vr0 = acc[ai][1][m][0] + br0, vr1 = acc[ai][1][m][1] + br1;
                    float rt[8], gr[8];
#pragma unroll
                    for (int j = 0; j < 4; ++j) {
                        const float er0 = 1.0f + __expf(-vr0[j]), er1 = 1.0f + __expf(-vr1[j]);
                        rt[j] = er0 * __builtin_amdgcn_rcpf(1.0f + __expf(-vm0[j])); rt[4 + j] = er1 * __builtin_amdgcn_rcpf(1.0f + __expf(-vm1[j]));
                        gr[j] = __builtin_amdgcn_rcpf(er0); gr[4 + j] = __builtin_amdgcn_rcpf(er1); }
                    u32x4 w; w.x = cvt_pk_bf16(rt[0], rt[1]); w.y = cvt_pk_bf16(rt[2], rt[3]); w.z = cvt_pk_bf16(rt[4], rt[5]); w.w = cvt_pk_bf16(rt[6], rt[7]);
                    *(u32x4*)(RT + row * 2048 + ch) = w;
                    w.x = cvt_pk_bf16(gr[0], gr[1]); w.y = cvt_pk_bf16(gr[2], gr[3]); w.z = cvt_pk_bf16(gr[4], gr[5]); w.w = cvt_pk_bf16(gr[6], gr[7]);
                    *(u32x4*)(GRS + row * 2048 + ch) = w; }
        } else if (u.pn >= 12 && u.pn < 20) {
            const float sc = u.pn >= 16 ? 0.0625f : 1.0f;
#pragma unroll
            for (int ai = 0; ai < 2; ++ai)
#pragma unroll
                for (int m = 0; m < 4; ++m) { const int row = row0 + ai * HALF + m * 16;
                    const int pi = row < MP ? (row & (SEQ - 1)) : 2048;
                    const f32x4* cs = (const f32x4*)(rope + ((size_t)pi * 128 + cw) * 2);
                    const f32x4 t0 = cs[0], t1 = cs[1], t2 = cs[2], t3 = cs[3];
                    const f32x4 a0 = acc[ai][0][m][0], a1 = acc[ai][0][m][1], b0 = acc[ai][1][m][0], b1 = acc[ai][1][m][1];
                    const float c[8] = {t0[0], t0[2], t1[0], t1[2], t2[0], t2[2], t3[0], t3[2]}, sn[8] = {t0[1], t0[3], t1[1], t1[3], t2[1], t2[3], t3[1], t3[3]};
                    const float x1[8] = {a0[0], a0[1], a0[2], a0[3], a1[0], a1[1], a1[2], a1[3]}, x2[8] = {b0[0], b0[1], b0[2], b0[3], b1[0], b1[1], b1[2], b1[3]};
                    float o1[8], o2[8];
#pragma unroll
                    for (int j = 0; j < 8; ++j) { o1[j] = (x1[j] * c[j] - x2[j] * sn[j]) * sc; o2[j] = (x1[j] * sn[j] + x2[j] * c[j]) * sc; }
                    bf16_t* rowp = P + (size_t)row * NP + u.pn * BM + cw;
                    u32x4 w; w.x = cvt_pk_bf16(o1[0], o1[1]); w.y = cvt_pk_bf16(o1[2], o1[3]); w.z = cvt_pk_bf16(o1[4], o1[5]); w.w = cvt_pk_bf16(o1[6], o1[7]);
                    *(u32x4*)rowp = w;
                    w.x = cvt_pk_bf16(o2[0], o2[1]); w.y = cvt_pk_bf16(o2[2], o2[3]); w.z = cvt_pk_bf16(o2[4], o2[5]); w.w = cvt_pk_bf16(o2[6], o2[7]);
                    *(u32x4*)(rowp + HALF) = w; }
        } else {
#pragma unroll
            for (int ai = 0; ai < 2; ++ai)
#pragma unroll
                for (int m = 0; m < 4; ++m) { bf16_t* rowp = P + (size_t)(row0 + ai * HALF + m * 16) * NP + u.pn * BM + cw;
#pragma unroll
                    for (int bj = 0; bj < 2; ++bj) { const f32x4 v0 = acc[ai][bj][m][0], v1 = acc[ai][bj][m][1];
                        u32x4 w; w.x = cvt_pk_bf16(v0[0], v0[1]); w.y = cvt_pk_bf16(v0[2], v0[3]); w.z = cvt_pk_bf16(v1[0], v1[1]); w.w = cvt_pk_bf16(v1[2], v1[3]);
                        *(u32x4*)(rowp + bj * HALF) = w; } }
        }
    }
};
struct EpiMerged {
    static constexpr bool PERM = true;
    bf16_t* O; const bf16_t* RT; const bf16_t* GRS;
    __device__ __forceinline__ void scale(f32x4 (&acc)[2][2][4][2], const bf16_t* S, const Unit& u, int wr, int wc, int fr, int fq) const {
        asm volatile("" : "+v"(fr), "+v"(fq));
        const int row0 = u.pm * BM + wr * 64 + fr, col0 = u.pn * BM + wc * 32 + 8 * fq;
#pragma unroll
        for (int ai = 0; ai < 2; ++ai) {
            u32x4 sv[4][2];
#pragma unroll
            for (int m = 0; m < 4; ++m)
#pragma unroll
                for (int bj = 0; bj < 2; ++bj) sv[m][bj] = *(const u32x4*)(S + (size_t)(row0 + ai * HALF + m * 16) * 2048 + col0 + bj * HALF);
#pragma unroll
            for (int m = 0; m < 4; ++m)
#pragma unroll
                for (int bj = 0; bj < 2; ++bj) { const u32x4 a = sv[m][bj];
                    acc[ai][bj][m][0][0] *= __uint_as_float(a.x << 16); acc[ai][bj][m][0][1] *= __uint_as_float(a.x & 0xffff0000u);
                    acc[ai][bj][m][0][2] *= __uint_as_float(a.y << 16); acc[ai][bj][m][0][3] *= __uint_as_float(a.y & 0xffff0000u);
                    acc[ai][bj][m][1][0] *= __uint_as_float(a.z << 16); acc[ai][bj][m][1][1] *= __uint_as_float(a.z & 0xffff0000u);
                    acc[ai][bj][m][1][2] *= __uint_as_float(a.w << 16); acc[ai][bj][m][1][3] *= __uint_as_float(a.w & 0xffff0000u); }
        }
    }
    __device__ __forceinline__ void mid(f32x4 (&acc)[2][2][4][2], const Unit& u, int wr, int wc, int fr, int fq) const { scale(acc, RT, u, wr, wc, fr, fq); }
    __device__ __forceinline__ void operator()(f32x4 (&acc)[2][2][4][2], const Unit& u, int wr, int wc, int fr, int fq) const {
        scale(acc, GRS, u, wr, wc, fr, fq);
        const int row0 = u.pm * BM + wr * 64 + fr, col0 = u.pn * BM + wc * 32 + 8 * fq;
#pragma unroll
        for (int ai = 0; ai < 2; ++ai)
#pragma unroll
            for (int m = 0; m < 4; ++m) { bf16_t* rowp = O + (size_t)(row0 + ai * HALF + m * 16) * 2048 + col0;
#pragma unroll
                for (int bj = 0; bj < 2; ++bj) { const f32x4 v0 = acc[ai][bj][m][0], v1 = acc[ai][bj][m][1];
                    u32x4 w; w.x = cvt_pk_bf16(v0[0], v0[1]); w.y = cvt_pk_bf16(v0[2], v0[3]); w.z = cvt_pk_bf16(v1[0], v1[1]); w.w = cvt_pk_bf16(v1[2], v1[3]);
                    *(u32x4*)(rowp + bj * HALF) = w; } }
    }
};
struct EpiResidual {
    static constexpr bool PERM = true;
    bf16_t* Xb; float* ssp; LAS float* red;
    __device__ __forceinline__ void operator()(f32x4 (&acc)[2][2][4][2], const Unit& u, int wr, int wc, int fr, int fq) const {
        const int row0 = u.pm * BM + wr * 64 + fr, col0 = u.pn * BM + wc * 32 + 8 * fq;
#pragma unroll
        for (int ai = 0; ai < 2; ++ai) {
            u32x4 xv[4][2];
#pragma unroll
            for (int m = 0; m < 4; ++m)
#pragma unroll
                for (int bj = 0; bj < 2; ++bj) xv[m][bj] = *(const u32x4*)(Xb + (size_t)(row0 + ai * HALF + m * 16) * 2048 + col0 + bj * HALF);
#pragma unroll
            for (int m = 0; m < 4; ++m) { float sq = 0.f;
#pragma unroll
                for (int bj = 0; bj < 2; ++bj) { const u32x4 a = xv[m][bj]; const f32x4 v0 = acc[ai][bj][m][0], v1 = acc[ai][bj][m][1];
                    u32x4 w;
                    w.x = cvt_pk_bf16(v0[0] + __uint_as_float(a.x << 16), v0[1] + __uint_as_float(a.x & 0xffff0000u)); w.y = cvt_pk_bf16(v0[2] + __uint_as_float(a.y << 16), v0[3] + __uint_as_float(a.y & 0xffff0000u));
                    w.z = cvt_pk_bf16(v1[0] + __uint_as_float(a.z << 16), v1[1] + __uint_as_float(a.z & 0xffff0000u)); w.w = cvt_pk_bf16(v1[2] + __uint_as_float(a.w << 16), v1[3] + __uint_as_float(a.w & 0xffff0000u));
                    *(u32x4*)(Xb + (size_t)(row0 + ai * HALF + m * 16) * 2048 + col0 + bj * HALF) = w;
                    const unsigned ww[4] = {w.x, w.y, w.z, w.w};
#pragma unroll
                    for (int q = 0; q < 4; ++q) { const float lo = __uint_as_float(ww[q] << 16), hi = __uint_as_float(ww[q] & 0xffff0000u); sq += lo * lo + hi * hi; } }
                sq += __shfl_xor(sq, 16); sq += __shfl_xor(sq, 32);
                if (fq == 0) red[(wr * 64 + fr + ai * HALF + m * 16) * 4 + wc] = sq; }
        }
        asm volatile("s_waitcnt lgkmcnt(0)" ::: "memory"); __builtin_amdgcn_s_barrier(); asm volatile("" ::: "memory");
        int t = threadIdx.x; asm volatile("" : "+v"(t));
        if (t < 256) { const f32x4 q = *(LAS const f32x4*)(red + 4 * t); ssp[(size_t)(u.pm * BM + t) * 8 + u.pn] = (q[0] + q[1]) + (q[2] + q[3]); }
        asm volatile("s_waitcnt lgkmcnt(0)" ::: "memory"); __builtin_amdgcn_s_barrier(); asm volatile("" ::: "memory");
    }
};

template <bool MID, class Epi, class Sched, bool ALIGN_EPI = true>
__device__ __forceinline__ void gemm_phase(LAS unsigned char* lds, const Gemm g, const Sched& S, const Epi& E) {
    const int tid = opaque_tid(), wid = __builtin_amdgcn_readfirstlane(tid >> 6), lane = tid & 63, wr = wid >> 2, wc = wid & 3, fr = lane & 15, fq = lane >> 4;
    const int K = g.K, nt = K / BK;
    unsigned voffA[2], voffB[2];
#pragma unroll
    for (int i = 0; i < 2; ++i) { int R, C; stage_rc(tid * 16 + i * 8192, R, C); const int Rb = Epi::PERM ? ((R & ~31) + perm32(R & 31)) : R;
        voffA[i] = (unsigned)(R * g.lda + C) * 2u; voffB[i] = (unsigned)(Rb * g.ldb + C) * 2u; }
    const size_t kstep = (size_t)(BK * 2);
    const size_t hstepA = (size_t)HALF * g.lda * 2, hstepB = (size_t)HALF * g.ldb * 2;
    const size_t tstepA = 2 * hstepA, tstepB = 2 * hstepB;
    const unsigned ldsw = (unsigned)wid * 1024u;
    const int aoff = lds_byte(wr * 64 + fr, fq * 8), boff = lds_byte(wc * 32 + fr, fq * 8);
#define PG8_SA(b, h) (((b) * 2 + (h)) * HTB)
#define PG8_SB(b, h) ((4 + (b) * 2 + (h)) * HTB)
#define PG8_STAGE(bufoff, gbase, voff) do { _Pragma("unroll") for (int _i = 0; _i < 2; ++_i) \
        __builtin_amdgcn_global_load_lds((const unsigned*)((const char*)(gbase) + (voff)[_i]), (LAS unsigned*)(lds + (bufoff) + ldsw + _i * 8192), 16, 0, 0); } while (0)
#define PG8_LDA(dst, b, h) do { _Pragma("unroll") for (int m = 0; m < 4; ++m) _Pragma("unroll") for (int k = 0; k < 2; ++k) dst[m][k] = *(const LAS bf16x8*)(lds + PG8_SA(b, h) + aoff + m * 2048 + k * 1024); } while (0)
#define PG8_LDB(dst, b, h) do { _Pragma("unroll") for (int n = 0; n < 2; ++n) _Pragma("unroll") for (int k = 0; k < 2; ++k) dst[n][k] = *(const LAS bf16x8*)(lds + PG8_SB(b, h) + boff + n * 2048 + k * 1024); } while (0)
#define PG8_MMA(ai, bj, At, Bt) do { __builtin_amdgcn_s_setprio(1); _Pragma("unroll") for (int m = 0; m < 4; ++m) _Pragma("unroll") for (int n = 0; n < 2; ++n) _Pragma("unroll") for (int k = 0; k < 2; ++k) \
        acc[ai][bj][m][n] = __builtin_amdgcn_mfma_f32_16x16x32_bf16(Bt[n][k], At[m][k], acc[ai][bj][m][n], 0, 0, 0); __builtin_amdgcn_s_setprio(0); } while (0)
#define PG8_WAIT_V(n) asm volatile("s_waitcnt vmcnt(" #n ")" ::: "memory")
#define PG8_WAIT_L(n) asm volatile("s_waitcnt lgkmcnt(" #n ")" ::: "memory")
#define PG8_BAR __builtin_amdgcn_s_barrier()
#define PG8_SCHED __builtin_amdgcn_sched_barrier(0)
#define PG8_APTR(u) ((const char*)g.A + (size_t)(u).pm * tstepA + (size_t)((u).pn >> g.a_pn_shift) * (size_t)g.a_pn_stride)
    Unit cur, nxt; int ui = 0;
    if (!S.next(0, cur)) return;
    f32x4 acc[2][2][4][2];
#pragma unroll
    for (int a = 0; a < 2; ++a)
#pragma unroll
        for (int b = 0; b < 2; ++b)
#pragma unroll
            for (int m = 0; m < 4; ++m)
#pragma unroll
                for (int n = 0; n < 2; ++n) acc[a][b][m][n] = (f32x4){0.f, 0.f, 0.f, 0.f};
    bf16x8 At[4][2], B0[2][2], B1[2][2];
    const char* cA = PG8_APTR(cur); const char* cB = (const char*)g.Bt + (size_t)cur.pn * tstepB;
    PG8_STAGE(PG8_SB(0, 0), cB, voffB); PG8_STAGE(PG8_SB(0, 1), cB + hstepB, voffB); PG8_STAGE(PG8_SA(0, 0), cA, voffA); PG8_STAGE(PG8_SA(0, 1), cA + hstepA, voffA);
    if (wr == 1) PG8_BAR;
    PG8_WAIT_V(2); PG8_BAR;
    PG8_STAGE(PG8_SB(1, 0), cB + kstep, voffB); PG8_STAGE(PG8_SA(1, 0), cA + kstep, voffA); PG8_STAGE(PG8_SB(1, 1), cB + hstepB + kstep, voffB);
    PG8_WAIT_V(6); PG8_BAR;
    for (;;) {
        const bool has_next = S.next(ui + 1, nxt);
        const char* nA = has_next ? PG8_APTR(nxt) : cA; const char* nB = has_next ? (const char*)g.Bt + (size_t)nxt.pn * tstepB : cB;
#pragma unroll 1
        for (int t = 0; t < nt; t += 2) {
            const bool last = (t == nt - 2);
            const char* a1 = cA + (size_t)(t + 1) * kstep;
            const char* a2 = last ? nA : cA + (size_t)(t + 2) * kstep; const char* b2 = last ? nB : cB + (size_t)(t + 2) * kstep;
            const char* a3 = a2 + kstep; const char* b3 = b2 + kstep;
            if constexpr (MID) { if (t == g.mid_t) E.mid(acc, cur, wr, wc, fr, fq); }
            PG8_LDB(B0, 0, 0); PG8_LDB(B1, 0, 1); PG8_SCHED; PG8_LDA(At, 0, 0); PG8_STAGE(PG8_SA(1, 1), a1 + hstepA, voffA);
            PG8_WAIT_V(8); PG8_WAIT_L(0); PG8_BAR; PG8_MMA(0, 0, At, B0); PG8_MMA(0, 1, At, B1); PG8_BAR; PG8_SCHED;
            PG8_LDA(At, 0, 1); PG8_STAGE(PG8_SB(0, 0), b2, voffB); PG8_STAGE(PG8_SB(0, 1), b2 + hstepB, voffB); PG8_STAGE(PG8_SA(0, 0), a2, voffA);
            PG8_WAIT_V(8); PG8_WAIT_L(0); PG8_BAR; PG8_MMA(1, 0, At, B0); PG8_MMA(1, 1, At, B1); PG8_BAR; PG8_SCHED;
            PG8_LDB(B0, 1, 0); PG8_LDB(B1, 1, 1); PG8_SCHED; PG8_LDA(At, 1, 0); PG8_STAGE(PG8_SA(0, 1), a2 + hstepA, voffA);
            PG8_WAIT_V(8); PG8_WAIT_L(0); PG8_BAR; PG8_MMA(0, 0, At, B0); PG8_MMA(0, 1, At, B1); PG8_BAR; PG8_SCHED;
            PG8_LDA(At, 1, 1); PG8_STAGE(PG8_SB(1, 0), b3, voffB); PG8_STAGE(PG8_SB(1, 1), b3 + hstepB, voffB); PG8_STAGE(PG8_SA(1, 0), a3, voffA);
            PG8_WAIT_V(8); PG8_WAIT_L(0); PG8_BAR; PG8_MMA(1, 0, At, B0); PG8_MMA(1, 1, At, B1); PG8_BAR; PG8_SCHED;
        }
        if constexpr (ALIGN_EPI) { if (wr == 0) PG8_BAR; }
        E(acc, cur, wr, wc, fr, fq);
        if (!has_next) break;
#pragma unroll
        for (int a = 0; a < 2; ++a)
#pragma unroll
            for (int b = 0; b < 2; ++b)
#pragma unroll
                for (int m = 0; m < 4; ++m)
#pragma unroll
                    for (int n = 0; n < 2; ++n) acc[a][b][m][n] = (f32x4){0.f, 0.f, 0.f, 0.f};
        cur = nxt; cA = nA; cB = nB; ++ui;
        if constexpr (ALIGN_EPI) { if (wr == 1) PG8_BAR; }
    }
    PG8_WAIT_V(0);
    if constexpr (!ALIGN_EPI) { if (wr == 0) PG8_BAR; }
    PG8_BAR;
#undef PG8_SA
#undef PG8_SB
#undef PG8_STAGE
#undef PG8_LDA
#undef PG8_LDB
#undef PG8_MMA
#undef PG8_WAIT_V
#undef PG8_WAIT_L
#undef PG8_BAR
#undef PG8_SCHED
#undef PG8_APTR
}
}

struct TrDesc { const float* src; bf16_t* dst; const float* ks; int ldsrc, ldd; float scale; };
__device__ __forceinline__ TrDesc tr_desc(const Params& p, int it) {
    constexpr int T0 = 1536, T1 = T0 + 2048, T2 = T1 + 2048, T3 = T2 + 512, T4 = T3 + 512, T5 = T4 + 1024, T6 = T5 + 64, T7 = T6 + 64;
    const int l = it / T7, r = it % T7;
    bf16_t* Wl = p.W_() + (size_t)l * WL;
    TrDesc d; d.scale = 1.f; d.ks = nullptr;
    int k0, c0, r0, kd0; const float* src; bf16_t* dst;
    if (r < T0)      { const int q = r;      src = p.w_in + (size_t)l * D * NIN; d.ldsrc = NIN; k0 = (q & 31) * 64; c0 = (q >> 5) * 64; dst = Wl + W1_OFF; d.ldd = D; r0 = (q >> 5) * 64; kd0 = k0; d.ks = p.norm_g + (size_t)l * D; }
    else if (r < T1) { const int q = r - T0; src = p.w_in + (size_t)l * D * NIN; d.ldsrc = NIN; k0 = (q & 31) * 64; c0 = 3080 + (q >> 5) * 64; dst = Wl + W1_OFF; d.ldd = D; r0 = 3072 + (q >> 5) * 64; kd0 = k0; d.ks = p.norm_g + (size_t)l * D; }
    else if (r < T2) { const int q = r - T1, ct = q >> 5;
                       src = p.w_gate + (size_t)l * D * 4096; d.ldsrc = 4096; k0 = (q & 31) * 64; c0 = (((ct & 3) < 2) ? 0 : 2048) + 128 * (ct >> 2) + (ct & 1) * 64; dst = Wl + W1_OFF; d.ldd = D; r0 = C_GM + ct * 64; kd0 = k0; d.ks = p.norm_g + (size_t)l * D; }
    else if (r < T3) { const int q = r - T2; src = p.w_pm + (size_t)l * WM * D; d.ldsrc = D; k0 = (q & 15) * 64; c0 = (q >> 4) * 64; dst = Wl + W3_OFF; d.ldd = D; r0 = c0; kd0 = k0; }
    else if (r < T4) { const int q = r - T3; src = p.w_pr + (size_t)l * WM * D; d.ldsrc = D; k0 = (q & 15) * 64; c0 = (q >> 4) * 64; dst = Wl + W3_OFF; d.ldd = D; r0 = c0; kd0 = 1024 + k0; }
    else if (r < T5) { const int q = r - T4; src = p.w_o + (size_t)l * D * D; d.ldsrc = D; k0 = (q & 31) * 64; c0 = (q >> 5) * 64; dst = Wl + W4_OFF; d.ldd = D; r0 = c0; kd0 = k0; }
    else if (r < T6) { const int q = r - T5, h = q >> 4, qq = q & 15; src = p.w_qm + ((size_t)l * HM + h) * SZ; d.ldsrc = DH; k0 = (qq & 3) * 64; c0 = (qq >> 2) * 64; dst = Wl + W2_OFF; d.ldd = DH; r0 = h * 512 + c0; kd0 = k0; d.scale = 0.0625f; }
    else             { const int q = r - T6, h = q >> 4, qq = q & 15; src = p.w_km + ((size_t)l * HM + h) * SZ; d.ldsrc = DH; k0 = (qq & 3) * 64; c0 = (qq >> 2) * 64; dst = Wl + W2_OFF; d.ldd = DH; r0 = h * 512 + 256 + c0; kd0 = k0; }
    d.src = src + (size_t)k0 * d.ldsrc + c0; d.dst = dst + (size_t)r0 * d.ldd + kd0; if (d.ks) d.ks += k0;
    return d;
}
__device__ __forceinline__ void tr_load(const TrDesc& d, f32x4 (&v)[16], f32x4 (&ks)[2], int lane) {
#pragma unroll
    for (int i = 0; i < 16; ++i) v[i] = __builtin_nontemporal_load((const f32x4*)(d.src + (size_t)((lane >> 4) + 4 * i) * d.ldsrc + 4 * (lane & 15)));
    if (d.ks) { ks[0] = *(const f32x4*)(d.ks + 8 * (lane & 7)); ks[1] = *(const f32x4*)(d.ks + 8 * (lane & 7) + 4); }
    else { ks[0] = (f32x4){1.f, 1.f, 1.f, 1.f}; ks[1] = ks[0]; }
}
__device__ __forceinline__ void tr_store(const TrDesc& d, const f32x4 (&v)[16], const f32x4 (&ks)[2], LAS float* t, int lane) {
#pragma unroll
    for (int i = 0; i < 16; ++i)
#pragma unroll
        for (int j = 0; j < 4; ++j) t[((lane >> 4) + 4 * i) * 65 + 4 * (lane & 15) + j] = v[i][j];
    const int c = lane & 7;
    const f32x4 s0 = ks[0] * d.scale, s1 = ks[1] * d.scale;
#pragma unroll
    for (int j = 0; j < 8; ++j) { const int n = (lane >> 3) + 8 * j; const LAS float* q = t + (8 * c) * 65 + n;
        u32x4 o; o.x = pk2(s0[0] * q[0], s0[1] * q[65]); o.y = pk2(s0[2] * q[130], s0[3] * q[195]); o.z = pk2(s1[0] * q[260], s1[1] * q[325]); o.w = pk2(s1[2] * q[390], s1[3] * q[455]);
        *(u32x4*)(d.dst + (size_t)n * d.ldd + 8 * c) = o; }
}
__device__ __forceinline__ void prep_phase(const Params& p, int wg, int nwg, LAS unsigned char* lds) {
    const int tid = opaque_tid();
    {
        const int lane = tid & 63, wid = tid >> 6;
        for (int row = wg * 8 + wid; row < MPAD; row += nwg * 8) {
            u32x2* hrow = (u32x2*)(p.Xb_() + (size_t)row * D);
            float ss = 0.f;
            if (row < MT) {
                const f32x4* xr = (const f32x4*)(row < MP ? p.x_prompt + (size_t)row * D : p.x_sample + (size_t)(row - MP) * D);
#pragma unroll
                for (int i = 0; i < 8; ++i) { const f32x4 v = xr[lane + 64 * i]; ss += (v[0] * v[0] + v[1] * v[1]) + (v[2] * v[2] + v[3] * v[3]); hrow[lane + 64 * i] = (u32x2){pk2(v[0], v[1]), pk2(v[2], v[3])}; }
                ss = wave_sum(ss);
            } else {
#pragma unroll
                for (int i = 0; i < 8; ++i) hrow[lane + 64 * i] = (u32x2){0u, 0u};
            }
            if (lane < 5) p.SS_()[(size_t)lane * MPAD + row] = lane == 0 ? ss_fix(ss) : 0ull;
            if (row < MP && lane < 8) p.SSP_()[(size_t)row * 8 + lane] = lane == 0 ? ss : 0.f;
        }
    }
    for (int i = wg * 512 + tid; i < 2049 * 128; i += nwg * 512) {
        const int pi = i >> 7, j = i & 127;
        const float pos = pi < 2048 ? (float)pi : 16384.0f;
        const float inv = powf(10000.0f, -((float)j / 128.0f));
        const float ang = pos * inv;
        p.ROPE_()[2 * i] = (float)cos((double)ang); p.ROPE_()[2 * i + 1] = (float)sin((double)ang);
    }
    for (int i = wg * 512 + tid; i < DEPTH * 256 * D; i += nwg * 512) {
        const int l = i / (256 * D), r = i % (256 * D), j = r / D, k = r % D;
        p.W_()[(size_t)l * WL + W1_OFF + (size_t)(11264 + j) * D + k] = j < 8 ? f2bf(p.w_in[((size_t)l * D + k) * NIN + 3072 + j] * p.norm_g[(size_t)l * D + k]) : (bf16_t)0;
    }
    const int lane = tid & 63, wid = tid >> 6;
    LAS float* t = (LAS float*)lds + wid * (64 * 65);
    constexpr int NT = DEPTH * 7808;
    int it = wg * 8 + wid;
    if (it < NT) {
        TrDesc d = tr_desc(p, it);
        f32x4 v[16], ks[2];
        tr_load(d, v, ks, lane);
        for (;;) {
            const int it2 = it + nwg * 8;
            const bool has = it2 < NT;
            TrDesc d2 = d; f32x4 v2[16], ks2[2];
            if (has) { d2 = tr_desc(p, it2); tr_load(d2, v2, ks2, lane); }
            tr_store(d, v, ks, t, lane);
            if (!has) break;
#pragma unroll
            for (int i = 0; i < 16; ++i) v[i] = v2[i];
            ks[0] = ks2[0]; ks[1] = ks2[1]; d = d2; it = it2;
        }
    }
}

__device__ __forceinline__ void final_phase(const Params& p, int wg, int nwg) {
    const int tid_ = opaque_tid(), lane = tid_ & 63, wid = tid_ >> 6;
    const f32x4* g4 = (const f32x4*)p.final_g;
    for (int row = wg * 8 + wid; row < MT; row += nwg * 8) {
        const u32x2* xr = (const u32x2*)(p.Xb_() + (size_t)row * D);
        f32x4* yr = (f32x4*)(p.out + (row < MP ? O_YP + (size_t)row * D : O_YS + (size_t)(row - MP) * D));
        const float rstd = rsqrtf(row_ss(p.SSP_(), p.SS_() + (size_t)4 * MPAD, row) * (1.0f / D) + EPS);
#pragma unroll
        for (int i = 0; i < 8; ++i) { const u32x2 xb = xr[lane + 64 * i];
            const f32x4 v = (f32x4){__uint_as_float(xb.x << 16), __uint_as_float(xb.x & 0xffff0000u), __uint_as_float(xb.y << 16), __uint_as_float(xb.y & 0xffff0000u)};
            yr[lane + 64 * i] = v * rstd * g4[lane + 64 * i]; }
    }
}

__device__ __forceinline__ void unpack8(const u32x4 v, float (&f)[8]) {
    f[0] = __uint_as_float(v.x << 16); f[1] = __uint_as_float(v.x & 0xffff0000u); f[2] = __uint_as_float(v.y << 16); f[3] = __uint_as_float(v.y & 0xffff0000u);
    f[4] = __uint_as_float(v.z << 16); f[5] = __uint_as_float(v.z & 0xffff0000u); f[6] = __uint_as_float(v.w << 16); f[7] = __uint_as_float(v.w & 0xffff0000u);
}
__device__ __forceinline__ u32x4 pack8(const float (&f)[8]) { u32x4 w; w.x = pk2(f[0], f[1]); w.y = pk2(f[2], f[3]); w.z = pk2(f[4], f[5]); w.w = pk2(f[6], f[7]); return w; }

__device__ __forceinline__ void gate_all(const Params& p, int layer, int bh, LAS float* G);
__device__ __forceinline__ void conv_phase(const Params& p, int layer, int wg, int nwg, LAS unsigned char* lds) {
    const int tid = opaque_tid();
    for (int bh = wg; bh < 16; bh += nwg) gate_all(p, layer, bh, (LAS float*)lds);
    const float* cw = p.conv_w + (size_t)layer * 4 * WM;
    const float* cb = p.conv_b + (size_t)layer * WM;
    for (int it = wg * 512 + tid; it < MT * 128; it += nwg * 512) {
        const int row = it >> 7, ch = (it & 127) * 8;
        float up[4][8];
        if (row < MP) {
            const int t = row & (SEQ - 1);
#pragma unroll
            for (int i = 0; i < 4; ++i) {
                if (t - 3 + i >= 0) unpack8(*(const u32x4*)(p.P_() + (size_t)(row - 3 + i) * NP + C_U + ch), up[i]);
                else {
#pragma unroll
                    for (int j = 0; j < 8; ++j) up[i][j] = 0.f;
                }
            }
            if (t >= SEQ - 3) {
                const int b = row >> 11;
                float* o = p.out + O_CVP + (((size_t)layer * BP + b) * 3 + (t - (SEQ - 3))) * WM + ch;
                *(f32x4*)o = (f32x4){up[3][0], up[3][1], up[3][2], up[3][3]}; *(f32x4*)(o + 4) = (f32x4){up[3][4], up[3][5], up[3][6], up[3][7]};
            }
        } else {
            const int b = row - MP;
            const float* hist = p.st_conv + ((size_t)layer * BS + b) * 3 * WM + ch;
#pragma unroll
            for (int i = 0; i < 3; ++i) { const f32x4 a = *(const f32x4*)(hist + (size_t)i * WM), c = *(const f32x4*)(hist + (size_t)i * WM + 4);
                up[i][0] = a[0]; up[i][1] = a[1]; up[i][2] = a[2]; up[i][3] = a[3]; up[i][4] = c[0]; up[i][5] = c[1]; up[i][6] = c[2]; up[i][7] = c[3]; }
            unpack8(*(const u32x4*)(p.P_() + (size_t)row * NP + C_U + ch), up[3]);
            float* o = p.out + O_CVS + ((size_t)layer * BS + b) * 3 * WM + ch;
#pragma unroll
            for (int i = 0; i < 3; ++i) { *(f32x4*)(o + (size_t)i * WM) = (f32x4){up[i + 1][0], up[i + 1][1], up[i + 1][2], up[i + 1][3]};
                *(f32x4*)(o + (size_t)i * WM + 4) = (f32x4){up[i + 1][4], up[i + 1][5], up[i + 1][6], up[i + 1][7]}; }
        }
        float r[8];
#pragma unroll
        for (int j = 0; j < 8; ++j) r[j] = cb[ch + j];
#pragma unroll
        for (int i = 0; i < 4; ++i)
#pragma unroll
            for (int j = 0; j < 8; ++j) r[j] += up[i][j] * cw[i * WM + ch + j];
#pragma unroll
        for (int j = 0; j < 8; ++j) r[j] = siluf_(r[j]);
        *(u32x4*)(p.CM_() + (size_t)row * WM + ch) = pack8(r);
    }
}

__device__ __forceinline__ void gate_all(const Params& p, int layer, int bh, LAS float* G) {
    const int tid = opaque_tid(), lane = tid & 63, wid = tid >> 6, b = bh >> 2, h = bh & 3;
    const float bi = p.b_i[layer * HM + h], bfv = p.b_f[layer * HM + h];
    float* gt = p.GT_() + (size_t)bh * 6208;
    float tb0[2], tb1[2], tg0[2], tg1[2], rm0[2], rm1[2];
#pragma unroll
    for (int q = 0; q < 2; ++q) {
        const int cc = wid + 8 * q;
        const size_t r0 = (size_t)b * SEQ + cc * 128 + 2 * lane;
        const float i0 = p.IF_()[r0 * 8 + h] + bi, i1 = p.IF_()[(r0 + 1) * 8 + h] + bi;
        const float l0 = logsigf_(p.IF_()[r0 * 8 + 4 + h] + bfv), l1 = logsigf_(p.IF_()[(r0 + 1) * 8 + 4 + h] + bfv);
        float inc = l0 + l1;
#pragma unroll
        for (int o = 1; o < 64; o <<= 1) { const float t = __shfl_up(inc, o); if (lane >= o) inc += t; }
        const float exc = inc - (l0 + l1);
        tb0[q] = exc + l0; tb1[q] = inc;
        tg0[q] = i0 - tb0[q]; tg1[q] = i1 - tb1[q];
        const float gm = wave_max(fmaxf(tg0[q], tg1[q]));
        const float Bc = __shfl(inc, 63);
        if (lane == 0) { G[cc] = Bc; G[16 + cc] = gm; }
        float rm = fmaxf(tg0[q], tg1[q]);
#pragma unroll
        for (int o = 1; o < 64; o <<= 1) { const float t = __shfl_up(rm, o); if (lane >= o) rm = fmaxf(rm, t); }
        float ex = __shfl_up(rm, 1); if (lane == 0) ex = -3.0e38f;
        rm0[q] = fmaxf(ex, tg0[q]); rm1[q] = fmaxf(rm0[q], tg1[q]);
    }
    __syncthreads();
    if (tid == 0) { float m = -1e30f; for (int cc = 0; cc < 16; ++cc) { G[32 + cc] = m; m = G[cc] + fmaxf(m, G[16 + cc]); } G[48] = m; }
    __syncthreads();
#pragma unroll
    for (int q = 0; q < 2; ++q) {
        const int cc = wid + 8 * q, t0 = cc * 128 + 2 * lane;
        const float mc = G[32 + cc];
        *(f32x2_t*)(gt + t0) = (f32x2_t){tb0[q], tb1[q]}; *(f32x2_t*)(gt + 2048 + t0) = (f32x2_t){tg0[q], tg1[q]};
        *(f32x2_t*)(gt + 4096 + t0) = (f32x2_t){fmaxf(rm0[q], mc), fmaxf(rm1[q], mc)};
    }
    if (tid < 16) { gt[6144 + tid] = G[tid]; gt[6160 + tid] = G[16 + tid]; }
    if (tid < 17) gt[6176 + tid] = G[32 + tid];
    __syncthreads();
}
__device__ __forceinline__ void gate_load(const Params& p, int bh, int c, LAS float* G, int tid) {
    const float* gt = p.GT_() + (size_t)bh * 6208;
    if (tid < 128) { G[64 + tid] = gt[c * 128 + tid]; G[192 + tid] = gt[2048 + c * 128 + tid]; G[320 + tid] = gt[4096 + c * 128 + tid]; }
    if (tid == 0) G[32 + c] = gt[6176 + c];
    __syncthreads();
}

template <int I> struct IC { static constexpr int value = I; };
template <int I, int N, class F> __device__ __forceinline__ void sfor(F&& f) { if constexpr (I < N) { f(IC<I>{}); sfor<I + 1, N>(f); } }

template <int CPR>
__device__ __forceinline__ void tile_load(u32x4 (&r)[8], const bf16_t* src, int ld_src, int tid) {
#pragma unroll
    for (int i = 0; i < 8; ++i) { const int id = tid + 512 * i, row = id / CPR, ch = id % CPR; r[i] = *(const u32x4*)(src + (size_t)row * ld_src + ch * 8); }
}
template <int CPR, int LDB>
__device__ __forceinline__ void tile_store(LAS unsigned char* dst, const u32x4 (&r)[8], int tid) {
#pragma unroll
    for (int i = 0; i < 8; ++i) { const int id = tid + 512 * i, row = id / CPR, ch = id % CPR; *(LAS u32x4*)(dst + row * LDB + ch * 16) = r[i]; }
}
__device__ __forceinline__ void tile_store_w(LAS unsigned char* dst, const u32x4 (&r)[8], LAS const float* w, int tid) {
#pragma unroll
    for (int i = 0; i < 8; ++i) { const int id = tid + 512 * i, row = id >> 5, ch = id & 31; float f[8]; unpack8(r[i], f); const float ww = w[row];
#pragma unroll
        for (int j = 0; j < 8; ++j) f[j] *= ww;
        *(LAS u32x4*)(dst + row * 544 + ch * 16) = pack8(f); }
}
template <int OFF, int HS>
__device__ __forceinline__ bf16x8 tr_frag1(unsigned base) {
    u32x2 l0, h0;
    asm volatile("ds_read_b64_tr_b16 %0, %2 offset:%3\n\tds_read_b64_tr_b16 %1, %2 offset:%4\n\ts_waitcnt lgkmcnt(0)"
                 : "=&v"(l0), "=&v"(h0) : "v"(base), "i"(OFF), "i"(OFF + HS) : "memory");
    const u32x4 v = (u32x4){l0.x, l0.y, h0.x, h0.y};
    return __builtin_bit_cast(bf16x8, v);
}
template <int OFF, int HS, int TS>
__device__ __forceinline__ void tr_frag4(unsigned base, bf16x8 (&f)[4]) {
    u32x2 l0, l1, l2, l3, h0, h1, h2, h3;
    asm volatile("ds_read_b64_tr_b16 %0, %8 offset:%9\n\tds_read_b64_tr_b16 %4, %8 offset:%10\n\t"
                 "ds_read_b64_tr_b16 %1, %8 offset:%11\n\tds_read_b64_tr_b16 %5, %8 offset:%12\n\t"
                 "ds_read_b64_tr_b16 %2, %8 offset:%13\n\tds_read_b64_tr_b16 %6, %8 offset:%14\n\t"
                 "ds_read_b64_tr_b16 %3, %8 offset:%15\n\tds_read_b64_tr_b16 %7, %8 offset:%16\n\t"
                 "s_waitcnt lgkmcnt(0)"
                 : "=&v"(l0), "=&v"(l1), "=&v"(l2), "=&v"(l3), "=&v"(h0), "=&v"(h1), "=&v"(h2), "=&v"(h3)
                 : "v"(base), "i"(OFF), "i"(OFF + HS), "i"(OFF + TS), "i"(OFF + TS + HS), "i"(OFF + 2 * TS), "i"(OFF + 2 * TS + HS), "i"(OFF + 3 * TS), "i"(OFF + 3 * TS + HS)
                 : "memory");
    f[0] = __builtin_bit_cast(bf16x8, (u32x4){l0.x, l0.y, h0.x, h0.y}); f[1] = __builtin_bit_cast(bf16x8, (u32x4){l1.x, l1.y, h1.x, h1.y});
    f[2] = __builtin_bit_cast(bf16x8, (u32x4){l2.x, l2.y, h2.x, h2.y}); f[3] = __builtin_bit_cast(bf16x8, (u32x4){l3.x, l3.y, h3.x, h3.y});
}
__device__ __forceinline__ unsigned lds_addr(LAS const void* p) { return (unsigned)(size_t)p; }

template <int NR, int NC, bool WEIGHT>
__device__ __forceinline__ void stage_T(LAS unsigned char* dst, int ldd_bytes, const bf16_t* src, int ld_src, LAS const float* w) {
    const int tid_ = opaque_tid(), lane = tid_ & 63, wid = tid_ >> 6;
    constexpr int PB = NR / 128, CG = NC / 8;
#pragma unroll 1
    for (int task = wid; task < PB * CG; task += 8) {
        const int pb = task % PB, cg = task / PB, r = pb * 128 + 2 * lane;
        float a[8], c[8];
        unpack8(*(const u32x4*)(src + (size_t)r * ld_src + cg * 8), a); unpack8(*(const u32x4*)(src + (size_t)(r + 1) * ld_src + cg * 8), c);
        float w0 = 1.f, w1 = 1.f; if (WEIGHT) { w0 = w[r]; w1 = w[r + 1]; }
#pragma unroll
        for (int j = 0; j < 8; ++j) *(LAS unsigned*)(dst + (cg * 8 + j) * ldd_bytes + r * 2) = pk2(a[j] * w0, c[j] * w1);
    }
}
__device__ __forceinline__ void stage_rows(LAS unsigned char* dst, const bf16_t* src, int ld_src) {
    const int tid_ = opaque_tid();
#pragma unroll
    for (int i = 0; i < 8; ++i) { const int id = tid_ + 512 * i, row = id >> 5, ch = id & 31;
        *(LAS u32x4*)(dst + row * 528 + ch * 16) = *(const u32x4*)(src + (size_t)row * ld_src + ch * 8); }
}
__device__ __forceinline__ bf16x8 lds_frag(LAS const unsigned char* base, int row, int ld_bytes, int kbyte) { return *(LAS const bf16x8*)(base + row * ld_bytes + kbyte); }
__device__ __forceinline__ float ret_lg(int h) { return logf(1.0f - exp2f(-5.0f - (float)h)); }

template <int BR>
__device__ __forceinline__ void chunk_passA(const Params& p, int layer, int b, int h, int c, LAS unsigned char* lds) {
    LAS unsigned char* Xt = lds; LAS unsigned char* Yt = lds + 69632; LAS float* G = (LAS float*)(lds + 139264); LAS float* wk = G + 512;
    const int tid = opaque_tid(), lane = tid & 63, w = __builtin_amdgcn_readfirstlane(tid >> 6), g = lane >> 4, lr = lane & 15;
    const size_t row0 = (size_t)b * SEQ + c * 128;
    const int pi = BR * 16 + b * 4 + h;
    const bf16_t* Xp = BR == 0 ? p.QK_() + row0 * 2048 + h * 512 + 256 : p.P_() + row0 * NP + C_VR + h * 256;
    const bf16_t* Yp = BR == 0 ? p.P_() + row0 * NP + C_VM + h * 256 : p.P_() + row0 * NP + C_KR + h * 256;
    u32x4 xr[8], yr[8];
    tile_load<32>(xr, Xp, BR == 0 ? 2048 : NP, tid); tile_load<32>(yr, Yp, NP, tid);
    if (BR == 0) { gate_load(p, b * 4 + h, c, G, tid); if (tid < 128) wk[tid] = expf(G[192 + tid] - G[320 + 127]); }
    else { if (tid < 128) wk[tid] = expf((float)(127 - tid) * ret_lg(h)); }
    __syncthreads();
    tile_store<32, 544>(Xt, xr, tid); tile_store_w(Yt, yr, wk, tid);
    __syncthreads();
    const unsigned lpart = (unsigned)(((8 * g + (lr >> 2)) * 272 + 4 * (lr & 3)) * 2);
    const unsigned baseX = lds_addr(Xt) + lpart + (unsigned)(32 * w * 2), baseY = lds_addr(Yt) + lpart;
    bf16_t* Uo = p.U_() + ((size_t)pi * 16 + c) * SZ;
    sfor<0, 2>([&](auto rt_) {
        constexpr int rt = decltype(rt_)::value;
        f32x4 acc[16];
#pragma unroll
        for (int j = 0; j < 16; ++j) acc[j] = (f32x4){0.f, 0.f, 0.f, 0.f};
        sfor<0, 4>([&](auto ks_) {
            constexpr int ks = decltype(ks_)::value;
            const bf16x8 fa = tr_frag1<ks * 32 * 544 + rt * 32, 4 * 544>(baseX);
            sfor<0, 4>([&](auto cq_) {
                constexpr int cq = decltype(cq_)::value;
                bf16x8 fb[4];
                tr_frag4<ks * 32 * 544 + cq * 128, 4 * 544, 32>(baseY, fb);
#pragma unroll
                for (int i = 0; i < 4; ++i) acc[4 * cq + i] = __builtin_amdgcn_mfma_f32_16x16x32_bf16(fa, fb[i], acc[4 * cq + i], 0, 0, 0);
            });
        });
#pragma unroll
        for (int ct = 0; ct < 16; ++ct)
            *(u32x2*)(Uo + (size_t)(16 * ct + lr) * 256 + 32 * w + 16 * rt + 4 * g) = (u32x2){pk2(acc[ct][0], acc[ct][1]), pk2(acc[ct][2], acc[ct][3])};
    });
    if (BR == 0 && tid < 256) {
        float sacc = 0.f;
        for (int ss = 0; ss < 128; ++ss) sacc += wk[ss] * bf2f(*(LAS const bf16_t*)(Xt + ss * 544 + tid * 2));
        p.NU_()[((size_t)(b * 4 + h) * 16 + c) * 256 + tid] = sacc;
    }
    __syncthreads();
}

__device__ __forceinline__ void scan_item(const Params& p, int layer, int pi, int slice, LAS unsigned char* lds) {
    LAS float* G = (LAS float*)lds; LAS float* dec = G + 512;
    const int tid = opaque_tid(), br = pi >> 4, bh = pi & 15, b = bh >> 2, h = bh & 3;
    if (br == 0) { const float* gt = p.GT_() + (size_t)bh * 6208; if (tid < 16) { const float mc = gt[6176 + tid]; dec[tid] = expf(mc - fmaxf(mc, gt[6160 + tid])); } if (tid == 0) G[48] = gt[6192]; }
    else if (tid < 16) dec[tid] = expf(128.0f * ret_lg(h));
    __syncthreads();
    float st[2][8];
#pragma unroll
    for (int j = 0; j < 2; ++j)
#pragma unroll
        for (int k = 0; k < 8; ++k) st[j][k] = 0.f;
    for (int c = 0; c < 16; ++c) {
        const float dc = dec[c];
#pragma unroll
        for (int j = 0; j < 2; ++j) { const size_t idx = (size_t)slice * 8192 + j * 4096 + tid * 8;
            float u[8]; unpack8(*(const u32x4*)(p.U_() + ((size_t)pi * 16 + c) * SZ + idx), u);
            *(u32x4*)(p.CS_() + ((size_t)pi * 16 + c) * SZ + idx) = pack8(st[j]);
#pragma unroll
            for (int k = 0; k < 8; ++k) st[j][k] = st[j][k] * dc + u[k]; }
    }
    float* fo = p.out + (br == 0 ? O_CP : O_SP) + (((size_t)layer * BP + b) * HM + h) * SZ;
#pragma unroll
    for (int j = 0; j < 2; ++j) { float* q = fo + (size_t)slice * 8192 + j * 4096 + tid * 8;
        *(f32x4*)q = (f32x4){st[j][0], st[j][1], st[j][2], st[j][3]}; *(f32x4*)(q + 4) = (f32x4){st[j][4], st[j][5], st[j][6], st[j][7]}; }
    if (br == 0 && slice == 0) {
        if (tid < 256) { float n = 0.f;
            for (int c = 0; c < 16; ++c) { p.NS_()[((size_t)bh * 16 + c) * 256 + tid] = n; n = dec[c] * n + p.NU_()[((size_t)bh * 16 + c) * 256 + tid]; }
            p.out[O_NP + (((size_t)layer * BP + b) * HM + h) * 256 + tid] = n; }
        if (tid == 0) p.out[O_MP + ((size_t)layer * BP + b) * HM + h] = G[48];
    }
    __syncthreads();
}

template <int BR>
__device__ __forceinline__ void chunk_passC(const Params& p, int layer, int b, int h, int c, LAS unsigned char* lds) {
    LAS unsigned char* BufB = lds; LAS unsigned char* Sw = lds + 69632; LAS float* G = (LAS float*)(lds + 104448);
    LAS float* av = G + 512; LAS float* fl = G + 640; LAS bf16_t* nbf = (LAS bf16_t*)(G + 768);
    const int tid = opaque_tid(), lane = tid & 63, w = __builtin_amdgcn_readfirstlane(tid >> 6), g = lane >> 4, lr = lane & 15;
    const size_t row0 = (size_t)b * SEQ + c * 128;
    const int pi = BR * 16 + b * 4 + h, l = 16 * w + lr;
    const float lg = ret_lg(h);
    u32x4 tr[8];
    tile_load<32>(tr, BR == 0 ? p.QK_() + row0 * 2048 + h * 512 + 256 : p.P_() + row0 * NP + C_KR + h * 256, BR == 0 ? 2048 : NP, tid);
    if (BR == 0) {
        gate_load(p, b * 4 + h, c, G, tid);
        if (tid < 128) { av[tid] = expf(G[32 + c] - G[320 + tid]); fl[tid] = expf(-(G[64 + tid] + G[320 + tid])); }
        if (tid < 256) nbf[tid] = f2bf(p.NS_()[((size_t)(b * 4 + h) * 16 + c) * 256 + tid]);
    } else { if (tid < 128) av[tid] = expf((float)(tid + 1) * lg); }
    const bf16_t* Qp = BR == 0 ? p.QK_() + (row0 + l) * 2048 + h * 512 : p.P_() + (row0 + l) * NP + C_QR + h * 256;
    bf16x8 qf[8];
#pragma unroll
    for (int ks = 0; ks < 8; ++ks) qf[ks] = *(const bf16x8*)(Qp + 32 * ks + 8 * g);
    tile_store<32, 544>(BufB, tr, tid);
    __syncthreads();
    const bf16_t* CSp = p.CS_() + ((size_t)pi * 16 + c) * SZ;
    if (BR == 0) tile_load<32>(tr, CSp, 256, tid); else tile_load<16>(tr, CSp, 256, tid);
    float rs = 0.f;
    const float Gl = BR == 0 ? G[320 + l] : 0.f;
#pragma unroll
    for (int j = 0; j < 8; ++j) {
        f32x4 a = (f32x4){0.f, 0.f, 0.f, 0.f};
        if (j <= w) {
#pragma unroll
            for (int ks = 0; ks < 8; ++ks) a = __builtin_amdgcn_mfma_f32_16x16x32_bf16(lds_frag(BufB, 16 * j + lr, 544, (32 * ks + 8 * g) * 2), qf[ks], a, 0, 0, 0);
        }
        float v[4];
#pragma unroll
        for (int r = 0; r < 4; ++r) {
            const int sidx = 16 * j + 4 * g + r;
            float d = 0.f;
            if (sidx <= l) d = BR == 0 ? expf(G[192 + sidx] - Gl) : expf((float)(l - sidx) * lg);
            v[r] = a[r] * d; rs += v[r];
        }
        *(LAS u32x2*)(Sw + l * 272 + (16 * j + 4 * g) * 2) = (u32x2){pk2(v[0], v[1]), pk2(v[2], v[3])};
        __builtin_amdgcn_sched_barrier(0);
    }
    rs += __shfl_xor(rs, 16); rs += __shfl_xor(rs, 32);
    __syncthreads();
    f32x4 accN[16];
#pragma unroll
    for (int t = 0; t < 16; ++t) accN[t] = (f32x4){0.f, 0.f, 0.f, 0.f};
    const unsigned lq = (unsigned)(8 * g + (lr >> 2)), lp4 = (unsigned)(4 * (lr & 3));
    sfor<0, 2>([&](auto half_) {
        constexpr int half = decltype(half_)::value;
        if (BR == 0) tile_store<32, 544>(BufB, tr, tid); else tile_store<16, 272>(BufB, tr, tid);
        __syncthreads();
        if (half == 0) { if (BR == 0) tile_load<32>(tr, CSp + 128 * 256, 256, tid); else tile_load<16>(tr, CSp + 128, 256, tid); }
        else tile_load<32>(tr, p.P_() + row0 * NP + (BR == 0 ? C_VM : C_VR) + h * 256, NP, tid);
        if (BR == 0) {
#pragma unroll
            for (int t = 0; t < 8; ++t) {
#pragma unroll
                for (int ks = 0; ks < 8; ++ks)
                    accN[half * 8 + t] = __builtin_amdgcn_mfma_f32_16x16x32_bf16(lds_frag(BufB, 16 * t + lr, 544, (32 * ks + 8 * g) * 2), qf[ks], accN[half * 8 + t], 0, 0, 0);
                __builtin_amdgcn_sched_barrier(0); }
        } else {
            const unsigned base = lds_addr(BufB) + (lq * 136 + lp4) * 2;
            sfor<0, 8>([&](auto ks_) {
                constexpr int ks = decltype(ks_)::value;
                sfor<0, 2>([&](auto tq_) {
                    constexpr int tq = decltype(tq_)::value;
                    bf16x8 f[4];
                    tr_frag4<ks * 32 * 272 + tq * 128, 4 * 272, 32>(base, f);
#pragma unroll
                    for (int i = 0; i < 4; ++i) accN[half * 8 + 4 * tq + i] = __builtin_amdgcn_mfma_f32_16x16x32_bf16(f[i], qf[ks], accN[half * 8 + 4 * tq + i], 0, 0, 0);
                });
            });
        }
        __syncthreads();
    });
    float nq = 0.f;
    if (BR == 0) {
        f32x4 ad = (f32x4){0.f, 0.f, 0.f, 0.f};
#pragma unroll
        for (int ks = 0; ks < 8; ++ks) {
            bf16x8 nf = *(LAS const bf16x8*)(nbf + 32 * ks + 8 * g);
            if (lr != 0) nf = (bf16x8){0, 0, 0, 0, 0, 0, 0, 0};
            ad = __builtin_amdgcn_mfma_f32_16x16x32_bf16(nf, qf[ks], ad, 0, 0, 0);
        }
        nq = __shfl(ad[0], lr);
    }
    const float al = av[l];
#pragma unroll
    for (int t = 0; t < 16; ++t) accN[t] *= al;
    tile_store<32, 544>(BufB, tr, tid);
    __syncthreads();
    {
        const unsigned base = lds_addr(BufB) + (lq * 272 + lp4) * 2;
        sfor<0, 4>([&](auto ks_) {
            constexpr int ks = decltype(ks_)::value;
            const bf16x8 bfr = lds_frag(Sw, l, 272, (32 * ks + 8 * g) * 2);
            sfor<0, 4>([&](auto tq_) {
                constexpr int tq = decltype(tq_)::value;
                bf16x8 f[4];
                tr_frag4<ks * 32 * 544 + tq * 128, 4 * 544, 32>(base, f);
#pragma unroll
                for (int i = 0; i < 4; ++i) accN[4 * tq + i] = __builtin_amdgcn_mfma_f32_16x16x32_bf16(f[i], bfr, accN[4 * tq + i], 0, 0, 0);
            });
        });
    }
    float inv = 1.0f;
    if (BR == 0) inv = 1.0f / fmaxf(fabsf(rs + al * nq), fl[l]);
    float sm = 0.f;
#pragma unroll
    for (int t = 0; t < 16; ++t) { accN[t] *= inv; sm += (accN[t][0] + accN[t][1]) + (accN[t][2] + accN[t][3]); }
    sm += __shfl_xor(sm, 16); sm += __shfl_xor(sm, 32);
    const float mu = sm * (1.0f / 256.0f);
    float qv = 0.f;
#pragma unroll
    for (int t = 0; t < 16; ++t) { const f32x4 d = accN[t] - mu; qv += (d[0] * d[0] + d[1] * d[1]) + (d[2] * d[2] + d[3] * d[3]); }
    qv += __shfl_xor(qv, 16); qv += __shfl_xor(qv, 32);
    const float rstd = rsqrtf(qv * (1.0f / 256.0f) + EPS);
    const float* gain = (BR == 0 ? p.hn_m_g : p.hn_r_g) + (size_t)layer * WM + h * 256 + 4 * g;
    const float* skip = p.skip_m + (size_t)layer * WM + h * 256 + 4 * g;
    const size_t row = row0 + l;
    const bf16_t* zp = p.P_() + row * NP + (BR == 0 ? C_ZM : C_ZR) + h * 256 + 4 * g;
    const bf16_t* cp = p.CM_() + row * WM + h * 256 + 4 * g;
    bf16_t* op = p.OC_() + row * 2048 + BR * 1024 + h * 256 + 4 * g;
#pragma unroll
    for (int t = 0; t < 16; ++t) {
        const f32x4 ge = *(const f32x4*)(gain + 16 * t);
        const u32x2 zb = *(const u32x2*)(zp + 16 * t);
        f32x4 v = (accN[t] - mu) * rstd * ge;
        if (BR == 0) { const f32x4 sk = *(const f32x4*)(skip + 16 * t); const u32x2 cb = *(const u32x2*)(cp + 16 * t);
            v[0] += sk[0] * __uint_as_float(cb.x << 16); v[1] += sk[1] * __uint_as_float(cb.x & 0xffff0000u);
            v[2] += sk[2] * __uint_as_float(cb.y << 16); v[3] += sk[3] * __uint_as_float(cb.y & 0xffff0000u); }
        const float z0 = __uint_as_float(zb.x << 16), z1 = __uint_as_float(zb.x & 0xffff0000u), z2 = __uint_as_float(zb.y << 16), z3 = __uint_as_float(zb.y & 0xffff0000u);
        *(u32x2*)(op + 16 * t) = (u32x2){pk2(v[0] * siluf_(z0), v[1] * siluf_(z1)), pk2(v[2] * siluf_(z2), v[3] * siluf_(z3))};
    }
    __syncthreads();
}

template <int BR>
__device__ __forceinline__ void sample_item(const Params& p, int layer, int b, int h, LAS unsigned char* lds) {
    LAS float* sq = (LAS float*)lds; LAS float* sk = sq + 256; LAS float* sv = sk + 256; LAS float* sn = sv + 256; LAS float* sr = sn + 256; LAS float* red = sr + 256;
    LAS float* part = red + 64;
    const int tid = opaque_tid(), lane = tid & 63, wid = tid >> 6;
    const size_t R = (size_t)MP + b;
    const size_t sidx = ((size_t)layer * BS + b) * HM + h;
    if (tid < 256) {
        if (BR == 0) { sq[tid] = bf2f(p.QK_()[R * 2048 + h * 512 + tid]); sk[tid] = bf2f(p.QK_()[R * 2048 + h * 512 + 256 + tid]); sv[tid] = bf2f(p.P_()[R * NP + C_VM + h * 256 + tid]); sn[tid] = p.st_n[sidx * 256 + tid]; }
        else { sq[tid] = bf2f(p.P_()[R * NP + C_QR + h * 256 + tid]); sk[tid] = bf2f(p.P_()[R * NP + C_KR + h * 256 + tid]); sv[tid] = bf2f(p.P_()[R * NP + C_VR + h * 256 + tid]); sn[tid] = 0.f; }
    }
    __syncthreads();
    float pq = 0.f, pn = 0.f;
    if (tid < 256) { pq = sq[tid] * sk[tid]; pn = sn[tid] * sq[tid]; }
    block_sum2(pq, pn, red);
    const float qk = pq, nq = pn;
    float wgt = 1.f, a = 1.f, mt = 0.f;
    if (BR == 0) {
        const float ig = p.IF_()[R * 8 + h] + p.b_i[layer * HM + h];
        const float lf = logsigf_(p.IF_()[R * 8 + 4 + h] + p.b_f[layer * HM + h]);
        const float inter = lf + p.st_m[sidx];
        mt = fmaxf(inter, ig); wgt = expf(ig - mt); a = expf(inter - mt);
    } else { a = 1.0f - exp2f(-5.0f - (float)h); }
    const float* S0 = (BR == 0 ? p.st_C : p.st_S) + sidx * SZ;
    float* S1 = p.out + (BR == 0 ? O_CS : O_SS) + sidx * SZ;
    const f32x4* S0v = (const f32x4*)S0 + lane; f32x4* S1v = (f32x4*)S1 + lane;
    f32x4 cc[8], cn[8];
#pragma unroll
    for (int j = 0; j < 8; ++j) cc[j] = __builtin_nontemporal_load(S0v + 64 * (wid + 8 * j));
    if (BR == 0) {
        const f32x4 q4 = *(LAS const f32x4*)(sq + 4 * lane), k4 = *(LAS const f32x4*)(sk + 4 * lane);
#pragma unroll
        for (int i0 = 0; i0 < 32; i0 += 8) {
            if (i0 + 8 < 32) {
#pragma unroll
                for (int j = 0; j < 8; ++j) cn[j] = __builtin_nontemporal_load(S0v + 64 * (wid + 8 * (i0 + 8 + j)));
            }
#pragma unroll
            for (int j = 0; j < 8; ++j) { const int e = wid + 8 * (i0 + j);
                float pt = (cc[j][0] * q4[0] + cc[j][1] * q4[1]) + (cc[j][2] * q4[2] + cc[j][3] * q4[3]);
                const float wv = wgt * sv[e];
                __builtin_nontemporal_store(cc[j] * a + k4 * wv, S1v + 64 * e);
                pt = wave_sum(pt);
                if (lane == 0) sr[e] = pt; }
#pragma unroll
            for (int j = 0; j < 8; ++j) cc[j] = cn[j];
        }
    } else {
        const f32x4 v4 = *(LAS const f32x4*)(sv + 4 * lane);
        f32x4 ac = (f32x4){0.f, 0.f, 0.f, 0.f};
#pragma unroll
        for (int i0 = 0; i0 < 32; i0 += 8) {
            if (i0 + 8 < 32) {
#pragma unroll
                for (int j = 0; j < 8; ++j) cn[j] = __builtin_nontemporal_load(S0v + 64 * (wid + 8 * (i0 + 8 + j)));
            }
#pragma unroll
            for (int j = 0; j < 8; ++j) { const int d = wid + 8 * (i0 + j);
                ac = ac + cc[j] * sq[d];
                __builtin_nontemporal_store(cc[j] * a + v4 * sk[d], S1v + 64 * d); }
#pragma unroll
            for (int j = 0; j < 8; ++j) cc[j] = cn[j];
        }
        *(LAS f32x4*)(part + wid * 256 + 4 * lane) = ac;
    }
    __syncthreads();
    float hv = 0.f;
    if (tid < 256) {
        if (BR == 0) {
            const float ws = wgt * qk;
            const float den = fmaxf(fabsf(ws + a * nq), expf(-mt));
            hv = (ws * sv[tid] + a * sr[tid]) / den;
            p.out[O_NS + sidx * 256 + tid] = a * sn[tid] + wgt * sk[tid];
            if (tid == 0) p.out[O_MS + sidx] = mt;
        } else {
            float s = 0.f;
#pragma unroll
            for (int i = 0; i < 8; ++i) s += part[i * 256 + tid];
            hv = qk * sv[tid] + a * s;
        }
    }
    float s1 = hv, s2 = 0.f;
    block_sum2(s1, s2, red);
    const float mean = s1 * (1.0f / 256.0f);
    float dv = tid < 256 ? hv - mean : 0.f;
    float q1 = dv * dv, q2 = 0.f;
    block_sum2(q1, q2, red);
    const float rstd = rsqrtf(q1 * (1.0f / 256.0f) + EPS);
    if (tid < 256) {
        const float ge = (BR == 0 ? p.hn_m_g : p.hn_r_g)[(size_t)layer * WM + h * 256 + tid];
        float v = dv * rstd * ge;
        const float z = bf2f(p.P_()[R * NP + (BR == 0 ? C_ZM : C_ZR) + h * 256 + tid]);
        if (BR == 0) v += p.skip_m[(size_t)layer * WM + h * 256 + tid] * bf2f(p.CM_()[R * WM + h * 256 + tid]);
        p.OC_()[R * 2048 + BR * 1024 + h * 256 + tid] = f2bf(v * siluf_(z));
    }
    __syncthreads();
}

template <int MODE>
__device__ __forceinline__ void sample_gemm(const Params& p, const bf16_t* Wl, int wg, int nwg, LAS unsigned char* lds, unsigned long long* ssn) {
    const int tid = opaque_tid(), lane = tid & 63, w = tid >> 6, g = lane >> 4, lr = lane & 15, hf = w >> 2;
    LAS f32x4* xch = (LAS f32x4*)lds;
    LAS float* red = (LAS float*)(lds + 4096);
    for (int j = wg; j < 256; j += nwg) {
        const int rbase = MP + 32 * (j & 3) + 16 * ((w >> 1) & 1), cbase = 32 * (j >> 2) + 16 * (w & 1);
        const bf16_t* A = (MODE == 0 ? p.OC_() : p.MG_()) + (size_t)(rbase + lr) * 2048 + hf * 1024 + 8 * g;
        const bf16_t* B = Wl + (MODE == 0 ? W3_OFF : W4_OFF) + (size_t)(cbase + lr) * 2048 + hf * 1024 + 8 * g;
        f32x4 acc = (f32x4){0.f, 0.f, 0.f, 0.f};
#pragma unroll 1
        for (int k0 = 0; k0 < 1024; k0 += 512) {
            bf16x8 af[16], bf[16];
#pragma unroll
            for (int i = 0; i < 16; ++i) { af[i] = *(const bf16x8*)(A + k0 + 32 * i); bf[i] = *(const bf16x8*)(B + k0 + 32 * i); }
#pragma unroll
            for (int i = 0; i < 16; ++i) acc = __builtin_amdgcn_mfma_f32_16x16x32_bf16(af[i], bf[i], acc, 0, 0, 0);
        }
        if (hf == 1) xch[(w & 3) * 64 + lane] = acc;
        __syncthreads();
        if (hf == 0) {
            const f32x4 hi = xch[(w & 3) * 64 + lane];
            const int col = cbase + lr;
#pragma unroll
            for (int r = 0; r < 4; ++r) {
                const size_t row = (size_t)rbase + 4 * g + r;
                if (MODE == 0) {
                    const float rt = bf2f(p.RT_()[row * 2048 + col]), gr = bf2f(p.GRS_()[row * 2048 + col]);
                    p.MG_()[row * 2048 + col] = f2bf(gr * (rt * acc[r] + hi[r]));
                } else {
                    const bf16_t nb = f2bf(bf2f(p.Xb_()[row * 2048 + col]) + acc[r] + hi[r]);
                    p.Xb_()[row * 2048 + col] = nb;
                    float q = bf2f(nb) * bf2f(nb);
                    q += __shfl_xor(q, 1); q += __shfl_xor(q, 2); q += __shfl_xor(q, 4); q += __shfl_xor(q, 8);
                    if (lr == 0) red[(w & 1) * 32 + 16 * ((w >> 1) & 1) + 4 * g + r] = q;
                }
            }
        }
        if (MODE == 1) {
            __syncthreads();
            if (tid < 32) atomicAdd(ssn + MP + 32 * (j & 3) + tid, ss_fix(red[tid] + red[32 + tid]));
        }
        __syncthreads();
    }
}

__device__ __forceinline__ void sample_gemm2(const Params& p, const bf16_t* W2t, int wg, int nwg) {
    const int tid = opaque_tid(), lane = tid & 63, w = tid >> 6, g = lane >> 4, lr = lane & 15;
    for (int j = wg; j < 128; j += nwg) {
        const int rbase = MP + 16 * (j & 7), cbase = 128 * (j >> 3) + 16 * w, head = cbase >> 9;
        const bf16_t* A = p.CM_() + (size_t)(rbase + lr) * WM + head * 256 + 8 * g;
        const bf16_t* B = W2t + (size_t)(cbase + lr) * 256 + 8 * g;
        bf16x8 af[8], bf[8];
#pragma unroll
        for (int i = 0; i < 8; ++i) { af[i] = *(const bf16x8*)(A + 32 * i); bf[i] = *(const bf16x8*)(B + 32 * i); }
        f32x4 acc = (f32x4){0.f, 0.f, 0.f, 0.f};
#pragma unroll
        for (int i = 0; i < 8; ++i) acc = __builtin_amdgcn_mfma_f32_16x16x32_bf16(af[i], bf[i], acc, 0, 0, 0);
#pragma unroll
        for (int r = 0; r < 4; ++r) p.QK_()[(size_t)(rbase + 4 * g + r) * 2048 + cbase + lr] = f2bf(acc[r]);
    }
}

__device__ __forceinline__ void phaseA(const Params& p, int layer, int wg, int nwg, LAS unsigned char* lds) {
    for (int it0 = wg; it0 < 1536; it0 += nwg) {
        const int it = (wg & 1) ? (it0 < 1024 ? it0 + 512 : it0 - 1024) : it0;
        if (it < 512) {
            const int br = it >> 8, rest = it & 255, b = rest >> 6, h = (rest >> 4) & 3, c = rest & 15;
            if (br == 0) chunk_passA<0>(p, layer, b, h, c, lds); else chunk_passA<1>(p, layer, b, h, c, lds);
        } else {
            const int s = it - 512, br = s >> 9, b = (s >> 2) & 127, h = s & 3;
            if (br == 0) sample_item<0>(p, layer, b, h, lds); else sample_item<1>(p, layer, b, h, lds);
        }
    }
}
__device__ __forceinline__ void phaseScan(const Params& p, int layer, int wg, int nwg, LAS unsigned char* lds) {
    for (int it = wg; it < 256; it += nwg) scan_item(p, layer, it >> 3, it & 7, lds);
}
__device__ __forceinline__ void phaseC(const Params& p, int layer, int wg, int nwg, LAS unsigned char* lds) {
    for (int it = wg; it < 512; it += nwg) {
        const int br = it >> 8, rest = it & 255, b = rest >> 6, h = (rest >> 4) & 3, c = rest & 15;
        if (br == 0) chunk_passC<0>(p, layer, b, h, c, lds); else chunk_passC<1>(p, layer, b, h, c, lds);
    }
}

template <int ONLY>
__device__ __forceinline__ void run_phases(const Params& p_in, int ph_lo, int ph_hi) {
    extern __shared__ __attribute__((aligned(16))) unsigned char smem_raw[];
    LAS unsigned char* lds = (LAS unsigned char*)smem_raw;
    volatile LAS unsigned* xbw = (volatile LAS unsigned*)(lds + LDS_BYTES - 16);
    const int wg_in = blockIdx.x, nwg = gridDim.x;
    const bool multi = (ph_hi - ph_lo) > 1;
    XcdBarrier bar; bar.bar = p_in.bar_(); bar.x = 0; bar.st = xbw;
    if (multi) {
        if (threadIdx.x == 0) { xbw[0] = 0u; xbw[1] = 0u; xbw[2] = 0u; xbw[3] = 0u; }
        __syncthreads();
        bar = xcd_barrier_post(p_in.bar_(), xbw);
    }
    int ph = 0; unsigned long long tacc_ = 0;
#define PHASE(KIND, ...) { if constexpr (ONLY < 0 || ONLY == KIND) { if (ph >= ph_lo && ph < ph_hi) { \
    unsigned long long t0_ = 0; if (KIND == TIMEK) t0_ = __builtin_amdgcn_s_memrealtime(); \
    Params p = p_in; int wg = wg_in; { size_t z_ = 0; asm volatile("" : "+s"(z_), "+s"(wg)); p.ws = p_in.ws + z_; p.out = p_in.out + z_; }     \
    __VA_ARGS__; if (ph + 1 < ph_hi) xcd_barrier(bar); \
    if (KIND == TIMEK) tacc_ += __builtin_amdgcn_s_memrealtime() - t0_; } } ++ph; }
    PHASE(0, prep_phase(p, wg, nwg, lds))
    for (int layer = 0; layer < DEPTH; ++layer) {
        PHASE(2, { pg8::StaticOrder S; S.init(MPAD, N1, nwg, wg); pg8::Gemm g{p.Xb_(), p.W_() + (size_t)layer * WL + W1_OFF, D, D, D, 31, 0, 0};
                pg8::EpiG1 E{p.P_(), p.b_gate + (size_t)layer * 4096, p.RT_(), p.GRS_(), p.ROPE_(), p.SS_() + (size_t)layer * MPAD, p.SSP_(), p.IF_()}; pg8::gemm_phase<false>(lds, g, S, E); })
        PHASE(3, conv_phase(p, layer, wg, nwg, lds))
        PHASE(4, { pg8::StaticOrder S; S.init(MP, 2048, nwg, wg); pg8::Gemm g{p.CM_(), p.W_() + (size_t)layer * WL + W2_OFF, 256, WM, 256, 1, 512, 0};
                pg8::EpiBf16 E{p.QK_(), 2048}; pg8::gemm_phase<false>(lds, g, S, E); sample_gemm2(p, p.W_() + (size_t)layer * WL + W2_OFF, wg, nwg); })
        PHASE(5, phaseA(p, layer, wg, nwg, lds))
        PHASE(6, phaseScan(p, layer, wg, nwg, lds))
        PHASE(7, phaseC(p, layer, wg, nwg, lds))
        PHASE(8, { pg8::StaticOrder S; S.init(MP, 2048, nwg, wg); pg8::Gemm g{p.OC_(), p.W_() + (size_t)layer * WL + W3_OFF, 2048, 2048, 2048, 31, 0, 16};
                pg8::EpiMerged E{p.MG_(), p.RT_(), p.GRS_()}; pg8::gemm_phase<true>(lds, g, S, E); sample_gemm<0>(p, p.W_() + (size_t)layer * WL, wg, nwg, lds, nullptr); })
        PHASE(10, { pg8::StaticOrder S; S.init(MP, 2048, nwg, wg); pg8::Gemm g{p.MG_(), p.W_() + (size_t)layer * WL + W4_OFF, 2048, 2048, 2048, 31, 0, 0};
                pg8::EpiResidual E{p.Xb_(), p.SSP_(), (LAS float*)(lds + pg8::STAGE_BYTES)}; pg8::gemm_phase<false>(lds, g, S, E); sample_gemm<1>(p, p.W_() + (size_t)layer * WL, wg, nwg, lds, p.SS_() + (size_t)(layer + 1) * MPAD); })
    }
    PHASE(11, final_phase(p, wg, nwg))
    if (TIMEK >= 0 && blockIdx.x == 0) { const unsigned long long te_ = __builtin_amdgcn_s_memrealtime(); while (__builtin_amdgcn_s_memrealtime() - te_ < TIMEX * tacc_) __builtin_amdgcn_s_sleep(8); }
#undef PHASE
}
__global__ void __launch_bounds__(512, 2) mega(Params p, int ph_lo, int ph_hi) { run_phases<-1>(p, ph_lo, ph_hi); }
#ifdef DIAG
template <int K> __global__ void __launch_bounds__(512, 2) mega_k(Params p, int ph_lo, int ph_hi) { run_phases<K>(p, ph_lo, ph_hi); }
template __global__ void mega_k<0>(Params, int, int); template __global__ void mega_k<2>(Params, int, int);
template __global__ void mega_k<3>(Params, int, int); template __global__ void mega_k<4>(Params, int, int); template __global__ void mega_k<5>(Params, int, int);
template __global__ void mega_k<6>(Params, int, int); template __global__ void mega_k<7>(Params, int, int); template __global__ void mega_k<8>(Params, int, int);
template __global__ void mega_k<10>(Params, int, int); template __global__ void mega_k<11>(Params, int, int);
#endif
constexpr int N_PHASES = 2 + DEPTH * 8;

extern "C" void kernel_launch(void* const* d_in, const int* in_sizes, int n_in, void* d_out, int out_size, void* d_ws, size_t ws_size, hipStream_t stream) {
    (void)in_sizes; (void)n_in; (void)out_size; (void)ws_size;
    static int grid = 0;
    if (grid == 0) {
        int dev = 0, cus = 0;
        hipGetDevice(&dev);
        hipDeviceGetAttribute(&cus, hipDeviceAttributeMultiprocessorCount, dev);
        if (hipFuncSetAttribute((const void*)mega, hipFuncAttributeMaxDynamicSharedMemorySize, LDS_BYTES) != hipSuccess) fprintf(stderr, "hipFuncSetAttribute failed\n");
        (void)hipGetLastError();
        grid = cus > 0 ? cus : 256;
    }
    Params p{};
    const float** in = (const float**)&p;
    for (int i = 0; i < 24; ++i) in[i] = (const float*)d_in[i];
    p.out = (float*)d_out;
    p.ws = (unsigned char*)d_ws;
    if (ws_size < WS_END) { fprintf(stderr, "workspace too small: %zu < %zu\n", ws_size, (size_t)WS_END); return; }
    hipMemsetAsync(d_ws, 0, 16384, stream);
#if MK_SINGLE
    hipLaunchKernelGGL(mega, dim3(grid), dim3(512), LDS_BYTES, stream, p, 0, N_PHASES);
#else
    for (int ph = 0; ph < N_PHASES; ++ph) hipLaunchKernelGGL(mega, dim3(grid), dim3(512), LDS_BYTES, stream, p, ph, ph + 1);
#endif
}
```

```cpp
#include <hip/hip_runtime.h>
#include <stdint.h>
#include <stdio.h>

#ifndef TIMEK
#define TIMEK -1
#define TIMEX 10
#endif
#ifndef MK_SINGLE
#define MK_SINGLE 1
#endif

#define LAS __attribute__((address_space(3)))
typedef unsigned short bf16_t;
typedef short bf16x8 __attribute__((ext_vector_type(8)));
typedef float f32x4 __attribute__((ext_vector_type(4)));
typedef unsigned u32x4 __attribute__((ext_vector_type(4)));
typedef unsigned u32x2 __attribute__((ext_vector_type(2)));
typedef float f32x2_t __attribute__((ext_vector_type(2)));

constexpr int D = 2048, SEQ = 2048, BP = 4, BS = 128, DEPTH = 4, HM = 4, DH = 256, WM = 1024, NIN = 7176;
constexpr int MP = BP * SEQ, MT = MP + BS, MPAD = 8448;
constexpr int NP = 7168;
constexpr int N1 = 11520;
constexpr int C_U = 0, C_VM = 1024, C_ZM = 2048, C_QR = 3072, C_KR = 4096, C_VR = 5120, C_ZR = 6144, C_GM = 7168, C_GR = 9216;
constexpr float EPS = 1e-6f;
constexpr size_t SZ = 65536;
constexpr size_t O_YP = 0, O_YS = O_YP + 16777216, O_CP = O_YS + 262144, O_NP = O_CP + 4194304, O_MP = O_NP + 16384, O_CVP = O_MP + 64,
                 O_SP = O_CVP + 49152, O_CS = O_SP + 4194304, O_NS = O_CS + 134217728, O_MS = O_NS + 524288, O_CVS = O_MS + 2048, O_SS = O_CVS + 1572864;
constexpr size_t W1_OFF = 0, W2_OFF = W1_OFF + (size_t)N1 * D, W3_OFF = W2_OFF + (size_t)2048 * 256, W4_OFF = W3_OFF + (size_t)D * D, WL = W4_OFF + (size_t)D * D;
constexpr int LDS_BYTES = 147456;

constexpr size_t al256(size_t x) { return (x + 255) & ~(size_t)255; }
constexpr size_t OFF_BAR = 0, OFF_SS = OFF_BAR + 16384, OFF_SSP = OFF_SS + al256((size_t)5 * MPAD * 8), OFF_XB = OFF_SSP + al256((size_t)8 * MP * 4),
    OFF_P = OFF_XB + al256((size_t)MPAD * D * 2), OFF_IF = OFF_P + al256((size_t)MPAD * NP * 2), OFF_CM = OFF_IF + al256((size_t)MPAD * 8 * 4),
    OFF_QK = OFF_CM + al256((size_t)MPAD * WM * 2), OFF_OC = OFF_QK + al256((size_t)MPAD * 2048 * 2), OFF_MG = OFF_OC + al256((size_t)MPAD * 2048 * 2),
    OFF_U = OFF_MG + al256((size_t)MPAD * 2048 * 2), OFF_CS = OFF_U + al256((size_t)32 * 16 * SZ * 2), OFF_NU = OFF_CS + al256((size_t)32 * 16 * SZ * 2),
    OFF_NS = OFF_NU + al256((size_t)16 * 16 * 256 * 4), OFF_W = OFF_NS + al256((size_t)16 * 16 * 256 * 4), OFF_ROPE = OFF_W + al256((size_t)DEPTH * WL * 2),
    OFF_RT = OFF_ROPE + al256((size_t)2049 * 128 * 2 * 4), OFF_GRS = OFF_RT + al256((size_t)MPAD * 2048 * 2), OFF_GT = OFF_GRS + al256((size_t)MPAD * 2048 * 2),
    WS_END = OFF_GT + al256((size_t)16 * 6208 * 4);

struct Params {
    const float *x_prompt, *x_sample, *st_C, *st_n, *st_m, *st_conv, *st_S, *norm_g, *w_in, *conv_w, *conv_b, *w_qm, *w_km, *b_i, *b_f,
                *hn_m_g, *skip_m, *hn_r_g, *w_pm, *w_pr, *w_gate, *b_gate, *w_o, *final_g;
    float* out;
    unsigned char* ws;
#define WSF(name, type, off) __device__ __forceinline__ type* name##_() const { return (type*)(ws + (off)); }
    WSF(bar, unsigned, OFF_BAR) WSF(SS, unsigned long long, OFF_SS) WSF(SSP, float, OFF_SSP) WSF(Xb, bf16_t, OFF_XB) WSF(P, bf16_t, OFF_P) WSF(IF, float, OFF_IF)
    WSF(CM, bf16_t, OFF_CM) WSF(QK, bf16_t, OFF_QK) WSF(OC, bf16_t, OFF_OC) WSF(MG, bf16_t, OFF_MG) WSF(U, bf16_t, OFF_U) WSF(CS, bf16_t, OFF_CS)
    WSF(NU, float, OFF_NU) WSF(NS, float, OFF_NS) WSF(W, bf16_t, OFF_W) WSF(ROPE, float, OFF_ROPE) WSF(RT, bf16_t, OFF_RT) WSF(GRS, bf16_t, OFF_GRS) WSF(GT, float, OFF_GT)
#undef WSF
};


__device__ __forceinline__ unsigned long long ss_fix(float v) { return (unsigned long long)(v * 1048576.0f + 0.5f); }
__device__ __forceinline__ float ss_val(unsigned long long v) { return (float)v * (1.0f / 1048576.0f); }
__device__ __forceinline__ float row_ss(const float* ssp, const unsigned long long* ss, int row) {
    if (row < 8192) { const f32x4 a = *(const f32x4*)(ssp + (size_t)row * 8), b = *(const f32x4*)(ssp + (size_t)row * 8 + 4);
        return ((a[0] + a[1]) + (a[2] + a[3])) + ((b[0] + b[1]) + (b[2] + b[3])); }
    return ss_val(ss[row]);
}
__device__ __forceinline__ int opaque_tid() { int t = threadIdx.x; asm volatile("" : "+v"(t)); return t; }
__device__ __forceinline__ float bf2f(bf16_t v) { return __uint_as_float((unsigned)v << 16); }
__device__ __forceinline__ bf16_t f2bf(float f) { unsigned u = __float_as_uint(f); u += 0x7fffu + ((u >> 16) & 1u); return (bf16_t)(u >> 16); }
__device__ __forceinline__ unsigned pk2(float lo, float hi) { return (unsigned)f2bf(lo) | ((unsigned)f2bf(hi) << 16); }
__device__ __forceinline__ float wave_sum(float v) {
#pragma unroll
    for (int o = 32; o >= 1; o >>= 1) v += __shfl_xor(v, o);
    return v;
}
__device__ __forceinline__ float wave_max(float v) {
#pragma unroll
    for (int o = 32; o >= 1; o >>= 1) v = fmaxf(v, __shfl_xor(v, o));
    return v;
}
__device__ __forceinline__ float sigmoidf_(float x) { return __builtin_amdgcn_rcpf(1.0f + __expf(-x)); }
__device__ __forceinline__ float siluf_(float x) { return x * __builtin_amdgcn_rcpf(1.0f + __expf(-x)); }
__device__ __forceinline__ float logsigf_(float x) { return x < 0.f ? x - log1pf(expf(x)) : -log1pf(expf(-x)); }
__device__ __forceinline__ void block_sum2(float& a, float& b, LAS float* red) {
    a = wave_sum(a); b = wave_sum(b);
    __syncthreads();
    if ((threadIdx.x & 63) == 0) { red[threadIdx.x >> 6] = a; red[8 + (threadIdx.x >> 6)] = b; }
    __syncthreads();
    float sa = 0.f, sb = 0.f;
#pragma unroll
    for (int i = 0; i < 8; ++i) { sa += red[i]; sb += red[8 + i]; }
    a = sa; b = sb;
}

#define XB_TMO      128
#define XB_XCNT(j)  (256  + 64 * (j))
#define XB_XSUB(j)  (1280 + 64 * (j))
#define XB_XGEN(j)  (2304 + 64 * (j))
#define XB_TOP      3328
#define XB_TOPGEN   3392
#define XCD_BAR_WORDS 3456
#define XB_SPIN_CAP (1u << 22)

__device__ __forceinline__ unsigned xb_ld(unsigned* p)              { return __hip_atomic_load(p, __ATOMIC_RELAXED, __HIP_MEMORY_SCOPE_AGENT); }
__device__ __forceinline__ unsigned xb_add(unsigned* p, unsigned v) { return __hip_atomic_fetch_add(p, v, __ATOMIC_RELAXED, __HIP_MEMORY_SCOPE_AGENT); }
__device__ __forceinline__ unsigned xb_xcc_id() { return (unsigned)__builtin_amdgcn_s_getreg((3 << 11) | 20) & 0xFu; }
#define XB_SPIN(cond, bar) do { unsigned _sp = 0; while (cond) { __builtin_amdgcn_s_sleep(1); \
    if ((++_sp & 255u) == 0u) { if (xb_ld(&(bar)[XB_TMO])) break; if (_sp > XB_SPIN_CAP) { atomicAdd(&(bar)[XB_TMO], 1u); break; } } } } while (0)

struct XcdBarrier { unsigned* bar; unsigned x; volatile LAS unsigned* st; };

__device__ __forceinline__ XcdBarrier xcd_barrier_post(unsigned* bar, volatile LAS unsigned* st) {
    XcdBarrier b; b.bar = bar; b.x = xb_xcc_id(); b.st = st;
    if (threadIdx.x == 0) (void)xb_add(&bar[XB_XCNT(b.x)], 1u);
    return b;
}
__device__ __forceinline__ void xcd_barrier_complete(unsigned* bar, unsigned x, unsigned& nloc, unsigned& nx) {
    const unsigned G = gridDim.x * gridDim.y * gridDim.z;
    unsigned sum, cnt, mine, sp = 0u;
    for (;;) {
        sum = 0u; cnt = 0u; mine = 0u;
#pragma unroll
        for (unsigned j = 0; j < 16; ++j) { const unsigned c = xb_ld(&bar[XB_XCNT(j)]); sum += c; cnt += (c > 0u) ? 1u : 0u; mine = (j == x) ? c : mine; }
        if (sum == G) break;
        __builtin_amdgcn_s_sleep(1);
        if ((++sp & 255u) == 0u) { if (xb_ld(&bar[XB_TMO])) break; if (sp > XB_SPIN_CAP) { atomicAdd(&bar[XB_TMO], 1u); break; } }
    }
    nloc = mine > 0u ? mine : 1u; nx = cnt > 0u ? cnt : 1u;
}
__device__ __forceinline__ void xcd_barrier(const XcdBarrier& b) {
    asm volatile("s_waitcnt vmcnt(0)" ::: "memory");
    __syncthreads();
    if (threadIdx.x == 0) {
        unsigned* bar = b.bar;
        __builtin_amdgcn_s_waitcnt(0);
        unsigned nloc = b.st[0], nx = b.st[1];
        if (nloc == 0u) { xcd_barrier_complete(bar, b.x, nloc, nx); b.st[0] = nloc; b.st[1] = nx; }
        const unsigned old = xb_add(&bar[XB_XSUB(b.x)], 1u);
        const unsigned gen = old / nloc;
        if (old + 1u == (gen + 1u) * nloc) {
            __builtin_amdgcn_fence(__ATOMIC_RELEASE, "agent");
            asm volatile("s_waitcnt vmcnt(0)" ::: "memory");
            const unsigned og = xb_add(&bar[XB_TOP], 1u);
            const unsigned tg = og / nx;
            if (og + 1u == (tg + 1u) * nx) xb_add(&bar[XB_TOPGEN], 1u);
            else XB_SPIN(xb_ld(&bar[XB_TOPGEN]) == tg, bar);
            __builtin_amdgcn_fence(__ATOMIC_ACQUIRE, "agent");
            xb_add(&bar[XB_XGEN(b.x)], 1u);
            asm volatile("s_waitcnt vmcnt(0)" ::: "memory");
        } else {
            XB_SPIN(xb_ld(&bar[XB_XGEN(b.x)]) == gen, bar);
            __builtin_amdgcn_fence(__ATOMIC_ACQUIRE, "agent");
            asm volatile("s_waitcnt vmcnt(0)" ::: "memory");
        }
    }
    __syncthreads();
}

namespace pg8 {
constexpr int BM = 256, BK = 64, HALF = 128, HTB = HALF * BK * 2, STAGE_BYTES = 8 * HTB, NXCD = 8, WGM = 8;
__host__ __device__ __forceinline__ int lds_byte(int r, int c) { const int st = (r >> 4) * 2 + (c >> 5), rr = r & 15, cc = c & 31, ob = rr * 64 + cc * 2; return st * 1024 + (ob ^ (((ob >> 9) & 1) << 5)); }
__host__ __device__ __forceinline__ void stage_rc(int b, int& R, int& C) { const int st = b / 1024, sb = b % 1024, swz = sb ^ (((sb >> 9) & 1) << 5); R = (st >> 1) * 16 + swz / 64; C = (st & 1) * 32 + (swz % 64) / 2; }
__host__ __device__ __forceinline__ int perm32(int rho) { const int n = rho >> 4, i = rho & 15; return 8 * (i >> 2) + 4 * n + (i & 3); }

struct Unit { int pm, pn; };
struct Gemm { const bf16_t* A; const bf16_t* Bt; int K, lda, ldb, a_pn_shift, a_pn_stride, mid_t; };

struct StaticOrder {
    int nM, nN, nwg, G, c;
    __device__ void init(int M, int N, int G_, int c_) { nM = M / BM; nN = N / BM; nwg = nM * nN; G = G_; c = c_; }
    __device__ bool next(int i, Unit& u) const {
        const long L = (long)i * G + c; if (L >= nwg) return false;
        int wgid = (int)L; { const int q = nwg / NXCD, r = nwg % NXCD, xcd = wgid % NXCD, off = wgid / NXCD; wgid = (xcd < r ? xcd * (q + 1) : r * (q + 1) + (xcd - r) * q) + off; }
        const int nig = WGM * nN, gid = wgid / nig, fm = gid * WGM, gsz = (nM - fm) < WGM ? (nM - fm) : WGM;
        u.pm = fm + ((wgid % nig) % gsz); u.pn = (wgid % nig) / gsz; return true;
    }
};
__device__ __forceinline__ unsigned cvt_pk_bf16(float lo, float hi) { unsigned r; asm volatile("v_cvt_pk_bf16_f32 %0, %1, %2" : "=v"(r) : "v"(lo), "v"(hi)); return r; }

struct EpiBf16 {
    static constexpr bool PERM = true;
    bf16_t* O; int ldc;
    __device__ __forceinline__ void operator()(const f32x4 (&acc)[2][2][4][2], const Unit& u, int wr, int wc, int fr, int fq) const {
        const int row0 = u.pm * BM + wr * 64 + fr, col0 = u.pn * BM + wc * 32 + 8 * fq;
#pragma unroll
        for (int ai = 0; ai < 2; ++ai)
#pragma unroll
            for (int m = 0; m < 4; ++m) { bf16_t* rowp = O + (size_t)(row0 + ai * HALF + m * 16) * ldc + col0;
#pragma unroll
                for (int bj = 0; bj < 2; ++bj) { const f32x4 v0 = acc[ai][bj][m][0], v1 = acc[ai][bj][m][1];
                    u32x4 w; w.x = cvt_pk_bf16(v0[0], v0[1]); w.y = cvt_pk_bf16(v0[2], v0[3]); w.z = cvt_pk_bf16(v1[0], v1[1]); w.w = cvt_pk_bf16(v1[2], v1[3]);
                    *(u32x4*)(rowp + bj * HALF) = w; } }
    }
};
struct EpiG1 {
    static constexpr bool PERM = true;
    bf16_t* P; const float* bg; bf16_t* RT; bf16_t* GRS; const float* rope; const unsigned long long* ss; const float* ssp; float* IFo;
    __device__ __forceinline__ void operator()(f32x4 (&acc)[2][2][4][2], const Unit& u, int wr, int wc, int fr, int fq) const {
        const int row0 = u.pm * BM + wr * 64 + fr, cw = wc * 32 + 8 * fq;
#pragma unroll
        for (int ai = 0; ai < 2; ++ai) {
            float sq[4];
            if (u.pm < 32) {
                f32x4 a[4], b[4];
#pragma unroll
                for (int m = 0; m < 4; ++m) { const float* q = ssp + (size_t)(row0 + ai * HALF + m * 16) * 8; a[m] = *(const f32x4*)q; b[m] = *(const f32x4*)(q + 4); }
#pragma unroll
                for (int m = 0; m < 4; ++m) sq[m] = ((a[m][0] + a[m][1]) + (a[m][2] + a[m][3])) + ((b[m][0] + b[m][1]) + (b[m][2] + b[m][3]));
            } else {
                unsigned long long v[4];
#pragma unroll
                for (int m = 0; m < 4; ++m) v[m] = ss[row0 + ai * HALF + m * 16];
#pragma unroll
                for (int m = 0; m < 4; ++m) sq[m] = ss_val(v[m]);
            }
#pragma unroll
            for (int m = 0; m < 4; ++m) { const float rstd = rsqrtf(sq[m] * (1.0f / 2048.0f) + 1e-6f);
#pragma unroll
                for (int bj = 0; bj < 2; ++bj) { acc[ai][bj][m][0] *= rstd; acc[ai][bj][m][1] *= rstd; } }
            __builtin_amdgcn_sched_barrier(0);
        }
        if (u.pn == 44) {
            if (wc == 0 && fq == 0) {
#pragma unroll
                for (int ai = 0; ai < 2; ++ai)
#pragma unroll
                    for (int m = 0; m < 4; ++m) { float* o = IFo + (size_t)(row0 + ai * HALF + m * 16) * 8; *(f32x4*)o = acc[ai][0][m][0]; *(f32x4*)(o + 4) = acc[ai][0][m][1]; }
            }
        } else if (u.pn >= 28) {
            const int ch = 128 * (u.pn - 28) + cw;
            const f32x4 bm0 = *(const f32x4*)(bg + ch), bm1 = *(const f32x4*)(bg + ch + 4), br0 = *(const f32x4*)(bg + 2048 + ch), br1 = *(const f32x4*)(bg + 2048 + ch + 4);
#pragma unroll
            for (int ai = 0; ai < 2; ++ai)
#pragma unroll
                for (int m = 0; m < 4; ++m) { const size_t row = (size_t)(row0 + ai * HALF + m * 16);
                    const f32x4 vm0 = acc[ai][0][m][0] + bm0, vm1 = acc[ai][0][m][1] + bm1, vr0 = acc[ai][1][m][0] + br0, vr1 = acc[ai][1][m][1] + br1;
                    float rt[8], gr[8];
#pragma unroll
                    for (int j = 0; j < 4; ++j) {
                        const float er0 = 1.0f + __expf(-vr0[j]), er1 = 1.0f + __expf(-vr1[j]);
                        rt[j] = er0 * __builtin_amdgcn_rcpf(1.0f + __expf(-vm0[j])); rt[4 + j] = er1 * __builtin_amdgcn_rcpf(1.0f + __expf(-vm1[j]));
                        gr[j] = __builtin_amdgcn_rcpf(er0); gr[4 + j] = __builtin_amdgcn_rcpf(er1); }
                    u32x4 w; w.x = cvt_pk_bf16(rt[0], rt[1]); w.y = cvt_pk_bf16(rt[2], rt[3]); w.z = cvt_pk_bf16(rt[4], rt[5]); w.w = cvt_pk_bf16(rt[6], rt[7]);
                    *(u32x4*)(RT + row * 2048 + ch) = w;
                    w.x = cvt_pk_bf16(gr[0], gr[1]); w.y = cvt_pk_bf16(gr[2], gr[3]); w.z = cvt_pk_bf16(gr[4], gr[5]); w.w = cvt_pk_bf16(gr[6], gr[7]);
                    *(u32x4*)(GRS + row * 2048 + ch) = w; }
        } else if (u.pn >= 12 && u.pn < 20) {
            const float sc = u.pn >= 16 ? 0.0625f : 1.0f;
#pragma unroll
            for (int ai = 0; ai < 2; ++ai)
#pragma unroll
                for (int m = 0; m < 4; ++m) { const int row = row0 + ai * HALF + m * 16;
                    const int pi = row < MP ? (row & (SEQ - 1)) : 2048;
                    const f32x4* cs = (const f32x4*)(rope + ((size_t)pi * 128 + cw) * 2);
                    const f32x4 t0 = cs[0], t1 = cs[1], t2 = cs[2], t3 = cs[3];
                    const f32x4 a0 = acc[ai][0][m][0], a1 = acc[ai][0][m][1], b0 = acc[ai][1][m][0], b1 = acc[ai][1][m][1];
                    const float c[8] = {t0[0], t0[2], t1[0], t1[2], t2[0], t2[2], t3[0], t3[2]}, sn[8] = {t0[1], t0[3], t1[1], t1[3], t2[1], t2[3], t3[1], t3[3]};
                    const float x1[8] = {a0[0], a0[1], a0[2], a0[3], a1[0], a1[1], a1[2], a1[3]}, x2[8] = {b0[0], b0[1], b0[2], b0[3], b1[0], b1[1], b1[2], b1[3]};
                    float o1[8], o2[8];
#pragma unroll
                    for (int j = 0; j < 8; ++j) { o1[j] = (x1[j] * c[j] - x2[j] * sn[j]) * sc; o2[j] = (x1[j] * sn[j] + x2[j] * c[j]) * sc; }
                    bf16_t* rowp = P + (size_t)row * NP + u.pn * BM + cw;
                    u32x4 w; w.x = cvt_pk_bf16(o1[0], o1[1]); w.y = cvt_pk_bf16(o1[2], o1[3]); w.z = cvt_pk_bf16(o1[4], o1[5]); w.w = cvt_pk_bf16(o1[6], o1[7]);
                    *(u32x4*)rowp = w;
                    w.x = cvt_pk_bf16(o2[0], o2[1]); w.y = cvt_pk_bf16(o2[2], o2[3]); w.z = cvt_pk_bf16(o2[4], o2[5]); w.w = cvt_pk_bf16(o2[6], o2[7]);
                    *(u32x4*)(rowp + HALF) = w; }
        } else {
#pragma unroll
            for (int ai = 0; ai < 2; ++ai)
#pragma unroll
                for (int m = 0; m < 4; ++m) { bf16_t* rowp = P + (size_t)(row0 + ai * HALF + m * 16) * NP + u.pn * BM + cw;
#pragma unroll
                    for (int bj = 0; bj < 2; ++bj) { const f32x4 v0 = acc[ai][bj][m][0], v1 = acc[ai][bj][m][1];
                        u32x4 w; w.x = cvt_pk_bf16(v0[0], v0[1]); w.y = cvt_pk_bf16(v0[2], v0[3]); w.z = cvt_pk_bf16(v1[0], v1[1]); w.w = cvt_pk_bf16(v1[2], v1[3]);
                        *(u32x4*)(rowp + bj * HALF) = w; } }
        }
    }
};
struct EpiMerged {
    static constexpr bool PERM = true;
    bf16_t* O; const bf16_t* RT; const bf16_t* GRS;
    __device__ __forceinline__ void scale(f32x4 (&acc)[2][2][4][2], const bf16_t* S, const Unit& u, int wr, int wc, int fr, int fq) const {
        asm volatile("" : "+v"(fr), "+v"(fq));
        const int row0 = u.pm * BM + wr * 64 + fr, col0 = u.pn * BM + wc * 32 + 8 * fq;
#pragma unroll
        for (int ai = 0; ai < 2; ++ai) {
            u32x4 sv[4][2];
#pragma unroll
            for (int m = 0; m < 4; ++m)
#pragma unroll
                for (int bj = 0; bj < 2; ++bj) sv[m][bj] = *(const u32x4*)(S + (size_t)(row0 + ai * HALF + m * 16) * 2048 + col0 + bj * HALF);
#pragma unroll
            for (int m = 0; m < 4; ++m)
#pragma unroll
                for (int bj = 0; bj < 2; ++bj) { const u32x4 a = sv[m][bj];
                    acc[ai][bj][m][0][0] *= __uint_as_float(a.x << 16); acc[ai][bj][m][0][1] *= __uint_as_float(a.x & 0xffff0000u);
                    acc[ai][bj][m][0][2] *= __uint_as_float(a.y << 16); acc[ai][bj][m][0][3] *= __uint_as_float(a.y & 0xffff0000u);
                    acc[ai][bj][m][1][0] *= __uint_as_float(a.z << 16); acc[ai][bj][m][1][1] *= __uint_as_float(a.z & 0xffff0000u);
                    acc[ai][bj][m][1][2] *= __uint_as_float(a.w << 16); acc[ai][bj][m][1][3] *= __uint_as_float(a.w & 0xffff0000u); }
        }
    }
    __device__ __forceinline__ void mid(f32x4 (&acc)[2][2][4][2], const Unit& u, int wr, int wc, int fr, int fq) const { scale(acc, RT, u, wr, wc, fr, fq); }
    __device__ __forceinline__ void operator()(f32x4 (&acc)[2][2][4][2], const Unit& u, int wr, int wc, int fr, int fq) const {
        scale(acc, GRS, u, wr, wc, fr, fq);
        const int row0 = u.pm * BM + wr * 64 + fr, col0 = u.pn * BM + wc * 32 + 8 * fq;
#pragma unroll
        for (int ai = 0; ai < 2; ++ai)
#pragma unroll
            for (int m = 0; m < 4; ++m) { bf16_t* rowp = O + (size_t)(row0 + ai * HALF + m * 16) * 2048 + col0;
#pragma unroll
                for (int bj = 0; bj < 2; ++bj) { const f32x4 v0 = acc[ai][bj][m][0], v1 = acc[ai][bj][m][1];
                    u32x4 w; w.x = cvt_pk_bf16(v0[0], v0[1]); w.y = cvt_pk_bf16(v0[2], v0[3]); w.z = cvt_pk_bf16(v1[0], v1[1]); w.w = cvt_pk_bf16(v1[2], v1[3]);
                    *(u32x4*)(rowp + bj * HALF) = w; } }
    }
};
struct EpiResidual {
    static constexpr bool PERM = true;
    bf16_t* Xb; float* ssp; LAS float* red;
    __device__ __forceinline__ void operator()(f32x4 (&acc)[2][2][4][2], const Unit& u, int wr, int wc, int fr, int fq) const {
        const int row0 = u.pm * BM + wr * 64 + fr, col0 = u.pn * BM + wc * 32 + 8 * fq;
#pragma unroll
        for (int ai = 0; ai < 2; ++ai) {
            u32x4 xv[4][2];
#pragma unroll
            for (int m = 0; m < 4; ++m)
#pragma unroll
                for (int bj = 0; bj < 2; ++bj) xv[m][bj] = *(const u32x4*)(Xb + (size_t)(row0 + ai * HALF + m * 16) * 2048 + col0 + bj * HALF);
#pragma unroll
            for (int m = 0; m < 4; ++m) { float sq = 0.f;
#pragma unroll
                for (int bj = 0; bj < 2; ++bj) { const u32x4 a = xv[m][bj]; const f32x4 v0 = acc[ai][bj][m][0], v1 = acc[ai][bj][m][1];
                    u32x4 w;
                    w.x = cvt_pk_bf16(v0[0] + __uint_as_float(a.x << 16), v0[1] + __uint_as_float(a.x & 0xffff0000u)); w.y = cvt_pk_bf16(v0[2] + __uint_as_float(a.y << 16), v0[3] + __uint_as_float(a.y & 0xffff0000u));
                    w.z = cvt_pk_bf16(v1[0] + __uint_as_float(a.z << 16), v1[1] + __uint_as_float(a.z & 0xffff0000u)); w.w = cvt_pk_bf16(v1[2] + __uint_as_float(a.w << 16), v1[3] + __uint_as_float(a.w & 0xffff0000u));
                    *(u32x4*)(Xb + (size_t)(row0 + ai * HALF + m * 16) * 2048 + col0 + bj * HALF) = w;
                    const unsigned ww[4] = {w.x, w.y, w.z, w.w};
#pragma unroll
                    for (int q = 0; q < 4; ++q) { const float lo = __uint_as_float(ww[q] << 16), hi = __uint_as_float(ww[q] & 0xffff0000u); sq += lo * lo + hi * hi; } }
                sq += __shfl_xor(sq, 16); sq += __shfl_xor(sq, 32);
                if (fq == 0) red[(wr * 64 + fr + ai * HALF + m * 16) * 4 + wc] = sq; }
        }
        asm volatile("s_waitcnt lgkmcnt(0)" ::: "memory"); __builtin_amdgcn_s_barrier(); asm volatile("" ::: "memory");
        int t = threadIdx.x; asm volatile("" : "+v"(t));
        if (t < 256) { const f32x4 q = *(LAS const f32x4*)(red + 4 * t); ssp[(size_t)(u.pm * BM + t) * 8 + u.pn] = (q[0] + q[1]) + (q[2] + q[3]); }
        asm volatile("s_waitcnt lgkmcnt(0)" ::: "memory"); __builtin_amdgcn_s_barrier(); asm volatile("" ::: "memory");
    }
};

template <bool MID, class Epi, class Sched, bool ALIGN_EPI = true>
__device__ __forceinline__ void gemm_phase(LAS unsigned char* lds, const Gemm g, const Sched& S, const Epi& E) {
    const int tid = opaque_tid(), wid = __builtin_amdgcn_readfirstlane(tid >> 6), lane = tid & 63, wr = wid >> 2, wc = wid & 3, fr = lane & 15, fq = lane >> 4;
    const int K = g.K, nt = K / BK;
    unsigned voffA[2], voffB[2];
#pragma unroll
    for (int i = 0; i < 2; ++i) { int R, C; stage_rc(tid * 16 + i * 8192, R, C); const int Rb = Epi::PERM ? ((R & ~31) + perm32(R & 31)) : R;
        voffA[i] = (unsigned)(R * g.lda + C) * 2u; voffB[i] = (unsigned)(Rb * g.ldb + C) * 2u; }
    const size_t kstep = (size_t)(BK * 2);
    const size_t hstepA = (size_t)HALF * g.lda * 2, hstepB = (size_t)HALF * g.ldb * 2;
    const size_t tstepA = 2 * hstepA, tstepB = 2 * hstepB;
    const unsigned ldsw = (unsigned)wid * 1024u;
    const int aoff = lds_byte(wr * 64 + fr, fq * 8), boff = lds_byte(wc * 32 + fr, fq * 8);
#define PG8_SA(b, h) (((b) * 2 + (h)) * HTB)
#define PG8_SB(b, h) ((4 + (b) * 2 + (h)) * HTB)
#define PG8_STAGE(bufoff, gbase, voff) do { _Pragma("unroll") for (int _i = 0; _i < 2; ++_i) \
        __builtin_amdgcn_global_load_lds((const unsigned*)((const char*)(gbase) + (voff)[_i]), (LAS unsigned*)(lds + (bufoff) + ldsw + _i * 8192), 16, 0, 0); } while (0)
#define PG8_LDA(dst, b, h) do { _Pragma("unroll") for (int m = 0; m < 4; ++m) _Pragma("unroll") for (int k = 0; k < 2; ++k) dst[m][k] = *(const LAS bf16x8*)(lds + PG8_SA(b, h) + aoff + m * 2048 + k * 1024); } while (0)
#define PG8_LDB(dst, b, h) do { _Pragma("unroll") for (int n = 0; n < 2; ++n) _Pragma("unroll") for (int k = 0; k < 2; ++k) dst[n][k] = *(const LAS bf16x8*)(lds + PG8_SB(b, h) + boff + n * 2048 + k * 1024); } while (0)
#define PG8_MMA(ai, bj, At, Bt) do { __builtin_amdgcn_s_setprio(1); _Pragma("unroll") for (int m = 0; m < 4; ++m) _Pragma("unroll") for (int n = 0; n < 2; ++n) _Pragma("unroll") for (int k = 0; k < 2; ++k) \
        acc[ai][bj][m][n] = __builtin_amdgcn_mfma_f32_16x16x32_bf16(Bt[n][k], At[m][k], acc[ai][bj][m][n], 0, 0, 0); __builtin_amdgcn_s_setprio(0); } while (0)
#define PG8_WAIT_V(n) asm volatile("s_waitcnt vmcnt(" #n ")" ::: "memory")
#define PG8_WAIT_L(n) asm volatile("s_waitcnt lgkmcnt(" #n ")" ::: "memory")
#define PG8_BAR __builtin_amdgcn_s_barrier()
#define PG8_SCHED __builtin_amdgcn_sched_barrier(0)
#define PG8_APTR(u) ((const char*)g.A + (size_t)(u).pm * tstepA + (size_t)((u).pn >> g.a_pn_shift) * (size_t)g.a_pn_stride)
    Unit cur, nxt; int ui = 0;
    if (!S.next(0, cur)) return;
    f32x4 acc[2][2][4][2];
#pragma unroll
    for (int a = 0; a < 2; ++a)
#pragma unroll
        for (int b = 0; b < 2; ++b)
#pragma unroll
            for (int m = 0; m < 4; ++m)
#pragma unroll
                for (int n = 0; n < 2; ++n) acc[a][b][m][n] = (f32x4){0.f, 0.f, 0.f, 0.f};
    bf16x8 At[4][2], B0[2][2], B1[2][2];
    const char* cA = PG8_APTR(cur); const char* cB = (const char*)g.Bt + (size_t)cur.pn * tstepB;
    PG8_STAGE(PG8_SB(0, 0), cB, voffB); PG8_STAGE(PG8_SB(0, 1), cB + hstepB, voffB); PG8_STAGE(PG8_SA(0, 0), cA, voffA); PG8_STAGE(PG8_SA(0, 1), cA + hstepA, voffA);
    if (wr == 1) PG8_BAR;
    PG8_WAIT_V(2); PG8_BAR;
    PG8_STAGE(PG8_SB(1, 0), cB + kstep, voffB); PG8_STAGE(PG8_SA(1, 0), cA + kstep, voffA); PG8_STAGE(PG8_SB(1, 1), cB + hstepB + kstep, voffB);
    PG8_WAIT_V(6); PG8_BAR;
    for (;;) {
        const bool has_next = S.next(ui + 1, nxt);
        const char* nA = has_next ? PG8_APTR(nxt) : cA; const char* nB = has_next ? (const char*)g.Bt + (size_t)nxt.pn * tstepB : cB;
#pragma unroll 1
        for (int t = 0; t < nt; t += 2) {
            const bool last = (t == nt - 2);
            const char* a1 = cA + (size_t)(t + 1) * kstep;
            const char* a2 = last ? nA : cA + (size_t)(t + 2) * kstep; const char* b2 = last ? nB : cB + (size_t)(t + 2) * kstep;
            const char* a3 = a2 + kstep; const char* b3 = b2 + kstep;
            if constexpr (MID) { if (t == g.mid_t) E.mid(acc, cur, wr, wc, fr, fq); }
            PG8_LDB(B0, 0, 0); PG8_LDB(B1, 0, 1); PG8_SCHED; PG8_LDA(At, 0, 0); PG8_STAGE(PG8_SA(1, 1), a1 + hstepA, voffA);
            PG8_WAIT_V(8); PG8_WAIT_L(0); PG8_BAR; PG8_MMA(0, 0, At, B0); PG8_MMA(0, 1, At, B1); PG8_BAR; PG8_SCHED;
            PG8_LDA(At, 0, 1); PG8_STAGE(PG8_SB(0, 0), b2, voffB); PG8_STAGE(PG8_SB(0, 1), b2 + hstepB, voffB); PG8_STAGE(PG8_SA(0, 0), a2, voffA);
            PG8_WAIT_V(8); PG8_WAIT_L(0); PG8_BAR; PG8_MMA(1, 0, At, B0); PG8_MMA(1, 1, At, B1); PG8_BAR; PG8_SCHED;
            PG8_LDB(B0, 1, 0); PG8_LDB(B1, 1, 1); PG8_SCHED; PG8_LDA(At, 1, 0); PG8_STAGE(PG8_SA(0, 1), a2 + hstepA, voffA);
            PG8_WAIT_V(8); PG8_WAIT_L(0); PG8_BAR; PG8_MMA(0, 0, At, B0); PG8_MMA(0, 1, At, B1); PG8_BAR; PG8_SCHED;
            PG8_LDA(At, 1, 1); PG8_STAGE(PG8_SB(1, 0), b3, voffB); PG8_STAGE(PG8_SB(1, 1), b3 + hstepB, voffB); PG8_STAGE(PG8_SA(1, 0), a3, voffA);
            PG8_WAIT_V(8); PG8_WAIT_L(0); PG8_BAR; PG8_MMA(1, 0, At, B0); PG8_MMA(1, 1, At, B1); PG8_BAR; PG8_SCHED;
        }
        if constexpr (ALIGN_EPI) { if (wr == 0) PG8_BAR; }
        E(acc, cur, wr, wc, fr, fq);
        if (!has_next) break;
#pragma unroll
        for (int a = 0; a < 2; ++a)
#pragma unroll
            for (int b = 0; b < 2; ++b)
#pragma unroll
                for (int m = 0; m < 4; ++m)
#pragma unroll
                    for (int n = 0; n < 2; ++n) acc[a][b][m][n] = (f32x4){0.f, 0.f, 0.f, 0.f};
        cur = nxt; cA = nA; cB = nB; ++ui;
        if constexpr (ALIGN_EPI) { if (wr == 1) PG8_BAR; }
    }
    PG8_WAIT_V(0);
    if constexpr (!ALIGN_EPI) { if (wr == 0) PG8_BAR; }
    PG8_BAR;
#undef PG8_SA
#undef PG8_SB
#undef PG8_STAGE
#undef PG8_LDA
#undef PG8_LDB
#undef PG8_MMA
#undef PG8_WAIT_V
#undef PG8_WAIT_L
#undef PG8_BAR
#undef PG8_SCHED
#undef PG8_APTR
}
}

struct TrDesc { const float* src; bf16_t* dst; const float* ks; int ldsrc, ldd; float scale; };
__device__ __forceinline__ TrDesc tr_desc(const Params& p, int it) {
    constexpr int T0 = 1536, T1 = T0 + 2048, T2 = T1 + 2048, T3 = T2 + 512, T4 = T3 + 512, T5 = T4 + 1024, T6 = T5 + 64, T7 = T6 + 64;
    const int l = it / T7, r = it % T7;
    bf16_t* Wl = p.W_() + (size_t)l * WL;
    TrDesc d; d.scale = 1.f; d.ks = nullptr;
    int k0, c0, r0, kd0; const float* src; bf16_t* dst;
    if (r < T0)      { const int q = r;      src = p.w_in + (size_t)l * D * NIN; d.ldsrc = NIN; k0 = (q & 31) * 64; c0 = (q >> 5) * 64; dst = Wl + W1_OFF; d.ldd = D; r0 = (q >> 5) * 64; kd0 = k0; d.ks = p.norm_g + (size_t)l * D; }
    else if (r < T1) { const int q = r - T0; src = p.w_in + (size_t)l * D * NIN; d.ldsrc = NIN; k0 = (q & 31) * 64; c0 = 3080 + (q >> 5) * 64; dst = Wl + W1_OFF; d.ldd = D; r0 = 3072 + (q >> 5) * 64; kd0 = k0; d.ks = p.norm_g + (size_t)l * D; }
    else if (r < T2) { const int q = r - T1, ct = q >> 5;
                       src = p.w_gate + (size_t)l * D * 4096; d.ldsrc = 4096; k0 = (q & 31) * 64; c0 = (((ct & 3) < 2) ? 0 : 2048) + 128 * (ct >> 2) + (ct & 1) * 64; dst = Wl + W1_OFF; d.ldd = D; r0 = C_GM + ct * 64; kd0 = k0; d.ks = p.norm_g + (size_t)l * D; }
    else if (r < T3) { const int q = r - T2; src = p.w_pm + (size_t)l * WM * D; d.ldsrc = D; k0 = (q & 15) * 64; c0 = (q >> 4) * 64; dst = Wl + W3_OFF; d.ldd = D; r0 = c0; kd0 = k0; }
    else if (r < T4) { const int q = r - T3; src = p.w_pr + (size_t)l * WM * D; d.ldsrc = D; k0 = (q & 15) * 64; c0 = (q >> 4) * 64; dst = Wl + W3_OFF; d.ldd = D; r0 = c0; kd0 = 1024 + k0; }
    else if (r < T5) { const int q = r - T4; src = p.w_o + (size_t)l * D * D; d.ldsrc = D; k0 = (q & 31) * 64; c0 = (q >> 5) * 64; dst = Wl + W4_OFF; d.ldd = D; r0 = c0; kd0 = k0; }
    else if (r < T6) { const int q = r - T5, h = q >> 4, qq = q & 15; src = p.w_qm + ((size_t)l * HM + h) * SZ; d.ldsrc = DH; k0 = (qq & 3) * 64; c0 = (qq >> 2) * 64; dst = Wl + W2_OFF; d.ldd = DH; r0 = h * 512 + c0; kd0 = k0; d.scale = 0.0625f; }
    else             { const int q = r - T6, h = q >> 4, qq = q & 15; src = p.w_km + ((size_t)l * HM + h) * SZ; d.ldsrc = DH; k0 = (qq & 3) * 64; c0 = (qq >> 2) * 64; dst = Wl + W2_OFF; d.ldd = DH; r0 = h * 512 + 256 + c0; kd0 = k0; }
    d.src = src + (size_t)k0 * d.ldsrc + c0; d.dst = dst + (size_t)r0 * d.ldd + kd0; if (d.ks) d.ks += k0;
    return d;
}
__device__ __forceinline__ void tr_load(const TrDesc& d, f32x4 (&v)[16], f32x4 (&ks)[2], int lane) {
#pragma unroll
    for (int i = 0; i < 16; ++i) v[i] = __builtin_nontemporal_load((const f32x4*)(d.src + (size_t)((lane >> 4) + 4 * i) * d.ldsrc + 4 * (lane & 15)));
    if (d.ks) { ks[0] = *(const f32x4*)(d.ks + 8 * (lane & 7)); ks[1] = *(const f32x4*)(d.ks + 8 * (lane & 7) + 4); }
    else { ks[0] = (f32x4){1.f, 1.f, 1.f, 1.f}; ks[1] = ks[0]; }
}
__device__ __forceinline__ void tr_store(const TrDesc& d, const f32x4 (&v)[16], const f32x4 (&ks)[2], LAS float* t, int lane) {
#pragma unroll
    for (int i = 0; i < 16; ++i)
#pragma unroll
        for (int j = 0; j < 4; ++j) t[((lane >> 4) + 4 * i) * 65 + 4 * (lane & 15) + j] = v[i][j];
    const int c = lane & 7;
    const f32x4 s0 = ks[0] * d.scale, s1 = ks[1] * d.scale;
#pragma unroll
    for (int j = 0; j < 8; ++j) { const int n = (lane >> 3) + 8 * j; const LAS float* q = t + (8 * c) * 65 + n;
        u32x4 o; o.x = pk2(s0[0] * q[0], s0[1] * q[65]); o.y = pk2(s0[2] * q[130], s0[3] * q[195]); o.z = pk2(s1[0] * q[260], s1[1] * q[325]); o.w = pk2(s1[2] * q[390], s1[3] * q[455]);
        *(u32x4*)(d.dst + (size_t)n * d.ldd + 8 * c) = o; }
}
__device__ __forceinline__ void prep_phase(const Params& p, int wg, int nwg, LAS unsigned char* lds) {
    const int tid = opaque_tid();
    {
        const int lane = tid & 63, wid = tid >> 6;
        for (int row = wg * 8 + wid; row < MPAD; row += nwg * 8) {
            u32x2* hrow = (u32x2*)(p.Xb_() + (size_t)row * D);
            float ss = 0.f;
            if (row < MT) {
                const f32x4* xr = (const f32x4*)(row < MP ? p.x_prompt + (size_t)row * D : p.x_sample + (size_t)(row - MP) * D);
#pragma unroll
                for (int i = 0; i < 8; ++i) { const f32x4 v = xr[lane + 64 * i]; ss += (v[0] * v[0] + v[1] * v[1]) + (v[2] * v[2] + v[3] * v[3]); hrow[lane + 64 * i] = (u32x2){pk2(v[0], v[1]), pk2(v[2], v[3])}; }
                ss = wave_sum(ss);
            } else {
#pragma unroll
                for (int i = 0; i < 8; ++i) hrow[lane + 64 * i] = (u32x2){0u, 0u};
            }
            if (lane < 5) p.SS_()[(size_t)lane * MPAD + row] = lane == 0 ? ss_fix(ss) : 0ull;
            if (row < MP && lane < 8) p.SSP_()[(size_t)row * 8 + lane] = lane == 0 ? ss : 0.f;
        }
    }
    for (int i = wg * 512 + tid; i < 2049 * 128; i += nwg * 512) {
        const int pi = i >> 7, j = i & 127;
        const float pos = pi < 2048 ? (float)pi : 16384.0f;
        const float inv = powf(10000.0f, -((float)j / 128.0f));
        const float ang = pos * inv;
        p.ROPE_()[2 * i] = (float)cos((double)ang); p.ROPE_()[2 * i + 1] = (float)sin((double)ang);
    }
    for (int i = wg * 512 + tid; i < DEPTH * 256 * D; i += nwg * 512) {
        const int l = i / (256 * D), r = i % (256 * D), j = r / D, k = r % D;
        p.W_()[(size_t)l * WL + W1_OFF + (size_t)(11264 + j) * D + k] = j < 8 ? f2bf(p.w_in[((size_t)l * D + k) * NIN + 3072 + j] * p.norm_g[(size_t)l * D + k]) : (bf16_t)0;
    }
    const int lane = tid & 63, wid = tid >> 6;
    LAS float* t = (LAS float*)lds + wid * (64 * 65);
    constexpr int NT = DEPTH * 7808;
    int it = wg * 8 + wid;
    if (it < NT) {
        TrDesc d = tr_desc(p, it);
        f32x4 v[16], ks[2];
        tr_load(d, v, ks, lane);
        for (;;) {
            const int it2 = it + nwg * 8;
            const bool has = it2 < NT;
            TrDesc d2 = d; f32x4 v2[16], ks2[2];
            if (has) { d2 = tr_desc(p, it2); tr_load(d2, v2, ks2, lane); }
            tr_store(d, v, ks, t, lane);
            if (!has) break;
#pragma unroll
            for (int i = 0; i < 16; ++i) v[i] = v2[i];
            ks[0] = ks2[0]; ks[1] = ks2[1]; d = d2; it = it2;
        }
    }
}

__device__ __forceinline__ void final_phase(const Params& p, int wg, int nwg) {
    const int tid_ = opaque_tid(), lane = tid_ & 63, wid = tid_ >> 6;
    const f32x4* g4 = (const f32x4*)p.final_g;
    for (int row = wg * 8 + wid; row < MT; row += nwg * 8) {
        const u32x2* xr = (const u32x2*)(p.Xb_() + (size_t)row * D);
        f32x4* yr = (f32x4*)(p.out + (row < MP ? O_YP + (size_t)row * D : O_YS + (size_t)(row - MP) * D));
        const float rstd = rsqrtf(row_ss(p.SSP_(), p.SS_() + (size_t)4 * MPAD, row) * (1.0f / D) + EPS);
#pragma unroll
        for (int i = 0; i < 8; ++i) { const u32x2 xb = xr[lane + 64 * i];
            const f32x4 v = (f32x4){__uint_as_float(xb.x << 16), __uint_as_float(xb.x & 0xffff0000u), __uint_as_float(xb.y << 16), __uint_as_float(xb.y & 0xffff0000u)};
            yr[lane + 64 * i] = v * rstd * g4[lane + 64 * i]; }
    }
}

__device__ __forceinline__ void unpack8(const u32x4 v, float (&f)[8]) {
    f[0] = __uint_as_float(v.x << 16); f[1] = __uint_as_float(v.x & 0xffff0000u); f[2] = __uint_as_float(v.y << 16); f[3] = __uint_as_float(v.y & 0xffff0000u);
    f[4] = __uint_as_float(v.z << 16); f[5] = __uint_as_float(v.z & 0xffff0000u); f[6] = __uint_as_float(v.w << 16); f[7] = __uint_as_float(v.w & 0xffff0000u);
}
__device__ __forceinline__ u32x4 pack8(const float (&f)[8]) { u32x4 w; w.x = pk2(f[0], f[1]); w.y = pk2(f[2], f[3]); w.z = pk2(f[4], f[5]); w.w = pk2(f[6], f[7]); return w; }

__device__ __forceinline__ void gate_all(const Params& p, int layer, int bh, LAS float* G);
__device__ __forceinline__ void conv_phase(const Params& p, int layer, int wg, int nwg, LAS unsigned char* lds) {
    const int tid = opaque_tid();
    for (int bh = wg; bh < 16; bh += nwg) gate_all(p, layer, bh, (LAS float*)lds);
    const float* cw = p.conv_w + (size_t)layer * 4 * WM;
    const float* cb = p.conv_b + (size_t)layer * WM;
    for (int it = wg * 512 + tid; it < MT * 128; it += nwg * 512) {
        const int row = it >> 7, ch = (it & 127) * 8;
        float up[4][8];
        if (row < MP) {
            const int t = row & (SEQ - 1);
#pragma unroll
            for (int i = 0; i < 4; ++i) {
                if (t - 3 + i >= 0) unpack8(*(const u32x4*)(p.P_() + (size_t)(row - 3 + i) * NP + C_U + ch), up[i]);
                else {
#pragma unroll
                    for (int j = 0; j < 8; ++j) up[i][j] = 0.f;
                }
            }
            if (t >= SEQ - 3) {
                const int b = row >> 11;
                float* o = p.out + O_CVP + (((size_t)layer * BP + b) * 3 + (t - (SEQ - 3))) * WM + ch;
                *(f32x4*)o = (f32x4){up[3][0], up[3][1], up[3][2], up[3][3]}; *(f32x4*)(o + 4) = (f32x4){up[3][4], up[3][5], up[3][6], up[3][7]};
            }
        } else {
            const int b = row - MP;
            const float* hist = p.st_conv + ((size_t)layer * BS + b) * 3 * WM + ch;
#pragma unroll
            for (int i = 0; i < 3; ++i) { const f32x4 a = *(const f32x4*)(hist + (size_t)i * WM), c = *(const f32x4*)(hist + (size_t)i * WM + 4);
                up[i][0] = a[0]; up[i][1] = a[1]; up[i][2] = a[2]; up[i][3] = a[3]; up[i][4] = c[0]; up[i][5] = c[1]; up[i][6] = c[2]; up[i][7] = c[3]; }
            unpack8(*(const u32x4*)(p.P_() + (size_t)row * NP + C_U + ch), up[3]);
            float* o = p.out + O_CVS + ((size_t)layer * BS + b) * 3 * WM + ch;
#pragma unroll
            for (int i = 0; i < 3; ++i) { *(f32x4*)(o + (size_t)i * WM) = (f32x4){up[i + 1][0], up[i + 1][1], up[i + 1][2], up[i + 1][3]};
                *(f32x4*)(o + (size_t)i * WM + 4) = (f32x4){up[i + 1][4], up[i + 1][5], up[i + 1][6], up[i + 1][7]}; }
        }
        float r[8];
#pragma unroll
        for (int j = 0; j < 8; ++j) r[j] = cb[ch + j];
#pragma unroll
        for (int i = 0; i < 4; ++i)
#pragma unroll
            for (int j = 0; j < 8; ++j) r[j] += up[i][j] * cw[i * WM + ch + j];
#pragma unroll
        for (int j = 0; j < 8; ++j) r[j] = siluf_(r[j]);
        *(u32x4*)(p.CM_() + (size_t)row * WM + ch) = pack8(r);
    }
}

__device__ __forceinline__ void gate_all(const Params& p, int layer, int bh, LAS float* G) {
    const int tid = opaque_tid(), lane = tid & 63, wid = tid >> 6, b = bh >> 2, h = bh & 3;
    const float bi = p.b_i[layer * HM + h], bfv = p.b_f[layer * HM + h];
    float* gt = p.GT_() + (size_t)bh * 6208;
    float tb0[2], tb1[2], tg0[2], tg1[2], rm0[2], rm1[2];
#pragma unroll
    for (int q = 0; q < 2; ++q) {
        const int cc = wid + 8 * q;
        const size_t r0 = (size_t)b * SEQ + cc * 128 + 2 * lane;
        const float i0 = p.IF_()[r0 * 8 + h] + bi, i1 = p.IF_()[(r0 + 1) * 8 + h] + bi;
        const float l0 = logsigf_(p.IF_()[r0 * 8 + 4 + h] + bfv), l1 = logsigf_(p.IF_()[(r0 + 1) * 8 + 4 + h] + bfv);
        float inc = l0 + l1;
#pragma unroll
        for (int o = 1; o < 64; o <<= 1) { const float t = __shfl_up(inc, o); if (lane >= o) inc += t; }
        const float exc = inc - (l0 + l1);
        tb0[q] = exc + l0; tb1[q] = inc;
        tg0[q] = i0 - tb0[q]; tg1[q] = i1 - tb1[q];
        const float gm = wave_max(fmaxf(tg0[q], tg1[q]));
        const float Bc = __shfl(inc, 63);
        if (lane == 0) { G[cc] = Bc; G[16 + cc] = gm; }
        float rm = fmaxf(tg0[q], tg1[q]);
#pragma unroll
        for (int o = 1; o < 64; o <<= 1) { const float t = __shfl_up(rm, o); if (lane >= o) rm = fmaxf(rm, t); }
        float ex = __shfl_up(rm, 1); if (lane == 0) ex = -3.0e38f;
        rm0[q] = fmaxf(ex, tg0[q]); rm1[q] = fmaxf(rm0[q], tg1[q]);
    }
    __syncthreads();
    if (tid == 0) { float m = -1e30f; for (int cc = 0; cc < 16; ++cc) { G[32 + cc] = m; m = G[cc] + fmaxf(m, G[16 + cc]); } G[48] = m; }
    __syncthreads();
#pragma unroll
    for (int q = 0; q < 2; ++q) {
        const int cc = wid + 8 * q, t0 = cc * 128 + 2 * lane;
        const float mc = G[32 + cc];
        *(f32x2_t*)(gt + t0) = (f32x2_t){tb0[q], tb1[q]}; *(f32x2_t*)(gt + 2048 + t0) = (f32x2_t){tg0[q], tg1[q]};
        *(f32x2_t*)(gt + 4096 + t0) = (f32x2_t){fmaxf(rm0[q], mc), fmaxf(rm1[q], mc)};
    }
    if (tid < 16) { gt[6144 + tid] = G[tid]; gt[6160 + tid] = G[16 + tid]; }
    if (tid < 17) gt[6176 + tid] = G[32 + tid];
    __syncthreads();
}
__device__ __forceinline__ void gate_load(const Params& p, int bh, int c, LAS float* G, int tid) {
    const float* gt = p.GT_() + (size_t)bh * 6208;
    if (tid < 128) { G[64 + tid] = gt[c * 128 + tid]; G[192 + tid] = gt[2048 + c * 128 + tid]; G[320 + tid] = gt[4096 + c * 128 + tid]; }
    if (tid == 0) G[32 + c] = gt[6176 + c];
    __syncthreads();
}

template <int I> struct IC { static constexpr int value = I; };
template <int I, int N, class F> __device__ __forceinline__ void sfor(F&& f) { if constexpr (I < N) { f(IC<I>{}); sfor<I + 1, N>(f); } }

template <int CPR>
__device__ __forceinline__ void tile_load(u32x4 (&r)[8], const bf16_t* src, int ld_src, int tid) {
#pragma unroll
    for (int i = 0; i < 8; ++i) { const int id = tid + 512 * i, row = id / CPR, ch = id % CPR; r[i] = *(const u32x4*)(src + (size_t)row * ld_src + ch * 8); }
}
template <int CPR, int LDB>
__device__ __forceinline__ void tile_store(LAS unsigned char* dst, const u32x4 (&r)[8], int tid) {
#pragma unroll
    for (int i = 0; i < 8; ++i) { const int id = tid + 512 * i, row = id / CPR, ch = id % CPR; *(LAS u32x4*)(dst + row * LDB + ch * 16) = r[i]; }
}
__device__ __forceinline__ void tile_store_w(LAS unsigned char* dst, const u32x4 (&r)[8], LAS const float* w, int tid) {
#pragma unroll
    for (int i = 0; i < 8; ++i) { const int id = tid + 512 * i, row = id >> 5, ch = id & 31; float f[8]; unpack8(r[i], f); const float ww = w[row];
#pragma unroll
        for (int j = 0; j < 8; ++j) f[j] *= ww;
        *(LAS u32x4*)(dst + row * 544 + ch * 16) = pack8(f); }
}
template <int OFF, int HS>
__device__ __forceinline__ bf16x8 tr_frag1(unsigned base) {
    u32x2 l0, h0;
    asm volatile("ds_read_b64_tr_b16 %0, %2 offset:%3\n\tds_read_b64_tr_b16 %1, %2 offset:%4\n\ts_waitcnt lgkmcnt(0)"
                 : "=&v"(l0), "=&v"(h0) : "v"(base), "i"(OFF), "i"(OFF + HS) : "memory");
    const u32x4 v = (u32x4){l0.x, l0.y, h0.x, h0.y};
    return __builtin_bit_cast(bf16x8, v);
}
template <int OFF, int HS, int TS>
__device__ __forceinline__ void tr_frag2(unsigned base, bf16x8& f0, bf16x8& f1) {
    u32x2 l0, l1, h0, h1;
    asm volatile("ds_read_b64_tr_b16 %0, %4 offset:%5\n\tds_read_b64_tr_b16 %2, %4 offset:%6\n\t"
                 "ds_read_b64_tr_b16 %1, %4 offset:%7\n\tds_read_b64_tr_b16 %3, %4 offset:%8\n\t"
                 "s_waitcnt lgkmcnt(0)"
                 : "=&v"(l0), "=&v"(l1), "=&v"(h0), "=&v"(h1)
                 : "v"(base), "i"(OFF), "i"(OFF + HS), "i"(OFF + TS), "i"(OFF + TS + HS)
                 : "memory");
    f0 = __builtin_bit_cast(bf16x8, (u32x4){l0.x, l0.y, h0.x, h0.y}); f1 = __builtin_bit_cast(bf16x8, (u32x4){l1.x, l1.y, h1.x, h1.y});
}
template <int OFF, int HS, int TS>
__device__ __forceinline__ void tr_frag4(unsigned base, bf16x8 (&f)[4]) {
    u32x2 l0, l1, l2, l3, h0, h1, h2, h3;
    asm volatile("ds_read_b64_tr_b16 %0, %8 offset:%9\n\tds_read_b64_tr_b16 %4, %8 offset:%10\n\t"
                 "ds_read_b64_tr_b16 %1, %8 offset:%11\n\tds_read_b64_tr_b16 %5, %8 offset:%12\n\t"
                 "ds_read_b64_tr_b16 %2, %8 offset:%13\n\tds_read_b64_tr_b16 %6, %8 offset:%14\n\t"
                 "ds_read_b64_tr_b16 %3, %8 offset:%15\n\tds_read_b64_tr_b16 %7, %8 offset:%16\n\t"
                 "s_waitcnt lgkmcnt(0)"
                 : "=&v"(l0), "=&v"(l1), "=&v"(l2), "=&v"(l3), "=&v"(h0), "=&v"(h1), "=&v"(h2), "=&v"(h3)
                 : "v"(base), "i"(OFF), "i"(OFF + HS), "i"(OFF + TS), "i"(OFF + TS + HS), "i"(OFF + 2 * TS), "i"(OFF + 2 * TS + HS), "i"(OFF + 3 * TS), "i"(OFF + 3 * TS + HS)
                 : "memory");
    f[0] = __builtin_bit_cast(bf16x8, (u32x4){l0.x, l0.y, h0.x, h0.y}); f[1] = __builtin_bit_cast(bf16x8, (u32x4){l1.x, l1.y, h1.x, h1.y});
    f[2] = __builtin_bit_cast(bf16x8, (u32x4){l2.x, l2.y, h2.x, h2.y}); f[3] = __builtin_bit_cast(bf16x8, (u32x4){l3.x, l3.y, h3.x, h3.y});
}
__device__ __forceinline__ unsigned lds_addr(LAS const void* p) { return (unsigned)(size_t)p; }

template <int NR, int NC, bool WEIGHT>
__device__ __forceinline__ void stage_T(LAS unsigned char* dst, int ldd_bytes, const bf16_t* src, int ld_src, LAS const float* w) {
    const int tid_ = opaque_tid(), lane = tid_ & 63, wid = tid_ >> 6;
    constexpr int PB = NR / 128, CG = NC / 8;
#pragma unroll 1
    for (int task = wid; task < PB * CG; task += 8) {
        const int pb = task % PB, cg = task / PB, r = pb * 128 + 2 * lane;
        float a[8], c[8];
        unpack8(*(const u32x4*)(src + (size_t)r * ld_src + cg * 8), a); unpack8(*(const u32x4*)(src + (size_t)(r + 1) * ld_src + cg * 8), c);
        float w0 = 1.f, w1 = 1.f; if (WEIGHT) { w0 = w[r]; w1 = w[r + 1]; }
#pragma unroll
        for (int j = 0; j < 8; ++j) *(LAS unsigned*)(dst + (cg * 8 + j) * ldd_bytes + r * 2) = pk2(a[j] * w0, c[j] * w1);
    }
}
__device__ __forceinline__ void stage_rows(LAS unsigned char* dst, const bf16_t* src, int ld_src) {
    const int tid_ = opaque_tid();
#pragma unroll
    for (int i = 0; i < 8; ++i) { const int id = tid_ + 512 * i, row = id >> 5, ch = id & 31;
        *(LAS u32x4*)(dst + row * 528 + ch * 16) = *(const u32x4*)(src + (size_t)row * ld_src + ch * 8); }
}
__device__ __forceinline__ bf16x8 lds_frag(LAS const unsigned char* base, int row, int ld_bytes, int kbyte) { return *(LAS const bf16x8*)(base + row * ld_bytes + kbyte); }
__device__ __forceinline__ float ret_lg(int h) { return logf(1.0f - exp2f(-5.0f - (float)h)); }

template <int BR>
__device__ __forceinline__ void chunk_passA(const Params& p, int layer, int b, int h, int c, LAS unsigned char* lds) {
    LAS unsigned char* Xt = lds; LAS unsigned char* Yt = lds + 69632; LAS float* G = (LAS float*)(lds + 139264); LAS float* wk = G + 512;
    const int tid = opaque_tid(), lane = tid & 63, w = __builtin_amdgcn_readfirstlane(tid >> 6), g = lane >> 4, lr = lane & 15;
    const size_t row0 = (size_t)b * SEQ + c * 128;
    const int pi = BR * 16 + b * 4 + h;
    const bf16_t* Xp = BR == 0 ? p.QK_() + row0 * 2048 + h * 512 + 256 : p.P_() + row0 * NP + C_VR + h * 256;
    const bf16_t* Yp = BR == 0 ? p.P_() + row0 * NP + C_VM + h * 256 : p.P_() + row0 * NP + C_KR + h * 256;
    u32x4 xr[8], yr[8];
    tile_load<32>(xr, Xp, BR == 0 ? 2048 : NP, tid); tile_load<32>(yr, Yp, NP, tid);
    if (BR == 0) { gate_load(p, b * 4 + h, c, G, tid); if (tid < 128) wk[tid] = expf(G[192 + tid] - G[320 + 127]); }
    else { if (tid < 128) wk[tid] = expf((float)(127 - tid) * ret_lg(h)); }
    __syncthreads();
    tile_store<32, 544>(Xt, xr, tid); tile_store_w(Yt, yr, wk, tid);
    __syncthreads();
    const unsigned lpart = (unsigned)(((8 * g + (lr >> 2)) * 272 + 4 * (lr & 3)) * 2);
    const unsigned baseX = lds_addr(Xt) + lpart + (unsigned)(32 * w * 2), baseY = lds_addr(Yt) + lpart;
    bf16_t* Uo = p.U_() + ((size_t)pi * 16 + c) * SZ;
    sfor<0, 2>([&](auto rt_) {
        constexpr int rt = decltype(rt_)::value;
        f32x4 acc[16];
#pragma unroll
        for (int j = 0; j < 16; ++j) acc[j] = (f32x4){0.f, 0.f, 0.f, 0.f};
        sfor<0, 4>([&](auto ks_) {
            constexpr int ks = decltype(ks_)::value;
            const bf16x8 fa = tr_frag1<ks * 32 * 544 + rt * 32, 4 * 544>(baseX);
            sfor<0, 4>([&](auto cq_) {
                constexpr int cq = decltype(cq_)::value;
                bf16x8 fb[4];
                tr_frag4<ks * 32 * 544 + cq * 128, 4 * 544, 32>(baseY, fb);
#pragma unroll
                for (int i = 0; i < 4; ++i) acc[4 * cq + i] = __builtin_amdgcn_mfma_f32_16x16x32_bf16(fa, fb[i], acc[4 * cq + i], 0, 0, 0);
            });
        });
#pragma unroll
        for (int ct = 0; ct < 16; ++ct)
            *(u32x2*)(Uo + (size_t)(16 * ct + lr) * 256 + 32 * w + 16 * rt + 4 * g) = (u32x2){pk2(acc[ct][0], acc[ct][1]), pk2(acc[ct][2], acc[ct][3])};
    });
    if (BR == 0 && tid < 256) {
        float sacc = 0.f;
        for (int ss = 0; ss < 128; ++ss) sacc += wk[ss] * bf2f(*(LAS const bf16_t*)(Xt + ss * 544 + tid * 2));
        p.NU_()[((size_t)(b * 4 + h) * 16 + c) * 256 + tid] = sacc;
    }
    __syncthreads();
}

template <int BR>
__device__ __forceinline__ void chunk_state_item(const Params& p, int layer, int b, int h, int sl, LAS unsigned char* lds) {
    LAS unsigned char* Xt = lds;
    LAS unsigned char* Ys = lds + 69632;
    LAS float* wka = (LAS float*)(lds + 79872);
    LAS float* dec = wka + 2048;
    const int tid = opaque_tid(), lane = tid & 63, w = __builtin_amdgcn_readfirstlane(tid >> 6), g = lane >> 4, lr = lane & 15;
    const int bh = b * 4 + h, pi = BR * 16 + bh;
    const float* gt = p.GT_() + (size_t)bh * 6208;
    if (BR == 0) {
#pragma unroll
        for (int i = 0; i < 4; ++i) { const int t = tid + 512 * i; wka[t] = expf(gt[2048 + t] - gt[4096 + (t | 127)]); }
        if (tid < 16) { const float mc = gt[6176 + tid]; dec[tid] = expf(mc - fmaxf(mc, gt[6160 + tid])); }
    } else {
        const float lg = ret_lg(h);
#pragma unroll
        for (int i = 0; i < 4; ++i) { const int t = tid + 512 * i; wka[t] = expf((float)(127 - (t & 127)) * lg); }
        if (tid < 16) dec[tid] = expf(128.0f * lg);
    }
    const size_t rowb = (size_t)b * SEQ;
    const bf16_t* Xp = BR == 0 ? p.QK_() + rowb * 2048 + h * 512 + 256 : p.P_() + rowb * NP + C_VR + h * 256;
    const int ldX = BR == 0 ? 2048 : NP;
    const bf16_t* Yp = (BR == 0 ? p.P_() + rowb * NP + C_VM + h * 256 : p.P_() + rowb * NP + C_KR + h * 256) + 32 * sl;
    const unsigned yoff = (unsigned)((tid >> 2) * NP + (tid & 3) * 8) * 2u;
    u32x4 xa[8], xb[8], ya, yb;
    tile_load<32>(xa, Xp, ldX, tid); ya = *(const u32x4*)((const char*)Yp + yoff);
    tile_load<32>(xb, Xp + (size_t)128 * ldX, ldX, tid); yb = *(const u32x4*)((const char*)(Yp + (size_t)128 * NP) + yoff);
    f32x4 st[2][2], nst[2];
#pragma unroll
    for (int i = 0; i < 2; ++i) { nst[i] = (f32x4){0.f, 0.f, 0.f, 0.f};
#pragma unroll
        for (int j = 0; j < 2; ++j) st[i][j] = (f32x4){0.f, 0.f, 0.f, 0.f}; }
    const unsigned lpart = (unsigned)(((8 * g + (lr >> 2)) * 272 + 4 * (lr & 3)) * 2), lparty = (unsigned)(((8 * g + (lr >> 2)) * 40 + 4 * (lr & 3)) * 2);
    const unsigned baseX = lds_addr(Xt) + lpart + (unsigned)(32 * w * 2), baseY = lds_addr(Ys) + lparty;
    bf16_t* CSp = p.CS_() + (size_t)pi * 16 * SZ + (size_t)(32 * sl + lr) * 256 + 32 * w + 4 * g;
    float* NSp = p.NS_() + (size_t)bh * 16 * 256 + 32 * w + 4 * g;
    const bool nown = (BR == 0) && (sl == 0) && (lr == 0);
    __syncthreads();
    auto step = [&](int c, u32x4 (&xr)[8], u32x4& yr) {
#pragma unroll
        for (int rt = 0; rt < 2; ++rt) {
#pragma unroll
            for (int ct = 0; ct < 2; ++ct) *(u32x2*)(CSp + (size_t)c * SZ + (size_t)(16 * ct) * 256 + 16 * rt) = (u32x2){pk2(st[rt][ct][0], st[rt][ct][1]), pk2(st[rt][ct][2], st[rt][ct][3])};
            if (nown) *(f32x4*)(NSp + (size_t)c * 256 + 16 * rt) = nst[rt];
        }
        tile_store<32, 544>(Xt, xr, tid);
        { float f[8]; unpack8(yr, f); const float ww = wka[c * 128 + (tid >> 2)];
#pragma unroll
          for (int j = 0; j < 8; ++j) f[j] *= ww;
          *(LAS u32x4*)(Ys + (tid >> 2) * 80 + (tid & 3) * 16) = pack8(f); }
        __syncthreads();
        if (c + 2 < 16) {
            tile_load<32>(xr, Xp + (size_t)(c + 2) * 128 * ldX, ldX, tid);
            yr = *(const u32x4*)((const char*)(Yp + (size_t)(c + 2) * 128 * NP) + yoff);
        }
        f32x4 u[2][2], un[2];
#pragma unroll
        for (int i = 0; i < 2; ++i) { un[i] = (f32x4){0.f, 0.f, 0.f, 0.f};
#pragma unroll
            for (int j = 0; j < 2; ++j) u[i][j] = (f32x4){0.f, 0.f, 0.f, 0.f}; }
        sfor<0, 4>([&](auto ks_) {
            constexpr int ks = decltype(ks_)::value;
            bf16x8 fa0, fa1, fb0, fb1;
            tr_frag2<ks * 32 * 544, 4 * 544, 32>(baseX, fa0, fa1);
            tr_frag2<ks * 32 * 80, 4 * 80, 32>(baseY, fb0, fb1);
            u[0][0] = __builtin_amdgcn_mfma_f32_16x16x32_bf16(fa0, fb0, u[0][0], 0, 0, 0); u[0][1] = __builtin_amdgcn_mfma_f32_16x16x32_bf16(fa0, fb1, u[0][1], 0, 0, 0);
            u[1][0] = __builtin_amdgcn_mfma_f32_16x16x32_bf16(fa1, fb0, u[1][0], 0, 0, 0); u[1][1] = __builtin_amdgcn_mfma_f32_16x16x32_bf16(fa1, fb1, u[1][1], 0, 0, 0);
            if (BR == 0) {
                const f32x4 w0 = *(LAS const f32x4*)(wka + c * 128 + 32 * ks + 8 * g), w1 = *(LAS const f32x4*)(wka + c * 128 + 32 * ks + 8 * g + 4);
                u32x4 wv = (u32x4){pk2(w0[0], w0[1]), pk2(w0[2], w0[3]), pk2(w1[0], w1[1]), pk2(w1[2], w1[3])};
                if (lr != 0) wv = (u32x4){0u, 0u, 0u, 0u};
                const bf16x8 wf = __builtin_bit_cast(bf16x8, wv);
                un[0] = __builtin_amdgcn_mfma_f32_16x16x32_bf16(fa0, wf, un[0], 0, 0, 0); un[1] = __builtin_amdgcn_mfma_f32_16x16x32_bf16(fa1, wf, un[1], 0, 0, 0);
            }
        });
        const float dc = dec[c];
#pragma unroll
        for (int i = 0; i < 2; ++i) { nst[i] = nst[i] * dc + un[i];
#pragma unroll
            for (int j = 0; j < 2; ++j) st[i][j] = st[i][j] * dc + u[i][j]; }
        __syncthreads();
    };
#pragma unroll 1
    for (int c = 0; c < 16; c += 2) { step(c, xa, ya); step(c + 1, xb, yb); }
    float* fo = p.out + (BR == 0 ? O_CP : O_SP) + (((size_t)layer * BP + b) * HM + h) * SZ + (size_t)(32 * sl + lr) * 256 + 32 * w + 4 * g;
#pragma unroll
    for (int rt = 0; rt < 2; ++rt) {
#pragma unroll
        for (int ct = 0; ct < 2; ++ct) *(f32x4*)(fo + (size_t)(16 * ct) * 256 + 16 * rt) = st[rt][ct];
        if (nown) *(f32x4*)(p.out + O_NP + (((size_t)layer * BP + b) * HM + h) * 256 + 32 * w + 4 * g + 16 * rt) = nst[rt];
    }
    if (BR == 0 && sl == 0 && tid == 0) p.out[O_MP + ((size_t)layer * BP + b) * HM + h] = gt[6192];
    __syncthreads();
}

__device__ __forceinline__ void scan_item(const Params& p, int layer, int pi, int slice, LAS unsigned char* lds) {
    LAS float* G = (LAS float*)lds; LAS float* dec = G + 512;
    const int tid = opaque_tid(), br = pi >> 4, bh = pi & 15, b = bh >> 2, h = bh & 3;
    if (br == 0) { const float* gt = p.GT_() + (size_t)bh * 6208; if (tid < 16) { const float mc = gt[6176 + tid]; dec[tid] = expf(mc - fmaxf(mc, gt[6160 + tid])); } if (tid == 0) G[48] = gt[6192]; }
    else if (tid < 16) dec[tid] = expf(128.0f * ret_lg(h));
    __syncthreads();
    float st[2][8];
#pragma unroll
    for (int j = 0; j < 2; ++j)
#pragma unroll
        for (int k = 0; k < 8; ++k) st[j][k] = 0.f;
    for (int c = 0; c < 16; ++c) {
        const float dc = dec[c];
#pragma unroll
        for (int j = 0; j < 2; ++j) { const size_t idx = (size_t)slice * 8192 + j * 4096 + tid * 8;
            float u[8]; unpack8(*(const u32x4*)(p.U_() + ((size_t)pi * 16 + c) * SZ + idx), u);
            *(u32x4*)(p.CS_() + ((size_t)pi * 16 + c) * SZ + idx) = pack8(st[j]);
#pragma unroll
            for (int k = 0; k < 8; ++k) st[j][k] = st[j][k] * dc + u[k]; }
    }
    float* fo = p.out + (br == 0 ? O_CP : O_SP) + (((size_t)layer * BP + b) * HM + h) * SZ;
#pragma unroll
    for (int j = 0; j < 2; ++j) { float* q = fo + (size_t)slice * 8192 + j * 4096 + tid * 8;
        *(f32x4*)q = (f32x4){st[j][0], st[j][1], st[j][2], st[j][3]}; *(f32x4*)(q + 4) = (f32x4){st[j][4], st[j][5], st[j][6], st[j][7]}; }
    if (br == 0 && slice == 0) {
        if (tid < 256) { float n = 0.f;
            for (int c = 0; c < 16; ++c) { p.NS_()[((size_t)bh * 16 + c) * 256 + tid] = n; n = dec[c] * n + p.NU_()[((size_t)bh * 16 + c) * 256 + tid]; }
            p.out[O_NP + (((size_t)layer * BP + b) * HM + h) * 256 + tid] = n; }
        if (tid == 0) p.out[O_MP + ((size_t)layer * BP + b) * HM + h] = G[48];
    }
    __syncthreads();
}

template <int BR>
__device__ __forceinline__ void chunk_passC(const Params& p, int layer, int b, int h, int c, LAS unsigned char* lds) {
    LAS unsigned char* BufB = lds; LAS unsigned char* Sw = lds + 69632; LAS float* G = (LAS float*)(lds + 104448);
    LAS float* av = G + 512; LAS float* fl = G + 640; LAS bf16_t* nbf = (LAS bf16_t*)(G + 768);
    const int tid = opaque_tid(), lane = tid & 63, w = __builtin_amdgcn_readfirstlane(tid >> 6), g = lane >> 4, lr = lane & 15;
    const size_t row0 = (size_t)b * SEQ + c * 128;
    const int pi = BR * 16 + b * 4 + h, l = 16 * w + lr;
    const float lg = ret_lg(h);
    u32x4 tr[8];
    tile_load<32>(tr, BR == 0 ? p.QK_() + row0 * 2048 + h * 512 + 256 : p.P_() + row0 * NP + C_KR + h * 256, BR == 0 ? 2048 : NP, tid);
    if (BR == 0) {
        gate_load(p, b * 4 + h, c, G, tid);
        if (tid < 128) { av[tid] = expf(G[32 + c] - G[320 + tid]); fl[tid] = expf(-(G[64 + tid] + G[320 + tid])); }
        if (tid < 256) nbf[tid] = f2bf(p.NS_()[((size_t)(b * 4 + h) * 16 + c) * 256 + tid]);
    } else { if (tid < 128) av[tid] = expf((float)(tid + 1) * lg); }
    const bf16_t* Qp = BR == 0 ? p.QK_() + (row0 + l) * 2048 + h * 512 : p.P_() + (row0 + l) * NP + C_QR + h * 256;
    bf16x8 qf[8];
#pragma unroll
    for (int ks = 0; ks < 8; ++ks) qf[ks] = *(const bf16x8*)(Qp + 32 * ks + 8 * g);
    tile_store<32, 544>(BufB, tr, tid);
    __syncthreads();
    const bf16_t* CSp = p.CS_() + ((size_t)pi * 16 + c) * SZ;
    if (BR == 0) tile_load<32>(tr, CSp, 256, tid); else tile_load<16>(tr, CSp, 256, tid);
    float rs = 0.f;
    const float Gl = BR == 0 ? G[320 + l] : 0.f;
#pragma unroll
    for (int j = 0; j < 8; ++j) {
        f32x4 a = (f32x4){0.f, 0.f, 0.f, 0.f};
        if (j <= w) {
#pragma unroll
            for (int ks = 0; ks < 8; ++ks) a = __builtin_amdgcn_mfma_f32_16x16x32_bf16(lds_frag(BufB, 16 * j + lr, 544, (32 * ks + 8 * g) * 2), qf[ks], a, 0, 0, 0);
        }
        float v[4];
#pragma unroll
        for (int r = 0; r < 4; ++r) {
            const int sidx = 16 * j + 4 * g + r;
            float d = 0.f;
            if (sidx <= l) d = BR == 0 ? expf(G[192 + sidx] - Gl) : expf((float)(l - sidx) * lg);
            v[r] = a[r] * d; rs += v[r];
        }
        *(LAS u32x2*)(Sw + l * 272 + (16 * j + 4 * g) * 2) = (u32x2){pk2(v[0], v[1]), pk2(v[2], v[3])};
        __builtin_amdgcn_sched_barrier(0);
    }
    rs += __shfl_xor(rs, 16); rs += __shfl_xor(rs, 32);
    __syncthreads();
    f32x4 accN[16];
#pragma unroll
    for (int t = 0; t < 16; ++t) accN[t] = (f32x4){0.f, 0.f, 0.f, 0.f};
    const unsigned lq = (unsigned)(8 * g + (lr >> 2)), lp4 = (unsigned)(4 * (lr & 3));
    sfor<0, 2>([&](auto half_) {
        constexpr int half = decltype(half_)::value;
        if (BR == 0) tile_store<32, 544>(BufB, tr, tid); else tile_store<16, 272>(BufB, tr, tid);
        __syncthreads();
        if (half == 0) { if (BR == 0) tile_load<32>(tr, CSp + 128 * 256, 256, tid); else tile_load<16>(tr, CSp + 128, 256, tid); }
        else tile_load<32>(tr, p.P_() + row0 * NP + (BR == 0 ? C_VM : C_VR) + h * 256, NP, tid);
        if (BR == 0) {
#pragma unroll
            for (int t = 0; t < 8; ++t) {
#pragma unroll
                for (int ks = 0; ks < 8; ++ks)
                    accN[half * 8 + t] = __builtin_amdgcn_mfma_f32_16x16x32_bf16(lds_frag(BufB, 16 * t + lr, 544, (32 * ks + 8 * g) * 2), qf[ks], accN[half * 8 + t], 0, 0, 0);
                __builtin_amdgcn_sched_barrier(0); }
        } else {
            const unsigned base = lds_addr(BufB) + (lq * 136 + lp4) * 2;
            sfor<0, 8>([&](auto ks_) {
                constexpr int ks = decltype(ks_)::value;
                sfor<0, 2>([&](auto tq_) {
                    constexpr int tq = decltype(tq_)::value;
                    bf16x8 f[4];
                    tr_frag4<ks * 32 * 272 + tq * 128, 4 * 272, 32>(base, f);
#pragma unroll
                    for (int i = 0; i < 4; ++i) accN[half * 8 + 4 * tq + i] = __builtin_amdgcn_mfma_f32_16x16x32_bf16(f[i], qf[ks], accN[half * 8 + 4 * tq + i], 0, 0, 0);
                });
            });
        }
        __syncthreads();
    });
    float nq = 0.f;
    if (BR == 0) {
        f32x4 ad = (f32x4){0.f, 0.f, 0.f, 0.f};
#pragma unroll
        for (int ks = 0; ks < 8; ++ks) {
            bf16x8 nf = *(LAS const bf16x8*)(nbf + 32 * ks + 8 * g);
            if (lr != 0) nf = (bf16x8){0, 0, 0, 0, 0, 0, 0, 0};
            ad = __builtin_amdgcn_mfma_f32_16x16x32_bf16(nf, qf[ks], ad, 0, 0, 0);
        }
        nq = __shfl(ad[0], lr);
    }
    const float al = av[l];
#pragma unroll
    for (int t = 0; t < 16; ++t) accN[t] *= al;
    tile_store<32, 544>(BufB, tr, tid);
    __syncthreads();
    {
        const unsigned base = lds_addr(BufB) + (lq * 272 + lp4) * 2;
        sfor<0, 4>([&](auto ks_) {
            constexpr int ks = decltype(ks_)::value;
            const bf16x8 bfr = lds_frag(Sw, l, 272, (32 * ks + 8 * g) * 2);
            sfor<0, 4>([&](auto tq_) {
                constexpr int tq = decltype(tq_)::value;
                bf16x8 f[4];
                tr_frag4<ks * 32 * 544 + tq * 128, 4 * 544, 32>(base, f);
#pragma unroll
                for (int i = 0; i < 4; ++i) accN[4 * tq + i] = __builtin_amdgcn_mfma_f32_16x16x32_bf16(f[i], bfr, accN[4 * tq + i], 0, 0, 0);
            });
        });
    }
    float inv = 1.0f;
    if (BR == 0) inv = 1.0f / fmaxf(fabsf(rs + al * nq), fl[l]);
    float sm = 0.f;
#pragma unroll
    for (int t = 0; t < 16; ++t) { accN[t] *= inv; sm += (accN[t][0] + accN[t][1]) + (accN[t][2] + accN[t][3]); }
    sm += __shfl_xor(sm, 16); sm += __shfl_xor(sm, 32);
    const float mu = sm * (1.0f / 256.0f);
    float qv = 0.f;
#pragma unroll
    for (int t = 0; t < 16; ++t) { const f32x4 d = accN[t] - mu; qv += (d[0] * d[0] + d[1] * d[1]) + (d[2] * d[2] + d[3] * d[3]); }
    qv += __shfl_xor(qv, 16); qv += __shfl_xor(qv, 32);
    const float rstd = rsqrtf(qv * (1.0f / 256.0f) + EPS);
    const float* gain = (BR == 0 ? p.hn_m_g : p.hn_r_g) + (size_t)layer * WM + h * 256 + 4 * g;
    const float* skip = p.skip_m + (size_t)layer * WM + h * 256 + 4 * g;
    const size_t row = row0 + l;
    const bf16_t* zp = p.P_() + row * NP + (BR == 0 ? C_ZM : C_ZR) + h * 256 + 4 * g;
    const bf16_t* cp = p.CM_() + row * WM + h * 256 + 4 * g;
    bf16_t* op = p.OC_() + row * 2048 + BR * 1024 + h * 256 + 4 * g;
#pragma unroll
    for (int t = 0; t < 16; ++t) {
        const f32x4 ge = *(const f32x4*)(gain + 16 * t);
        const u32x2 zb = *(const u32x2*)(zp + 16 * t);
        f32x4 v = (accN[t] - mu) * rstd * ge;
        if (BR == 0) { const f32x4 sk = *(const f32x4*)(skip + 16 * t); const u32x2 cb = *(const u32x2*)(cp + 16 * t);
            v[0] += sk[0] * __uint_as_float(cb.x << 16); v[1] += sk[1] * __uint_as_float(cb.x & 0xffff0000u);
            v[2] += sk[2] * __uint_as_float(cb.y << 16); v[3] += sk[3] * __uint_as_float(cb.y & 0xffff0000u); }
        const float z0 = __uint_as_float(zb.x << 16), z1 = __uint_as_float(zb.x & 0xffff0000u), z2 = __uint_as_float(zb.y << 16), z3 = __uint_as_float(zb.y & 0xffff0000u);
        *(u32x2*)(op + 16 * t) = (u32x2){pk2(v[0] * siluf_(z0), v[1] * siluf_(z1)), pk2(v[2] * siluf_(z2), v[3] * siluf_(z3))};
    }
    __syncthreads();
}

template <int BR>
__device__ __forceinline__ void sample_item(const Params& p, int layer, int b, int h, LAS unsigned char* lds) {
    LAS float* sq = (LAS float*)lds; LAS float* sk = sq + 256; LAS float* sv = sk + 256; LAS float* sn = sv + 256; LAS float* sr = sn + 256; LAS float* red = sr + 256;
    LAS float* part = red + 64;
    const int tid = opaque_tid(), lane = tid & 63, wid = tid >> 6;
    const size_t R = (size_t)MP + b;
    const size_t sidx = ((size_t)layer * BS + b) * HM + h;
    if (tid < 256) {
        if (BR == 0) { sq[tid] = bf2f(p.QK_()[R * 2048 + h * 512 + tid]); sk[tid] = bf2f(p.QK_()[R * 2048 + h * 512 + 256 + tid]); sv[tid] = bf2f(p.P_()[R * NP + C_VM + h * 256 + tid]); sn[tid] = p.st_n[sidx * 256 + tid]; }
        else { sq[tid] = bf2f(p.P_()[R * NP + C_QR + h * 256 + tid]); sk[tid] = bf2f(p.P_()[R * NP + C_KR + h * 256 + tid]); sv[tid] = bf2f(p.P_()[R * NP + C_VR + h * 256 + tid]); sn[tid] = 0.f; }
    }
    __syncthreads();
    float pq = 0.f, pn = 0.f;
    if (tid < 256) { pq = sq[tid] * sk[tid]; pn = sn[tid] * sq[tid]; }
    block_sum2(pq, pn, red);
    const float qk = pq, nq = pn;
    float wgt = 1.f, a = 1.f, mt = 0.f;
    if (BR == 0) {
        const float ig = p.IF_()[R * 8 + h] + p.b_i[layer * HM + h];
        const float lf = logsigf_(p.IF_()[R * 8 + 4 + h] + p.b_f[layer * HM + h]);
        const float inter = lf + p.st_m[sidx];
        mt = fmaxf(inter, ig); wgt = expf(ig - mt); a = expf(inter - mt);
    } else { a = 1.0f - exp2f(-5.0f - (float)h); }
    const float* S0 = (BR == 0 ? p.st_C : p.st_S) + sidx * SZ;
    float* S1 = p.out + (BR == 0 ? O_CS : O_SS) + sidx * SZ;
    const f32x4* S0v = (const f32x4*)S0 + lane; f32x4* S1v = (f32x4*)S1 + lane;
    f32x4 cc[8], cn[8];
#pragma unroll
    for (int j = 0; j < 8; ++j) cc[j] = __builtin_nontemporal_load(S0v + 64 * (wid + 8 * j));
    if (BR == 0) {
        const f32x4 q4 = *(LAS const f32x4*)(sq + 4 * lane), k4 = *(LAS const f32x4*)(sk + 4 * lane);
#pragma unroll
        for (int i0 = 0; i0 < 32; i0 += 8) {
            if (i0 + 8 < 32) {
#pragma unroll
                for (int j = 0; j < 8; ++j) cn[j] = __builtin_nontemporal_load(S0v + 64 * (wid + 8 * (i0 + 8 + j)));
            }
#pragma unroll
            for (int j = 0; j < 8; ++j) { const int e = wid + 8 * (i0 + j);
                float pt = (cc[j][0] * q4[0] + cc[j][1] * q4[1]) + (cc[j][2] * q4[2] + cc[j][3] * q4[3]);
                const float wv = wgt * sv[e];
                __builtin_nontemporal_store(cc[j] * a + k4 * wv, S1v + 64 * e);
                pt = wave_sum(pt);
                if (lane == 0) sr[e] = pt; }
#pragma unroll
            for (int j = 0; j < 8; ++j) cc[j] = cn[j];
        }
    } else {
        const f32x4 v4 = *(LAS const f32x4*)(sv + 4 * lane);
        f32x4 ac = (f32x4){0.f, 0.f, 0.f, 0.f};
#pragma unroll
        for (int i0 = 0; i0 < 32; i0 += 8) {
            if (i0 + 8 < 32) {
#pragma unroll
                for (int j = 0; j < 8; ++j) cn[j] = __builtin_nontemporal_load(S0v + 64 * (wid + 8 * (i0 + 8 + j)));
            }
#pragma unroll
            for (int j = 0; j < 8; ++j) { const int d = wid + 8 * (i0 + j);
                ac = ac + cc[j] * sq[d];
                __builtin_nontemporal_store(cc[j] * a + v4 * sk[d], S1v + 64 * d); }
#pragma unroll
            for (int j = 0; j < 8; ++j) cc[j] = cn[j];
        }
        *(LAS f32x4*)(part + wid * 256 + 4 * lane) = ac;
    }
    __syncthreads();
    float hv = 0.f;
    if (tid < 256) {
        if (BR == 0) {
            const float ws = wgt * qk;
            const float den = fmaxf(fabsf(ws + a * nq), expf(-mt));
            hv = (ws * sv[tid] + a * sr[tid]) / den;
            p.out[O_NS + sidx * 256 + tid] = a * sn[tid] + wgt * sk[tid];
            if (tid == 0) p.out[O_MS + sidx] = mt;
        } else {
            float s = 0.f;
#pragma unroll
            for (int i = 0; i < 8; ++i) s += part[i * 256 + tid];
            hv = qk * sv[tid] + a * s;
        }
    }
    float s1 = hv, s2 = 0.f;
    block_sum2(s1, s2, red);
    const float mean = s1 * (1.0f / 256.0f);
    float dv = tid < 256 ? hv - mean : 0.f;
    float q1 = dv * dv, q2 = 0.f;
    block_sum2(q1, q2, red);
    const float rstd = rsqrtf(q1 * (1.0f / 256.0f) + EPS);
    if (tid < 256) {
        const float ge = (BR == 0 ? p.hn_m_g : p.hn_r_g)[(size_t)layer * WM + h * 256 + tid];
        float v = dv * rstd * ge;
        const float z = bf2f(p.P_()[R * NP + (BR == 0 ? C_ZM : C_ZR) + h * 256 + tid]);
        if (BR == 0) v += p.skip_m[(size_t)layer * WM + h * 256 + tid] * bf2f(p.CM_()[R * WM + h * 256 + tid]);
        p.OC_()[R * 2048 + BR * 1024 + h * 256 + tid] = f2bf(v * siluf_(z));
    }
    __syncthreads();
}

template <int MODE>
__device__ __forceinline__ void sample_gemm(const Params& p, const bf16_t* Wl, int wg, int nwg, LAS unsigned char* lds, unsigned long long* ssn) {
    const int tid = opaque_tid(), lane = tid & 63, w = tid >> 6, g = lane >> 4, lr = lane & 15, hf = w >> 2;
    LAS f32x4* xch = (LAS f32x4*)lds;
    LAS float* red = (LAS float*)(lds + 4096);
    for (int j = wg; j < 256; j += nwg) {
        const int rbase = MP + 32 * (j & 3) + 16 * ((w >> 1) & 1), cbase = 32 * (j >> 2) + 16 * (w & 1);
        const bf16_t* A = (MODE == 0 ? p.OC_() : p.MG_()) + (size_t)(rbase + lr) * 2048 + hf * 1024 + 8 * g;
        const bf16_t* B = Wl + (MODE == 0 ? W3_OFF : W4_OFF) + (size_t)(cbase + lr) * 2048 + hf * 1024 + 8 * g;
        f32x4 acc = (f32x4){0.f, 0.f, 0.f, 0.f};
#pragma unroll 1
        for (int k0 = 0; k0 < 1024; k0 += 512) {
            bf16x8 af[16], bf[16];
#pragma unroll
            for (int i = 0; i < 16; ++i) { af[i] = *(const bf16x8*)(A + k0 + 32 * i); bf[i] = *(const bf16x8*)(B + k0 + 32 * i); }
#pragma unroll
            for (int i = 0; i < 16; ++i) acc = __builtin_amdgcn_mfma_f32_16x16x32_bf16(af[i], bf[i], acc, 0, 0, 0);
        }
        if (hf == 1) xch[(w & 3) * 64 + lane] = acc;
        __syncthreads();
        if (hf == 0) {
            const f32x4 hi = xch[(w & 3) * 64 + lane];
            const int col = cbase + lr;
#pragma unroll
            for (int r = 0; r < 4; ++r) {
                const size_t row = (size_t)rbase + 4 * g + r;
                if (MODE == 0) {
                    const float rt = bf2f(p.RT_()[row * 2048 + col]), gr = bf2f(p.GRS_()[row * 2048 + col]);
                    p.MG_()[row * 2048 + col] = f2bf(gr * (rt * acc[r] + hi[r]));
                } else {
                    const bf16_t nb = f2bf(bf2f(p.Xb_()[row * 2048 + col]) + acc[r] + hi[r]);
                    p.Xb_()[row * 2048 + col] = nb;
                    float q = bf2f(nb) * bf2f(nb);
                    q += __shfl_xor(q, 1); q += __shfl_xor(q, 2); q += __shfl_xor(q, 4); q += __shfl_xor(q, 8);
                    if (lr == 0) red[(w & 1) * 32 + 16 * ((w >> 1) & 1) + 4 * g + r] = q;
                }
            }
        }
        if (MODE == 1) {
            __syncthreads();
            if (tid < 32) atomicAdd(ssn + MP + 32 * (j & 3) + tid, ss_fix(red[tid] + red[32 + tid]));
        }
        __syncthreads();
    }
}

__device__ __forceinline__ void sample_gemm2(const Params& p, const bf16_t* W2t, int wg, int nwg) {
    const int tid = opaque_tid(), lane = tid & 63, w = tid >> 6, g = lane >> 4, lr = lane & 15;
    for (int j = wg; j < 128; j += nwg) {
        const int rbase = MP + 16 * (j & 7), cbase = 128 * (j >> 3) + 16 * w, head = cbase >> 9;
        const bf16_t* A = p.CM_() + (size_t)(rbase + lr) * WM + head * 256 + 8 * g;
        const bf16_t* B = W2t + (size_t)(cbase + lr) * 256 + 8 * g;
        bf16x8 af[8], bf[8];
#pragma unroll
        for (int i = 0; i < 8; ++i) { af[i] = *(const bf16x8*)(A + 32 * i); bf[i] = *(const bf16x8*)(B + 32 * i); }
        f32x4 acc = (f32x4){0.f, 0.f, 0.f, 0.f};
#pragma unroll
        for (int i = 0; i < 8; ++i) acc = __builtin_amdgcn_mfma_f32_16x16x32_bf16(af[i], bf[i], acc, 0, 0, 0);
#pragma unroll
        for (int r = 0; r < 4; ++r) p.QK_()[(size_t)(rbase + 4 * g + r) * 2048 + cbase + lr] = f2bf(acc[r]);
    }
}

__device__ __forceinline__ void phaseA(const Params& p, int layer, int wg, int nwg, LAS unsigned char* lds) {
    for (int it = wg; it < 256; it += nwg) {
        const int pi = (it & 7) * 4 + (it >> 6), sl = (it >> 3) & 7, bh = pi & 15;
        if (pi < 16) chunk_state_item<0>(p, layer, bh >> 2, bh & 3, sl, lds); else chunk_state_item<1>(p, layer, bh >> 2, bh & 3, sl, lds);
    }
    for (int s = wg; s < 1024; s += nwg) {
        const int br = s >> 9, b = (s >> 2) & 127, h = s & 3;
        if (br == 0) sample_item<0>(p, layer, b, h, lds); else sample_item<1>(p, layer, b, h, lds);
    }
}
__device__ __forceinline__ void phaseScan(const Params& p, int layer, int wg, int nwg, LAS unsigned char* lds) {
    for (int it = wg; it < 256; it += nwg) scan_item(p, layer, it >> 3, it & 7, lds);
}
__device__ __forceinline__ void phaseC(const Params& p, int layer, int wg, int nwg, LAS unsigned char* lds) {
    for (int it = wg; it < 512; it += nwg) {
        const int br = it >> 8, rest = it & 255, b = rest >> 6, h = (rest >> 4) & 3, c = rest & 15;
        if (br == 0) chunk_passC<0>(p, layer, b, h, c, lds); else chunk_passC<1>(p, layer, b, h, c, lds);
    }
}

template <int ONLY>
__device__ __forceinline__ void run_phases(const Params& p_in, int ph_lo, int ph_hi) {
    extern __shared__ __attribute__((aligned(16))) unsigned char smem_raw[];
    LAS unsigned char* lds = (LAS unsigned char*)smem_raw;
    volatile LAS unsigned* xbw = (volatile LAS unsigned*)(lds + LDS_BYTES - 16);
    const int wg_in = blockIdx.x, nwg = gridDim.x;
    const bool multi = (ph_hi - ph_lo) > 1;
    XcdBarrier bar; bar.bar = p_in.bar_(); bar.x = 0; bar.st = xbw;
    if (multi) {
        if (threadIdx.x == 0) { xbw[0] = 0u; xbw[1] = 0u; xbw[2] = 0u; xbw[3] = 0u; }
        __syncthreads();
        bar = xcd_barrier_post(p_in.bar_(), xbw);
    }
    int ph = 0; unsigned long long tacc_ = 0;
#define PHASE(KIND, ...) { if constexpr (ONLY < 0 || ONLY == KIND) { if (ph >= ph_lo && ph < ph_hi) { \
    unsigned long long t0_ = 0; if (KIND == TIMEK) t0_ = __builtin_amdgcn_s_memrealtime(); \
    Params p = p_in; int wg = wg_in; { size_t z_ = 0; asm volatile("" : "+s"(z_), "+s"(wg)); p.ws = p_in.ws + z_; p.out = p_in.out + z_; }     \
    __VA_ARGS__; if (ph + 1 < ph_hi) xcd_barrier(bar); \
    if (KIND == TIMEK) tacc_ += __builtin_amdgcn_s_memrealtime() - t0_; } } ++ph; }
    PHASE(0, prep_phase(p, wg, nwg, lds))
    for (int layer = 0; layer < DEPTH; ++layer) {
        PHASE(2, { pg8::StaticOrder S; S.init(MPAD, N1, nwg, wg); pg8::Gemm g{p.Xb_(), p.W_() + (size_t)layer * WL + W1_OFF, D, D, D, 31, 0, 0};
                pg8::EpiG1 E{p.P_(), p.b_gate + (size_t)layer * 4096, p.RT_(), p.GRS_(), p.ROPE_(), p.SS_() + (size_t)layer * MPAD, p.SSP_(), p.IF_()}; pg8::gemm_phase<false>(lds, g, S, E); })
        PHASE(3, conv_phase(p, layer, wg, nwg, lds))
        PHASE(4, { pg8::StaticOrder S; S.init(MP, 2048, nwg, wg); pg8::Gemm g{p.CM_(), p.W_() + (size_t)layer * WL + W2_OFF, 256, WM, 256, 1, 512, 0};
                pg8::EpiBf16 E{p.QK_(), 2048}; pg8::gemm_phase<false>(lds, g, S, E); sample_gemm2(p, p.W_() + (size_t)layer * WL + W2_OFF, wg, nwg); })
        PHASE(5, phaseA(p, layer, wg, nwg, lds))
        PHASE(7, phaseC(p, layer, wg, nwg, lds))
        PHASE(8, { pg8::StaticOrder S; S.init(MP, 2048, nwg, wg); pg8::Gemm g{p.OC_(), p.W_() + (size_t)layer * WL + W3_OFF, 2048, 2048, 2048, 31, 0, 16};
                pg8::EpiMerged E{p.MG_(), p.RT_(), p.GRS_()}; pg8::gemm_phase<true>(lds, g, S, E); sample_gemm<0>(p, p.W_() + (size_t)layer * WL, wg, nwg, lds, nullptr); })
        PHASE(10, { pg8::StaticOrder S; S.init(MP, 2048, nwg, wg); pg8::Gemm g{p.MG_(), p.W_() + (size_t)layer * WL + W4_OFF, 2048, 2048, 2048, 31, 0, 0};
                pg8::EpiResidual E{p.Xb_(), p.SSP_(), (LAS float*)(lds + pg8::STAGE_BYTES)}; pg8::gemm_phase<false>(lds, g, S, E); sample_gemm<1>(p, p.W_() + (size_t)layer * WL, wg, nwg, lds, p.SS_() + (size_t)(layer + 1) * MPAD); })
    }
    PHASE(11, final_phase(p, wg, nwg))
    if (TIMEK >= 0 && blockIdx.x == 0) { const unsigned long long te_ = __builtin_amdgcn_s_memrealtime(); while (__builtin_amdgcn_s_memrealtime() - te_ < TIMEX * tacc_) __builtin_amdgcn_s_sleep(8); }
#undef PHASE
}
__global__ void __launch_bounds__(512, 2) mega(Params p, int ph_lo, int ph_hi) { run_phases<-1>(p, ph_lo, ph_hi); }
#ifdef DIAG
template <int K> __global__ void __launch_bounds__(512, 2) mega_k(Params p, int ph_lo, int ph_hi) { run_phases<K>(p, ph_lo, ph_hi); }
template __global__ void mega_k<0>(Params, int, int); template __global__ void mega_k<2>(Params, int, int);
template __global__ void mega_k<3>(Params, int, int); template __global__ void mega_k<4>(Params, int, int); template __global__ void mega_k<5>(Params, int, int);
template __global__ void mega_k<7>(Params, int, int); template __global__ void mega_k<8>(Params, int, int);
template __global__ void mega_k<10>(Params, int, int); template __global__ void mega_k<11>(Params, int, int);
#endif
constexpr int N_PHASES = 2 + DEPTH * 7;

extern "C" void kernel_launch(void* const* d_in, const int* in_sizes, int n_in, void* d_out, int out_size, void* d_ws, size_t ws_size, hipStream_t stream) {
    (void)in_sizes; (void)n_in; (void)out_size; (void)ws_size;
    static int grid = 0;
    if (grid == 0) {
        int dev = 0, cus = 0;
        hipGetDevice(&dev);
        hipDeviceGetAttribute(&cus, hipDeviceAttributeMultiprocessorCount, dev);
        if (hipFuncSetAttribute((const void*)mega, hipFuncAttributeMaxDynamicSharedMemorySize, LDS_BYTES) != hipSuccess) fprintf(stderr, "hipFuncSetAttribute failed\n");
        (void)hipGetLastError();
        grid = cus > 0 ? cus : 256;
    }
    Params p{};
    const float** in = (const float**)&p;
    for (int i = 0; i < 24; ++i) in[i] = (const float*)d_in[i];
    p.out = (float*)d_out;
    p.ws = (unsigned char*)d_ws;
    if (ws_size < WS_END) { fprintf(stderr, "workspace too small: %zu < %zu\n", ws_size, (size_t)WS_END); return; }
    hipMemsetAsync(d_ws, 0, 16384, stream);
#if MK_SINGLE
    hipLaunchKernelGGL(mega, dim3(grid), dim3(512), LDS_BYTES, stream, p, 0, N_PHASES);
#else
    for (int ph = 0; ph < N_PHASES; ++ph) hipLaunchKernelGGL(mega, dim3(grid), dim3(512), LDS_BYTES, stream, p, ph, ph + 1);
#endif
}
```

```cpp
#include <hip/hip_runtime.h>
#include <stdint.h>
#include <stdio.h>

#ifndef TIMEK
#define TIMEK -1
#define TIMEX 10
#endif
#ifndef MK_SINGLE
#define MK_SINGLE 1
#endif

#define LAS __attribute__((address_space(3)))
typedef unsigned short bf16_t;
typedef short bf16x8 __attribute__((ext_vector_type(8)));
typedef float f32x4 __attribute__((ext_vector_type(4)));
typedef unsigned u32x4 __attribute__((ext_vector_type(4)));
typedef unsigned u32x2 __attribute__((ext_vector_type(2)));
typedef float f32x2_t __attribute__((ext_vector_type(2)));

constexpr int D = 2048, SEQ = 2048, BP = 4, BS = 128, DEPTH = 4, HM = 4, DH = 256, WM = 1024, NIN = 7176;
constexpr int MP = BP * SEQ, MT = MP + BS, MPAD = 8448;
constexpr int NP = 7168;
constexpr int N1 = 11520;
constexpr int C_U = 0, C_VM = 1024, C_ZM = 2048, C_QR = 3072, C_KR = 4096, C_VR = 5120, C_ZR = 6144, C_GM = 7168, C_GR = 9216;
constexpr float EPS = 1e-6f;
constexpr size_t SZ = 65536;
constexpr size_t O_YP = 0, O_YS = O_YP + 16777216, O_CP = O_YS + 262144, O_NP = O_CP + 4194304, O_MP = O_NP + 16384, O_CVP = O_MP + 64,
                 O_SP = O_CVP + 49152, O_CS = O_SP + 4194304, O_NS = O_CS + 134217728, O_MS = O_NS + 524288, O_CVS = O_MS + 2048, O_SS = O_CVS + 1572864;
constexpr size_t W1_OFF = 0, W2_OFF = W1_OFF + (size_t)N1 * D, W3_OFF = W2_OFF + (size_t)2048 * 256, W4_OFF = W3_OFF + (size_t)D * D, WL = W4_OFF + (size_t)D * D;
constexpr int LDS_BYTES = 147456;

constexpr size_t al256(size_t x) { return (x + 255) & ~(size_t)255; }
constexpr size_t OFF_BAR = 0, OFF_SS = OFF_BAR + 16384, OFF_SSP = OFF_SS + al256((size_t)5 * MPAD * 8), OFF_XB = OFF_SSP + al256((size_t)8 * MP * 4),
    OFF_P = OFF_XB + al256((size_t)MPAD * D * 2), OFF_IF = OFF_P + al256((size_t)MPAD * NP * 2), OFF_CM = OFF_IF + al256((size_t)MPAD * 8 * 4),
    OFF_QK = OFF_CM + al256((size_t)MPAD * WM * 2), OFF_OC = OFF_QK + al256((size_t)MPAD * 2048 * 2), OFF_MG = OFF_OC + al256((size_t)MPAD * 2048 * 2),
    OFF_U = OFF_MG + al256((size_t)MPAD * 2048 * 2), OFF_CS = OFF_U + al256((size_t)32 * 16 * SZ * 2), OFF_NU = OFF_CS + al256((size_t)32 * 16 * SZ * 2),
    OFF_NS = OFF_NU + al256((size_t)16 * 16 * 256 * 4), OFF_W = OFF_NS + al256((size_t)16 * 16 * 256 * 4), OFF_ROPE = OFF_W + al256((size_t)DEPTH * WL * 2),
    OFF_RT = OFF_ROPE + al256((size_t)2049 * 128 * 2 * 4), OFF_GRS = OFF_RT + al256((size_t)MPAD * 2048 * 2), OFF_GT = OFF_GRS + al256((size_t)MPAD * 2048 * 2),
    WS_END = OFF_GT + al256((size_t)16 * 6208 * 4);

struct Params {
    const float *x_prompt, *x_sample, *st_C, *st_n, *st_m, *st_conv, *st_S, *norm_g, *w_in, *conv_w, *conv_b, *w_qm, *w_km, *b_i, *b_f,
                *hn_m_g, *skip_m, *hn_r_g, *w_pm, *w_pr, *w_gate, *b_gate, *w_o, *final_g;
    float* out;
    unsigned char* ws;
#define WSF(name, type, off) __device__ __forceinline__ type* name##_() const { return (type*)(ws + (off)); }
    WSF(bar, unsigned, OFF_BAR) WSF(SS, unsigned long long, OFF_SS) WSF(SSP, float, OFF_SSP) WSF(Xb, bf16_t, OFF_XB) WSF(P, bf16_t, OFF_P) WSF(IF, float, OFF_IF)
    WSF(CM, bf16_t, OFF_CM) WSF(QK, bf16_t, OFF_QK) WSF(OC, bf16_t, OFF_OC) WSF(MG, bf16_t, OFF_MG) WSF(U, bf16_t, OFF_U) WSF(CS, bf16_t, OFF_CS)
    WSF(NU, float, OFF_NU) WSF(NS, float, OFF_NS) WSF(W, bf16_t, OFF_W) WSF(ROPE, float, OFF_ROPE) WSF(RT, bf16_t, OFF_RT) WSF(GRS, bf16_t, OFF_GRS) WSF(GT, float, OFF_GT)
#undef WSF
};


__device__ __forceinline__ unsigned long long ss_fix(float v) { return (unsigned long long)(v * 1048576.0f + 0.5f); }
__device__ __forceinline__ float ss_val(unsigned long long v) { return (float)v * (1.0f / 1048576.0f); }
__device__ __forceinline__ float row_ss(const float* ssp, const unsigned long long* ss, int row) {
    if (row < 8192) { const f32x4 a = *(const f32x4*)(ssp + (size_t)row * 8), b = *(const f32x4*)(ssp + (size_t)row * 8 + 4);
        return ((a[0] + a[1]) + (a[2] + a[3])) + ((b[0] + b[1]) + (b[2] + b[3])); }
    return ss_val(ss[row]);
}
__device__ __forceinline__ int opaque_tid() { int t = threadIdx.x; asm volatile("" : "+v"(t)); return t; }
__device__ __forceinline__ float bf2f(bf16_t v) { return __uint_as_float((unsigned)v << 16); }
__device__ __forceinline__ bf16_t f2bf(float f) { unsigned u = __float_as_uint(f); u += 0x7fffu + ((u >> 16) & 1u); return (bf16_t)(u >> 16); }
__device__ __forceinline__ unsigned pk2(float lo, float hi) { return (unsigned)f2bf(lo) | ((unsigned)f2bf(hi) << 16); }
__device__ __forceinline__ float wave_sum(float v) {
#pragma unroll
    for (int o = 32; o >= 1; o >>= 1) v += __shfl_xor(v, o);
    return v;
}
__device__ __forceinline__ float wave_max(float v) {
#pragma unroll
    for (int o = 32; o >= 1; o >>= 1) v = fmaxf(v, __shfl_xor(v, o));
    return v;
}
__device__ __forceinline__ float sigmoidf_(float x) { return __builtin_amdgcn_rcpf(1.0f + __expf(-x)); }
__device__ __forceinline__ float siluf_(float x) { return x * __builtin_amdgcn_rcpf(1.0f + __expf(-x)); }
__device__ __forceinline__ float logsigf_(float x) { return x < 0.f ? x - log1pf(expf(x)) : -log1pf(expf(-x)); }
__device__ __forceinline__ void block_sum2(float& a, float& b, LAS float* red) {
    a = wave_sum(a); b = wave_sum(b);
    __syncthreads();
    if ((threadIdx.x & 63) == 0) { red[threadIdx.x >> 6] = a; red[8 + (threadIdx.x >> 6)] = b; }
    __syncthreads();
    float sa = 0.f, sb = 0.f;
#pragma unroll
    for (int i = 0; i < 8; ++i) { sa += red[i]; sb += red[8 + i]; }
    a = sa; b = sb;
}

#define XB_TMO      128
#define XB_XCNT(j)  (256  + 64 * (j))
#define XB_XSUB(j)  (1280 + 64 * (j))
#define XB_XGEN(j)  (2304 + 64 * (j))
#define XB_TOP      3328
#define XB_TOPGEN   3392
#define XCD_BAR_WORDS 3456
#define XB_SPIN_CAP (1u << 22)

__device__ __forceinline__ unsigned xb_ld(unsigned* p)              { return __hip_atomic_load(p, __ATOMIC_RELAXED, __HIP_MEMORY_SCOPE_AGENT); }
__device__ __forceinline__ unsigned xb_add(unsigned* p, unsigned v) { return __hip_atomic_fetch_add(p, v, __ATOMIC_RELAXED, __HIP_MEMORY_SCOPE_AGENT); }
__device__ __forceinline__ unsigned xb_xcc_id() { return (unsigned)__builtin_amdgcn_s_getreg((3 << 11) | 20) & 0xFu; }
#define XB_SPIN(cond, bar) do { unsigned _sp = 0; while (cond) { __builtin_amdgcn_s_sleep(1); \
    if ((++_sp & 255u) == 0u) { if (xb_ld(&(bar)[XB_TMO])) break; if (_sp > XB_SPIN_CAP) { atomicAdd(&(bar)[XB_TMO], 1u); break; } } } } while (0)

struct XcdBarrier { unsigned* bar; unsigned x; volatile LAS unsigned* st; };

__device__ __forceinline__ XcdBarrier xcd_barrier_post(unsigned* bar, volatile LAS unsigned* st) {
    XcdBarrier b; b.bar = bar; b.x = xb_xcc_id(); b.st = st;
    if (threadIdx.x == 0) (void)xb_add(&bar[XB_XCNT(b.x)], 1u);
    return b;
}
__device__ __forceinline__ void xcd_barrier_complete(unsigned* bar, unsigned x, unsigned& nloc, unsigned& nx) {
    const unsigned G = gridDim.x * gridDim.y * gridDim.z;
    unsigned sum, cnt, mine, sp = 0u;
    for (;;) {
        sum = 0u; cnt = 0u; mine = 0u;
#pragma unroll
        for (unsigned j = 0; j < 16; ++j) { const unsigned c = xb_ld(&bar[XB_XCNT(j)]); sum += c; cnt += (c > 0u) ? 1u : 0u; mine = (j == x) ? c : mine; }
        if (sum == G) break;
        __builtin_amdgcn_s_sleep(1);
        if ((++sp & 255u) == 0u) { if (xb_ld(&bar[XB_TMO])) break; if (sp > XB_SPIN_CAP) { atomicAdd(&bar[XB_TMO], 1u); break; } }
    }
    nloc = mine > 0u ? mine : 1u; nx = cnt > 0u ? cnt : 1u;
}
__device__ __forceinline__ void xcd_barrier(const XcdBarrier& b) {
    asm volatile("s_waitcnt vmcnt(0)" ::: "memory");
    __syncthreads();
    if (threadIdx.x == 0) {
        unsigned* bar = b.bar;
        __builtin_amdgcn_s_waitcnt(0);
        unsigned nloc = b.st[0], nx = b.st[1];
        if (nloc == 0u) { xcd_barrier_complete(bar, b.x, nloc, nx); b.st[0] = nloc; b.st[1] = nx; }
        const unsigned old = xb_add(&bar[XB_XSUB(b.x)], 1u);
        const unsigned gen = old / nloc;
        if (old + 1u == (gen + 1u) * nloc) {
            __builtin_amdgcn_fence(__ATOMIC_RELEASE, "agent");
            asm volatile("s_waitcnt vmcnt(0)" ::: "memory");
            const unsigned og = xb_add(&bar[XB_TOP], 1u);
            const unsigned tg = og / nx;
            if (og + 1u == (tg + 1u) * nx) xb_add(&bar[XB_TOPGEN], 1u);
            else XB_SPIN(xb_ld(&bar[XB_TOPGEN]) == tg, bar);
            __builtin_amdgcn_fence(__ATOMIC_ACQUIRE, "agent");
            xb_add(&bar[XB_XGEN(b.x)], 1u);
            asm volatile("s_waitcnt vmcnt(0)" ::: "memory");
        } else {
            XB_SPIN(xb_ld(&bar[XB_XGEN(b.x)]) == gen, bar);
            __builtin_amdgcn_fence(__ATOMIC_ACQUIRE, "agent");
            asm volatile("s_waitcnt vmcnt(0)" ::: "memory");
        }
    }
    __syncthreads();
}

namespace pg8 {
constexpr int BM = 256, BK = 64, HALF = 128, HTB = HALF * BK * 2, STAGE_BYTES = 8 * HTB, NXCD = 8, WGM = 8;
__host__ __device__ __forceinline__ int lds_byte(int r, int c) { const int st = (r >> 4) * 2 + (c >> 5), rr = r & 15, cc = c & 31, ob = rr * 64 + cc * 2; return st * 1024 + (ob ^ (((ob >> 9) & 1) << 5)); }
__host__ __device__ __forceinline__ void stage_rc(int b, int& R, int& C) { const int st = b / 1024, sb = b % 1024, swz = sb ^ (((sb >> 9) & 1) << 5); R = (st >> 1) * 16 + swz / 64; C = (st & 1) * 32 + (swz % 64) / 2; }
__host__ __device__ __forceinline__ int perm32(int rho) { const int n = rho >> 4, i = rho & 15; return 8 * (i >> 2) + 4 * n + (i & 3); }

struct Unit { int pm, pn; };
struct Gemm { const bf16_t* A; const bf16_t* Bt; int K, lda, ldb, a_pn_shift, a_pn_stride, mid_t; };

struct StaticOrder {
    int nM, nN, nwg, G, c;
    __device__ void init(int M, int N, int G_, int c_) { nM = M / BM; nN = N / BM; nwg = nM * nN; G = G_; c = c_; }
    __device__ bool next(int i, Unit& u) const {
        const long L = (long)i * G + c; if (L >= nwg) return false;
        int wgid = (int)L; { const int q = nwg / NXCD, r = nwg % NXCD, xcd = wgid % NXCD, off = wgid / NXCD; wgid = (xcd < r ? xcd * (q + 1) : r * (q + 1) + (xcd - r) * q) + off; }
        const int nig = WGM * nN, gid = wgid / nig, fm = gid * WGM, gsz = (nM - fm) < WGM ? (nM - fm) : WGM;
        u.pm = fm + ((wgid % nig) % gsz); u.pn = (wgid % nig) / gsz; return true;
    }
};
__device__ __forceinline__ unsigned cvt_pk_bf16(float lo, float hi) { unsigned r; asm volatile("v_cvt_pk_bf16_f32 %0, %1, %2" : "=v"(r) : "v"(lo), "v"(hi)); return r; }

struct EpiBf16 {
    static constexpr bool PERM = true;
    bf16_t* O; int ldc;
    __device__ __forceinline__ void operator()(const f32x4 (&acc)[2][2][4][2], const Unit& u, int wr, int wc, int fr, int fq) const {
        const int row0 = u.pm * BM + wr * 64 + fr, col0 = u.pn * BM + wc * 32 + 8 * fq;
#pragma unroll
        for (int ai = 0; ai < 2; ++ai)
#pragma unroll
            for (int m = 0; m < 4; ++m) { bf16_t* rowp = O + (size_t)(row0 + ai * HALF + m * 16) * ldc + col0;
#pragma unroll
                for (int bj = 0; bj < 2; ++bj) { const f32x4 v0 = acc[ai][bj][m][0], v1 = acc[ai][bj][m][1];
                    u32x4 w; w.x = cvt_pk_bf16(v0[0], v0[1]); w.y = cvt_pk_bf16(v0[2], v0[3]); w.z = cvt_pk_bf16(v1[0], v1[1]); w.w = cvt_pk_bf16(v1[2], v1[3]);
                    *(u32x4*)(rowp + bj * HALF) = w; } }
    }
};
struct EpiG1 {
    static constexpr bool PERM = true;
    bf16_t* P; const float* bg; bf16_t* RT; bf16_t* GRS; const float* rope; const unsigned long long* ss; const float* ssp; float* IFo;
    __device__ __forceinline__ void operator()(f32x4 (&acc)[2][2][4][2], const Unit& u, int wr, int wc, int fr, int fq) const {
        const int row0 = u.pm * BM + wr * 64 + fr, cw = wc * 32 + 8 * fq;
#pragma unroll
        for (int ai = 0; ai < 2; ++ai) {
            float sq[4];
            if (u.pm < 32) {
                f32x4 a[4], b[4];
#pragma unroll
                for (int m = 0; m < 4; ++m) { const float* q = ssp + (size_t)(row0 + ai * HALF + m * 16) * 8; a[m] = *(const f32x4*)q; b[m] = *(const f32x4*)(q + 4); }
#pragma unroll
                for (int m = 0; m < 4; ++m) sq[m] = ((a[m][0] + a[m][1]) + (a[m][2] + a[m][3])) + ((b[m][0] + b[m][1]) + (b[m][2] + b[m][3]));
            } else {
                unsigned long long v[4];
#pragma unroll
                for (int m = 0; m < 4; ++m) v[m] = ss[row0 + ai * HALF + m * 16];
#pragma unroll
                for (int m = 0; m < 4; ++m) sq[m] = ss_val(v[m]);
            }
#pragma unroll
            for (int m = 0; m < 4; ++m) { const float rstd = rsqrtf(sq[m] * (1.0f / 2048.0f) + 1e-6f);
#pragma unroll
                for (int bj = 0; bj < 2; ++bj) { acc[ai][bj][m][0] *= rstd; acc[ai][bj][m][1] *= rstd; } }
            __builtin_amdgcn_sched_barrier(0);
        }
        if (u.pn == 44) {
            if (wc == 0 && fq == 0) {
#pragma unroll
                for (int ai = 0; ai < 2; ++ai)
#pragma unroll
                    for (int m = 0; m < 4; ++m) { float* o = IFo + (size_t)(row0 + ai * HALF + m * 16) * 8; *(f32x4*)o = acc[ai][0][m][0]; *(f32x4*)(o + 4) = acc[ai][0][m][1]; }
            }
        } else if (u.pn >= 28) {
            const int ch = 128 * (u.pn - 28) + cw;
            const f32x4 bm0 = *(const f32x4*)(bg + ch), bm1 = *(const f32x4*)(bg + ch + 4), br0 = *(const f32x4*)(bg + 2048 + ch), br1 = *(const f32x4*)(bg + 2048 + ch + 4);
#pragma unroll
            for (int ai = 0; ai < 2; ++ai)
#pragma unroll
                for (int m = 0; m < 4; ++m) { const size_t row = (size_t)(row0 + ai * HALF + m * 16);
                    const f32x4 vm0 = acc[ai][0][m][0] + bm0, vm1 = acc[ai][0][m][1] + bm1, vr0 = acc[ai][1][m][0] + br0, vr1 = acc[ai][1][m][1] + br1;
                    float rt[8], gr[8];
#pragma unroll
                    for (int j = 0; j < 4; ++j) {
                        const float er0 = 1.0f + __expf(-vr0[j]), er1 = 1.0f + __expf(-vr1[j]);
                        rt[j] = er0 * __builtin_amdgcn_rcpf(1.0f + __expf(-vm0[j])); rt[4 + j] = er1 * __builtin_amdgcn_rcpf(1.0f + __expf(-vm1[j]));
                        gr[j] = __builtin_amdgcn_rcpf(er0); gr[4 + j] = __builtin_amdgcn_rcpf(er1); }
                    u32x4 w; w.x = cvt_pk_bf16(rt[0], rt[1]); w.y = cvt_pk_bf16(rt[2], rt[3]); w.z = cvt_pk_bf16(rt[4], rt[5]); w.w = cvt_pk_bf16(rt[6], rt[7]);
                    *(u32x4*)(RT + row * 2048 + ch) = w;
                    w.x = cvt_pk_bf16(gr[0], gr[1]); w.y = cvt_pk_bf16(gr[2], gr[3]); w.z = cvt_pk_bf16(gr[4], gr[5]); w.w = cvt_pk_bf16(gr[6], gr[7]);
                    *(u32x4*)(GRS + row * 2048 + ch) = w; }
        } else if (u.pn >= 12 && u.pn < 20) {
            const float sc = u.pn >= 16 ? 0.0625f : 1.0f;
#pragma unroll
            for (int ai = 0; ai < 2; ++ai)
#pragma unroll
                for (int m = 0; m < 4; ++m) { const int row = row0 + ai * HALF + m * 16;
                    const int pi = row < MP ? (row & (SEQ - 1)) : 2048;
                    const f32x4* cs = (const f32x4*)(rope + ((size_t)pi * 128 + cw) * 2);
                    const f32x4 t0 = cs[0], t1 = cs[1], t2 = cs[2], t3 = cs[3];
                    const f32x4 a0 = acc[ai][0][m][0], a1 = acc[ai][0][m][1], b0 = acc[ai][1][m][0], b1 = acc[ai][1][m][1];
                    const float c[8] = {t0[0], t0[2], t1[0], t1[2], t2[0], t2[2], t3[0], t3[2]}, sn[8] = {t0[1], t0[3], t1[1], t1[3], t2[1], t2[3], t3[1], t3[3]};
                    const float x1[8] = {a0[0], a0[1], a0[2], a0[3], a1[0], a1[1], a1[2], a1[3]}, x2[8] = {b0[0], b0[1], b0[2], b0[3], b1[0], b1[1], b1[2], b1[3]};
                    float o1[8], o2[8];
#pragma unroll
                    for (int j = 0; j < 8; ++j) { o1[j] = (x1[j] * c[j] - x2[j] * sn[j]) * sc; o2[j] = (x1[j] * sn[j] + x2[j] * c[j]) * sc; }
                    bf16_t* rowp = P + (size_t)row * NP + u.pn * BM + cw;
                    u32x4 w; w.x = cvt_pk_bf16(o1[0], o1[1]); w.y = cvt_pk_bf16(o1[2], o1[3]); w.z = cvt_pk_bf16(o1[4], o1[5]); w.w = cvt_pk_bf16(o1[6], o1[7]);
                    *(u32x4*)rowp = w;
                    w.x = cvt_pk_bf16(o2[0], o2[1]); w.y = cvt_pk_bf16(o2[2], o2[3]); w.z = cvt_pk_bf16(o2[4], o2[5]); w.w = cvt_pk_bf16(o2[6], o2[7]);
                    *(u32x4*)(rowp + HALF) = w; }
        } else {
#pragma unroll
            for (int ai = 0; ai < 2; ++ai)
#pragma unroll
                for (int m = 0; m < 4; ++m) { bf16_t* rowp = P + (size_t)(row0 + ai * HALF + m * 16) * NP + u.pn * BM + cw;
#pragma unroll
                    for (int bj = 0; bj < 2; ++bj) { const f32x4 v0 = acc[ai][bj][m][0], v1 = acc[ai][bj][m][1];
                        u32x4 w; w.x = cvt_pk_bf16(v0[0], v0[1]); w.y = cvt_pk_bf16(v0[2], v0[3]); w.z = cvt_pk_bf16(v1[0], v1[1]); w.w = cvt_pk_bf16(v1[2], v1[3]);
                        *(u32x4*)(rowp + bj * HALF) = w; } }
        }
    }
};
struct EpiMerged {
    static constexpr bool PERM = true;
    bf16_t* O; const bf16_t* RT; const bf16_t* GRS;
    __device__ __forceinline__ void scale(f32x4 (&acc)[2][2][4][2], const bf16_t* S, const Unit& u, int wr, int wc, int fr, int fq) const {
        asm volatile("" : "+v"(fr), "+v"(fq));
        const int row0 = u.pm * BM + wr * 64 + fr, col0 = u.pn * BM + wc * 32 + 8 * fq;
#pragma unroll
        for (int ai = 0; ai < 2; ++ai) {
            u32x4 sv[4][2];
#pragma unroll
            for (int m = 0; m < 4; ++m)
#pragma unroll
                for (int bj = 0; bj < 2; ++bj) sv[m][bj] = *(const u32x4*)(S + (size_t)(row0 + ai * HALF + m * 16) * 2048 + col0 + bj * HALF);
#pragma unroll
            for (int m = 0; m < 4; ++m)
#pragma unroll
                for (int bj = 0; bj < 2; ++bj) { const u32x4 a = sv[m][bj];
                    acc[ai][bj][m][0][0] *= __uint_as_float(a.x << 16); acc[ai][bj][m][0][1] *= __uint_as_float(a.x & 0xffff0000u);
                    acc[ai][bj][m][0][2] *= __uint_as_float(a.y << 16); acc[ai][bj][m][0][3] *= __uint_as_float(a.y & 0xffff0000u);
                    acc[ai][bj][m][1][0] *= __uint_as_float(a.z << 16); acc[ai][bj][m][1][1] *= __uint_as_float(a.z & 0xffff0000u);
                    acc[ai][bj][m][1][2] *= __uint_as_float(a.w << 16); acc[ai][bj][m][1][3] *= __uint_as_float(a.w & 0xffff0000u); }
        }
    }
    __device__ __forceinline__ void mid(f32x4 (&acc)[2][2][4][2], const Unit& u, int wr, int wc, int fr, int fq) const { scale(acc, RT, u, wr, wc, fr, fq); }
    __device__ __forceinline__ void operator()(f32x4 (&acc)[2][2][4][2], const Unit& u, int wr, int wc, int fr, int fq) const {
        scale(acc, GRS, u, wr, wc, fr, fq);
        const int row0 = u.pm * BM + wr * 64 + fr, col0 = u.pn * BM + wc * 32 + 8 * fq;
#pragma unroll
        for (int ai = 0; ai < 2; ++ai)
#pragma unroll
            for (int m = 0; m < 4; ++m) { bf16_t* rowp = O + (size_t)(row0 + ai * HALF + m * 16) * 2048 + col0;
#pragma unroll
                for (int bj = 0; bj < 2; ++bj) { const f32x4 v0 = acc[ai][bj][m][0], v1 = acc[ai][bj][m][1];
                    u32x4 w; w.x = cvt_pk_bf16(v0[0], v0[1]); w.y = cvt_pk_bf16(v0[2], v0[3]); w.z = cvt_pk_bf16(v1[0], v1[1]); w.w = cvt_pk_bf16(v1[2], v1[3]);
                    *(u32x4*)(rowp + bj * HALF) = w; } }
    }
};
struct EpiResidual {
    static constexpr bool PERM = true;
    bf16_t* Xb; float* ssp; LAS float* red;
    __device__ __forceinline__ void operator()(f32x4 (&acc)[2][2][4][2], const Unit& u, int wr, int wc, int fr, int fq) const {
        const int row0 = u.pm * BM + wr * 64 + fr, col0 = u.pn * BM + wc * 32 + 8 * fq;
#pragma unroll
        for (int ai = 0; ai < 2; ++ai) {
            u32x4 xv[4][2];
#pragma unroll
            for (int m = 0; m < 4; ++m)
#pragma unroll
                for (int bj = 0; bj < 2; ++bj) xv[m][bj] = *(const u32x4*)(Xb + (size_t)(row0 + ai * HALF + m * 16) * 2048 + col0 + bj * HALF);
#pragma unroll
            for (int m = 0; m < 4; ++m) { float sq = 0.f;
#pragma unroll
                for (int bj = 0; bj < 2; ++bj) { const u32x4 a = xv[m][bj]; const f32x4 v0 = acc[ai][bj][m][0], v1 = acc[ai][bj][m][1];
                    u32x4 w;
                    w.x = cvt_pk_bf16(v0[0] + __uint_as_float(a.x << 16), v0[1] + __uint_as_float(a.x & 0xffff0000u)); w.y = cvt_pk_bf16(v0[2] + __uint_as_float(a.y << 16), v0[3] + __uint_as_float(a.y & 0xffff0000u));
                    w.z = cvt_pk_bf16(v1[0] + __uint_as_float(a.z << 16), v1[1] + __uint_as_float(a.z & 0xffff0000u)); w.w = cvt_pk_bf16(v1[2] + __uint_as_float(a.w << 16), v1[3] + __uint_as_float(a.w & 0xffff0000u));
                    *(u32x4*)(Xb + (size_t)(row0 + ai * HALF + m * 16) * 2048 + col0 + bj * HALF) = w;
                    const unsigned ww[4] = {w.x, w.y, w.z, w.w};
#pragma unroll
                    for (int q = 0; q < 4; ++q) { const float lo = __uint_as_float(ww[q] << 16), hi = __uint_as_float(ww[q] & 0xffff0000u); sq += lo * lo + hi * hi; } }
                sq += __shfl_xor(sq, 16); sq += __shfl_xor(sq, 32);
                if (fq == 0) red[(wr * 64 + fr + ai * HALF + m * 16) * 4 + wc] = sq; }
        }
        asm volatile("s_waitcnt lgkmcnt(0)" ::: "memory"); __builtin_amdgcn_s_barrier(); asm volatile("" ::: "memory");
        int t = threadIdx.x; asm volatile("" : "+v"(t));
        if (t < 256) { const f32x4 q = *(LAS const f32x4*)(red + 4 * t); ssp[(size_t)(u.pm * BM + t) * 8 + u.pn] = (q[0] + q[1]) + (q[2] + q[3]); }
        asm volatile("s_waitcnt lgkmcnt(0)" ::: "memory"); __builtin_amdgcn_s_barrier(); asm volatile("" ::: "memory");
    }
};

template <bool MID, class Epi, class Sched, bool ALIGN_EPI = true>
__device__ __forceinline__ void gemm_phase(LAS unsigned char* lds, const Gemm g, const Sched& S, const Epi& E) {
    const int tid = opaque_tid(), wid = __builtin_amdgcn_readfirstlane(tid >> 6), lane = tid & 63, wr = wid >> 2, wc = wid & 3, fr = lane & 15, fq = lane >> 4;
    const int K = g.K, nt = K / BK;
    unsigned voffA[2], voffB[2];
#pragma unroll
    for (int i = 0; i < 2; ++i) { int R, C; stage_rc(tid * 16 + i * 8192, R, C); const int Rb = Epi::PERM ? ((R & ~31) + perm32(R & 31)) : R;
        voffA[i] = (unsigned)(R * g.lda + C) * 2u; voffB[i] = (unsigned)(Rb * g.ldb + C) * 2u; }
    const size_t kstep = (size_t)(BK * 2);
    const size_t hstepA = (size_t)HALF * g.lda * 2, hstepB = (size_t)HALF * g.ldb * 2;
    const size_t tstepA = 2 * hstepA, tstepB = 2 * hstepB;
    const unsigned ldsw = (unsigned)wid * 1024u;
    const int aoff = lds_byte(wr * 64 + fr, fq * 8), boff = lds_byte(wc * 32 + fr, fq * 8);
#define PG8_SA(b, h) (((b) * 2 + (h)) * HTB)
#define PG8_SB(b, h) ((4 + (b) * 2 + (h)) * HTB)
#define PG8_STAGE(bufoff, gbase, voff) do { _Pragma("unroll") for (int _i = 0; _i < 2; ++_i) \
        __builtin_amdgcn_global_load_lds((const unsigned*)((const char*)(gbase) + (voff)[_i]), (LAS unsigned*)(lds + (bufoff) + ldsw + _i * 8192), 16, 0, 0); } while (0)
#define PG8_LDA(dst, b, h) do { _Pragma("unroll") for (int m = 0; m < 4; ++m) _Pragma("unroll") for (int k = 0; k < 2; ++k) dst[m][k] = *(const LAS bf16x8*)(lds + PG8_SA(b, h) + aoff + m * 2048 + k * 1024); } while (0)
#define PG8_LDB(dst, b, h) do { _Pragma("unroll") for (int n = 0; n < 2; ++n) _Pragma("unroll") for (int k = 0; k < 2; ++k) dst[n][k] = *(const LAS bf16x8*)(lds + PG8_SB(b, h) + boff + n * 2048 + k * 1024); } while (0)
#define PG8_MMA(ai, bj, At, Bt) do { __builtin_amdgcn_s_setprio(1); _Pragma("unroll") for (int m = 0; m < 4; ++m) _Pragma("unroll") for (int n = 0; n < 2; ++n) _Pragma("unroll") for (int k = 0; k < 2; ++k) \
        acc[ai][bj][m][n] = __builtin_amdgcn_mfma_f32_16x16x32_bf16(Bt[n][k], At[m][k], acc[ai][bj][m][n], 0, 0, 0); __builtin_amdgcn_s_setprio(0); } while (0)
#define PG8_WAIT_V(n) asm volatile("s_waitcnt vmcnt(" #n ")" ::: "memory")
#define PG8_WAIT_L(n) asm volatile("s_waitcnt lgkmcnt(" #n ")" ::: "memory")
#define PG8_BAR __builtin_amdgcn_s_barrier()
#define PG8_SCHED __builtin_amdgcn_sched_barrier(0)
#define PG8_APTR(u) ((const char*)g.A + (size_t)(u).pm * tstepA + (size_t)((u).pn >> g.a_pn_shift) * (size_t)g.a_pn_stride)
    Unit cur, nxt; int ui = 0;
    if (!S.next(0, cur)) return;
    f32x4 acc[2][2][4][2];
#pragma unroll
    for (int a = 0; a < 2; ++a)
#pragma unroll
        for (int b = 0; b < 2; ++b)
#pragma unroll
            for (int m = 0; m < 4; ++m)
#pragma unroll
                for (int n = 0; n < 2; ++n) acc[a][b][m][n] = (f32x4){0.f, 0.f, 0.f, 0.f};
    bf16x8 At[4][2], B0[2][2], B1[2][2];
    const char* cA = PG8_APTR(cur); const char* cB = (const char*)g.Bt + (size_t)cur.pn * tstepB;
    PG8_STAGE(PG8_SB(0, 0), cB, voffB); PG8_STAGE(PG8_SB(0, 1), cB + hstepB, voffB); PG8_STAGE(PG8_SA(0, 0), cA, voffA); PG8_STAGE(PG8_SA(0, 1), cA + hstepA, voffA);
    if (wr == 1) PG8_BAR;
    PG8_WAIT_V(2); PG8_BAR;
    PG8_STAGE(PG8_SB(1, 0), cB + kstep, voffB); PG8_STAGE(PG8_SA(1, 0), cA + kstep, voffA); PG8_STAGE(PG8_SB(1, 1), cB + hstepB + kstep, voffB);
    PG8_WAIT_V(6); PG8_BAR;
    for (;;) {
        const bool has_next = S.next(ui + 1, nxt);
        const char* nA = has_next ? PG8_APTR(nxt) : cA; const char* nB = has_next ? (const char*)g.Bt + (size_t)nxt.pn * tstepB : cB;
#pragma unroll 1
        for (int t = 0; t < nt; t += 2) {
            const bool last = (t == nt - 2);
            const char* a1 = cA + (size_t)(t + 1) * kstep;
            const char* a2 = last ? nA : cA + (size_t)(t + 2) * kstep; const char* b2 = last ? nB : cB + (size_t)(t + 2) * kstep;
            const char* a3 = a2 + kstep; const char* b3 = b2 + kstep;
            if constexpr (MID) { if (t == g.mid_t) E.mid(acc, cur, wr, wc, fr, fq); }
            PG8_LDB(B0, 0, 0); PG8_LDB(B1, 0, 1); PG8_SCHED; PG8_LDA(At, 0, 0); PG8_STAGE(PG8_SA(1, 1), a1 + hstepA, voffA);
            PG8_WAIT_V(8); PG8_WAIT_L(0); PG8_BAR; PG8_MMA(0, 0, At, B0); PG8_MMA(0, 1, At, B1); PG8_BAR; PG8_SCHED;
            PG8_LDA(At, 0, 1); PG8_STAGE(PG8_SB(0, 0), b2, voffB); PG8_STAGE(PG8_SB(0, 1), b2 + hstepB, voffB); PG8_STAGE(PG8_SA(0, 0), a2, voffA);
            PG8_WAIT_V(8); PG8_WAIT_L(0); PG8_BAR; PG8_MMA(1, 0, At, B0); PG8_MMA(1, 1, At, B1); PG8_BAR; PG8_SCHED;
            PG8_LDB(B0, 1, 0); PG8_LDB(B1, 1, 1); PG8_SCHED; PG8_LDA(At, 1, 0); PG8_STAGE(PG8_SA(0, 1), a2 + hstepA, voffA);
            PG8_WAIT_V(8); PG8_WAIT_L(0); PG8_BAR; PG8_MMA(0, 0, At, B0); PG8_MMA(0, 1, At, B1); PG8_BAR; PG8_SCHED;
            PG8_LDA(At, 1, 1); PG8_STAGE(PG8_SB(1, 0), b3, voffB); PG8_STAGE(PG8_SB(1, 1), b3 + hstepB, voffB); PG8_STAGE(PG8_SA(1, 0), a3, voffA);
            PG8_WAIT_V(8); PG8_WAIT_L(0); PG8_BAR; PG8_MMA(1, 0, At, B0); PG8_MMA(1, 1, At, B1); PG8_BAR; PG8_SCHED;
        }
        if constexpr (ALIGN_EPI) { if (wr == 0) PG8_BAR; }
        E(acc, cur, wr, wc, fr, fq);
        if (!has_next) break;
#pragma unroll
        for (int a = 0; a < 2; ++a)
#pragma unroll
            for (int b = 0; b < 2; ++b)
#pragma unroll
                for (int m = 0; m < 4; ++m)
#pragma unroll
                    for (int n = 0; n < 2; ++n) acc[a][b][m][n] = (f32x4){0.f, 0.f, 0.f, 0.f};
        cur = nxt; cA = nA; cB = nB; ++ui;
        if constexpr (ALIGN_EPI) { if (wr == 1) PG8_BAR; }
    }
    PG8_WAIT_V(0);
    if constexpr (!ALIGN_EPI) { if (wr == 0) PG8_BAR; }
    PG8_BAR;
#undef PG8_SA
#undef PG8_SB
#undef PG8_STAGE
#undef PG8_LDA
#undef PG8_LDB
#undef PG8_MMA
#undef PG8_WAIT_V
#undef PG8_WAIT_L
#undef PG8_BAR
#undef PG8_SCHED
#undef PG8_APTR
}
}

struct TrDesc { const float* src; bf16_t* dst; const float* ks; int ldsrc, ldd; float scale; };
__device__ __forceinline__ TrDesc tr_desc(const Params& p, int it) {
    constexpr int T0 = 1536, T1 = T0 + 2048, T2 = T1 + 2048, T3 = T2 + 512, T4 = T3 + 512, T5 = T4 + 1024, T6 = T5 + 64, T7 = T6 + 64;
    const int l = it / T7, r = it % T7;
    bf16_t* Wl = p.W_() + (size_t)l * WL;
    TrDesc d; d.scale = 1.f; d.ks = nullptr;
    int k0, c0, r0, kd0; const float* src; bf16_t* dst;
    if (r < T0)      { const int q = r;      src = p.w_in + (size_t)l * D * NIN; d.ldsrc = NIN; k0 = (q & 31) * 64; c0 = (q >> 5) * 64; dst = Wl + W1_OFF; d.ldd = D; r0 = (q >> 5) * 64; kd0 = k0; d.ks = p.norm_g + (size_t)l * D; }
    else if (r < T1) { const int q = r - T0; src = p.w_in + (size_t)l * D * NIN; d.ldsrc = NIN; k0 = (q & 31) * 64; c0 = 3080 + (q >> 5) * 64; dst = Wl + W1_OFF; d.ldd = D; r0 = 3072 + (q >> 5) * 64; kd0 = k0; d.ks = p.norm_g + (size_t)l * D; }
    else if (r < T2) { const int q = r - T1, ct = q >> 5;
                       src = p.w_gate + (size_t)l * D * 4096; d.ldsrc = 4096; k0 = (q & 31) * 64; c0 = (((ct & 3) < 2) ? 0 : 2048) + 128 * (ct >> 2) + (ct & 1) * 64; dst = Wl + W1_OFF; d.ldd = D; r0 = C_GM + ct * 64; kd0 = k0; d.ks = p.norm_g + (size_t)l * D; }
    else if (r < T3) { const int q = r - T2; src = p.w_pm + (size_t)l * WM * D; d.ldsrc = D; k0 = (q & 15) * 64; c0 = (q >> 4) * 64; dst = Wl + W3_OFF; d.ldd = D; r0 = c0; kd0 = k0; }
    else if (r < T4) { const int q = r - T3; src = p.w_pr + (size_t)l * WM * D; d.ldsrc = D; k0 = (q & 15) * 64; c0 = (q >> 4) * 64; dst = Wl + W3_OFF; d.ldd = D; r0 = c0; kd0 = 1024 + k0; }
    else if (r < T5) { const int q = r - T4; src = p.w_o + (size_t)l * D * D; d.ldsrc = D; k0 = (q & 31) * 64; c0 = (q >> 5) * 64; dst = Wl + W4_OFF; d.ldd = D; r0 = c0; kd0 = k0; }
    else if (r < T6) { const int q = r - T5, h = q >> 4, qq = q & 15; src = p.w_qm + ((size_t)l * HM + h) * SZ; d.ldsrc = DH; k0 = (qq & 3) * 64; c0 = (qq >> 2) * 64; dst = Wl + W2_OFF; d.ldd = DH; r0 = h * 512 + c0; kd0 = k0; d.scale = 0.0625f; }
    else             { const int q = r - T6, h = q >> 4, qq = q & 15; src = p.w_km + ((size_t)l * HM + h) * SZ; d.ldsrc = DH; k0 = (qq & 3) * 64; c0 = (qq >> 2) * 64; dst = Wl + W2_OFF; d.ldd = DH; r0 = h * 512 + 256 + c0; kd0 = k0; }
    d.src = src + (size_t)k0 * d.ldsrc + c0; d.dst = dst + (size_t)r0 * d.ldd + kd0; if (d.ks) d.ks += k0;
    return d;
}
__device__ __forceinline__ void tr_load(const TrDesc& d, f32x4 (&v)[16], f32x4 (&ks)[2], int lane) {
#pragma unroll
    for (int i = 0; i < 16; ++i) v[i] = __builtin_nontemporal_load((const f32x4*)(d.src + (size_t)((lane >> 4) + 4 * i) * d.ldsrc + 4 * (lane & 15)));
    if (d.ks) { ks[0] = *(const f32x4*)(d.ks + 8 * (lane & 7)); ks[1] = *(const f32x4*)(d.ks + 8 * (lane & 7) + 4); }
    else { ks[0] = (f32x4){1.f, 1.f, 1.f, 1.f}; ks[1] = ks[0]; }
}
__device__ __forceinline__ void tr_store(const TrDesc& d, const f32x4 (&v)[16], const f32x4 (&ks)[2], LAS float* t, int lane) {
#pragma unroll
    for (int i = 0; i < 16; ++i)
#pragma unroll
        for (int j = 0; j < 4; ++j) t[((lane >> 4) + 4 * i) * 65 + 4 * (lane & 15) + j] = v[i][j];
    const int c = lane & 7;
    const f32x4 s0 = ks[0] * d.scale, s1 = ks[1] * d.scale;
#pragma unroll
    for (int j = 0; j < 8; ++j) { const int n = (lane >> 3) + 8 * j; const LAS float* q = t + (8 * c) * 65 + n;
        u32x4 o; o.x = pk2(s0[0] * q[0], s0[1] * q[65]); o.y = pk2(s0[2] * q[130], s0[3] * q[195]); o.z = pk2(s1[0] * q[260], s1[1] * q[325]); o.w = pk2(s1[2] * q[390], s1[3] * q[455]);
        *(u32x4*)(d.dst + (size_t)n * d.ldd + 8 * c) = o; }
}
__device__ __forceinline__ void prep_phase(const Params& p, int wg, int nwg, LAS unsigned char* lds) {
    const int tid = opaque_tid();
    {
        const int lane = tid & 63, wid = tid >> 6;
        for (int row = wg * 8 + wid; row < MPAD; row += nwg * 8) {
            u32x2* hrow = (u32x2*)(p.Xb_() + (size_t)row * D);
            float ss = 0.f;
            if (row < MT) {
                const f32x4* xr = (const f32x4*)(row < MP ? p.x_prompt + (size_t)row * D : p.x_sample + (size_t)(row - MP) * D);
#pragma unroll
                for (int i = 0; i < 8; ++i) { const f32x4 v = xr[lane + 64 * i]; ss += (v[0] * v[0] + v[1] * v[1]) + (v[2] * v[2] + v[3] * v[3]); hrow[lane + 64 * i] = (u32x2){pk2(v[0], v[1]), pk2(v[2], v[3])}; }
                ss = wave_sum(ss);
            } else {
#pragma unroll
                for (int i = 0; i < 8; ++i) hrow[lane + 64 * i] = (u32x2){0u, 0u};
            }
            if (lane < 5) p.SS_()[(size_t)lane * MPAD + row] = lane == 0 ? ss_fix(ss) : 0ull;
            if (row < MP && lane < 8) p.SSP_()[(size_t)row * 8 + lane] = lane == 0 ? ss : 0.f;
        }
    }
    for (int i = wg * 512 + tid; i < 2049 * 128; i += nwg * 512) {
        const int pi = i >> 7, j = i & 127;
        const float pos = pi < 2048 ? (float)pi : 16384.0f;
        const float inv = powf(10000.0f, -((float)j / 128.0f));
        const float ang = pos * inv;
        p.ROPE_()[2 * i] = (float)cos((double)ang); p.ROPE_()[2 * i + 1] = (float)sin((double)ang);
    }
    for (int i = wg * 512 + tid; i < DEPTH * 256 * D; i += nwg * 512) {
        const int l = i / (256 * D), r = i % (256 * D), j = r / D, k = r % D;
        p.W_()[(size_t)l * WL + W1_OFF + (size_t)(11264 + j) * D + k] = j < 8 ? f2bf(p.w_in[((size_t)l * D + k) * NIN + 3072 + j] * p.norm_g[(size_t)l * D + k]) : (bf16_t)0;
    }
    const int lane = tid & 63, wid = tid >> 6;
    LAS float* t = (LAS float*)lds + wid * (64 * 65);
    constexpr int NT = DEPTH * 7808;
    int it = wg * 8 + wid;
    if (it < NT) {
        TrDesc d = tr_desc(p, it);
        f32x4 v[16], ks[2];
        tr_load(d, v, ks, lane);
        for (;;) {
            const int it2 = it + nwg * 8;
            const bool has = it2 < NT;
            TrDesc d2 = d; f32x4 v2[16], ks2[2];
            if (has) { d2 = tr_desc(p, it2); tr_load(d2, v2, ks2, lane); }
            tr_store(d, v, ks, t, lane);
            if (!has) break;
#pragma unroll
            for (int i = 0; i < 16; ++i) v[i] = v2[i];
            ks[0] = ks2[0]; ks[1] = ks2[1]; d = d2; it = it2;
        }
    }
}

__device__ __forceinline__ void final_phase(const Params& p, int wg, int nwg) {
    const int tid_ = opaque_tid(), lane = tid_ & 63, wid = tid_ >> 6;
    const f32x4* g4 = (const f32x4*)p.final_g;
    for (int row = wg * 8 + wid; row < MT; row += nwg * 8) {
        const u32x2* xr = (const u32x2*)(p.Xb_() + (size_t)row * D);
        f32x4* yr = (f32x4*)(p.out + (row < MP ? O_YP + (size_t)row * D : O_YS + (size_t)(row - MP) * D));
        const float rstd = rsqrtf(row_ss(p.SSP_(), p.SS_() + (size_t)4 * MPAD, row) * (1.0f / D) + EPS);
#pragma unroll
        for (int i = 0; i < 8; ++i) { const u32x2 xb = xr[lane + 64 * i];
            const f32x4 v = (f32x4){__uint_as_float(xb.x << 16), __uint_as_float(xb.x & 0xffff0000u), __uint_as_float(xb.y << 16), __uint_as_float(xb.y & 0xffff0000u)};
            yr[lane + 64 * i] = v * rstd * g4[lane + 64 * i]; }
    }
}

__device__ __forceinline__ void unpack8(const u32x4 v, float (&f)[8]) {
    f[0] = __uint_as_float(v.x << 16); f[1] = __uint_as_float(v.x & 0xffff0000u); f[2] = __uint_as_float(v.y << 16); f[3] = __uint_as_float(v.y & 0xffff0000u);
    f[4] = __uint_as_float(v.z << 16); f[5] = __uint_as_float(v.z & 0xffff0000u); f[6] = __uint_as_float(v.w << 16); f[7] = __uint_as_float(v.w & 0xffff0000u);
}
__device__ __forceinline__ u32x4 pack8(const float (&f)[8]) { u32x4 w; w.x = pk2(f[0], f[1]); w.y = pk2(f[2], f[3]); w.z = pk2(f[4], f[5]); w.w = pk2(f[6], f[7]); return w; }

__device__ __forceinline__ void gate_all(const Params& p, int layer, int bh, LAS float* G);
__device__ __forceinline__ void conv_phase(const Params& p, int layer, int wg, int nwg, LAS unsigned char* lds) {
    const int tid = opaque_tid();
    for (int bh = wg; bh < 16; bh += nwg) gate_all(p, layer, bh, (LAS float*)lds);
    const float* cw = p.conv_w + (size_t)layer * 4 * WM;
    const float* cb = p.conv_b + (size_t)layer * WM;
    for (int it = wg * 512 + tid; it < MT * 128; it += nwg * 512) {
        const int row = it >> 7, ch = (it & 127) * 8;
        float up[4][8];
        if (row < MP) {
            const int t = row & (SEQ - 1);
#pragma unroll
            for (int i = 0; i < 4; ++i) {
                if (t - 3 + i >= 0) unpack8(*(const u32x4*)(p.P_() + (size_t)(row - 3 + i) * NP + C_U + ch), up[i]);
                else {
#pragma unroll
                    for (int j = 0; j < 8; ++j) up[i][j] = 0.f;
                }
            }
            if (t >= SEQ - 3) {
                const int b = row >> 11;
                float* o = p.out + O_CVP + (((size_t)layer * BP + b) * 3 + (t - (SEQ - 3))) * WM + ch;
                *(f32x4*)o = (f32x4){up[3][0], up[3][1], up[3][2], up[3][3]}; *(f32x4*)(o + 4) = (f32x4){up[3][4], up[3][5], up[3][6], up[3][7]};
            }
        } else {
            const int b = row - MP;
            const float* hist = p.st_conv + ((size_t)layer * BS + b) * 3 * WM + ch;
#pragma unroll
            for (int i = 0; i < 3; ++i) { const f32x4 a = *(const f32x4*)(hist + (size_t)i * WM), c = *(const f32x4*)(hist + (size_t)i * WM + 4);
                up[i][0] = a[0]; up[i][1] = a[1]; up[i][2] = a[2]; up[i][3] = a[3]; up[i][4] = c[0]; up[i][5] = c[1]; up[i][6] = c[2]; up[i][7] = c[3]; }
            unpack8(*(const u32x4*)(p.P_() + (size_t)row * NP + C_U + ch), up[3]);
            float* o = p.out + O_CVS + ((size_t)layer * BS + b) * 3 * WM + ch;
#pragma unroll
            for (int i = 0; i < 3; ++i) { *(f32x4*)(o + (size_t)i * WM) = (f32x4){up[i + 1][0], up[i + 1][1], up[i + 1][2], up[i + 1][3]};
                *(f32x4*)(o + (size_t)i * WM + 4) = (f32x4){up[i + 1][4], up[i + 1][5], up[i + 1][6], up[i + 1][7]}; }
        }
        float r[8];
#pragma unroll
        for (int j = 0; j < 8; ++j) r[j] = cb[ch + j];
#pragma unroll
        for (int i = 0; i < 4; ++i)
#pragma unroll
            for (int j = 0; j < 8; ++j) r[j] += up[i][j] * cw[i * WM + ch + j];
#pragma unroll
        for (int j = 0; j < 8; ++j) r[j] = siluf_(r[j]);
        *(u32x4*)(p.CM_() + (size_t)row * WM + ch) = pack8(r);
    }
}

__device__ __forceinline__ void gate_all(const Params& p, int layer, int bh, LAS float* G) {
    const int tid = opaque_tid(), lane = tid & 63, wid = tid >> 6, b = bh >> 2, h = bh & 3;
    const float bi = p.b_i[layer * HM + h], bfv = p.b_f[layer * HM + h];
    float* gt = p.GT_() + (size_t)bh * 6208;
    float tb0[2], tb1[2], tg0[2], tg1[2], rm0[2], rm1[2];
#pragma unroll
    for (int q = 0; q < 2; ++q) {
        const int cc = wid + 8 * q;
        const size_t r0 = (size_t)b * SEQ + cc * 128 + 2 * lane;
        const float i0 = p.IF_()[r0 * 8 + h] + bi, i1 = p.IF_()[(r0 + 1) * 8 + h] + bi;
        const float l0 = logsigf_(p.IF_()[r0 * 8 + 4 + h] + bfv), l1 = logsigf_(p.IF_()[(r0 + 1) * 8 + 4 + h] + bfv);
        float inc = l0 + l1;
#pragma unroll
        for (int o = 1; o < 64; o <<= 1) { const float t = __shfl_up(inc, o); if (lane >= o) inc += t; }
        const float exc = inc - (l0 + l1);
        tb0[q] = exc + l0; tb1[q] = inc;
        tg0[q] = i0 - tb0[q]; tg1[q] = i1 - tb1[q];
        const float gm = wave_max(fmaxf(tg0[q], tg1[q]));
        const float Bc = __shfl(inc, 63);
        if (lane == 0) { G[cc] = Bc; G[16 + cc] = gm; }
        float rm = fmaxf(tg0[q], tg1[q]);
#pragma unroll
        for (int o = 1; o < 64; o <<= 1) { const float t = __shfl_up(rm, o); if (lane >= o) rm = fmaxf(rm, t); }
        float ex = __shfl_up(rm, 1); if (lane == 0) ex = -3.0e38f;
        rm0[q] = fmaxf(ex, tg0[q]); rm1[q] = fmaxf(rm0[q], tg1[q]);
    }
    __syncthreads();
    if (tid == 0) { float m = -1e30f; for (int cc = 0; cc < 16; ++cc) { G[32 + cc] = m; m = G[cc] + fmaxf(m, G[16 + cc]); } G[48] = m; }
    __syncthreads();
#pragma unroll
    for (int q = 0; q < 2; ++q) {
        const int cc = wid + 8 * q, t0 = cc * 128 + 2 * lane;
        const float mc = G[32 + cc];
        *(f32x2_t*)(gt + t0) = (f32x2_t){tb0[q], tb1[q]}; *(f32x2_t*)(gt + 2048 + t0) = (f32x2_t){tg0[q], tg1[q]};
        *(f32x2_t*)(gt + 4096 + t0) = (f32x2_t){fmaxf(rm0[q], mc), fmaxf(rm1[q], mc)};
    }
    if (tid < 16) { gt[6144 + tid] = G[tid]; gt[6160 + tid] = G[16 + tid]; }
    if (tid < 17) gt[6176 + tid] = G[32 + tid];
    __syncthreads();
}
__device__ __forceinline__ void gate_load(const Params& p, int bh, int c, LAS float* G, int tid) {
    const float* gt = p.GT_() + (size_t)bh * 6208;
    if (tid < 128) { G[64 + tid] = gt[c * 128 + tid]; G[192 + tid] = gt[2048 + c * 128 + tid]; G[320 + tid] = gt[4096 + c * 128 + tid]; }
    if (tid == 0) G[32 + c] = gt[6176 + c];
    __syncthreads();
}

template <int I> struct IC { static constexpr int value = I; };
template <int I, int N, class F> __device__ __forceinline__ void sfor(F&& f) { if constexpr (I < N) { f(IC<I>{}); sfor<I + 1, N>(f); } }

template <int CPR>
__device__ __forceinline__ void tile_load(u32x4 (&r)[8], const bf16_t* src, int ld_src, int tid) {
#pragma unroll
    for (int i = 0; i < 8; ++i) { const int id = tid + 512 * i, row = id / CPR, ch = id % CPR; r[i] = *(const u32x4*)(src + (size_t)row * ld_src + ch * 8); }
}
template <int CPR, int LDB>
__device__ __forceinline__ void tile_store(LAS unsigned char* dst, const u32x4 (&r)[8], int tid) {
#pragma unroll
    for (int i = 0; i < 8; ++i) { const int id = tid + 512 * i, row = id / CPR, ch = id % CPR; *(LAS u32x4*)(dst + row * LDB + ch * 16) = r[i]; }
}
__device__ __forceinline__ void tile_store_w(LAS unsigned char* dst, const u32x4 (&r)[8], LAS const float* w, int tid) {
#pragma unroll
    for (int i = 0; i < 8; ++i) { const int id = tid + 512 * i, row = id >> 5, ch = id & 31; float f[8]; unpack8(r[i], f); const float ww = w[row];
#pragma unroll
        for (int j = 0; j < 8; ++j) f[j] *= ww;
        *(LAS u32x4*)(dst + row * 544 + ch * 16) = pack8(f); }
}
template <int OFF, int HS>
__device__ __forceinline__ bf16x8 tr_frag1(unsigned base) {
    u32x2 l0, h0;
    asm volatile("ds_read_b64_tr_b16 %0, %2 offset:%3\n\tds_read_b64_tr_b16 %1, %2 offset:%4\n\ts_waitcnt lgkmcnt(0)"
                 : "=&v"(l0), "=&v"(h0) : "v"(base), "i"(OFF), "i"(OFF + HS) : "memory");
    const u32x4 v = (u32x4){l0.x, l0.y, h0.x, h0.y};
    return __builtin_bit_cast(bf16x8, v);
}
template <int OFF, int HS, int TS>
__device__ __forceinline__ void tr_frag2(unsigned base, bf16x8& f0, bf16x8& f1) {
    u32x2 l0, l1, h0, h1;
    asm volatile("ds_read_b64_tr_b16 %0, %4 offset:%5\n\tds_read_b64_tr_b16 %2, %4 offset:%6\n\t"
                 "ds_read_b64_tr_b16 %1, %4 offset:%7\n\tds_read_b64_tr_b16 %3, %4 offset:%8\n\t"
                 "s_waitcnt lgkmcnt(0)"
                 : "=&v"(l0), "=&v"(l1), "=&v"(h0), "=&v"(h1)
                 : "v"(base), "i"(OFF), "i"(OFF + HS), "i"(OFF + TS), "i"(OFF + TS + HS)
                 : "memory");
    f0 = __builtin_bit_cast(bf16x8, (u32x4){l0.x, l0.y, h0.x, h0.y}); f1 = __builtin_bit_cast(bf16x8, (u32x4){l1.x, l1.y, h1.x, h1.y});
}
template <int OFF, int HS, int TS>
__device__ __forceinline__ void tr_frag4(unsigned base, bf16x8 (&f)[4]) {
    u32x2 l0, l1, l2, l3, h0, h1, h2, h3;
    asm volatile("ds_read_b64_tr_b16 %0, %8 offset:%9\n\tds_read_b64_tr_b16 %4, %8 offset:%10\n\t"
                 "ds_read_b64_tr_b16 %1, %8 offset:%11\n\tds_read_b64_tr_b16 %5, %8 offset:%12\n\t"
                 "ds_read_b64_tr_b16 %2, %8 offset:%13\n\tds_read_b64_tr_b16 %6, %8 offset:%14\n\t"
                 "ds_read_b64_tr_b16 %3, %8 offset:%15\n\tds_read_b64_tr_b16 %7, %8 offset:%16\n\t"
                 "s_waitcnt lgkmcnt(0)"
                 : "=&v"(l0), "=&v"(l1), "=&v"(l2), "=&v"(l3), "=&v"(h0), "=&v"(h1), "=&v"(h2), "=&v"(h3)
                 : "v"(base), "i"(OFF), "i"(OFF + HS), "i"(OFF + TS), "i"(OFF + TS + HS), "i"(OFF + 2 * TS), "i"(OFF + 2 * TS + HS), "i"(OFF + 3 * TS), "i"(OFF + 3 * TS + HS)
                 : "memory");
    f[0] = __builtin_bit_cast(bf16x8, (u32x4){l0.x, l0.y, h0.x, h0.y}); f[1] = __builtin_bit_cast(bf16x8, (u32x4){l1.x, l1.y, h1.x, h1.y});
    f[2] = __builtin_bit_cast(bf16x8, (u32x4){l2.x, l2.y, h2.x, h2.y}); f[3] = __builtin_bit_cast(bf16x8, (u32x4){l3.x, l3.y, h3.x, h3.y});
}
__device__ __forceinline__ unsigned lds_addr(LAS const void* p) { return (unsigned)(size_t)p; }

template <int NR, int NC, bool WEIGHT>
__device__ __forceinline__ void stage_T(LAS unsigned char* dst, int ldd_bytes, const bf16_t* src, int ld_src, LAS const float* w) {
    const int tid_ = opaque_tid(), lane = tid_ & 63, wid = tid_ >> 6;
    constexpr int PB = NR / 128, CG = NC / 8;
#pragma unroll 1
    for (int task = wid; task < PB * CG; task += 8) {
        const int pb = task % PB, cg = task / PB, r = pb * 128 + 2 * lane;
        float a[8], c[8];
        unpack8(*(const u32x4*)(src + (size_t)r * ld_src + cg * 8), a); unpack8(*(const u32x4*)(src + (size_t)(r + 1) * ld_src + cg * 8), c);
        float w0 = 1.f, w1 = 1.f; if (WEIGHT) { w0 = w[r]; w1 = w[r + 1]; }
#pragma unroll
        for (int j = 0; j < 8; ++j) *(LAS unsigned*)(dst + (cg * 8 + j) * ldd_bytes + r * 2) = pk2(a[j] * w0, c[j] * w1);
    }
}
__device__ __forceinline__ void stage_rows(LAS unsigned char* dst, const bf16_t* src, int ld_src) {
    const int tid_ = opaque_tid();
#pragma unroll
    for (int i = 0; i < 8; ++i) { const int id = tid_ + 512 * i, row = id >> 5, ch = id & 31;
        *(LAS u32x4*)(dst + row * 528 + ch * 16) = *(const u32x4*)(src + (size_t)row * ld_src + ch * 8); }
}
__device__ __forceinline__ bf16x8 lds_frag(LAS const unsigned char* base, int row, int ld_bytes, int kbyte) { return *(LAS const bf16x8*)(base + row * ld_bytes + kbyte); }
__device__ __forceinline__ float ret_lg(int h) { return logf(1.0f - exp2f(-5.0f - (float)h)); }

template <int BR>
__device__ __forceinline__ void chunk_passA(const Params& p, int layer, int b, int h, int c, LAS unsigned char* lds) {
    LAS unsigned char* Xt = lds; LAS unsigned char* Yt = lds + 69632; LAS float* G = (LAS float*)(lds + 139264); LAS float* wk = G + 512;
    const int tid = opaque_tid(), lane = tid & 63, w = __builtin_amdgcn_readfirstlane(tid >> 6), g = lane >> 4, lr = lane & 15;
    const size_t row0 = (size_t)b * SEQ + c * 128;
    const int pi = BR * 16 + b * 4 + h;
    const bf16_t* Xp = BR == 0 ? p.QK_() + row0 * 2048 + h * 512 + 256 : p.P_() + row0 * NP + C_VR + h * 256;
    const bf16_t* Yp = BR == 0 ? p.P_() + row0 * NP + C_VM + h * 256 : p.P_() + row0 * NP + C_KR + h * 256;
    u32x4 xr[8], yr[8];
    tile_load<32>(xr, Xp, BR == 0 ? 2048 : NP, tid); tile_load<32>(yr, Yp, NP, tid);
    if (BR == 0) { gate_load(p, b * 4 + h, c, G, tid); if (tid < 128) wk[tid] = expf(G[192 + tid] - G[320 + 127]); }
    else { if (tid < 128) wk[tid] = expf((float)(127 - tid) * ret_lg(h)); }
    __syncthreads();
    tile_store<32, 544>(Xt, xr, tid); tile_store_w(Yt, yr, wk, tid);
    __syncthreads();
    const unsigned lpart = (unsigned)(((8 * g + (lr >> 2)) * 272 + 4 * (lr & 3)) * 2);
    const unsigned baseX = lds_addr(Xt) + lpart + (unsigned)(32 * w * 2), baseY = lds_addr(Yt) + lpart;
    bf16_t* Uo = p.U_() + ((size_t)pi * 16 + c) * SZ;
    sfor<0, 2>([&](auto rt_) {
        constexpr int rt = decltype(rt_)::value;
        f32x4 acc[16];
#pragma unroll
        for (int j = 0; j < 16; ++j) acc[j] = (f32x4){0.f, 0.f, 0.f, 0.f};
        sfor<0, 4>([&](auto ks_) {
            constexpr int ks = decltype(ks_)::value;
            const bf16x8 fa = tr_frag1<ks * 32 * 544 + rt * 32, 4 * 544>(baseX);
            sfor<0, 4>([&](auto cq_) {
                constexpr int cq = decltype(cq_)::value;
                bf16x8 fb[4];
                tr_frag4<ks * 32 * 544 + cq * 128, 4 * 544, 32>(baseY, fb);
#pragma unroll
                for (int i = 0; i < 4; ++i) acc[4 * cq + i] = __builtin_amdgcn_mfma_f32_16x16x32_bf16(fa, fb[i], acc[4 * cq + i], 0, 0, 0);
            });
        });
#pragma unroll
        for (int ct = 0; ct < 16; ++ct)
            *(u32x2*)(Uo + (size_t)(16 * ct + lr) * 256 + 32 * w + 16 * rt + 4 * g) = (u32x2){pk2(acc[ct][0], acc[ct][1]), pk2(acc[ct][2], acc[ct][3])};
    });
    if (BR == 0 && tid < 256) {
        float sacc = 0.f;
        for (int ss = 0; ss < 128; ++ss) sacc += wk[ss] * bf2f(*(LAS const bf16_t*)(Xt + ss * 544 + tid * 2));
        p.NU_()[((size_t)(b * 4 + h) * 16 + c) * 256 + tid] = sacc;
    }
    __syncthreads();
}

template <int BR>
__device__ __forceinline__ void chunk_state_item(const Params& p, int layer, int b, int h, int sl, LAS unsigned char* lds) {
    LAS unsigned char* Xt = lds;
    LAS unsigned char* Ys = lds + 69632;
    LAS float* wka = (LAS float*)(lds + 79872);
    LAS float* dec = wka + 2048;
    const int tid = opaque_tid(), lane = tid & 63, w = __builtin_amdgcn_readfirstlane(tid >> 6), g = lane >> 4, lr = lane & 15;
    const int bh = b * 4 + h, pi = BR * 16 + bh;
    const float* gt = p.GT_() + (size_t)bh * 6208;
    if (BR == 0) {
#pragma unroll
        for (int i = 0; i < 4; ++i) { const int t = tid + 512 * i; wka[t] = expf(gt[2048 + t] - gt[4096 + (t | 127)]); }
        if (tid < 16) { const float mc = gt[6176 + tid]; dec[tid] = expf(mc - fmaxf(mc, gt[6160 + tid])); }
    } else {
        const float lg = ret_lg(h);
#pragma unroll
        for (int i = 0; i < 4; ++i) { const int t = tid + 512 * i; wka[t] = expf((float)(127 - (t & 127)) * lg); }
        if (tid < 16) dec[tid] = expf(128.0f * lg);
    }
    const size_t rowb = (size_t)b * SEQ;
    const bf16_t* Xp = BR == 0 ? p.QK_() + rowb * 2048 + h * 512 + 256 : p.P_() + rowb * NP + C_VR + h * 256;
    const int ldX = BR == 0 ? 2048 : NP;
    const bf16_t* Yp = (BR == 0 ? p.P_() + rowb * NP + C_VM + h * 256 : p.P_() + rowb * NP + C_KR + h * 256) + 32 * sl;
    const unsigned yoff = (unsigned)((tid >> 2) * NP + (tid & 3) * 8) * 2u;
    u32x4 xa[8], xb[8], ya, yb;
    tile_load<32>(xa, Xp, ldX, tid); ya = *(const u32x4*)((const char*)Yp + yoff);
    tile_load<32>(xb, Xp + (size_t)128 * ldX, ldX, tid); yb = *(const u32x4*)((const char*)(Yp + (size_t)128 * NP) + yoff);
    f32x4 st[2][2], nst[2];
#pragma unroll
    for (int i = 0; i < 2; ++i) { nst[i] = (f32x4){0.f, 0.f, 0.f, 0.f};
#pragma unroll
        for (int j = 0; j < 2; ++j) st[i][j] = (f32x4){0.f, 0.f, 0.f, 0.f}; }
    const unsigned lpart = (unsigned)(((8 * g + (lr >> 2)) * 272 + 4 * (lr & 3)) * 2), lparty = (unsigned)(((8 * g + (lr >> 2)) * 40 + 4 * (lr & 3)) * 2);
    const unsigned baseX = lds_addr(Xt) + lpart + (unsigned)(32 * w * 2), baseY = lds_addr(Ys) + lparty;
    bf16_t* CSp = p.CS_() + (size_t)pi * 16 * SZ + (size_t)(32 * sl + lr) * 256 + 32 * w + 4 * g;
    float* NSp = p.NS_() + (size_t)bh * 16 * 256 + 32 * w + 4 * g;
    const bool nown = (BR == 0) && (sl == 0) && (lr == 0);
    __syncthreads();
    auto step = [&](int c, u32x4 (&xr)[8], u32x4& yr) {
#pragma unroll
        for (int rt = 0; rt < 2; ++rt) {
#pragma unroll
            for (int ct = 0; ct < 2; ++ct) *(u32x2*)(CSp + (size_t)c * SZ + (size_t)(16 * ct) * 256 + 16 * rt) = (u32x2){pk2(st[rt][ct][0], st[rt][ct][1]), pk2(st[rt][ct][2], st[rt][ct][3])};
            if (nown) *(f32x4*)(NSp + (size_t)c * 256 + 16 * rt) = nst[rt];
        }
        tile_store<32, 544>(Xt, xr, tid);
        { float f[8]; unpack8(yr, f); const float ww = wka[c * 128 + (tid >> 2)];
#pragma unroll
          for (int j = 0; j < 8; ++j) f[j] *= ww;
          *(LAS u32x4*)(Ys + (tid >> 2) * 80 + (tid & 3) * 16) = pack8(f); }
        __syncthreads();
        if (c + 2 < 16) {
            tile_load<32>(xr, Xp + (size_t)(c + 2) * 128 * ldX, ldX, tid);
            yr = *(const u32x4*)((const char*)(Yp + (size_t)(c + 2) * 128 * NP) + yoff);
        }
        f32x4 u[2][2], un[2];
#pragma unroll
        for (int i = 0; i < 2; ++i) { un[i] = (f32x4){0.f, 0.f, 0.f, 0.f};
#pragma unroll
            for (int j = 0; j < 2; ++j) u[i][j] = (f32x4){0.f, 0.f, 0.f, 0.f}; }
        sfor<0, 4>([&](auto ks_) {
            constexpr int ks = decltype(ks_)::value;
            bf16x8 fa0, fa1, fb0, fb1;
            tr_frag2<ks * 32 * 544, 4 * 544, 32>(baseX, fa0, fa1);
            tr_frag2<ks * 32 * 80, 4 * 80, 32>(baseY, fb0, fb1);
            u[0][0] = __builtin_amdgcn_mfma_f32_16x16x32_bf16(fa0, fb0, u[0][0], 0, 0, 0); u[0][1] = __builtin_amdgcn_mfma_f32_16x16x32_bf16(fa0, fb1, u[0][1], 0, 0, 0);
            u[1][0] = __builtin_amdgcn_mfma_f32_16x16x32_bf16(fa1, fb0, u[1][0], 0, 0, 0); u[1][1] = __builtin_amdgcn_mfma_f32_16x16x32_bf16(fa1, fb1, u[1][1], 0, 0, 0);
            if (BR == 0) {
                const f32x4 w0 = *(LAS const f32x4*)(wka + c * 128 + 32 * ks + 8 * g), w1 = *(LAS const f32x4*)(wka + c * 128 + 32 * ks + 8 * g + 4);
                u32x4 wv = (u32x4){pk2(w0[0], w0[1]), pk2(w0[2], w0[3]), pk2(w1[0], w1[1]), pk2(w1[2], w1[3])};
                if (lr != 0) wv = (u32x4){0u, 0u, 0u, 0u};
                const bf16x8 wf = __builtin_bit_cast(bf16x8, wv);
                un[0] = __builtin_amdgcn_mfma_f32_16x16x32_bf16(fa0, wf, un[0], 0, 0, 0); un[1] = __builtin_amdgcn_mfma_f32_16x16x32_bf16(fa1, wf, un[1], 0, 0, 0);
            }
        });
        const float dc = dec[c];
#pragma unroll
        for (int i = 0; i < 2; ++i) { nst[i] = nst[i] * dc + un[i];
#pragma unroll
            for (int j = 0; j < 2; ++j) st[i][j] = st[i][j] * dc + u[i][j]; }
        __syncthreads();
    };
#pragma unroll 1
    for (int c = 0; c < 16; c += 2) { step(c, xa, ya); step(c + 1, xb, yb); }
    float* fo = p.out + (BR == 0 ? O_CP : O_SP) + (((size_t)layer * BP + b) * HM + h) * SZ + (size_t)(32 * sl + lr) * 256 + 32 * w + 4 * g;
#pragma unroll
    for (int rt = 0; rt < 2; ++rt) {
#pragma unroll
        for (int ct = 0; ct < 2; ++ct) *(f32x4*)(fo + (size_t)(16 * ct) * 256 + 16 * rt) = st[rt][ct];
        if (nown) *(f32x4*)(p.out + O_NP + (((size_t)layer * BP + b) * HM + h) * 256 + 32 * w + 4 * g + 16 * rt) = nst[rt];
    }
    if (BR == 0 && sl == 0 && tid == 0) p.out[O_MP + ((size_t)layer * BP + b) * HM + h] = gt[6192];
    __syncthreads();
}

__device__ __forceinline__ void scan_item(const Params& p, int layer, int pi, int slice, LAS unsigned char* lds) {
    LAS float* G = (LAS float*)lds; LAS float* dec = G + 512;
    const int tid = opaque_tid(), br = pi >> 4, bh = pi & 15, b = bh >> 2, h = bh & 3;
    if (br == 0) { const float* gt = p.GT_() + (size_t)bh * 6208; if (tid < 16) { const float mc = gt[6176 + tid]; dec[tid] = expf(mc - fmaxf(mc, gt[6160 + tid])); } if (tid == 0) G[48] = gt[6192]; }
    else if (tid < 16) dec[tid] = expf(128.0f * ret_lg(h));
    __syncthreads();
    float st[2][8];
#pragma unroll
    for (int j = 0; j < 2; ++j)
#pragma unroll
        for (int k = 0; k < 8; ++k) st[j][k] = 0.f;
    for (int c = 0; c < 16; ++c) {
        const float dc = dec[c];
#pragma unroll
        for (int j = 0; j < 2; ++j) { const size_t idx = (size_t)slice * 8192 + j * 4096 + tid * 8;
            float u[8]; unpack8(*(const u32x4*)(p.U_() + ((size_t)pi * 16 + c) * SZ + idx), u);
            *(u32x4*)(p.CS_() + ((size_t)pi * 16 + c) * SZ + idx) = pack8(st[j]);
#pragma unroll
            for (int k = 0; k < 8; ++k) st[j][k] = st[j][k] * dc + u[k]; }
    }
    float* fo = p.out + (br == 0 ? O_CP : O_SP) + (((size_t)layer * BP + b) * HM + h) * SZ;
#pragma unroll
    for (int j = 0; j < 2; ++j) { float* q = fo + (size_t)slice * 8192 + j * 4096 + tid * 8;
        *(f32x4*)q = (f32x4){st[j][0], st[j][1], st[j][2], st[j][3]}; *(f32x4*)(q + 4) = (f32x4){st[j][4], st[j][5], st[j][6], st[j][7]}; }
    if (br == 0 && slice == 0) {
        if (tid < 256) { float n = 0.f;
            for (int c = 0; c < 16; ++c) { p.NS_()[((size_t)bh * 16 + c) * 256 + tid] = n; n = dec[c] * n + p.NU_()[((size_t)bh * 16 + c) * 256 + tid]; }
            p.out[O_NP + (((size_t)layer * BP + b) * HM + h) * 256 + tid] = n; }
        if (tid == 0) p.out[O_MP + ((size_t)layer * BP + b) * HM + h] = G[48];
    }
    __syncthreads();
}

template <int BR>
__device__ __forceinline__ void chunk_passC(const Params& p, int layer, int b, int h, int c, LAS unsigned char* lds) {
    LAS unsigned char* BufB = lds; LAS unsigned char* Sw = lds + 69632; LAS float* G = (LAS float*)(lds + 104448);
    LAS float* av = G + 512; LAS float* fl = G + 640; LAS bf16_t* nbf = (LAS bf16_t*)(G + 768);
    const int tid = opaque_tid(), lane = tid & 63, w = __builtin_amdgcn_readfirstlane(tid >> 6), g = lane >> 4, lr = lane & 15;
    const size_t row0 = (size_t)b * SEQ + c * 128;
    const int pi = BR * 16 + b * 4 + h, l = 16 * w + lr;
    const float lg = ret_lg(h);
    u32x4 tr[8];
    tile_load<32>(tr, BR == 0 ? p.QK_() + row0 * 2048 + h * 512 + 256 : p.P_() + row0 * NP + C_KR + h * 256, BR == 0 ? 2048 : NP, tid);
    if (BR == 0) {
        gate_load(p, b * 4 + h, c, G, tid);
        if (tid < 128) { av[tid] = expf(G[32 + c] - G[320 + tid]); fl[tid] = expf(-(G[64 + tid] + G[320 + tid])); }
        if (tid < 256) nbf[tid] = f2bf(p.NS_()[((size_t)(b * 4 + h) * 16 + c) * 256 + tid]);
    } else { if (tid < 128) av[tid] = expf((float)(tid + 1) * lg); }
    const bf16_t* Qp = BR == 0 ? p.QK_() + (row0 + l) * 2048 + h * 512 : p.P_() + (row0 + l) * NP + C_QR + h * 256;
    bf16x8 qf[8];
#pragma unroll
    for (int ks = 0; ks < 8; ++ks) qf[ks] = *(const bf16x8*)(Qp + 32 * ks + 8 * g);
    tile_store<32, 544>(BufB, tr, tid);
    __syncthreads();
    const bf16_t* CSp = p.CS_() + ((size_t)pi * 16 + c) * SZ;
    if (BR == 0) tile_load<32>(tr, CSp, 256, tid); else tile_load<16>(tr, CSp, 256, tid);
    float rs = 0.f;
    const float Gl = BR == 0 ? G[320 + l] : 0.f;
#pragma unroll
    for (int j = 0; j < 8; ++j) {
        f32x4 a = (f32x4){0.f, 0.f, 0.f, 0.f};
        if (j <= w) {
#pragma unroll
            for (int ks = 0; ks < 8; ++ks) a = __builtin_amdgcn_mfma_f32_16x16x32_bf16(lds_frag(BufB, 16 * j + lr, 544, (32 * ks + 8 * g) * 2), qf[ks], a, 0, 0, 0);
        }
        float v[4];
#pragma unroll
        for (int r = 0; r < 4; ++r) {
            const int sidx = 16 * j + 4 * g + r;
            float d = 0.f;
            if (sidx <= l) d = BR == 0 ? expf(G[192 + sidx] - Gl) : expf((float)(l - sidx) * lg);
            v[r] = a[r] * d; rs += v[r];
        }
        *(LAS u32x2*)(Sw + l * 272 + (16 * j + 4 * g) * 2) = (u32x2){pk2(v[0], v[1]), pk2(v[2], v[3])};
        __builtin_amdgcn_sched_barrier(0);
    }
    rs += __shfl_xor(rs, 16); rs += __shfl_xor(rs, 32);
    __syncthreads();
    f32x4 accN[16];
#pragma unroll
    for (int t = 0; t < 16; ++t) accN[t] = (f32x4){0.f, 0.f, 0.f, 0.f};
    const unsigned lq = (unsigned)(8 * g + (lr >> 2)), lp4 = (unsigned)(4 * (lr & 3));
    sfor<0, 2>([&](auto half_) {
        constexpr int half = decltype(half_)::value;
        if (BR == 0) tile_store<32, 544>(BufB, tr, tid); else tile_store<16, 272>(BufB, tr, tid);
        __syncthreads();
        if (half == 0) { if (BR == 0) tile_load<32>(tr, CSp + 128 * 256, 256, tid); else tile_load<16>(tr, CSp + 128, 256, tid); }
        else tile_load<32>(tr, p.P_() + row0 * NP + (BR == 0 ? C_VM : C_VR) + h * 256, NP, tid);
        if (BR == 0) {
#pragma unroll
            for (int t = 0; t < 8; ++t) {
#pragma unroll
                for (int ks = 0; ks < 8; ++ks)
                    accN[half * 8 + t] = __builtin_amdgcn_mfma_f32_16x16x32_bf16(lds_frag(BufB, 16 * t + lr, 544, (32 * ks + 8 * g) * 2), qf[ks], accN[half * 8 + t], 0, 0, 0);
                __builtin_amdgcn_sched_barrier(0); }
        } else {
            const unsigned base = lds_addr(BufB) + (lq * 136 + lp4) * 2;
            sfor<0, 8>([&](auto ks_) {
                constexpr int ks = decltype(ks_)::value;
                sfor<0, 2>([&](auto tq_) {
                    constexpr int tq = decltype(tq_)::value;
                    bf16x8 f[4];
                    tr_frag4<ks * 32 * 272 + tq * 128, 4 * 272, 32>(base, f);
#pragma unroll
                    for (int i = 0; i < 4; ++i) accN[half * 8 + 4 * tq + i] = __builtin_amdgcn_mfma_f32_16x16x32_bf16(f[i], qf[ks], accN[half * 8 + 4 * tq + i], 0, 0, 0);
                });
            });
        }
        __syncthreads();
    });
    float nq = 0.f;
    if (BR == 0) {
        f32x4 ad = (f32x4){0.f, 0.f, 0.f, 0.f};
#pragma unroll
        for (int ks = 0; ks < 8; ++ks) {
            bf16x8 nf = *(LAS const bf16x8*)(nbf + 32 * ks + 8 * g);
            if (lr != 0) nf = (bf16x8){0, 0, 0, 0, 0, 0, 0, 0};
            ad = __builtin_amdgcn_mfma_f32_16x16x32_bf16(nf, qf[ks], ad, 0, 0, 0);
        }
        nq = __shfl(ad[0], lr);
    }
    const float al = av[l];
#pragma unroll
    for (int t = 0; t < 16; ++t) accN[t] *= al;
    tile_store<32, 544>(BufB, tr, tid);
    __syncthreads();
    {
        const unsigned base = lds_addr(BufB) + (lq * 272 + lp4) * 2;
        sfor<0, 4>([&](auto ks_) {
            constexpr int ks = decltype(ks_)::value;
            const bf16x8 bfr = lds_frag(Sw, l, 272, (32 * ks + 8 * g) * 2);
            sfor<0, 4>([&](auto tq_) {
                constexpr int tq = decltype(tq_)::value;
                bf16x8 f[4];
                tr_frag4<ks * 32 * 544 + tq * 128, 4 * 544, 32>(base, f);
#pragma unroll
                for (int i = 0; i < 4; ++i) accN[4 * tq + i] = __builtin_amdgcn_mfma_f32_16x16x32_bf16(f[i], bfr, accN[4 * tq + i], 0, 0, 0);
            });
        });
    }
    float inv = 1.0f;
    if (BR == 0) inv = 1.0f / fmaxf(fabsf(rs + al * nq), fl[l]);
    float sm = 0.f;
#pragma unroll
    for (int t = 0; t < 16; ++t) { accN[t] *= inv; sm += (accN[t][0] + accN[t][1]) + (accN[t][2] + accN[t][3]); }
    sm += __shfl_xor(sm, 16); sm += __shfl_xor(sm, 32);
    const float mu = sm * (1.0f / 256.0f);
    float qv = 0.f;
#pragma unroll
    for (int t = 0; t < 16; ++t) { const f32x4 d = accN[t] - mu; qv += (d[0] * d[0] + d[1] * d[1]) + (d[2] * d[2] + d[3] * d[3]); }
    qv += __shfl_xor(qv, 16); qv += __shfl_xor(qv, 32);
    const float rstd = rsqrtf(qv * (1.0f / 256.0f) + EPS);
    const float* gain = (BR == 0 ? p.hn_m_g : p.hn_r_g) + (size_t)layer * WM + h * 256 + 4 * g;
    const float* skip = p.skip_m + (size_t)layer * WM + h * 256 + 4 * g;
    const size_t row = row0 + l;
    const bf16_t* zp = p.P_() + row * NP + (BR == 0 ? C_ZM : C_ZR) + h * 256 + 4 * g;
    const bf16_t* cp = p.CM_() + row * WM + h * 256 + 4 * g;
    bf16_t* op = p.OC_() + row * 2048 + BR * 1024 + h * 256 + 4 * g;
#pragma unroll
    for (int t = 0; t < 16; ++t) {
        const f32x4 ge = *(const f32x4*)(gain + 16 * t);
        const u32x2 zb = *(const u32x2*)(zp + 16 * t);
        f32x4 v = (accN[t] - mu) * rstd * ge;
        if (BR == 0) { const f32x4 sk = *(const f32x4*)(skip + 16 * t); const u32x2 cb = *(const u32x2*)(cp + 16 * t);
            v[0] += sk[0] * __uint_as_float(cb.x << 16); v[1] += sk[1] * __uint_as_float(cb.x & 0xffff0000u);
            v[2] += sk[2] * __uint_as_float(cb.y << 16); v[3] += sk[3] * __uint_as_float(cb.y & 0xffff0000u); }
        const float z0 = __uint_as_float(zb.x << 16), z1 = __uint_as_float(zb.x & 0xffff0000u), z2 = __uint_as_float(zb.y << 16), z3 = __uint_as_float(zb.y & 0xffff0000u);
        *(u32x2*)(op + 16 * t) = (u32x2){pk2(v[0] * siluf_(z0), v[1] * siluf_(z1)), pk2(v[2] * siluf_(z2), v[3] * siluf_(z3))};
    }
    __syncthreads();
}

__device__ __forceinline__ f32x4 bf4_to_f32(u32x2 v) { return (f32x4){__uint_as_float(v.x << 16), __uint_as_float(v.x & 0xffff0000u), __uint_as_float(v.y << 16), __uint_as_float(v.y & 0xffff0000u)}; }
__device__ __forceinline__ const char* sample_state(const Params& p, int layer, int s) {
    const int br = s >> 9, b = (s >> 2) & 127, h = s & 3;
    return (const char*)((br == 0 ? p.st_C : p.st_S) + (((size_t)layer * BS + b) * HM + h) * SZ);
}
template <int BR>
__device__ __forceinline__ void sample_item(const Params& p, int layer, int b, int h, LAS float* base, const f32x4 (&cin)[8], f32x4 (&cnx)[8], const char* nsrc) {
    LAS float* sq = base; LAS float* sk = sq + 256; LAS float* sv = sk + 256; LAS float* sr = sv + 256; LAS float* part = sr + 256;
    const int tid = opaque_tid(), lane = tid & 63, wid = __builtin_amdgcn_readfirstlane(tid >> 6), e0 = 4 * lane;
    const size_t R = (size_t)MP + b;
    const size_t sidx = ((size_t)layer * BS + b) * HM + h;
    const bf16_t* qg = BR == 0 ? p.QK_() + R * 2048 + h * 512 : p.P_() + R * NP + C_QR + h * 256;
    const bf16_t* kg = BR == 0 ? p.QK_() + R * 2048 + h * 512 + 256 : p.P_() + R * NP + C_KR + h * 256;
    const bf16_t* vg = p.P_() + R * NP + (BR == 0 ? C_VM : C_VR) + h * 256;
    if (tid < 256) { sq[tid] = bf2f(qg[tid]); sk[tid] = bf2f(kg[tid]); sv[tid] = bf2f(vg[tid]); }
    const f32x4 q4 = bf4_to_f32(*(const u32x2*)(qg + e0)), k4 = bf4_to_f32(*(const u32x2*)(kg + e0)), v4 = bf4_to_f32(*(const u32x2*)(vg + e0));
    float wgt = 1.f, a = 1.0f - exp2f(-5.0f - (float)h), mt = 0.f;
    if (BR == 0) {
        const float ig = p.IF_()[R * 8 + h] + p.b_i[layer * HM + h];
        const float lf = logsigf_(p.IF_()[R * 8 + 4 + h] + p.b_f[layer * HM + h]);
        const float inter = lf + p.st_m[sidx];
        mt = fmaxf(inter, ig); wgt = expf(ig - mt); a = expf(inter - mt);
    }
    const char* sb = sample_state(p, layer, (BR << 9) | (b << 2) | h) + (size_t)wid * 1024 + (unsigned)lane * 16u;
    char* ob = (char*)(p.out + (BR == 0 ? O_CS : O_SS) + sidx * SZ) + (size_t)wid * 1024 + (unsigned)lane * 16u;
    __syncthreads();
    f32x4 cc[8], cn[8];
#pragma unroll
    for (int j = 0; j < 8; ++j) cc[j] = cin[j];
    f32x4 ac = (f32x4){0.f, 0.f, 0.f, 0.f};
#pragma unroll
    for (int i0 = 0; i0 < 32; i0 += 8) {
        if (i0 + 8 < 32) {
#pragma unroll
            for (int j = 0; j < 8; ++j) cn[j] = __builtin_nontemporal_load((const f32x4*)(sb + (size_t)(i0 + 8 + j) * 8192));
        } else if (nsrc) {
            const char* nb = nsrc + (size_t)wid * 1024 + (unsigned)lane * 16u;
#pragma unroll
            for (int j = 0; j < 8; ++j) cnx[j] = __builtin_nontemporal_load((const f32x4*)(nb + (size_t)j * 8192));
        }
#pragma unroll
        for (int j = 0; j < 8; ++j) { const int e = wid + 8 * (i0 + j);
            if (BR == 0) {
                float pt = (cc[j][0] * q4[0] + cc[j][1] * q4[1]) + (cc[j][2] * q4[2] + cc[j][3] * q4[3]);
                __builtin_nontemporal_store(cc[j] * a + k4 * (wgt * sv[e]), (f32x4*)(ob + (size_t)(i0 + j) * 8192));
                pt = wave_sum(pt);
                if (lane == 0) sr[e] = pt;
            } else {
                ac = ac + cc[j] * sq[e];
                __builtin_nontemporal_store(cc[j] * a + v4 * sk[e], (f32x4*)(ob + (size_t)(i0 + j) * 8192));
            }
        }
        if (i0 + 8 < 32) {
#pragma unroll
            for (int j = 0; j < 8; ++j) cc[j] = cn[j];
        }
    }
    if (BR == 1) *(LAS f32x4*)(part + wid * 256 + e0) = ac;
    __syncthreads();
    if (wid == 0) {
        f32x4 hv;
        if (BR == 0) {
            const f32x4 n4 = *(const f32x4*)(p.st_n + sidx * 256 + e0);
            const f32x4 cq = *(LAS const f32x4*)(sr + e0);
            const float qk = wave_sum((q4[0] * k4[0] + q4[1] * k4[1]) + (q4[2] * k4[2] + q4[3] * k4[3]));
            const float nq = wave_sum((n4[0] * q4[0] + n4[1] * q4[1]) + (n4[2] * q4[2] + n4[3] * q4[3]));
            const float ws = wgt * qk, inv = 1.0f / fmaxf(fabsf(ws + a * nq), expf(-mt));
            hv = (v4 * ws + cq * a) * inv;
            *(f32x4*)(p.out + O_NS + sidx * 256 + e0) = n4 * a + k4 * wgt;
            if (lane == 0) p.out[O_MS + sidx] = mt;
        } else {
            f32x4 oi = (f32x4){0.f, 0.f, 0.f, 0.f};
#pragma unroll
            for (int i = 0; i < 8; ++i) oi = oi + *(LAS const f32x4*)(part + i * 256 + e0);
            const float qk = wave_sum((q4[0] * k4[0] + q4[1] * k4[1]) + (q4[2] * k4[2] + q4[3] * k4[3]));
            hv = v4 * qk + oi * a;
        }
        const float mean = wave_sum((hv[0] + hv[1]) + (hv[2] + hv[3])) * (1.0f / 256.0f);
        const f32x4 dv = hv - mean;
        const float rstd = rsqrtf(wave_sum((dv[0] * dv[0] + dv[1] * dv[1]) + (dv[2] * dv[2] + dv[3] * dv[3])) * (1.0f / 256.0f) + EPS);
        const f32x4 ge = *(const f32x4*)((BR == 0 ? p.hn_m_g : p.hn_r_g) + (size_t)layer * WM + h * 256 + e0);
        f32x4 v = dv * rstd * ge;
        const f32x4 z = bf4_to_f32(*(const u32x2*)(p.P_() + R * NP + (BR == 0 ? C_ZM : C_ZR) + h * 256 + e0));
        if (BR == 0) v = v + *(const f32x4*)(p.skip_m + (size_t)layer * WM + h * 256 + e0) * bf4_to_f32(*(const u32x2*)(p.CM_() + R * WM + h * 256 + e0));
        *(u32x2*)(p.OC_() + R * 2048 + BR * 1024 + h * 256 + e0) = (u32x2){pk2(v[0] * siluf_(z[0]), v[1] * siluf_(z[1])), pk2(v[2] * siluf_(z[2]), v[3] * siluf_(z[3]))};
    }
    __syncthreads();
}

template <int MODE>
__device__ __forceinline__ void sample_gemm(const Params& p, const bf16_t* Wl, int wg, int nwg, LAS unsigned char* lds, unsigned long long* ssn) {
    const int tid = opaque_tid(), lane = tid & 63, w = tid >> 6, g = lane >> 4, lr = lane & 15, hf = w >> 2;
    LAS f32x4* xch = (LAS f32x4*)lds;
    LAS float* red = (LAS float*)(lds + 4096);
    for (int j = wg; j < 256; j += nwg) {
        const int rbase = MP + 32 * (j & 3) + 16 * ((w >> 1) & 1), cbase = 32 * (j >> 2) + 16 * (w & 1);
        const bf16_t* A = (MODE == 0 ? p.OC_() : p.MG_()) + (size_t)(rbase + lr) * 2048 + hf * 1024 + 8 * g;
        const bf16_t* B = Wl + (MODE == 0 ? W3_OFF : W4_OFF) + (size_t)(cbase + lr) * 2048 + hf * 1024 + 8 * g;
        f32x4 acc = (f32x4){0.f, 0.f, 0.f, 0.f};
#pragma unroll 1
        for (int k0 = 0; k0 < 1024; k0 += 512) {
            bf16x8 af[16], bf[16];
#pragma unroll
            for (int i = 0; i < 16; ++i) { af[i] = *(const bf16x8*)(A + k0 + 32 * i); bf[i] = *(const bf16x8*)(B + k0 + 32 * i); }
#pragma unroll
            for (int i = 0; i < 16; ++i) acc = __builtin_amdgcn_mfma_f32_16x16x32_bf16(af[i], bf[i], acc, 0, 0, 0);
        }
        if (hf == 1) xch[(w & 3) * 64 + lane] = acc;
        __syncthreads();
        if (hf == 0) {
            const f32x4 hi = xch[(w & 3) * 64 + lane];
            const int col = cbase + lr;
#pragma unroll
            for (int r = 0; r < 4; ++r) {
                const size_t row = (size_t)rbase + 4 * g + r;
                if (MODE == 0) {
                    const float rt = bf2f(p.RT_()[row * 2048 + col]), gr = bf2f(p.GRS_()[row * 2048 + col]);
                    p.MG_()[row * 2048 + col] = f2bf(gr * (rt * acc[r] + hi[r]));
                } else {
                    const bf16_t nb = f2bf(bf2f(p.Xb_()[row * 2048 + col]) + acc[r] + hi[r]);
                    p.Xb_()[row * 2048 + col] = nb;
                    float q = bf2f(nb) * bf2f(nb);
                    q += __shfl_xor(q, 1); q += __shfl_xor(q, 2); q += __shfl_xor(q, 4); q += __shfl_xor(q, 8);
                    if (lr == 0) red[(w & 1) * 32 + 16 * ((w >> 1) & 1) + 4 * g + r] = q;
                }
            }
        }
        if (MODE == 1) {
            __syncthreads();
            if (tid < 32) atomicAdd(ssn + MP + 32 * (j & 3) + tid, ss_fix(red[tid] + red[32 + tid]));
        }
        __syncthreads();
    }
}

__device__ __forceinline__ void sample_gemm2(const Params& p, const bf16_t* W2t, int wg, int nwg) {
    const int tid = opaque_tid(), lane = tid & 63, w = tid >> 6, g = lane >> 4, lr = lane & 15;
    for (int j = wg; j < 128; j += nwg) {
        const int rbase = MP + 16 * (j & 7), cbase = 128 * (j >> 3) + 16 * w, head = cbase >> 9;
        const bf16_t* A = p.CM_() + (size_t)(rbase + lr) * WM + head * 256 + 8 * g;
        const bf16_t* B = W2t + (size_t)(cbase + lr) * 256 + 8 * g;
        bf16x8 af[8], bf[8];
#pragma unroll
        for (int i = 0; i < 8; ++i) { af[i] = *(const bf16x8*)(A + 32 * i); bf[i] = *(const bf16x8*)(B + 32 * i); }
        f32x4 acc = (f32x4){0.f, 0.f, 0.f, 0.f};
#pragma unroll
        for (int i = 0; i < 8; ++i) acc = __builtin_amdgcn_mfma_f32_16x16x32_bf16(af[i], bf[i], acc, 0, 0, 0);
#pragma unroll
        for (int r = 0; r < 4; ++r) p.QK_()[(size_t)(rbase + 4 * g + r) * 2048 + cbase + lr] = f2bf(acc[r]);
    }
}

__device__ __forceinline__ void phaseA(const Params& p, int layer, int wg, int nwg, LAS unsigned char* lds) {
    for (int it = wg; it < 256; it += nwg) {
        const int pi = (it & 7) * 4 + (it >> 6), sl = (it >> 3) & 7, bh = pi & 15;
        if (pi < 16) chunk_state_item<0>(p, layer, bh >> 2, bh & 3, sl, lds); else chunk_state_item<1>(p, layer, bh >> 2, bh & 3, sl, lds);
    }
    {
        const int tid = opaque_tid(), lane = tid & 63, wid = __builtin_amdgcn_readfirstlane(tid >> 6);
        int s = wg, k = 0;
        if (s < 1024) {
            f32x4 cc[8], cx[8];
            { const char* sb = sample_state(p, layer, s) + (size_t)wid * 1024 + (unsigned)lane * 16u;
#pragma unroll
              for (int j = 0; j < 8; ++j) cc[j] = __builtin_nontemporal_load((const f32x4*)(sb + (size_t)j * 8192)); }
            for (;; ++k) {
                const int sn = s + nwg;
                const char* nsrc = sn < 1024 ? sample_state(p, layer, sn) : nullptr;
                LAS float* base = (LAS float*)lds + (k & 1) * 3072;
                const int b = (s >> 2) & 127, h = s & 3;
                if (s < 512) sample_item<0>(p, layer, b, h, base, cc, cx, nsrc); else sample_item<1>(p, layer, b, h, base, cc, cx, nsrc);
                if (sn >= 1024) break;
#pragma unroll
                for (int j = 0; j < 8; ++j) cc[j] = cx[j];
                s = sn;
            }
        }
        __syncthreads();
    }
}
__device__ __forceinline__ void phaseScan(const Params& p, int layer, int wg, int nwg, LAS unsigned char* lds) {
    for (int it = wg; it < 256; it += nwg) scan_item(p, layer, it >> 3, it & 7, lds);
}
__device__ __forceinline__ void phaseC(const Params& p, int layer, int wg, int nwg, LAS unsigned char* lds) {
    for (int it = wg; it < 512; it += nwg) {
        const int br = it >> 8, rest = it & 255, b = rest >> 6, h = (rest >> 4) & 3, c = rest & 15;
        if (br == 0) chunk_passC<0>(p, layer, b, h, c, lds); else chunk_passC<1>(p, layer, b, h, c, lds);
    }
}

template <int ONLY>
__device__ __forceinline__ void run_phases(const Params& p_in, int ph_lo, int ph_hi) {
    extern __shared__ __attribute__((aligned(16))) unsigned char smem_raw[];
    LAS unsigned char* lds = (LAS unsigned char*)smem_raw;
    volatile LAS unsigned* xbw = (volatile LAS unsigned*)(lds + LDS_BYTES - 16);
    const int wg_in = blockIdx.x, nwg = gridDim.x;
    const bool multi = (ph_hi - ph_lo) > 1;
    XcdBarrier bar; bar.bar = p_in.bar_(); bar.x = 0; bar.st = xbw;
    if (multi) {
        if (threadIdx.x == 0) { xbw[0] = 0u; xbw[1] = 0u; xbw[2] = 0u; xbw[3] = 0u; }
        __syncthreads();
        bar = xcd_barrier_post(p_in.bar_(), xbw);
    }
    int ph = 0; unsigned long long tacc_ = 0;
#define PHASE(KIND, ...) { if constexpr (ONLY < 0 || ONLY == KIND) { if (ph >= ph_lo && ph < ph_hi) { \
    unsigned long long t0_ = 0; if (KIND == TIMEK) t0_ = __builtin_amdgcn_s_memrealtime(); \
    Params p = p_in; int wg = wg_in; { size_t z_ = 0; asm volatile("" : "+s"(z_), "+s"(wg)); p.ws = p_in.ws + z_; p.out = p_in.out + z_; }     \
    __VA_ARGS__; if (ph + 1 < ph_hi) xcd_barrier(bar); \
    if (KIND == TIMEK) tacc_ += __builtin_amdgcn_s_memrealtime() - t0_; } } ++ph; }
    PHASE(0, prep_phase(p, wg, nwg, lds))
    for (int layer = 0; layer < DEPTH; ++layer) {
        PHASE(2, { pg8::StaticOrder S; S.init(MPAD, N1, nwg, wg); pg8::Gemm g{p.Xb_(), p.W_() + (size_t)layer * WL + W1_OFF, D, D, D, 31, 0, 0};
                pg8::EpiG1 E{p.P_(), p.b_gate + (size_t)layer * 4096, p.RT_(), p.GRS_(), p.ROPE_(), p.SS_() + (size_t)layer * MPAD, p.SSP_(), p.IF_()}; pg8::gemm_phase<false>(lds, g, S, E); })
        PHASE(3, conv_phase(p, layer, wg, nwg, lds))
        PHASE(4, { pg8::StaticOrder S; S.init(MP, 2048, nwg, wg); pg8::Gemm g{p.CM_(), p.W_() + (size_t)layer * WL + W2_OFF, 256, WM, 256, 1, 512, 0};
                pg8::EpiBf16 E{p.QK_(), 2048}; pg8::gemm_phase<false>(lds, g, S, E); sample_gemm2(p, p.W_() + (size_t)layer * WL + W2_OFF, wg, nwg); })
        PHASE(5, phaseA(p, layer, wg, nwg, lds))
        PHASE(7, phaseC(p, layer, wg, nwg, lds))
        PHASE(8, { pg8::StaticOrder S; S.init(MP, 2048, nwg, wg); pg8::Gemm g{p.OC_(), p.W_() + (size_t)layer * WL + W3_OFF, 2048, 2048, 2048, 31, 0, 16};
                pg8::EpiMerged E{p.MG_(), p.RT_(), p.GRS_()}; pg8::gemm_phase<true>(lds, g, S, E); sample_gemm<0>(p, p.W_() + (size_t)layer * WL, wg, nwg, lds, nullptr); })
        PHASE(10, { pg8::StaticOrder S; S.init(MP, 2048, nwg, wg); pg8::Gemm g{p.MG_(), p.W_() + (size_t)layer * WL + W4_OFF, 2048, 2048, 2048, 31, 0, 0};
                pg8::EpiResidual E{p.Xb_(), p.SSP_(), (LAS float*)(lds + pg8::STAGE_BYTES)}; pg8::gemm_phase<false>(lds, g, S, E); sample_gemm<1>(p, p.W_() + (size_t)layer * WL, wg, nwg, lds, p.SS_() + (size_t)(layer + 1) * MPAD); })
    }
    PHASE(11, final_phase(p, wg, nwg))
    if (TIMEK >= 0 && blockIdx.x == 0) { const unsigned long long te_ = __builtin_amdgcn_s_memrealtime(); while (__builtin_amdgcn_s_memrealtime() - te_ < TIMEX * tacc_) __builtin_amdgcn_s_sleep(8); }
#undef PHASE
}
__global__ void __launch_bounds__(512, 2) mega(Params p, int ph_lo, int ph_hi) { run_phases<-1>(p, ph_lo, ph_hi); }
#ifdef DIAG
template <int K> __global__ void __launch_bounds__(512, 2) mega_k(Params p, int ph_lo, int ph_hi) { run_phases<K>(p, ph_lo, ph_hi); }
template __global__ void mega_k<0>(Params, int, int); template __global__ void mega_k<2>(Params, int, int);
template __global__ void mega_k<3>(Params, int, int); template __global__ void mega_k<4>(Params, int, int); template __global__ void mega_k<5>(Params, int, int);
template __global__ void mega_k<7>(Params, int, int); template __global__ void mega_k<8>(Params, int, int);
template __global__ void mega_k<10>(Params, int, int); template __global__ void mega_k<11>(Params, int, int);
#endif
constexpr int N_PHASES = 2 + DEPTH * 7;

extern "C" void kernel_launch(void* const* d_in, const int* in_sizes, int n_in, void* d_out, int out_size, void* d_ws, size_t ws_size, hipStream_t stream) {
    (void)in_sizes; (void)n_in; (void)out_size; (void)ws_size;
    static int grid = 0;
    if (grid == 0) {
        int dev = 0, cus = 0;
        hipGetDevice(&dev);
        hipDeviceGetAttribute(&cus, hipDeviceAttributeMultiprocessorCount, dev);
        if (hipFuncSetAttribute((const void*)mega, hipFuncAttributeMaxDynamicSharedMemorySize, LDS_BYTES) != hipSuccess) fprintf(stderr, "hipFuncSetAttribute failed\n");
        (void)hipGetLastError();
        grid = cus > 0 ? cus : 256;
    }
    Params p{};
    const float** in = (const float**)&p;
    for (int i = 0; i < 24; ++i) in[i] = (const float*)d_in[i];
    p.out = (float*)d_out;
    p.ws = (unsigned char*)d_ws;
    if (ws_size < WS_END) { fprintf(stderr, "workspace too small: %zu < %zu\n", ws_size, (size_t)WS_END); return; }
    hipMemsetAsync(d_ws, 0, 16384, stream);
#if MK_SINGLE
    hipLaunchKernelGGL(mega, dim3(grid), dim3(512), LDS_BYTES, stream, p, 0, N_PHASES);
#else
    for (int ph = 0; ph < N_PHASES; ++ph) hipLaunchKernelGGL(mega, dim3(grid), dim3(512), LDS_BYTES, stream, p, ph, ph + 1);
#endif
}
```

```cpp
#include <hip/hip_runtime.h>
#include <stdint.h>
#include <stdio.h>

#ifndef TIMEK
#define TIMEK -1
#define TIMEX 10
#endif
#ifndef MK_SINGLE
#define MK_SINGLE 1
#endif

#define LAS __attribute__((address_space(3)))
typedef unsigned short bf16_t;
typedef short bf16x8 __attribute__((ext_vector_type(8)));
typedef float f32x4 __attribute__((ext_vector_type(4)));
typedef unsigned u32x4 __attribute__((ext_vector_type(4)));
typedef unsigned u32x2 __attribute__((ext_vector_type(2)));
typedef float f32x2_t __attribute__((ext_vector_type(2)));

constexpr int D = 2048, SEQ = 2048, BP = 4, BS = 128, DEPTH = 4, HM = 4, DH = 256, WM = 1024, NIN = 7176;
constexpr int MP = BP * SEQ, MT = MP + BS, MPAD = 8448;
constexpr int NP = 7168;
constexpr int N1 = 11520;
constexpr int C_U = 0, C_VM = 1024, C_ZM = 2048, C_QR = 3072, C_KR = 4096, C_VR = 5120, C_ZR = 6144, C_GM = 7168, C_GR = 9216;
constexpr float EPS = 1e-6f;
constexpr size_t SZ = 65536;
constexpr size_t O_YP = 0, O_YS = O_YP + 16777216, O_CP = O_YS + 262144, O_NP = O_CP + 4194304, O_MP = O_NP + 16384, O_CVP = O_MP + 64,
                 O_SP = O_CVP + 49152, O_CS = O_SP + 4194304, O_NS = O_CS + 134217728, O_MS = O_NS + 524288, O_CVS = O_MS + 2048, O_SS = O_CVS + 1572864;
constexpr size_t W1_OFF = 0, W2_OFF = W1_OFF + (size_t)N1 * D, W3_OFF = W2_OFF + (size_t)2048 * 256, W4_OFF = W3_OFF + (size_t)D * D, WL = W4_OFF + (size_t)D * D;
constexpr int LDS_BYTES = 147456;

constexpr size_t al256(size_t x) { return (x + 255) & ~(size_t)255; }
constexpr size_t OFF_BAR = 0, OFF_SS = OFF_BAR + 16384, OFF_SSP = OFF_SS + al256((size_t)5 * MPAD * 8), OFF_XB = OFF_SSP + al256((size_t)8 * MP * 4),
    OFF_P = OFF_XB + al256((size_t)MPAD * D * 2), OFF_IF = OFF_P + al256((size_t)MPAD * NP * 2), OFF_CM = OFF_IF + al256((size_t)MPAD * 8 * 4),
    OFF_QK = OFF_CM + al256((size_t)MPAD * WM * 2), OFF_OC = OFF_QK + al256((size_t)MPAD * 2048 * 2), OFF_MG = OFF_OC + al256((size_t)MPAD * 2048 * 2),
    OFF_U = OFF_MG + al256((size_t)MPAD * 2048 * 2), OFF_CS = OFF_U + al256((size_t)32 * 16 * SZ * 2), OFF_NU = OFF_CS + al256((size_t)32 * 16 * SZ * 2),
    OFF_NS = OFF_NU + al256((size_t)16 * 16 * 256 * 4), OFF_W = OFF_NS + al256((size_t)16 * 16 * 256 * 4), OFF_ROPE = OFF_W + al256((size_t)DEPTH * WL * 2),
    OFF_RT = OFF_ROPE + al256((size_t)2049 * 128 * 2 * 4), OFF_GRS = OFF_RT + al256((size_t)MPAD * 2048 * 2), OFF_GT = OFF_GRS + al256((size_t)MPAD * 2048 * 2),
    WS_END = OFF_GT + al256((size_t)16 * 6208 * 4);

struct Params {
    const float *x_prompt, *x_sample, *st_C, *st_n, *st_m, *st_conv, *st_S, *norm_g, *w_in, *conv_w, *conv_b, *w_qm, *w_km, *b_i, *b_f,
                *hn_m_g, *skip_m, *hn_r_g, *w_pm, *w_pr, *w_gate, *b_gate, *w_o, *final_g;
    float* out;
    unsigned char* ws;
#define WSF(name, type, off) __device__ __forceinline__ type* name##_() const { return (type*)(ws + (off)); }
    WSF(bar, unsigned, OFF_BAR) WSF(SS, unsigned long long, OFF_SS) WSF(SSP, float, OFF_SSP) WSF(Xb, bf16_t, OFF_XB) WSF(P, bf16_t, OFF_P) WSF(IF, float, OFF_IF)
    WSF(CM, bf16_t, OFF_CM) WSF(QK, bf16_t, OFF_QK) WSF(OC, bf16_t, OFF_OC) WSF(MG, bf16_t, OFF_MG) WSF(U, bf16_t, OFF_U) WSF(CS, bf16_t, OFF_CS)
    WSF(NU, float, OFF_NU) WSF(NS, float, OFF_NS) WSF(W, bf16_t, OFF_W) WSF(ROPE, float, OFF_ROPE) WSF(RT, bf16_t, OFF_RT) WSF(GRS, bf16_t, OFF_GRS) WSF(GT, float, OFF_GT)
#undef WSF
};


__device__ __forceinline__ unsigned long long ss_fix(float v) { return (unsigned long long)(v * 1048576.0f + 0.5f); }
__device__ __forceinline__ float ss_val(unsigned long long v) { return (float)v * (1.0f / 1048576.0f); }
__device__ __forceinline__ float row_ss(const float* ssp, const unsigned long long* ss, int row) {
    if (row < 8192) { const f32x4 a = *(const f32x4*)(ssp + (size_t)row * 8), b = *(const f32x4*)(ssp + (size_t)row * 8 + 4);
        return ((a[0] + a[1]) + (a[2] + a[3])) + ((b[0] + b[1]) + (b[2] + b[3])); }
    return ss_val(ss[row]);
}
__device__ __forceinline__ int opaque_tid() { int t = threadIdx.x; asm volatile("" : "+v"(t)); return t; }
__device__ __forceinline__ float bf2f(bf16_t v) { return __uint_as_float((unsigned)v << 16); }
__device__ __forceinline__ bf16_t f2bf(float f) { unsigned u = __float_as_uint(f); u += 0x7fffu + ((u >> 16) & 1u); return (bf16_t)(u >> 16); }
__device__ __forceinline__ unsigned pk2(float lo, float hi) { return (unsigned)f2bf(lo) | ((unsigned)f2bf(hi) << 16); }
__device__ __forceinline__ float wave_sum(float v) {
#pragma unroll
    for (int o = 32; o >= 1; o >>= 1) v += __shfl_xor(v, o);
    return v;
}
__device__ __forceinline__ float wave_max(float v) {
#pragma unroll
    for (int o = 32; o >= 1; o >>= 1) v = fmaxf(v, __shfl_xor(v, o));
    return v;
}
__device__ __forceinline__ float sigmoidf_(float x) { return __builtin_amdgcn_rcpf(1.0f + __expf(-x)); }
__device__ __forceinline__ float siluf_(float x) { return x * __builtin_amdgcn_rcpf(1.0f + __expf(-x)); }
__device__ __forceinline__ float logsigf_(float x) { return x < 0.f ? x - log1pf(expf(x)) : -log1pf(expf(-x)); }
__device__ __forceinline__ void block_sum2(float& a, float& b, LAS float* red) {
    a = wave_sum(a); b = wave_sum(b);
    __syncthreads();
    if ((threadIdx.x & 63) == 0) { red[threadIdx.x >> 6] = a; red[8 + (threadIdx.x >> 6)] = b; }
    __syncthreads();
    float sa = 0.f, sb = 0.f;
#pragma unroll
    for (int i = 0; i < 8; ++i) { sa += red[i]; sb += red[8 + i]; }
    a = sa; b = sb;
}

#define XB_TMO      128
#define XB_XCNT(j)  (256  + 64 * (j))
#define XB_XSUB(j)  (1280 + 64 * (j))
#define XB_XGEN(j)  (2304 + 64 * (j))
#define XB_TOP      3328
#define XB_TOPGEN   3392
#define XCD_BAR_WORDS 3456
#define XB_SPIN_CAP (1u << 22)

__device__ __forceinline__ unsigned xb_ld(unsigned* p)              { return __hip_atomic_load(p, __ATOMIC_RELAXED, __HIP_MEMORY_SCOPE_AGENT); }
__device__ __forceinline__ unsigned xb_add(unsigned* p, unsigned v) { return __hip_atomic_fetch_add(p, v, __ATOMIC_RELAXED, __HIP_MEMORY_SCOPE_AGENT); }
__device__ __forceinline__ unsigned xb_xcc_id() { return (unsigned)__builtin_amdgcn_s_getreg((3 << 11) | 20) & 0xFu; }
#define XB_SPIN(cond, bar) do { unsigned _sp = 0; while (cond) { __builtin_amdgcn_s_sleep(1); \
    if ((++_sp & 255u) == 0u) { if (xb_ld(&(bar)[XB_TMO])) break; if (_sp > XB_SPIN_CAP) { atomicAdd(&(bar)[XB_TMO], 1u); break; } } } } while (0)

struct XcdBarrier { unsigned* bar; unsigned x; volatile LAS unsigned* st; };

__device__ __forceinline__ XcdBarrier xcd_barrier_post(unsigned* bar, volatile LAS unsigned* st) {
    XcdBarrier b; b.bar = bar; b.x = xb_xcc_id(); b.st = st;
    if (threadIdx.x == 0) (void)xb_add(&bar[XB_XCNT(b.x)], 1u);
    return b;
}
__device__ __forceinline__ void xcd_barrier_complete(unsigned* bar, unsigned x, unsigned& nloc, unsigned& nx) {
    const unsigned G = gridDim.x * gridDim.y * gridDim.z;
    unsigned sum, cnt, mine, sp = 0u;
    for (;;) {
        sum = 0u; cnt = 0u; mine = 0u;
#pragma unroll
        for (unsigned j = 0; j < 16; ++j) { const unsigned c = xb_ld(&bar[XB_XCNT(j)]); sum += c; cnt += (c > 0u) ? 1u : 0u; mine = (j == x) ? c : mine; }
        if (sum == G) break;
        __builtin_amdgcn_s_sleep(1);
        if ((++sp & 255u) == 0u) { if (xb_ld(&bar[XB_TMO])) break; if (sp > XB_SPIN_CAP) { atomicAdd(&bar[XB_TMO], 1u); break; } }
    }
    nloc = mine > 0u ? mine : 1u; nx = cnt > 0u ? cnt : 1u;
}
__device__ __forceinline__ void xcd_barrier(const XcdBarrier& b) {
    asm volatile("s_waitcnt vmcnt(0)" ::: "memory");
    __syncthreads();
    if (threadIdx.x == 0) {
        unsigned* bar = b.bar;
        __builtin_amdgcn_s_waitcnt(0);
        unsigned nloc = b.st[0], nx = b.st[1];
        if (nloc == 0u) { xcd_barrier_complete(bar, b.x, nloc, nx); b.st[0] = nloc; b.st[1] = nx; }
        const unsigned old = xb_add(&bar[XB_XSUB(b.x)], 1u);
        const unsigned gen = old / nloc;
        if (old + 1u == (gen + 1u) * nloc) {
            __builtin_amdgcn_fence(__ATOMIC_RELEASE, "agent");
            asm volatile("s_waitcnt vmcnt(0)" ::: "memory");
            const unsigned og = xb_add(&bar[XB_TOP], 1u);
            const unsigned tg = og / nx;
            if (og + 1u == (tg + 1u) * nx) xb_add(&bar[XB_TOPGEN], 1u);
            else XB_SPIN(xb_ld(&bar[XB_TOPGEN]) == tg, bar);
            __builtin_amdgcn_fence(__ATOMIC_ACQUIRE, "agent");
            xb_add(&bar[XB_XGEN(b.x)], 1u);
            asm volatile("s_waitcnt vmcnt(0)" ::: "memory");
        } else {
            XB_SPIN(xb_ld(&bar[XB_XGEN(b.x)]) == gen, bar);
            __builtin_amdgcn_fence(__ATOMIC_ACQUIRE, "agent");
            asm volatile("s_waitcnt vmcnt(0)" ::: "memory");
        }
    }
    __syncthreads();
}

namespace pg8 {
constexpr int BM = 256, BK = 64, HALF = 128, HTB = HALF * BK * 2, STAGE_BYTES = 8 * HTB, NXCD = 8, WGM = 8;
__host__ __device__ __forceinline__ int lds_byte(int r, int c) { const int st = (r >> 4) * 2 + (c >> 5), rr = r & 15, cc = c & 31, ob = rr * 64 + cc * 2; return st * 1024 + (ob ^ (((ob >> 9) & 1) << 5)); }
__host__ __device__ __forceinline__ void stage_rc(int b, int& R, int& C) { const int st = b / 1024, sb = b % 1024, swz = sb ^ (((sb >> 9) & 1) << 5); R = (st >> 1) * 16 + swz / 64; C = (st & 1) * 32 + (swz % 64) / 2; }
__host__ __device__ __forceinline__ int perm32(int rho) { const int n = rho >> 4, i = rho & 15; return 8 * (i >> 2) + 4 * n + (i & 3); }

struct Unit { int pm, pn; };
struct Gemm { const bf16_t* A; const bf16_t* Bt; int K, lda, ldb, a_pn_shift, a_pn_stride, mid_t; };

struct StaticOrder {
    int nM, nN, nwg, G, c;
    __device__ void init(int M, int N, int G_, int c_) { nM = M / BM; nN = N / BM; nwg = nM * nN; G = G_; c = c_; }
    __device__ bool next(int i, Unit& u) const {
        const long L = (long)i * G + c; if (L >= nwg) return false;
        int wgid = (int)L; { const int q = nwg / NXCD, r = nwg % NXCD, xcd = wgid % NXCD, off = wgid / NXCD; wgid = (xcd < r ? xcd * (q + 1) : r * (q + 1) + (xcd - r) * q) + off; }
        const int nig = WGM * nN, gid = wgid / nig, fm = gid * WGM, gsz = (nM - fm) < WGM ? (nM - fm) : WGM;
        u.pm = fm + ((wgid % nig) % gsz); u.pn = (wgid % nig) / gsz; return true;
    }
};
__device__ __forceinline__ unsigned cvt_pk_bf16(float lo, float hi) { unsigned r; asm volatile("v_cvt_pk_bf16_f32 %0, %1, %2" : "=v"(r) : "v"(lo), "v"(hi)); return r; }

struct EpiBf16 {
    static constexpr bool PERM = true;
    bf16_t* O; int ldc;
    __device__ __forceinline__ void operator()(const f32x4 (&acc)[2][2][4][2], const Unit& u, int wr, int wc, int fr, int fq) const {
        const int row0 = u.pm * BM + wr * 64 + fr, col0 = u.pn * BM + wc * 32 + 8 * fq;
#pragma unroll
        for (int ai = 0; ai < 2; ++ai)
#pragma unroll
            for (int m = 0; m < 4; ++m) { bf16_t* rowp = O + (size_t)(row0 + ai * HALF + m * 16) * ldc + col0;
#pragma unroll
                for (int bj = 0; bj < 2; ++bj) { const f32x4 v0 = acc[ai][bj][m][0], v1 = acc[ai][bj][m][1];
                    u32x4 w; w.x = cvt_pk_bf16(v0[0], v0[1]); w.y = cvt_pk_bf16(v0[2], v0[3]); w.z = cvt_pk_bf16(v1[0], v1[1]); w.w = cvt_pk_bf16(v1[2], v1[3]);
                    *(u32x4*)(rowp + bj * HALF) = w; } }
    }
};
struct EpiG1 {
    static constexpr bool PERM = true;
    bf16_t* P; const float* bg; bf16_t* RT; bf16_t* GRS; const float* rope; const unsigned long long* ss; const float* ssp; float* IFo;
    __device__ __forceinline__ void operator()(f32x4 (&acc)[2][2][4][2], const Unit& u, int wr, int wc, int fr, int fq) const {
        const int row0 = u.pm * BM + wr * 64 + fr, cw = wc * 32 + 8 * fq;
#pragma unroll
        for (int ai = 0; ai < 2; ++ai) {
            float sq[4];
            if (u.pm < 32) {
                f32x4 a[4], b[4];
#pragma unroll
                for (int m = 0; m < 4; ++m) { const float* q = ssp + (size_t)(row0 + ai * HALF + m * 16) * 8; a[m] = *(const f32x4*)q; b[m] = *(const f32x4*)(q + 4); }
#pragma unroll
                for (int m = 0; m < 4; ++m) sq[m] = ((a[m][0] + a[m][1]) + (a[m][2] + a[m][3])) + ((b[m][0] + b[m][1]) + (b[m][2] + b[m][3]));
            } else {
                unsigned long long v[4];
#pragma unroll
                for (int m = 0; m < 4; ++m) v[m] = ss[row0 + ai * HALF + m * 16];
#pragma unroll
                for (int m = 0; m < 4; ++m) sq[m] = ss_val(v[m]);
            }
#pragma unroll
            for (int m = 0; m < 4; ++m) { const float rstd = rsqrtf(sq[m] * (1.0f / 2048.0f) + 1e-6f);
#pragma unroll
                for (int bj = 0; bj < 2; ++bj) { acc[ai][bj][m][0] *= rstd; acc[ai][bj][m][1] *= rstd; } }
            __builtin_amdgcn_sched_barrier(0);
        }
        if (u.pn == 44) {
            if (wc == 0 && fq == 0) {
#pragma unroll
                for (int ai = 0; ai < 2; ++ai)
#pragma unroll
                    for (int m = 0; m < 4; ++m) { float* o = IFo + (size_t)(row0 + ai * HALF + m * 16) * 8; *(f32x4*)o = acc[ai][0][m][0]; *(f32x4*)(o + 4) = acc[ai][0][m][1]; }
            }
        } else if (u.pn >= 28) {
            const int ch = 128 * (u.pn - 28) + cw;
            const f32x4 bm0 = *(const f32x4*)(bg + ch), bm1 = *(const f32x4*)(bg + ch + 4), br0 = *(const f32x4*)(bg + 2048 + ch), br1 = *(const f32x4*)(bg + 2048 + ch + 4);
#pragma unroll
            for (int ai = 0; ai < 2; ++ai)
#pragma unroll
                for (int m = 0; m < 4; ++m) { const size_t row = (size_t)(row0 + ai * HALF + m * 16);
                    const f32x4 vm0 = acc[ai][0][m][0] + bm0, vm1 = acc[ai][0][m][1] + bm1, vr0 = acc[ai][1][m][0] + br0, vr1 = acc[ai][1][m][1] + br1;
                    float rt[8], gr[8];
#pragma unroll
                    for (int j = 0; j < 4; ++j) {
                        const float er0 = 1.0f + __expf(-vr0[j]), er1 = 1.0f + __expf(-vr1[j]);
                        rt[j] = er0 * __builtin_amdgcn_rcpf(1.0f + __expf(-vm0[j])); rt[4 + j] = er1 * __builtin_amdgcn_rcpf(1.0f + __expf(-vm1[j]));
                        gr[j] = __builtin_amdgcn_rcpf(er0); gr[4 + j] = __builtin_amdgcn_rcpf(er1); }
                    u32x4 w; w.x = cvt_pk_bf16(rt[0], rt[1]); w.y = cvt_pk_bf16(rt[2], rt[3]); w.z = cvt_pk_bf16(rt[4], rt[5]); w.w = cvt_pk_bf16(rt[6], rt[7]);
                    *(u32x4*)(RT + row * 2048 + ch) = w;
                    w.x = cvt_pk_bf16(gr[0], gr[1]); w.y = cvt_pk_bf16(gr[2], gr[3]); w.z = cvt_pk_bf16(gr[4], gr[5]); w.w = cvt_pk_bf16(gr[6], gr[7]);
                    *(u32x4*)(GRS + row * 2048 + ch) = w; }
        } else if (u.pn >= 12 && u.pn < 20) {
            const float sc = u.pn >= 16 ? 0.0625f : 1.0f;
#pragma unroll
            for (int ai = 0; ai < 2; ++ai)
#pragma unroll
                for (int m = 0; m < 4; ++m) { const int row = row0 + ai * HALF + m * 16;
                    const int pi = row < MP ? (row & (SEQ - 1)) : 2048;
                    const f32x4* cs = (const f32x4*)(rope + ((size_t)pi * 128 + cw) * 2);
                    const f32x4 t0 = cs[0], t1 = cs[1], t2 = cs[2], t3 = cs[3];
                    const f32x4 a0 = acc[ai][0][m][0], a1 = acc[ai][0][m][1], b0 = acc[ai][1][m][0], b1 = acc[ai][1][m][1];
                    const float c[8] = {t0[0], t0[2], t1[0], t1[2], t2[0], t2[2], t3[0], t3[2]}, sn[8] = {t0[1], t0[3], t1[1], t1[3], t2[1], t2[3], t3[1], t3[3]};
                    const float x1[8] = {a0[0], a0[1], a0[2], a0[3], a1[0], a1[1], a1[2], a1[3]}, x2[8] = {b0[0], b0[1], b0[2], b0[3], b1[0], b1[1], b1[2], b1[3]};
                    float o1[8], o2[8];
#pragma unroll
                    for (int j = 0; j < 8; ++j) { o1[j] = (x1[j] * c[j] - x2[j] * sn[j]) * sc; o2[j] = (x1[j] * sn[j] + x2[j] * c[j]) * sc; }
                    bf16_t* rowp = P + (size_t)row * NP + u.pn * BM + cw;
                    u32x4 w; w.x = cvt_pk_bf16(o1[0], o1[1]); w.y = cvt_pk_bf16(o1[2], o1[3]); w.z = cvt_pk_bf16(o1[4], o1[5]); w.w = cvt_pk_bf16(o1[6], o1[7]);
                    *(u32x4*)rowp = w;
                    w.x = cvt_pk_bf16(o2[0], o2[1]); w.y = cvt_pk_bf16(o2[2], o2[3]); w.z = cvt_pk_bf16(o2[4], o2[5]); w.w = cvt_pk_bf16(o2[6], o2[7]);
                    *(u32x4*)(rowp + HALF) = w; }
        } else {
#pragma unroll
            for (int ai = 0; ai < 2; ++ai)
#pragma unroll
                for (int m = 0; m < 4; ++m) { bf16_t* rowp = P + (size_t)(row0 + ai * HALF + m * 16) * NP + u.pn * BM + cw;
#pragma unroll
                    for (int bj = 0; bj < 2; ++bj) { const f32x4 v0 = acc[ai][bj][m][0], v1 = acc[ai][bj][m][1];
                        u32x4 w; w.x = cvt_pk_bf16(v0[0], v0[1]); w.y = cvt_pk_bf16(v0[2], v0[3]); w.z = cvt_pk_bf16(v1[0], v1[1]); w.w = cvt_pk_bf16(v1[2], v1[3]);
                        *(u32x4*)(rowp + bj * HALF) = w; } }
        }
    }
};
struct EpiMerged {
    static constexpr bool PERM = true;
    bf16_t* O; const bf16_t* RT; const bf16_t* GRS;
    __device__ __forceinline__ void scale(f32x4 (&acc)[2][2][4][2], const bf16_t* S, const Unit& u, int wr, int wc, int fr, int fq) const {
        asm volatile("" : "+v"(fr), "+v"(fq));
        const int row0 = u.pm * BM + wr * 64 + fr, col0 = u.pn * BM + wc * 32 + 8 * fq;
#pragma unroll
        for (int ai = 0; ai < 2; ++ai) {
            u32x4 sv[4][2];
#pragma unroll
            for (int m = 0; m < 4; ++m)
#pragma unroll
                for (int bj = 0; bj < 2; ++bj) sv[m][bj] = *(const u32x4*)(S + (size_t)(row0 + ai * HALF + m * 16) * 2048 + col0 + bj * HALF);
#pragma unroll
            for (int m = 0; m < 4; ++m)
#pragma unroll
                for (int bj = 0; bj < 2; ++bj) { const u32x4 a = sv[m][bj];
                    acc[ai][bj][m][0][0] *= __uint_as_float(a.x << 16); acc[ai][bj][m][0][1] *= __uint_as_float(a.x & 0xffff0000u);
                    acc[ai][bj][m][0][2] *= __uint_as_float(a.y << 16); acc[ai][bj][m][0][3] *= __uint_as_float(a.y & 0xffff0000u);
                    acc[ai][bj][m][1][0] *= __uint_as_float(a.z << 16); acc[ai][bj][m][1][1] *= __uint_as_float(a.z & 0xffff0000u);
                    acc[ai][bj][m][1][2] *= __uint_as_float(a.w << 16); acc[ai][bj][m][1][3] *= __uint_as_float(a.w & 0xffff0000u); }
        }
    }
    __device__ __forceinline__ void mid(f32x4 (&acc)[2][2][4][2], const Unit& u, int wr, int wc, int fr, int fq) const { scale(acc, RT, u, wr, wc, fr, fq); }
    __device__ __forceinline__ void operator()(f32x4 (&acc)[2][2][4][2], const Unit& u, int wr, int wc, int fr, int fq) const {
        scale(acc, GRS, u, wr, wc, fr, fq);
        const int row0 = u.pm * BM + wr * 64 + fr, col0 = u.pn * BM + wc * 32 + 8 * fq;
#pragma unroll
        for (int ai = 0; ai < 2; ++ai)
#pragma unroll
            for (int m = 0; m < 4; ++m) { bf16_t* rowp = O + (size_t)(row0 + ai * HALF + m * 16) * 2048 + col0;
#pragma unroll
                for (int bj = 0; bj < 2; ++bj) { const f32x4 v0 = acc[ai][bj][m][0], v1 = acc[ai][bj][m][1];
                    u32x4 w; w.x = cvt_pk_bf16(v0[0], v0[1]); w.y = cvt_pk_bf16(v0[2], v0[3]); w.z = cvt_pk_bf16(v1[0], v1[1]); w.w = cvt_pk_bf16(v1[2], v1[3]);
                    *(u32x4*)(rowp + bj * HALF) = w; } }
    }
};
struct EpiResidual {
    static constexpr bool PERM = true;
    bf16_t* Xb; float* ssp; LAS float* red;
    __device__ __forceinline__ void operator()(f32x4 (&acc)[2][2][4][2], const Unit& u, int wr, int wc, int fr, int fq) const {
        const int row0 = u.pm * BM + wr * 64 + fr, col0 = u.pn * BM + wc * 32 + 8 * fq;
#pragma unroll
        for (int ai = 0; ai < 2; ++ai) {
            u32x4 xv[4][2];
#pragma unroll
            for (int m = 0; m < 4; ++m)
#pragma unroll
                for (int bj = 0; bj < 2; ++bj) xv[m][bj] = *(const u32x4*)(Xb + (size_t)(row0 + ai * HALF + m * 16) * 2048 + col0 + bj * HALF);
#pragma unroll
            for (int m = 0; m < 4; ++m) { float sq = 0.f;
#pragma unroll
                for (int bj = 0; bj < 2; ++bj) { const u32x4 a = xv[m][bj]; const f32x4 v0 = acc[ai][bj][m][0], v1 = acc[ai][bj][m][1];
                    u32x4 w;
                    w.x = cvt_pk_bf16(v0[0] + __uint_as_float(a.x << 16), v0[1] + __uint_as_float(a.x & 0xffff0000u)); w.y = cvt_pk_bf16(v0[2] + __uint_as_float(a.y << 16), v0[3] + __uint_as_float(a.y & 0xffff0000u));
                    w.z = cvt_pk_bf16(v1[0] + __uint_as_float(a.z << 16), v1[1] + __uint_as_float(a.z & 0xffff0000u)); w.w = cvt_pk_bf16(v1[2] + __uint_as_float(a.w << 16), v1[3] + __uint_as_float(a.w & 0xffff0000u));
                    *(u32x4*)(Xb + (size_t)(row0 + ai * HALF + m * 16) * 2048 + col0 + bj * HALF) = w;
                    const unsigned ww[4] = {w.x, w.y, w.z, w.w};
#pragma unroll
                    for (int q = 0; q < 4; ++q) { const float lo = __uint_as_float(ww[q] << 16), hi = __uint_as_float(ww[q] & 0xffff0000u); sq += lo * lo + hi * hi; } }
                sq += __shfl_xor(sq, 16); sq += __shfl_xor(sq, 32);
                if (fq == 0) red[(wr * 64 + fr + ai * HALF + m * 16) * 4 + wc] = sq; }
        }
        asm volatile("s_waitcnt lgkmcnt(0)" ::: "memory"); __builtin_amdgcn_s_barrier(); asm volatile("" ::: "memory");
        int t = threadIdx.x; asm volatile("" : "+v"(t));
        if (t < 256) { const f32x4 q = *(LAS const f32x4*)(red + 4 * t); ssp[(size_t)(u.pm * BM + t) * 8 + u.pn] = (q[0] + q[1]) + (q[2] + q[3]); }
        asm volatile("s_waitcnt lgkmcnt(0)" ::: "memory"); __builtin_amdgcn_s_barrier(); asm volatile("" ::: "memory");
    }
};

template <bool MID, class Epi, class Sched, bool ALIGN_EPI = true>
__device__ __forceinline__ void gemm_phase(LAS unsigned char* lds, const Gemm g, const Sched& S, const Epi& E) {
    const int tid = opaque_tid(), wid = __builtin_amdgcn_readfirstlane(tid >> 6), lane = tid & 63, wr = wid >> 2, wc = wid & 3, fr = lane & 15, fq = lane >> 4;
    const int K = g.K, nt = K / BK;
    unsigned voffA[2], voffB[2];
#pragma unroll
    for (int i = 0; i < 2; ++i) { int R, C; stage_rc(tid * 16 + i * 8192, R, C); const int Rb = Epi::PERM ? ((R & ~31) + perm32(R & 31)) : R;
        voffA[i] = (unsigned)(R * g.lda + C) * 2u; voffB[i] = (unsigned)(Rb * g.ldb + C) * 2u; }
    const size_t kstep = (size_t)(BK * 2);
    const size_t hstepA = (size_t)HALF * g.lda * 2, hstepB = (size_t)HALF * g.ldb * 2;
    const size_t tstepA = 2 * hstepA, tstepB = 2 * hstepB;
    const unsigned ldsw = (unsigned)wid * 1024u;
    const int aoff = lds_byte(wr * 64 + fr, fq * 8), boff = lds_byte(wc * 32 + fr, fq * 8);
#define PG8_SA(b, h) (((b) * 2 + (h)) * HTB)
#define PG8_SB(b, h) ((4 + (b) * 2 + (h)) * HTB)
#define PG8_STAGE(bufoff, gbase, voff) do { _Pragma("unroll") for (int _i = 0; _i < 2; ++_i) \
        __builtin_amdgcn_global_load_lds((const unsigned*)((const char*)(gbase) + (voff)[_i]), (LAS unsigned*)(lds + (bufoff) + ldsw + _i * 8192), 16, 0, 0); } while (0)
#define PG8_LDA(dst, b, h) do { _Pragma("unroll") for (int m = 0; m < 4; ++m) _Pragma("unroll") for (int k = 0; k < 2; ++k) dst[m][k] = *(const LAS bf16x8*)(lds + PG8_SA(b, h) + aoff + m * 2048 + k * 1024); } while (0)
#define PG8_LDB(dst, b, h) do { _Pragma("unroll") for (int n = 0; n < 2; ++n) _Pragma("unroll") for (int k = 0; k < 2; ++k) dst[n][k] = *(const LAS bf16x8*)(lds + PG8_SB(b, h) + boff + n * 2048 + k * 1024); } while (0)
#define PG8_MMA(ai, bj, At, Bt) do { __builtin_amdgcn_s_setprio(1); _Pragma("unroll") for (int m = 0; m < 4; ++m) _Pragma("unroll") for (int n = 0; n < 2; ++n) _Pragma("unroll") for (int k = 0; k < 2; ++k) \
        acc[ai][bj][m][n] = __builtin_amdgcn_mfma_f32_16x16x32_bf16(Bt[n][k], At[m][k], acc[ai][bj][m][n], 0, 0, 0); __builtin_amdgcn_s_setprio(0); } while (0)
#define PG8_WAIT_V(n) asm volatile("s_waitcnt vmcnt(" #n ")" ::: "memory")
#define PG8_WAIT_L(n) asm volatile("s_waitcnt lgkmcnt(" #n ")" ::: "memory")
#define PG8_BAR __builtin_amdgcn_s_barrier()
#define PG8_SCHED __builtin_amdgcn_sched_barrier(0)
#define PG8_APTR(u) ((const char*)g.A + (size_t)(u).pm * tstepA + (size_t)((u).pn >> g.a_pn_shift) * (size_t)g.a_pn_stride)
    Unit cur, nxt; int ui = 0;
    if (!S.next(0, cur)) return;
    f32x4 acc[2][2][4][2];
#pragma unroll
    for (int a = 0; a < 2; ++a)
#pragma unroll
        for (int b = 0; b < 2; ++b)
#pragma unroll
            for (int m = 0; m < 4; ++m)
#pragma unroll
                for (int n = 0; n < 2; ++n) acc[a][b][m][n] = (f32x4){0.f, 0.f, 0.f, 0.f};
    bf16x8 At[4][2], B0[2][2], B1[2][2];
    const char* cA = PG8_APTR(cur); const char* cB = (const char*)g.Bt + (size_t)cur.pn * tstepB;
    PG8_STAGE(PG8_SB(0, 0), cB, voffB); PG8_STAGE(PG8_SB(0, 1), cB + hstepB, voffB); PG8_STAGE(PG8_SA(0, 0), cA, voffA); PG8_STAGE(PG8_SA(0, 1), cA + hstepA, voffA);
    if (wr == 1) PG8_BAR;
    PG8_WAIT_V(2); PG8_BAR;
    PG8_STAGE(PG8_SB(1, 0), cB + kstep, voffB); PG8_STAGE(PG8_SA(1, 0), cA + kstep, voffA); PG8_STAGE(PG8_SB(1, 1), cB + hstepB + kstep, voffB);
    PG8_WAIT_V(6); PG8_BAR;
    for (;;) {
        const bool has_next = S.next(ui + 1, nxt);
        const char* nA = has_next ? PG8_APTR(nxt) : cA; const char* nB = has_next ? (const char*)g.Bt + (size_t)nxt.pn * tstepB : cB;
#pragma unroll 1
        for (int t = 0; t < nt; t += 2) {
            const bool last = (t == nt - 2);
            const char* a1 = cA + (size_t)(t + 1) * kstep;
            const char* a2 = last ? nA : cA + (size_t)(t + 2) * kstep; const char* b2 = last ? nB : cB + (size_t)(t + 2) * kstep;
            const char* a3 = a2 + kstep; const char* b3 = b2 + kstep;
            if constexpr (MID) { if (t == g.mid_t) E.mid(acc, cur, wr, wc, fr, fq); }
            PG8_LDB(B0, 0, 0); PG8_LDB(B1, 0, 1); PG8_SCHED; PG8_LDA(At, 0, 0); PG8_STAGE(PG8_SA(1, 1), a1 + hstepA, voffA);
            PG8_WAIT_V(8); PG8_WAIT_L(0); PG8_BAR; PG8_MMA(0, 0, At, B0); PG8_MMA(0, 1, At, B1); PG8_BAR; PG8_SCHED;
            PG8_LDA(At, 0, 1); PG8_STAGE(PG8_SB(0, 0), b2, voffB); PG8_STAGE(PG8_SB(0, 1), b2 + hstepB, voffB); PG8_STAGE(PG8_SA(0, 0), a2, voffA);
            PG8_WAIT_V(8); PG8_WAIT_L(0); PG8_BAR; PG8_MMA(1, 0, At, B0); PG8_MMA(1, 1, At, B1); PG8_BAR; PG8_SCHED;
            PG8_LDB(B0, 1, 0); PG8_LDB(B1, 1, 1); PG8_SCHED; PG8_LDA(At, 1, 0); PG8_STAGE(PG8_SA(0, 1), a2 + hstepA, voffA);
            PG8_WAIT_V(8); PG8_WAIT_L(0); PG8_BAR; PG8_MMA(0, 0, At, B0); PG8_MMA(0, 1, At, B1); PG8_BAR; PG8_SCHED;
            PG8_LDA(At, 1, 1); PG8_STAGE(PG8_SB(1, 0), b3, voffB); PG8_STAGE(PG8_SB(1, 1), b3 + hstepB, voffB); PG8_STAGE(PG8_SA(1, 0), a3, voffA);
            PG8_WAIT_V(8); PG8_WAIT_L(0); PG8_BAR; PG8_MMA(1, 0, At, B0); PG8_MMA(1, 1, At, B1); PG8_BAR; PG8_SCHED;
        }
        if constexpr (ALIGN_EPI) { if (wr == 0) PG8_BAR; }
        E(acc, cur, wr, wc, fr, fq);
        if (!has_next) break;
#pragma unroll
        for (int a = 0; a < 2; ++a)
#pragma unroll
            for (int b = 0; b < 2; ++b)
#pragma unroll
                for (int m = 0; m < 4; ++m)
#pragma unroll
                    for (int n = 0; n < 2; ++n) acc[a][b][m][n] = (f32x4){0.f, 0.f, 0.f, 0.f};
        cur = nxt; cA = nA; cB = nB; ++ui;
        if constexpr (ALIGN_EPI) { if (wr == 1) PG8_BAR; }
    }
    PG8_WAIT_V(0);
    if constexpr (!ALIGN_EPI) { if (wr == 0) PG8_BAR; }
    PG8_BAR;
#undef PG8_SA
#undef PG8_SB
#undef PG8_STAGE
#undef PG8_LDA
#undef PG8_LDB
#undef PG8_MMA
#undef PG8_WAIT_V
#undef PG8_WAIT_L
#undef PG8_BAR
#undef PG8_SCHED
#undef PG8_APTR
}
}

struct TrDesc { const float* src; bf16_t* dst; const float* ks; int ldsrc, ldd; float scale; };
__device__ __forceinline__ TrDesc tr_desc(const Params& p, int it) {
    constexpr int T0 = 1536, T1 = T0 + 2048, T2 = T1 + 2048, T3 = T2 + 512, T4 = T3 + 512, T5 = T4 + 1024, T6 = T5 + 64, T7 = T6 + 64;
    const int l = it / T7, r = it % T7;
    bf16_t* Wl = p.W_() + (size_t)l * WL;
    TrDesc d; d.scale = 1.f; d.ks = nullptr;
    int k0, c0, r0, kd0; const float* src; bf16_t* dst;
    if (r < T0)      { const int q = r;      src = p.w_in + (size_t)l * D * NIN; d.ldsrc = NIN; k0 = (q & 31) * 64; c0 = (q >> 5) * 64; dst = Wl + W1_OFF; d.ldd = D; r0 = (q >> 5) * 64; kd0 = k0; d.ks = p.norm_g + (size_t)l * D; }
    else if (r < T1) { const int q = r - T0; src = p.w_in + (size_t)l * D * NIN; d.ldsrc = NIN; k0 = (q & 31) * 64; c0 = 3080 + (q >> 5) * 64; dst = Wl + W1_OFF; d.ldd = D; r0 = 3072 + (q >> 5) * 64; kd0 = k0; d.ks = p.norm_g + (size_t)l * D; }
    else if (r < T2) { const int q = r - T1, ct = q >> 5;
                       src = p.w_gate + (size_t)l * D * 4096; d.ldsrc = 4096; k0 = (q & 31) * 64; c0 = (((ct & 3) < 2) ? 0 : 2048) + 128 * (ct >> 2) + (ct & 1) * 64; dst = Wl + W1_OFF; d.ldd = D; r0 = C_GM + ct * 64; kd0 = k0; d.ks = p.norm_g + (size_t)l * D; }
    else if (r < T3) { const int q = r - T2; src = p.w_pm + (size_t)l * WM * D; d.ldsrc = D; k0 = (q & 15) * 64; c0 = (q >> 4) * 64; dst = Wl + W3_OFF; d.ldd = D; r0 = c0; kd0 = k0; }
    else if (r < T4) { const int q = r - T3; src = p.w_pr + (size_t)l * WM * D; d.ldsrc = D; k0 = (q & 15) * 64; c0 = (q >> 4) * 64; dst = Wl + W3_OFF; d.ldd = D; r0 = c0; kd0 = 1024 + k0; }
    else if (r < T5) { const int q = r - T4; src = p.w_o + (size_t)l * D * D; d.ldsrc = D; k0 = (q & 31) * 64; c0 = (q >> 5) * 64; dst = Wl + W4_OFF; d.ldd = D; r0 = c0; kd0 = k0; }
    else if (r < T6) { const int q = r - T5, h = q >> 4, qq = q & 15; src = p.w_qm + ((size_t)l * HM + h) * SZ; d.ldsrc = DH; k0 = (qq & 3) * 64; c0 = (qq >> 2) * 64; dst = Wl + W2_OFF; d.ldd = DH; r0 = h * 512 + c0; kd0 = k0; d.scale = 0.0625f; }
    else             { const int q = r - T6, h = q >> 4, qq = q & 15; src = p.w_km + ((size_t)l * HM + h) * SZ; d.ldsrc = DH; k0 = (qq & 3) * 64; c0 = (qq >> 2) * 64; dst = Wl + W2_OFF; d.ldd = DH; r0 = h * 512 + 256 + c0; kd0 = k0; }
    d.src = src + (size_t)k0 * d.ldsrc + c0; d.dst = dst + (size_t)r0 * d.ldd + kd0; if (d.ks) d.ks += k0;
    return d;
}
__device__ __forceinline__ void tr_load(const TrDesc& d, f32x4 (&v)[16], f32x4 (&ks)[2], int lane) {
#pragma unroll
    for (int i = 0; i < 16; ++i) v[i] = __builtin_nontemporal_load((const f32x4*)(d.src + (size_t)((lane >> 4) + 4 * i) * d.ldsrc + 4 * (lane & 15)));
    if (d.ks) { ks[0] = *(const f32x4*)(d.ks + 8 * (lane & 7)); ks[1] = *(const f32x4*)(d.ks + 8 * (lane & 7) + 4); }
    else { ks[0] = (f32x4){1.f, 1.f, 1.f, 1.f}; ks[1] = ks[0]; }
}
__device__ __forceinline__ void tr_store(const TrDesc& d, const f32x4 (&v)[16], const f32x4 (&ks)[2], LAS float* t, int lane) {
#pragma unroll
    for (int i = 0; i < 16; ++i)
#pragma unroll
        for (int j = 0; j < 4; ++j) t[((lane >> 4) + 4 * i) * 65 + 4 * (lane & 15) + j] = v[i][j];
    const int c = lane & 7;
    const f32x4 s0 = ks[0] * d.scale, s1 = ks[1] * d.scale;
#pragma unroll
    for (int j = 0; j < 8; ++j) { const int n = (lane >> 3) + 8 * j; const LAS float* q = t + (8 * c) * 65 + n;
        u32x4 o; o.x = pk2(s0[0] * q[0], s0[1] * q[65]); o.y = pk2(s0[2] * q[130], s0[3] * q[195]); o.z = pk2(s1[0] * q[260], s1[1] * q[325]); o.w = pk2(s1[2] * q[390], s1[3] * q[455]);
        *(u32x4*)(d.dst + (size_t)n * d.ldd + 8 * c) = o; }
}
__device__ __forceinline__ void prep_phase(const Params& p, int wg, int nwg, LAS unsigned char* lds) {
    const int tid = opaque_tid();
    {
        const int lane = tid & 63, wid = tid >> 6;
        for (int row = wg * 8 + wid; row < MPAD; row += nwg * 8) {
            u32x2* hrow = (u32x2*)(p.Xb_() + (size_t)row * D);
            float ss = 0.f;
            if (row < MT) {
                const f32x4* xr = (const f32x4*)(row < MP ? p.x_prompt + (size_t)row * D : p.x_sample + (size_t)(row - MP) * D);
#pragma unroll
                for (int i = 0; i < 8; ++i) { const f32x4 v = xr[lane + 64 * i]; ss += (v[0] * v[0] + v[1] * v[1]) + (v[2] * v[2] + v[3] * v[3]); hrow[lane + 64 * i] = (u32x2){pk2(v[0], v[1]), pk2(v[2], v[3])}; }
                ss = wave_sum(ss);
            } else {
#pragma unroll
                for (int i = 0; i < 8; ++i) hrow[lane + 64 * i] = (u32x2){0u, 0u};
            }
            if (lane < 5) p.SS_()[(size_t)lane * MPAD + row] = lane == 0 ? ss_fix(ss) : 0ull;
            if (row < MP && lane < 8) p.SSP_()[(size_t)row * 8 + lane] = lane == 0 ? ss : 0.f;
        }
    }
    for (int i = wg * 512 + tid; i < 2049 * 128; i += nwg * 512) {
        const int pi = i >> 7, j = i & 127;
        const float pos = pi < 2048 ? (float)pi : 16384.0f;
        const float inv = powf(10000.0f, -((float)j / 128.0f));
        const float ang = pos * inv;
        p.ROPE_()[2 * i] = (float)cos((double)ang); p.ROPE_()[2 * i + 1] = (float)sin((double)ang);
    }
    for (int i = wg * 512 + tid; i < DEPTH * 256 * D; i += nwg * 512) {
        const int l = i / (256 * D), r = i % (256 * D), j = r / D, k = r % D;
        p.W_()[(size_t)l * WL + W1_OFF + (size_t)(11264 + j) * D + k] = j < 8 ? f2bf(p.w_in[((size_t)l * D + k) * NIN + 3072 + j] * p.norm_g[(size_t)l * D + k]) : (bf16_t)0;
    }
    const int lane = tid & 63, wid = tid >> 6;
    LAS float* t = (LAS float*)lds + wid * (64 * 65);
    constexpr int NT = DEPTH * 7808;
    int it = wg * 8 + wid;
    if (it < NT) {
        TrDesc d = tr_desc(p, it);
        f32x4 v[16], ks[2];
        tr_load(d, v, ks, lane);
        for (;;) {
            const int it2 = it + nwg * 8;
            const bool has = it2 < NT;
            TrDesc d2 = d; f32x4 v2[16], ks2[2];
            if (has) { d2 = tr_desc(p, it2); tr_load(d2, v2, ks2, lane); }
            tr_store(d, v, ks, t, lane);
            if (!has) break;
#pragma unroll
            for (int i = 0; i < 16; ++i) v[i] = v2[i];
            ks[0] = ks2[0]; ks[1] = ks2[1]; d = d2; it = it2;
        }
    }
}

__device__ __forceinline__ void final_phase(const Params& p, int wg, int nwg) {
    const int tid_ = opaque_tid(), lane = tid_ & 63, wid = tid_ >> 6;
    const f32x4* g4 = (const f32x4*)p.final_g;
    for (int row = wg * 8 + wid; row < MT; row += nwg * 8) {
        const u32x2* xr = (const u32x2*)(p.Xb_() + (size_t)row * D);
        f32x4* yr = (f32x4*)(p.out + (row < MP ? O_YP + (size_t)row * D : O_YS + (size_t)(row - MP) * D));
        const float rstd = rsqrtf(row_ss(p.SSP_(), p.SS_() + (size_t)4 * MPAD, row) * (1.0f / D) + EPS);
#pragma unroll
        for (int i = 0; i < 8; ++i) { const u32x2 xb = xr[lane + 64 * i];
            const f32x4 v = (f32x4){__uint_as_float(xb.x << 16), __uint_as_float(xb.x & 0xffff0000u), __uint_as_float(xb.y << 16), __uint_as_float(xb.y & 0xffff0000u)};
            yr[lane + 64 * i] = v * rstd * g4[lane + 64 * i]; }
    }
}

__device__ __forceinline__ void unpack8(const u32x4 v, float (&f)[8]) {
    f[0] = __uint_as_float(v.x << 16); f[1] = __uint_as_float(v.x & 0xffff0000u); f[2] = __uint_as_float(v.y << 16); f[3] = __uint_as_float(v.y & 0xffff0000u);
    f[4] = __uint_as_float(v.z << 16); f[5] = __uint_as_float(v.z & 0xffff0000u); f[6] = __uint_as_float(v.w << 16); f[7] = __uint_as_float(v.w & 0xffff0000u);
}
__device__ __forceinline__ u32x4 pack8(const float (&f)[8]) { u32x4 w; w.x = pk2(f[0], f[1]); w.y = pk2(f[2], f[3]); w.z = pk2(f[4], f[5]); w.w = pk2(f[6], f[7]); return w; }

__device__ __forceinline__ void gate_all(const Params& p, int layer, int bh, LAS float* G);
__device__ __forceinline__ void conv_phase(const Params& p, int layer, int wg, int nwg, LAS unsigned char* lds) {
    const int tid = opaque_tid();
    for (int bh = wg; bh < 16; bh += nwg) gate_all(p, layer, bh, (LAS float*)lds);
    const float* cw = p.conv_w + (size_t)layer * 4 * WM;
    const float* cb = p.conv_b + (size_t)layer * WM;
    const int cwg = nwg > 32 ? wg - 16 : wg, cnw = nwg > 32 ? nwg - 16 : nwg;
    if (cwg >= 0)
    for (int it = cwg * 512 + tid; it < MT * 128; it += cnw * 512) {
        const int row = it >> 7, ch = (it & 127) * 8;
        float up[4][8];
        if (row < MP) {
            const int t = row & (SEQ - 1);
#pragma unroll
            for (int i = 0; i < 4; ++i) {
                if (t - 3 + i >= 0) unpack8(*(const u32x4*)(p.P_() + (size_t)(row - 3 + i) * NP + C_U + ch), up[i]);
                else {
#pragma unroll
                    for (int j = 0; j < 8; ++j) up[i][j] = 0.f;
                }
            }
            if (t >= SEQ - 3) {
                const int b = row >> 11;
                float* o = p.out + O_CVP + (((size_t)layer * BP + b) * 3 + (t - (SEQ - 3))) * WM + ch;
                *(f32x4*)o = (f32x4){up[3][0], up[3][1], up[3][2], up[3][3]}; *(f32x4*)(o + 4) = (f32x4){up[3][4], up[3][5], up[3][6], up[3][7]};
            }
        } else {
            const int b = row - MP;
            const float* hist = p.st_conv + ((size_t)layer * BS + b) * 3 * WM + ch;
#pragma unroll
            for (int i = 0; i < 3; ++i) { const f32x4 a = *(const f32x4*)(hist + (size_t)i * WM), c = *(const f32x4*)(hist + (size_t)i * WM + 4);
                up[i][0] = a[0]; up[i][1] = a[1]; up[i][2] = a[2]; up[i][3] = a[3]; up[i][4] = c[0]; up[i][5] = c[1]; up[i][6] = c[2]; up[i][7] = c[3]; }
            unpack8(*(const u32x4*)(p.P_() + (size_t)row * NP + C_U + ch), up[3]);
            float* o = p.out + O_CVS + ((size_t)layer * BS + b) * 3 * WM + ch;
#pragma unroll
            for (int i = 0; i < 3; ++i) { *(f32x4*)(o + (size_t)i * WM) = (f32x4){up[i + 1][0], up[i + 1][1], up[i + 1][2], up[i + 1][3]};
                *(f32x4*)(o + (size_t)i * WM + 4) = (f32x4){up[i + 1][4], up[i + 1][5], up[i + 1][6], up[i + 1][7]}; }
        }
        float r[8];
#pragma unroll
        for (int j = 0; j < 8; ++j) r[j] = cb[ch + j];
#pragma unroll
        for (int i = 0; i < 4; ++i)
#pragma unroll
            for (int j = 0; j < 8; ++j) r[j] += up[i][j] * cw[i * WM + ch + j];
#pragma unroll
        for (int j = 0; j < 8; ++j) r[j] = siluf_(r[j]);
        *(u32x4*)(p.CM_() + (size_t)row * WM + ch) = pack8(r);
    }
}

__device__ __forceinline__ void gate_all(const Params& p, int layer, int bh, LAS float* G) {
    const int tid = opaque_tid(), lane = tid & 63, wid = tid >> 6, b = bh >> 2, h = bh & 3;
    const float bi = p.b_i[layer * HM + h], bfv = p.b_f[layer * HM + h];
    float* gt = p.GT_() + (size_t)bh * 6208;
    float tb0[2], tb1[2], tg0[2], tg1[2], rm0[2], rm1[2];
#pragma unroll
    for (int q = 0; q < 2; ++q) {
        const int cc = wid + 8 * q;
        const size_t r0 = (size_t)b * SEQ + cc * 128 + 2 * lane;
        const float i0 = p.IF_()[r0 * 8 + h] + bi, i1 = p.IF_()[(r0 + 1) * 8 + h] + bi;
        const float l0 = logsigf_(p.IF_()[r0 * 8 + 4 + h] + bfv), l1 = logsigf_(p.IF_()[(r0 + 1) * 8 + 4 + h] + bfv);
        float inc = l0 + l1;
#pragma unroll
        for (int o = 1; o < 64; o <<= 1) { const float t = __shfl_up(inc, o); if (lane >= o) inc += t; }
        const float exc = inc - (l0 + l1);
        tb0[q] = exc + l0; tb1[q] = inc;
        tg0[q] = i0 - tb0[q]; tg1[q] = i1 - tb1[q];
        const float gm = wave_max(fmaxf(tg0[q], tg1[q]));
        const float Bc = __shfl(inc, 63);
        if (lane == 0) { G[cc] = Bc; G[16 + cc] = gm; }
        float rm = fmaxf(tg0[q], tg1[q]);
#pragma unroll
        for (int o = 1; o < 64; o <<= 1) { const float t = __shfl_up(rm, o); if (lane >= o) rm = fmaxf(rm, t); }
        float ex = __shfl_up(rm, 1); if (lane == 0) ex = -3.0e38f;
        rm0[q] = fmaxf(ex, tg0[q]); rm1[q] = fmaxf(rm0[q], tg1[q]);
    }
    __syncthreads();
    if (tid == 0) { float m = -1e30f; for (int cc = 0; cc < 16; ++cc) { G[32 + cc] = m; m = G[cc] + fmaxf(m, G[16 + cc]); } G[48] = m; }
    __syncthreads();
#pragma unroll
    for (int q = 0; q < 2; ++q) {
        const int cc = wid + 8 * q, t0 = cc * 128 + 2 * lane;
        const float mc = G[32 + cc];
        *(f32x2_t*)(gt + t0) = (f32x2_t){tb0[q], tb1[q]}; *(f32x2_t*)(gt + 2048 + t0) = (f32x2_t){tg0[q], tg1[q]};
        *(f32x2_t*)(gt + 4096 + t0) = (f32x2_t){fmaxf(rm0[q], mc), fmaxf(rm1[q], mc)};
    }
    if (tid < 16) { gt[6144 + tid] = G[tid]; gt[6160 + tid] = G[16 + tid]; }
    if (tid < 17) gt[6176 + tid] = G[32 + tid];
    __syncthreads();
}
__device__ __forceinline__ void gate_load(const Params& p, int bh, int c, LAS float* G, int tid) {
    const float* gt = p.GT_() + (size_t)bh * 6208;
    if (tid < 128) { G[64 + tid] = gt[c * 128 + tid]; G[192 + tid] = gt[2048 + c * 128 + tid]; G[320 + tid] = gt[4096 + c * 128 + tid]; }
    if (tid == 0) G[32 + c] = gt[6176 + c];
    __syncthreads();
}

template <int I> struct IC { static constexpr int value = I; };
template <int I, int N, class F> __device__ __forceinline__ void sfor(F&& f) { if constexpr (I < N) { f(IC<I>{}); sfor<I + 1, N>(f); } }

template <int CPR>
__device__ __forceinline__ void tile_load(u32x4 (&r)[8], const bf16_t* src, int ld_src, int tid) {
#pragma unroll
    for (int i = 0; i < 8; ++i) { const int id = tid + 512 * i, row = id / CPR, ch = id % CPR; r[i] = *(const u32x4*)(src + (size_t)row * ld_src + ch * 8); }
}
template <int CPR, int LDB>
__device__ __forceinline__ void tile_store(LAS unsigned char* dst, const u32x4 (&r)[8], int tid) {
#pragma unroll
    for (int i = 0; i < 8; ++i) { const int id = tid + 512 * i, row = id / CPR, ch = id % CPR; *(LAS u32x4*)(dst + row * LDB + ch * 16) = r[i]; }
}
__device__ __forceinline__ void tile_store_w(LAS unsigned char* dst, const u32x4 (&r)[8], LAS const float* w, int tid) {
#pragma unroll
    for (int i = 0; i < 8; ++i) { const int id = tid + 512 * i, row = id >> 5, ch = id & 31; float f[8]; unpack8(r[i], f); const float ww = w[row];
#pragma unroll
        for (int j = 0; j < 8; ++j) f[j] *= ww;
        *(LAS u32x4*)(dst + row * 544 + ch * 16) = pack8(f); }
}
template <int OFF, int HS>
__device__ __forceinline__ bf16x8 tr_frag1(unsigned base) {
    u32x2 l0, h0;
    asm volatile("ds_read_b64_tr_b16 %0, %2 offset:%3\n\tds_read_b64_tr_b16 %1, %2 offset:%4\n\ts_waitcnt lgkmcnt(0)"
                 : "=&v"(l0), "=&v"(h0) : "v"(base), "i"(OFF), "i"(OFF + HS) : "memory");
    const u32x4 v = (u32x4){l0.x, l0.y, h0.x, h0.y};
    return __builtin_bit_cast(bf16x8, v);
}
template <int OFF, int HS, int TS>
__device__ __forceinline__ void tr_frag2(unsigned base, bf16x8& f0, bf16x8& f1) {
    u32x2 l0, l1, h0, h1;
    asm volatile("ds_read_b64_tr_b16 %0, %4 offset:%5\n\tds_read_b64_tr_b16 %2, %4 offset:%6\n\t"
                 "ds_read_b64_tr_b16 %1, %4 offset:%7\n\tds_read_b64_tr_b16 %3, %4 offset:%8\n\t"
                 "s_waitcnt lgkmcnt(0)"
                 : "=&v"(l0), "=&v"(l1), "=&v"(h0), "=&v"(h1)
                 : "v"(base), "i"(OFF), "i"(OFF + HS), "i"(OFF + TS), "i"(OFF + TS + HS)
                 : "memory");
    f0 = __builtin_bit_cast(bf16x8, (u32x4){l0.x, l0.y, h0.x, h0.y}); f1 = __builtin_bit_cast(bf16x8, (u32x4){l1.x, l1.y, h1.x, h1.y});
}
template <int OFF, int HS, int TS>
__device__ __forceinline__ void tr_frag4(unsigned base, bf16x8 (&f)[4]) {
    u32x2 l0, l1, l2, l3, h0, h1, h2, h3;
    asm volatile("ds_read_b64_tr_b16 %0, %8 offset:%9\n\tds_read_b64_tr_b16 %4, %8 offset:%10\n\t"
                 "ds_read_b64_tr_b16 %1, %8 offset:%11\n\tds_read_b64_tr_b16 %5, %8 offset:%12\n\t"
                 "ds_read_b64_tr_b16 %2, %8 offset:%13\n\tds_read_b64_tr_b16 %6, %8 offset:%14\n\t"
                 "ds_read_b64_tr_b16 %3, %8 offset:%15\n\tds_read_b64_tr_b16 %7, %8 offset:%16\n\t"
                 "s_waitcnt lgkmcnt(0)"
                 : "=&v"(l0), "=&v"(l1), "=&v"(l2), "=&v"(l3), "=&v"(h0), "=&v"(h1), "=&v"(h2), "=&v"(h3)
                 : "v"(base), "i"(OFF), "i"(OFF + HS), "i"(OFF + TS), "i"(OFF + TS + HS), "i"(OFF + 2 * TS), "i"(OFF + 2 * TS + HS), "i"(OFF + 3 * TS), "i"(OFF + 3 * TS + HS)
                 : "memory");
    f[0] = __builtin_bit_cast(bf16x8, (u32x4){l0.x, l0.y, h0.x, h0.y}); f[1] = __builtin_bit_cast(bf16x8, (u32x4){l1.x, l1.y, h1.x, h1.y});
    f[2] = __builtin_bit_cast(bf16x8, (u32x4){l2.x, l2.y, h2.x, h2.y}); f[3] = __builtin_bit_cast(bf16x8, (u32x4){l3.x, l3.y, h3.x, h3.y});
}
__device__ __forceinline__ unsigned lds_addr(LAS const void* p) { return (unsigned)(size_t)p; }

template <int NR, int NC, bool WEIGHT>
__device__ __forceinline__ void stage_T(LAS unsigned char* dst, int ldd_bytes, const bf16_t* src, int ld_src, LAS const float* w) {
    const int tid_ = opaque_tid(), lane = tid_ & 63, wid = tid_ >> 6;
    constexpr int PB = NR / 128, CG = NC / 8;
#pragma unroll 1
    for (int task = wid; task < PB * CG; task += 8) {
        const int pb = task % PB, cg = task / PB, r = pb * 128 + 2 * lane;
        float a[8], c[8];
        unpack8(*(const u32x4*)(src + (size_t)r * ld_src + cg * 8), a); unpack8(*(const u32x4*)(src + (size_t)(r + 1) * ld_src + cg * 8), c);
        float w0 = 1.f, w1 = 1.f; if (WEIGHT) { w0 = w[r]; w1 = w[r + 1]; }
#pragma unroll
        for (int j = 0; j < 8; ++j) *(LAS unsigned*)(dst + (cg * 8 + j) * ldd_bytes + r * 2) = pk2(a[j] * w0, c[j] * w1);
    }
}
__device__ __forceinline__ void stage_rows(LAS unsigned char* dst, const bf16_t* src, int ld_src) {
    const int tid_ = opaque_tid();
#pragma unroll
    for (int i = 0; i < 8; ++i) { const int id = tid_ + 512 * i, row = id >> 5, ch = id & 31;
        *(LAS u32x4*)(dst + row * 528 + ch * 16) = *(const u32x4*)(src + (size_t)row * ld_src + ch * 8); }
}
__device__ __forceinline__ bf16x8 lds_frag(LAS const unsigned char* base, int row, int ld_bytes, int kbyte) { return *(LAS const bf16x8*)(base + row * ld_bytes + kbyte); }
__device__ __forceinline__ float ret_lg(int h) { return logf(1.0f - exp2f(-5.0f - (float)h)); }

template <int BR>
__device__ __forceinline__ void chunk_passA(const Params& p, int layer, int b, int h, int c, LAS unsigned char* lds) {
    LAS unsigned char* Xt = lds; LAS unsigned char* Yt = lds + 69632; LAS float* G = (LAS float*)(lds + 139264); LAS float* wk = G + 512;
    const int tid = opaque_tid(), lane = tid & 63, w = __builtin_amdgcn_readfirstlane(tid >> 6), g = lane >> 4, lr = lane & 15;
    const size_t row0 = (size_t)b * SEQ + c * 128;
    const int pi = BR * 16 + b * 4 + h;
    const bf16_t* Xp = BR == 0 ? p.QK_() + row0 * 2048 + h * 512 + 256 : p.P_() + row0 * NP + C_VR + h * 256;
    const bf16_t* Yp = BR == 0 ? p.P_() + row0 * NP + C_VM + h * 256 : p.P_() + row0 * NP + C_KR + h * 256;
    u32x4 xr[8], yr[8];
    tile_load<32>(xr, Xp, BR == 0 ? 2048 : NP, tid); tile_load<32>(yr, Yp, NP, tid);
    if (BR == 0) { gate_load(p, b * 4 + h, c, G, tid); if (tid < 128) wk[tid] = expf(G[192 + tid] - G[320 + 127]); }
    else { if (tid < 128) wk[tid] = expf((float)(127 - tid) * ret_lg(h)); }
    __syncthreads();
    tile_store<32, 544>(Xt, xr, tid); tile_store_w(Yt, yr, wk, tid);
    __syncthreads();
    const unsigned lpart = (unsigned)(((8 * g + (lr >> 2)) * 272 + 4 * (lr & 3)) * 2);
    const unsigned baseX = lds_addr(Xt) + lpart + (unsigned)(32 * w * 2), baseY = lds_addr(Yt) + lpart;
    bf16_t* Uo = p.U_() + ((size_t)pi * 16 + c) * SZ;
    sfor<0, 2>([&](auto rt_) {
        constexpr int rt = decltype(rt_)::value;
        f32x4 acc[16];
#pragma unroll
        for (int j = 0; j < 16; ++j) acc[j] = (f32x4){0.f, 0.f, 0.f, 0.f};
        sfor<0, 4>([&](auto ks_) {
            constexpr int ks = decltype(ks_)::value;
            const bf16x8 fa = tr_frag1<ks * 32 * 544 + rt * 32, 4 * 544>(baseX);
            sfor<0, 4>([&](auto cq_) {
                constexpr int cq = decltype(cq_)::value;
                bf16x8 fb[4];
                tr_frag4<ks * 32 * 544 + cq * 128, 4 * 544, 32>(baseY, fb);
#pragma unroll
                for (int i = 0; i < 4; ++i) acc[4 * cq + i] = __builtin_amdgcn_mfma_f32_16x16x32_bf16(fa, fb[i], acc[4 * cq + i], 0, 0, 0);
            });
        });
#pragma unroll
        for (int ct = 0; ct < 16; ++ct)
            *(u32x2*)(Uo + (size_t)(16 * ct + lr) * 256 + 32 * w + 16 * rt + 4 * g) = (u32x2){pk2(acc[ct][0], acc[ct][1]), pk2(acc[ct][2], acc[ct][3])};
    });
    if (BR == 0 && tid < 256) {
        float sacc = 0.f;
        for (int ss = 0; ss < 128; ++ss) sacc += wk[ss] * bf2f(*(LAS const bf16_t*)(Xt + ss * 544 + tid * 2));
        p.NU_()[((size_t)(b * 4 + h) * 16 + c) * 256 + tid] = sacc;
    }
    __syncthreads();
}

template <int BR>
__device__ __forceinline__ void chunk_state_item(const Params& p, int layer, int b, int h, int sl, LAS unsigned char* lds) {
    LAS unsigned char* Xt = lds;
    LAS unsigned char* Ys = lds + 69632;
    LAS float* wka = (LAS float*)(lds + 79872);
    LAS float* dec = wka + 2048;
    const int tid = opaque_tid(), lane = tid & 63, w = __builtin_amdgcn_readfirstlane(tid >> 6), g = lane >> 4, lr = lane & 15;
    const int bh = b * 4 + h, pi = BR * 16 + bh;
    const float* gt = p.GT_() + (size_t)bh * 6208;
    if (BR == 0) {
#pragma unroll
        for (int i = 0; i < 4; ++i) { const int t = tid + 512 * i; wka[t] = expf(gt[2048 + t] - gt[4096 + (t | 127)]); }
        if (tid < 16) { const float mc = gt[6176 + tid]; dec[tid] = expf(mc - fmaxf(mc, gt[6160 + tid])); }
    } else {
        const float lg = ret_lg(h);
#pragma unroll
        for (int i = 0; i < 4; ++i) { const int t = tid + 512 * i; wka[t] = expf((float)(127 - (t & 127)) * lg); }
        if (tid < 16) dec[tid] = expf(128.0f * lg);
    }
    const size_t rowb = (size_t)b * SEQ;
    const bf16_t* Xp = BR == 0 ? p.QK_() + rowb * 2048 + h * 512 + 256 : p.P_() + rowb * NP + C_VR + h * 256;
    const int ldX = BR == 0 ? 2048 : NP;
    const bf16_t* Yp = (BR == 0 ? p.P_() + rowb * NP + C_VM + h * 256 : p.P_() + rowb * NP + C_KR + h * 256) + 32 * sl;
    const unsigned yoff = (unsigned)((tid >> 2) * NP + (tid & 3) * 8) * 2u;
    u32x4 xa[8], xb[8], ya, yb;
    tile_load<32>(xa, Xp, ldX, tid); ya = *(const u32x4*)((const char*)Yp + yoff);
    tile_load<32>(xb, Xp + (size_t)128 * ldX, ldX, tid); yb = *(const u32x4*)((const char*)(Yp + (size_t)128 * NP) + yoff);
    f32x4 st[2][2], nst[2];
#pragma unroll
    for (int i = 0; i < 2; ++i) { nst[i] = (f32x4){0.f, 0.f, 0.f, 0.f};
#pragma unroll
        for (int j = 0; j < 2; ++j) st[i][j] = (f32x4){0.f, 0.f, 0.f, 0.f}; }
    const unsigned lpart = (unsigned)(((8 * g + (lr >> 2)) * 272 + 4 * (lr & 3)) * 2), lparty = (unsigned)(((8 * g + (lr >> 2)) * 40 + 4 * (lr & 3)) * 2);
    const unsigned baseX = lds_addr(Xt) + lpart + (unsigned)(32 * w * 2), baseY = lds_addr(Ys) + lparty;
    bf16_t* CSp = p.CS_() + (size_t)pi * 16 * SZ + (size_t)(32 * sl + lr) * 256 + 32 * w + 4 * g;
    float* NSp = p.NS_() + (size_t)bh * 16 * 256 + 32 * w + 4 * g;
    const bool nown = (BR == 0) && (sl == 0) && (lr == 0);
    __syncthreads();
    auto step = [&](int c, u32x4 (&xr)[8], u32x4& yr) {
#pragma unroll
        for (int rt = 0; rt < 2; ++rt) {
#pragma unroll
            for (int ct = 0; ct < 2; ++ct) *(u32x2*)(CSp + (size_t)c * SZ + (size_t)(16 * ct) * 256 + 16 * rt) = (u32x2){pk2(st[rt][ct][0], st[rt][ct][1]), pk2(st[rt][ct][2], st[rt][ct][3])};
            if (nown) *(f32x4*)(NSp + (size_t)c * 256 + 16 * rt) = nst[rt];
        }
        tile_store<32, 544>(Xt, xr, tid);
        { float f[8]; unpack8(yr, f); const float ww = wka[c * 128 + (tid >> 2)];
#pragma unroll
          for (int j = 0; j < 8; ++j) f[j] *= ww;
          *(LAS u32x4*)(Ys + (tid >> 2) * 80 + (tid & 3) * 16) = pack8(f); }
        __syncthreads();
        if (c + 2 < 16) {
            tile_load<32>(xr, Xp + (size_t)(c + 2) * 128 * ldX, ldX, tid);
            yr = *(const u32x4*)((const char*)(Yp + (size_t)(c + 2) * 128 * NP) + yoff);
        }
        f32x4 u[2][2], un[2];
#pragma unroll
        for (int i = 0; i < 2; ++i) { un[i] = (f32x4){0.f, 0.f, 0.f, 0.f};
#pragma unroll
            for (int j = 0; j < 2; ++j) u[i][j] = (f32x4){0.f, 0.f, 0.f, 0.f}; }
        sfor<0, 4>([&](auto ks_) {
            constexpr int ks = decltype(ks_)::value;
            bf16x8 fa0, fa1, fb0, fb1;
            tr_frag2<ks * 32 * 544, 4 * 544, 32>(baseX, fa0, fa1);
            tr_frag2<ks * 32 * 80, 4 * 80, 32>(baseY, fb0, fb1);
            u[0][0] = __builtin_amdgcn_mfma_f32_16x16x32_bf16(fa0, fb0, u[0][0], 0, 0, 0); u[0][1] = __builtin_amdgcn_mfma_f32_16x16x32_bf16(fa0, fb1, u[0][1], 0, 0, 0);
            u[1][0] = __builtin_amdgcn_mfma_f32_16x16x32_bf16(fa1, fb0, u[1][0], 0, 0, 0); u[1][1] = __builtin_amdgcn_mfma_f32_16x16x32_bf16(fa1, fb1, u[1][1], 0, 0, 0);
            if (BR == 0) {
                const f32x4 w0 = *(LAS const f32x4*)(wka + c * 128 + 32 * ks + 8 * g), w1 = *(LAS const f32x4*)(wka + c * 128 + 32 * ks + 8 * g + 4);
                u32x4 wv = (u32x4){pk2(w0[0], w0[1]), pk2(w0[2], w0[3]), pk2(w1[0], w1[1]), pk2(w1[2], w1[3])};
                if (lr != 0) wv = (u32x4){0u, 0u, 0u, 0u};
                const bf16x8 wf = __builtin_bit_cast(bf16x8, wv);
                un[0] = __builtin_amdgcn_mfma_f32_16x16x32_bf16(fa0, wf, un[0], 0, 0, 0); un[1] = __builtin_amdgcn_mfma_f32_16x16x32_bf16(fa1, wf, un[1], 0, 0, 0);
            }
        });
        const float dc = dec[c];
#pragma unroll
        for (int i = 0; i < 2; ++i) { nst[i] = nst[i] * dc + un[i];
#pragma unroll
            for (int j = 0; j < 2; ++j) st[i][j] = st[i][j] * dc + u[i][j]; }
        __syncthreads();
    };
#pragma unroll 1
    for (int c = 0; c < 16; c += 2) { step(c, xa, ya); step(c + 1, xb, yb); }
    float* fo = p.out + (BR == 0 ? O_CP : O_SP) + (((size_t)layer * BP + b) * HM + h) * SZ + (size_t)(32 * sl + lr) * 256 + 32 * w + 4 * g;
#pragma unroll
    for (int rt = 0; rt < 2; ++rt) {
#pragma unroll
        for (int ct = 0; ct < 2; ++ct) *(f32x4*)(fo + (size_t)(16 * ct) * 256 + 16 * rt) = st[rt][ct];
        if (nown) *(f32x4*)(p.out + O_NP + (((size_t)layer * BP + b) * HM + h) * 256 + 32 * w + 4 * g + 16 * rt) = nst[rt];
    }
    if (BR == 0 && sl == 0 && tid == 0) p.out[O_MP + ((size_t)layer * BP + b) * HM + h] = gt[6192];
    __syncthreads();
}

__device__ __forceinline__ void scan_item(const Params& p, int layer, int pi, int slice, LAS unsigned char* lds) {
    LAS float* G = (LAS float*)lds; LAS float* dec = G + 512;
    const int tid = opaque_tid(), br = pi >> 4, bh = pi & 15, b = bh >> 2, h = bh & 3;
    if (br == 0) { const float* gt = p.GT_() + (size_t)bh * 6208; if (tid < 16) { const float mc = gt[6176 + tid]; dec[tid] = expf(mc - fmaxf(mc, gt[6160 + tid])); } if (tid == 0) G[48] = gt[6192]; }
    else if (tid < 16) dec[tid] = expf(128.0f * ret_lg(h));
    __syncthreads();
    float st[2][8];
#pragma unroll
    for (int j = 0; j < 2; ++j)
#pragma unroll
        for (int k = 0; k < 8; ++k) st[j][k] = 0.f;
    for (int c = 0; c < 16; ++c) {
        const float dc = dec[c];
#pragma unroll
        for (int j = 0; j < 2; ++j) { const size_t idx = (size_t)slice * 8192 + j * 4096 + tid * 8;
            float u[8]; unpack8(*(const u32x4*)(p.U_() + ((size_t)pi * 16 + c) * SZ + idx), u);
            *(u32x4*)(p.CS_() + ((size_t)pi * 16 + c) * SZ + idx) = pack8(st[j]);
#pragma unroll
            for (int k = 0; k < 8; ++k) st[j][k] = st[j][k] * dc + u[k]; }
    }
    float* fo = p.out + (br == 0 ? O_CP : O_SP) + (((size_t)layer * BP + b) * HM + h) * SZ;
#pragma unroll
    for (int j = 0; j < 2; ++j) { float* q = fo + (size_t)slice * 8192 + j * 4096 + tid * 8;
        *(f32x4*)q = (f32x4){st[j][0], st[j][1], st[j][2], st[j][3]}; *(f32x4*)(q + 4) = (f32x4){st[j][4], st[j][5], st[j][6], st[j][7]}; }
    if (br == 0 && slice == 0) {
        if (tid < 256) { float n = 0.f;
            for (int c = 0; c < 16; ++c) { p.NS_()[((size_t)bh * 16 + c) * 256 + tid] = n; n = dec[c] * n + p.NU_()[((size_t)bh * 16 + c) * 256 + tid]; }
            p.out[O_NP + (((size_t)layer * BP + b) * HM + h) * 256 + tid] = n; }
        if (tid == 0) p.out[O_MP + ((size_t)layer * BP + b) * HM + h] = G[48];
    }
    __syncthreads();
}

template <int BR>
__device__ __forceinline__ void chunk_passC(const Params& p, int layer, int b, int h, int c, LAS unsigned char* lds) {
    LAS unsigned char* BufB = lds; LAS unsigned char* Sw = lds + 69632; LAS float* G = (LAS float*)(lds + 104448);
    LAS float* av = G + 512; LAS float* fl = G + 640; LAS bf16_t* nbf = (LAS bf16_t*)(G + 768);
    const int tid = opaque_tid(), lane = tid & 63, w = __builtin_amdgcn_readfirstlane(tid >> 6), g = lane >> 4, lr = lane & 15;
    const size_t row0 = (size_t)b * SEQ + c * 128;
    const int pi = BR * 16 + b * 4 + h, l = 16 * w + lr;
    const float lg = ret_lg(h);
    u32x4 tr[8];
    tile_load<32>(tr, BR == 0 ? p.QK_() + row0 * 2048 + h * 512 + 256 : p.P_() + row0 * NP + C_KR + h * 256, BR == 0 ? 2048 : NP, tid);
    if (BR == 0) {
        gate_load(p, b * 4 + h, c, G, tid);
        if (tid < 128) { av[tid] = expf(G[32 + c] - G[320 + tid]); fl[tid] = expf(-(G[64 + tid] + G[320 + tid])); }
        if (tid < 256) nbf[tid] = f2bf(p.NS_()[((size_t)(b * 4 + h) * 16 + c) * 256 + tid]);
    } else { if (tid < 128) av[tid] = expf((float)(tid + 1) * lg); }
    const bf16_t* Qp = BR == 0 ? p.QK_() + (row0 + l) * 2048 + h * 512 : p.P_() + (row0 + l) * NP + C_QR + h * 256;
    bf16x8 qf[8];
#pragma unroll
    for (int ks = 0; ks < 8; ++ks) qf[ks] = *(const bf16x8*)(Qp + 32 * ks + 8 * g);
    tile_store<32, 544>(BufB, tr, tid);
    __syncthreads();
    const bf16_t* CSp = p.CS_() + ((size_t)pi * 16 + c) * SZ;
    if (BR == 0) tile_load<32>(tr, CSp, 256, tid); else tile_load<16>(tr, CSp, 256, tid);
    float rs = 0.f;
    const float Gl = BR == 0 ? G[320 + l] : 0.f;
#pragma unroll
    for (int j = 0; j < 8; ++j) {
        f32x4 a = (f32x4){0.f, 0.f, 0.f, 0.f};
        if (j <= w) {
#pragma unroll
            for (int ks = 0; ks < 8; ++ks) a = __builtin_amdgcn_mfma_f32_16x16x32_bf16(lds_frag(BufB, 16 * j + lr, 544, (32 * ks + 8 * g) * 2), qf[ks], a, 0, 0, 0);
        }
        float v[4];
#pragma unroll
        for (int r = 0; r < 4; ++r) {
            const int sidx = 16 * j + 4 * g + r;
            float d = 0.f;
            if (sidx <= l) d = BR == 0 ? expf(G[192 + sidx] - Gl) : expf((float)(l - sidx) * lg);
            v[r] = a[r] * d; rs += v[r];
        }
        *(LAS u32x2*)(Sw + l * 272 + (16 * j + 4 * g) * 2) = (u32x2){pk2(v[0], v[1]), pk2(v[2], v[3])};
        __builtin_amdgcn_sched_barrier(0);
    }
    rs += __shfl_xor(rs, 16); rs += __shfl_xor(rs, 32);
    __syncthreads();
    f32x4 accN[16];
#pragma unroll
    for (int t = 0; t < 16; ++t) accN[t] = (f32x4){0.f, 0.f, 0.f, 0.f};
    const unsigned lq = (unsigned)(8 * g + (lr >> 2)), lp4 = (unsigned)(4 * (lr & 3));
    sfor<0, 2>([&](auto half_) {
        constexpr int half = decltype(half_)::value;
        if (BR == 0) tile_store<32, 544>(BufB, tr, tid); else tile_store<16, 272>(BufB, tr, tid);
        __syncthreads();
        if (half == 0) { if (BR == 0) tile_load<32>(tr, CSp + 128 * 256, 256, tid); else tile_load<16>(tr, CSp + 128, 256, tid); }
        else tile_load<32>(tr, p.P_() + row0 * NP + (BR == 0 ? C_VM : C_VR) + h * 256, NP, tid);
        if (BR == 0) {
#pragma unroll
            for (int t = 0; t < 8; ++t) {
#pragma unroll
                for (int ks = 0; ks < 8; ++ks)
                    accN[half * 8 + t] = __builtin_amdgcn_mfma_f32_16x16x32_bf16(lds_frag(BufB, 16 * t + lr, 544, (32 * ks + 8 * g) * 2), qf[ks], accN[half * 8 + t], 0, 0, 0);
                __builtin_amdgcn_sched_barrier(0); }
        } else {
            const unsigned base = lds_addr(BufB) + (lq * 136 + lp4) * 2;
            sfor<0, 8>([&](auto ks_) {
                constexpr int ks = decltype(ks_)::value;
                sfor<0, 2>([&](auto tq_) {
                    constexpr int tq = decltype(tq_)::value;
                    bf16x8 f[4];
                    tr_frag4<ks * 32 * 272 + tq * 128, 4 * 272, 32>(base, f);
#pragma unroll
                    for (int i = 0; i < 4; ++i) accN[half * 8 + 4 * tq + i] = __builtin_amdgcn_mfma_f32_16x16x32_bf16(f[i], qf[ks], accN[half * 8 + 4 * tq + i], 0, 0, 0);
                });
            });
        }
        __syncthreads();
    });
    float nq = 0.f;
    if (BR == 0) {
        f32x4 ad = (f32x4){0.f, 0.f, 0.f, 0.f};
#pragma unroll
        for (int ks = 0; ks < 8; ++ks) {
            bf16x8 nf = *(LAS const bf16x8*)(nbf + 32 * ks + 8 * g);
            if (lr != 0) nf = (bf16x8){0, 0, 0, 0, 0, 0, 0, 0};
            ad = __builtin_amdgcn_mfma_f32_16x16x32_bf16(nf, qf[ks], ad, 0, 0, 0);
        }
        nq = __shfl(ad[0], lr);
    }
    const float al = av[l];
#pragma unroll
    for (int t = 0; t < 16; ++t) accN[t] *= al;
    tile_store<32, 544>(BufB, tr, tid);
    __syncthreads();
    {
        const unsigned base = lds_addr(BufB) + (lq * 272 + lp4) * 2;
        sfor<0, 4>([&](auto ks_) {
            constexpr int ks = decltype(ks_)::value;
            const bf16x8 bfr = lds_frag(Sw, l, 272, (32 * ks + 8 * g) * 2);
            sfor<0, 4>([&](auto tq_) {
                constexpr int tq = decltype(tq_)::value;
                bf16x8 f[4];
                tr_frag4<ks * 32 * 544 + tq * 128, 4 * 544, 32>(base, f);
#pragma unroll
                for (int i = 0; i < 4; ++i) accN[4 * tq + i] = __builtin_amdgcn_mfma_f32_16x16x32_bf16(f[i], bfr, accN[4 * tq + i], 0, 0, 0);
            });
        });
    }
    float inv = 1.0f;
    if (BR == 0) inv = 1.0f / fmaxf(fabsf(rs + al * nq), fl[l]);
    float sm = 0.f;
#pragma unroll
    for (int t = 0; t < 16; ++t) { accN[t] *= inv; sm += (accN[t][0] + accN[t][1]) + (accN[t][2] + accN[t][3]); }
    sm += __shfl_xor(sm, 16); sm += __shfl_xor(sm, 32);
    const float mu = sm * (1.0f / 256.0f);
    float qv = 0.f;
#pragma unroll
    for (int t = 0; t < 16; ++t) { const f32x4 d = accN[t] - mu; qv += (d[0] * d[0] + d[1] * d[1]) + (d[2] * d[2] + d[3] * d[3]); }
    qv += __shfl_xor(qv, 16); qv += __shfl_xor(qv, 32);
    const float rstd = rsqrtf(qv * (1.0f / 256.0f) + EPS);
    const float* gain = (BR == 0 ? p.hn_m_g : p.hn_r_g) + (size_t)layer * WM + h * 256 + 4 * g;
    const float* skip = p.skip_m + (size_t)layer * WM + h * 256 + 4 * g;
    const size_t row = row0 + l;
    const bf16_t* zp = p.P_() + row * NP + (BR == 0 ? C_ZM : C_ZR) + h * 256 + 4 * g;
    const bf16_t* cp = p.CM_() + row * WM + h * 256 + 4 * g;
    bf16_t* op = p.OC_() + row * 2048 + BR * 1024 + h * 256 + 4 * g;
#pragma unroll
    for (int t = 0; t < 16; ++t) {
        const f32x4 ge = *(const f32x4*)(gain + 16 * t);
        const u32x2 zb = *(const u32x2*)(zp + 16 * t);
        f32x4 v = (accN[t] - mu) * rstd * ge;
        if (BR == 0) { const f32x4 sk = *(const f32x4*)(skip + 16 * t); const u32x2 cb = *(const u32x2*)(cp + 16 * t);
            v[0] += sk[0] * __uint_as_float(cb.x << 16); v[1] += sk[1] * __uint_as_float(cb.x & 0xffff0000u);
            v[2] += sk[2] * __uint_as_float(cb.y << 16); v[3] += sk[3] * __uint_as_float(cb.y & 0xffff0000u); }
        const float z0 = __uint_as_float(zb.x << 16), z1 = __uint_as_float(zb.x & 0xffff0000u), z2 = __uint_as_float(zb.y << 16), z3 = __uint_as_float(zb.y & 0xffff0000u);
        *(u32x2*)(op + 16 * t) = (u32x2){pk2(v[0] * siluf_(z0), v[1] * siluf_(z1)), pk2(v[2] * siluf_(z2), v[3] * siluf_(z3))};
    }
    __syncthreads();
}

__device__ __forceinline__ f32x4 bf4_to_f32(u32x2 v) { return (f32x4){__uint_as_float(v.x << 16), __uint_as_float(v.x & 0xffff0000u), __uint_as_float(v.y << 16), __uint_as_float(v.y & 0xffff0000u)}; }
__device__ __forceinline__ const char* sample_state(const Params& p, int layer, int s) {
    const int br = s >> 9, b = (s >> 2) & 127, h = s & 3;
    return (const char*)((br == 0 ? p.st_C : p.st_S) + (((size_t)layer * BS + b) * HM + h) * SZ);
}
template <int BR>
__device__ __forceinline__ void sample_item(const Params& p, int layer, int b, int h, LAS float* base, const f32x4 (&cin)[8], f32x4 (&cnx)[8], const char* nsrc) {
    LAS float* sq = base; LAS float* sk = sq + 256; LAS float* sv = sk + 256; LAS float* sr = sv + 256; LAS float* part = sr + 256;
    const int tid = opaque_tid(), lane = tid & 63, wid = __builtin_amdgcn_readfirstlane(tid >> 6), e0 = 4 * lane;
    const size_t R = (size_t)MP + b;
    const size_t sidx = ((size_t)layer * BS + b) * HM + h;
    const bf16_t* qg = BR == 0 ? p.QK_() + R * 2048 + h * 512 : p.P_() + R * NP + C_QR + h * 256;
    const bf16_t* kg = BR == 0 ? p.QK_() + R * 2048 + h * 512 + 256 : p.P_() + R * NP + C_KR + h * 256;
    const bf16_t* vg = p.P_() + R * NP + (BR == 0 ? C_VM : C_VR) + h * 256;
    if (tid < 256) { sq[tid] = bf2f(qg[tid]); sk[tid] = bf2f(kg[tid]); sv[tid] = bf2f(vg[tid]); }
    const f32x4 q4 = bf4_to_f32(*(const u32x2*)(qg + e0)), k4 = bf4_to_f32(*(const u32x2*)(kg + e0)), v4 = bf4_to_f32(*(const u32x2*)(vg + e0));
    float wgt = 1.f, a = 1.0f - exp2f(-5.0f - (float)h), mt = 0.f;
    if (BR == 0) {
        const float ig = p.IF_()[R * 8 + h] + p.b_i[layer * HM + h];
        const float lf = logsigf_(p.IF_()[R * 8 + 4 + h] + p.b_f[layer * HM + h]);
        const float inter = lf + p.st_m[sidx];
        mt = fmaxf(inter, ig); wgt = expf(ig - mt); a = expf(inter - mt);
    }
    const char* sb = sample_state(p, layer, (BR << 9) | (b << 2) | h) + (size_t)wid * 1024 + (unsigned)lane * 16u;
    char* ob = (char*)(p.out + (BR == 0 ? O_CS : O_SS) + sidx * SZ) + (size_t)wid * 1024 + (unsigned)lane * 16u;
    __syncthreads();
    f32x4 cc[8], cn[8];
#pragma unroll
    for (int j = 0; j < 8; ++j) cc[j] = cin[j];
    f32x4 ac = (f32x4){0.f, 0.f, 0.f, 0.f};
#pragma unroll
    for (int i0 = 0; i0 < 32; i0 += 8) {
        if (i0 + 8 < 32) {
#pragma unroll
            for (int j = 0; j < 8; ++j) cn[j] = __builtin_nontemporal_load((const f32x4*)(sb + (size_t)(i0 + 8 + j) * 8192));
        } else if (nsrc) {
            const char* nb = nsrc + (size_t)wid * 1024 + (unsigned)lane * 16u;
#pragma unroll
            for (int j = 0; j < 8; ++j) cnx[j] = __builtin_nontemporal_load((const f32x4*)(nb + (size_t)j * 8192));
        }
#pragma unroll
        for (int j = 0; j < 8; ++j) { const int e = wid + 8 * (i0 + j);
            if (BR == 0) {
                float pt = (cc[j][0] * q4[0] + cc[j][1] * q4[1]) + (cc[j][2] * q4[2] + cc[j][3] * q4[3]);
                __builtin_nontemporal_store(cc[j] * a + k4 * (wgt * sv[e]), (f32x4*)(ob + (size_t)(i0 + j) * 8192));
                pt = wave_sum(pt);
                if (lane == 0) sr[e] = pt;
            } else {
                ac = ac + cc[j] * sq[e];
                __builtin_nontemporal_store(cc[j] * a + v4 * sk[e], (f32x4*)(ob + (size_t)(i0 + j) * 8192));
            }
        }
        if (i0 + 8 < 32) {
#pragma unroll
            for (int j = 0; j < 8; ++j) cc[j] = cn[j];
        }
    }
    if (BR == 1) *(LAS f32x4*)(part + wid * 256 + e0) = ac;
    __syncthreads();
    if (wid == 0) {
        f32x4 hv;
        if (BR == 0) {
            const f32x4 n4 = *(const f32x4*)(p.st_n + sidx * 256 + e0);
            const f32x4 cq = *(LAS const f32x4*)(sr + e0);
            const float qk = wave_sum((q4[0] * k4[0] + q4[1] * k4[1]) + (q4[2] * k4[2] + q4[3] * k4[3]));
            const float nq = wave_sum((n4[0] * q4[0] + n4[1] * q4[1]) + (n4[2] * q4[2] + n4[3] * q4[3]));
            const float ws = wgt * qk, inv = 1.0f / fmaxf(fabsf(ws + a * nq), expf(-mt));
            hv = (v4 * ws + cq * a) * inv;
            *(f32x4*)(p.out + O_NS + sidx * 256 + e0) = n4 * a + k4 * wgt;
            if (lane == 0) p.out[O_MS + sidx] = mt;
        } else {
            f32x4 oi = (f32x4){0.f, 0.f, 0.f, 0.f};
#pragma unroll
            for (int i = 0; i < 8; ++i) oi = oi + *(LAS const f32x4*)(part + i * 256 + e0);
            const float qk = wave_sum((q4[0] * k4[0] + q4[1] * k4[1]) + (q4[2] * k4[2] + q4[3] * k4[3]));
            hv = v4 * qk + oi * a;
        }
        const float mean = wave_sum((hv[0] + hv[1]) + (hv[2] + hv[3])) * (1.0f / 256.0f);
        const f32x4 dv = hv - mean;
        const float rstd = rsqrtf(wave_sum((dv[0] * dv[0] + dv[1] * dv[1]) + (dv[2] * dv[2] + dv[3] * dv[3])) * (1.0f / 256.0f) + EPS);
        const f32x4 ge = *(const f32x4*)((BR == 0 ? p.hn_m_g : p.hn_r_g) + (size_t)layer * WM + h * 256 + e0);
        f32x4 v = dv * rstd * ge;
        const f32x4 z = bf4_to_f32(*(const u32x2*)(p.P_() + R * NP + (BR == 0 ? C_ZM : C_ZR) + h * 256 + e0));
        if (BR == 0) v = v + *(const f32x4*)(p.skip_m + (size_t)layer * WM + h * 256 + e0) * bf4_to_f32(*(const u32x2*)(p.CM_() + R * WM + h * 256 + e0));
        *(u32x2*)(p.OC_() + R * 2048 + BR * 1024 + h * 256 + e0) = (u32x2){pk2(v[0] * siluf_(z[0]), v[1] * siluf_(z[1])), pk2(v[2] * siluf_(z[2]), v[3] * siluf_(z[3]))};
    }
    __syncthreads();
}

template <int MODE>
__device__ __forceinline__ void sample_gemm(const Params& p, const bf16_t* Wl, int wg, int nwg, LAS unsigned char* lds, unsigned long long* ssn) {
    const int tid = opaque_tid(), lane = tid & 63, w = tid >> 6, g = lane >> 4, lr = lane & 15, hf = w >> 2;
    LAS f32x4* xch = (LAS f32x4*)lds;
    LAS float* red = (LAS float*)(lds + 4096);
    for (int j = wg; j < 256; j += nwg) {
        const int rbase = MP + 32 * (j & 3) + 16 * ((w >> 1) & 1), cbase = 32 * (j >> 2) + 16 * (w & 1);
        const bf16_t* A = (MODE == 0 ? p.OC_() : p.MG_()) + (size_t)(rbase + lr) * 2048 + hf * 1024 + 8 * g;
        const bf16_t* B = Wl + (MODE == 0 ? W3_OFF : W4_OFF) + (size_t)(cbase + lr) * 2048 + hf * 1024 + 8 * g;
        f32x4 acc = (f32x4){0.f, 0.f, 0.f, 0.f};
#pragma unroll 1
        for (int k0 = 0; k0 < 1024; k0 += 512) {
            bf16x8 af[16], bf[16];
#pragma unroll
            for (int i = 0; i < 16; ++i) { af[i] = *(const bf16x8*)(A + k0 + 32 * i); bf[i] = *(const bf16x8*)(B + k0 + 32 * i); }
#pragma unroll
            for (int i = 0; i < 16; ++i) acc = __builtin_amdgcn_mfma_f32_16x16x32_bf16(af[i], bf[i], acc, 0, 0, 0);
        }
        if (hf == 1) xch[(w & 3) * 64 + lane] = acc;
        __syncthreads();
        if (hf == 0) {
            const f32x4 hi = xch[(w & 3) * 64 + lane];
            const int col = cbase + lr;
#pragma unroll
            for (int r = 0; r < 4; ++r) {
                const size_t row = (size_t)rbase + 4 * g + r;
                if (MODE == 0) {
                    const float rt = bf2f(p.RT_()[row * 2048 + col]), gr = bf2f(p.GRS_()[row * 2048 + col]);
                    p.MG_()[row * 2048 + col] = f2bf(gr * (rt * acc[r] + hi[r]));
                } else {
                    const bf16_t nb = f2bf(bf2f(p.Xb_()[row * 2048 + col]) + acc[r] + hi[r]);
                    p.Xb_()[row * 2048 + col] = nb;
                    float q = bf2f(nb) * bf2f(nb);
                    q += __shfl_xor(q, 1); q += __shfl_xor(q, 2); q += __shfl_xor(q, 4); q += __shfl_xor(q, 8);
                    if (lr == 0) red[(w & 1) * 32 + 16 * ((w >> 1) & 1) + 4 * g + r] = q;
                }
            }
        }
        if (MODE == 1) {
            __syncthreads();
            if (tid < 32) atomicAdd(ssn + MP + 32 * (j & 3) + tid, ss_fix(red[tid] + red[32 + tid]));
        }
        __syncthreads();
    }
}

__device__ __forceinline__ void sample_gemm2(const Params& p, const bf16_t* W2t, int wg, int nwg) {
    const int tid = opaque_tid(), lane = tid & 63, w = tid >> 6, g = lane >> 4, lr = lane & 15;
    for (int j = wg; j < 128; j += nwg) {
        const int rbase = MP + 16 * (j & 7), cbase = 128 * (j >> 3) + 16 * w, head = cbase >> 9;
        const bf16_t* A = p.CM_() + (size_t)(rbase + lr) * WM + head * 256 + 8 * g;
        const bf16_t* B = W2t + (size_t)(cbase + lr) * 256 + 8 * g;
        bf16x8 af[8], bf[8];
#pragma unroll
        for (int i = 0; i < 8; ++i) { af[i] = *(const bf16x8*)(A + 32 * i); bf[i] = *(const bf16x8*)(B + 32 * i); }
        f32x4 acc = (f32x4){0.f, 0.f, 0.f, 0.f};
#pragma unroll
        for (int i = 0; i < 8; ++i) acc = __builtin_amdgcn_mfma_f32_16x16x32_bf16(af[i], bf[i], acc, 0, 0, 0);
#pragma unroll
        for (int r = 0; r < 4; ++r) p.QK_()[(size_t)(rbase + 4 * g + r) * 2048 + cbase + lr] = f2bf(acc[r]);
    }
}

__device__ __forceinline__ void phaseA(const Params& p, int layer, int wg, int nwg, LAS unsigned char* lds) {
    for (int it = wg; it < 256; it += nwg) {
        const int pi = (it & 7) * 4 + (it >> 6), sl = (it >> 3) & 7, bh = pi & 15;
        if (pi < 16) chunk_state_item<0>(p, layer, bh >> 2, bh & 3, sl, lds); else chunk_state_item<1>(p, layer, bh >> 2, bh & 3, sl, lds);
    }
    {
        const int tid = opaque_tid(), lane = tid & 63, wid = __builtin_amdgcn_readfirstlane(tid >> 6);
        int s = wg, k = 0;
        if (s < 1024) {
            f32x4 cc[8], cx[8];
            { const char* sb = sample_state(p, layer, s) + (size_t)wid * 1024 + (unsigned)lane * 16u;
#pragma unroll
              for (int j = 0; j < 8; ++j) cc[j] = __builtin_nontemporal_load((const f32x4*)(sb + (size_t)j * 8192)); }
            for (;; ++k) {
                const int sn = s + nwg;
                const char* nsrc = sn < 1024 ? sample_state(p, layer, sn) : nullptr;
                LAS float* base = (LAS float*)lds + (k & 1) * 3072;
                const int b = (s >> 2) & 127, h = s & 3;
                if (s < 512) sample_item<0>(p, layer, b, h, base, cc, cx, nsrc); else sample_item<1>(p, layer, b, h, base, cc, cx, nsrc);
                if (sn >= 1024) break;
#pragma unroll
                for (int j = 0; j < 8; ++j) cc[j] = cx[j];
                s = sn;
            }
        }
        __syncthreads();
    }
}
__device__ __forceinline__ void phaseScan(const Params& p, int layer, int wg, int nwg, LAS unsigned char* lds) {
    for (int it = wg; it < 256; it += nwg) scan_item(p, layer, it >> 3, it & 7, lds);
}
__device__ __forceinline__ void phaseC(const Params& p, int layer, int wg, int nwg, LAS unsigned char* lds) {
    for (int it = wg; it < 512; it += nwg) {
        const int br = it >> 8, rest = it & 255, b = rest >> 6, h = (rest >> 4) & 3, c = rest & 15;
        if (br == 0) chunk_passC<0>(p, layer, b, h, c, lds); else chunk_passC<1>(p, layer, b, h, c, lds);
    }
}

template <int ONLY>
__device__ __forceinline__ void run_phases(const Params& p_in, int ph_lo, int ph_hi) {
    extern __shared__ __attribute__((aligned(16))) unsigned char smem_raw[];
    LAS unsigned char* lds = (LAS unsigned char*)smem_raw;
    volatile LAS unsigned* xbw = (volatile LAS unsigned*)(lds + LDS_BYTES - 16);
    const int wg_in = blockIdx.x, nwg = gridDim.x;
    const bool multi = (ph_hi - ph_lo) > 1;
    XcdBarrier bar; bar.bar = p_in.bar_(); bar.x = 0; bar.st = xbw;
    if (multi) {
        if (threadIdx.x == 0) { xbw[0] = 0u; xbw[1] = 0u; xbw[2] = 0u; xbw[3] = 0u; }
        __syncthreads();
        bar = xcd_barrier_post(p_in.bar_(), xbw);
    }
    int ph = 0; unsigned long long tacc_ = 0;
#define PHASE(KIND, ...) { if constexpr (ONLY < 0 || ONLY == KIND) { if (ph >= ph_lo && ph < ph_hi) { \
    unsigned long long t0_ = 0; if (KIND == TIMEK) t0_ = __builtin_amdgcn_s_memrealtime(); \
    Params p = p_in; int wg = wg_in; { size_t z_ = 0; asm volatile("" : "+s"(z_), "+s"(wg)); p.ws = p_in.ws + z_; p.out = p_in.out + z_; }     \
    __VA_ARGS__; if (ph + 1 < ph_hi) xcd_barrier(bar); \
    if (KIND == TIMEK) tacc_ += __builtin_amdgcn_s_memrealtime() - t0_; } } ++ph; }
    PHASE(0, prep_phase(p, wg, nwg, lds))
    for (int layer = 0; layer < DEPTH; ++layer) {
        PHASE(2, { pg8::StaticOrder S; S.init(MPAD, N1, nwg, wg); pg8::Gemm g{p.Xb_(), p.W_() + (size_t)layer * WL + W1_OFF, D, D, D, 31, 0, 0};
                pg8::EpiG1 E{p.P_(), p.b_gate + (size_t)layer * 4096, p.RT_(), p.GRS_(), p.ROPE_(), p.SS_() + (size_t)layer * MPAD, p.SSP_(), p.IF_()}; pg8::gemm_phase<false>(lds, g, S, E); })
        PHASE(3, conv_phase(p, layer, wg, nwg, lds))
        PHASE(4, { pg8::StaticOrder S; S.init(MP, 2048, nwg, wg); pg8::Gemm g{p.CM_(), p.W_() + (size_t)layer * WL + W2_OFF, 256, WM, 256, 1, 512, 0};
                pg8::EpiBf16 E{p.QK_(), 2048}; pg8::gemm_phase<false>(lds, g, S, E); sample_gemm2(p, p.W_() + (size_t)layer * WL + W2_OFF, wg, nwg); })
        PHASE(5, phaseA(p, layer, wg, nwg, lds))
        PHASE(7, phaseC(p, layer, wg, nwg, lds))
        PHASE(8, { pg8::StaticOrder S; S.init(MP, 2048, nwg, wg); pg8::Gemm g{p.OC_(), p.W_() + (size_t)layer * WL + W3_OFF, 2048, 2048, 2048, 31, 0, 16};
                pg8::EpiMerged E{p.MG_(), p.RT_(), p.GRS_()}; pg8::gemm_phase<true>(lds, g, S, E); sample_gemm<0>(p, p.W_() + (size_t)layer * WL, wg, nwg, lds, nullptr); })
        PHASE(10, { pg8::StaticOrder S; S.init(MP, 2048, nwg, wg); pg8::Gemm g{p.MG_(), p.W_() + (size_t)layer * WL + W4_OFF, 2048, 2048, 2048, 31, 0, 0};
                pg8::EpiResidual E{p.Xb_(), p.SSP_(), (LAS float*)(lds + pg8::STAGE_BYTES)}; pg8::gemm_phase<false>(lds, g, S, E); sample_gemm<1>(p, p.W_() + (size_t)layer * WL, wg, nwg, lds, p.SS_() + (size_t)(layer + 1) * MPAD); })
    }
    PHASE(11, final_phase(p, wg, nwg))
    if (TIMEK >= 0 && blockIdx.x == 0) { const unsigned long long te_ = __builtin_amdgcn_s_memrealtime(); while (__builtin_amdgcn_s_memrealtime() - te_ < TIMEX * tacc_) __builtin_amdgcn_s_sleep(8); }
#undef PHASE
}
__global__ void __launch_bounds__(512, 2) mega(Params p, int ph_lo, int ph_hi) { run_phases<-1>(p, ph_lo, ph_hi); }
#ifdef DIAG
template <int K> __global__ void __launch_bounds__(512, 2) mega_k(Params p, int ph_lo, int ph_hi) { run_phases<K>(p, ph_lo, ph_hi); }
template __global__ void mega_k<0>(Params, int, int); template __global__ void mega_k<2>(Params, int, int);
template __global__ void mega_k<3>(Params, int, int); template __global__ void mega_k<4>(Params, int, int); template __global__ void mega_k<5>(Params, int, int);
template __global__ void mega_k<7>(Params, int, int); template __global__ void mega_k<8>(Params, int, int);
template __global__ void mega_k<10>(Params, int, int); template __global__ void mega_k<11>(Params, int, int);
#endif
constexpr int N_PHASES = 2 + DEPTH * 7;

extern "C" void kernel_launch(void* const* d_in, const int* in_sizes, int n_in, void* d_out, int out_size, void* d_ws, size_t ws_size, hipStream_t stream) {
    (void)in_sizes; (void)n_in; (void)out_size; (void)ws_size;
    static int grid = 0;
    if (grid == 0) {
        int dev = 0, cus = 0;
        hipGetDevice(&dev);
        hipDeviceGetAttribute(&cus, hipDeviceAttributeMultiprocessorCount, dev);
        if (hipFuncSetAttribute((const void*)mega, hipFuncAttributeMaxDynamicSharedMemorySize, LDS_BYTES) != hipSuccess) fprintf(stderr, "hipFuncSetAttribute failed\n");
        (void)hipGetLastError();
        grid = cus > 0 ? cus : 256;
    }
    Params p{};
    const float** in = (const float**)&p;
    for (int i = 0; i < 24; ++i) in[i] = (const float*)d_in[i];
    p.out = (float*)d_out;
    p.ws = (unsigned char*)d_ws;
    if (ws_size < WS_END) { fprintf(stderr, "workspace too small: %zu < %zu\n", ws_size, (size_t)WS_END); return; }
    hipMemsetAsync(d_ws, 0, 16384, stream);
#if MK_SINGLE
    hipLaunchKernelGGL(mega, dim3(grid), dim3(512), LDS_BYTES, stream, p, 0, N_PHASES);
#else
    for (int ph = 0; ph < N_PHASES; ++ph) hipLaunchKernelGGL(mega, dim3(grid), dim3(512), LDS_BYTES, stream, p, ph, ph + 1);
#endif
}
```

```cpp
#include <hip/hip_runtime.h>
#include <stdint.h>
#include <stdio.h>

#ifndef MK_SINGLE
#define MK_SINGLE 1
#endif

#define LAS __attribute__((address_space(3)))
typedef unsigned short bf16_t;
typedef short bf16x8 __attribute__((ext_vector_type(8)));
typedef float f32x4 __attribute__((ext_vector_type(4)));
typedef unsigned u32x4 __attribute__((ext_vector_type(4)));
typedef unsigned u32x2 __attribute__((ext_vector_type(2)));
typedef float f32x2_t __attribute__((ext_vector_type(2)));

constexpr int D = 2048, SEQ = 2048, BP = 4, BS = 128, DEPTH = 4, HM = 4, DH = 256, WM = 1024, NIN = 7176;
constexpr int MP = BP * SEQ, MT = MP + BS, MPAD = 8448;
constexpr int NP = 7168;
constexpr int N1 = 11520;
constexpr int C_U = 0, C_VM = 1024, C_ZM = 2048, C_QR = 3072, C_KR = 4096, C_VR = 5120, C_ZR = 6144, C_GM = 7168, C_GR = 9216;
constexpr float EPS = 1e-6f;
constexpr size_t SZ = 65536;
constexpr size_t O_YP = 0, O_YS = O_YP + 16777216, O_CP = O_YS + 262144, O_NP = O_CP + 4194304, O_MP = O_NP + 16384, O_CVP = O_MP + 64,
                 O_SP = O_CVP + 49152, O_CS = O_SP + 4194304, O_NS = O_CS + 134217728, O_MS = O_NS + 524288, O_CVS = O_MS + 2048, O_SS = O_CVS + 1572864;
constexpr size_t W1_OFF = 0, W2_OFF = W1_OFF + (size_t)N1 * D, W3_OFF = W2_OFF + (size_t)2048 * 256, W4_OFF = W3_OFF + (size_t)D * D, WL = W4_OFF + (size_t)D * D;
constexpr int LDS_BYTES = 147456;

constexpr size_t al256(size_t x) { return (x + 255) & ~(size_t)255; }
constexpr size_t OFF_BAR = 0, OFF_SS = OFF_BAR + 16384, OFF_SSP = OFF_SS + al256((size_t)5 * MPAD * 8), OFF_XB = OFF_SSP + al256((size_t)8 * MP * 4),
    OFF_P = OFF_XB + al256((size_t)MPAD * D * 2), OFF_IF = OFF_P + al256((size_t)MPAD * NP * 2), OFF_CM = OFF_IF + al256((size_t)MPAD * 8 * 4),
    OFF_QK = OFF_CM + al256((size_t)MPAD * WM * 2), OFF_OC = OFF_QK + al256((size_t)MPAD * 2048 * 2), OFF_MG = OFF_OC + al256((size_t)MPAD * 2048 * 2),
    OFF_U = OFF_MG + al256((size_t)MPAD * 2048 * 2), OFF_CS = OFF_U + al256((size_t)32 * 16 * SZ * 2), OFF_NU = OFF_CS + al256((size_t)32 * 16 * SZ * 2),
    OFF_NS = OFF_NU + al256((size_t)16 * 16 * 256 * 4), OFF_W = OFF_NS + al256((size_t)16 * 16 * 256 * 4), OFF_ROPE = OFF_W + al256((size_t)DEPTH * WL * 2),
    OFF_RT = OFF_ROPE + al256((size_t)2049 * 128 * 2 * 4), OFF_GRS = OFF_RT + al256((size_t)MPAD * 2048 * 2), OFF_GT = OFF_GRS + al256((size_t)MPAD * 2048 * 2),
    WS_END = OFF_GT + al256((size_t)16 * 6208 * 4);

struct Params {
    const float *x_prompt, *x_sample, *st_C, *st_n, *st_m, *st_conv, *st_S, *norm_g, *w_in, *conv_w, *conv_b, *w_qm, *w_km, *b_i, *b_f,
                *hn_m_g, *skip_m, *hn_r_g, *w_pm, *w_pr, *w_gate, *b_gate, *w_o, *final_g;
    float* out;
    unsigned char* ws;
#define WSF(name, type, off) __device__ __forceinline__ type* name##_() const { return (type*)(ws + (off)); }
    WSF(bar, unsigned, OFF_BAR) WSF(SS, unsigned long long, OFF_SS) WSF(SSP, float, OFF_SSP) WSF(Xb, bf16_t, OFF_XB) WSF(P, bf16_t, OFF_P) WSF(IF, float, OFF_IF)
    WSF(CM, bf16_t, OFF_CM) WSF(QK, bf16_t, OFF_QK) WSF(OC, bf16_t, OFF_OC) WSF(MG, bf16_t, OFF_MG) WSF(U, bf16_t, OFF_U) WSF(CS, bf16_t, OFF_CS)
    WSF(NU, float, OFF_NU) WSF(NS, float, OFF_NS) WSF(W, bf16_t, OFF_W) WSF(ROPE, float, OFF_ROPE) WSF(RT, bf16_t, OFF_RT) WSF(GRS, bf16_t, OFF_GRS) WSF(GT, float, OFF_GT)
#undef WSF
};


__device__ __forceinline__ unsigned long long ss_fix(float v) { return (unsigned long long)(v * 1048576.0f + 0.5f); }
__device__ __forceinline__ float ss_val(unsigned long long v) { return (float)v * (1.0f / 1048576.0f); }
__device__ __forceinline__ float row_ss(const float* ssp, const unsigned long long* ss, int row) {
    if (row < 8192) { const f32x4 a = *(const f32x4*)(ssp + (size_t)row * 8), b = *(const f32x4*)(ssp + (size_t)row * 8 + 4);
        return ((a[0] + a[1]) + (a[2] + a[3])) + ((b[0] + b[1]) + (b[2] + b[3])); }
    return ss_val(ss[row]);
}
__device__ __forceinline__ int opaque_tid() { int t = threadIdx.x; asm volatile("" : "+v"(t)); return t; }
__device__ __forceinline__ float bf2f(bf16_t v) { return __uint_as_float((unsigned)v << 16); }
__device__ __forceinline__ bf16_t f2bf(float f) { unsigned u = __float_as_uint(f); u += 0x7fffu + ((u >> 16) & 1u); return (bf16_t)(u >> 16); }
__device__ __forceinline__ unsigned pk2(float lo, float hi) { return (unsigned)f2bf(lo) | ((unsigned)f2bf(hi) << 16); }
__device__ __forceinline__ float wave_sum(float v) {
#pragma unroll
    for (int o = 32; o >= 1; o >>= 1) v += __shfl_xor(v, o);
    return v;
}
__device__ __forceinline__ float wave_max(float v) {
#pragma unroll
    for (int o = 32; o >= 1; o >>= 1) v = fmaxf(v, __shfl_xor(v, o));
    return v;
}
__device__ __forceinline__ float sigmoidf_(float x) { return __builtin_amdgcn_rcpf(1.0f + __expf(-x)); }
__device__ __forceinline__ float siluf_(float x) { return x * __builtin_amdgcn_rcpf(1.0f + __expf(-x)); }
__device__ __forceinline__ float logsigf_(float x) { return x < 0.f ? x - log1pf(expf(x)) : -log1pf(expf(-x)); }
__device__ __forceinline__ void block_sum2(float& a, float& b, LAS float* red) {
    a = wave_sum(a); b = wave_sum(b);
    __syncthreads();
    if ((threadIdx.x & 63) == 0) { red[threadIdx.x >> 6] = a; red[8 + (threadIdx.x >> 6)] = b; }
    __syncthreads();
    float sa = 0.f, sb = 0.f;
#pragma unroll
    for (int i = 0; i < 8; ++i) { sa += red[i]; sb += red[8 + i]; }
    a = sa; b = sb;
}

#define XB_TMO      128
#define XB_XCNT(j)  (256  + 64 * (j))
#define XB_XSUB(j)  (1280 + 64 * (j))
#define XB_XGEN(j)  (2304 + 64 * (j))
#define XB_TOP      3328
#define XB_TOPGEN   3392
#define XCD_BAR_WORDS 3456
#define XB_SPIN_CAP (1u << 22)

__device__ __forceinline__ unsigned xb_ld(unsigned* p)              { return __hip_atomic_load(p, __ATOMIC_RELAXED, __HIP_MEMORY_SCOPE_AGENT); }
__device__ __forceinline__ unsigned xb_add(unsigned* p, unsigned v) { return __hip_atomic_fetch_add(p, v, __ATOMIC_RELAXED, __HIP_MEMORY_SCOPE_AGENT); }
__device__ __forceinline__ unsigned xb_xcc_id() { return (unsigned)__builtin_amdgcn_s_getreg((3 << 11) | 20) & 0xFu; }
#define XB_SPIN(cond, bar) do { unsigned _sp = 0; while (cond) { __builtin_amdgcn_s_sleep(1); \
    if ((++_sp & 255u) == 0u) { if (xb_ld(&(bar)[XB_TMO])) break; if (_sp > XB_SPIN_CAP) { atomicAdd(&(bar)[XB_TMO], 1u); break; } } } } while (0)

struct XcdBarrier { unsigned* bar; unsigned x; volatile LAS unsigned* st; };

__device__ __forceinline__ XcdBarrier xcd_barrier_post(unsigned* bar, volatile LAS unsigned* st) {
    XcdBarrier b; b.bar = bar; b.x = xb_xcc_id(); b.st = st;
    if (threadIdx.x == 0) (void)xb_add(&bar[XB_XCNT(b.x)], 1u);
    return b;
}
__device__ __forceinline__ void xcd_barrier_complete(unsigned* bar, unsigned x, unsigned& nloc, unsigned& nx) {
    const unsigned G = gridDim.x * gridDim.y * gridDim.z;
    unsigned sum, cnt, mine, sp = 0u;
    for (;;) {
        sum = 0u; cnt = 0u; mine = 0u;
#pragma unroll
        for (unsigned j = 0; j < 16; ++j) { const unsigned c = xb_ld(&bar[XB_XCNT(j)]); sum += c; cnt += (c > 0u) ? 1u : 0u; mine = (j == x) ? c : mine; }
        if (sum == G) break;
        __builtin_amdgcn_s_sleep(1);
        if ((++sp & 255u) == 0u) { if (xb_ld(&bar[XB_TMO])) break; if (sp > XB_SPIN_CAP) { atomicAdd(&bar[XB_TMO], 1u); break; } }
    }
    nloc = mine > 0u ? mine : 1u; nx = cnt > 0u ? cnt : 1u;
}
__device__ __forceinline__ void xcd_barrier(const XcdBarrier& b) {
    asm volatile("s_waitcnt vmcnt(0)" ::: "memory");
    __syncthreads();
    if (threadIdx.x == 0) {
        unsigned* bar = b.bar;
        __builtin_amdgcn_s_waitcnt(0);
        unsigned nloc = b.st[0], nx = b.st[1];
        if (nloc == 0u) { xcd_barrier_complete(bar, b.x, nloc, nx); b.st[0] = nloc; b.st[1] = nx; }
        const unsigned old = xb_add(&bar[XB_XSUB(b.x)], 1u);
        const unsigned gen = old / nloc;
        if (old + 1u == (gen + 1u) * nloc) {
            __builtin_amdgcn_fence(__ATOMIC_RELEASE, "agent");
            asm volatile("s_waitcnt vmcnt(0)" ::: "memory");
            const unsigned og = xb_add(&bar[XB_TOP], 1u);
            const unsigned tg = og / nx;
            if (og + 1u == (tg + 1u) * nx) xb_add(&bar[XB_TOPGEN], 1u);
            else XB_SPIN(xb_ld(&bar[XB_TOPGEN]) == tg, bar);
            __builtin_amdgcn_fence(__ATOMIC_ACQUIRE, "agent");
            xb_add(&bar[XB_XGEN(b.x)], 1u);
            asm volatile("s_waitcnt vmcnt(0)" ::: "memory");
        } else {
            XB_SPIN(xb_ld(&bar[XB_XGEN(b.x)]) == gen, bar);
            __builtin_amdgcn_fence(__ATOMIC_ACQUIRE, "agent");
            asm volatile("s_waitcnt vmcnt(0)" ::: "memory");
        }
    }
    __syncthreads();
}

namespace pg8 {
constexpr int BM = 256, BK = 64, HALF = 128, HTB = HALF * BK * 2, STAGE_BYTES = 8 * HTB, NXCD = 8, WGM = 8;
__host__ __device__ __forceinline__ int lds_byte(int r, int c) { const int st = (r >> 4) * 2 + (c >> 5), rr = r & 15, cc = c & 31, ob = rr * 64 + cc * 2; return st * 1024 + (ob ^ (((ob >> 9) & 1) << 5)); }
__host__ __device__ __forceinline__ void stage_rc(int b, int& R, int& C) { const int st = b / 1024, sb = b % 1024, swz = sb ^ (((sb >> 9) & 1) << 5); R = (st >> 1) * 16 + swz / 64; C = (st & 1) * 32 + (swz % 64) / 2; }
__host__ __device__ __forceinline__ int perm32(int rho) { const int n = rho >> 4, i = rho & 15; return 8 * (i >> 2) + 4 * n + (i & 3); }

struct Unit { int pm, pn; };
struct Gemm { const bf16_t* A; const bf16_t* Bt; int K, lda, ldb, a_pn_shift, a_pn_stride, mid_t; };

struct StaticOrder {
    int nM, nN, nwg, G, c;
    __device__ void init(int M, int N, int G_, int c_) { nM = M / BM; nN = N / BM; nwg = nM * nN; G = G_; c = c_; }
    __device__ bool next(int i, Unit& u) const {
        const long L = (long)i * G + c; if (L >= nwg) return false;
        int wgid = (int)L; { const int q = nwg / NXCD, r = nwg % NXCD, xcd = wgid % NXCD, off = wgid / NXCD; wgid = (xcd < r ? xcd * (q + 1) : r * (q + 1) + (xcd - r) * q) + off; }
        const int nig = WGM * nN, gid = wgid / nig, fm = gid * WGM, gsz = (nM - fm) < WGM ? (nM - fm) : WGM;
        u.pm = fm + ((wgid % nig) % gsz); u.pn = (wgid % nig) / gsz; return true;
    }
};
__device__ __forceinline__ unsigned cvt_pk_bf16(float lo, float hi) { unsigned r; asm volatile("v_cvt_pk_bf16_f32 %0, %1, %2" : "=v"(r) : "v"(lo), "v"(hi)); return r; }

struct EpiBf16 {
    static constexpr bool PERM = true;
    bf16_t* O; int ldc;
    __device__ __forceinline__ void operator()(const f32x4 (&acc)[2][2][4][2], const Unit& u, int wr, int wc, int fr, int fq) const {
        const int row0 = u.pm * BM + wr * 64 + fr, col0 = u.pn * BM + wc * 32 + 8 * fq;
#pragma unroll
        for (int ai = 0; ai < 2; ++ai)
#pragma unroll
            for (int m = 0; m < 4; ++m) { bf16_t* rowp = O + (size_t)(row0 + ai * HALF + m * 16) * ldc + col0;
#pragma unroll
                for (int bj = 0; bj < 2; ++bj) { const f32x4 v0 = acc[ai][bj][m][0], v1 = acc[ai][bj][m][1];
                    u32x4 w; w.x = cvt_pk_bf16(v0[0], v0[1]); w.y = cvt_pk_bf16(v0[2], v0[3]); w.z = cvt_pk_bf16(v1[0], v1[1]); w.w = cvt_pk_bf16(v1[2], v1[3]);
                    *(u32x4*)(rowp + bj * HALF) = w; } }
    }
};
struct EpiG1 {
    static constexpr bool PERM = true;
    bf16_t* P; const float* bg; bf16_t* RT; bf16_t* GRS; const float* rope; const unsigned long long* ss; const float* ssp; float* IFo;
    __device__ __forceinline__ void operator()(f32x4 (&acc)[2][2][4][2], const Unit& u, int wr, int wc, int fr, int fq) const {
        const int row0 = u.pm * BM + wr * 64 + fr, cw = wc * 32 + 8 * fq;
#pragma unroll
        for (int ai = 0; ai < 2; ++ai) {
            float sq[4];
            if (u.pm < 32) {
                f32x4 a[4], b[4];
#pragma unroll
                for (int m = 0; m < 4; ++m) { const float* q = ssp + (size_t)(row0 + ai * HALF + m * 16) * 8; a[m] = *(const f32x4*)q; b[m] = *(const f32x4*)(q + 4); }
#pragma unroll
                for (int m = 0; m < 4; ++m) sq[m] = ((a[m][0] + a[m][1]) + (a[m][2] + a[m][3])) + ((b[m][0] + b[m][1]) + (b[m][2] + b[m][3]));
            } else {
                unsigned long long v[4];
#pragma unroll
                for (int m = 0; m < 4; ++m) v[m] = ss[row0 + ai * HALF + m * 16];
#pragma unroll
                for (int m = 0; m < 4; ++m) sq[m] = ss_val(v[m]);
            }
#pragma unroll
            for (int m = 0; m < 4; ++m) { const float rstd = rsqrtf(sq[m] * (1.0f / 2048.0f) + 1e-6f);
#pragma unroll
                for (int bj = 0; bj < 2; ++bj) { acc[ai][bj][m][0] *= rstd; acc[ai][bj][m][1] *= rstd; } }
            __builtin_amdgcn_sched_barrier(0);
        }
        if (u.pn == 44) {
            if (wc == 0 && fq == 0) {
#pragma unroll
                for (int ai = 0; ai < 2; ++ai)
#pragma unroll
                    for (int m = 0; m < 4; ++m) { float* o = IFo + (size_t)(row0 + ai * HALF + m * 16) * 8; *(f32x4*)o = acc[ai][0][m][0]; *(f32x4*)(o + 4) = acc[ai][0][m][1]; }
            }
        } else if (u.pn >= 28) {
            const int ch = 128 * (u.pn - 28) + cw;
            const f32x4 bm0 = *(const f32x4*)(bg + ch), bm1 = *(const f32x4*)(bg + ch + 4), br0 = *(const f32x4*)(bg + 2048 + ch), br1 = *(const f32x4*)(bg + 2048 + ch + 4);
#pragma unroll
            for (int ai = 0; ai < 2; ++ai)
#pragma unroll
                for (int m = 0; m < 4; ++m) { const size_t row = (size_t)(row0 + ai * HALF + m * 16);
                    const f32x4 vm0 = acc[ai][0][m][0] + bm0, vm1 = acc[ai][0][m][1] + bm1, vr0 = acc[ai][1][m][0] + br0, vr1 = acc[ai][1][m][1] + br1;
                    float rt[8], gr[8];
#pragma unroll
                    for (int j = 0; j < 4; ++j) {
                        const float er0 = 1.0f + __expf(-vr0[j]), er1 = 1.0f + __expf(-vr1[j]);
                        rt[j] = er0 * __builtin_amdgcn_rcpf(1.0f + __expf(-vm0[j])); rt[4 + j] = er1 * __builtin_amdgcn_rcpf(1.0f + __expf(-vm1[j]));
                        gr[j] = __builtin_amdgcn_rcpf(er0); gr[4 + j] = __builtin_amdgcn_rcpf(er1); }
                    u32x4 w; w.x = cvt_pk_bf16(rt[0], rt[1]); w.y = cvt_pk_bf16(rt[2], rt[3]); w.z = cvt_pk_bf16(rt[4], rt[5]); w.w = cvt_pk_bf16(rt[6], rt[7]);
                    *(u32x4*)(RT + row * 2048 + ch) = w;
                    w.x = cvt_pk_bf16(gr[0], gr[1]); w.y = cvt_pk_bf16(gr[2], gr[3]); w.z = cvt_pk_bf16(gr[4], gr[5]); w.w = cvt_pk_bf16(gr[6], gr[7]);
                    *(u32x4*)(GRS + row * 2048 + ch) = w; }
        } else if (u.pn >= 12 && u.pn < 20) {
            const float sc = u.pn >= 16 ? 0.0625f : 1.0f;
#pragma unroll
            for (int ai = 0; ai < 2; ++ai)
#pragma unroll
                for (int m = 0; m < 4; ++m) { const int row = row0 + ai * HALF + m * 16;
                    const int pi = row < MP ? (row & (SEQ - 1)) : 2048;
                    const f32x4* cs = (const f32x4*)(rope + ((size_t)pi * 128 + cw) * 2);
                    const f32x4 t0 = cs[0], t1 = cs[1], t2 = cs[2], t3 = cs[3];
                    const f32x4 a0 = acc[ai][0][m][0], a1 = acc[ai][0][m][1], b0 = acc[ai][1][m][0], b1 = acc[ai][1][m][1];
                    const float c[8] = {t0[0], t0[2], t1[0], t1[2], t2[0], t2[2], t3[0], t3[2]}, sn[8] = {t0[1], t0[3], t1[1], t1[3], t2[1], t2[3], t3[1], t3[3]};
                    const float x1[8] = {a0[0], a0[1], a0[2], a0[3], a1[0], a1[1], a1[2], a1[3]}, x2[8] = {b0[0], b0[1], b0[2], b0[3], b1[0], b1[1], b1[2], b1[3]};
                    float o1[8], o2[8];
#pragma unroll
                    for (int j = 0; j < 8; ++j) { o1[j] = (x1[j] * c[j] - x2[j] * sn[j]) * sc; o2[j] = (x1[j] * sn[j] + x2[j] * c[j]) * sc; }
                    bf16_t* rowp = P + (size_t)row * NP + u.pn * BM + cw;
                    u32x4 w; w.x = cvt_pk_bf16(o1[0], o1[1]); w.y = cvt_pk_bf16(o1[2], o1[3]); w.z = cvt_pk_bf16(o1[4], o1[5]); w.w = cvt_pk_bf16(o1[6], o1[7]);
                    *(u32x4*)rowp = w;
                    w.x = cvt_pk_bf16(o2[0], o2[1]); w.y = cvt_pk_bf16(o2[2], o2[3]); w.z = cvt_pk_bf16(o2[4], o2[5]); w.w = cvt_pk_bf16(o2[6], o2[7]);
                    *(u32x4*)(rowp + HALF) = w; }
        } else {
#pragma unroll
            for (int ai = 0; ai < 2; ++ai)
#pragma unroll
                for (int m = 0; m < 4; ++m) { bf16_t* rowp = P + (size_t)(row0 + ai * HALF + m * 16) * NP + u.pn * BM + cw;
#pragma unroll
                    for (int bj = 0; bj < 2; ++bj) { const f32x4 v0 = acc[ai][bj][m][0], v1 = acc[ai][bj][m][1];
                        u32x4 w; w.x = cvt_pk_bf16(v0[0], v0[1]); w.y = cvt_pk_bf16(v0[2], v0[3]); w.z = cvt_pk_bf16(v1[0], v1[1]); w.w = cvt_pk_bf16(v1[2], v1[3]);
                        *(u32x4*)(rowp + bj * HALF) = w; } }
        }
    }
};
struct EpiMerged {
    static constexpr bool PERM = true;
    bf16_t* O; const bf16_t* RT; const bf16_t* GRS;
    __device__ __forceinline__ void scale(f32x4 (&acc)[2][2][4][2], const bf16_t* S, const Unit& u, int wr, int wc, int fr, int fq) const {
        asm volatile("" : "+v"(fr), "+v"(fq));
        const int row0 = u.pm * BM + wr * 64 + fr, col0 = u.pn * BM + wc * 32 + 8 * fq;
#pragma unroll
        for (int ai = 0; ai < 2; ++ai) {
            u32x4 sv[4][2];
#pragma unroll
            for (int m = 0; m < 4; ++m)
#pragma unroll
                for (int bj = 0; bj < 2; ++bj) sv[m][bj] = *(const u32x4*)(S + (size_t)(row0 + ai * HALF + m * 16) * 2048 + col0 + bj * HALF);
#pragma unroll
            for (int m = 0; m < 4; ++m)
#pragma unroll
                for (int bj = 0; bj < 2; ++bj) { const u32x4 a = sv[m][bj];
                    acc[ai][bj][m][0][0] *= __uint_as_float(a.x << 16); acc[ai][bj][m][0][1] *= __uint_as_float(a.x & 0xffff0000u);
                    acc[ai][bj][m][0][2] *= __uint_as_float(a.y << 16); acc[ai][bj][m][0][3] *= __uint_as_float(a.y & 0xffff0000u);
                    acc[ai][bj][m][1][0] *= __uint_as_float(a.z << 16); acc[ai][bj][m][1][1] *= __uint_as_float(a.z & 0xffff0000u);
                    acc[ai][bj][m][1][2] *= __uint_as_float(a.w << 16); acc[ai][bj][m][1][3] *= __uint_as_float(a.w & 0xffff0000u); }
        }
    }
    __device__ __forceinline__ void mid(f32x4 (&acc)[2][2][4][2], const Unit& u, int wr, int wc, int fr, int fq) const { scale(acc, RT, u, wr, wc, fr, fq); }
    __device__ __forceinline__ void operator()(f32x4 (&acc)[2][2][4][2], const Unit& u, int wr, int wc, int fr, int fq) const {
        scale(acc, GRS, u, wr, wc, fr, fq);
        const int row0 = u.pm * BM + wr * 64 + fr, col0 = u.pn * BM + wc * 32 + 8 * fq;
#pragma unroll
        for (int ai = 0; ai < 2; ++ai)
#pragma unroll
            for (int m = 0; m < 4; ++m) { bf16_t* rowp = O + (size_t)(row0 + ai * HALF + m * 16) * 2048 + col0;
#pragma unroll
                for (int bj = 0; bj < 2; ++bj) { const f32x4 v0 = acc[ai][bj][m][0], v1 = acc[ai][bj][m][1];
                    u32x4 w; w.x = cvt_pk_bf16(v0[0], v0[1]); w.y = cvt_pk_bf16(v0[2], v0[3]); w.z = cvt_pk_bf16(v1[0], v1[1]); w.w = cvt_pk_bf16(v1[2], v1[3]);
                    *(u32x4*)(rowp + bj * HALF) = w; } }
    }
};
struct EpiResidual {
    static constexpr bool PERM = true;
    bf16_t* Xb; float* ssp; LAS float* red;
    __device__ __forceinline__ void operator()(f32x4 (&acc)[2][2][4][2], const Unit& u, int wr, int wc, int fr, int fq) const {
        const int row0 = u.pm * BM + wr * 64 + fr, col0 = u.pn * BM + wc * 32 + 8 * fq;
#pragma unroll
        for (int ai = 0; ai < 2; ++ai) {
            u32x4 xv[4][2];
#pragma unroll
            for (int m = 0; m < 4; ++m)
#pragma unroll
                for (int bj = 0; bj < 2; ++bj) xv[m][bj] = *(const u32x4*)(Xb + (size_t)(row0 + ai * HALF + m * 16) * 2048 + col0 + bj * HALF);
#pragma unroll
            for (int m = 0; m < 4; ++m) { float sq = 0.f;
#pragma unroll
                for (int bj = 0; bj < 2; ++bj) { const u32x4 a = xv[m][bj]; const f32x4 v0 = acc[ai][bj][m][0], v1 = acc[ai][bj][m][1];
                    u32x4 w;
                    w.x = cvt_pk_bf16(v0[0] + __uint_as_float(a.x << 16), v0[1] + __uint_as_float(a.x & 0xffff0000u)); w.y = cvt_pk_bf16(v0[2] + __uint_as_float(a.y << 16), v0[3] + __uint_as_float(a.y & 0xffff0000u));
                    w.z = cvt_pk_bf16(v1[0] + __uint_as_float(a.z << 16), v1[1] + __uint_as_float(a.z & 0xffff0000u)); w.w = cvt_pk_bf16(v1[2] + __uint_as_float(a.w << 16), v1[3] + __uint_as_float(a.w & 0xffff0000u));
                    *(u32x4*)(Xb + (size_t)(row0 + ai * HALF + m * 16) * 2048 + col0 + bj * HALF) = w;
                    const unsigned ww[4] = {w.x, w.y, w.z, w.w};
#pragma unroll
                    for (int q = 0; q < 4; ++q) { const float lo = __uint_as_float(ww[q] << 16), hi = __uint_as_float(ww[q] & 0xffff0000u); sq += lo * lo + hi * hi; } }
                sq += __shfl_xor(sq, 16); sq += __shfl_xor(sq, 32);
                if (fq == 0) red[(wr * 64 + fr + ai * HALF + m * 16) * 4 + wc] = sq; }
        }
        asm volatile("s_waitcnt lgkmcnt(0)" ::: "memory"); __builtin_amdgcn_s_barrier(); asm volatile("" ::: "memory");
        int t = threadIdx.x; asm volatile("" : "+v"(t));
        if (t < 256) { const f32x4 q = *(LAS const f32x4*)(red + 4 * t); ssp[(size_t)(u.pm * BM + t) * 8 + u.pn] = (q[0] + q[1]) + (q[2] + q[3]); }
        asm volatile("s_waitcnt lgkmcnt(0)" ::: "memory"); __builtin_amdgcn_s_barrier(); asm volatile("" ::: "memory");
    }
};

template <bool MID, class Epi, class Sched, bool ALIGN_EPI = true>
__device__ __forceinline__ void gemm_phase(LAS unsigned char* lds, const Gemm g, const Sched& S, const Epi& E) {
    const int tid = opaque_tid(), wid = __builtin_amdgcn_readfirstlane(tid >> 6), lane = tid & 63, wr = wid >> 2, wc = wid & 3, fr = lane & 15, fq = lane >> 4;
    const int K = g.K, nt = K / BK;
    unsigned voffA[2], voffB[2];
#pragma unroll
    for (int i = 0; i < 2; ++i) { int R, C; stage_rc(tid * 16 + i * 8192, R, C); const int Rb = Epi::PERM ? ((R & ~31) + perm32(R & 31)) : R;
        voffA[i] = (unsigned)(R * g.lda + C) * 2u; voffB[i] = (unsigned)(Rb * g.ldb + C) * 2u; }
    const size_t kstep = (size_t)(BK * 2);
    const size_t hstepA = (size_t)HALF * g.lda * 2, hstepB = (size_t)HALF * g.ldb * 2;
    const size_t tstepA = 2 * hstepA, tstepB = 2 * hstepB;
    const unsigned ldsw = (unsigned)wid * 1024u;
    const int aoff = lds_byte(wr * 64 + fr, fq * 8), boff = lds_byte(wc * 32 + fr, fq * 8);
#define PG8_SA(b, h) (((b) * 2 + (h)) * HTB)
#define PG8_SB(b, h) ((4 + (b) * 2 + (h)) * HTB)
#define PG8_STAGE(bufoff, gbase, voff) do { _Pragma("unroll") for (int _i = 0; _i < 2; ++_i) \
        __builtin_amdgcn_global_load_lds((const unsigned*)((const char*)(gbase) + (voff)[_i]), (LAS unsigned*)(lds + (bufoff) + ldsw + _i * 8192), 16, 0, 0); } while (0)
#define PG8_LDA(dst, b, h) do { _Pragma("unroll") for (int m = 0; m < 4; ++m) _Pragma("unroll") for (int k = 0; k < 2; ++k) dst[m][k] = *(const LAS bf16x8*)(lds + PG8_SA(b, h) + aoff + m * 2048 + k * 1024); } while (0)
#define PG8_LDB(dst, b, h) do { _Pragma("unroll") for (int n = 0; n < 2; ++n) _Pragma("unroll") for (int k = 0; k < 2; ++k) dst[n][k] = *(const LAS bf16x8*)(lds + PG8_SB(b, h) + boff + n * 2048 + k * 1024); } while (0)
#define PG8_MMA(ai, bj, At, Bt) do { __builtin_amdgcn_s_setprio(1); _Pragma("unroll") for (int m = 0; m < 4; ++m) _Pragma("unroll") for (int n = 0; n < 2; ++n) _Pragma("unroll") for (int k = 0; k < 2; ++k) \
        acc[ai][bj][m][n] = __builtin_amdgcn_mfma_f32_16x16x32_bf16(Bt[n][k], At[m][k], acc[ai][bj][m][n], 0, 0, 0); __builtin_amdgcn_s_setprio(0); } while (0)
#define PG8_WAIT_V(n) asm volatile("s_waitcnt vmcnt(" #n ")" ::: "memory")
#define PG8_WAIT_L(n) asm volatile("s_waitcnt lgkmcnt(" #n ")" ::: "memory")
#define PG8_BAR __builtin_amdgcn_s_barrier()
#define PG8_SCHED __builtin_amdgcn_sched_barrier(0)
#define PG8_APTR(u) ((const char*)g.A + (size_t)(u).pm * tstepA + (size_t)((u).pn >> g.a_pn_shift) * (size_t)g.a_pn_stride)
    Unit cur, nxt; int ui = 0;
    if (!S.next(0, cur)) return;
    f32x4 acc[2][2][4][2];
#pragma unroll
    for (int a = 0; a < 2; ++a)
#pragma unroll
        for (int b = 0; b < 2; ++b)
#pragma unroll
            for (int m = 0; m < 4; ++m)
#pragma unroll
                for (int n = 0; n < 2; ++n) acc[a][b][m][n] = (f32x4){0.f, 0.f, 0.f, 0.f};
    bf16x8 At[4][2], B0[2][2], B1[2][2];
    const char* cA = PG8_APTR(cur); const char* cB = (const char*)g.Bt + (size_t)cur.pn * tstepB;
    PG8_STAGE(PG8_SB(0, 0), cB, voffB); PG8_STAGE(PG8_SB(0, 1), cB + hstepB, voffB); PG8_STAGE(PG8_SA(0, 0), cA, voffA); PG8_STAGE(PG8_SA(0, 1), cA + hstepA, voffA);
    if (wr == 1) PG8_BAR;
    PG8_WAIT_V(2); PG8_BAR;
    PG8_STAGE(PG8_SB(1, 0), cB + kstep, voffB); PG8_STAGE(PG8_SA(1, 0), cA + kstep, voffA); PG8_STAGE(PG8_SB(1, 1), cB + hstepB + kstep, voffB);
    PG8_WAIT_V(6); PG8_BAR;
    for (;;) {
        const bool has_next = S.next(ui + 1, nxt);
        const char* nA = has_next ? PG8_APTR(nxt) : cA; const char* nB = has_next ? (const char*)g.Bt + (size_t)nxt.pn * tstepB : cB;
#pragma unroll 1
        for (int t = 0; t < nt; t += 2) {
            const bool last = (t == nt - 2);
            const char* a1 = cA + (size_t)(t + 1) * kstep;
            const char* a2 = last ? nA : cA + (size_t)(t + 2) * kstep; const char* b2 = last ? nB : cB + (size_t)(t + 2) * kstep;
            const char* a3 = a2 + kstep; const char* b3 = b2 + kstep;
            if constexpr (MID) { if (t == g.mid_t) E.mid(acc, cur, wr, wc, fr, fq); }
            PG8_LDB(B0, 0, 0); PG8_LDB(B1, 0, 1); PG8_SCHED; PG8_LDA(At, 0, 0); PG8_STAGE(PG8_SA(1, 1), a1 + hstepA, voffA);
            PG8_WAIT_V(8); PG8_WAIT_L(0); PG8_BAR; PG8_MMA(0, 0, At, B0); PG8_MMA(0, 1, At, B1); PG8_BAR; PG8_SCHED;
            PG8_LDA(At, 0, 1); PG8_STAGE(PG8_SB(0, 0), b2, voffB); PG8_STAGE(PG8_SB(0, 1), b2 + hstepB, voffB); PG8_STAGE(PG8_SA(0, 0), a2, voffA);
            PG8_WAIT_V(8); PG8_WAIT_L(0); PG8_BAR; PG8_MMA(1, 0, At, B0); PG8_MMA(1, 1, At, B1); PG8_BAR; PG8_SCHED;
            PG8_LDB(B0, 1, 0); PG8_LDB(B1, 1, 1); PG8_SCHED; PG8_LDA(At, 1, 0); PG8_STAGE(PG8_SA(0, 1), a2 + hstepA, voffA);
            PG8_WAIT_V(8); PG8_WAIT_L(0); PG8_BAR; PG8_MMA(0, 0, At, B0); PG8_MMA(0, 1, At, B1); PG8_BAR; PG8_SCHED;
            PG8_LDA(At, 1, 1); PG8_STAGE(PG8_SB(1, 0), b3, voffB); PG8_STAGE(PG8_SB(1, 1), b3 + hstepB, voffB); PG8_STAGE(PG8_SA(1, 0), a3, voffA);
            PG8_WAIT_V(8); PG8_WAIT_L(0); PG8_BAR; PG8_MMA(1, 0, At, B0); PG8_MMA(1, 1, At, B1); PG8_BAR; PG8_SCHED;
        }
        if constexpr (ALIGN_EPI) { if (wr == 0) PG8_BAR; }
        E(acc, cur, wr, wc, fr, fq);
        if (!has_next) break;
#pragma unroll
        for (int a = 0; a < 2; ++a)
#pragma unroll
            for (int b = 0; b < 2; ++b)
#pragma unroll
                for (int m = 0; m < 4; ++m)
#pragma unroll
                    for (int n = 0; n < 2; ++n) acc[a][b][m][n] = (f32x4){0.f, 0.f, 0.f, 0.f};
        cur = nxt; cA = nA; cB = nB; ++ui;
        if constexpr (ALIGN_EPI) { if (wr == 1) PG8_BAR; }
    }
    PG8_WAIT_V(0);
    if constexpr (!ALIGN_EPI) { if (wr == 0) PG8_BAR; }
    PG8_BAR;
#undef PG8_SA
#undef PG8_SB
#undef PG8_STAGE
#undef PG8_LDA
#undef PG8_LDB
#undef PG8_MMA
#undef PG8_WAIT_V
#undef PG8_WAIT_L
#undef PG8_BAR
#undef PG8_SCHED
#undef PG8_APTR
}
}

struct TrDesc { const float* src; bf16_t* dst; const float* ks; int ldsrc, ldd; float scale; };
__device__ __forceinline__ TrDesc tr_desc(const Params& p, int it) {
    constexpr int T0 = 1536, T1 = T0 + 2048, T2 = T1 + 2048, T3 = T2 + 512, T4 = T3 + 512, T5 = T4 + 1024, T6 = T5 + 64, T7 = T6 + 64;
    const int l = it / T7, r = it % T7;
    bf16_t* Wl = p.W_() + (size_t)l * WL;
    TrDesc d; d.scale = 1.f; d.ks = nullptr;
    int k0, c0, r0, kd0; const float* src; bf16_t* dst;
    if (r < T0)      { const int q = r;      src = p.w_in + (size_t)l * D * NIN; d.ldsrc = NIN; k0 = (q & 31) * 64; c0 = (q >> 5) * 64; dst = Wl + W1_OFF; d.ldd = D; r0 = (q >> 5) * 64; kd0 = k0; d.ks = p.norm_g + (size_t)l * D; }
    else if (r < T1) { const int q = r - T0; src = p.w_in + (size_t)l * D * NIN; d.ldsrc = NIN; k0 = (q & 31) * 64; c0 = 3080 + (q >> 5) * 64; dst = Wl + W1_OFF; d.ldd = D; r0 = 3072 + (q >> 5) * 64; kd0 = k0; d.ks = p.norm_g + (size_t)l * D; }
    else if (r < T2) { const int q = r - T1, ct = q >> 5;
                       src = p.w_gate + (size_t)l * D * 4096; d.ldsrc = 4096; k0 = (q & 31) * 64; c0 = (((ct & 3) < 2) ? 0 : 2048) + 128 * (ct >> 2) + (ct & 1) * 64; dst = Wl + W1_OFF; d.ldd = D; r0 = C_GM + ct * 64; kd0 = k0; d.ks = p.norm_g + (size_t)l * D; }
    else if (r < T3) { const int q = r - T2; src = p.w_pm + (size_t)l * WM * D; d.ldsrc = D; k0 = (q & 15) * 64; c0 = (q >> 4) * 64; dst = Wl + W3_OFF; d.ldd = D; r0 = c0; kd0 = k0; }
    else if (r < T4) { const int q = r - T3; src = p.w_pr + (size_t)l * WM * D; d.ldsrc = D; k0 = (q & 15) * 64; c0 = (q >> 4) * 64; dst = Wl + W3_OFF; d.ldd = D; r0 = c0; kd0 = 1024 + k0; }
    else if (r < T5) { const int q = r - T4; src = p.w_o + (size_t)l * D * D; d.ldsrc = D; k0 = (q & 31) * 64; c0 = (q >> 5) * 64; dst = Wl + W4_OFF; d.ldd = D; r0 = c0; kd0 = k0; }
    else if (r < T6) { const int q = r - T5, h = q >> 4, qq = q & 15; src = p.w_qm + ((size_t)l * HM + h) * SZ; d.ldsrc = DH; k0 = (qq & 3) * 64; c0 = (qq >> 2) * 64; dst = Wl + W2_OFF; d.ldd = DH; r0 = h * 512 + c0; kd0 = k0; d.scale = 0.0625f; }
    else             { const int q = r - T6, h = q >> 4, qq = q & 15; src = p.w_km + ((size_t)l * HM + h) * SZ; d.ldsrc = DH; k0 = (qq & 3) * 64; c0 = (qq >> 2) * 64; dst = Wl + W2_OFF; d.ldd = DH; r0 = h * 512 + 256 + c0; kd0 = k0; }
    d.src = src + (size_t)k0 * d.ldsrc + c0; d.dst = dst + (size_t)r0 * d.ldd + kd0; if (d.ks) d.ks += k0;
    return d;
}
__device__ __forceinline__ void tr_load(const TrDesc& d, f32x4 (&v)[16], f32x4 (&ks)[2], int lane) {
#pragma unroll
    for (int i = 0; i < 16; ++i) v[i] = __builtin_nontemporal_load((const f32x4*)(d.src + (size_t)((lane >> 4) + 4 * i) * d.ldsrc + 4 * (lane & 15)));
    if (d.ks) { ks[0] = *(const f32x4*)(d.ks + 8 * (lane & 7)); ks[1] = *(const f32x4*)(d.ks + 8 * (lane & 7) + 4); }
    else { ks[0] = (f32x4){1.f, 1.f, 1.f, 1.f}; ks[1] = ks[0]; }
}
__device__ __forceinline__ void tr_store(const TrDesc& d, const f32x4 (&v)[16], const f32x4 (&ks)[2], LAS float* t, int lane) {
#pragma unroll
    for (int i = 0; i < 16; ++i)
#pragma unroll
        for (int j = 0; j < 4; ++j) t[((lane >> 4) + 4 * i) * 65 + 4 * (lane & 15) + j] = v[i][j];
    const int c = lane & 7;
    const f32x4 s0 = ks[0] * d.scale, s1 = ks[1] * d.scale;
#pragma unroll
    for (int j = 0; j < 8; ++j) { const int n = (lane >> 3) + 8 * j; const LAS float* q = t + (8 * c) * 65 + n;
        u32x4 o; o.x = pk2(s0[0] * q[0], s0[1] * q[65]); o.y = pk2(s0[2] * q[130], s0[3] * q[195]); o.z = pk2(s1[0] * q[260], s1[1] * q[325]); o.w = pk2(s1[2] * q[390], s1[3] * q[455]);
        *(u32x4*)(d.dst + (size_t)n * d.ldd + 8 * c) = o; }
}
__device__ __forceinline__ void prep_phase(const Params& p, int wg, int nwg, LAS unsigned char* lds) {
    const int tid = opaque_tid();
    {
        const int lane = tid & 63, wid = tid >> 6;
        for (int row = wg * 8 + wid; row < MPAD; row += nwg * 8) {
            u32x2* hrow = (u32x2*)(p.Xb_() + (size_t)row * D);
            float ss = 0.f;
            if (row < MT) {
                const f32x4* xr = (const f32x4*)(row < MP ? p.x_prompt + (size_t)row * D : p.x_sample + (size_t)(row - MP) * D);
#pragma unroll
                for (int i = 0; i < 8; ++i) { const f32x4 v = xr[lane + 64 * i]; ss += (v[0] * v[0] + v[1] * v[1]) + (v[2] * v[2] + v[3] * v[3]); hrow[lane + 64 * i] = (u32x2){pk2(v[0], v[1]), pk2(v[2], v[3])}; }
                ss = wave_sum(ss);
            } else {
#pragma unroll
                for (int i = 0; i < 8; ++i) hrow[lane + 64 * i] = (u32x2){0u, 0u};
            }
            if (lane < 5) p.SS_()[(size_t)lane * MPAD + row] = lane == 0 ? ss_fix(ss) : 0ull;
            if (row < MP && lane < 8) p.SSP_()[(size_t)row * 8 + lane] = lane == 0 ? ss : 0.f;
        }
    }
    for (int i = wg * 512 + tid; i < 2049 * 128; i += nwg * 512) {
        const int pi = i >> 7, j = i & 127;
        const float pos = pi < 2048 ? (float)pi : 16384.0f;
        const float inv = powf(10000.0f, -((float)j / 128.0f));
        const float ang = pos * inv;
        p.ROPE_()[2 * i] = (float)cos((double)ang); p.ROPE_()[2 * i + 1] = (float)sin((double)ang);
    }
    for (int i = wg * 512 + tid; i < DEPTH * 256 * D; i += nwg * 512) {
        const int l = i / (256 * D), r = i % (256 * D), j = r / D, k = r % D;
        p.W_()[(size_t)l * WL + W1_OFF + (size_t)(11264 + j) * D + k] = j < 8 ? f2bf(p.w_in[((size_t)l * D + k) * NIN + 3072 + j] * p.norm_g[(size_t)l * D + k]) : (bf16_t)0;
    }
    const int lane = tid & 63, wid = tid >> 6;
    LAS float* t = (LAS float*)lds + wid * (64 * 65);
    constexpr int NT = DEPTH * 7808;
    int it = wg * 8 + wid;
    if (it < NT) {
        TrDesc d = tr_desc(p, it);
        f32x4 v[16], ks[2];
        tr_load(d, v, ks, lane);
        for (;;) {
            const int it2 = it + nwg * 8;
            const bool has = it2 < NT;
            TrDesc d2 = d; f32x4 v2[16], ks2[2];
            if (has) { d2 = tr_desc(p, it2); tr_load(d2, v2, ks2, lane); }
            tr_store(d, v, ks, t, lane);
            if (!has) break;
#pragma unroll
            for (int i = 0; i < 16; ++i) v[i] = v2[i];
            ks[0] = ks2[0]; ks[1] = ks2[1]; d = d2; it = it2;
        }
    }
}

__device__ __forceinline__ void final_phase(const Params& p, int wg, int nwg) {
    const int tid_ = opaque_tid(), lane = tid_ & 63, wid = tid_ >> 6;
    const f32x4* g4 = (const f32x4*)p.final_g;
    for (int row = wg * 8 + wid; row < MT; row += nwg * 8) {
        const u32x2* xr = (const u32x2*)(p.Xb_() + (size_t)row * D);
        f32x4* yr = (f32x4*)(p.out + (row < MP ? O_YP + (size_t)row * D : O_YS + (size_t)(row - MP) * D));
        const float rstd = rsqrtf(row_ss(p.SSP_(), p.SS_() + (size_t)4 * MPAD, row) * (1.0f / D) + EPS);
#pragma unroll
        for (int i = 0; i < 8; ++i) { const u32x2 xb = xr[lane + 64 * i];
            const f32x4 v = (f32x4){__uint_as_float(xb.x << 16), __uint_as_float(xb.x & 0xffff0000u), __uint_as_float(xb.y << 16), __uint_as_float(xb.y & 0xffff0000u)};
            yr[lane + 64 * i] = v * rstd * g4[lane + 64 * i]; }
    }
}

__device__ __forceinline__ void unpack8(const u32x4 v, float (&f)[8]) {
    f[0] = __uint_as_float(v.x << 16); f[1] = __uint_as_float(v.x & 0xffff0000u); f[2] = __uint_as_float(v.y << 16); f[3] = __uint_as_float(v.y & 0xffff0000u);
    f[4] = __uint_as_float(v.z << 16); f[5] = __uint_as_float(v.z & 0xffff0000u); f[6] = __uint_as_float(v.w << 16); f[7] = __uint_as_float(v.w & 0xffff0000u);
}
__device__ __forceinline__ u32x4 pack8(const float (&f)[8]) { u32x4 w; w.x = pk2(f[0], f[1]); w.y = pk2(f[2], f[3]); w.z = pk2(f[4], f[5]); w.w = pk2(f[6], f[7]); return w; }

__device__ __forceinline__ void gate_all(const Params& p, int layer, int bh, LAS float* G);
__device__ __forceinline__ void conv_phase(const Params& p, int layer, int wg, int nwg, LAS unsigned char* lds) {
    const int tid = opaque_tid();
    for (int bh = wg; bh < 16; bh += nwg) gate_all(p, layer, bh, (LAS float*)lds);
    const float* cw = p.conv_w + (size_t)layer * 4 * WM;
    const float* cb = p.conv_b + (size_t)layer * WM;
    const int cwg = nwg > 32 ? wg - 16 : wg, cnw = nwg > 32 ? nwg - 16 : nwg;
    if (cwg >= 0)
    for (int it = cwg * 512 + tid; it < MT * 128; it += cnw * 512) {
        const int row = it >> 7, ch = (it & 127) * 8;
        float up[4][8];
        if (row < MP) {
            const int t = row & (SEQ - 1);
#pragma unroll
            for (int i = 0; i < 4; ++i) {
                if (t - 3 + i >= 0) unpack8(*(const u32x4*)(p.P_() + (size_t)(row - 3 + i) * NP + C_U + ch), up[i]);
                else {
#pragma unroll
                    for (int j = 0; j < 8; ++j) up[i][j] = 0.f;
                }
            }
            if (t >= SEQ - 3) {
                const int b = row >> 11;
                float* o = p.out + O_CVP + (((size_t)layer * BP + b) * 3 + (t - (SEQ - 3))) * WM + ch;
                *(f32x4*)o = (f32x4){up[3][0], up[3][1], up[3][2], up[3][3]}; *(f32x4*)(o + 4) = (f32x4){up[3][4], up[3][5], up[3][6], up[3][7]};
            }
        } else {
            const int b = row - MP;
            const float* hist = p.st_conv + ((size_t)layer * BS + b) * 3 * WM + ch;
#pragma unroll
            for (int i = 0; i < 3; ++i) { const f32x4 a = *(const f32x4*)(hist + (size_t)i * WM), c = *(const f32x4*)(hist + (size_t)i * WM + 4);
                up[i][0] = a[0]; up[i][1] = a[1]; up[i][2] = a[2]; up[i][3] = a[3]; up[i][4] = c[0]; up[i][5] = c[1]; up[i][6] = c[2]; up[i][7] = c[3]; }
            unpack8(*(const u32x4*)(p.P_() + (size_t)row * NP + C_U + ch), up[3]);
            float* o = p.out + O_CVS + ((size_t)layer * BS + b) * 3 * WM + ch;
#pragma unroll
            for (int i = 0; i < 3; ++i) { *(f32x4*)(o + (size_t)i * WM) = (f32x4){up[i + 1][0], up[i + 1][1], up[i + 1][2], up[i + 1][3]};
                *(f32x4*)(o + (size_t)i * WM + 4) = (f32x4){up[i + 1][4], up[i + 1][5], up[i + 1][6], up[i + 1][7]}; }
        }
        float r[8];
#pragma unroll
        for (int j = 0; j < 8; ++j) r[j] = cb[ch + j];
#pragma unroll
        for (int i = 0; i < 4; ++i)
#pragma unroll
            for (int j = 0; j < 8; ++j) r[j] += up[i][j] * cw[i * WM + ch + j];
#pragma unroll
        for (int j = 0; j < 8; ++j) r[j] = siluf_(r[j]);
        *(u32x4*)(p.CM_() + (size_t)row * WM + ch) = pack8(r);
    }
}

__device__ __forceinline__ void gate_all(const Params& p, int layer, int bh, LAS float* G) {
    const int tid = opaque_tid(), lane = tid & 63, wid = tid >> 6, b = bh >> 2, h = bh & 3;
    const float bi = p.b_i[layer * HM + h], bfv = p.b_f[layer * HM + h];
    float* gt = p.GT_() + (size_t)bh * 6208;
    float tb0[2], tb1[2], tg0[2], tg1[2], rm0[2], rm1[2];
#pragma unroll
    for (int q = 0; q < 2; ++q) {
        const int cc = wid + 8 * q;
        const size_t r0 = (size_t)b * SEQ + cc * 128 + 2 * lane;
        const float i0 = p.IF_()[r0 * 8 + h] + bi, i1 = p.IF_()[(r0 + 1) * 8 + h] + bi;
        const float l0 = logsigf_(p.IF_()[r0 * 8 + 4 + h] + bfv), l1 = logsigf_(p.IF_()[(r0 + 1) * 8 + 4 + h] + bfv);
        float inc = l0 + l1;
#pragma unroll
        for (int o = 1; o < 64; o <<= 1) { const float t = __shfl_up(inc, o); if (lane >= o) inc += t; }
        const float exc = inc - (l0 + l1);
        tb0[q] = exc + l0; tb1[q] = inc;
        tg0[q] = i0 - tb0[q]; tg1[q] = i1 - tb1[q];
        const float gm = wave_max(fmaxf(tg0[q], tg1[q]));
        const float Bc = __shfl(inc, 63);
        if (lane == 0) { G[cc] = Bc; G[16 + cc] = gm; }
        float rm = fmaxf(tg0[q], tg1[q]);
#pragma unroll
        for (int o = 1; o < 64; o <<= 1) { const float t = __shfl_up(rm, o); if (lane >= o) rm = fmaxf(rm, t); }
        float ex = __shfl_up(rm, 1); if (lane == 0) ex = -3.0e38f;
        rm0[q] = fmaxf(ex, tg0[q]); rm1[q] = fmaxf(rm0[q], tg1[q]);
    }
    __syncthreads();
    if (tid == 0) { float m = -1e30f; for (int cc = 0; cc < 16; ++cc) { G[32 + cc] = m; m = G[cc] + fmaxf(m, G[16 + cc]); } G[48] = m; }
    __syncthreads();
#pragma unroll
    for (int q = 0; q < 2; ++q) {
        const int cc = wid + 8 * q, t0 = cc * 128 + 2 * lane;
        const float mc = G[32 + cc];
        *(f32x2_t*)(gt + t0) = (f32x2_t){tb0[q], tb1[q]}; *(f32x2_t*)(gt + 2048 + t0) = (f32x2_t){tg0[q], tg1[q]};
        *(f32x2_t*)(gt + 4096 + t0) = (f32x2_t){fmaxf(rm0[q], mc), fmaxf(rm1[q], mc)};
    }
    if (tid < 16) { gt[6144 + tid] = G[tid]; gt[6160 + tid] = G[16 + tid]; }
    if (tid < 17) gt[6176 + tid] = G[32 + tid];
    __syncthreads();
}
__device__ __forceinline__ void gate_load(const Params& p, int bh, int c, LAS float* G, int tid) {
    const float* gt = p.GT_() + (size_t)bh * 6208;
    if (tid < 128) { G[64 + tid] = gt[c * 128 + tid]; G[192 + tid] = gt[2048 + c * 128 + tid]; G[320 + tid] = gt[4096 + c * 128 + tid]; }
    if (tid == 0) G[32 + c] = gt[6176 + c];
    __syncthreads();
}

template <int I> struct IC { static constexpr int value = I; };
template <int I, int N, class F> __device__ __forceinline__ void sfor(F&& f) { if constexpr (I < N) { f(IC<I>{}); sfor<I + 1, N>(f); } }

template <int CPR>
__device__ __forceinline__ void tile_load(u32x4 (&r)[8], const bf16_t* src, int ld_src, int tid) {
#pragma unroll
    for (int i = 0; i < 8; ++i) { const int id = tid + 512 * i, row = id / CPR, ch = id % CPR; r[i] = *(const u32x4*)(src + (size_t)row * ld_src + ch * 8); }
}
template <int CPR, int LDB>
__device__ __forceinline__ void tile_store(LAS unsigned char* dst, const u32x4 (&r)[8], int tid) {
#pragma unroll
    for (int i = 0; i < 8; ++i) { const int id = tid + 512 * i, row = id / CPR, ch = id % CPR; *(LAS u32x4*)(dst + row * LDB + ch * 16) = r[i]; }
}
__device__ __forceinline__ void tile_store_w(LAS unsigned char* dst, const u32x4 (&r)[8], LAS const float* w, int tid) {
#pragma unroll
    for (int i = 0; i < 8; ++i) { const int id = tid + 512 * i, row = id >> 5, ch = id & 31; float f[8]; unpack8(r[i], f); const float ww = w[row];
#pragma unroll
        for (int j = 0; j < 8; ++j) f[j] *= ww;
        *(LAS u32x4*)(dst + row * 544 + ch * 16) = pack8(f); }
}
template <int OFF, int HS>
__device__ __forceinline__ bf16x8 tr_frag1(unsigned base) {
    u32x2 l0, h0;
    asm volatile("ds_read_b64_tr_b16 %0, %2 offset:%3\n\tds_read_b64_tr_b16 %1, %2 offset:%4\n\ts_waitcnt lgkmcnt(0)"
                 : "=&v"(l0), "=&v"(h0) : "v"(base), "i"(OFF), "i"(OFF + HS) : "memory");
    const u32x4 v = (u32x4){l0.x, l0.y, h0.x, h0.y};
    return __builtin_bit_cast(bf16x8, v);
}
template <int OFF, int HS, int TS>
__device__ __forceinline__ void tr_frag2(unsigned base, bf16x8& f0, bf16x8& f1) {
    u32x2 l0, l1, h0, h1;
    asm volatile("ds_read_b64_tr_b16 %0, %4 offset:%5\n\tds_read_b64_tr_b16 %2, %4 offset:%6\n\t"
                 "ds_read_b64_tr_b16 %1, %4 offset:%7\n\tds_read_b64_tr_b16 %3, %4 offset:%8\n\t"
                 "s_waitcnt lgkmcnt(0)"
                 : "=&v"(l0), "=&v"(l1), "=&v"(h0), "=&v"(h1)
                 : "v"(base), "i"(OFF), "i"(OFF + HS), "i"(OFF + TS), "i"(OFF + TS + HS)
                 : "memory");
    f0 = __builtin_bit_cast(bf16x8, (u32x4){l0.x, l0.y, h0.x, h0.y}); f1 = __builtin_bit_cast(bf16x8, (u32x4){l1.x, l1.y, h1.x, h1.y});
}
template <int OFF, int HS, int TS>
__device__ __forceinline__ void tr_frag4(unsigned base, bf16x8 (&f)[4]) {
    u32x2 l0, l1, l2, l3, h0, h1, h2, h3;
    asm volatile("ds_read_b64_tr_b16 %0, %8 offset:%9\n\tds_read_b64_tr_b16 %4, %8 offset:%10\n\t"
                 "ds_read_b64_tr_b16 %1, %8 offset:%11\n\tds_read_b64_tr_b16 %5, %8 offset:%12\n\t"
                 "ds_read_b64_tr_b16 %2, %8 offset:%13\n\tds_read_b64_tr_b16 %6, %8 offset:%14\n\t"
                 "ds_read_b64_tr_b16 %3, %8 offset:%15\n\tds_read_b64_tr_b16 %7, %8 offset:%16\n\t"
                 "s_waitcnt lgkmcnt(0)"
                 : "=&v"(l0), "=&v"(l1), "=&v"(l2), "=&v"(l3), "=&v"(h0), "=&v"(h1), "=&v"(h2), "=&v"(h3)
                 : "v"(base), "i"(OFF), "i"(OFF + HS), "i"(OFF + TS), "i"(OFF + TS + HS), "i"(OFF + 2 * TS), "i"(OFF + 2 * TS + HS), "i"(OFF + 3 * TS), "i"(OFF + 3 * TS + HS)
                 : "memory");
    f[0] = __builtin_bit_cast(bf16x8, (u32x4){l0.x, l0.y, h0.x, h0.y}); f[1] = __builtin_bit_cast(bf16x8, (u32x4){l1.x, l1.y, h1.x, h1.y});
    f[2] = __builtin_bit_cast(bf16x8, (u32x4){l2.x, l2.y, h2.x, h2.y}); f[3] = __builtin_bit_cast(bf16x8, (u32x4){l3.x, l3.y, h3.x, h3.y});
}
__device__ __forceinline__ unsigned lds_addr(LAS const void* p) { return (unsigned)(size_t)p; }

template <int NR, int NC, bool WEIGHT>
__device__ __forceinline__ void stage_T(LAS unsigned char* dst, int ldd_bytes, const bf16_t* src, int ld_src, LAS const float* w) {
    const int tid_ = opaque_tid(), lane = tid_ & 63, wid = tid_ >> 6;
    constexpr int PB = NR / 128, CG = NC / 8;
#pragma unroll 1
    for (int task = wid; task < PB * CG; task += 8) {
        const int pb = task % PB, cg = task / PB, r = pb * 128 + 2 * lane;
        float a[8], c[8];
        unpack8(*(const u32x4*)(src + (size_t)r * ld_src + cg * 8), a); unpack8(*(const u32x4*)(src + (size_t)(r + 1) * ld_src + cg * 8), c);
        float w0 = 1.f, w1 = 1.f; if (WEIGHT) { w0 = w[r]; w1 = w[r + 1]; }
#pragma unroll
        for (int j = 0; j < 8; ++j) *(LAS unsigned*)(dst + (cg * 8 + j) * ldd_bytes + r * 2) = pk2(a[j] * w0, c[j] * w1);
    }
}
__device__ __forceinline__ void stage_rows(LAS unsigned char* dst, const bf16_t* src, int ld_src) {
    const int tid_ = opaque_tid();
#pragma unroll
    for (int i = 0; i < 8; ++i) { const int id = tid_ + 512 * i, row = id >> 5, ch = id & 31;
        *(LAS u32x4*)(dst + row * 528 + ch * 16) = *(const u32x4*)(src + (size_t)row * ld_src + ch * 8); }
}
__device__ __forceinline__ bf16x8 lds_frag(LAS const unsigned char* base, int row, int ld_bytes, int kbyte) { return *(LAS const bf16x8*)(base + row * ld_bytes + kbyte); }
__device__ __forceinline__ float ret_lg(int h) { return logf(1.0f - exp2f(-5.0f - (float)h)); }

template <int BR>
__device__ __forceinline__ void chunk_passA(const Params& p, int layer, int b, int h, int c, LAS unsigned char* lds) {
    LAS unsigned char* Xt = lds; LAS unsigned char* Yt = lds + 69632; LAS float* G = (LAS float*)(lds + 139264); LAS float* wk = G + 512;
    const int tid = opaque_tid(), lane = tid & 63, w = __builtin_amdgcn_readfirstlane(tid >> 6), g = lane >> 4, lr = lane & 15;
    const size_t row0 = (size_t)b * SEQ + c * 128;
    const int pi = BR * 16 + b * 4 + h;
    const bf16_t* Xp = BR == 0 ? p.QK_() + row0 * 2048 + h * 512 + 256 : p.P_() + row0 * NP + C_VR + h * 256;
    const bf16_t* Yp = BR == 0 ? p.P_() + row0 * NP + C_VM + h * 256 : p.P_() + row0 * NP + C_KR + h * 256;
    u32x4 xr[8], yr[8];
    tile_load<32>(xr, Xp, BR == 0 ? 2048 : NP, tid); tile_load<32>(yr, Yp, NP, tid);
    if (BR == 0) { gate_load(p, b * 4 + h, c, G, tid); if (tid < 128) wk[tid] = expf(G[192 + tid] - G[320 + 127]); }
    else { if (tid < 128) wk[tid] = expf((float)(127 - tid) * ret_lg(h)); }
    __syncthreads();
    tile_store<32, 544>(Xt, xr, tid); tile_store_w(Yt, yr, wk, tid);
    __syncthreads();
    const unsigned lpart = (unsigned)(((8 * g + (lr >> 2)) * 272 + 4 * (lr & 3)) * 2);
    const unsigned baseX = lds_addr(Xt) + lpart + (unsigned)(32 * w * 2), baseY = lds_addr(Yt) + lpart;
    bf16_t* Uo = p.U_() + ((size_t)pi * 16 + c) * SZ;
    sfor<0, 2>([&](auto rt_) {
        constexpr int rt = decltype(rt_)::value;
        f32x4 acc[16];
#pragma unroll
        for (int j = 0; j < 16; ++j) acc[j] = (f32x4){0.f, 0.f, 0.f, 0.f};
        sfor<0, 4>([&](auto ks_) {
            constexpr int ks = decltype(ks_)::value;
            const bf16x8 fa = tr_frag1<ks * 32 * 544 + rt * 32, 4 * 544>(baseX);
            sfor<0, 4>([&](auto cq_) {
                constexpr int cq = decltype(cq_)::value;
                bf16x8 fb[4];
                tr_frag4<ks * 32 * 544 + cq * 128, 4 * 544, 32>(baseY, fb);
#pragma unroll
                for (int i = 0; i < 4; ++i) acc[4 * cq + i] = __builtin_amdgcn_mfma_f32_16x16x32_bf16(fa, fb[i], acc[4 * cq + i], 0, 0, 0);
            });
        });
#pragma unroll
        for (int ct = 0; ct < 16; ++ct)
            *(u32x2*)(Uo + (size_t)(16 * ct + lr) * 256 + 32 * w + 16 * rt + 4 * g) = (u32x2){pk2(acc[ct][0], acc[ct][1]), pk2(acc[ct][2], acc[ct][3])};
    });
    if (BR == 0 && tid < 256) {
        float sacc = 0.f;
        for (int ss = 0; ss < 128; ++ss) sacc += wk[ss] * bf2f(*(LAS const bf16_t*)(Xt + ss * 544 + tid * 2));
        p.NU_()[((size_t)(b * 4 + h) * 16 + c) * 256 + tid] = sacc;
    }
    __syncthreads();
}

template <int BR>
__device__ __forceinline__ void chunk_state_item(const Params& p, int layer, int b, int h, int sl, LAS unsigned char* lds) {
    LAS unsigned char* Xt = lds;
    LAS unsigned char* Ys = lds + 69632;
    LAS float* wka = (LAS float*)(lds + 79872);
    LAS float* dec = wka + 2048;
    const int tid = opaque_tid(), lane = tid & 63, w = __builtin_amdgcn_readfirstlane(tid >> 6), g = lane >> 4, lr = lane & 15;
    const int bh = b * 4 + h, pi = BR * 16 + bh;
    const float* gt = p.GT_() + (size_t)bh * 6208;
    if (BR == 0) {
#pragma unroll
        for (int i = 0; i < 4; ++i) { const int t = tid + 512 * i; wka[t] = expf(gt[2048 + t] - gt[4096 + (t | 127)]); }
        if (tid < 16) { const float mc = gt[6176 + tid]; dec[tid] = expf(mc - fmaxf(mc, gt[6160 + tid])); }
    } else {
        const float lg = ret_lg(h);
#pragma unroll
        for (int i = 0; i < 4; ++i) { const int t = tid + 512 * i; wka[t] = expf((float)(127 - (t & 127)) * lg); }
        if (tid < 16) dec[tid] = expf(128.0f * lg);
    }
    const size_t rowb = (size_t)b * SEQ;
    const bf16_t* Xp = BR == 0 ? p.QK_() + rowb * 2048 + h * 512 + 256 : p.P_() + rowb * NP + C_VR + h * 256;
    const int ldX = BR == 0 ? 2048 : NP;
    const bf16_t* Yp = (BR == 0 ? p.P_() + rowb * NP + C_VM + h * 256 : p.P_() + rowb * NP + C_KR + h * 256) + 32 * sl;
    const unsigned yoff = (unsigned)((tid >> 2) * NP + (tid & 3) * 8) * 2u;
    u32x4 xa[8], xb[8], ya, yb;
    tile_load<32>(xa, Xp, ldX, tid); ya = *(const u32x4*)((const char*)Yp + yoff);
    tile_load<32>(xb, Xp + (size_t)128 * ldX, ldX, tid); yb = *(const u32x4*)((const char*)(Yp + (size_t)128 * NP) + yoff);
    f32x4 st[2][2], nst[2];
#pragma unroll
    for (int i = 0; i < 2; ++i) { nst[i] = (f32x4){0.f, 0.f, 0.f, 0.f};
#pragma unroll
        for (int j = 0; j < 2; ++j) st[i][j] = (f32x4){0.f, 0.f, 0.f, 0.f}; }
    const unsigned lpart = (unsigned)(((8 * g + (lr >> 2)) * 272 + 4 * (lr & 3)) * 2), lparty = (unsigned)(((8 * g + (lr >> 2)) * 40 + 4 * (lr & 3)) * 2);
    const unsigned baseX = lds_addr(Xt) + lpart + (unsigned)(32 * w * 2), baseY = lds_addr(Ys) + lparty;
    bf16_t* CSp = p.CS_() + (size_t)pi * 16 * SZ + (size_t)(32 * sl + lr) * 256 + 32 * w + 4 * g;
    float* NSp = p.NS_() + (size_t)bh * 16 * 256 + 32 * w + 4 * g;
    const bool nown = (BR == 0) && (sl == 0) && (lr == 0);
    __syncthreads();
    auto step = [&](int c, u32x4 (&xr)[8], u32x4& yr) {
#pragma unroll
        for (int rt = 0; rt < 2; ++rt) {
#pragma unroll
            for (int ct = 0; ct < 2; ++ct) *(u32x2*)(CSp + (size_t)c * SZ + (size_t)(16 * ct) * 256 + 16 * rt) = (u32x2){pk2(st[rt][ct][0], st[rt][ct][1]), pk2(st[rt][ct][2], st[rt][ct][3])};
            if (nown) *(f32x4*)(NSp + (size_t)c * 256 + 16 * rt) = nst[rt];
        }
        tile_store<32, 544>(Xt, xr, tid);
        { float f[8]; unpack8(yr, f); const float ww = wka[c * 128 + (tid >> 2)];
#pragma unroll
          for (int j = 0; j < 8; ++j) f[j] *= ww;
          *(LAS u32x4*)(Ys + (tid >> 2) * 80 + (tid & 3) * 16) = pack8(f); }
        __syncthreads();
        if (c + 2 < 16) {
            tile_load<32>(xr, Xp + (size_t)(c + 2) * 128 * ldX, ldX, tid);
            yr = *(const u32x4*)((const char*)(Yp + (size_t)(c + 2) * 128 * NP) + yoff);
        }
        f32x4 u[2][2], un[2];
#pragma unroll
        for (int i = 0; i < 2; ++i) { un[i] = (f32x4){0.f, 0.f, 0.f, 0.f};
#pragma unroll
            for (int j = 0; j < 2; ++j) u[i][j] = (f32x4){0.f, 0.f, 0.f, 0.f}; }
        sfor<0, 4>([&](auto ks_) {
            constexpr int ks = decltype(ks_)::value;
            bf16x8 fa0, fa1, fb0, fb1;
            tr_frag2<ks * 32 * 544, 4 * 544, 32>(baseX, fa0, fa1);
            tr_frag2<ks * 32 * 80, 4 * 80, 32>(baseY, fb0, fb1);
            u[0][0] = __builtin_amdgcn_mfma_f32_16x16x32_bf16(fa0, fb0, u[0][0], 0, 0, 0); u[0][1] = __builtin_amdgcn_mfma_f32_16x16x32_bf16(fa0, fb1, u[0][1], 0, 0, 0);
            u[1][0] = __builtin_amdgcn_mfma_f32_16x16x32_bf16(fa1, fb0, u[1][0], 0, 0, 0); u[1][1] = __builtin_amdgcn_mfma_f32_16x16x32_bf16(fa1, fb1, u[1][1], 0, 0, 0);
            if (BR == 0) {
                const f32x4 w0 = *(LAS const f32x4*)(wka + c * 128 + 32 * ks + 8 * g), w1 = *(LAS const f32x4*)(wka + c * 128 + 32 * ks + 8 * g + 4);
                u32x4 wv = (u32x4){pk2(w0[0], w0[1]), pk2(w0[2], w0[3]), pk2(w1[0], w1[1]), pk2(w1[2], w1[3])};
                if (lr != 0) wv = (u32x4){0u, 0u, 0u, 0u};
                const bf16x8 wf = __builtin_bit_cast(bf16x8, wv);
                un[0] = __builtin_amdgcn_mfma_f32_16x16x32_bf16(fa0, wf, un[0], 0, 0, 0); un[1] = __builtin_amdgcn_mfma_f32_16x16x32_bf16(fa1, wf, un[1], 0, 0, 0);
            }
        });
        const float dc = dec[c];
#pragma unroll
        for (int i = 0; i < 2; ++i) { nst[i] = nst[i] * dc + un[i];
#pragma unroll
            for (int j = 0; j < 2; ++j) st[i][j] = st[i][j] * dc + u[i][j]; }
        __syncthreads();
    };
#pragma unroll 1
    for (int c = 0; c < 16; c += 2) { step(c, xa, ya); step(c + 1, xb, yb); }
    float* fo = p.out + (BR == 0 ? O_CP : O_SP) + (((size_t)layer * BP + b) * HM + h) * SZ + (size_t)(32 * sl + lr) * 256 + 32 * w + 4 * g;
#pragma unroll
    for (int rt = 0; rt < 2; ++rt) {
#pragma unroll
        for (int ct = 0; ct < 2; ++ct) *(f32x4*)(fo + (size_t)(16 * ct) * 256 + 16 * rt) = st[rt][ct];
        if (nown) *(f32x4*)(p.out + O_NP + (((size_t)layer * BP + b) * HM + h) * 256 + 32 * w + 4 * g + 16 * rt) = nst[rt];
    }
    if (BR == 0 && sl == 0 && tid == 0) p.out[O_MP + ((size_t)layer * BP + b) * HM + h] = gt[6192];
    __syncthreads();
}

__device__ __forceinline__ void scan_item(const Params& p, int layer, int pi, int slice, LAS unsigned char* lds) {
    LAS float* G = (LAS float*)lds; LAS float* dec = G + 512;
    const int tid = opaque_tid(), br = pi >> 4, bh = pi & 15, b = bh >> 2, h = bh & 3;
    if (br == 0) { const float* gt = p.GT_() + (size_t)bh * 6208; if (tid < 16) { const float mc = gt[6176 + tid]; dec[tid] = expf(mc - fmaxf(mc, gt[6160 + tid])); } if (tid == 0) G[48] = gt[6192]; }
    else if (tid < 16) dec[tid] = expf(128.0f * ret_lg(h));
    __syncthreads();
    float st[2][8];
#pragma unroll
    for (int j = 0; j < 2; ++j)
#pragma unroll
        for (int k = 0; k < 8; ++k) st[j][k] = 0.f;
    for (int c = 0; c < 16; ++c) {
        const float dc = dec[c];
#pragma unroll
        for (int j = 0; j < 2; ++j) { const size_t idx = (size_t)slice * 8192 + j * 4096 + tid * 8;
            float u[8]; unpack8(*(const u32x4*)(p.U_() + ((size_t)pi * 16 + c) * SZ + idx), u);
            *(u32x4*)(p.CS_() + ((size_t)pi * 16 + c) * SZ + idx) = pack8(st[j]);
#pragma unroll
            for (int k = 0; k < 8; ++k) st[j][k] = st[j][k] * dc + u[k]; }
    }
    float* fo = p.out + (br == 0 ? O_CP : O_SP) + (((size_t)layer * BP + b) * HM + h) * SZ;
#pragma unroll
    for (int j = 0; j < 2; ++j) { float* q = fo + (size_t)slice * 8192 + j * 4096 + tid * 8;
        *(f32x4*)q = (f32x4){st[j][0], st[j][1], st[j][2], st[j][3]}; *(f32x4*)(q + 4) = (f32x4){st[j][4], st[j][5], st[j][6], st[j][7]}; }
    if (br == 0 && slice == 0) {
        if (tid < 256) { float n = 0.f;
            for (int c = 0; c < 16; ++c) { p.NS_()[((size_t)bh * 16 + c) * 256 + tid] = n; n = dec[c] * n + p.NU_()[((size_t)bh * 16 + c) * 256 + tid]; }
            p.out[O_NP + (((size_t)layer * BP + b) * HM + h) * 256 + tid] = n; }
        if (tid == 0) p.out[O_MP + ((size_t)layer * BP + b) * HM + h] = G[48];
    }
    __syncthreads();
}

template <int BR>
__device__ __forceinline__ void chunk_passC(const Params& p, int layer, int b, int h, int c, LAS unsigned char* lds) {
    LAS unsigned char* BufB = lds; LAS unsigned char* Sw = lds + 69632; LAS float* G = (LAS float*)(lds + 104448);
    LAS float* av = G + 512; LAS float* fl = G + 640; LAS bf16_t* nbf = (LAS bf16_t*)(G + 768);
    const int tid = opaque_tid(), lane = tid & 63, w = __builtin_amdgcn_readfirstlane(tid >> 6), g = lane >> 4, lr = lane & 15;
    const size_t row0 = (size_t)b * SEQ + c * 128;
    const int pi = BR * 16 + b * 4 + h, l = 16 * w + lr;
    const float lg = ret_lg(h);
    u32x4 tr[8];
    tile_load<32>(tr, BR == 0 ? p.QK_() + row0 * 2048 + h * 512 + 256 : p.P_() + row0 * NP + C_KR + h * 256, BR == 0 ? 2048 : NP, tid);
    if (BR == 0) {
        gate_load(p, b * 4 + h, c, G, tid);
        if (tid < 128) { av[tid] = expf(G[32 + c] - G[320 + tid]); fl[tid] = expf(-(G[64 + tid] + G[320 + tid])); }
        if (tid < 256) nbf[tid] = f2bf(p.NS_()[((size_t)(b * 4 + h) * 16 + c) * 256 + tid]);
    } else { if (tid < 128) av[tid] = expf((float)(tid + 1) * lg); }
    const bf16_t* Qp = BR == 0 ? p.QK_() + (row0 + l) * 2048 + h * 512 : p.P_() + (row0 + l) * NP + C_QR + h * 256;
    bf16x8 qf[8];
#pragma unroll
    for (int ks = 0; ks < 8; ++ks) qf[ks] = *(const bf16x8*)(Qp + 32 * ks + 8 * g);
    tile_store<32, 544>(BufB, tr, tid);
    __syncthreads();
    const bf16_t* CSp = p.CS_() + ((size_t)pi * 16 + c) * SZ;
    if (BR == 0) tile_load<32>(tr, CSp, 256, tid); else tile_load<16>(tr, CSp, 256, tid);
    float rs = 0.f;
    const float Gl = BR == 0 ? G[320 + l] : 0.f;
#pragma unroll
    for (int j = 0; j < 8; ++j) {
        f32x4 a = (f32x4){0.f, 0.f, 0.f, 0.f};
        if (j <= w) {
#pragma unroll
            for (int ks = 0; ks < 8; ++ks) a = __builtin_amdgcn_mfma_f32_16x16x32_bf16(lds_frag(BufB, 16 * j + lr, 544, (32 * ks + 8 * g) * 2), qf[ks], a, 0, 0, 0);
        }
        float v[4];
#pragma unroll
        for (int r = 0; r < 4; ++r) {
            const int sidx = 16 * j + 4 * g + r;
            float d = 0.f;
            if (sidx <= l) d = BR == 0 ? expf(G[192 + sidx] - Gl) : expf((float)(l - sidx) * lg);
            v[r] = a[r] * d; rs += v[r];
        }
        *(LAS u32x2*)(Sw + l * 272 + (16 * j + 4 * g) * 2) = (u32x2){pk2(v[0], v[1]), pk2(v[2], v[3])};
        __builtin_amdgcn_sched_barrier(0);
    }
    rs += __shfl_xor(rs, 16); rs += __shfl_xor(rs, 32);
    __syncthreads();
    f32x4 accN[16];
#pragma unroll
    for (int t = 0; t < 16; ++t) accN[t] = (f32x4){0.f, 0.f, 0.f, 0.f};
    const unsigned lq = (unsigned)(8 * g + (lr >> 2)), lp4 = (unsigned)(4 * (lr & 3));
    sfor<0, 2>([&](auto half_) {
        constexpr int half = decltype(half_)::value;
        if (BR == 0) tile_store<32, 544>(BufB, tr, tid); else tile_store<16, 272>(BufB, tr, tid);
        __syncthreads();
        if (half == 0) { if (BR == 0) tile_load<32>(tr, CSp + 128 * 256, 256, tid); else tile_load<16>(tr, CSp + 128, 256, tid); }
        else tile_load<32>(tr, p.P_() + row0 * NP + (BR == 0 ? C_VM : C_VR) + h * 256, NP, tid);
        if (BR == 0) {
#pragma unroll
            for (int t = 0; t < 8; ++t) {
#pragma unroll
                for (int ks = 0; ks < 8; ++ks)
                    accN[half * 8 + t] = __builtin_amdgcn_mfma_f32_16x16x32_bf16(lds_frag(BufB, 16 * t + lr, 544, (32 * ks + 8 * g) * 2), qf[ks], accN[half * 8 + t], 0, 0, 0);
                __builtin_amdgcn_sched_barrier(0); }
        } else {
            const unsigned base = lds_addr(BufB) + (lq * 136 + lp4) * 2;
            sfor<0, 8>([&](auto ks_) {
                constexpr int ks = decltype(ks_)::value;
                sfor<0, 2>([&](auto tq_) {
                    constexpr int tq = decltype(tq_)::value;
                    bf16x8 f[4];
                    tr_frag4<ks * 32 * 272 + tq * 128, 4 * 272, 32>(base, f);
#pragma unroll
                    for (int i = 0; i < 4; ++i) accN[half * 8 + 4 * tq + i] = __builtin_amdgcn_mfma_f32_16x16x32_bf16(f[i], qf[ks], accN[half * 8 + 4 * tq + i], 0, 0, 0);
                });
            });
        }
        __syncthreads();
    });
    float nq = 0.f;
    if (BR == 0) {
        f32x4 ad = (f32x4){0.f, 0.f, 0.f, 0.f};
#pragma unroll
        for (int ks = 0; ks < 8; ++ks) {
            bf16x8 nf = *(LAS const bf16x8*)(nbf + 32 * ks + 8 * g);
            if (lr != 0) nf = (bf16x8){0, 0, 0, 0, 0, 0, 0, 0};
            ad = __builtin_amdgcn_mfma_f32_16x16x32_bf16(nf, qf[ks], ad, 0, 0, 0);
        }
        nq = __shfl(ad[0], lr);
    }
    const float al = av[l];
#pragma unroll
    for (int t = 0; t < 16; ++t) accN[t] *= al;
    tile_store<32, 544>(BufB, tr, tid);
    __syncthreads();
    {
        const unsigned base = lds_addr(BufB) + (lq * 272 + lp4) * 2;
        sfor<0, 4>([&](auto ks_) {
            constexpr int ks = decltype(ks_)::value;
            const bf16x8 bfr = lds_frag(Sw, l, 272, (32 * ks + 8 * g) * 2);
            sfor<0, 4>([&](auto tq_) {
                constexpr int tq = decltype(tq_)::value;
                bf16x8 f[4];
                tr_frag4<ks * 32 * 544 + tq * 128, 4 * 544, 32>(base, f);
#pragma unroll
                for (int i = 0; i < 4; ++i) accN[4 * tq + i] = __builtin_amdgcn_mfma_f32_16x16x32_bf16(f[i], bfr, accN[4 * tq + i], 0, 0, 0);
            });
        });
    }
    float inv = 1.0f;
    if (BR == 0) inv = 1.0f / fmaxf(fabsf(rs + al * nq), fl[l]);
    float sm = 0.f;
#pragma unroll
    for (int t = 0; t < 16; ++t) { accN[t] *= inv; sm += (accN[t][0] + accN[t][1]) + (accN[t][2] + accN[t][3]); }
    sm += __shfl_xor(sm, 16); sm += __shfl_xor(sm, 32);
    const float mu = sm * (1.0f / 256.0f);
    float qv = 0.f;
#pragma unroll
    for (int t = 0; t < 16; ++t) { const f32x4 d = accN[t] - mu; qv += (d[0] * d[0] + d[1] * d[1]) + (d[2] * d[2] + d[3] * d[3]); }
    qv += __shfl_xor(qv, 16); qv += __shfl_xor(qv, 32);
    const float rstd = rsqrtf(qv * (1.0f / 256.0f) + EPS);
    const float* gain = (BR == 0 ? p.hn_m_g : p.hn_r_g) + (size_t)layer * WM + h * 256 + 4 * g;
    const float* skip = p.skip_m + (size_t)layer * WM + h * 256 + 4 * g;
    const size_t row = row0 + l;
    const bf16_t* zp = p.P_() + row * NP + (BR == 0 ? C_ZM : C_ZR) + h * 256 + 4 * g;
    const bf16_t* cp = p.CM_() + row * WM + h * 256 + 4 * g;
    bf16_t* op = p.OC_() + row * 2048 + BR * 1024 + h * 256 + 4 * g;
#pragma unroll
    for (int t = 0; t < 16; ++t) {
        const f32x4 ge = *(const f32x4*)(gain + 16 * t);
        const u32x2 zb = *(const u32x2*)(zp + 16 * t);
        f32x4 v = (accN[t] - mu) * rstd * ge;
        if (BR == 0) { const f32x4 sk = *(const f32x4*)(skip + 16 * t); const u32x2 cb = *(const u32x2*)(cp + 16 * t);
            v[0] += sk[0] * __uint_as_float(cb.x << 16); v[1] += sk[1] * __uint_as_float(cb.x & 0xffff0000u);
            v[2] += sk[2] * __uint_as_float(cb.y << 16); v[3] += sk[3] * __uint_as_float(cb.y & 0xffff0000u); }
        const float z0 = __uint_as_float(zb.x << 16), z1 = __uint_as_float(zb.x & 0xffff0000u), z2 = __uint_as_float(zb.y << 16), z3 = __uint_as_float(zb.y & 0xffff0000u);
        *(u32x2*)(op + 16 * t) = (u32x2){pk2(v[0] * siluf_(z0), v[1] * siluf_(z1)), pk2(v[2] * siluf_(z2), v[3] * siluf_(z3))};
    }
    __syncthreads();
}

__device__ __forceinline__ f32x4 bf4_to_f32(u32x2 v) { return (f32x4){__uint_as_float(v.x << 16), __uint_as_float(v.x & 0xffff0000u), __uint_as_float(v.y << 16), __uint_as_float(v.y & 0xffff0000u)}; }
__device__ __forceinline__ const char* sample_state(const Params& p, int layer, int s) {
    const int br = s >> 9, b = (s >> 2) & 127, h = s & 3;
    return (const char*)((br == 0 ? p.st_C : p.st_S) + (((size_t)layer * BS + b) * HM + h) * SZ);
}
template <int BR>
__device__ __forceinline__ void sample_item(const Params& p, int layer, int b, int h, LAS float* base, const f32x4 (&cin)[8], f32x4 (&cnx)[8], const char* nsrc) {
    LAS float* sq = base; LAS float* sk = sq + 256; LAS float* sv = sk + 256; LAS float* sr = sv + 256; LAS float* part = sr + 256;
    const int tid = opaque_tid(), lane = tid & 63, wid = __builtin_amdgcn_readfirstlane(tid >> 6), e0 = 4 * lane;
    const size_t R = (size_t)MP + b;
    const size_t sidx = ((size_t)layer * BS + b) * HM + h;
    const bf16_t* qg = BR == 0 ? p.QK_() + R * 2048 + h * 512 : p.P_() + R * NP + C_QR + h * 256;
    const bf16_t* kg = BR == 0 ? p.QK_() + R * 2048 + h * 512 + 256 : p.P_() + R * NP + C_KR + h * 256;
    const bf16_t* vg = p.P_() + R * NP + (BR == 0 ? C_VM : C_VR) + h * 256;
    if (tid < 256) { sq[tid] = bf2f(qg[tid]); sk[tid] = bf2f(kg[tid]); sv[tid] = bf2f(vg[tid]); }
    const f32x4 q4 = bf4_to_f32(*(const u32x2*)(qg + e0)), k4 = bf4_to_f32(*(const u32x2*)(kg + e0)), v4 = bf4_to_f32(*(const u32x2*)(vg + e0));
    float wgt = 1.f, a = 1.0f - exp2f(-5.0f - (float)h), mt = 0.f;
    if (BR == 0) {
        const float ig = p.IF_()[R * 8 + h] + p.b_i[layer * HM + h];
        const float lf = logsigf_(p.IF_()[R * 8 + 4 + h] + p.b_f[layer * HM + h]);
        const float inter = lf + p.st_m[sidx];
        mt = fmaxf(inter, ig); wgt = expf(ig - mt); a = expf(inter - mt);
    }
    const char* sb = sample_state(p, layer, (BR << 9) | (b << 2) | h) + (size_t)wid * 1024 + (unsigned)lane * 16u;
    char* ob = (char*)(p.out + (BR == 0 ? O_CS : O_SS) + sidx * SZ) + (size_t)wid * 1024 + (unsigned)lane * 16u;
    __syncthreads();
    f32x4 cc[8], cn[8];
#pragma unroll
    for (int j = 0; j < 8; ++j) cc[j] = cin[j];
    f32x4 ac = (f32x4){0.f, 0.f, 0.f, 0.f};
#pragma unroll
    for (int i0 = 0; i0 < 32; i0 += 8) {
        if (i0 + 8 < 32) {
#pragma unroll
            for (int j = 0; j < 8; ++j) cn[j] = __builtin_nontemporal_load((const f32x4*)(sb + (size_t)(i0 + 8 + j) * 8192));
        } else if (nsrc) {
            const char* nb = nsrc + (size_t)wid * 1024 + (unsigned)lane * 16u;
#pragma unroll
            for (int j = 0; j < 8; ++j) cnx[j] = __builtin_nontemporal_load((const f32x4*)(nb + (size_t)j * 8192));
        }
#pragma unroll
        for (int j = 0; j < 8; ++j) { const int e = wid + 8 * (i0 + j);
            if (BR == 0) {
                float pt = (cc[j][0] * q4[0] + cc[j][1] * q4[1]) + (cc[j][2] * q4[2] + cc[j][3] * q4[3]);
                __builtin_nontemporal_store(cc[j] * a + k4 * (wgt * sv[e]), (f32x4*)(ob + (size_t)(i0 + j) * 8192));
                pt = wave_sum(pt);
                if (lane == 0) sr[e] = pt;
            } else {
                ac = ac + cc[j] * sq[e];
                __builtin_nontemporal_store(cc[j] * a + v4 * sk[e], (f32x4*)(ob + (size_t)(i0 + j) * 8192));
            }
        }
        if (i0 + 8 < 32) {
#pragma unroll
            for (int j = 0; j < 8; ++j) cc[j] = cn[j];
        }
    }
    if (BR == 1) *(LAS f32x4*)(part + wid * 256 + e0) = ac;
    __syncthreads();
    if (wid == 0) {
        f32x4 hv;
        if (BR == 0) {
            const f32x4 n4 = *(const f32x4*)(p.st_n + sidx * 256 + e0);
            const f32x4 cq = *(LAS const f32x4*)(sr + e0);
            const float qk = wave_sum((q4[0] * k4[0] + q4[1] * k4[1]) + (q4[2] * k4[2] + q4[3] * k4[3]));
            const float nq = wave_sum((n4[0] * q4[0] + n4[1] * q4[1]) + (n4[2] * q4[2] + n4[3] * q4[3]));
            const float ws = wgt * qk, inv = 1.0f / fmaxf(fabsf(ws + a * nq), expf(-mt));
            hv = (v4 * ws + cq * a) * inv;
            *(f32x4*)(p.out + O_NS + sidx * 256 + e0) = n4 * a + k4 * wgt;
            if (lane == 0) p.out[O_MS + sidx] = mt;
        } else {
            f32x4 oi = (f32x4){0.f, 0.f, 0.f, 0.f};
#pragma unroll
            for (int i = 0; i < 8; ++i) oi = oi + *(LAS const f32x4*)(part + i * 256 + e0);
            const float qk = wave_sum((q4[0] * k4[0] + q4[1] * k4[1]) + (q4[2] * k4[2] + q4[3] * k4[3]));
            hv = v4 * qk + oi * a;
        }
        const float mean = wave_sum((hv[0] + hv[1]) + (hv[2] + hv[3])) * (1.0f / 256.0f);
        const f32x4 dv = hv - mean;
        const float rstd = rsqrtf(wave_sum((dv[0] * dv[0] + dv[1] * dv[1]) + (dv[2] * dv[2] + dv[3] * dv[3])) * (1.0f / 256.0f) + EPS);
        const f32x4 ge = *(const f32x4*)((BR == 0 ? p.hn_m_g : p.hn_r_g) + (size_t)layer * WM + h * 256 + e0);
        f32x4 v = dv * rstd * ge;
        const f32x4 z = bf4_to_f32(*(const u32x2*)(p.P_() + R * NP + (BR == 0 ? C_ZM : C_ZR) + h * 256 + e0));
        if (BR == 0) v = v + *(const f32x4*)(p.skip_m + (size_t)layer * WM + h * 256 + e0) * bf4_to_f32(*(const u32x2*)(p.CM_() + R * WM + h * 256 + e0));
        *(u32x2*)(p.OC_() + R * 2048 + BR * 1024 + h * 256 + e0) = (u32x2){pk2(v[0] * siluf_(z[0]), v[1] * siluf_(z[1])), pk2(v[2] * siluf_(z[2]), v[3] * siluf_(z[3]))};
    }
    __syncthreads();
}

template <int MODE>
__device__ __forceinline__ void sample_gemm(const Params& p, const bf16_t* Wl, int wg, int nwg, LAS unsigned char* lds, unsigned long long* ssn) {
    const int tid = opaque_tid(), lane = tid & 63, w = tid >> 6, g = lane >> 4, lr = lane & 15, hf = w >> 2;
    LAS f32x4* xch = (LAS f32x4*)lds;
    LAS float* red = (LAS float*)(lds + 4096);
    for (int j = wg; j < 256; j += nwg) {
        const int rbase = MP + 32 * (j & 3) + 16 * ((w >> 1) & 1), cbase = 32 * (j >> 2) + 16 * (w & 1);
        const bf16_t* A = (MODE == 0 ? p.OC_() : p.MG_()) + (size_t)(rbase + lr) * 2048 + hf * 1024 + 8 * g;
        const bf16_t* B = Wl + (MODE == 0 ? W3_OFF : W4_OFF) + (size_t)(cbase + lr) * 2048 + hf * 1024 + 8 * g;
        f32x4 acc = (f32x4){0.f, 0.f, 0.f, 0.f};
#pragma unroll 1
        for (int k0 = 0; k0 < 1024; k0 += 512) {
            bf16x8 af[16], bf[16];
#pragma unroll
            for (int i = 0; i < 16; ++i) { af[i] = *(const bf16x8*)(A + k0 + 32 * i); bf[i] = *(const bf16x8*)(B + k0 + 32 * i); }
#pragma unroll
            for (int i = 0; i < 16; ++i) acc = __builtin_amdgcn_mfma_f32_16x16x32_bf16(af[i], bf[i], acc, 0, 0, 0);
        }
        if (hf == 1) xch[(w & 3) * 64 + lane] = acc;
        __syncthreads();
        if (hf == 0) {
            const f32x4 hi = xch[(w & 3) * 64 + lane];
            const int col = cbase + lr;
#pragma unroll
            for (int r = 0; r < 4; ++r) {
                const size_t row = (size_t)rbase + 4 * g + r;
                if (MODE == 0) {
                    const float rt = bf2f(p.RT_()[row * 2048 + col]), gr = bf2f(p.GRS_()[row * 2048 + col]);
                    p.MG_()[row * 2048 + col] = f2bf(gr * (rt * acc[r] + hi[r]));
                } else {
                    const bf16_t nb = f2bf(bf2f(p.Xb_()[row * 2048 + col]) + acc[r] + hi[r]);
                    p.Xb_()[row * 2048 + col] = nb;
                    float q = bf2f(nb) * bf2f(nb);
                    q += __shfl_xor(q, 1); q += __shfl_xor(q, 2); q += __shfl_xor(q, 4); q += __shfl_xor(q, 8);
                    if (lr == 0) red[(w & 1) * 32 + 16 * ((w >> 1) & 1) + 4 * g + r] = q;
                }
            }
        }
        if (MODE == 1) {
            __syncthreads();
            if (tid < 32) atomicAdd(ssn + MP + 32 * (j & 3) + tid, ss_fix(red[tid] + red[32 + tid]));
        }
        __syncthreads();
    }
}

__device__ __forceinline__ void sample_gemm2(const Params& p, const bf16_t* W2t, int wg, int nwg) {
    const int tid = opaque_tid(), lane = tid & 63, w = tid >> 6, g = lane >> 4, lr = lane & 15;
    for (int j = wg; j < 128; j += nwg) {
        const int rbase = MP + 16 * (j & 7), cbase = 128 * (j >> 3) + 16 * w, head = cbase >> 9;
        const bf16_t* A = p.CM_() + (size_t)(rbase + lr) * WM + head * 256 + 8 * g;
        const bf16_t* B = W2t + (size_t)(cbase + lr) * 256 + 8 * g;
        bf16x8 af[8], bf[8];
#pragma unroll
        for (int i = 0; i < 8; ++i) { af[i] = *(const bf16x8*)(A + 32 * i); bf[i] = *(const bf16x8*)(B + 32 * i); }
        f32x4 acc = (f32x4){0.f, 0.f, 0.f, 0.f};
#pragma unroll
        for (int i = 0; i < 8; ++i) acc = __builtin_amdgcn_mfma_f32_16x16x32_bf16(af[i], bf[i], acc, 0, 0, 0);
#pragma unroll
        for (int r = 0; r < 4; ++r) p.QK_()[(size_t)(rbase + 4 * g + r) * 2048 + cbase + lr] = f2bf(acc[r]);
    }
}

__device__ __forceinline__ void phaseA(const Params& p, int layer, int wg, int nwg, LAS unsigned char* lds) {
    for (int it = wg; it < 256; it += nwg) {
        const int pi = (it & 7) * 4 + (it >> 6), sl = (it >> 3) & 7, bh = pi & 15;
        if (pi < 16) chunk_state_item<0>(p, layer, bh >> 2, bh & 3, sl, lds); else chunk_state_item<1>(p, layer, bh >> 2, bh & 3, sl, lds);
    }
    {
        const int tid = opaque_tid(), lane = tid & 63, wid = __builtin_amdgcn_readfirstlane(tid >> 6);
        int s = wg, k = 0;
        if (s < 1024) {
            f32x4 cc[8], cx[8];
            { const char* sb = sample_state(p, layer, s) + (size_t)wid * 1024 + (unsigned)lane * 16u;
#pragma unroll
              for (int j = 0; j < 8; ++j) cc[j] = __builtin_nontemporal_load((const f32x4*)(sb + (size_t)j * 8192)); }
            for (;; ++k) {
                const int sn = s + nwg;
                const char* nsrc = sn < 1024 ? sample_state(p, layer, sn) : nullptr;
                LAS float* base = (LAS float*)lds + (k & 1) * 3072;
                const int b = (s >> 2) & 127, h = s & 3;
                if (s < 512) sample_item<0>(p, layer, b, h, base, cc, cx, nsrc); else sample_item<1>(p, layer, b, h, base, cc, cx, nsrc);
                if (sn >= 1024) break;
#pragma unroll
                for (int j = 0; j < 8; ++j) cc[j] = cx[j];
                s = sn;
            }
        }
        __syncthreads();
    }
}
__device__ __forceinline__ void phaseScan(const Params& p, int layer, int wg, int nwg, LAS unsigned char* lds) {
    for (int it = wg; it < 256; it += nwg) scan_item(p, layer, it >> 3, it & 7, lds);
}
__device__ __forceinline__ void phaseC(const Params& p, int layer, int wg, int nwg, LAS unsigned char* lds) {
    for (int it = wg; it < 512; it += nwg) {
        const int br = it >> 8, rest = it & 255, b = rest >> 6, h = (rest >> 4) & 3, c = rest & 15;
        if (br == 0) chunk_passC<0>(p, layer, b, h, c, lds); else chunk_passC<1>(p, layer, b, h, c, lds);
    }
}

template <int ONLY>
__device__ __forceinline__ void run_phases(const Params& p_in, int ph_lo, int ph_hi) {
    extern __shared__ __attribute__((aligned(16))) unsigned char smem_raw[];
    LAS unsigned char* lds = (LAS unsigned char*)smem_raw;
    volatile LAS unsigned* xbw = (volatile LAS unsigned*)(lds + LDS_BYTES - 16);
    const int wg_in = blockIdx.x, nwg = gridDim.x;
    const bool multi = (ph_hi - ph_lo) > 1;
    XcdBarrier bar; bar.bar = p_in.bar_(); bar.x = 0; bar.st = xbw;
    if (multi) {
        if (threadIdx.x == 0) { xbw[0] = 0u; xbw[1] = 0u; xbw[2] = 0u; xbw[3] = 0u; }
        __syncthreads();
        bar = xcd_barrier_post(p_in.bar_(), xbw);
    }
    int ph = 0;
#define PHASE(KIND, ...) { if constexpr (ONLY < 0 || ONLY == KIND) { if (ph >= ph_lo && ph < ph_hi) { \
    Params p = p_in; int wg = wg_in; { size_t z_ = 0; asm volatile("" : "+s"(z_), "+s"(wg)); p.ws = p_in.ws + z_; p.out = p_in.out + z_; }     \
    __VA_ARGS__; if (ph + 1 < ph_hi) xcd_barrier(bar); } } ++ph; }
    PHASE(0, prep_phase(p, wg, nwg, lds))
    for (int layer = 0; layer < DEPTH; ++layer) {
        PHASE(2, { pg8::StaticOrder S; S.init(MPAD, N1, nwg, wg); pg8::Gemm g{p.Xb_(), p.W_() + (size_t)layer * WL + W1_OFF, D, D, D, 31, 0, 0};
                pg8::EpiG1 E{p.P_(), p.b_gate + (size_t)layer * 4096, p.RT_(), p.GRS_(), p.ROPE_(), p.SS_() + (size_t)layer * MPAD, p.SSP_(), p.IF_()}; pg8::gemm_phase<false>(lds, g, S, E); })
        PHASE(3, conv_phase(p, layer, wg, nwg, lds))
        PHASE(4, { pg8::StaticOrder S; S.init(MP, 2048, nwg, wg); pg8::Gemm g{p.CM_(), p.W_() + (size_t)layer * WL + W2_OFF, 256, WM, 256, 1, 512, 0};
                pg8::EpiBf16 E{p.QK_(), 2048}; pg8::gemm_phase<false>(lds, g, S, E); sample_gemm2(p, p.W_() + (size_t)layer * WL + W2_OFF, wg, nwg); })
        PHASE(5, phaseA(p, layer, wg, nwg, lds))
        PHASE(7, phaseC(p, layer, wg, nwg, lds))
        PHASE(8, { pg8::StaticOrder S; S.init(MP, 2048, nwg, wg); pg8::Gemm g{p.OC_(), p.W_() + (size_t)layer * WL + W3_OFF, 2048, 2048, 2048, 31, 0, 16};
                pg8::EpiMerged E{p.MG_(), p.RT_(), p.GRS_()}; pg8::gemm_phase<true>(lds, g, S, E); sample_gemm<0>(p, p.W_() + (size_t)layer * WL, wg, nwg, lds, nullptr); })
        PHASE(10, { pg8::StaticOrder S; S.init(MP, 2048, nwg, wg); pg8::Gemm g{p.MG_(), p.W_() + (size_t)layer * WL + W4_OFF, 2048, 2048, 2048, 31, 0, 0};
                pg8::EpiResidual E{p.Xb_(), p.SSP_(), (LAS float*)(lds + pg8::STAGE_BYTES)}; pg8::gemm_phase<false>(lds, g, S, E); sample_gemm<1>(p, p.W_() + (size_t)layer * WL, wg, nwg, lds, p.SS_() + (size_t)(layer + 1) * MPAD); })
    }
    PHASE(11, final_phase(p, wg, nwg))
#undef PHASE
}
__global__ void __launch_bounds__(512, 2) mega(Params p, int ph_lo, int ph_hi) { run_phases<-1>(p, ph_lo, ph_hi); }
#ifdef DIAG
template <int K> __global__ void __launch_bounds__(512, 2) mega_k(Params p, int ph_lo, int ph_hi) { run_phases<K>(p, ph_lo, ph_hi); }
template __global__ void mega_k<0>(Params, int, int); template __global__ void mega_k<2>(Params, int, int);
template __global__ void mega_k<3>(Params, int, int); template __global__ void mega_k<4>(Params, int, int); template __global__ void mega_k<5>(Params, int, int);
template __global__ void mega_k<7>(Params, int, int); template __global__ void mega_k<8>(Params, int, int);
template __global__ void mega_k<10>(Params, int, int); template __global__ void mega_k<11>(Params, int, int);
#endif
constexpr int N_PHASES = 2 + DEPTH * 7;

extern "C" void kernel_launch(void* const* d_in, const int* in_sizes, int n_in, void* d_out, int out_size, void* d_ws, size_t ws_size, hipStream_t stream) {
    (void)in_sizes; (void)n_in; (void)out_size; (void)ws_size;
    static int grid = 0;
    if (grid == 0) {
        int dev = 0, cus = 0;
        hipGetDevice(&dev);
        hipDeviceGetAttribute(&cus, hipDeviceAttributeMultiprocessorCount, dev);
        if (hipFuncSetAttribute((const void*)mega, hipFuncAttributeMaxDynamicSharedMemorySize, LDS_BYTES) != hipSuccess) fprintf(stderr, "hipFuncSetAttribute failed\n");
        (void)hipGetLastError();
        grid = cus > 0 ? cus : 256;
    }
    Params p{};
    const float** in = (const float**)&p;
    for (int i = 0; i < 24; ++i) in[i] = (const float*)d_in[i];
    p.out = (float*)d_out;
    p.ws = (unsigned char*)d_ws;
    if (ws_size < WS_END) { fprintf(stderr, "workspace too small: %zu < %zu\n", ws_size, (size_t)WS_END); return; }
    hipMemsetAsync(d_ws, 0, 16384, stream);
#if MK_SINGLE
    hipLaunchKernelGGL(mega, dim3(grid), dim3(512), LDS_BYTES, stream, p, 0, N_PHASES);
#else
    for (int ph = 0; ph < N_PHASES; ++ph) hipLaunchKernelGGL(mega, dim3(grid), dim3(512), LDS_BYTES, stream, p, ph, ph + 1);
#endif
}
```

```cpp
#include <hip/hip_runtime.h>
#include <stdint.h>
#include <stdio.h>

#ifndef MK_SINGLE
#define MK_SINGLE 1
#endif

#define LAS __attribute__((address_space(3)))
typedef unsigned short bf16_t;
typedef short bf16x8 __attribute__((ext_vector_type(8)));
typedef float f32x4 __attribute__((ext_vector_type(4)));
typedef unsigned u32x4 __attribute__((ext_vector_type(4)));
typedef unsigned u32x2 __attribute__((ext_vector_type(2)));
typedef float f32x2_t __attribute__((ext_vector_type(2)));

constexpr int D = 2048, SEQ = 2048, BP = 4, BS = 128, DEPTH = 4, HM = 4, DH = 256, WM = 1024, NIN = 7176;
constexpr int MP = BP * SEQ, MT = MP + BS, MPAD = 8448;
constexpr int NP = 7168;
constexpr int N1 = 11520;
constexpr int C_U = 0, C_VM = 1024, C_ZM = 2048, C_QR = 3072, C_KR = 4096, C_VR = 5120, C_ZR = 6144, C_GM = 7168, C_GR = 9216;
constexpr float EPS = 1e-6f;
constexpr size_t SZ = 65536;
constexpr size_t O_YP = 0, O_YS = O_YP + 16777216, O_CP = O_YS + 262144, O_NP = O_CP + 4194304, O_MP = O_NP + 16384, O_CVP = O_MP + 64,
                 O_SP = O_CVP + 49152, O_CS = O_SP + 4194304, O_NS = O_CS + 134217728, O_MS = O_NS + 524288, O_CVS = O_MS + 2048, O_SS = O_CVS + 1572864;
constexpr size_t W1_OFF = 0, W2_OFF = W1_OFF + (size_t)N1 * D, W3_OFF = W2_OFF + (size_t)2048 * 256, W4_OFF = W3_OFF + (size_t)D * D, WL = W4_OFF + (size_t)D * D;
constexpr int LDS_BYTES = 147456;

constexpr size_t al256(size_t x) { return (x + 255) & ~(size_t)255; }
constexpr size_t OFF_BAR = 0, OFF_SS = OFF_BAR + 16384, OFF_SSP = OFF_SS + al256((size_t)5 * MPAD * 8), OFF_XB = OFF_SSP + al256((size_t)8 * MP * 4),
    OFF_P = OFF_XB + al256((size_t)MPAD * D * 2), OFF_IF = OFF_P + al256((size_t)MPAD * NP * 2), OFF_CM = OFF_IF + al256((size_t)MPAD * 8 * 4),
    OFF_QK = OFF_CM + al256((size_t)MPAD * WM * 2), OFF_OC = OFF_QK + al256((size_t)MPAD * 2048 * 2), OFF_MG = OFF_OC + al256((size_t)MPAD * 2048 * 2),
    OFF_U = OFF_MG + al256((size_t)MPAD * 2048 * 2), OFF_CS = OFF_U + al256((size_t)32 * 16 * SZ * 2), OFF_NU = OFF_CS + al256((size_t)32 * 16 * SZ * 2),
    OFF_NS = OFF_NU + al256((size_t)16 * 16 * 256 * 4), OFF_W = OFF_NS + al256((size_t)16 * 16 * 256 * 4), OFF_ROPE = OFF_W + al256((size_t)DEPTH * WL * 2),
    OFF_RT = OFF_ROPE + al256((size_t)2049 * 128 * 2 * 4), OFF_GRS = OFF_RT + al256((size_t)MPAD * 2048 * 2), OFF_GT = OFF_GRS + al256((size_t)MPAD * 2048 * 2),
    WS_END = OFF_GT + al256((size_t)16 * 6208 * 4);

struct Params {
    const float *x_prompt, *x_sample, *st_C, *st_n, *st_m, *st_conv, *st_S, *norm_g, *w_in, *conv_w, *conv_b, *w_qm, *w_km, *b_i, *b_f,
                *hn_m_g, *skip_m, *hn_r_g, *w_pm, *w_pr, *w_gate, *b_gate, *w_o, *final_g;
    float* out;
    unsigned char* ws;
#define WSF(name, type, off) __device__ __forceinline__ type* name##_() const { return (type*)(ws + (off)); }
    WSF(bar, unsigned, OFF_BAR) WSF(SS, unsigned long long, OFF_SS) WSF(SSP, float, OFF_SSP) WSF(Xb, bf16_t, OFF_XB) WSF(P, bf16_t, OFF_P) WSF(IF, float, OFF_IF)
    WSF(CM, bf16_t, OFF_CM) WSF(QK, bf16_t, OFF_QK) WSF(OC, bf16_t, OFF_OC) WSF(MG, bf16_t, OFF_MG) WSF(U, bf16_t, OFF_U) WSF(CS, bf16_t, OFF_CS)
    WSF(NU, float, OFF_NU) WSF(NS, float, OFF_NS) WSF(W, bf16_t, OFF_W) WSF(ROPE, float, OFF_ROPE) WSF(RT, bf16_t, OFF_RT) WSF(GRS, bf16_t, OFF_GRS) WSF(GT, float, OFF_GT)
#undef WSF
};


__device__ __forceinline__ unsigned long long ss_fix(float v) { return (unsigned long long)(v * 1048576.0f + 0.5f); }
__device__ __forceinline__ float ss_val(unsigned long long v) { return (float)v * (1.0f / 1048576.0f); }
__device__ __forceinline__ float row_ss(const float* ssp, const unsigned long long* ss, int row) {
    if (row < 8192) { const f32x4 a = *(const f32x4*)(ssp + (size_t)row * 8), b = *(const f32x4*)(ssp + (size_t)row * 8 + 4);
        return ((a[0] + a[1]) + (a[2] + a[3])) + ((b[0] + b[1]) + (b[2] + b[3])); }
    return ss_val(ss[row]);
}
__device__ __forceinline__ int opaque_tid() { int t = threadIdx.x; asm volatile("" : "+v"(t)); return t; }
__device__ __forceinline__ float bf2f(bf16_t v) { return __uint_as_float((unsigned)v << 16); }
__device__ __forceinline__ bf16_t f2bf(float f) { unsigned u = __float_as_uint(f); u += 0x7fffu + ((u >> 16) & 1u); return (bf16_t)(u >> 16); }
__device__ __forceinline__ unsigned pk2(float lo, float hi) { return (unsigned)f2bf(lo) | ((unsigned)f2bf(hi) << 16); }
__device__ __forceinline__ float wave_sum(float v) {
#pragma unroll
    for (int o = 32; o >= 1; o >>= 1) v += __shfl_xor(v, o);
    return v;
}
__device__ __forceinline__ float wave_max(float v) {
#pragma unroll
    for (int o = 32; o >= 1; o >>= 1) v = fmaxf(v, __shfl_xor(v, o));
    return v;
}
__device__ __forceinline__ float sigmoidf_(float x) { return __builtin_amdgcn_rcpf(1.0f + __expf(-x)); }
__device__ __forceinline__ float siluf_(float x) { return x * __builtin_amdgcn_rcpf(1.0f + __expf(-x)); }
__device__ __forceinline__ float logsigf_(float x) { return x < 0.f ? x - log1pf(expf(x)) : -log1pf(expf(-x)); }
__device__ __forceinline__ void block_sum2(float& a, float& b, LAS float* red) {
    a = wave_sum(a); b = wave_sum(b);
    __syncthreads();
    if ((threadIdx.x & 63) == 0) { red[threadIdx.x >> 6] = a; red[8 + (threadIdx.x >> 6)] = b; }
    __syncthreads();
    float sa = 0.f, sb = 0.f;
#pragma unroll
    for (int i = 0; i < 8; ++i) { sa += red[i]; sb += red[8 + i]; }
    a = sa; b = sb;
}

#define XB_TMO      128
#define XB_XCNT(j)  (256  + 64 * (j))
#define XB_XSUB(j)  (1280 + 64 * (j))
#define XB_XGEN(j)  (2304 + 64 * (j))
#define XB_TOP      3328
#define XB_TOPGEN   3392
#define XCD_BAR_WORDS 3456
#define XB_SPIN_CAP (1u << 22)

__device__ __forceinline__ unsigned xb_ld(unsigned* p)              { return __hip_atomic_load(p, __ATOMIC_RELAXED, __HIP_MEMORY_SCOPE_AGENT); }
__device__ __forceinline__ unsigned xb_add(unsigned* p, unsigned v) { return __hip_atomic_fetch_add(p, v, __ATOMIC_RELAXED, __HIP_MEMORY_SCOPE_AGENT); }
__device__ __forceinline__ unsigned xb_xcc_id() { return (unsigned)__builtin_amdgcn_s_getreg((3 << 11) | 20) & 0xFu; }
#define XB_SPIN(cond, bar) do { unsigned _sp = 0; while (cond) { __builtin_amdgcn_s_sleep(1); \
    if ((++_sp & 255u) == 0u) { if (xb_ld(&(bar)[XB_TMO])) break; if (_sp > XB_SPIN_CAP) { atomicAdd(&(bar)[XB_TMO], 1u); break; } } } } while (0)

struct XcdBarrier { unsigned* bar; unsigned x; volatile LAS unsigned* st; };

__device__ __forceinline__ XcdBarrier xcd_barrier_post(unsigned* bar, volatile LAS unsigned* st) {
    XcdBarrier b; b.bar = bar; b.x = xb_xcc_id(); b.st = st;
    if (threadIdx.x == 0) (void)xb_add(&bar[XB_XCNT(b.x)], 1u);
    return b;
}
__device__ __forceinline__ void xcd_barrier_complete(unsigned* bar, unsigned x, unsigned& nloc, unsigned& nx) {
    const unsigned G = gridDim.x * gridDim.y * gridDim.z;
    unsigned sum, cnt, mine, sp = 0u;
    for (;;) {
        sum = 0u; cnt = 0u; mine = 0u;
#pragma unroll
        for (unsigned j = 0; j < 16; ++j) { const unsigned c = xb_ld(&bar[XB_XCNT(j)]); sum += c; cnt += (c > 0u) ? 1u : 0u; mine = (j == x) ? c : mine; }
        if (sum == G) break;
        __builtin_amdgcn_s_sleep(1);
        if ((++sp & 255u) == 0u) { if (xb_ld(&bar[XB_TMO])) break; if (sp > XB_SPIN_CAP) { atomicAdd(&bar[XB_TMO], 1u); break; } }
    }
    nloc = mine > 0u ? mine : 1u; nx = cnt > 0u ? cnt : 1u;
}
__device__ __forceinline__ void xcd_barrier(const XcdBarrier& b) {
    asm volatile("s_waitcnt vmcnt(0)" ::: "memory");
    __syncthreads();
    if (threadIdx.x == 0) {
        unsigned* bar = b.bar;
        __builtin_amdgcn_s_waitcnt(0);
        unsigned nloc = b.st[0], nx = b.st[1];
        if (nloc == 0u) { xcd_barrier_complete(bar, b.x, nloc, nx); b.st[0] = nloc; b.st[1] = nx; }
        const unsigned old = xb_add(&bar[XB_XSUB(b.x)], 1u);
        const unsigned gen = old / nloc;
        if (old + 1u == (gen + 1u) * nloc) {
            __builtin_amdgcn_fence(__ATOMIC_RELEASE, "agent");
            asm volatile("s_waitcnt vmcnt(0)" ::: "memory");
            const unsigned og = xb_add(&bar[XB_TOP], 1u);
            const unsigned tg = og / nx;
            if (og + 1u == (tg + 1u) * nx) xb_add(&bar[XB_TOPGEN], 1u);
            else XB_SPIN(xb_ld(&bar[XB_TOPGEN]) == tg, bar);
            __builtin_amdgcn_fence(__ATOMIC_ACQUIRE, "agent");
            xb_add(&bar[XB_XGEN(b.x)], 1u);
            asm volatile("s_waitcnt vmcnt(0)" ::: "memory");
        } else {
            XB_SPIN(xb_ld(&bar[XB_XGEN(b.x)]) == gen, bar);
            __builtin_amdgcn_fence(__ATOMIC_ACQUIRE, "agent");
            asm volatile("s_waitcnt vmcnt(0)" ::: "memory");
        }
    }
    __syncthreads();
}

namespace pg8 {
constexpr int BM = 256, BK = 64, HALF = 128, HTB = HALF * BK * 2, STAGE_BYTES = 8 * HTB, NXCD = 8, WGM = 8;
__host__ __device__ __forceinline__ int lds_byte(int r, int c) { const int st = (r >> 4) * 2 + (c >> 5), rr = r & 15, cc = c & 31, ob = rr * 64 + cc * 2; return st * 1024 + (ob ^ (((ob >> 9) & 1) << 5)); }
__host__ __device__ __forceinline__ void stage_rc(int b, int& R, int& C) { const int st = b / 1024, sb = b % 1024, swz = sb ^ (((sb >> 9) & 1) << 5); R = (st >> 1) * 16 + swz / 64; C = (st & 1) * 32 + (swz % 64) / 2; }
__host__ __device__ __forceinline__ int perm32(int rho) { const int n = rho >> 4, i = rho & 15; return 8 * (i >> 2) + 4 * n + (i & 3); }

struct Unit { int pm, pn; };
struct Gemm { const bf16_t* A; const bf16_t* Bt; int K, lda, ldb, a_pn_shift, a_pn_stride, mid_t; };

struct StaticOrder {
    int nM, nN, nwg, G, c;
    __device__ void init(int M, int N, int G_, int c_) { nM = M / BM; nN = N / BM; nwg = nM * nN; G = G_; c = c_; }
    __device__ bool next(int i, Unit& u) const {
        const long L = (long)i * G + c; if (L >= nwg) return false;
        int wgid = (int)L; { const int q = nwg / NXCD, r = nwg % NXCD, xcd = wgid % NXCD, off = wgid / NXCD; wgid = (xcd < r ? xcd * (q + 1) : r * (q + 1) + (xcd - r) * q) + off; }
        const int nig = WGM * nN, gid = wgid / nig, fm = gid * WGM, gsz = (nM - fm) < WGM ? (nM - fm) : WGM;
        u.pm = fm + ((wgid % nig) % gsz); u.pn = (wgid % nig) / gsz; return true;
    }
};
__device__ __forceinline__ unsigned cvt_pk_bf16(float lo, float hi) { unsigned r; asm volatile("v_cvt_pk_bf16_f32 %0, %1, %2" : "=v"(r) : "v"(lo), "v"(hi)); return r; }

struct EpiBf16 {
    static constexpr bool PERM = true;
    bf16_t* O; int ldc;
    __device__ __forceinline__ void operator()(const f32x4 (&acc)[2][2][4][2], const Unit& u, int wr, int wc, int fr, int fq) const {
        const int row0 = u.pm * BM + wr * 64 + fr, col0 = u.pn * BM + wc * 32 + 8 * fq;
#pragma unroll
        for (int ai = 0; ai < 2; ++ai)
#pragma unroll
            for (int m = 0; m < 4; ++m) { bf16_t* rowp = O + (size_t)(row0 + ai * HALF + m * 16) * ldc + col0;
#pragma unroll
                for (int bj = 0; bj < 2; ++bj) { const f32x4 v0 = acc[ai][bj][m][0], v1 = acc[ai][bj][m][1];
                    u32x4 w; w.x = cvt_pk_bf16(v0[0], v0[1]); w.y = cvt_pk_bf16(v0[2], v0[3]); w.z = cvt_pk_bf16(v1[0], v1[1]); w.w = cvt_pk_bf16(v1[2], v1[3]);
                    *(u32x4*)(rowp + bj * HALF) = w; } }
    }
};
struct EpiG1 {
    static constexpr bool PERM = true;
    bf16_t* P; const float* bg; bf16_t* RT; bf16_t* GRS; const float* rope; const unsigned long long* ss; const float* ssp; float* IFo;
    __device__ __forceinline__ void operator()(f32x4 (&acc)[2][2][4][2], const Unit& u, int wr, int wc, int fr, int fq) const {
        const int row0 = u.pm * BM + wr * 64 + fr, cw = wc * 32 + 8 * fq;
#pragma unroll
        for (int ai = 0; ai < 2; ++ai) {
            float sq[4];
            if (u.pm < 32) {
                f32x4 a[4], b[4];
#pragma unroll
                for (int m = 0; m < 4; ++m) { const float* q = ssp + (size_t)(row0 + ai * HALF + m * 16) * 8; a[m] = *(const f32x4*)q; b[m] = *(const f32x4*)(q + 4); }
#pragma unroll
                for (int m = 0; m < 4; ++m) sq[m] = ((a[m][0] + a[m][1]) + (a[m][2] + a[m][3])) + ((b[m][0] + b[m][1]) + (b[m][2] + b[m][3]));
            } else {
                unsigned long long v[4];
#pragma unroll
                for (int m = 0; m < 4; ++m) v[m] = ss[row0 + ai * HALF + m * 16];
#pragma unroll
                for (int m = 0; m < 4; ++m) sq[m] = ss_val(v[m]);
            }
#pragma unroll
            for (int m = 0; m < 4; ++m) { const float rstd = rsqrtf(sq[m] * (1.0f / 2048.0f) + 1e-6f);
#pragma unroll
                for (int bj = 0; bj < 2; ++bj) { acc[ai][bj][m][0] *= rstd; acc[ai][bj][m][1] *= rstd; } }
            __builtin_amdgcn_sched_barrier(0);
        }
        if (u.pn == 44) {
            if (wc == 0 && fq == 0) {
#pragma unroll
                for (int ai = 0; ai < 2; ++ai)
#pragma unroll
                    for (int m = 0; m < 4; ++m) { float* o = IFo + (size_t)(row0 + ai * HALF + m * 16) * 8; *(f32x4*)o = acc[ai][0][m][0]; *(f32x4*)(o + 4) = acc[ai][0][m][1]; }
            }
        } else if (u.pn >= 28) {
            const int ch = 128 * (u.pn - 28) + cw;
            const f32x4 bm0 = *(const f32x4*)(bg + ch), bm1 = *(const f32x4*)(bg + ch + 4), br0 = *(const f32x4*)(bg + 2048 + ch), br1 = *(const f32x4*)(bg + 2048 + ch + 4);
#pragma unroll
            for (int ai = 0; ai < 2; ++ai)
#pragma unroll
                for (int m = 0; m < 4; ++m) { const size_t row = (size_t)(row0 + ai * HALF + m * 16);
                    const f32x4 vm0 = acc[ai][0][m][0] + bm0, vm1 = acc[ai][0][m][1] + bm1, vr0 = acc[ai][1][m][0] + br0, vr1 = acc[ai][1][m][1] + br1;
                    float rt[8], gr[8];
#pragma unroll
                    for (int j = 0; j < 4; ++j) {
                        const float er0 = 1.0f + __expf(-vr0[j]), er1 = 1.0f + __expf(-vr1[j]);
                        rt[j] = er0 * __builtin_amdgcn_rcpf(1.0f + __expf(-vm0[j])); rt[4 + j] = er1 * __builtin_amdgcn_rcpf(1.0f + __expf(-vm1[j]));
                        gr[j] = __builtin_amdgcn_rcpf(er0); gr[4 + j] = __builtin_amdgcn_rcpf(er1); }
                    u32x4 w; w.x = cvt_pk_bf16(rt[0], rt[1]); w.y = cvt_pk_bf16(rt[2], rt[3]); w.z = cvt_pk_bf16(rt[4], rt[5]); w.w = cvt_pk_bf16(rt[6], rt[7]);
                    *(u32x4*)(RT + row * 2048 + ch) = w;
                    w.x = cvt_pk_bf16(gr[0], gr[1]); w.y = cvt_pk_bf16(gr[2], gr[3]); w.z = cvt_pk_bf16(gr[4], gr[5]); w.w = cvt_pk_bf16(gr[6], gr[7]);
                    *(u32x4*)(GRS + row * 2048 + ch) = w; }
        } else if (u.pn >= 12 && u.pn < 20) {
            const float sc = u.pn >= 16 ? 0.0625f : 1.0f;
#pragma unroll
            for (int ai = 0; ai < 2; ++ai)
#pragma unroll
                for (int m = 0; m < 4; ++m) { const int row = row0 + ai * HALF + m * 16;
                    const int pi = row < MP ? (row & (SEQ - 1)) : 2048;
                    const f32x4* cs = (const f32x4*)(rope + ((size_t)pi * 128 + cw) * 2);
                    const f32x4 t0 = cs[0], t1 = cs[1], t2 = cs[2], t3 = cs[3];
                    const f32x4 a0 = acc[ai][0][m][0], a1 = acc[ai][0][m][1], b0 = acc[ai][1][m][0], b1 = acc[ai][1][m][1];
                    const float c[8] = {t0[0], t0[2], t1[0], t1[2], t2[0], t2[2], t3[0], t3[2]}, sn[8] = {t0[1], t0[3], t1[1], t1[3], t2[1], t2[3], t3[1], t3[3]};
                    const float x1[8] = {a0[0], a0[1], a0[2], a0[3], a1[0], a1[1], a1[2], a1[3]}, x2[8] = {b0[0], b0[1], b0[2], b0[3], b1[0], b1[1], b1[2], b1[3]};
                    float o1[8], o2[8];
#pragma unroll
                    for (int j = 0; j < 8; ++j) { o1[j] = (x1[j] * c[j] - x2[j] * sn[j]) * sc; o2[j] = (x1[j] * sn[j] + x2[j] * c[j]) * sc; }
                    bf16_t* rowp = P + (size_t)row * NP + u.pn * BM + cw;
                    u32x4 w; w.x = cvt_pk_bf16(o1[0], o1[1]); w.y = cvt_pk_bf16(o1[2], o1[3]); w.z = cvt_pk_bf16(o1[4], o1[5]); w.w = cvt_pk_bf16(o1[6], o1[7]);
                    *(u32x4*)rowp = w;
                    w.x = cvt_pk_bf16(o2[0], o2[1]); w.y = cvt_pk_bf16(o2[2], o2[3]); w.z = cvt_pk_bf16(o2[4], o2[5]); w.w = cvt_pk_bf16(o2[6], o2[7]);
                    *(u32x4*)(rowp + HALF) = w; }
        } else {
#pragma unroll
            for (int ai = 0; ai < 2; ++ai)
#pragma unroll
                for (int m = 0; m < 4; ++m) { bf16_t* rowp = P + (size_t)(row0 + ai * HALF + m * 16) * NP + u.pn * BM + cw;
#pragma unroll
                    for (int bj = 0; bj < 2; ++bj) { const f32x4 v0 = acc[ai][bj][m][0], v1 = acc[ai][bj][m][1];
                        u32x4 w; w.x = cvt_pk_bf16(v0[0], v0[1]); w.y = cvt_pk_bf16(v0[2], v0[3]); w.z = cvt_pk_bf16(v1[0], v1[1]); w.w = cvt_pk_bf16(v1[2], v1[3]);
                        *(u32x4*)(rowp + bj * HALF) = w; } }
        }
    }
};
struct EpiMerged {
    static constexpr bool PERM = true;
    bf16_t* O; const bf16_t* RT; const bf16_t* GRS;
    __device__ __forceinline__ void scale(f32x4 (&acc)[2][2][4][2], const bf16_t* S, const Unit& u, int wr, int wc, int fr, int fq) const {
        asm volatile("" : "+v"(fr), "+v"(fq));
        const int row0 = u.pm * BM + wr * 64 + fr, col0 = u.pn * BM + wc * 32 + 8 * fq;
#pragma unroll
        for (int ai = 0; ai < 2; ++ai) {
            u32x4 sv[4][2];
#pragma unroll
            for (int m = 0; m < 4; ++m)
#pragma unroll
                for (int bj = 0; bj < 2; ++bj) sv[m][bj] = *(const u32x4*)(S + (size_t)(row0 + ai * HALF + m * 16) * 2048 + col0 + bj * HALF);
#pragma unroll
            for (int m = 0; m < 4; ++m)
#pragma unroll
                for (int bj = 0; bj < 2; ++bj) { const u32x4 a = sv[m][bj];
                    acc[ai][bj][m][0][0] *= __uint_as_float(a.x << 16); acc[ai][bj][m][0][1] *= __uint_as_float(a.x & 0xffff0000u);
                    acc[ai][bj][m][0][2] *= __uint_as_float(a.y << 16); acc[ai][bj][m][0][3] *= __uint_as_float(a.y & 0xffff0000u);
                    acc[ai][bj][m][1][0] *= __uint_as_float(a.z << 16); acc[ai][bj][m][1][1] *= __uint_as_float(a.z & 0xffff0000u);
                    acc[ai][bj][m][1][2] *= __uint_as_float(a.w << 16); acc[ai][bj][m][1][3] *= __uint_as_float(a.w & 0xffff0000u); }
        }
    }
    __device__ __forceinline__ void mid(f32x4 (&acc)[2][2][4][2], const Unit& u, int wr, int wc, int fr, int fq) const { scale(acc, RT, u, wr, wc, fr, fq); }
    __device__ __forceinline__ void operator()(f32x4 (&acc)[2][2][4][2], const Unit& u, int wr, int wc, int fr, int fq) const {
        scale(acc, GRS, u, wr, wc, fr, fq);
        const int row0 = u.pm * BM + wr * 64 + fr, col0 = u.pn * BM + wc * 32 + 8 * fq;
#pragma unroll
        for (int ai = 0; ai < 2; ++ai)
#pragma unroll
            for (int m = 0; m < 4; ++m) { bf16_t* rowp = O + (size_t)(row0 + ai * HALF + m * 16) * 2048 + col0;
#pragma unroll
                for (int bj = 0; bj < 2; ++bj) { const f32x4 v0 = acc[ai][bj][m][0], v1 = acc[ai][bj][m][1];
                    u32x4 w; w.x = cvt_pk_bf16(v0[0], v0[1]); w.y = cvt_pk_bf16(v0[2], v0[3]); w.z = cvt_pk_bf16(v1[0], v1[1]); w.w = cvt_pk_bf16(v1[2], v1[3]);
                    *(u32x4*)(rowp + bj * HALF) = w; } }
    }
};
struct EpiResidual {
    static constexpr bool PERM = true;
    bf16_t* Xb; float* ssp; LAS float* red;
    __device__ __forceinline__ void operator()(f32x4 (&acc)[2][2][4][2], const Unit& u, int wr, int wc, int fr, int fq) const {
        const int row0 = u.pm * BM + wr * 64 + fr, col0 = u.pn * BM + wc * 32 + 8 * fq;
#pragma unroll
        for (int ai = 0; ai < 2; ++ai) {
            u32x4 xv[4][2];
#pragma unroll
            for (int m = 0; m < 4; ++m)
#pragma unroll
                for (int bj = 0; bj < 2; ++bj) xv[m][bj] = *(const u32x4*)(Xb + (size_t)(row0 + ai * HALF + m * 16) * 2048 + col0 + bj * HALF);
#pragma unroll
            for (int m = 0; m < 4; ++m) { float sq = 0.f;
#pragma unroll
                for (int bj = 0; bj < 2; ++bj) { const u32x4 a = xv[m][bj]; const f32x4 v0 = acc[ai][bj][m][0], v1 = acc[ai][bj][m][1];
                    u32x4 w;
                    w.x = cvt_pk_bf16(v0[0] + __uint_as_float(a.x << 16), v0[1] + __uint_as_float(a.x & 0xffff0000u)); w.y = cvt_pk_bf16(v0[2] + __uint_as_float(a.y << 16), v0[3] + __uint_as_float(a.y & 0xffff0000u));
                    w.z = cvt_pk_bf16(v1[0] + __uint_as_float(a.z << 16), v1[1] + __uint_as_float(a.z & 0xffff0000u)); w.w = cvt_pk_bf16(v1[2] + __uint_as_float(a.w << 16), v1[3] + __uint_as_float(a.w & 0xffff0000u));
                    *(u32x4*)(Xb + (size_t)(row0 + ai * HALF + m * 16) * 2048 + col0 + bj * HALF) = w;
                    const unsigned ww[4] = {w.x, w.y, w.z, w.w};
#pragma unroll
                    for (int q = 0; q < 4; ++q) { const float lo = __uint_as_float(ww[q] << 16), hi = __uint_as_float(ww[q] & 0xffff0000u); sq += lo * lo + hi * hi; } }
                sq += __shfl_xor(sq, 16); sq += __shfl_xor(sq, 32);
                if (fq == 0) red[(wr * 64 + fr + ai * HALF + m * 16) * 4 + wc] = sq; }
        }
        asm volatile("s_waitcnt lgkmcnt(0)" ::: "memory"); __builtin_amdgcn_s_barrier(); asm volatile("" ::: "memory");
        int t = threadIdx.x; asm volatile("" : "+v"(t));
        if (t < 256) { const f32x4 q = *(LAS const f32x4*)(red + 4 * t); ssp[(size_t)(u.pm * BM + t) * 8 + u.pn] = (q[0] + q[1]) + (q[2] + q[3]); }
        asm volatile("s_waitcnt lgkmcnt(0)" ::: "memory"); __builtin_amdgcn_s_barrier(); asm volatile("" ::: "memory");
    }
};

template <bool MID, class Epi, class Sched, bool ALIGN_EPI = true>
__device__ __forceinline__ void gemm_phase(LAS unsigned char* lds, const Gemm g, const Sched& S, const Epi& E) {
    const int tid = opaque_tid(), wid = __builtin_amdgcn_readfirstlane(tid >> 6), lane = tid & 63, wr = wid >> 2, wc = wid & 3, fr = lane & 15, fq = lane >> 4;
    const int K = g.K, nt = K / BK;
    unsigned voffA[2], voffB[2];
#pragma unroll
    for (int i = 0; i < 2; ++i) { int R, C; stage_rc(tid * 16 + i * 8192, R, C); const int Rb = Epi::PERM ? ((R & ~31) + perm32(R & 31)) : R;
        voffA[i] = (unsigned)(R * g.lda + C) * 2u; voffB[i] = (unsigned)(Rb * g.ldb + C) * 2u; }
    const size_t kstep = (size_t)(BK * 2);
    const size_t hstepA = (size_t)HALF * g.lda * 2, hstepB = (size_t)HALF * g.ldb * 2;
    const size_t tstepA = 2 * hstepA, tstepB = 2 * hstepB;
    const unsigned ldsw = (unsigned)wid * 1024u;
    const int aoff = lds_byte(wr * 64 + fr, fq * 8), boff = lds_byte(wc * 32 + fr, fq * 8);
#define PG8_SA(b, h) (((b) * 2 + (h)) * HTB)
#define PG8_SB(b, h) ((4 + (b) * 2 + (h)) * HTB)
#define PG8_STAGE(bufoff, gbase, voff) do { _Pragma("unroll") for (int _i = 0; _i < 2; ++_i) \
        __builtin_amdgcn_global_load_lds((const unsigned*)((const char*)(gbase) + (voff)[_i]), (LAS unsigned*)(lds + (bufoff) + ldsw + _i * 8192), 16, 0, 0); } while (0)
#define PG8_LDA(dst, b, h) do { _Pragma("unroll") for (int m = 0; m < 4; ++m) _Pragma("unroll") for (int k = 0; k < 2; ++k) dst[m][k] = *(const LAS bf16x8*)(lds + PG8_SA(b, h) + aoff + m * 2048 + k * 1024); } while (0)
#define PG8_LDB(dst, b, h) do { _Pragma("unroll") for (int n = 0; n < 2; ++n) _Pragma("unroll") for (int k = 0; k < 2; ++k) dst[n][k] = *(const LAS bf16x8*)(lds + PG8_SB(b, h) + boff + n * 2048 + k * 1024); } while (0)
#define PG8_MMA(ai, bj, At, Bt) do { __builtin_amdgcn_s_setprio(1); _Pragma("unroll") for (int m = 0; m < 4; ++m) _Pragma("unroll") for (int n = 0; n < 2; ++n) _Pragma("unroll") for (int k = 0; k < 2; ++k) \
        acc[ai][bj][m][n] = __builtin_amdgcn_mfma_f32_16x16x32_bf16(Bt[n][k], At[m][k], acc[ai][bj][m][n], 0, 0, 0); __builtin_amdgcn_s_setprio(0); } while (0)
#define PG8_WAIT_V(n) asm volatile("s_waitcnt vmcnt(" #n ")" ::: "memory")
#define PG8_WAIT_L(n) asm volatile("s_waitcnt lgkmcnt(" #n ")" ::: "memory")
#define PG8_BAR __builtin_amdgcn_s_barrier()
#define PG8_SCHED __builtin_amdgcn_sched_barrier(0)
#define PG8_APTR(u) ((const char*)g.A + (size_t)(u).pm * tstepA + (size_t)((u).pn >> g.a_pn_shift) * (size_t)g.a_pn_stride)
    Unit cur, nxt; int ui = 0;
    if (!S.next(0, cur)) return;
    f32x4 acc[2][2][4][2];
#pragma unroll
    for (int a = 0; a < 2; ++a)
#pragma unroll
        for (int b = 0; b < 2; ++b)
#pragma unroll
            for (int m = 0; m < 4; ++m)
#pragma unroll
                for (int n = 0; n < 2; ++n) acc[a][b][m][n] = (f32x4){0.f, 0.f, 0.f, 0.f};
    bf16x8 At[4][2], B0[2][2], B1[2][2];
    const char* cA = PG8_APTR(cur); const char* cB = (const char*)g.Bt + (size_t)cur.pn * tstepB;
    PG8_STAGE(PG8_SB(0, 0), cB, voffB); PG8_STAGE(PG8_SB(0, 1), cB + hstepB, voffB); PG8_STAGE(PG8_SA(0, 0), cA, voffA); PG8_STAGE(PG8_SA(0, 1), cA + hstepA, voffA);
    if (wr == 1) PG8_BAR;
    PG8_WAIT_V(2); PG8_BAR;
    PG8_STAGE(PG8_SB(1, 0), cB + kstep, voffB); PG8_STAGE(PG8_SA(1, 0), cA + kstep, voffA); PG8_STAGE(PG8_SB(1, 1), cB + hstepB + kstep, voffB);
    PG8_WAIT_V(6); PG8_BAR;
    for (;;) {
        const bool has_next = S.next(ui + 1, nxt);
        const char* nA = has_next ? PG8_APTR(nxt) : cA; const char* nB = has_next ? (const char*)g.Bt + (size_t)nxt.pn * tstepB : cB;
#pragma unroll 1
        for (int t = 0; t < nt; t += 2) {
            const bool last = (t == nt - 2);
            const char* a1 = cA + (size_t)(t + 1) * kstep;
            const char* a2 = last ? nA : cA + (size_t)(t + 2) * kstep; const char* b2 = last ? nB : cB + (size_t)(t + 2) * kstep;
            const char* a3 = a2 + kstep; const char* b3 = b2 + kstep;
            if constexpr (MID) { if (t == g.mid_t) E.mid(acc, cur, wr, wc, fr, fq); }
            PG8_LDB(B0, 0, 0); PG8_LDB(B1, 0, 1); PG8_SCHED; PG8_LDA(At, 0, 0); PG8_STAGE(PG8_SA(1, 1), a1 + hstepA, voffA);
            PG8_WAIT_V(8); PG8_WAIT_L(0); PG8_BAR; PG8_MMA(0, 0, At, B0); PG8_MMA(0, 1, At, B1); PG8_BAR; PG8_SCHED;
            PG8_LDA(At, 0, 1); PG8_STAGE(PG8_SB(0, 0), b2, voffB); PG8_STAGE(PG8_SB(0, 1), b2 + hstepB, voffB); PG8_STAGE(PG8_SA(0, 0), a2, voffA);
            PG8_WAIT_V(8); PG8_WAIT_L(0); PG8_BAR; PG8_MMA(1, 0, At, B0); PG8_MMA(1, 1, At, B1); PG8_BAR; PG8_SCHED;
            PG8_LDB(B0, 1, 0); PG8_LDB(B1, 1, 1); PG8_SCHED; PG8_LDA(At, 1, 0); PG8_STAGE(PG8_SA(0, 1), a2 + hstepA, voffA);
            PG8_WAIT_V(8); PG8_WAIT_L(0); PG8_BAR; PG8_MMA(0, 0, At, B0); PG8_MMA(0, 1, At, B1); PG8_BAR; PG8_SCHED;
            PG8_LDA(At, 1, 1); PG8_STAGE(PG8_SB(1, 0), b3, voffB); PG8_STAGE(PG8_SB(1, 1), b3 + hstepB, voffB); PG8_STAGE(PG8_SA(1, 0), a3, voffA);
            PG8_WAIT_V(8); PG8_WAIT_L(0); PG8_BAR; PG8_MMA(1, 0, At, B0); PG8_MMA(1, 1, At, B1); PG8_BAR; PG8_SCHED;
        }
        if constexpr (ALIGN_EPI) { if (wr == 0) PG8_BAR; }
        E(acc, cur, wr, wc, fr, fq);
        if (!has_next) break;
#pragma unroll
        for (int a = 0; a < 2; ++a)
#pragma unroll
            for (int b = 0; b < 2; ++b)
#pragma unroll
                for (int m = 0; m < 4; ++m)
#pragma unroll
                    for (int n = 0; n < 2; ++n) acc[a][b][m][n] = (f32x4){0.f, 0.f, 0.f, 0.f};
        cur = nxt; cA = nA; cB = nB; ++ui;
        if constexpr (ALIGN_EPI) { if (wr == 1) PG8_BAR; }
    }
    PG8_WAIT_V(0);
    if constexpr (!ALIGN_EPI) { if (wr == 0) PG8_BAR; }
    PG8_BAR;
#undef PG8_SA
#undef PG8_SB
#undef PG8_STAGE
#undef PG8_LDA
#undef PG8_LDB
#undef PG8_MMA
#undef PG8_WAIT_V
#undef PG8_WAIT_L
#undef PG8_BAR
#undef PG8_SCHED
#undef PG8_APTR
}
}

struct TrDesc { const float* src; bf16_t* dst; const float* ks; int ldsrc, ldd; float scale; };
__device__ __forceinline__ TrDesc tr_desc(const Params& p, int it) {
    constexpr int T0 = 1536, T1 = T0 + 2048, T2 = T1 + 2048, T3 = T2 + 512, T4 = T3 + 512, T5 = T4 + 1024, T6 = T5 + 64, T7 = T6 + 64;
    const int l = it / T7, r = it % T7;
    bf16_t* Wl = p.W_() + (size_t)l * WL;
    TrDesc d; d.scale = 1.f; d.ks = nullptr;
    int k0, c0, r0, kd0; const float* src; bf16_t* dst;
    if (r < T0)      { const int q = r;      src = p.w_in + (size_t)l * D * NIN; d.ldsrc = NIN; k0 = (q & 31) * 64; c0 = (q >> 5) * 64; dst = Wl + W1_OFF; d.ldd = D; r0 = (q >> 5) * 64; kd0 = k0; d.ks = p.norm_g + (size_t)l * D; }
    else if (r < T1) { const int q = r - T0; src = p.w_in + (size_t)l * D * NIN; d.ldsrc = NIN; k0 = (q & 31) * 64; c0 = 3080 + (q >> 5) * 64; dst = Wl + W1_OFF; d.ldd = D; r0 = 3072 + (q >> 5) * 64; kd0 = k0; d.ks = p.norm_g + (size_t)l * D; }
    else if (r < T2) { const int q = r - T1, ct = q >> 5;
                       src = p.w_gate + (size_t)l * D * 4096; d.ldsrc = 4096; k0 = (q & 31) * 64; c0 = (((ct & 3) < 2) ? 0 : 2048) + 128 * (ct >> 2) + (ct & 1) * 64; dst = Wl + W1_OFF; d.ldd = D; r0 = C_GM + ct * 64; kd0 = k0; d.ks = p.norm_g + (size_t)l * D; }
    else if (r < T3) { const int q = r - T2; src = p.w_pm + (size_t)l * WM * D; d.ldsrc = D; k0 = (q & 15) * 64; c0 = (q >> 4) * 64; dst = Wl + W3_OFF; d.ldd = D; r0 = c0; kd0 = k0; }
    else if (r < T4) { const int q = r - T3; src = p.w_pr + (size_t)l * WM * D; d.ldsrc = D; k0 = (q & 15) * 64; c0 = (q >> 4) * 64; dst = Wl + W3_OFF; d.ldd = D; r0 = c0; kd0 = 1024 + k0; }
    else if (r < T5) { const int q = r - T4; src = p.w_o + (size_t)l * D * D; d.ldsrc = D; k0 = (q & 31) * 64; c0 = (q >> 5) * 64; dst = Wl + W4_OFF; d.ldd = D; r0 = c0; kd0 = k0; }
    else if (r < T6) { const int q = r - T5, h = q >> 4, qq = q & 15; src = p.w_qm + ((size_t)l * HM + h) * SZ; d.ldsrc = DH; k0 = (qq & 3) * 64; c0 = (qq >> 2) * 64; dst = Wl + W2_OFF; d.ldd = DH; r0 = h * 512 + c0; kd0 = k0; d.scale = 0.0625f; }
    else             { const int q = r - T6, h = q >> 4, qq = q & 15; src = p.w_km + ((size_t)l * HM + h) * SZ; d.ldsrc = DH; k0 = (qq & 3) * 64; c0 = (qq >> 2) * 64; dst = Wl + W2_OFF; d.ldd = DH; r0 = h * 512 + 256 + c0; kd0 = k0; }
    d.src = src + (size_t)k0 * d.ldsrc + c0; d.dst = dst + (size_t)r0 * d.ldd + kd0; if (d.ks) d.ks += k0;
    return d;
}
__device__ __forceinline__ void tr_load(const TrDesc& d, f32x4 (&v)[16], f32x4 (&ks)[2], int lane) {
#pragma unroll
    for (int i = 0; i < 16; ++i) v[i] = __builtin_nontemporal_load((const f32x4*)(d.src + (size_t)((lane >> 4) + 4 * i) * d.ldsrc + 4 * (lane & 15)));
    if (d.ks) { ks[0] = *(const f32x4*)(d.ks + 8 * (lane & 7)); ks[1] = *(const f32x4*)(d.ks + 8 * (lane & 7) + 4); }
    else { ks[0] = (f32x4){1.f, 1.f, 1.f, 1.f}; ks[1] = ks[0]; }
}
__device__ __forceinline__ void tr_store(const TrDesc& d, const f32x4 (&v)[16], const f32x4 (&ks)[2], LAS float* t, int lane) {
#pragma unroll
    for (int i = 0; i < 16; ++i)
#pragma unroll
        for (int j = 0; j < 4; ++j) t[((lane >> 4) + 4 * i) * 65 + 4 * (lane & 15) + j] = v[i][j];
    const int c = lane & 7;
    const f32x4 s0 = ks[0] * d.scale, s1 = ks[1] * d.scale;
#pragma unroll
    for (int j = 0; j < 8; ++j) { const int n = (lane >> 3) + 8 * j; const LAS float* q = t + (8 * c) * 65 + n;
        u32x4 o; o.x = pk2(s0[0] * q[0], s0[1] * q[65]); o.y = pk2(s0[2] * q[130], s0[3] * q[195]); o.z = pk2(s1[0] * q[260], s1[1] * q[325]); o.w = pk2(s1[2] * q[390], s1[3] * q[455]);
        *(u32x4*)(d.dst + (size_t)n * d.ldd + 8 * c) = o; }
}
template <class Map>
__device__ __forceinline__ void tr_run(const Params& p, int j, const int step, const int nj, LAS unsigned char* lds, Map map) {
    const int tid = opaque_tid();
    const int lane = tid & 63, wid = tid >> 6;
    LAS float* t = (LAS float*)lds + wid * (64 * 65);
    if (j < nj) {
        TrDesc d = tr_desc(p, map(j));
        f32x4 v[16], ks[2];
        tr_load(d, v, ks, lane);
        for (;;) {
            const int j2 = j + step;
            const bool has = j2 < nj;
            TrDesc d2 = d; f32x4 v2[16], ks2[2];
            if (has) { d2 = tr_desc(p, map(j2)); tr_load(d2, v2, ks2, lane); }
            tr_store(d, v, ks, t, lane);
            if (!has) break;
#pragma unroll
            for (int i = 0; i < 16; ++i) v[i] = v2[i];
            ks[0] = ks2[0]; ks[1] = ks2[1]; d = d2; j = j2;
        }
    }
}
constexpr int G1_UNITS = (MPAD / 256) * (N1 / 256), TR_DEF_PER_WAVE = 6;
__device__ __forceinline__ int g1_rem(int nwg) { return G1_UNITS % nwg; }
__device__ __forceinline__ int tr_def(int nwg) { const int r = g1_rem(nwg); const int d = r ? (nwg - r) * 8 * TR_DEF_PER_WAVE : 0; return d < 5632 ? d : 5632; }
__device__ __forceinline__ void prep_phase(const Params& p, int wg, int nwg, LAS unsigned char* lds) {
    const int tid = opaque_tid();
    {
        const int lane = tid & 63, wid = tid >> 6;
        for (int row = wg * 8 + wid; row < MPAD; row += nwg * 8) {
            u32x2* hrow = (u32x2*)(p.Xb_() + (size_t)row * D);
            float ss = 0.f;
            if (row < MT) {
                const f32x4* xr = (const f32x4*)(row < MP ? p.x_prompt + (size_t)row * D : p.x_sample + (size_t)(row - MP) * D);
#pragma unroll
                for (int i = 0; i < 8; ++i) { const f32x4 v = xr[lane + 64 * i]; ss += (v[0] * v[0] + v[1] * v[1]) + (v[2] * v[2] + v[3] * v[3]); hrow[lane + 64 * i] = (u32x2){pk2(v[0], v[1]), pk2(v[2], v[3])}; }
                ss = wave_sum(ss);
            } else {
#pragma unroll
                for (int i = 0; i < 8; ++i) hrow[lane + 64 * i] = (u32x2){0u, 0u};
            }
            if (lane < 5) p.SS_()[(size_t)lane * MPAD + row] = lane == 0 ? ss_fix(ss) : 0ull;
            if (row < MP && lane < 8) p.SSP_()[(size_t)row * 8 + lane] = lane == 0 ? ss : 0.f;
        }
    }
    for (int i = wg * 512 + tid; i < 2049 * 128; i += nwg * 512) {
        const int pi = i >> 7, j = i & 127;
        const float pos = pi < 2048 ? (float)pi : 16384.0f;
        const float inv = powf(10000.0f, -((float)j / 128.0f));
        const float ang = pos * inv;
        p.ROPE_()[2 * i] = (float)cos((double)ang); p.ROPE_()[2 * i + 1] = (float)sin((double)ang);
    }
    for (int i = wg * 512 + tid; i < DEPTH * 256 * D; i += nwg * 512) {
        const int l = i / (256 * D), r = i % (256 * D), j = r / D, k = r % D;
        p.W_()[(size_t)l * WL + W1_OFF + (size_t)(11264 + j) * D + k] = j < 8 ? f2bf(p.w_in[((size_t)l * D + k) * NIN + 3072 + j] * p.norm_g[(size_t)l * D + k]) : (bf16_t)0;
    }
    const int def = tr_def(nwg), rest = 7808 - def;
    tr_run(p, wg * 8 + (tid >> 6), nwg * 8, 7808 + (DEPTH - 1) * rest, lds, [=](int j) { if (j < 7808) return j; const int q = j - 7808, l = q / rest; return (l + 1) * 7808 + def + (q - l * rest); });
}

__device__ __forceinline__ void final_phase(const Params& p, int wg, int nwg) {
    const int tid_ = opaque_tid(), lane = tid_ & 63, wid = tid_ >> 6;
    const f32x4* g4 = (const f32x4*)p.final_g;
    for (int row = wg * 8 + wid; row < MT; row += nwg * 8) {
        const u32x2* xr = (const u32x2*)(p.Xb_() + (size_t)row * D);
        f32x4* yr = (f32x4*)(p.out + (row < MP ? O_YP + (size_t)row * D : O_YS + (size_t)(row - MP) * D));
        const float rstd = rsqrtf(row_ss(p.SSP_(), p.SS_() + (size_t)4 * MPAD, row) * (1.0f / D) + EPS);
#pragma unroll
        for (int i = 0; i < 8; ++i) { const u32x2 xb = xr[lane + 64 * i];
            const f32x4 v = (f32x4){__uint_as_float(xb.x << 16), __uint_as_float(xb.x & 0xffff0000u), __uint_as_float(xb.y << 16), __uint_as_float(xb.y & 0xffff0000u)};
            yr[lane + 64 * i] = v * rstd * g4[lane + 64 * i]; }
    }
}

__device__ __forceinline__ void unpack8(const u32x4 v, float (&f)[8]) {
    f[0] = __uint_as_float(v.x << 16); f[1] = __uint_as_float(v.x & 0xffff0000u); f[2] = __uint_as_float(v.y << 16); f[3] = __uint_as_float(v.y & 0xffff0000u);
    f[4] = __uint_as_float(v.z << 16); f[5] = __uint_as_float(v.z & 0xffff0000u); f[6] = __uint_as_float(v.w << 16); f[7] = __uint_as_float(v.w & 0xffff0000u);
}
__device__ __forceinline__ u32x4 pack8(const float (&f)[8]) { u32x4 w; w.x = pk2(f[0], f[1]); w.y = pk2(f[2], f[3]); w.z = pk2(f[4], f[5]); w.w = pk2(f[6], f[7]); return w; }

__device__ __forceinline__ void gate_all(const Params& p, int layer, int bh, LAS float* G);
__device__ __forceinline__ void conv_phase(const Params& p, int layer, int wg, int nwg, LAS unsigned char* lds) {
    const int tid = opaque_tid();
    for (int bh = wg; bh < 16; bh += nwg) gate_all(p, layer, bh, (LAS float*)lds);
    const float* cw = p.conv_w + (size_t)layer * 4 * WM;
    const float* cb = p.conv_b + (size_t)layer * WM;
    const int cwg = nwg > 32 ? wg - 16 : wg, cnw = nwg > 32 ? nwg - 16 : nwg;
    if (cwg >= 0)
    for (int it = cwg * 512 + tid; it < MT * 128; it += cnw * 512) {
        const int row = it >> 7, ch = (it & 127) * 8;
        float up[4][8];
        if (row < MP) {
            const int t = row & (SEQ - 1);
#pragma unroll
            for (int i = 0; i < 4; ++i) {
                if (t - 3 + i >= 0) unpack8(*(const u32x4*)(p.P_() + (size_t)(row - 3 + i) * NP + C_U + ch), up[i]);
                else {
#pragma unroll
                    for (int j = 0; j < 8; ++j) up[i][j] = 0.f;
                }
            }
            if (t >= SEQ - 3) {
                const int b = row >> 11;
                float* o = p.out + O_CVP + (((size_t)layer * BP + b) * 3 + (t - (SEQ - 3))) * WM + ch;
                *(f32x4*)o = (f32x4){up[3][0], up[3][1], up[3][2], up[3][3]}; *(f32x4*)(o + 4) = (f32x4){up[3][4], up[3][5], up[3][6], up[3][7]};
            }
        } else {
            const int b = row - MP;
            const float* hist = p.st_conv + ((size_t)layer * BS + b) * 3 * WM + ch;
#pragma unroll
            for (int i = 0; i < 3; ++i) { const f32x4 a = *(const f32x4*)(hist + (size_t)i * WM), c = *(const f32x4*)(hist + (size_t)i * WM + 4);
                up[i][0] = a[0]; up[i][1] = a[1]; up[i][2] = a[2]; up[i][3] = a[3]; up[i][4] = c[0]; up[i][5] = c[1]; up[i][6] = c[2]; up[i][7] = c[3]; }
            unpack8(*(const u32x4*)(p.P_() + (size_t)row * NP + C_U + ch), up[3]);
            float* o = p.out + O_CVS + ((size_t)layer * BS + b) * 3 * WM + ch;
#pragma unroll
            for (int i = 0; i < 3; ++i) { *(f32x4*)(o + (size_t)i * WM) = (f32x4){up[i + 1][0], up[i + 1][1], up[i + 1][2], up[i + 1][3]};
                *(f32x4*)(o + (size_t)i * WM + 4) = (f32x4){up[i + 1][4], up[i + 1][5], up[i + 1][6], up[i + 1][7]}; }
        }
        float r[8];
#pragma unroll
        for (int j = 0; j < 8; ++j) r[j] = cb[ch + j];
#pragma unroll
        for (int i = 0; i < 4; ++i)
#pragma unroll
            for (int j = 0; j < 8; ++j) r[j] += up[i][j] * cw[i * WM + ch + j];
#pragma unroll
        for (int j = 0; j < 8; ++j) r[j] = siluf_(r[j]);
        *(u32x4*)(p.CM_() + (size_t)row * WM + ch) = pack8(r);
    }
}

__device__ __forceinline__ void gate_all(const Params& p, int layer, int bh, LAS float* G) {
    const int tid = opaque_tid(), lane = tid & 63, wid = tid >> 6, b = bh >> 2, h = bh & 3;
    const float bi = p.b_i[layer * HM + h], bfv = p.b_f[layer * HM + h];
    float* gt = p.GT_() + (size_t)bh * 6208;
    float tb0[2], tb1[2], tg0[2], tg1[2], rm0[2], rm1[2];
#pragma unroll
    for (int q = 0; q < 2; ++q) {
        const int cc = wid + 8 * q;
        const size_t r0 = (size_t)b * SEQ + cc * 128 + 2 * lane;
        const float i0 = p.IF_()[r0 * 8 + h] + bi, i1 = p.IF_()[(r0 + 1) * 8 + h] + bi;
        const float l0 = logsigf_(p.IF_()[r0 * 8 + 4 + h] + bfv), l1 = logsigf_(p.IF_()[(r0 + 1) * 8 + 4 + h] + bfv);
        float inc = l0 + l1;
#pragma unroll
        for (int o = 1; o < 64; o <<= 1) { const float t = __shfl_up(inc, o); if (lane >= o) inc += t; }
        const float exc = inc - (l0 + l1);
        tb0[q] = exc + l0; tb1[q] = inc;
        tg0[q] = i0 - tb0[q]; tg1[q] = i1 - tb1[q];
        const float gm = wave_max(fmaxf(tg0[q], tg1[q]));
        const float Bc = __shfl(inc, 63);
        if (lane == 0) { G[cc] = Bc; G[16 + cc] = gm; }
        float rm = fmaxf(tg0[q], tg1[q]);
#pragma unroll
        for (int o = 1; o < 64; o <<= 1) { const float t = __shfl_up(rm, o); if (lane >= o) rm = fmaxf(rm, t); }
        float ex = __shfl_up(rm, 1); if (lane == 0) ex = -3.0e38f;
        rm0[q] = fmaxf(ex, tg0[q]); rm1[q] = fmaxf(rm0[q], tg1[q]);
    }
    __syncthreads();
    if (tid == 0) { float m = -1e30f; for (int cc = 0; cc < 16; ++cc) { G[32 + cc] = m; m = G[cc] + fmaxf(m, G[16 + cc]); } G[48] = m; }
    __syncthreads();
#pragma unroll
    for (int q = 0; q < 2; ++q) {
        const int cc = wid + 8 * q, t0 = cc * 128 + 2 * lane;
        const float mc = G[32 + cc];
        *(f32x2_t*)(gt + t0) = (f32x2_t){tb0[q], tb1[q]}; *(f32x2_t*)(gt + 2048 + t0) = (f32x2_t){tg0[q], tg1[q]};
        *(f32x2_t*)(gt + 4096 + t0) = (f32x2_t){fmaxf(rm0[q], mc), fmaxf(rm1[q], mc)};
    }
    if (tid < 16) { gt[6144 + tid] = G[tid]; gt[6160 + tid] = G[16 + tid]; }
    if (tid < 17) gt[6176 + tid] = G[32 + tid];
    __syncthreads();
}
__device__ __forceinline__ void gate_load(const Params& p, int bh, int c, LAS float* G, int tid) {
    const float* gt = p.GT_() + (size_t)bh * 6208;
    if (tid < 128) { G[64 + tid] = gt[c * 128 + tid]; G[192 + tid] = gt[2048 + c * 128 + tid]; G[320 + tid] = gt[4096 + c * 128 + tid]; }
    if (tid == 0) G[32 + c] = gt[6176 + c];
    __syncthreads();
}

template <int I> struct IC { static constexpr int value = I; };
template <int I, int N, class F> __device__ __forceinline__ void sfor(F&& f) { if constexpr (I < N) { f(IC<I>{}); sfor<I + 1, N>(f); } }

template <int CPR>
__device__ __forceinline__ void tile_load(u32x4 (&r)[8], const bf16_t* src, int ld_src, int tid) {
#pragma unroll
    for (int i = 0; i < 8; ++i) { const int id = tid + 512 * i, row = id / CPR, ch = id % CPR; r[i] = *(const u32x4*)(src + (size_t)row * ld_src + ch * 8); }
}
template <int CPR, int LDB>
__device__ __forceinline__ void tile_store(LAS unsigned char* dst, const u32x4 (&r)[8], int tid) {
#pragma unroll
    for (int i = 0; i < 8; ++i) { const int id = tid + 512 * i, row = id / CPR, ch = id % CPR; *(LAS u32x4*)(dst + row * LDB + ch * 16) = r[i]; }
}
__device__ __forceinline__ void tile_store_w(LAS unsigned char* dst, const u32x4 (&r)[8], LAS const float* w, int tid) {
#pragma unroll
    for (int i = 0; i < 8; ++i) { const int id = tid + 512 * i, row = id >> 5, ch = id & 31; float f[8]; unpack8(r[i], f); const float ww = w[row];
#pragma unroll
        for (int j = 0; j < 8; ++j) f[j] *= ww;
        *(LAS u32x4*)(dst + row * 544 + ch * 16) = pack8(f); }
}
template <int OFF, int HS>
__device__ __forceinline__ bf16x8 tr_frag1(unsigned base) {
    u32x2 l0, h0;
    asm volatile("ds_read_b64_tr_b16 %0, %2 offset:%3\n\tds_read_b64_tr_b16 %1, %2 offset:%4\n\ts_waitcnt lgkmcnt(0)"
                 : "=&v"(l0), "=&v"(h0) : "v"(base), "i"(OFF), "i"(OFF + HS) : "memory");
    const u32x4 v = (u32x4){l0.x, l0.y, h0.x, h0.y};
    return __builtin_bit_cast(bf16x8, v);
}
template <int OFF, int HS, int TS>
__device__ __forceinline__ void tr_frag2(unsigned base, bf16x8& f0, bf16x8& f1) {
    u32x2 l0, l1, h0, h1;
    asm volatile("ds_read_b64_tr_b16 %0, %4 offset:%5\n\tds_read_b64_tr_b16 %2, %4 offset:%6\n\t"
                 "ds_read_b64_tr_b16 %1, %4 offset:%7\n\tds_read_b64_tr_b16 %3, %4 offset:%8\n\t"
                 "s_waitcnt lgkmcnt(0)"
                 : "=&v"(l0), "=&v"(l1), "=&v"(h0), "=&v"(h1)
                 : "v"(base), "i"(OFF), "i"(OFF + HS), "i"(OFF + TS), "i"(OFF + TS + HS)
                 : "memory");
    f0 = __builtin_bit_cast(bf16x8, (u32x4){l0.x, l0.y, h0.x, h0.y}); f1 = __builtin_bit_cast(bf16x8, (u32x4){l1.x, l1.y, h1.x, h1.y});
}
template <int OFF, int HS, int TS>
__device__ __forceinline__ void tr_frag4(unsigned base, bf16x8 (&f)[4]) {
    u32x2 l0, l1, l2, l3, h0, h1, h2, h3;
    asm volatile("ds_read_b64_tr_b16 %0, %8 offset:%9\n\tds_read_b64_tr_b16 %4, %8 offset:%10\n\t"
                 "ds_read_b64_tr_b16 %1, %8 offset:%11\n\tds_read_b64_tr_b16 %5, %8 offset:%12\n\t"
                 "ds_read_b64_tr_b16 %2, %8 offset:%13\n\tds_read_b64_tr_b16 %6, %8 offset:%14\n\t"
                 "ds_read_b64_tr_b16 %3, %8 offset:%15\n\tds_read_b64_tr_b16 %7, %8 offset:%16\n\t"
                 "s_waitcnt lgkmcnt(0)"
                 : "=&v"(l0), "=&v"(l1), "=&v"(l2), "=&v"(l3), "=&v"(h0), "=&v"(h1), "=&v"(h2), "=&v"(h3)
                 : "v"(base), "i"(OFF), "i"(OFF + HS), "i"(OFF + TS), "i"(OFF + TS + HS), "i"(OFF + 2 * TS), "i"(OFF + 2 * TS + HS), "i"(OFF + 3 * TS), "i"(OFF + 3 * TS + HS)
                 : "memory");
    f[0] = __builtin_bit_cast(bf16x8, (u32x4){l0.x, l0.y, h0.x, h0.y}); f[1] = __builtin_bit_cast(bf16x8, (u32x4){l1.x, l1.y, h1.x, h1.y});
    f[2] = __builtin_bit_cast(bf16x8, (u32x4){l2.x, l2.y, h2.x, h2.y}); f[3] = __builtin_bit_cast(bf16x8, (u32x4){l3.x, l3.y, h3.x, h3.y});
}
__device__ __forceinline__ unsigned lds_addr(LAS const void* p) { return (unsigned)(size_t)p; }

template <int NR, int NC, bool WEIGHT>
__device__ __forceinline__ void stage_T(LAS unsigned char* dst, int ldd_bytes, const bf16_t* src, int ld_src, LAS const float* w) {
    const int tid_ = opaque_tid(), lane = tid_ & 63, wid = tid_ >> 6;
    constexpr int PB = NR / 128, CG = NC / 8;
#pragma unroll 1
    for (int task = wid; task < PB * CG; task += 8) {
        const int pb = task % PB, cg = task / PB, r = pb * 128 + 2 * lane;
        float a[8], c[8];
        unpack8(*(const u32x4*)(src + (size_t)r * ld_src + cg * 8), a); unpack8(*(const u32x4*)(src + (size_t)(r + 1) * ld_src + cg * 8), c);
        float w0 = 1.f, w1 = 1.f; if (WEIGHT) { w0 = w[r]; w1 = w[r + 1]; }
#pragma unroll
        for (int j = 0; j < 8; ++j) *(LAS unsigned*)(dst + (cg * 8 + j) * ldd_bytes + r * 2) = pk2(a[j] * w0, c[j] * w1);
    }
}
__device__ __forceinline__ void stage_rows(LAS unsigned char* dst, const bf16_t* src, int ld_src) {
    const int tid_ = opaque_tid();
#pragma unroll
    for (int i = 0; i < 8; ++i) { const int id = tid_ + 512 * i, row = id >> 5, ch = id & 31;
        *(LAS u32x4*)(dst + row * 528 + ch * 16) = *(const u32x4*)(src + (size_t)row * ld_src + ch * 8); }
}
__device__ __forceinline__ bf16x8 lds_frag(LAS const unsigned char* base, int row, int ld_bytes, int kbyte) { return *(LAS const bf16x8*)(base + row * ld_bytes + kbyte); }
__device__ __forceinline__ float ret_lg(int h) { return logf(1.0f - exp2f(-5.0f - (float)h)); }

template <int BR>
__device__ __forceinline__ void chunk_passA(const Params& p, int layer, int b, int h, int c, LAS unsigned char* lds) {
    LAS unsigned char* Xt = lds; LAS unsigned char* Yt = lds + 69632; LAS float* G = (LAS float*)(lds + 139264); LAS float* wk = G + 512;
    const int tid = opaque_tid(), lane = tid & 63, w = __builtin_amdgcn_readfirstlane(tid >> 6), g = lane >> 4, lr = lane & 15;
    const size_t row0 = (size_t)b * SEQ + c * 128;
    const int pi = BR * 16 + b * 4 + h;
    const bf16_t* Xp = BR == 0 ? p.QK_() + row0 * 2048 + h * 512 + 256 : p.P_() + row0 * NP + C_VR + h * 256;
    const bf16_t* Yp = BR == 0 ? p.P_() + row0 * NP + C_VM + h * 256 : p.P_() + row0 * NP + C_KR + h * 256;
    u32x4 xr[8], yr[8];
    tile_load<32>(xr, Xp, BR == 0 ? 2048 : NP, tid); tile_load<32>(yr, Yp, NP, tid);
    if (BR == 0) { gate_load(p, b * 4 + h, c, G, tid); if (tid < 128) wk[tid] = expf(G[192 + tid] - G[320 + 127]); }
    else { if (tid < 128) wk[tid] = expf((float)(127 - tid) * ret_lg(h)); }
    __syncthreads();
    tile_store<32, 544>(Xt, xr, tid); tile_store_w(Yt, yr, wk, tid);
    __syncthreads();
    const unsigned lpart = (unsigned)(((8 * g + (lr >> 2)) * 272 + 4 * (lr & 3)) * 2);
    const unsigned baseX = lds_addr(Xt) + lpart + (unsigned)(32 * w * 2), baseY = lds_addr(Yt) + lpart;
    bf16_t* Uo = p.U_() + ((size_t)pi * 16 + c) * SZ;
    sfor<0, 2>([&](auto rt_) {
        constexpr int rt = decltype(rt_)::value;
        f32x4 acc[16];
#pragma unroll
        for (int j = 0; j < 16; ++j) acc[j] = (f32x4){0.f, 0.f, 0.f, 0.f};
        sfor<0, 4>([&](auto ks_) {
            constexpr int ks = decltype(ks_)::value;
            const bf16x8 fa = tr_frag1<ks * 32 * 544 + rt * 32, 4 * 544>(baseX);
            sfor<0, 4>([&](auto cq_) {
                constexpr int cq = decltype(cq_)::value;
                bf16x8 fb[4];
                tr_frag4<ks * 32 * 544 + cq * 128, 4 * 544, 32>(baseY, fb);
#pragma unroll
                for (int i = 0; i < 4; ++i) acc[4 * cq + i] = __builtin_amdgcn_mfma_f32_16x16x32_bf16(fa, fb[i], acc[4 * cq + i], 0, 0, 0);
            });
        });
#pragma unroll
        for (int ct = 0; ct < 16; ++ct)
            *(u32x2*)(Uo + (size_t)(16 * ct + lr) * 256 + 32 * w + 16 * rt + 4 * g) = (u32x2){pk2(acc[ct][0], acc[ct][1]), pk2(acc[ct][2], acc[ct][3])};
    });
    if (BR == 0 && tid < 256) {
        float sacc = 0.f;
        for (int ss = 0; ss < 128; ++ss) sacc += wk[ss] * bf2f(*(LAS const bf16_t*)(Xt + ss * 544 + tid * 2));
        p.NU_()[((size_t)(b * 4 + h) * 16 + c) * 256 + tid] = sacc;
    }
    __syncthreads();
}

template <int BR>
__device__ __forceinline__ void chunk_state_item(const Params& p, int layer, int b, int h, int sl, LAS unsigned char* lds) {
    LAS unsigned char* Xt = lds;
    LAS unsigned char* Ys = lds + 69632;
    LAS float* wka = (LAS float*)(lds + 79872);
    LAS float* dec = wka + 2048;
    const int tid = opaque_tid(), lane = tid & 63, w = __builtin_amdgcn_readfirstlane(tid >> 6), g = lane >> 4, lr = lane & 15;
    const int bh = b * 4 + h, pi = BR * 16 + bh;
    const float* gt = p.GT_() + (size_t)bh * 6208;
    if (BR == 0) {
#pragma unroll
        for (int i = 0; i < 4; ++i) { const int t = tid + 512 * i; wka[t] = expf(gt[2048 + t] - gt[4096 + (t | 127)]); }
        if (tid < 16) { const float mc = gt[6176 + tid]; dec[tid] = expf(mc - fmaxf(mc, gt[6160 + tid])); }
    } else {
        const float lg = ret_lg(h);
#pragma unroll
        for (int i = 0; i < 4; ++i) { const int t = tid + 512 * i; wka[t] = expf((float)(127 - (t & 127)) * lg); }
        if (tid < 16) dec[tid] = expf(128.0f * lg);
    }
    const size_t rowb = (size_t)b * SEQ;
    const bf16_t* Xp = BR == 0 ? p.QK_() + rowb * 2048 + h * 512 + 256 : p.P_() + rowb * NP + C_VR + h * 256;
    const int ldX = BR == 0 ? 2048 : NP;
    const bf16_t* Yp = (BR == 0 ? p.P_() + rowb * NP + C_VM + h * 256 : p.P_() + rowb * NP + C_KR + h * 256) + 32 * sl;
    const unsigned yoff = (unsigned)((tid >> 2) * NP + (tid & 3) * 8) * 2u;
    u32x4 xa[8], xb[8], ya, yb;
    tile_load<32>(xa, Xp, ldX, tid); ya = *(const u32x4*)((const char*)Yp + yoff);
    tile_load<32>(xb, Xp + (size_t)128 * ldX, ldX, tid); yb = *(const u32x4*)((const char*)(Yp + (size_t)128 * NP) + yoff);
    f32x4 st[2][2], nst[2];
#pragma unroll
    for (int i = 0; i < 2; ++i) { nst[i] = (f32x4){0.f, 0.f, 0.f, 0.f};
#pragma unroll
        for (int j = 0; j < 2; ++j) st[i][j] = (f32x4){0.f, 0.f, 0.f, 0.f}; }
    const unsigned lpart = (unsigned)(((8 * g + (lr >> 2)) * 272 + 4 * (lr & 3)) * 2), lparty = (unsigned)(((8 * g + (lr >> 2)) * 40 + 4 * (lr & 3)) * 2);
    const unsigned baseX = lds_addr(Xt) + lpart + (unsigned)(32 * w * 2), baseY = lds_addr(Ys) + lparty;
    bf16_t* CSp = p.CS_() + (size_t)pi * 16 * SZ + (size_t)(32 * sl + lr) * 256 + 32 * w + 4 * g;
    float* NSp = p.NS_() + (size_t)bh * 16 * 256 + 32 * w + 4 * g;
    const bool nown = (BR == 0) && (sl == 0) && (lr == 0);
    __syncthreads();
    auto step = [&](int c, u32x4 (&xr)[8], u32x4& yr) {
#pragma unroll
        for (int rt = 0; rt < 2; ++rt) {
#pragma unroll
            for (int ct = 0; ct < 2; ++ct) *(u32x2*)(CSp + (size_t)c * SZ + (size_t)(16 * ct) * 256 + 16 * rt) = (u32x2){pk2(st[rt][ct][0], st[rt][ct][1]), pk2(st[rt][ct][2], st[rt][ct][3])};
            if (nown) *(f32x4*)(NSp + (size_t)c * 256 + 16 * rt) = nst[rt];
        }
        tile_store<32, 544>(Xt, xr, tid);
        { float f[8]; unpack8(yr, f); const float ww = wka[c * 128 + (tid >> 2)];
#pragma unroll
          for (int j = 0; j < 8; ++j) f[j] *= ww;
          *(LAS u32x4*)(Ys + (tid >> 2) * 80 + (tid & 3) * 16) = pack8(f); }
        __syncthreads();
        if (c + 2 < 16) {
            tile_load<32>(xr, Xp + (size_t)(c + 2) * 128 * ldX, ldX, tid);
            yr = *(const u32x4*)((const char*)(Yp + (size_t)(c + 2) * 128 * NP) + yoff);
        }
        f32x4 u[2][2], un[2];
#pragma unroll
        for (int i = 0; i < 2; ++i) { un[i] = (f32x4){0.f, 0.f, 0.f, 0.f};
#pragma unroll
            for (int j = 0; j < 2; ++j) u[i][j] = (f32x4){0.f, 0.f, 0.f, 0.f}; }
        sfor<0, 4>([&](auto ks_) {
            constexpr int ks = decltype(ks_)::value;
            bf16x8 fa0, fa1, fb0, fb1;
            tr_frag2<ks * 32 * 544, 4 * 544, 32>(baseX, fa0, fa1);
            tr_frag2<ks * 32 * 80, 4 * 80, 32>(baseY, fb0, fb1);
            u[0][0] = __builtin_amdgcn_mfma_f32_16x16x32_bf16(fa0, fb0, u[0][0], 0, 0, 0); u[0][1] = __builtin_amdgcn_mfma_f32_16x16x32_bf16(fa0, fb1, u[0][1], 0, 0, 0);
            u[1][0] = __builtin_amdgcn_mfma_f32_16x16x32_bf16(fa1, fb0, u[1][0], 0, 0, 0); u[1][1] = __builtin_amdgcn_mfma_f32_16x16x32_bf16(fa1, fb1, u[1][1], 0, 0, 0);
            if (BR == 0) {
                const f32x4 w0 = *(LAS const f32x4*)(wka + c * 128 + 32 * ks + 8 * g), w1 = *(LAS const f32x4*)(wka + c * 128 + 32 * ks + 8 * g + 4);
                u32x4 wv = (u32x4){pk2(w0[0], w0[1]), pk2(w0[2], w0[3]), pk2(w1[0], w1[1]), pk2(w1[2], w1[3])};
                if (lr != 0) wv = (u32x4){0u, 0u, 0u, 0u};
                const bf16x8 wf = __builtin_bit_cast(bf16x8, wv);
                un[0] = __builtin_amdgcn_mfma_f32_16x16x32_bf16(fa0, wf, un[0], 0, 0, 0); un[1] = __builtin_amdgcn_mfma_f32_16x16x32_bf16(fa1, wf, un[1], 0, 0, 0);
            }
        });
        const float dc = dec[c];
#pragma unroll
        for (int i = 0; i < 2; ++i) { nst[i] = nst[i] * dc + un[i];
#pragma unroll
            for (int j = 0; j < 2; ++j) st[i][j] = st[i][j] * dc + u[i][j]; }
        __syncthreads();
    };
#pragma unroll 1
    for (int c = 0; c < 16; c += 2) { step(c, xa, ya); step(c + 1, xb, yb); }
    float* fo = p.out + (BR == 0 ? O_CP : O_SP) + (((size_t)layer * BP + b) * HM + h) * SZ + (size_t)(32 * sl + lr) * 256 + 32 * w + 4 * g;
#pragma unroll
    for (int rt = 0; rt < 2; ++rt) {
#pragma unroll
        for (int ct = 0; ct < 2; ++ct) *(f32x4*)(fo + (size_t)(16 * ct) * 256 + 16 * rt) = st[rt][ct];
        if (nown) *(f32x4*)(p.out + O_NP + (((size_t)layer * BP + b) * HM + h) * 256 + 32 * w + 4 * g + 16 * rt) = nst[rt];
    }
    if (BR == 0 && sl == 0 && tid == 0) p.out[O_MP + ((size_t)layer * BP + b) * HM + h] = gt[6192];
    __syncthreads();
}

__device__ __forceinline__ void scan_item(const Params& p, int layer, int pi, int slice, LAS unsigned char* lds) {
    LAS float* G = (LAS float*)lds; LAS float* dec = G + 512;
    const int tid = opaque_tid(), br = pi >> 4, bh = pi & 15, b = bh >> 2, h = bh & 3;
    if (br == 0) { const float* gt = p.GT_() + (size_t)bh * 6208; if (tid < 16) { const float mc = gt[6176 + tid]; dec[tid] = expf(mc - fmaxf(mc, gt[6160 + tid])); } if (tid == 0) G[48] = gt[6192]; }
    else if (tid < 16) dec[tid] = expf(128.0f * ret_lg(h));
    __syncthreads();
    float st[2][8];
#pragma unroll
    for (int j = 0; j < 2; ++j)
#pragma unroll
        for (int k = 0; k < 8; ++k) st[j][k] = 0.f;
    for (int c = 0; c < 16; ++c) {
        const float dc = dec[c];
#pragma unroll
        for (int j = 0; j < 2; ++j) { const size_t idx = (size_t)slice * 8192 + j * 4096 + tid * 8;
            float u[8]; unpack8(*(const u32x4*)(p.U_() + ((size_t)pi * 16 + c) * SZ + idx), u);
            *(u32x4*)(p.CS_() + ((size_t)pi * 16 + c) * SZ + idx) = pack8(st[j]);
#pragma unroll
            for (int k = 0; k < 8; ++k) st[j][k] = st[j][k] * dc + u[k]; }
    }
    float* fo = p.out + (br == 0 ? O_CP : O_SP) + (((size_t)layer * BP + b) * HM + h) * SZ;
#pragma unroll
    for (int j = 0; j < 2; ++j) { float* q = fo + (size_t)slice * 8192 + j * 4096 + tid * 8;
        *(f32x4*)q = (f32x4){st[j][0], st[j][1], st[j][2], st[j][3]}; *(f32x4*)(q + 4) = (f32x4){st[j][4], st[j][5], st[j][6], st[j][7]}; }
    if (br == 0 && slice == 0) {
        if (tid < 256) { float n = 0.f;
            for (int c = 0; c < 16; ++c) { p.NS_()[((size_t)bh * 16 + c) * 256 + tid] = n; n = dec[c] * n + p.NU_()[((size_t)bh * 16 + c) * 256 + tid]; }
            p.out[O_NP + (((size_t)layer * BP + b) * HM + h) * 256 + tid] = n; }
        if (tid == 0) p.out[O_MP + ((size_t)layer * BP + b) * HM + h] = G[48];
    }
    __syncthreads();
}

template <int BR>
__device__ __forceinline__ void chunk_passC(const Params& p, int layer, int b, int h, int c, LAS unsigned char* lds) {
    LAS unsigned char* BufB = lds; LAS unsigned char* Sw = lds + 69632; LAS float* G = (LAS float*)(lds + 104448);
    LAS float* av = G + 512; LAS float* fl = G + 640; LAS bf16_t* nbf = (LAS bf16_t*)(G + 768);
    const int tid = opaque_tid(), lane = tid & 63, w = __builtin_amdgcn_readfirstlane(tid >> 6), g = lane >> 4, lr = lane & 15;
    const size_t row0 = (size_t)b * SEQ + c * 128;
    const int pi = BR * 16 + b * 4 + h, l = 16 * w + lr;
    const float lg = ret_lg(h);
    u32x4 tr[8];
    tile_load<32>(tr, BR == 0 ? p.QK_() + row0 * 2048 + h * 512 + 256 : p.P_() + row0 * NP + C_KR + h * 256, BR == 0 ? 2048 : NP, tid);
    if (BR == 0) {
        gate_load(p, b * 4 + h, c, G, tid);
        if (tid < 128) { av[tid] = expf(G[32 + c] - G[320 + tid]); fl[tid] = expf(-(G[64 + tid] + G[320 + tid])); }
        if (tid < 256) nbf[tid] = f2bf(p.NS_()[((size_t)(b * 4 + h) * 16 + c) * 256 + tid]);
    } else { if (tid < 128) av[tid] = expf((float)(tid + 1) * lg); }
    const bf16_t* Qp = BR == 0 ? p.QK_() + (row0 + l) * 2048 + h * 512 : p.P_() + (row0 + l) * NP + C_QR + h * 256;
    bf16x8 qf[8];
#pragma unroll
    for (int ks = 0; ks < 8; ++ks) qf[ks] = *(const bf16x8*)(Qp + 32 * ks + 8 * g);
    tile_store<32, 544>(BufB, tr, tid);
    __syncthreads();
    const bf16_t* CSp = p.CS_() + ((size_t)pi * 16 + c) * SZ;
    if (BR == 0) tile_load<32>(tr, CSp, 256, tid); else tile_load<16>(tr, CSp, 256, tid);
    float rs = 0.f;
    const float Gl = BR == 0 ? G[320 + l] : 0.f;
#pragma unroll
    for (int j = 0; j < 8; ++j) {
        f32x4 a = (f32x4){0.f, 0.f, 0.f, 0.f};
        if (j <= w) {
#pragma unroll
            for (int ks = 0; ks < 8; ++ks) a = __builtin_amdgcn_mfma_f32_16x16x32_bf16(lds_frag(BufB, 16 * j + lr, 544, (32 * ks + 8 * g) * 2), qf[ks], a, 0, 0, 0);
        }
        float v[4];
#pragma unroll
        for (int r = 0; r < 4; ++r) {
            const int sidx = 16 * j + 4 * g + r;
            float d = 0.f;
            if (sidx <= l) d = BR == 0 ? expf(G[192 + sidx] - Gl) : expf((float)(l - sidx) * lg);
            v[r] = a[r] * d; rs += v[r];
        }
        *(LAS u32x2*)(Sw + l * 272 + (16 * j + 4 * g) * 2) = (u32x2){pk2(v[0], v[1]), pk2(v[2], v[3])};
        __builtin_amdgcn_sched_barrier(0);
    }
    rs += __shfl_xor(rs, 16); rs += __shfl_xor(rs, 32);
    __syncthreads();
    f32x4 accN[16];
#pragma unroll
    for (int t = 0; t < 16; ++t) accN[t] = (f32x4){0.f, 0.f, 0.f, 0.f};
    const unsigned lq = (unsigned)(8 * g + (lr >> 2)), lp4 = (unsigned)(4 * (lr & 3));
    sfor<0, 2>([&](auto half_) {
        constexpr int half = decltype(half_)::value;
        if (BR == 0) tile_store<32, 544>(BufB, tr, tid); else tile_store<16, 272>(BufB, tr, tid);
        __syncthreads();
        if (half == 0) { if (BR == 0) tile_load<32>(tr, CSp + 128 * 256, 256, tid); else tile_load<16>(tr, CSp + 128, 256, tid); }
        else tile_load<32>(tr, p.P_() + row0 * NP + (BR == 0 ? C_VM : C_VR) + h * 256, NP, tid);
        if (BR == 0) {
#pragma unroll
            for (int t = 0; t < 8; ++t) {
#pragma unroll
                for (int ks = 0; ks < 8; ++ks)
                    accN[half * 8 + t] = __builtin_amdgcn_mfma_f32_16x16x32_bf16(lds_frag(BufB, 16 * t + lr, 544, (32 * ks + 8 * g) * 2), qf[ks], accN[half * 8 + t], 0, 0, 0);
                __builtin_amdgcn_sched_barrier(0); }
        } else {
            const unsigned base = lds_addr(BufB) + (lq * 136 + lp4) * 2;
            sfor<0, 8>([&](auto ks_) {
                constexpr int ks = decltype(ks_)::value;
                sfor<0, 2>([&](auto tq_) {
                    constexpr int tq = decltype(tq_)::value;
                    bf16x8 f[4];
                    tr_frag4<ks * 32 * 272 + tq * 128, 4 * 272, 32>(base, f);
#pragma unroll
                    for (int i = 0; i < 4; ++i) accN[half * 8 + 4 * tq + i] = __builtin_amdgcn_mfma_f32_16x16x32_bf16(f[i], qf[ks], accN[half * 8 + 4 * tq + i], 0, 0, 0);
                });
            });
        }
        __syncthreads();
    });
    float nq = 0.f;
    if (BR == 0) {
        f32x4 ad = (f32x4){0.f, 0.f, 0.f, 0.f};
#pragma unroll
        for (int ks = 0; ks < 8; ++ks) {
            bf16x8 nf = *(LAS const bf16x8*)(nbf + 32 * ks + 8 * g);
            if (lr != 0) nf = (bf16x8){0, 0, 0, 0, 0, 0, 0, 0};
            ad = __builtin_amdgcn_mfma_f32_16x16x32_bf16(nf, qf[ks], ad, 0, 0, 0);
        }
        nq = __shfl(ad[0], lr);
    }
    const float al = av[l];
#pragma unroll
    for (int t = 0; t < 16; ++t) accN[t] *= al;
    tile_store<32, 544>(BufB, tr, tid);
    __syncthreads();
    {
        const unsigned base = lds_addr(BufB) + (lq * 272 + lp4) * 2;
        sfor<0, 4>([&](auto ks_) {
            constexpr int ks = decltype(ks_)::value;
            const bf16x8 bfr = lds_frag(Sw, l, 272, (32 * ks + 8 * g) * 2);
            sfor<0, 4>([&](auto tq_) {
                constexpr int tq = decltype(tq_)::value;
                bf16x8 f[4];
                tr_frag4<ks * 32 * 544 + tq * 128, 4 * 544, 32>(base, f);
#pragma unroll
                for (int i = 0; i < 4; ++i) accN[4 * tq + i] = __builtin_amdgcn_mfma_f32_16x16x32_bf16(f[i], bfr, accN[4 * tq + i], 0, 0, 0);
            });
        });
    }
    float inv = 1.0f;
    if (BR == 0) inv = 1.0f / fmaxf(fabsf(rs + al * nq), fl[l]);
    float sm = 0.f;
#pragma unroll
    for (int t = 0; t < 16; ++t) { accN[t] *= inv; sm += (accN[t][0] + accN[t][1]) + (accN[t][2] + accN[t][3]); }
    sm += __shfl_xor(sm, 16); sm += __shfl_xor(sm, 32);
    const float mu = sm * (1.0f / 256.0f);
    float qv = 0.f;
#pragma unroll
    for (int t = 0; t < 16; ++t) { const f32x4 d = accN[t] - mu; qv += (d[0] * d[0] + d[1] * d[1]) + (d[2] * d[2] + d[3] * d[3]); }
    qv += __shfl_xor(qv, 16); qv += __shfl_xor(qv, 32);
    const float rstd = rsqrtf(qv * (1.0f / 256.0f) + EPS);
    const float* gain = (BR == 0 ? p.hn_m_g : p.hn_r_g) + (size_t)layer * WM + h * 256 + 4 * g;
    const float* skip = p.skip_m + (size_t)layer * WM + h * 256 + 4 * g;
    const size_t row = row0 + l;
    const bf16_t* zp = p.P_() + row * NP + (BR == 0 ? C_ZM : C_ZR) + h * 256 + 4 * g;
    const bf16_t* cp = p.CM_() + row * WM + h * 256 + 4 * g;
    bf16_t* op = p.OC_() + row * 2048 + BR * 1024 + h * 256 + 4 * g;
#pragma unroll
    for (int t = 0; t < 16; ++t) {
        const f32x4 ge = *(const f32x4*)(gain + 16 * t);
        const u32x2 zb = *(const u32x2*)(zp + 16 * t);
        f32x4 v = (accN[t] - mu) * rstd * ge;
        if (BR == 0) { const f32x4 sk = *(const f32x4*)(skip + 16 * t); const u32x2 cb = *(const u32x2*)(cp + 16 * t);
            v[0] += sk[0] * __uint_as_float(cb.x << 16); v[1] += sk[1] * __uint_as_float(cb.x & 0xffff0000u);
            v[2] += sk[2] * __uint_as_float(cb.y << 16); v[3] += sk[3] * __uint_as_float(cb.y & 0xffff0000u); }
        const float z0 = __uint_as_float(zb.x << 16), z1 = __uint_as_float(zb.x & 0xffff0000u), z2 = __uint_as_float(zb.y << 16), z3 = __uint_as_float(zb.y & 0xffff0000u);
        *(u32x2*)(op + 16 * t) = (u32x2){pk2(v[0] * siluf_(z0), v[1] * siluf_(z1)), pk2(v[2] * siluf_(z2), v[3] * siluf_(z3))};
    }
    __syncthreads();
}

__device__ __forceinline__ f32x4 bf4_to_f32(u32x2 v) { return (f32x4){__uint_as_float(v.x << 16), __uint_as_float(v.x & 0xffff0000u), __uint_as_float(v.y << 16), __uint_as_float(v.y & 0xffff0000u)}; }
__device__ __forceinline__ const char* sample_state(const Params& p, int layer, int s) {
    const int br = s >> 9, b = (s >> 2) & 127, h = s & 3;
    return (const char*)((br == 0 ? p.st_C : p.st_S) + (((size_t)layer * BS + b) * HM + h) * SZ);
}
template <int BR>
__device__ __forceinline__ void sample_item(const Params& p, int layer, int b, int h, LAS float* base, const f32x4 (&cin)[8], f32x4 (&cnx)[8], const char* nsrc) {
    LAS float* sq = base; LAS float* sk = sq + 256; LAS float* sv = sk + 256; LAS float* sr = sv + 256; LAS float* part = sr + 256;
    const int tid = opaque_tid(), lane = tid & 63, wid = __builtin_amdgcn_readfirstlane(tid >> 6), e0 = 4 * lane;
    const size_t R = (size_t)MP + b;
    const size_t sidx = ((size_t)layer * BS + b) * HM + h;
    const bf16_t* qg = BR == 0 ? p.QK_() + R * 2048 + h * 512 : p.P_() + R * NP + C_QR + h * 256;
    const bf16_t* kg = BR == 0 ? p.QK_() + R * 2048 + h * 512 + 256 : p.P_() + R * NP + C_KR + h * 256;
    const bf16_t* vg = p.P_() + R * NP + (BR == 0 ? C_VM : C_VR) + h * 256;
    if (tid < 256) { sq[tid] = bf2f(qg[tid]); sk[tid] = bf2f(kg[tid]); sv[tid] = bf2f(vg[tid]); }
    const f32x4 q4 = bf4_to_f32(*(const u32x2*)(qg + e0)), k4 = bf4_to_f32(*(const u32x2*)(kg + e0)), v4 = bf4_to_f32(*(const u32x2*)(vg + e0));
    float wgt = 1.f, a = 1.0f - exp2f(-5.0f - (float)h), mt = 0.f;
    if (BR == 0) {
        const float ig = p.IF_()[R * 8 + h] + p.b_i[layer * HM + h];
        const float lf = logsigf_(p.IF_()[R * 8 + 4 + h] + p.b_f[layer * HM + h]);
        const float inter = lf + p.st_m[sidx];
        mt = fmaxf(inter, ig); wgt = expf(ig - mt); a = expf(inter - mt);
    }
    const char* sb = sample_state(p, layer, (BR << 9) | (b << 2) | h) + (size_t)wid * 1024 + (unsigned)lane * 16u;
    char* ob = (char*)(p.out + (BR == 0 ? O_CS : O_SS) + sidx * SZ) + (size_t)wid * 1024 + (unsigned)lane * 16u;
    __syncthreads();
    f32x4 cc[8], cn[8];
#pragma unroll
    for (int j = 0; j < 8; ++j) cc[j] = cin[j];
    f32x4 ac = (f32x4){0.f, 0.f, 0.f, 0.f};
#pragma unroll
    for (int i0 = 0; i0 < 32; i0 += 8) {
        if (i0 + 8 < 32) {
#pragma unroll
            for (int j = 0; j < 8; ++j) cn[j] = __builtin_nontemporal_load((const f32x4*)(sb + (size_t)(i0 + 8 + j) * 8192));
        } else if (nsrc) {
            const char* nb = nsrc + (size_t)wid * 1024 + (unsigned)lane * 16u;
#pragma unroll
            for (int j = 0; j < 8; ++j) cnx[j] = __builtin_nontemporal_load((const f32x4*)(nb + (size_t)j * 8192));
        }
#pragma unroll
        for (int j = 0; j < 8; ++j) { const int e = wid + 8 * (i0 + j);
            if (BR == 0) {
                float pt = (cc[j][0] * q4[0] + cc[j][1] * q4[1]) + (cc[j][2] * q4[2] + cc[j][3] * q4[3]);
                __builtin_nontemporal_store(cc[j] * a + k4 * (wgt * sv[e]), (f32x4*)(ob + (size_t)(i0 + j) * 8192));
                pt = wave_sum(pt);
                if (lane == 0) sr[e] = pt;
            } else {
                ac = ac + cc[j] * sq[e];
                __builtin_nontemporal_store(cc[j] * a + v4 * sk[e], (f32x4*)(ob + (size_t)(i0 + j) * 8192));
            }
        }
        if (i0 + 8 < 32) {
#pragma unroll
            for (int j = 0; j < 8; ++j) cc[j] = cn[j];
        }
    }
    if (BR == 1) *(LAS f32x4*)(part + wid * 256 + e0) = ac;
    __syncthreads();
    if (wid == 0) {
        f32x4 hv;
        if (BR == 0) {
            const f32x4 n4 = *(const f32x4*)(p.st_n + sidx * 256 + e0);
            const f32x4 cq = *(LAS const f32x4*)(sr + e0);
            const float qk = wave_sum((q4[0] * k4[0] + q4[1] * k4[1]) + (q4[2] * k4[2] + q4[3] * k4[3]));
            const float nq = wave_sum((n4[0] * q4[0] + n4[1] * q4[1]) + (n4[2] * q4[2] + n4[3] * q4[3]));
            const float ws = wgt * qk, inv = 1.0f / fmaxf(fabsf(ws + a * nq), expf(-mt));
            hv = (v4 * ws + cq * a) * inv;
            *(f32x4*)(p.out + O_NS + sidx * 256 + e0) = n4 * a + k4 * wgt;
            if (lane == 0) p.out[O_MS + sidx] = mt;
        } else {
            f32x4 oi = (f32x4){0.f, 0.f, 0.f, 0.f};
#pragma unroll
            for (int i = 0; i < 8; ++i) oi = oi + *(LAS const f32x4*)(part + i * 256 + e0);
            const float qk = wave_sum((q4[0] * k4[0] + q4[1] * k4[1]) + (q4[2] * k4[2] + q4[3] * k4[3]));
            hv = v4 * qk + oi * a;
        }
        const float mean = wave_sum((hv[0] + hv[1]) + (hv[2] + hv[3])) * (1.0f / 256.0f);
        const f32x4 dv = hv - mean;
        const float rstd = rsqrtf(wave_sum((dv[0] * dv[0] + dv[1] * dv[1]) + (dv[2] * dv[2] + dv[3] * dv[3])) * (1.0f / 256.0f) + EPS);
        const f32x4 ge = *(const f32x4*)((BR == 0 ? p.hn_m_g : p.hn_r_g) + (size_t)layer * WM + h * 256 + e0);
        f32x4 v = dv * rstd * ge;
        const f32x4 z = bf4_to_f32(*(const u32x2*)(p.P_() + R * NP + (BR == 0 ? C_ZM : C_ZR) + h * 256 + e0));
        if (BR == 0) v = v + *(const f32x4*)(p.skip_m + (size_t)layer * WM + h * 256 + e0) * bf4_to_f32(*(const u32x2*)(p.CM_() + R * WM + h * 256 + e0));
        *(u32x2*)(p.OC_() + R * 2048 + BR * 1024 + h * 256 + e0) = (u32x2){pk2(v[0] * siluf_(z[0]), v[1] * siluf_(z[1])), pk2(v[2] * siluf_(z[2]), v[3] * siluf_(z[3]))};
    }
    __syncthreads();
}

template <int MODE>
__device__ __forceinline__ void sample_gemm(const Params& p, const bf16_t* Wl, int wg, int nwg, LAS unsigned char* lds, unsigned long long* ssn) {
    const int tid = opaque_tid(), lane = tid & 63, w = tid >> 6, g = lane >> 4, lr = lane & 15, hf = w >> 2;
    LAS f32x4* xch = (LAS f32x4*)lds;
    LAS float* red = (LAS float*)(lds + 4096);
    for (int j = wg; j < 256; j += nwg) {
        const int rbase = MP + 32 * (j & 3) + 16 * ((w >> 1) & 1), cbase = 32 * (j >> 2) + 16 * (w & 1);
        const bf16_t* A = (MODE == 0 ? p.OC_() : p.MG_()) + (size_t)(rbase + lr) * 2048 + hf * 1024 + 8 * g;
        const bf16_t* B = Wl + (MODE == 0 ? W3_OFF : W4_OFF) + (size_t)(cbase + lr) * 2048 + hf * 1024 + 8 * g;
        f32x4 acc = (f32x4){0.f, 0.f, 0.f, 0.f};
#pragma unroll 1
        for (int k0 = 0; k0 < 1024; k0 += 512) {
            bf16x8 af[16], bf[16];
#pragma unroll
            for (int i = 0; i < 16; ++i) { af[i] = *(const bf16x8*)(A + k0 + 32 * i); bf[i] = *(const bf16x8*)(B + k0 + 32 * i); }
#pragma unroll
            for (int i = 0; i < 16; ++i) acc = __builtin_amdgcn_mfma_f32_16x16x32_bf16(af[i], bf[i], acc, 0, 0, 0);
        }
        if (hf == 1) xch[(w & 3) * 64 + lane] = acc;
        __syncthreads();
        if (hf == 0) {
            const f32x4 hi = xch[(w & 3) * 64 + lane];
            const int col = cbase + lr;
#pragma unroll
            for (int r = 0; r < 4; ++r) {
                const size_t row = (size_t)rbase + 4 * g + r;
                if (MODE == 0) {
                    const float rt = bf2f(p.RT_()[row * 2048 + col]), gr = bf2f(p.GRS_()[row * 2048 + col]);
                    p.MG_()[row * 2048 + col] = f2bf(gr * (rt * acc[r] + hi[r]));
                } else {
                    const bf16_t nb = f2bf(bf2f(p.Xb_()[row * 2048 + col]) + acc[r] + hi[r]);
                    p.Xb_()[row * 2048 + col] = nb;
                    float q = bf2f(nb) * bf2f(nb);
                    q += __shfl_xor(q, 1); q += __shfl_xor(q, 2); q += __shfl_xor(q, 4); q += __shfl_xor(q, 8);
                    if (lr == 0) red[(w & 1) * 32 + 16 * ((w >> 1) & 1) + 4 * g + r] = q;
                }
            }
        }
        if (MODE == 1) {
            __syncthreads();
            if (tid < 32) atomicAdd(ssn + MP + 32 * (j & 3) + tid, ss_fix(red[tid] + red[32 + tid]));
        }
        __syncthreads();
    }
}

__device__ __forceinline__ void sample_gemm2(const Params& p, const bf16_t* W2t, int wg, int nwg) {
    const int tid = opaque_tid(), lane = tid & 63, w = tid >> 6, g = lane >> 4, lr = lane & 15;
    for (int j = wg; j < 128; j += nwg) {
        const int rbase = MP + 16 * (j & 7), cbase = 128 * (j >> 3) + 16 * w, head = cbase >> 9;
        const bf16_t* A = p.CM_() + (size_t)(rbase + lr) * WM + head * 256 + 8 * g;
        const bf16_t* B = W2t + (size_t)(cbase + lr) * 256 + 8 * g;
        bf16x8 af[8], bf[8];
#pragma unroll
        for (int i = 0; i < 8; ++i) { af[i] = *(const bf16x8*)(A + 32 * i); bf[i] = *(const bf16x8*)(B + 32 * i); }
        f32x4 acc = (f32x4){0.f, 0.f, 0.f, 0.f};
#pragma unroll
        for (int i = 0; i < 8; ++i) acc = __builtin_amdgcn_mfma_f32_16x16x32_bf16(af[i], bf[i], acc, 0, 0, 0);
#pragma unroll
        for (int r = 0; r < 4; ++r) p.QK_()[(size_t)(rbase + 4 * g + r) * 2048 + cbase + lr] = f2bf(acc[r]);
    }
}

__device__ __forceinline__ void phaseA(const Params& p, int layer, int wg, int nwg, LAS unsigned char* lds) {
    for (int it = wg; it < 256; it += nwg) {
        const int pi = (it & 7) * 4 + (it >> 6), sl = (it >> 3) & 7, bh = pi & 15;
        if (pi < 16) chunk_state_item<0>(p, layer, bh >> 2, bh & 3, sl, lds); else chunk_state_item<1>(p, layer, bh >> 2, bh & 3, sl, lds);
    }
    {
        const int tid = opaque_tid(), lane = tid & 63, wid = __builtin_amdgcn_readfirstlane(tid >> 6);
        int s = wg, k = 0;
        if (s < 1024) {
            f32x4 cc[8], cx[8];
            { const char* sb = sample_state(p, layer, s) + (size_t)wid * 1024 + (unsigned)lane * 16u;
#pragma unroll
              for (int j = 0; j < 8; ++j) cc[j] = __builtin_nontemporal_load((const f32x4*)(sb + (size_t)j * 8192)); }
            for (;; ++k) {
                const int sn = s + nwg;
                const char* nsrc = sn < 1024 ? sample_state(p, layer, sn) : nullptr;
                LAS float* base = (LAS float*)lds + (k & 1) * 3072;
                const int b = (s >> 2) & 127, h = s & 3;
                if (s < 512) sample_item<0>(p, layer, b, h, base, cc, cx, nsrc); else sample_item<1>(p, layer, b, h, base, cc, cx, nsrc);
                if (sn >= 1024) break;
#pragma unroll
                for (int j = 0; j < 8; ++j) cc[j] = cx[j];
                s = sn;
            }
        }
        __syncthreads();
    }
}
__device__ __forceinline__ void phaseScan(const Params& p, int layer, int wg, int nwg, LAS unsigned char* lds) {
    for (int it = wg; it < 256; it += nwg) scan_item(p, layer, it >> 3, it & 7, lds);
}
__device__ __forceinline__ void phaseC(const Params& p, int layer, int wg, int nwg, LAS unsigned char* lds) {
    for (int it = wg; it < 512; it += nwg) {
        const int br = it >> 8, rest = it & 255, b = rest >> 6, h = (rest >> 4) & 3, c = rest & 15;
        if (br == 0) chunk_passC<0>(p, layer, b, h, c, lds); else chunk_passC<1>(p, layer, b, h, c, lds);
    }
}

template <int ONLY>
__device__ __forceinline__ void run_phases(const Params& p_in, int ph_lo, int ph_hi) {
    extern __shared__ __attribute__((aligned(16))) unsigned char smem_raw[];
    LAS unsigned char* lds = (LAS unsigned char*)smem_raw;
    volatile LAS unsigned* xbw = (volatile LAS unsigned*)(lds + LDS_BYTES - 16);
    const int wg_in = blockIdx.x, nwg = gridDim.x;
    const bool multi = (ph_hi - ph_lo) > 1;
    XcdBarrier bar; bar.bar = p_in.bar_(); bar.x = 0; bar.st = xbw;
    if (multi) {
        if (threadIdx.x == 0) { xbw[0] = 0u; xbw[1] = 0u; xbw[2] = 0u; xbw[3] = 0u; }
        __syncthreads();
        bar = xcd_barrier_post(p_in.bar_(), xbw);
    }
    int ph = 0;
#define PHASE(KIND, ...) { if constexpr (ONLY < 0 || ONLY == KIND) { if (ph >= ph_lo && ph < ph_hi) { \
    Params p = p_in; int wg = wg_in; { size_t z_ = 0; asm volatile("" : "+s"(z_), "+s"(wg)); p.ws = p_in.ws + z_; p.out = p_in.out + z_; }     \
    __VA_ARGS__; if (ph + 1 < ph_hi) xcd_barrier(bar); } } ++ph; }
    PHASE(0, prep_phase(p, wg, nwg, lds))
    for (int layer = 0; layer < DEPTH; ++layer) {
        PHASE(2, { pg8::StaticOrder S; S.init(MPAD, N1, nwg, wg); pg8::Gemm g{p.Xb_(), p.W_() + (size_t)layer * WL + W1_OFF, D, D, D, 31, 0, 0};
                pg8::EpiG1 E{p.P_(), p.b_gate + (size_t)layer * 4096, p.RT_(), p.GRS_(), p.ROPE_(), p.SS_() + (size_t)layer * MPAD, p.SSP_(), p.IF_()}; pg8::gemm_phase<false>(lds, g, S, E);
                if (layer + 1 < DEPTH) { int nw_ = nwg; asm volatile("" : "+s"(nw_)); const int r_ = g1_rem(nw_); if (r_ && wg >= r_) { __syncthreads(); const int l1 = layer + 1; tr_run(p, (wg - r_) * 8 + (opaque_tid() >> 6), (nw_ - r_) * 8, tr_def(nw_), lds, [=](int j) { return l1 * 7808 + j; }); } } })
        PHASE(3, conv_phase(p, layer, wg, nwg, lds))
        PHASE(4, { pg8::StaticOrder S; S.init(MP, 2048, nwg, wg); pg8::Gemm g{p.CM_(), p.W_() + (size_t)layer * WL + W2_OFF, 256, WM, 256, 1, 512, 0};
                pg8::EpiBf16 E{p.QK_(), 2048}; pg8::gemm_phase<false>(lds, g, S, E); sample_gemm2(p, p.W_() + (size_t)layer * WL + W2_OFF, wg, nwg); })
        PHASE(5, phaseA(p, layer, wg, nwg, lds))
        PHASE(7, phaseC(p, layer, wg, nwg, lds))
        PHASE(8, { pg8::StaticOrder S; S.init(MP, 2048, nwg, wg); pg8::Gemm g{p.OC_(), p.W_() + (size_t)layer * WL + W3_OFF, 2048, 2048, 2048, 31, 0, 16};
                pg8::EpiMerged E{p.MG_(), p.RT_(), p.GRS_()}; pg8::gemm_phase<true>(lds, g, S, E); sample_gemm<0>(p, p.W_() + (size_t)layer * WL, wg, nwg, lds, nullptr); })
        PHASE(10, { pg8::StaticOrder S; S.init(MP, 2048, nwg, wg); pg8::Gemm g{p.MG_(), p.W_() + (size_t)layer * WL + W4_OFF, 2048, 2048, 2048, 31, 0, 0};
                pg8::EpiResidual E{p.Xb_(), p.SSP_(), (LAS float*)(lds + pg8::STAGE_BYTES)}; pg8::gemm_phase<false>(lds, g, S, E); sample_gemm<1>(p, p.W_() + (size_t)layer * WL, wg, nwg, lds, p.SS_() + (size_t)(layer + 1) * MPAD); })
    }
    PHASE(11, final_phase(p, wg, nwg))
#undef PHASE
}
__global__ void __launch_bounds__(512, 2) mega(Params p, int ph_lo, int ph_hi) { run_phases<-1>(p, ph_lo, ph_hi); }
#ifdef DIAG
template <int K> __global__ void __launch_bounds__(512, 2) mega_k(Params p, int ph_lo, int ph_hi) { run_phases<K>(p, ph_lo, ph_hi); }
template __global__ void mega_k<0>(Params, int, int); template __global__ void mega_k<2>(Params, int, int);
template __global__ void mega_k<3>(Params, int, int); template __global__ void mega_k<4>(Params, int, int); template __global__ void mega_k<5>(Params, int, int);
template __global__ void mega_k<7>(Params, int, int); template __global__ void mega_k<8>(Params, int, int);
template __global__ void mega_k<10>(Params, int, int); template __global__ void mega_k<11>(Params, int, int);
#endif
constexpr int N_PHASES = 2 + DEPTH * 7;

extern "C" void kernel_launch(void* const* d_in, const int* in_sizes, int n_in, void* d_out, int out_size, void* d_ws, size_t ws_size, hipStream_t stream) {
    (void)in_sizes; (void)n_in; (void)out_size; (void)ws_size;
    static int grid = 0;
    if (grid == 0) {
        int dev = 0, cus = 0;
        hipGetDevice(&dev);
        hipDeviceGetAttribute(&cus, hipDeviceAttributeMultiprocessorCount, dev);
        if (hipFuncSetAttribute((const void*)mega, hipFuncAttributeMaxDynamicSharedMemorySize, LDS_BYTES) != hipSuccess) fprintf(stderr, "hipFuncSetAttribute failed\n");
        (void)hipGetLastError();
        grid = cus > 0 ? cus : 256;
    }
    Params p{};
    const float** in = (const float**)&p;
    for (int i = 0; i < 24; ++i) in[i] = (const float*)d_in[i];
    p.out = (float*)d_out;
    p.ws = (unsigned char*)d_ws;
    if (ws_size < WS_END) { fprintf(stderr, "workspace too small: %zu < %zu\n", ws_size, (size_t)WS_END); return; }
    hipMemsetAsync(d_ws, 0, 16384, stream);
#if MK_SINGLE
    hipLaunchKernelGGL(mega, dim3(grid), dim3(512), LDS_BYTES, stream, p, 0, N_PHASES);
#else
    for (int ph = 0; ph < N_PHASES; ++ph) hipLaunchKernelGGL(mega, dim3(grid), dim3(512), LDS_BYTES, stream, p, ph, ph + 1);
#endif
}
```

```cpp
#include <hip/hip_runtime.h>
#include <stdint.h>
#include <stdio.h>

#ifndef MK_SINGLE
#define MK_SINGLE 1
#endif

#define LAS __attribute__((address_space(3)))
typedef unsigned short bf16_t;
typedef short bf16x8 __attribute__((ext_vector_type(8)));
typedef float f32x4 __attribute__((ext_vector_type(4)));
typedef unsigned u32x4 __attribute__((ext_vector_type(4)));
typedef unsigned u32x2 __attribute__((ext_vector_type(2)));
typedef float f32x2_t __attribute__((ext_vector_type(2)));

constexpr int D = 2048, SEQ = 2048, BP = 4, BS = 128, DEPTH = 4, HM = 4, DH = 256, WM = 1024, NIN = 7176;
constexpr int MP = BP * SEQ, MT = MP + BS, MPAD = 8448;
constexpr int NP = 7168;
constexpr int N1 = 11520;
constexpr int C_U = 0, C_VM = 1024, C_ZM = 2048, C_QR = 3072, C_KR = 4096, C_VR = 5120, C_ZR = 6144, C_GM = 7168, C_GR = 9216;
constexpr float EPS = 1e-6f;
constexpr size_t SZ = 65536;
constexpr size_t O_YP = 0, O_YS = O_YP + 16777216, O_CP = O_YS + 262144, O_NP = O_CP + 4194304, O_MP = O_NP + 16384, O_CVP = O_MP + 64,
                 O_SP = O_CVP + 49152, O_CS = O_SP + 4194304, O_NS = O_CS + 134217728, O_MS = O_NS + 524288, O_CVS = O_MS + 2048, O_SS = O_CVS + 1572864;
constexpr size_t W1_OFF = 0, W2_OFF = W1_OFF + (size_t)N1 * D, W3_OFF = W2_OFF + (size_t)2048 * 256, W4_OFF = W3_OFF + (size_t)D * D, WL = W4_OFF + (size_t)D * D;
constexpr int LDS_BYTES = 147456;

constexpr size_t al256(size_t x) { return (x + 255) & ~(size_t)255; }
constexpr size_t OFF_BAR = 0, OFF_SS = OFF_BAR + 16384, OFF_SSP = OFF_SS + al256((size_t)5 * MPAD * 8), OFF_XB = OFF_SSP + al256((size_t)8 * MP * 4),
    OFF_P = OFF_XB + al256((size_t)MPAD * D * 2), OFF_IF = OFF_P + al256((size_t)MPAD * NP * 2), OFF_CM = OFF_IF + al256((size_t)MPAD * 8 * 4),
    OFF_QK = OFF_CM + al256((size_t)MPAD * WM * 2), OFF_OC = OFF_QK + al256((size_t)MPAD * 2048 * 2), OFF_MG = OFF_OC + al256((size_t)MPAD * 2048 * 2),
    OFF_U = OFF_MG + al256((size_t)MPAD * 2048 * 2), OFF_CS = OFF_U + al256((size_t)32 * 16 * SZ * 2), OFF_NU = OFF_CS + al256((size_t)32 * 16 * SZ * 2),
    OFF_NS = OFF_NU + al256((size_t)16 * 16 * 256 * 4), OFF_W = OFF_NS + al256((size_t)16 * 16 * 256 * 4), OFF_ROPE = OFF_W + al256((size_t)DEPTH * WL * 2),
    OFF_RT = OFF_ROPE + al256((size_t)2049 * 128 * 2 * 4), OFF_GRS = OFF_RT + al256((size_t)MPAD * 2048 * 2), OFF_GT = OFF_GRS + al256((size_t)MPAD * 2048 * 2),
    WS_END = OFF_GT + al256((size_t)16 * 6208 * 4);

struct Params {
    const float *x_prompt, *x_sample, *st_C, *st_n, *st_m, *st_conv, *st_S, *norm_g, *w_in, *conv_w, *conv_b, *w_qm, *w_km, *b_i, *b_f,
                *hn_m_g, *skip_m, *hn_r_g, *w_pm, *w_pr, *w_gate, *b_gate, *w_o, *final_g;
    float* out;
    unsigned char* ws;
#define WSF(name, type, off) __device__ __forceinline__ type* name##_() const { return (type*)(ws + (off)); }
    WSF(bar, unsigned, OFF_BAR) WSF(SS, unsigned long long, OFF_SS) WSF(SSP, float, OFF_SSP) WSF(Xb, bf16_t, OFF_XB) WSF(P, bf16_t, OFF_P) WSF(IF, float, OFF_IF)
    WSF(CM, bf16_t, OFF_CM) WSF(QK, bf16_t, OFF_QK) WSF(OC, bf16_t, OFF_OC) WSF(MG, bf16_t, OFF_MG) WSF(U, bf16_t, OFF_U) WSF(CS, bf16_t, OFF_CS)
    WSF(NU, float, OFF_NU) WSF(NS, float, OFF_NS) WSF(W, bf16_t, OFF_W) WSF(ROPE, float, OFF_ROPE) WSF(RT, bf16_t, OFF_RT) WSF(GRS, bf16_t, OFF_GRS) WSF(GT, float, OFF_GT)
#undef WSF
};


__device__ __forceinline__ unsigned long long ss_fix(float v) { return (unsigned long long)(v * 1048576.0f + 0.5f); }
__device__ __forceinline__ float ss_val(unsigned long long v) { return (float)v * (1.0f / 1048576.0f); }
__device__ __forceinline__ float row_ss(const float* ssp, const unsigned long long* ss, int row) {
    if (row < 8192) { const f32x4 a = *(const f32x4*)(ssp + (size_t)row * 8), b = *(const f32x4*)(ssp + (size_t)row * 8 + 4);
        return ((a[0] + a[1]) + (a[2] + a[3])) + ((b[0] + b[1]) + (b[2] + b[3])); }
    return ss_val(ss[row]);
}
__device__ __forceinline__ int opaque_tid() { int t = threadIdx.x; asm volatile("" : "+v"(t)); return t; }
__device__ __forceinline__ float bf2f(bf16_t v) { return __uint_as_float((unsigned)v << 16); }
__device__ __forceinline__ bf16_t f2bf(float f) { unsigned u = __float_as_uint(f); u += 0x7fffu + ((u >> 16) & 1u); return (bf16_t)(u >> 16); }
__device__ __forceinline__ unsigned pk2(float lo, float hi) { return (unsigned)f2bf(lo) | ((unsigned)f2bf(hi) << 16); }
__device__ __forceinline__ float wave_sum(float v) {
#pragma unroll
    for (int o = 32; o >= 1; o >>= 1) v += __shfl_xor(v, o);
    return v;
}
__device__ __forceinline__ float wave_max(float v) {
#pragma unroll
    for (int o = 32; o >= 1; o >>= 1) v = fmaxf(v, __shfl_xor(v, o));
    return v;
}
__device__ __forceinline__ float sigmoidf_(float x) { return __builtin_amdgcn_rcpf(1.0f + __expf(-x)); }
__device__ __forceinline__ float siluf_(float x) { return x * __builtin_amdgcn_rcpf(1.0f + __expf(-x)); }
__device__ __forceinline__ float logsigf_(float x) { return x < 0.f ? x - log1pf(expf(x)) : -log1pf(expf(-x)); }
__device__ __forceinline__ void block_sum2(float& a, float& b, LAS float* red) {
    a = wave_sum(a); b = wave_sum(b);
    __syncthreads();
    if ((threadIdx.x & 63) == 0) { red[threadIdx.x >> 6] = a; red[8 + (threadIdx.x >> 6)] = b; }
    __syncthreads();
    float sa = 0.f, sb = 0.f;
#pragma unroll
    for (int i = 0; i < 8; ++i) { sa += red[i]; sb += red[8 + i]; }
    a = sa; b = sb;
}

#define XB_TMO      128
#define XB_XCNT(j)  (256  + 64 * (j))
#define XB_XSUB(j)  (1280 + 64 * (j))
#define XB_XGEN(j)  (2304 + 64 * (j))
#define XB_TOP      3328
#define XB_TOPGEN   3392
#define XCD_BAR_WORDS 3456
#define XB_SPIN_CAP (1u << 22)

__device__ __forceinline__ unsigned xb_ld(unsigned* p)              { return __hip_atomic_load(p, __ATOMIC_RELAXED, __HIP_MEMORY_SCOPE_AGENT); }
__device__ __forceinline__ unsigned xb_add(unsigned* p, unsigned v) { return __hip_atomic_fetch_add(p, v, __ATOMIC_RELAXED, __HIP_MEMORY_SCOPE_AGENT); }
__device__ __forceinline__ unsigned xb_xcc_id() { return (unsigned)__builtin_amdgcn_s_getreg((3 << 11) | 20) & 0xFu; }
#define XB_SPIN(cond, bar) do { unsigned _sp = 0; while (cond) { __builtin_amdgcn_s_sleep(1); \
    if ((++_sp & 255u) == 0u) { if (xb_ld(&(bar)[XB_TMO])) break; if (_sp > XB_SPIN_CAP) { atomicAdd(&(bar)[XB_TMO], 1u); break; } } } } while (0)

struct XcdBarrier { unsigned* bar; unsigned x; volatile LAS unsigned* st; };

__device__ __forceinline__ XcdBarrier xcd_barrier_post(unsigned* bar, volatile LAS unsigned* st) {
    XcdBarrier b; b.bar = bar; b.x = xb_xcc_id(); b.st = st;
    if (threadIdx.x == 0) (void)xb_add(&bar[XB_XCNT(b.x)], 1u);
    return b;
}
__device__ __forceinline__ void xcd_barrier_complete(unsigned* bar, unsigned x, unsigned& nloc, unsigned& nx) {
    const unsigned G = gridDim.x * gridDim.y * gridDim.z;
    unsigned sum, cnt, mine, sp = 0u;
    for (;;) {
        sum = 0u; cnt = 0u;
#pragma unroll 1
        for (unsigned j = 0; j < 16; ++j) { const unsigned c = xb_ld(&bar[XB_XCNT(j)]); sum += c; cnt += (c > 0u) ? 1u : 0u; }
        if (sum == G) break;
        __builtin_amdgcn_s_sleep(1);
        if ((++sp & 255u) == 0u) { if (xb_ld(&bar[XB_TMO])) break; if (sp > XB_SPIN_CAP) { atomicAdd(&bar[XB_TMO], 1u); break; } }
    }
    mine = xb_ld(&bar[XB_XCNT(x)]);
    nloc = mine > 0u ? mine : 1u; nx = cnt > 0u ? cnt : 1u;
}
__device__ __forceinline__ void xcd_barrier(const XcdBarrier& b) {
    asm volatile("s_waitcnt vmcnt(0)" ::: "memory");
    __syncthreads();
    if (threadIdx.x == 0) {
        unsigned* bar = b.bar;
        __builtin_amdgcn_s_waitcnt(0);
        unsigned nloc = b.st[0], nx = b.st[1];
        if (nloc == 0u) { xcd_barrier_complete(bar, b.x, nloc, nx); b.st[0] = nloc; b.st[1] = nx; }
        const unsigned old = xb_add(&bar[XB_XSUB(b.x)], 1u);
        const unsigned gen = old / nloc;
        if (old + 1u == (gen + 1u) * nloc) {
            __builtin_amdgcn_fence(__ATOMIC_RELEASE, "agent");
            asm volatile("s_waitcnt vmcnt(0)" ::: "memory");
            const unsigned og = xb_add(&bar[XB_TOP], 1u);
            const unsigned tg = og / nx;
            if (og + 1u == (tg + 1u) * nx) xb_add(&bar[XB_TOPGEN], 1u);
            else XB_SPIN(xb_ld(&bar[XB_TOPGEN]) == tg, bar);
            __builtin_amdgcn_fence(__ATOMIC_ACQUIRE, "agent");
            xb_add(&bar[XB_XGEN(b.x)], 1u);
            asm volatile("s_waitcnt vmcnt(0)" ::: "memory");
        } else {
            XB_SPIN(xb_ld(&bar[XB_XGEN(b.x)]) == gen, bar);
            __builtin_amdgcn_fence(__ATOMIC_ACQUIRE, "agent");
            asm volatile("s_waitcnt vmcnt(0)" ::: "memory");
        }
    }
    __syncthreads();
}

namespace pg8 {
constexpr int BM = 256, BK = 64, HALF = 128, HTB = HALF * BK * 2, STAGE_BYTES = 8 * HTB, NXCD = 8, WGM = 8;
__host__ __device__ __forceinline__ int lds_byte(int r, int c) { const int st = (r >> 4) * 2 + (c >> 5), rr = r & 15, cc = c & 31, ob = rr * 64 + cc * 2; return st * 1024 + (ob ^ (((ob >> 9) & 1) << 5)); }
__host__ __device__ __forceinline__ void stage_rc(int b, int& R, int& C) { const int st = b / 1024, sb = b % 1024, swz = sb ^ (((sb >> 9) & 1) << 5); R = (st >> 1) * 16 + swz / 64; C = (st & 1) * 32 + (swz % 64) / 2; }
__host__ __device__ __forceinline__ int perm32(int rho) { const int n = rho >> 4, i = rho & 15; return 8 * (i >> 2) + 4 * n + (i & 3); }

struct Unit { int pm, pn; };
struct Gemm { const bf16_t* A; const bf16_t* Bt; int K, lda, ldb, a_pn_shift, a_pn_stride, mid_t; };

struct StaticOrder {
    int nM, nN, nwg, G, c;
    __device__ void init(int M, int N, int G_, int c_) { nM = M / BM; nN = N / BM; nwg = nM * nN; G = G_; c = c_; }
    __device__ bool next(int i, Unit& u) const {
        const long L = (long)i * G + c; if (L >= nwg) return false;
        int wgid = (int)L; { const int q = nwg / NXCD, r = nwg % NXCD, xcd = wgid % NXCD, off = wgid / NXCD; wgid = (xcd < r ? xcd * (q + 1) : r * (q + 1) + (xcd - r) * q) + off; }
        const int nig = WGM * nN, gid = wgid / nig, fm = gid * WGM, gsz = (nM - fm) < WGM ? (nM - fm) : WGM;
        u.pm = fm + ((wgid % nig) % gsz); u.pn = (wgid % nig) / gsz; return true;
    }
};
struct BalOrder : StaticOrder {
    __device__ bool next(int i, Unit& u) const {
        if (G != 256 || nM != 33 || nN != 45) return StaticOrder::next(i, u);
        if (i > 5) return false;
        const int x = c & 7, off = c >> 3, rg = x >> 1, odd = x & 1;
        if (!odd || i < 5) { u.pm = rg * 8 + (off & 7); u.pn = 4 * (2 * i + odd) + (off >> 3); return true; }
        if (off < 8) { u.pm = rg * 8 + off; u.pn = 44; return true; }
        const int su = rg * 12 + off - 8;
        if (off < 20 && su < 45) { u.pm = 32; u.pn = su; return true; }
        return false;
    }
    __device__ int idle_index(int& n) const {
        if (G != 256 || nM != 33 || nN != 45) { const int r = nwg % G; n = r ? G - r : 0; return (r && c >= r) ? c - r : -1; }
        n = 51;
        const int x = c & 7, off = c >> 3, rg = x >> 1;
        if (!(x & 1)) return -1;
        if (off >= 20) return rg * 12 + off - 20;
        if (rg == 3 && off >= 17) return 48 + off - 17;
        return -1;
    }
};
__device__ __forceinline__ unsigned cvt_pk_bf16(float lo, float hi) { unsigned r; asm volatile("v_cvt_pk_bf16_f32 %0, %1, %2" : "=v"(r) : "v"(lo), "v"(hi)); return r; }

struct EpiBf16 {
    static constexpr bool PERM = true;
    bf16_t* O; int ldc;
    __device__ __forceinline__ void operator()(const f32x4 (&acc)[2][2][4][2], const Unit& u, int wr, int wc, int fr, int fq) const {
        const int row0 = u.pm * BM + wr * 64 + fr, col0 = u.pn * BM + wc * 32 + 8 * fq;
#pragma unroll
        for (int ai = 0; ai < 2; ++ai)
#pragma unroll
            for (int m = 0; m < 4; ++m) { bf16_t* rowp = O + (size_t)(row0 + ai * HALF + m * 16) * ldc + col0;
#pragma unroll
                for (int bj = 0; bj < 2; ++bj) { const f32x4 v0 = acc[ai][bj][m][0], v1 = acc[ai][bj][m][1];
                    u32x4 w; w.x = cvt_pk_bf16(v0[0], v0[1]); w.y = cvt_pk_bf16(v0[2], v0[3]); w.z = cvt_pk_bf16(v1[0], v1[1]); w.w = cvt_pk_bf16(v1[2], v1[3]);
                    *(u32x4*)(rowp + bj * HALF) = w; } }
    }
};
struct EpiG1 {
    static constexpr bool PERM = true;
    bf16_t* P; const float* bg; bf16_t* RT; bf16_t* GRS; const float* rope; const unsigned long long* ss; const float* ssp; float* IFo;
    __device__ __forceinline__ void operator()(f32x4 (&acc)[2][2][4][2], const Unit& u, int wr, int wc, int fr, int fq) const {
        const int row0 = u.pm * BM + wr * 64 + fr, cw = wc * 32 + 8 * fq;
#pragma unroll
        for (int ai = 0; ai < 2; ++ai) {
            float sq[4];
            if (u.pm < 32) {
                f32x4 a[4], b[4];
#pragma unroll
                for (int m = 0; m < 4; ++m) { const float* q = ssp + (size_t)(row0 + ai * HALF + m * 16) * 8; a[m] = *(const f32x4*)q; b[m] = *(const f32x4*)(q + 4); }
#pragma unroll
                for (int m = 0; m < 4; ++m) sq[m] = ((a[m][0] + a[m][1]) + (a[m][2] + a[m][3])) + ((b[m][0] + b[m][1]) + (b[m][2] + b[m][3]));
            } else {
                unsigned long long v[4];
#pragma unroll
                for (int m = 0; m < 4; ++m) v[m] = ss[row0 + ai * HALF + m * 16];
#pragma unroll
                for (int m = 0; m < 4; ++m) sq[m] = ss_val(v[m]);
            }
#pragma unroll
            for (int m = 0; m < 4; ++m) { const float rstd = rsqrtf(sq[m] * (1.0f / 2048.0f) + 1e-6f);
#pragma unroll
                for (int bj = 0; bj < 2; ++bj) { acc[ai][bj][m][0] *= rstd; acc[ai][bj][m][1] *= rstd; } }
            __builtin_amdgcn_sched_barrier(0);
        }
        if (u.pn == 44) {
            if (wc == 0 && fq == 0) {
#pragma unroll
                for (int ai = 0; ai < 2; ++ai)
#pragma unroll
                    for (int m = 0; m < 4; ++m) { float* o = IFo + (size_t)(row0 + ai * HALF + m * 16) * 8; *(f32x4*)o = acc[ai][0][m][0]; *(f32x4*)(o + 4) = acc[ai][0][m][1]; }
            }
        } else if (u.pn >= 28) {
            const int ch = 128 * (u.pn - 28) + cw;
            const f32x4 bm0 = *(const f32x4*)(bg + ch), bm1 = *(const f32x4*)(bg + ch + 4), br0 = *(const f32x4*)(bg + 2048 + ch), br1 = *(const f32x4*)(bg + 2048 + ch + 4);
#pragma unroll
            for (int ai = 0; ai < 2; ++ai)
#pragma unroll
                for (int m = 0; m < 4; ++m) { const size_t row = (size_t)(row0 + ai * HALF + m * 16);
                    const f32x4 vm0 = acc[ai][0][m][0] + bm0, vm1 = acc[ai][0][m][1] + bm1, vr0 = acc[ai][1][m][0] + br0, vr1 = acc[ai][1][m][1] + br1;
                    float rt[8], gr[8];
#pragma unroll
                    for (int j = 0; j < 4; ++j) {
                        const float er0 = 1.0f + __expf(-vr0[j]), er1 = 1.0f + __expf(-vr1[j]);
                        rt[j] = er0 * __builtin_amdgcn_rcpf(1.0f + __expf(-vm0[j])); rt[4 + j] = er1 * __builtin_amdgcn_rcpf(1.0f + __expf(-vm1[j]));
                        gr[j] = __builtin_amdgcn_rcpf(er0); gr[4 + j] = __builtin_amdgcn_rcpf(er1); }
                    u32x4 w; w.x = cvt_pk_bf16(rt[0], rt[1]); w.y = cvt_pk_bf16(rt[2], rt[3]); w.z = cvt_pk_bf16(rt[4], rt[5]); w.w = cvt_pk_bf16(rt[6], rt[7]);
                    *(u32x4*)(RT + row * 2048 + ch) = w;
                    w.x = cvt_pk_bf16(gr[0], gr[1]); w.y = cvt_pk_bf16(gr[2], gr[3]); w.z = cvt_pk_bf16(gr[4], gr[5]); w.w = cvt_pk_bf16(gr[6], gr[7]);
                    *(u32x4*)(GRS + row * 2048 + ch) = w; }
        } else if (u.pn >= 12 && u.pn < 20) {
            const float sc = u.pn >= 16 ? 0.0625f : 1.0f;
#pragma unroll
            for (int ai = 0; ai < 2; ++ai)
#pragma unroll
                for (int m = 0; m < 4; ++m) { const int row = row0 + ai * HALF + m * 16;
                    const int pi = row < MP ? (row & (SEQ - 1)) : 2048;
                    const f32x4* cs = (const f32x4*)(rope + ((size_t)pi * 128 + cw) * 2);
                    const f32x4 t0 = cs[0], t1 = cs[1], t2 = cs[2], t3 = cs[3];
                    const f32x4 a0 = acc[ai][0][m][0], a1 = acc[ai][0][m][1], b0 = acc[ai][1][m][0], b1 = acc[ai][1][m][1];
                    const float c[8] = {t0[0], t0[2], t1[0], t1[2], t2[0], t2[2], t3[0], t3[2]}, sn[8] = {t0[1], t0[3], t1[1], t1[3], t2[1], t2[3], t3[1], t3[3]};
                    const float x1[8] = {a0[0], a0[1], a0[2], a0[3], a1[0], a1[1], a1[2], a1[3]}, x2[8] = {b0[0], b0[1], b0[2], b0[3], b1[0], b1[1], b1[2], b1[3]};
                    float o1[8], o2[8];
#pragma unroll
                    for (int j = 0; j < 8; ++j) { o1[j] = (x1[j] * c[j] - x2[j] * sn[j]) * sc; o2[j] = (x1[j] * sn[j] + x2[j] * c[j]) * sc; }
                    bf16_t* rowp = P + (size_t)row * NP + u.pn * BM + cw;
                    u32x4 w; w.x = cvt_pk_bf16(o1[0], o1[1]); w.y = cvt_pk_bf16(o1[2], o1[3]); w.z = cvt_pk_bf16(o1[4], o1[5]); w.w = cvt_pk_bf16(o1[6], o1[7]);
                    *(u32x4*)rowp = w;
                    w.x = cvt_pk_bf16(o2[0], o2[1]); w.y = cvt_pk_bf16(o2[2], o2[3]); w.z = cvt_pk_bf16(o2[4], o2[5]); w.w = cvt_pk_bf16(o2[6], o2[7]);
                    *(u32x4*)(rowp + HALF) = w; }
        } else {
#pragma unroll
            for (int ai = 0; ai < 2; ++ai)
#pragma unroll
                for (int m = 0; m < 4; ++m) { bf16_t* rowp = P + (size_t)(row0 + ai * HALF + m * 16) * NP + u.pn * BM + cw;
#pragma unroll
                    for (int bj = 0; bj < 2; ++bj) { const f32x4 v0 = acc[ai][bj][m][0], v1 = acc[ai][bj][m][1];
                        u32x4 w; w.x = cvt_pk_bf16(v0[0], v0[1]); w.y = cvt_pk_bf16(v0[2], v0[3]); w.z = cvt_pk_bf16(v1[0], v1[1]); w.w = cvt_pk_bf16(v1[2], v1[3]);
                        *(u32x4*)(rowp + bj * HALF) = w; } }
        }
    }
};
struct EpiMerged {
    static constexpr bool PERM = true;
    bf16_t* O; const bf16_t* RT; const bf16_t* GRS;
    __device__ __forceinline__ void scale(f32x4 (&acc)[2][2][4][2], const bf16_t* S, const Unit& u, int wr, int wc, int fr, int fq) const {
        asm volatile("" : "+v"(fr), "+v"(fq));
        const int row0 = u.pm * BM + wr * 64 + fr, col0 = u.pn * BM + wc * 32 + 8 * fq;
#pragma unroll
        for (int ai = 0; ai < 2; ++ai) {
            u32x4 sv[4][2];
#pragma unroll
            for (int m = 0; m < 4; ++m)
#pragma unroll
                for (int bj = 0; bj < 2; ++bj) sv[m][bj] = *(const u32x4*)(S + (size_t)(row0 + ai * HALF + m * 16) * 2048 + col0 + bj * HALF);
#pragma unroll
            for (int m = 0; m < 4; ++m)
#pragma unroll
                for (int bj = 0; bj < 2; ++bj) { const u32x4 a = sv[m][bj];
                    acc[ai][bj][m][0][0] *= __uint_as_float(a.x << 16); acc[ai][bj][m][0][1] *= __uint_as_float(a.x & 0xffff0000u);
                    acc[ai][bj][m][0][2] *= __uint_as_float(a.y << 16); acc[ai][bj][m][0][3] *= __uint_as_float(a.y & 0xffff0000u);
                    acc[ai][bj][m][1][0] *= __uint_as_float(a.z << 16); acc[ai][bj][m][1][1] *= __uint_as_float(a.z & 0xffff0000u);
                    acc[ai][bj][m][1][2] *= __uint_as_float(a.w << 16); acc[ai][bj][m][1][3] *= __uint_as_float(a.w & 0xffff0000u); }
        }
    }
    __device__ __forceinline__ void mid(f32x4 (&acc)[2][2][4][2], const Unit& u, int wr, int wc, int fr, int fq) const { scale(acc, RT, u, wr, wc, fr, fq); }
    __device__ __forceinline__ void operator()(f32x4 (&acc)[2][2][4][2], const Unit& u, int wr, int wc, int fr, int fq) const {
        scale(acc, GRS, u, wr, wc, fr, fq);
        const int row0 = u.pm * BM + wr * 64 + fr, col0 = u.pn * BM + wc * 32 + 8 * fq;
#pragma unroll
        for (int ai = 0; ai < 2; ++ai)
#pragma unroll
            for (int m = 0; m < 4; ++m) { bf16_t* rowp = O + (size_t)(row0 + ai * HALF + m * 16) * 2048 + col0;
#pragma unroll
                for (int bj = 0; bj < 2; ++bj) { const f32x4 v0 = acc[ai][bj][m][0], v1 = acc[ai][bj][m][1];
                    u32x4 w; w.x = cvt_pk_bf16(v0[0], v0[1]); w.y = cvt_pk_bf16(v0[2], v0[3]); w.z = cvt_pk_bf16(v1[0], v1[1]); w.w = cvt_pk_bf16(v1[2], v1[3]);
                    *(u32x4*)(rowp + bj * HALF) = w; } }
    }
};
struct EpiResidual {
    static constexpr bool PERM = true;
    bf16_t* Xb; float* ssp; LAS float* red;
    __device__ __forceinline__ void operator()(f32x4 (&acc)[2][2][4][2], const Unit& u, int wr, int wc, int fr, int fq) const {
        const int row0 = u.pm * BM + wr * 64 + fr, col0 = u.pn * BM + wc * 32 + 8 * fq;
#pragma unroll
        for (int ai = 0; ai < 2; ++ai) {
            u32x4 xv[4][2];
#pragma unroll
            for (int m = 0; m < 4; ++m)
#pragma unroll
                for (int bj = 0; bj < 2; ++bj) xv[m][bj] = *(const u32x4*)(Xb + (size_t)(row0 + ai * HALF + m * 16) * 2048 + col0 + bj * HALF);
#pragma unroll
            for (int m = 0; m < 4; ++m) { float sq = 0.f;
#pragma unroll
                for (int bj = 0; bj < 2; ++bj) { const u32x4 a = xv[m][bj]; const f32x4 v0 = acc[ai][bj][m][0], v1 = acc[ai][bj][m][1];
                    u32x4 w;
                    w.x = cvt_pk_bf16(v0[0] + __uint_as_float(a.x << 16), v0[1] + __uint_as_float(a.x & 0xffff0000u)); w.y = cvt_pk_bf16(v0[2] + __uint_as_float(a.y << 16), v0[3] + __uint_as_float(a.y & 0xffff0000u));
                    w.z = cvt_pk_bf16(v1[0] + __uint_as_float(a.z << 16), v1[1] + __uint_as_float(a.z & 0xffff0000u)); w.w = cvt_pk_bf16(v1[2] + __uint_as_float(a.w << 16), v1[3] + __uint_as_float(a.w & 0xffff0000u));
                    *(u32x4*)(Xb + (size_t)(row0 + ai * HALF + m * 16) * 2048 + col0 + bj * HALF) = w;
                    const unsigned ww[4] = {w.x, w.y, w.z, w.w};
#pragma unroll
                    for (int q = 0; q < 4; ++q) { const float lo = __uint_as_float(ww[q] << 16), hi = __uint_as_float(ww[q] & 0xffff0000u); sq += lo * lo + hi * hi; } }
                sq += __shfl_xor(sq, 16); sq += __shfl_xor(sq, 32);
                if (fq == 0) red[(wr * 64 + fr + ai * HALF + m * 16) * 4 + wc] = sq; }
        }
        asm volatile("s_waitcnt lgkmcnt(0)" ::: "memory"); __builtin_amdgcn_s_barrier(); asm volatile("" ::: "memory");
        int t = threadIdx.x; asm volatile("" : "+v"(t));
        if (t < 256) { const f32x4 q = *(LAS const f32x4*)(red + 4 * t); ssp[(size_t)(u.pm * BM + t) * 8 + u.pn] = (q[0] + q[1]) + (q[2] + q[3]); }
        asm volatile("s_waitcnt lgkmcnt(0)" ::: "memory"); __builtin_amdgcn_s_barrier(); asm volatile("" ::: "memory");
    }
};

template <bool MID, class Epi, class Sched, bool ALIGN_EPI = true>
__device__ __forceinline__ void gemm_phase(LAS unsigned char* lds, const Gemm g, const Sched& S, const Epi& E) {
    const int tid = opaque_tid(), wid = __builtin_amdgcn_readfirstlane(tid >> 6), lane = tid & 63, wr = wid >> 2, wc = wid & 3, fr = lane & 15, fq = lane >> 4;
    const int K = g.K, nt = K / BK;
    unsigned voffA[2], voffB[2];
#pragma unroll
    for (int i = 0; i < 2; ++i) { int R, C; stage_rc(tid * 16 + i * 8192, R, C); const int Rb = Epi::PERM ? ((R & ~31) + perm32(R & 31)) : R;
        voffA[i] = (unsigned)(R * g.lda + C) * 2u; voffB[i] = (unsigned)(Rb * g.ldb + C) * 2u; }
    const size_t kstep = (size_t)(BK * 2);
    const size_t hstepA = (size_t)HALF * g.lda * 2, hstepB = (size_t)HALF * g.ldb * 2;
    const size_t tstepA = 2 * hstepA, tstepB = 2 * hstepB;
    const unsigned ldsw = (unsigned)wid * 1024u;
    const int aoff = lds_byte(wr * 64 + fr, fq * 8), boff = lds_byte(wc * 32 + fr, fq * 8);
#define PG8_SA(b, h) (((b) * 2 + (h)) * HTB)
#define PG8_SB(b, h) ((4 + (b) * 2 + (h)) * HTB)
#define PG8_STAGE(bufoff, gbase, voff) do { _Pragma("unroll") for (int _i = 0; _i < 2; ++_i) \
        __builtin_amdgcn_global_load_lds((const unsigned*)((const char*)(gbase) + (voff)[_i]), (LAS unsigned*)(lds + (bufoff) + ldsw + _i * 8192), 16, 0, 0); } while (0)
#define PG8_LDA(dst, b, h) do { _Pragma("unroll") for (int m = 0; m < 4; ++m) _Pragma("unroll") for (int k = 0; k < 2; ++k) dst[m][k] = *(const LAS bf16x8*)(lds + PG8_SA(b, h) + aoff + m * 2048 + k * 1024); } while (0)
#define PG8_LDB(dst, b, h) do { _Pragma("unroll") for (int n = 0; n < 2; ++n) _Pragma("unroll") for (int k = 0; k < 2; ++k) dst[n][k] = *(const LAS bf16x8*)(lds + PG8_SB(b, h) + boff + n * 2048 + k * 1024); } while (0)
#define PG8_MMA(ai, bj, At, Bt) do { __builtin_amdgcn_s_setprio(1); _Pragma("unroll") for (int m = 0; m < 4; ++m) _Pragma("unroll") for (int n = 0; n < 2; ++n) _Pragma("unroll") for (int k = 0; k < 2; ++k) \
        acc[ai][bj][m][n] = __builtin_amdgcn_mfma_f32_16x16x32_bf16(Bt[n][k], At[m][k], acc[ai][bj][m][n], 0, 0, 0); __builtin_amdgcn_s_setprio(0); } while (0)
#define PG8_WAIT_V(n) asm volatile("s_waitcnt vmcnt(" #n ")" ::: "memory")
#define PG8_WAIT_L(n) asm volatile("s_waitcnt lgkmcnt(" #n ")" ::: "memory")
#define PG8_BAR __builtin_amdgcn_s_barrier()
#define PG8_SCHED __builtin_amdgcn_sched_barrier(0)
#define PG8_APTR(u) ((const char*)g.A + (size_t)(u).pm * tstepA + (size_t)((u).pn >> g.a_pn_shift) * (size_t)g.a_pn_stride)
    Unit cur, nxt; int ui = 0;
    if (!S.next(0, cur)) return;
    f32x4 acc[2][2][4][2];
#pragma unroll
    for (int a = 0; a < 2; ++a)
#pragma unroll
        for (int b = 0; b < 2; ++b)
#pragma unroll
            for (int m = 0; m < 4; ++m)
#pragma unroll
                for (int n = 0; n < 2; ++n) acc[a][b][m][n] = (f32x4){0.f, 0.f, 0.f, 0.f};
    bf16x8 At[4][2], B0[2][2], B1[2][2];
    const char* cA = PG8_APTR(cur); const char* cB = (const char*)g.Bt + (size_t)cur.pn * tstepB;
    PG8_STAGE(PG8_SB(0, 0), cB, voffB); PG8_STAGE(PG8_SB(0, 1), cB + hstepB, voffB); PG8_STAGE(PG8_SA(0, 0), cA, voffA); PG8_STAGE(PG8_SA(0, 1), cA + hstepA, voffA);
    if (wr == 1) PG8_BAR;
    PG8_WAIT_V(2); PG8_BAR;
    PG8_STAGE(PG8_SB(1, 0), cB + kstep, voffB); PG8_STAGE(PG8_SA(1, 0), cA + kstep, voffA); PG8_STAGE(PG8_SB(1, 1), cB + hstepB + kstep, voffB);
    PG8_WAIT_V(6); PG8_BAR;
    for (;;) {
        const bool has_next = S.next(ui + 1, nxt);
        const char* nA = has_next ? PG8_APTR(nxt) : cA; const char* nB = has_next ? (const char*)g.Bt + (size_t)nxt.pn * tstepB : cB;
#pragma unroll 1
        for (int t = 0; t < nt; t += 2) {
            const bool last = (t == nt - 2);
            const char* a1 = cA + (size_t)(t + 1) * kstep;
            const char* a2 = last ? nA : cA + (size_t)(t + 2) * kstep; const char* b2 = last ? nB : cB + (size_t)(t + 2) * kstep;
            const char* a3 = a2 + kstep; const char* b3 = b2 + kstep;
            if constexpr (MID) { if (t == g.mid_t) E.mid(acc, cur, wr, wc, fr, fq); }
            PG8_LDB(B0, 0, 0); PG8_LDB(B1, 0, 1); PG8_SCHED; PG8_LDA(At, 0, 0); PG8_STAGE(PG8_SA(1, 1), a1 + hstepA, voffA);
            PG8_WAIT_V(8); PG8_WAIT_L(0); PG8_BAR; PG8_MMA(0, 0, At, B0); PG8_MMA(0, 1, At, B1); PG8_BAR; PG8_SCHED;
            PG8_LDA(At, 0, 1); PG8_STAGE(PG8_SB(0, 0), b2, voffB); PG8_STAGE(PG8_SB(0, 1), b2 + hstepB, voffB); PG8_STAGE(PG8_SA(0, 0), a2, voffA);
            PG8_WAIT_V(8); PG8_WAIT_L(0); PG8_BAR; PG8_MMA(1, 0, At, B0); PG8_MMA(1, 1, At, B1); PG8_BAR; PG8_SCHED;
            PG8_LDB(B0, 1, 0); PG8_LDB(B1, 1, 1); PG8_SCHED; PG8_LDA(At, 1, 0); PG8_STAGE(PG8_SA(0, 1), a2 + hstepA, voffA);
            PG8_WAIT_V(8); PG8_WAIT_L(0); PG8_BAR; PG8_MMA(0, 0, At, B0); PG8_MMA(0, 1, At, B1); PG8_BAR; PG8_SCHED;
            PG8_LDA(At, 1, 1); PG8_STAGE(PG8_SB(1, 0), b3, voffB); PG8_STAGE(PG8_SB(1, 1), b3 + hstepB, voffB); PG8_STAGE(PG8_SA(1, 0), a3, voffA);
            PG8_WAIT_V(8); PG8_WAIT_L(0); PG8_BAR; PG8_MMA(1, 0, At, B0); PG8_MMA(1, 1, At, B1); PG8_BAR; PG8_SCHED;
        }
        if constexpr (ALIGN_EPI) { if (wr == 0) PG8_BAR; }
        E(acc, cur, wr, wc, fr, fq);
        if (!has_next) break;
#pragma unroll
        for (int a = 0; a < 2; ++a)
#pragma unroll
            for (int b = 0; b < 2; ++b)
#pragma unroll
                for (int m = 0; m < 4; ++m)
#pragma unroll
                    for (int n = 0; n < 2; ++n) acc[a][b][m][n] = (f32x4){0.f, 0.f, 0.f, 0.f};
        cur = nxt; cA = nA; cB = nB; ++ui;
        if constexpr (ALIGN_EPI) { if (wr == 1) PG8_BAR; }
    }
    PG8_WAIT_V(0);
    if constexpr (!ALIGN_EPI) { if (wr == 0) PG8_BAR; }
    PG8_BAR;
#undef PG8_SA
#undef PG8_SB
#undef PG8_STAGE
#undef PG8_LDA
#undef PG8_LDB
#undef PG8_MMA
#undef PG8_WAIT_V
#undef PG8_WAIT_L
#undef PG8_BAR
#undef PG8_SCHED
#undef PG8_APTR
}
}

struct TrDesc { const float* src; bf16_t* dst; const float* ks; int ldsrc, ldd; float scale; };
__device__ __forceinline__ TrDesc tr_desc(const Params& p, int it) {
    constexpr int T0 = 1536, T1 = T0 + 2048, T2 = T1 + 2048, T3 = T2 + 512, T4 = T3 + 512, T5 = T4 + 1024, T6 = T5 + 64, T7 = T6 + 64;
    const int l = it / T7, r = it % T7;
    bf16_t* Wl = p.W_() + (size_t)l * WL;
    TrDesc d; d.scale = 1.f; d.ks = nullptr;
    int k0, c0, r0, kd0; const float* src; bf16_t* dst;
    if (r < T0)      { const int q = r;      src = p.w_in + (size_t)l * D * NIN; d.ldsrc = NIN; k0 = (q & 31) * 64; c0 = (q >> 5) * 64; dst = Wl + W1_OFF; d.ldd = D; r0 = (q >> 5) * 64; kd0 = k0; d.ks = p.norm_g + (size_t)l * D; }
    else if (r < T1) { const int q = r - T0; src = p.w_in + (size_t)l * D * NIN; d.ldsrc = NIN; k0 = (q & 31) * 64; c0 = 3080 + (q >> 5) * 64; dst = Wl + W1_OFF; d.ldd = D; r0 = 3072 + (q >> 5) * 64; kd0 = k0; d.ks = p.norm_g + (size_t)l * D; }
    else if (r < T2) { const int q = r - T1, ct = q >> 5;
                       src = p.w_gate + (size_t)l * D * 4096; d.ldsrc = 4096; k0 = (q & 31) * 64; c0 = (((ct & 3) < 2) ? 0 : 2048) + 128 * (ct >> 2) + (ct & 1) * 64; dst = Wl + W1_OFF; d.ldd = D; r0 = C_GM + ct * 64; kd0 = k0; d.ks = p.norm_g + (size_t)l * D; }
    else if (r < T3) { const int q = r - T2; src = p.w_pm + (size_t)l * WM * D; d.ldsrc = D; k0 = (q & 15) * 64; c0 = (q >> 4) * 64; dst = Wl + W3_OFF; d.ldd = D; r0 = c0; kd0 = k0; }
    else if (r < T4) { const int q = r - T3; src = p.w_pr + (size_t)l * WM * D; d.ldsrc = D; k0 = (q & 15) * 64; c0 = (q >> 4) * 64; dst = Wl + W3_OFF; d.ldd = D; r0 = c0; kd0 = 1024 + k0; }
    else if (r < T5) { const int q = r - T4; src = p.w_o + (size_t)l * D * D; d.ldsrc = D; k0 = (q & 31) * 64; c0 = (q >> 5) * 64; dst = Wl + W4_OFF; d.ldd = D; r0 = c0; kd0 = k0; }
    else if (r < T6) { const int q = r - T5, h = q >> 4, qq = q & 15; src = p.w_qm + ((size_t)l * HM + h) * SZ; d.ldsrc = DH; k0 = (qq & 3) * 64; c0 = (qq >> 2) * 64; dst = Wl + W2_OFF; d.ldd = DH; r0 = h * 512 + c0; kd0 = k0; d.scale = 0.0625f; }
    else             { const int q = r - T6, h = q >> 4, qq = q & 15; src = p.w_km + ((size_t)l * HM + h) * SZ; d.ldsrc = DH; k0 = (qq & 3) * 64; c0 = (qq >> 2) * 64; dst = Wl + W2_OFF; d.ldd = DH; r0 = h * 512 + 256 + c0; kd0 = k0; }
    d.src = src + (size_t)k0 * d.ldsrc + c0; d.dst = dst + (size_t)r0 * d.ldd + kd0; if (d.ks) d.ks += k0;
    return d;
}
__device__ __forceinline__ void tr_load(const TrDesc& d, f32x4 (&v)[16], f32x4 (&ks)[2], int lane) {
#pragma unroll
    for (int i = 0; i < 16; ++i) v[i] = __builtin_nontemporal_load((const f32x4*)(d.src + (size_t)((lane >> 4) + 4 * i) * d.ldsrc + 4 * (lane & 15)));
    if (d.ks) { ks[0] = *(const f32x4*)(d.ks + 8 * (lane & 7)); ks[1] = *(const f32x4*)(d.ks + 8 * (lane & 7) + 4); }
    else { ks[0] = (f32x4){1.f, 1.f, 1.f, 1.f}; ks[1] = ks[0]; }
}
__device__ __forceinline__ void tr_store(const TrDesc& d, const f32x4 (&v)[16], const f32x4 (&ks)[2], LAS float* t, int lane) {
#pragma unroll
    for (int i = 0; i < 16; ++i)
#pragma unroll
        for (int j = 0; j < 4; ++j) t[((lane >> 4) + 4 * i) * 65 + 4 * (lane & 15) + j] = v[i][j];
    const int c = lane & 7;
    const f32x4 s0 = ks[0] * d.scale, s1 = ks[1] * d.scale;
#pragma unroll
    for (int j = 0; j < 8; ++j) { const int n = (lane >> 3) + 8 * j; const LAS float* q = t + (8 * c) * 65 + n;
        u32x4 o; o.x = pk2(s0[0] * q[0], s0[1] * q[65]); o.y = pk2(s0[2] * q[130], s0[3] * q[195]); o.z = pk2(s1[0] * q[260], s1[1] * q[325]); o.w = pk2(s1[2] * q[390], s1[3] * q[455]);
        *(u32x4*)(d.dst + (size_t)n * d.ldd + 8 * c) = o; }
}
template <class Map>
__device__ __forceinline__ void tr_run(const Params& p, int j, const int step, const int nj, LAS unsigned char* lds, Map map) {
    const int tid = opaque_tid();
    const int lane = tid & 63, wid = tid >> 6;
    LAS float* t = (LAS float*)lds + wid * (64 * 65);
    if (j < nj) {
        TrDesc d = tr_desc(p, map(j));
        f32x4 v[16], ks[2];
        tr_load(d, v, ks, lane);
        for (;;) {
            const int j2 = j + step;
            const bool has = j2 < nj;
            TrDesc d2 = d; f32x4 v2[16], ks2[2];
            if (has) { d2 = tr_desc(p, map(j2)); tr_load(d2, v2, ks2, lane); }
            tr_store(d, v, ks, t, lane);
            if (!has) break;
#pragma unroll
            for (int i = 0; i < 16; ++i) v[i] = v2[i];
            ks[0] = ks2[0]; ks[1] = ks2[1]; d = d2; j = j2;
        }
    }
}
constexpr int G1_UNITS = (MPAD / 256) * (N1 / 256), TR_DEF_PER_WAVE = 4;
__device__ __forceinline__ int g1_rem(int nwg) { return G1_UNITS % nwg; }
__device__ __forceinline__ int tr_def(int nwg) { const int r = g1_rem(nwg); const int d = r ? (nwg - r) * 8 * TR_DEF_PER_WAVE : 0; return d < 2048 ? d : 2048; }
__device__ __forceinline__ void prep_phase(const Params& p, int wg, int nwg, LAS unsigned char* lds) {
    const int tid = opaque_tid();
    {
        const int lane = tid & 63, wid = tid >> 6;
        for (int row = wg * 8 + wid; row < MPAD; row += nwg * 8) {
            u32x2* hrow = (u32x2*)(p.Xb_() + (size_t)row * D);
            float ss = 0.f;
            if (row < MT) {
                const f32x4* xr = (const f32x4*)(row < MP ? p.x_prompt + (size_t)row * D : p.x_sample + (size_t)(row - MP) * D);
#pragma unroll
                for (int i = 0; i < 8; ++i) { const f32x4 v = xr[lane + 64 * i]; ss += (v[0] * v[0] + v[1] * v[1]) + (v[2] * v[2] + v[3] * v[3]); hrow[lane + 64 * i] = (u32x2){pk2(v[0], v[1]), pk2(v[2], v[3])}; }
                ss = wave_sum(ss);
            } else {
#pragma unroll
                for (int i = 0; i < 8; ++i) hrow[lane + 64 * i] = (u32x2){0u, 0u};
            }
            if (lane < 5) p.SS_()[(size_t)lane * MPAD + row] = lane == 0 ? ss_fix(ss) : 0ull;
            if (row < MP && lane < 8) p.SSP_()[(size_t)row * 8 + lane] = lane == 0 ? ss : 0.f;
        }
    }
    for (int i = wg * 512 + tid; i < 2049 * 128; i += nwg * 512) {
        const int pi = i >> 7, j = i & 127;
        const float pos = pi < 2048 ? (float)pi : 16384.0f;
        const float inv = powf(10000.0f, -((float)j / 128.0f));
        const float ang = pos * inv;
        p.ROPE_()[2 * i] = (float)cos((double)ang); p.ROPE_()[2 * i + 1] = (float)sin((double)ang);
    }
    for (int i = wg * 512 + tid; i < DEPTH * 256 * D; i += nwg * 512) {
        const int l = i / (256 * D), r = i % (256 * D), j = r / D, k = r % D;
        p.W_()[(size_t)l * WL + W1_OFF + (size_t)(11264 + j) * D + k] = j < 8 ? f2bf(p.w_in[((size_t)l * D + k) * NIN + 3072 + j] * p.norm_g[(size_t)l * D + k]) : (bf16_t)0;
    }
    const int def = tr_def(nwg), rest = 7808 - def;
    tr_run(p, wg * 8 + (tid >> 6), nwg * 8, 7808 + (DEPTH - 1) * rest - def, lds, [=](int j) { if (j < 7808) return j; const int q = j - 7808, l = q / rest; int r = def + (q - l * rest); if (l == DEPTH - 2 && r >= 5632) r += def; return (l + 1) * 7808 + r; });
}

__device__ __forceinline__ void final_phase(const Params& p, int wg, int nwg) {
    const int tid_ = opaque_tid(), lane = tid_ & 63, wid = tid_ >> 6;
    const f32x4* g4 = (const f32x4*)p.final_g;
    for (int row = wg * 8 + wid; row < MT; row += nwg * 8) {
        const u32x2* xr = (const u32x2*)(p.Xb_() + (size_t)row * D);
        f32x4* yr = (f32x4*)(p.out + (row < MP ? O_YP + (size_t)row * D : O_YS + (size_t)(row - MP) * D));
        const float rstd = rsqrtf(row_ss(p.SSP_(), p.SS_() + (size_t)4 * MPAD, row) * (1.0f / D) + EPS);
#pragma unroll
        for (int i = 0; i < 8; ++i) { const u32x2 xb = xr[lane + 64 * i];
            const f32x4 v = (f32x4){__uint_as_float(xb.x << 16), __uint_as_float(xb.x & 0xffff0000u), __uint_as_float(xb.y << 16), __uint_as_float(xb.y & 0xffff0000u)};
            yr[lane + 64 * i] = v * rstd * g4[lane + 64 * i]; }
    }
}

__device__ __forceinline__ void unpack8(const u32x4 v, float (&f)[8]) {
    f[0] = __uint_as_float(v.x << 16); f[1] = __uint_as_float(v.x & 0xffff0000u); f[2] = __uint_as_float(v.y << 16); f[3] = __uint_as_float(v.y & 0xffff0000u);
    f[4] = __uint_as_float(v.z << 16); f[5] = __uint_as_float(v.z & 0xffff0000u); f[6] = __uint_as_float(v.w << 16); f[7] = __uint_as_float(v.w & 0xffff0000u);
}
__device__ __forceinline__ u32x4 pack8(const float (&f)[8]) { u32x4 w; w.x = pk2(f[0], f[1]); w.y = pk2(f[2], f[3]); w.z = pk2(f[4], f[5]); w.w = pk2(f[6], f[7]); return w; }

__device__ __forceinline__ void gate_all(const Params& p, int layer, int bh, LAS float* G);
__device__ __forceinline__ void conv_phase(const Params& p, int layer, int wg, int nwg, LAS unsigned char* lds) {
    const int tid = opaque_tid();
    for (int bh = wg; bh < 16; bh += nwg) gate_all(p, layer, bh, (LAS float*)lds);
    const float* cw = p.conv_w + (size_t)layer * 4 * WM;
    const float* cb = p.conv_b + (size_t)layer * WM;
    const int cwg = nwg > 32 ? wg - 16 : wg, cnw = nwg > 32 ? nwg - 16 : nwg;
    if (cwg >= 0) {
        constexpr int CR = 2;
        const int ch = (tid & 127) * 8;
        float w[4][8], bs[8];
#pragma unroll
        for (int i = 0; i < 4; ++i) { const f32x4 a = *(const f32x4*)(cw + i * WM + ch), c = *(const f32x4*)(cw + i * WM + ch + 4);
            w[i][0] = a[0]; w[i][1] = a[1]; w[i][2] = a[2]; w[i][3] = a[3]; w[i][4] = c[0]; w[i][5] = c[1]; w[i][6] = c[2]; w[i][7] = c[3]; }
        { const f32x4 a = *(const f32x4*)(cb + ch), c = *(const f32x4*)(cb + ch + 4); bs[0] = a[0]; bs[1] = a[1]; bs[2] = a[2]; bs[3] = a[3]; bs[4] = c[0]; bs[5] = c[1]; bs[6] = c[2]; bs[7] = c[3]; }
#pragma unroll 1
        for (int blk = cwg * 4 + (tid >> 7); blk < MP / CR; blk += cnw * 4) {
            const int row = blk * CR, t = row & (SEQ - 1);
            float up[CR + 3][8];
#pragma unroll
            for (int i = 0; i < CR + 3; ++i) {
                if (t - 3 + i >= 0) unpack8(*(const u32x4*)(p.P_() + (size_t)(row - 3 + i) * NP + C_U + ch), up[i]);
                else {
#pragma unroll
                    for (int j = 0; j < 8; ++j) up[i][j] = 0.f;
                }
            }
#pragma unroll
            for (int r = 0; r < CR; ++r) {
                if (t + r >= SEQ - 3) {
                    float* o = p.out + O_CVP + (((size_t)layer * BP + (row >> 11)) * 3 + (t + r - (SEQ - 3))) * WM + ch;
                    *(f32x4*)o = (f32x4){up[r + 3][0], up[r + 3][1], up[r + 3][2], up[r + 3][3]}; *(f32x4*)(o + 4) = (f32x4){up[r + 3][4], up[r + 3][5], up[r + 3][6], up[r + 3][7]};
                }
                float q[8];
#pragma unroll
                for (int j = 0; j < 8; ++j) q[j] = bs[j];
#pragma unroll
                for (int i = 0; i < 4; ++i)
#pragma unroll
                    for (int j = 0; j < 8; ++j) q[j] += up[r + i][j] * w[i][j];
#pragma unroll
                for (int j = 0; j < 8; ++j) q[j] = siluf_(q[j]);
                *(u32x4*)(p.CM_() + (size_t)(row + r) * WM + ch) = pack8(q);
            }
        }
        for (int it = (cnw - 1 - cwg) * 512 + tid; it < BS * 128; it += cnw * 512) {
            const int b = it >> 7, row = MP + b;
            float up[4][8];
            const float* hist = p.st_conv + ((size_t)layer * BS + b) * 3 * WM + ch;
#pragma unroll
            for (int i = 0; i < 3; ++i) { const f32x4 a = *(const f32x4*)(hist + (size_t)i * WM), c = *(const f32x4*)(hist + (size_t)i * WM + 4);
                up[i][0] = a[0]; up[i][1] = a[1]; up[i][2] = a[2]; up[i][3] = a[3]; up[i][4] = c[0]; up[i][5] = c[1]; up[i][6] = c[2]; up[i][7] = c[3]; }
            unpack8(*(const u32x4*)(p.P_() + (size_t)row * NP + C_U + ch), up[3]);
            float* o = p.out + O_CVS + ((size_t)layer * BS + b) * 3 * WM + ch;
#pragma unroll
            for (int i = 0; i < 3; ++i) { *(f32x4*)(o + (size_t)i * WM) = (f32x4){up[i + 1][0], up[i + 1][1], up[i + 1][2], up[i + 1][3]};
                *(f32x4*)(o + (size_t)i * WM + 4) = (f32x4){up[i + 1][4], up[i + 1][5], up[i + 1][6], up[i + 1][7]}; }
            float q[8];
#pragma unroll
            for (int j = 0; j < 8; ++j) q[j] = bs[j];
#pragma unroll
            for (int i = 0; i < 4; ++i)
#pragma unroll
                for (int j = 0; j < 8; ++j) q[j] += up[i][j] * w[i][j];
#pragma unroll
            for (int j = 0; j < 8; ++j) q[j] = siluf_(q[j]);
            *(u32x4*)(p.CM_() + (size_t)row * WM + ch) = pack8(q);
        }
    }
}

__device__ __forceinline__ void gate_all(const Params& p, int layer, int bh, LAS float* G) {
    const int tid = opaque_tid(), lane = tid & 63, wid = tid >> 6, b = bh >> 2, h = bh & 3;
    const float bi = p.b_i[layer * HM + h], bfv = p.b_f[layer * HM + h];
    float* gt = p.GT_() + (size_t)bh * 6208;
    float tb0[2], tb1[2], tg0[2], tg1[2], rm0[2], rm1[2];
#pragma unroll
    for (int q = 0; q < 2; ++q) {
        const int cc = wid + 8 * q;
        const size_t r0 = (size_t)b * SEQ + cc * 128 + 2 * lane;
        const float i0 = p.IF_()[r0 * 8 + h] + bi, i1 = p.IF_()[(r0 + 1) * 8 + h] + bi;
        const float l0 = logsigf_(p.IF_()[r0 * 8 + 4 + h] + bfv), l1 = logsigf_(p.IF_()[(r0 + 1) * 8 + 4 + h] + bfv);
        float inc = l0 + l1;
#pragma unroll
        for (int o = 1; o < 64; o <<= 1) { const float t = __shfl_up(inc, o); if (lane >= o) inc += t; }
        const float exc = inc - (l0 + l1);
        tb0[q] = exc + l0; tb1[q] = inc;
        tg0[q] = i0 - tb0[q]; tg1[q] = i1 - tb1[q];
        const float gm = wave_max(fmaxf(tg0[q], tg1[q]));
        const float Bc = __shfl(inc, 63);
        if (lane == 0) { G[cc] = Bc; G[16 + cc] = gm; }
        float rm = fmaxf(tg0[q], tg1[q]);
#pragma unroll
        for (int o = 1; o < 64; o <<= 1) { const float t = __shfl_up(rm, o); if (lane >= o) rm = fmaxf(rm, t); }
        float ex = __shfl_up(rm, 1); if (lane == 0) ex = -3.0e38f;
        rm0[q] = fmaxf(ex, tg0[q]); rm1[q] = fmaxf(rm0[q], tg1[q]);
    }
    __syncthreads();
    if (tid == 0) { float m = -1e30f;
#pragma unroll 1
        for (int cc = 0; cc < 16; ++cc) { G[32 + cc] = m; m = G[cc] + fmaxf(m, G[16 + cc]); } G[48] = m; }
    __syncthreads();
#pragma unroll
    for (int q = 0; q < 2; ++q) {
        const int cc = wid + 8 * q, t0 = cc * 128 + 2 * lane;
        const float mc = G[32 + cc];
        *(f32x2_t*)(gt + t0) = (f32x2_t){tb0[q], tb1[q]}; *(f32x2_t*)(gt + 2048 + t0) = (f32x2_t){tg0[q], tg1[q]};
        *(f32x2_t*)(gt + 4096 + t0) = (f32x2_t){fmaxf(rm0[q], mc), fmaxf(rm1[q], mc)};
    }
    if (tid < 16) { gt[6144 + tid] = G[tid]; gt[6160 + tid] = G[16 + tid]; }
    if (tid < 17) gt[6176 + tid] = G[32 + tid];
    __syncthreads();
}
__device__ __forceinline__ void gate_load(const Params& p, int bh, int c, LAS float* G, int tid) {
    const float* gt = p.GT_() + (size_t)bh * 6208;
    if (tid < 128) { G[64 + tid] = gt[c * 128 + tid]; G[192 + tid] = gt[2048 + c * 128 + tid]; G[320 + tid] = gt[4096 + c * 128 + tid]; }
    if (tid == 0) G[32 + c] = gt[6176 + c];
    __syncthreads();
}

template <int I> struct IC { static constexpr int value = I; };
template <int I, int N, class F> __device__ __forceinline__ void sfor(F&& f) { if constexpr (I < N) { f(IC<I>{}); sfor<I + 1, N>(f); } }

template <int CPR>
__device__ __forceinline__ void tile_load(u32x4 (&r)[8], const bf16_t* src, int ld_src, int tid) {
#pragma unroll
    for (int i = 0; i < 8; ++i) { const int id = tid + 512 * i, row = id / CPR, ch = id % CPR; r[i] = *(const u32x4*)(src + (size_t)row * ld_src + ch * 8); }
}
template <int CPR, int LDB>
__device__ __forceinline__ void tile_store(LAS unsigned char* dst, const u32x4 (&r)[8], int tid) {
#pragma unroll
    for (int i = 0; i < 8; ++i) { const int id = tid + 512 * i, row = id / CPR, ch = id % CPR; *(LAS u32x4*)(dst + row * LDB + ch * 16) = r[i]; }
}
__device__ __forceinline__ void tile_store_w(LAS unsigned char* dst, const u32x4 (&r)[8], LAS const float* w, int tid) {
#pragma unroll
    for (int i = 0; i < 8; ++i) { const int id = tid + 512 * i, row = id >> 5, ch = id & 31; float f[8]; unpack8(r[i], f); const float ww = w[row];
#pragma unroll
        for (int j = 0; j < 8; ++j) f[j] *= ww;
        *(LAS u32x4*)(dst + row * 544 + ch * 16) = pack8(f); }
}
template <int OFF, int HS>
__device__ __forceinline__ bf16x8 tr_frag1(unsigned base) {
    u32x2 l0, h0;
    asm volatile("ds_read_b64_tr_b16 %0, %2 offset:%3\n\tds_read_b64_tr_b16 %1, %2 offset:%4\n\ts_waitcnt lgkmcnt(0)"
                 : "=&v"(l0), "=&v"(h0) : "v"(base), "i"(OFF), "i"(OFF + HS) : "memory");
    const u32x4 v = (u32x4){l0.x, l0.y, h0.x, h0.y};
    return __builtin_bit_cast(bf16x8, v);
}
template <int OFF, int HS, int TS>
__device__ __forceinline__ void tr_frag2(unsigned base, bf16x8& f0, bf16x8& f1) {
    u32x2 l0, l1, h0, h1;
    asm volatile("ds_read_b64_tr_b16 %0, %4 offset:%5\n\tds_read_b64_tr_b16 %2, %4 offset:%6\n\t"
                 "ds_read_b64_tr_b16 %1, %4 offset:%7\n\tds_read_b64_tr_b16 %3, %4 offset:%8\n\t"
                 "s_waitcnt lgkmcnt(0)"
                 : "=&v"(l0), "=&v"(l1), "=&v"(h0), "=&v"(h1)
                 : "v"(base), "i"(OFF), "i"(OFF + HS), "i"(OFF + TS), "i"(OFF + TS + HS)
                 : "memory");
    f0 = __builtin_bit_cast(bf16x8, (u32x4){l0.x, l0.y, h0.x, h0.y}); f1 = __builtin_bit_cast(bf16x8, (u32x4){l1.x, l1.y, h1.x, h1.y});
}
template <int OFF, int HS, int TS>
__device__ __forceinline__ void tr_frag4(unsigned base, bf16x8 (&f)[4]) {
    u32x2 l0, l1, l2, l3, h0, h1, h2, h3;
    asm volatile("ds_read_b64_tr_b16 %0, %8 offset:%9\n\tds_read_b64_tr_b16 %4, %8 offset:%10\n\t"
                 "ds_read_b64_tr_b16 %1, %8 offset:%11\n\tds_read_b64_tr_b16 %5, %8 offset:%12\n\t"
                 "ds_read_b64_tr_b16 %2, %8 offset:%13\n\tds_read_b64_tr_b16 %6, %8 offset:%14\n\t"
                 "ds_read_b64_tr_b16 %3, %8 offset:%15\n\tds_read_b64_tr_b16 %7, %8 offset:%16\n\t"
                 "s_waitcnt lgkmcnt(0)"
                 : "=&v"(l0), "=&v"(l1), "=&v"(l2), "=&v"(l3), "=&v"(h0), "=&v"(h1), "=&v"(h2), "=&v"(h3)
                 : "v"(base), "i"(OFF), "i"(OFF + HS), "i"(OFF + TS), "i"(OFF + TS + HS), "i"(OFF + 2 * TS), "i"(OFF + 2 * TS + HS), "i"(OFF + 3 * TS), "i"(OFF + 3 * TS + HS)
                 : "memory");
    f[0] = __builtin_bit_cast(bf16x8, (u32x4){l0.x, l0.y, h0.x, h0.y}); f[1] = __builtin_bit_cast(bf16x8, (u32x4){l1.x, l1.y, h1.x, h1.y});
    f[2] = __builtin_bit_cast(bf16x8, (u32x4){l2.x, l2.y, h2.x, h2.y}); f[3] = __builtin_bit_cast(bf16x8, (u32x4){l3.x, l3.y, h3.x, h3.y});
}
__device__ __forceinline__ unsigned lds_addr(LAS const void* p) { return (unsigned)(size_t)p; }

template <int NR, int NC, bool WEIGHT>
__device__ __forceinline__ void stage_T(LAS unsigned char* dst, int ldd_bytes, const bf16_t* src, int ld_src, LAS const float* w) {
    const int tid_ = opaque_tid(), lane = tid_ & 63, wid = tid_ >> 6;
    constexpr int PB = NR / 128, CG = NC / 8;
#pragma unroll 1
    for (int task = wid; task < PB * CG; task += 8) {
        const int pb = task % PB, cg = task / PB, r = pb * 128 + 2 * lane;
        float a[8], c[8];
        unpack8(*(const u32x4*)(src + (size_t)r * ld_src + cg * 8), a); unpack8(*(const u32x4*)(src + (size_t)(r + 1) * ld_src + cg * 8), c);
        float w0 = 1.f, w1 = 1.f; if (WEIGHT) { w0 = w[r]; w1 = w[r + 1]; }
#pragma unroll
        for (int j = 0; j < 8; ++j) *(LAS unsigned*)(dst + (cg * 8 + j) * ldd_bytes + r * 2) = pk2(a[j] * w0, c[j] * w1);
    }
}
__device__ __forceinline__ void stage_rows(LAS unsigned char* dst, const bf16_t* src, int ld_src) {
    const int tid_ = opaque_tid();
#pragma unroll
    for (int i = 0; i < 8; ++i) { const int id = tid_ + 512 * i, row = id >> 5, ch = id & 31;
        *(LAS u32x4*)(dst + row * 528 + ch * 16) = *(const u32x4*)(src + (size_t)row * ld_src + ch * 8); }
}
__device__ __forceinline__ bf16x8 lds_frag(LAS const unsigned char* base, int row, int ld_bytes, int kbyte) { return *(LAS const bf16x8*)(base + row * ld_bytes + kbyte); }
__device__ __forceinline__ float ret_lg(int h) { return logf(1.0f - exp2f(-5.0f - (float)h)); }

template <int BR>
__device__ __forceinline__ void chunk_passA(const Params& p, int layer, int b, int h, int c, LAS unsigned char* lds) {
    LAS unsigned char* Xt = lds; LAS unsigned char* Yt = lds + 69632; LAS float* G = (LAS float*)(lds + 139264); LAS float* wk = G + 512;
    const int tid = opaque_tid(), lane = tid & 63, w = __builtin_amdgcn_readfirstlane(tid >> 6), g = lane >> 4, lr = lane & 15;
    const size_t row0 = (size_t)b * SEQ + c * 128;
    const int pi = BR * 16 + b * 4 + h;
    const bf16_t* Xp = BR == 0 ? p.QK_() + row0 * 2048 + h * 512 + 256 : p.P_() + row0 * NP + C_VR + h * 256;
    const bf16_t* Yp = BR == 0 ? p.P_() + row0 * NP + C_VM + h * 256 : p.P_() + row0 * NP + C_KR + h * 256;
    u32x4 xr[8], yr[8];
    tile_load<32>(xr, Xp, BR == 0 ? 2048 : NP, tid); tile_load<32>(yr, Yp, NP, tid);
    if (BR == 0) { gate_load(p, b * 4 + h, c, G, tid); if (tid < 128) wk[tid] = expf(G[192 + tid] - G[320 + 127]); }
    else { if (tid < 128) wk[tid] = expf((float)(127 - tid) * ret_lg(h)); }
    __syncthreads();
    tile_store<32, 544>(Xt, xr, tid); tile_store_w(Yt, yr, wk, tid);
    __syncthreads();
    const unsigned lpart = (unsigned)(((8 * g + (lr >> 2)) * 272 + 4 * (lr & 3)) * 2);
    const unsigned baseX = lds_addr(Xt) + lpart + (unsigned)(32 * w * 2), baseY = lds_addr(Yt) + lpart;
    bf16_t* Uo = p.U_() + ((size_t)pi * 16 + c) * SZ;
    sfor<0, 2>([&](auto rt_) {
        constexpr int rt = decltype(rt_)::value;
        f32x4 acc[16];
#pragma unroll
        for (int j = 0; j < 16; ++j) acc[j] = (f32x4){0.f, 0.f, 0.f, 0.f};
        sfor<0, 4>([&](auto ks_) {
            constexpr int ks = decltype(ks_)::value;
            const bf16x8 fa = tr_frag1<ks * 32 * 544 + rt * 32, 4 * 544>(baseX);
            sfor<0, 4>([&](auto cq_) {
                constexpr int cq = decltype(cq_)::value;
                bf16x8 fb[4];
                tr_frag4<ks * 32 * 544 + cq * 128, 4 * 544, 32>(baseY, fb);
#pragma unroll
                for (int i = 0; i < 4; ++i) acc[4 * cq + i] = __builtin_amdgcn_mfma_f32_16x16x32_bf16(fa, fb[i], acc[4 * cq + i], 0, 0, 0);
            });
        });
#pragma unroll
        for (int ct = 0; ct < 16; ++ct)
            *(u32x2*)(Uo + (size_t)(16 * ct + lr) * 256 + 32 * w + 16 * rt + 4 * g) = (u32x2){pk2(acc[ct][0], acc[ct][1]), pk2(acc[ct][2], acc[ct][3])};
    });
    if (BR == 0 && tid < 256) {
        float sacc = 0.f;
        for (int ss = 0; ss < 128; ++ss) sacc += wk[ss] * bf2f(*(LAS const bf16_t*)(Xt + ss * 544 + tid * 2));
        p.NU_()[((size_t)(b * 4 + h) * 16 + c) * 256 + tid] = sacc;
    }
    __syncthreads();
}

template <int BR>
__device__ __forceinline__ void chunk_state_item(const Params& p, int layer, int b, int h, int sl, LAS unsigned char* lds) {
    LAS unsigned char* Xt = lds;
    LAS unsigned char* Ys = lds + 69632;
    LAS float* wka = (LAS float*)(lds + 79872);
    LAS float* dec = wka + 2048;
    const int tid = opaque_tid(), lane = tid & 63, w = __builtin_amdgcn_readfirstlane(tid >> 6), g = lane >> 4, lr = lane & 15;
    const int bh = b * 4 + h, pi = BR * 16 + bh;
    const float* gt = p.GT_() + (size_t)bh * 6208;
    if (BR == 0) {
#pragma unroll
        for (int i = 0; i < 4; ++i) { const int t = tid + 512 * i; wka[t] = expf(gt[2048 + t] - gt[4096 + (t | 127)]); }
        if (tid < 16) { const float mc = gt[6176 + tid]; dec[tid] = expf(mc - fmaxf(mc, gt[6160 + tid])); }
    } else {
        const float lg = ret_lg(h);
#pragma unroll
        for (int i = 0; i < 4; ++i) { const int t = tid + 512 * i; wka[t] = expf((float)(127 - (t & 127)) * lg); }
        if (tid < 16) dec[tid] = expf(128.0f * lg);
    }
    const size_t rowb = (size_t)b * SEQ;
    const bf16_t* Xp = BR == 0 ? p.QK_() + rowb * 2048 + h * 512 + 256 : p.P_() + rowb * NP + C_VR + h * 256;
    const int ldX = BR == 0 ? 2048 : NP;
    const bf16_t* Yp = (BR == 0 ? p.P_() + rowb * NP + C_VM + h * 256 : p.P_() + rowb * NP + C_KR + h * 256) + 32 * sl;
    const unsigned yoff = (unsigned)((tid >> 2) * NP + (tid & 3) * 8) * 2u;
    u32x4 xa[8], xb[8], ya, yb;
    tile_load<32>(xa, Xp, ldX, tid); ya = *(const u32x4*)((const char*)Yp + yoff);
    tile_load<32>(xb, Xp + (size_t)128 * ldX, ldX, tid); yb = *(const u32x4*)((const char*)(Yp + (size_t)128 * NP) + yoff);
    f32x4 st[2][2], nst[2];
#pragma unroll
    for (int i = 0; i < 2; ++i) { nst[i] = (f32x4){0.f, 0.f, 0.f, 0.f};
#pragma unroll
        for (int j = 0; j < 2; ++j) st[i][j] = (f32x4){0.f, 0.f, 0.f, 0.f}; }
    const unsigned lpart = (unsigned)(((8 * g + (lr >> 2)) * 272 + 4 * (lr & 3)) * 2), lparty = (unsigned)(((8 * g + (lr >> 2)) * 40 + 4 * (lr & 3)) * 2);
    const unsigned baseX = lds_addr(Xt) + lpart + (unsigned)(32 * w * 2), baseY = lds_addr(Ys) + lparty;
    bf16_t* CSp = p.CS_() + (size_t)pi * 16 * SZ + (size_t)(32 * sl + lr) * 256 + 32 * w + 4 * g;
    float* NSp = p.NS_() + (size_t)bh * 16 * 256 + 32 * w + 4 * g;
    const bool nown = (BR == 0) && (sl == 0) && (lr == 0);
    __syncthreads();
    auto step = [&](int c, u32x4 (&xr)[8], u32x4& yr) {
#pragma unroll
        for (int rt = 0; rt < 2; ++rt) {
#pragma unroll
            for (int ct = 0; ct < 2; ++ct) *(u32x2*)(CSp + (size_t)c * SZ + (size_t)(16 * ct) * 256 + 16 * rt) = (u32x2){pk2(st[rt][ct][0], st[rt][ct][1]), pk2(st[rt][ct][2], st[rt][ct][3])};
            if (nown) *(f32x4*)(NSp + (size_t)c * 256 + 16 * rt) = nst[rt];
        }
        tile_store<32, 544>(Xt, xr, tid);
        { float f[8]; unpack8(yr, f); const float ww = wka[c * 128 + (tid >> 2)];
#pragma unroll
          for (int j = 0; j < 8; ++j) f[j] *= ww;
          *(LAS u32x4*)(Ys + (tid >> 2) * 80 + (tid & 3) * 16) = pack8(f); }
        __syncthreads();
        if (c + 2 < 16) {
            tile_load<32>(xr, Xp + (size_t)(c + 2) * 128 * ldX, ldX, tid);
            yr = *(const u32x4*)((const char*)(Yp + (size_t)(c + 2) * 128 * NP) + yoff);
        }
        f32x4 u[2][2], un[2];
#pragma unroll
        for (int i = 0; i < 2; ++i) { un[i] = (f32x4){0.f, 0.f, 0.f, 0.f};
#pragma unroll
            for (int j = 0; j < 2; ++j) u[i][j] = (f32x4){0.f, 0.f, 0.f, 0.f}; }
        sfor<0, 4>([&](auto ks_) {
            constexpr int ks = decltype(ks_)::value;
            bf16x8 fa0, fa1, fb0, fb1;
            tr_frag2<ks * 32 * 544, 4 * 544, 32>(baseX, fa0, fa1);
            tr_frag2<ks * 32 * 80, 4 * 80, 32>(baseY, fb0, fb1);
            u[0][0] = __builtin_amdgcn_mfma_f32_16x16x32_bf16(fa0, fb0, u[0][0], 0, 0, 0); u[0][1] = __builtin_amdgcn_mfma_f32_16x16x32_bf16(fa0, fb1, u[0][1], 0, 0, 0);
            u[1][0] = __builtin_amdgcn_mfma_f32_16x16x32_bf16(fa1, fb0, u[1][0], 0, 0, 0); u[1][1] = __builtin_amdgcn_mfma_f32_16x16x32_bf16(fa1, fb1, u[1][1], 0, 0, 0);
            if (BR == 0) {
                const f32x4 w0 = *(LAS const f32x4*)(wka + c * 128 + 32 * ks + 8 * g), w1 = *(LAS const f32x4*)(wka + c * 128 + 32 * ks + 8 * g + 4);
                u32x4 wv = (u32x4){pk2(w0[0], w0[1]), pk2(w0[2], w0[3]), pk2(w1[0], w1[1]), pk2(w1[2], w1[3])};
                if (lr != 0) wv = (u32x4){0u, 0u, 0u, 0u};
                const bf16x8 wf = __builtin_bit_cast(bf16x8, wv);
                un[0] = __builtin_amdgcn_mfma_f32_16x16x32_bf16(fa0, wf, un[0], 0, 0, 0); un[1] = __builtin_amdgcn_mfma_f32_16x16x32_bf16(fa1, wf, un[1], 0, 0, 0);
            }
        });
        const float dc = dec[c];
#pragma unroll
        for (int i = 0; i < 2; ++i) { nst[i] = nst[i] * dc + un[i];
#pragma unroll
            for (int j = 0; j < 2; ++j) st[i][j] = st[i][j] * dc + u[i][j]; }
        __syncthreads();
    };
#pragma unroll 1
    for (int c = 0; c < 16; c += 2) { step(c, xa, ya); step(c + 1, xb, yb); }
    float* fo = p.out + (BR == 0 ? O_CP : O_SP) + (((size_t)layer * BP + b) * HM + h) * SZ + (size_t)(32 * sl + lr) * 256 + 32 * w + 4 * g;
#pragma unroll
    for (int rt = 0; rt < 2; ++rt) {
#pragma unroll
        for (int ct = 0; ct < 2; ++ct) *(f32x4*)(fo + (size_t)(16 * ct) * 256 + 16 * rt) = st[rt][ct];
        if (nown) *(f32x4*)(p.out + O_NP + (((size_t)layer * BP + b) * HM + h) * 256 + 32 * w + 4 * g + 16 * rt) = nst[rt];
    }
    if (BR == 0 && sl == 0 && tid == 0) p.out[O_MP + ((size_t)layer * BP + b) * HM + h] = gt[6192];
    __syncthreads();
}

__device__ __forceinline__ void scan_item(const Params& p, int layer, int pi, int slice, LAS unsigned char* lds) {
    LAS float* G = (LAS float*)lds; LAS float* dec = G + 512;
    const int tid = opaque_tid(), br = pi >> 4, bh = pi & 15, b = bh >> 2, h = bh & 3;
    if (br == 0) { const float* gt = p.GT_() + (size_t)bh * 6208; if (tid < 16) { const float mc = gt[6176 + tid]; dec[tid] = expf(mc - fmaxf(mc, gt[6160 + tid])); } if (tid == 0) G[48] = gt[6192]; }
    else if (tid < 16) dec[tid] = expf(128.0f * ret_lg(h));
    __syncthreads();
    float st[2][8];
#pragma unroll
    for (int j = 0; j < 2; ++j)
#pragma unroll
        for (int k = 0; k < 8; ++k) st[j][k] = 0.f;
    for (int c = 0; c < 16; ++c) {
        const float dc = dec[c];
#pragma unroll
        for (int j = 0; j < 2; ++j) { const size_t idx = (size_t)slice * 8192 + j * 4096 + tid * 8;
            float u[8]; unpack8(*(const u32x4*)(p.U_() + ((size_t)pi * 16 + c) * SZ + idx), u);
            *(u32x4*)(p.CS_() + ((size_t)pi * 16 + c) * SZ + idx) = pack8(st[j]);
#pragma unroll
            for (int k = 0; k < 8; ++k) st[j][k] = st[j][k] * dc + u[k]; }
    }
    float* fo = p.out + (br == 0 ? O_CP : O_SP) + (((size_t)layer * BP + b) * HM + h) * SZ;
#pragma unroll
    for (int j = 0; j < 2; ++j) { float* q = fo + (size_t)slice * 8192 + j * 4096 + tid * 8;
        *(f32x4*)q = (f32x4){st[j][0], st[j][1], st[j][2], st[j][3]}; *(f32x4*)(q + 4) = (f32x4){st[j][4], st[j][5], st[j][6], st[j][7]}; }
    if (br == 0 && slice == 0) {
        if (tid < 256) { float n = 0.f;
            for (int c = 0; c < 16; ++c) { p.NS_()[((size_t)bh * 16 + c) * 256 + tid] = n; n = dec[c] * n + p.NU_()[((size_t)bh * 16 + c) * 256 + tid]; }
            p.out[O_NP + (((size_t)layer * BP + b) * HM + h) * 256 + tid] = n; }
        if (tid == 0) p.out[O_MP + ((size_t)layer * BP + b) * HM + h] = G[48];
    }
    __syncthreads();
}

template <int BR>
__device__ __forceinline__ void chunk_passC(const Params& p, int layer, int b, int h, int c, LAS unsigned char* lds) {
    LAS unsigned char* BufB = lds; LAS unsigned char* Sw = lds + 69632; LAS float* G = (LAS float*)(lds + 104448);
    LAS float* av = G + 512; LAS float* fl = G + 640; LAS bf16_t* nbf = (LAS bf16_t*)(G + 768);
    const int tid = opaque_tid(), lane = tid & 63, w = __builtin_amdgcn_readfirstlane(tid >> 6), g = lane >> 4, lr = lane & 15;
    const size_t row0 = (size_t)b * SEQ + c * 128;
    const int pi = BR * 16 + b * 4 + h, l = 16 * w + lr;
    const float lg = ret_lg(h);
    u32x4 tr[8];
    tile_load<32>(tr, BR == 0 ? p.QK_() + row0 * 2048 + h * 512 + 256 : p.P_() + row0 * NP + C_KR + h * 256, BR == 0 ? 2048 : NP, tid);
    const bf16_t* Qp = BR == 0 ? p.QK_() + (row0 + l) * 2048 + h * 512 : p.P_() + (row0 + l) * NP + C_QR + h * 256;
    bf16x8 qf[8];
#pragma unroll
    for (int ks = 0; ks < 8; ++ks) qf[ks] = *(const bf16x8*)(Qp + 32 * ks + 8 * g);
    float gn_ = 0.f, sk_ = 0.f, ns_ = 0.f, g0_ = 0.f, g1_ = 0.f, g2_ = 0.f, mc_ = 0.f;
    if (tid < 256) { gn_ = ((BR == 0 ? p.hn_m_g : p.hn_r_g) + (size_t)layer * WM + h * 256)[tid];
        if (BR == 0) { sk_ = (p.skip_m + (size_t)layer * WM + h * 256)[tid]; ns_ = p.NS_()[((size_t)(b * 4 + h) * 16 + c) * 256 + tid]; } }
    if (BR == 0) { const float* gt = p.GT_() + (size_t)(b * 4 + h) * 6208;
        if (tid < 128) { g0_ = gt[c * 128 + tid]; g1_ = gt[2048 + c * 128 + tid]; g2_ = gt[4096 + c * 128 + tid]; }
        mc_ = gt[6176 + c]; }
    if (tid < 256) { G[1024 + tid] = gn_; if (BR == 0) { G[1280 + tid] = sk_; nbf[tid] = f2bf(ns_); } }
    if (BR == 0) {
        if (tid < 128) { G[64 + tid] = g0_; G[192 + tid] = g1_; G[320 + tid] = g2_; av[tid] = expf(mc_ - g2_); fl[tid] = expf(-(g0_ + g2_)); }
        if (tid == 0) G[32 + c] = mc_;
    } else { if (tid < 128) av[tid] = expf((float)(tid + 1) * lg); }
    tile_store<32, 544>(BufB, tr, tid);
    __syncthreads();
    const bf16_t* CSp = p.CS_() + ((size_t)pi * 16 + c) * SZ;
    if (BR == 0) tile_load<32>(tr, CSp, 256, tid); else tile_load<16>(tr, CSp, 256, tid);
    float rs = 0.f;
    const float Gl = BR == 0 ? G[320 + l] : 0.f;
#pragma unroll
    for (int j = 0; j < 8; ++j) {
        f32x4 a = (f32x4){0.f, 0.f, 0.f, 0.f};
        if (j <= w) {
#pragma unroll
            for (int ks = 0; ks < 8; ++ks) a = __builtin_amdgcn_mfma_f32_16x16x32_bf16(lds_frag(BufB, 16 * j + lr, 544, (32 * ks + 8 * g) * 2), qf[ks], a, 0, 0, 0);
        }
        float v[4];
#pragma unroll
        for (int r = 0; r < 4; ++r) {
            const int sidx = 16 * j + 4 * g + r;
            float d = 0.f;
            if (sidx <= l) d = BR == 0 ? expf(G[192 + sidx] - Gl) : expf((float)(l - sidx) * lg);
            v[r] = a[r] * d; rs += v[r];
        }
        *(LAS u32x2*)(Sw + l * 272 + (16 * j + 4 * g) * 2) = (u32x2){pk2(v[0], v[1]), pk2(v[2], v[3])};
        __builtin_amdgcn_sched_barrier(0);
    }
    rs += __shfl_xor(rs, 16); rs += __shfl_xor(rs, 32);
    __syncthreads();
    f32x4 accN[16];
#pragma unroll
    for (int t = 0; t < 16; ++t) accN[t] = (f32x4){0.f, 0.f, 0.f, 0.f};
    const unsigned lq = (unsigned)(8 * g + (lr >> 2)), lp4 = (unsigned)(4 * (lr & 3));
    sfor<0, 2>([&](auto half_) {
        constexpr int half = decltype(half_)::value;
        if (BR == 0) tile_store<32, 544>(BufB, tr, tid); else tile_store<16, 272>(BufB, tr, tid);
        __syncthreads();
        if (half == 0) { if (BR == 0) tile_load<32>(tr, CSp + 128 * 256, 256, tid); else tile_load<16>(tr, CSp + 128, 256, tid); }
        else tile_load<32>(tr, p.P_() + row0 * NP + (BR == 0 ? C_VM : C_VR) + h * 256, NP, tid);
        if (BR == 0) {
#pragma unroll
            for (int t = 0; t < 8; ++t) {
#pragma unroll
                for (int ks = 0; ks < 8; ++ks)
                    accN[half * 8 + t] = __builtin_amdgcn_mfma_f32_16x16x32_bf16(lds_frag(BufB, 16 * t + lr, 544, (32 * ks + 8 * g) * 2), qf[ks], accN[half * 8 + t], 0, 0, 0);
                __builtin_amdgcn_sched_barrier(0); }
        } else {
            const unsigned base = lds_addr(BufB) + (lq * 136 + lp4) * 2;
            sfor<0, 8>([&](auto ks_) {
                constexpr int ks = decltype(ks_)::value;
                sfor<0, 2>([&](auto tq_) {
                    constexpr int tq = decltype(tq_)::value;
                    bf16x8 f[4];
                    tr_frag4<ks * 32 * 272 + tq * 128, 4 * 272, 32>(base, f);
#pragma unroll
                    for (int i = 0; i < 4; ++i) accN[half * 8 + 4 * tq + i] = __builtin_amdgcn_mfma_f32_16x16x32_bf16(f[i], qf[ks], accN[half * 8 + 4 * tq + i], 0, 0, 0);
                });
            });
        }
        __syncthreads();
    });
    float nq = 0.f;
    if (BR == 0) {
        f32x4 ad = (f32x4){0.f, 0.f, 0.f, 0.f};
#pragma unroll
        for (int ks = 0; ks < 8; ++ks) {
            bf16x8 nf = *(LAS const bf16x8*)(nbf + 32 * ks + 8 * g);
            if (lr != 0) nf = (bf16x8){0, 0, 0, 0, 0, 0, 0, 0};
            ad = __builtin_amdgcn_mfma_f32_16x16x32_bf16(nf, qf[ks], ad, 0, 0, 0);
        }
        nq = __shfl(ad[0], lr);
    }
    const float al = av[l];
#pragma unroll
    for (int t = 0; t < 16; ++t) accN[t] *= al;
    tile_store<32, 544>(BufB, tr, tid);
    __syncthreads();
    {
        const unsigned base = lds_addr(BufB) + (lq * 272 + lp4) * 2;
        sfor<0, 4>([&](auto ks_) {
            constexpr int ks = decltype(ks_)::value;
            const bf16x8 bfr = lds_frag(Sw, l, 272, (32 * ks + 8 * g) * 2);
            sfor<0, 4>([&](auto tq_) {
                constexpr int tq = decltype(tq_)::value;
                bf16x8 f[4];
                tr_frag4<ks * 32 * 544 + tq * 128, 4 * 544, 32>(base, f);
#pragma unroll
                for (int i = 0; i < 4; ++i) accN[4 * tq + i] = __builtin_amdgcn_mfma_f32_16x16x32_bf16(f[i], bfr, accN[4 * tq + i], 0, 0, 0);
            });
        });
    }
    float inv = 1.0f;
    if (BR == 0) inv = 1.0f / fmaxf(fabsf(rs + al * nq), fl[l]);
    float sm = 0.f;
#pragma unroll
    for (int t = 0; t < 16; ++t) { accN[t] *= inv; sm += (accN[t][0] + accN[t][1]) + (accN[t][2] + accN[t][3]); }
    sm += __shfl_xor(sm, 16); sm += __shfl_xor(sm, 32);
    const float mu = sm * (1.0f / 256.0f);
    float qv = 0.f;
#pragma unroll
    for (int t = 0; t < 16; ++t) { const f32x4 d = accN[t] - mu; qv += (d[0] * d[0] + d[1] * d[1]) + (d[2] * d[2] + d[3] * d[3]); }
    qv += __shfl_xor(qv, 16); qv += __shfl_xor(qv, 32);
    const float rstd = rsqrtf(qv * (1.0f / 256.0f) + EPS);
    const int odd = g & 1, gp = 4 * (g & 2);
    const size_t row = row0 + l;
    const bf16_t* zp = p.P_() + row * NP + (BR == 0 ? C_ZM : C_ZR) + h * 256 + gp;
    const bf16_t* cp = p.CM_() + row * WM + h * 256 + gp;
    bf16_t* op = p.OC_() + row * 2048 + BR * 1024 + h * 256 + gp;
    LAS const float* gs = G + 1024 + gp; LAS const float* sks = G + 1280 + gp;
#pragma unroll
    for (int k = 0; k < 8; ++k) {
        f32x4 X = (accN[2 * k] - mu) * rstd, Y = (accN[2 * k + 1] - mu) * rstd;
        const f32x4 snd = odd ? X : Y; f32x4 rcv;
#pragma unroll
        for (int c2 = 0; c2 < 4; ++c2) rcv[c2] = __shfl_xor(snd[c2], 16);
        if (odd) X = rcv; else Y = rcv;
        const int ch = 16 * (2 * k + odd);
        const u32x4 zb = *(const u32x4*)(zp + ch);
        X *= *(LAS const f32x4*)(gs + ch); Y *= *(LAS const f32x4*)(gs + ch + 4);
        if (BR == 0) { const f32x4 s0 = *(LAS const f32x4*)(sks + ch), s1 = *(LAS const f32x4*)(sks + ch + 4); const u32x4 cb = *(const u32x4*)(cp + ch);
            X[0] += s0[0] * __uint_as_float(cb.x << 16); X[1] += s0[1] * __uint_as_float(cb.x & 0xffff0000u); X[2] += s0[2] * __uint_as_float(cb.y << 16); X[3] += s0[3] * __uint_as_float(cb.y & 0xffff0000u);
            Y[0] += s1[0] * __uint_as_float(cb.z << 16); Y[1] += s1[1] * __uint_as_float(cb.z & 0xffff0000u); Y[2] += s1[2] * __uint_as_float(cb.w << 16); Y[3] += s1[3] * __uint_as_float(cb.w & 0xffff0000u); }
        const float z0 = __uint_as_float(zb.x << 16), z1 = __uint_as_float(zb.x & 0xffff0000u), z2 = __uint_as_float(zb.y << 16), z3 = __uint_as_float(zb.y & 0xffff0000u);
        const float z4 = __uint_as_float(zb.z << 16), z5 = __uint_as_float(zb.z & 0xffff0000u), z6 = __uint_as_float(zb.w << 16), z7 = __uint_as_float(zb.w & 0xffff0000u);
        *(u32x4*)(op + ch) = (u32x4){pk2(X[0] * siluf_(z0), X[1] * siluf_(z1)), pk2(X[2] * siluf_(z2), X[3] * siluf_(z3)), pk2(Y[0] * siluf_(z4), Y[1] * siluf_(z5)), pk2(Y[2] * siluf_(z6), Y[3] * siluf_(z7))};
    }
    __syncthreads();
}

__device__ __forceinline__ f32x4 bf4_to_f32(u32x2 v) { return (f32x4){__uint_as_float(v.x << 16), __uint_as_float(v.x & 0xffff0000u), __uint_as_float(v.y << 16), __uint_as_float(v.y & 0xffff0000u)}; }
__device__ __forceinline__ const char* sample_state(const Params& p, int layer, int s) {
    const int br = s >> 9, b = (s >> 2) & 127, h = s & 3;
    return (const char*)((br == 0 ? p.st_C : p.st_S) + (((size_t)layer * BS + b) * HM + h) * SZ);
}
template <int BR>
__device__ __forceinline__ void sample_item(const Params& p, int layer, int b, int h, LAS float* base, const f32x4 (&cin)[8], f32x4 (&cnx)[8], const char* nsrc) {
    LAS float* sq = base; LAS float* sk = sq + 256; LAS float* sv = sk + 256; LAS float* sr = sv + 256; LAS float* part = sr + 256;
    LAS float* sz = part + 2048; LAS float* sge = sz + 256; LAS float* scm = sge + 256; LAS float* ssk = scm + 256; LAS float* sn = ssk + 256;
    const int tid = opaque_tid(), lane = tid & 63, wid = __builtin_amdgcn_readfirstlane(tid >> 6), e0 = 4 * lane;
    const size_t R = (size_t)MP + b;
    const size_t sidx = ((size_t)layer * BS + b) * HM + h;
    const bf16_t* qg = BR == 0 ? p.QK_() + R * 2048 + h * 512 : p.P_() + R * NP + C_QR + h * 256;
    const bf16_t* kg = BR == 0 ? p.QK_() + R * 2048 + h * 512 + 256 : p.P_() + R * NP + C_KR + h * 256;
    const bf16_t* vg = p.P_() + R * NP + (BR == 0 ? C_VM : C_VR) + h * 256;
    if (tid < 256) {
        const bf16_t zz = (p.P_() + R * NP + (BR == 0 ? C_ZM : C_ZR) + h * 256)[tid]; const float gg = ((BR == 0 ? p.hn_m_g : p.hn_r_g) + (size_t)layer * WM + h * 256)[tid];
        bf16_t cmv = 0; float skv = 0.f, nv = 0.f;
        if (BR == 0) { cmv = (p.CM_() + R * WM + h * 256)[tid]; skv = (p.skip_m + (size_t)layer * WM + h * 256)[tid]; nv = (p.st_n + sidx * 256)[tid]; }
        sq[tid] = bf2f(qg[tid]); sk[tid] = bf2f(kg[tid]); sv[tid] = bf2f(vg[tid]);
        sz[tid] = bf2f(zz); sge[tid] = gg; if (BR == 0) { scm[tid] = bf2f(cmv); ssk[tid] = skv; sn[tid] = nv; }
    }
    const f32x4 q4 = bf4_to_f32(*(const u32x2*)(qg + e0)), k4 = bf4_to_f32(*(const u32x2*)(kg + e0)), v4 = bf4_to_f32(*(const u32x2*)(vg + e0));
    float wgt = 1.f, a = 1.0f - exp2f(-5.0f - (float)h), mt = 0.f;
    if (BR == 0) {
        const float ig = p.IF_()[R * 8 + h] + p.b_i[layer * HM + h];
        const float lf = logsigf_(p.IF_()[R * 8 + 4 + h] + p.b_f[layer * HM + h]);
        const float inter = lf + p.st_m[sidx];
        mt = fmaxf(inter, ig); wgt = expf(ig - mt); a = expf(inter - mt);
    }
    const char* sb = sample_state(p, layer, (BR << 9) | (b << 2) | h) + (size_t)wid * 1024 + (unsigned)lane * 16u;
    char* ob = (char*)(p.out + (BR == 0 ? O_CS : O_SS) + sidx * SZ) + (size_t)wid * 1024 + (unsigned)lane * 16u;
    __syncthreads();
    f32x4 cc[8], cn[8];
#pragma unroll
    for (int j = 0; j < 8; ++j) cc[j] = cin[j];
    f32x4 ac = (f32x4){0.f, 0.f, 0.f, 0.f};
#pragma unroll
    for (int i0 = 0; i0 < 32; i0 += 8) {
        if (i0 + 8 < 32) {
#pragma unroll
            for (int j = 0; j < 8; ++j) cn[j] = __builtin_nontemporal_load((const f32x4*)(sb + (size_t)(i0 + 8 + j) * 8192));
        } else if (nsrc) {
            const char* nb = nsrc + (size_t)wid * 1024 + (unsigned)lane * 16u;
#pragma unroll
            for (int j = 0; j < 8; ++j) cnx[j] = __builtin_nontemporal_load((const f32x4*)(nb + (size_t)j * 8192));
        }
#pragma unroll
        for (int j = 0; j < 8; ++j) { const int e = wid + 8 * (i0 + j);
            if (BR == 0) {
                float pt = (cc[j][0] * q4[0] + cc[j][1] * q4[1]) + (cc[j][2] * q4[2] + cc[j][3] * q4[3]);
                __builtin_nontemporal_store(cc[j] * a + k4 * (wgt * sv[e]), (f32x4*)(ob + (size_t)(i0 + j) * 8192));
                pt = wave_sum(pt);
                if (lane == 0) sr[e] = pt;
            } else {
                ac = ac + cc[j] * sq[e];
                __builtin_nontemporal_store(cc[j] * a + v4 * sk[e], (f32x4*)(ob + (size_t)(i0 + j) * 8192));
            }
        }
        if (i0 + 8 < 32) {
#pragma unroll
            for (int j = 0; j < 8; ++j) cc[j] = cn[j];
        }
    }
    if (BR == 1) *(LAS f32x4*)(part + wid * 256 + e0) = ac;
    __syncthreads();
    if (wid == 0) {
        f32x4 hv;
        if (BR == 0) {
            const f32x4 n4 = *(LAS const f32x4*)(sn + e0);
            const f32x4 cq = *(LAS const f32x4*)(sr + e0);
            const float qk = wave_sum((q4[0] * k4[0] + q4[1] * k4[1]) + (q4[2] * k4[2] + q4[3] * k4[3]));
            const float nq = wave_sum((n4[0] * q4[0] + n4[1] * q4[1]) + (n4[2] * q4[2] + n4[3] * q4[3]));
            const float ws = wgt * qk, inv = 1.0f / fmaxf(fabsf(ws + a * nq), expf(-mt));
            hv = (v4 * ws + cq * a) * inv;
            *(f32x4*)(p.out + O_NS + sidx * 256 + e0) = n4 * a + k4 * wgt;
            if (lane == 0) p.out[O_MS + sidx] = mt;
        } else {
            f32x4 oi = (f32x4){0.f, 0.f, 0.f, 0.f};
#pragma unroll
            for (int i = 0; i < 8; ++i) oi = oi + *(LAS const f32x4*)(part + i * 256 + e0);
            const float qk = wave_sum((q4[0] * k4[0] + q4[1] * k4[1]) + (q4[2] * k4[2] + q4[3] * k4[3]));
            hv = v4 * qk + oi * a;
        }
        const float mean = wave_sum((hv[0] + hv[1]) + (hv[2] + hv[3])) * (1.0f / 256.0f);
        const f32x4 dv = hv - mean;
        const float rstd = rsqrtf(wave_sum((dv[0] * dv[0] + dv[1] * dv[1]) + (dv[2] * dv[2] + dv[3] * dv[3])) * (1.0f / 256.0f) + EPS);
        const f32x4 ge = *(LAS const f32x4*)(sge + e0);
        f32x4 v = dv * rstd * ge;
        const f32x4 z = *(LAS const f32x4*)(sz + e0);
        if (BR == 0) v = v + *(LAS const f32x4*)(ssk + e0) * *(LAS const f32x4*)(scm + e0);
        *(u32x2*)(p.OC_() + R * 2048 + BR * 1024 + h * 256 + e0) = (u32x2){pk2(v[0] * siluf_(z[0]), v[1] * siluf_(z[1])), pk2(v[2] * siluf_(z[2]), v[3] * siluf_(z[3]))};
    }
    __syncthreads();
}

template <int MODE>
__device__ __forceinline__ void sample_gemm(const Params& p, const bf16_t* Wl, int wg, int nwg, LAS unsigned char* lds, unsigned long long* ssn) {
    const int tid = opaque_tid(), lane = tid & 63, w = tid >> 6, g = lane >> 4, lr = lane & 15;
    LAS float* part = (LAS float*)lds;
#pragma unroll 1
    for (int j = wg; j < 256; j += nwg) {
        const int rbase = MP + 32 * ((j >> 3) & 3), cbase = 32 * ((j & 7) + 8 * (j >> 5));
        const size_t o = (size_t)(rbase + (tid >> 4)) * 2048 + cbase + (tid & 15) * 2;
        const unsigned e0 = *(const unsigned*)((MODE == 0 ? p.RT_() : p.Xb_()) + o), e1 = MODE == 0 ? *(const unsigned*)(p.GRS_() + o) : 0u;
        const bf16_t* A = (MODE == 0 ? p.OC_() : p.MG_()) + (size_t)(rbase + lr) * 2048 + w * 256 + 8 * g;
        const bf16_t* B = Wl + (MODE == 0 ? W3_OFF : W4_OFF) + (size_t)(cbase + lr) * 2048 + w * 256 + 8 * g;
        bf16x8 af[2][8], bf[2][8];
#pragma unroll
        for (int t = 0; t < 2; ++t)
#pragma unroll
            for (int i = 0; i < 8; ++i) { af[t][i] = *(const bf16x8*)(A + (size_t)t * 16 * 2048 + 32 * i); bf[t][i] = *(const bf16x8*)(B + (size_t)t * 16 * 2048 + 32 * i); }
#pragma unroll
        for (int rt = 0; rt < 2; ++rt)
#pragma unroll
            for (int ct = 0; ct < 2; ++ct) {
                f32x4 acc = (f32x4){0.f, 0.f, 0.f, 0.f};
#pragma unroll
                for (int i = 0; i < 8; ++i) acc = __builtin_amdgcn_mfma_f32_16x16x32_bf16(af[rt][i], bf[ct][i], acc, 0, 0, 0);
#pragma unroll
                for (int r = 0; r < 4; ++r) part[((w * 2 + rt) * 2 + ct) * 256 + (4 * g + r) * 16 + lr] = acc[r];
            }
        __syncthreads();
        {
            const int rr = tid >> 4, cc = (tid & 15) * 2;
            const LAS float* q = part + (((rr >> 4) * 2 + (cc >> 4)) * 256 + (rr & 15) * 16 + (cc & 15));
            float lo0 = 0.f, lo1 = 0.f, hi0 = 0.f, hi1 = 0.f;
#pragma unroll
            for (int ww = 0; ww < 4; ++ww) { lo0 += q[ww * 1024]; lo1 += q[ww * 1024 + 1]; hi0 += q[(ww + 4) * 1024]; hi1 += q[(ww + 4) * 1024 + 1]; }
            if (MODE == 0) {
                const unsigned rt2 = e0, gr2 = e1;
                const float m0 = bf2f((bf16_t)(gr2 & 0xffffu)) * (bf2f((bf16_t)(rt2 & 0xffffu)) * lo0 + hi0), m1 = bf2f((bf16_t)(gr2 >> 16)) * (bf2f((bf16_t)(rt2 >> 16)) * lo1 + hi1);
                *(unsigned*)(p.MG_() + o) = (unsigned)f2bf(m0) | ((unsigned)f2bf(m1) << 16);
            } else {
                const unsigned x2 = e0;
                const bf16_t n0 = f2bf(bf2f((bf16_t)(x2 & 0xffffu)) + (lo0 + hi0)), n1 = f2bf(bf2f((bf16_t)(x2 >> 16)) + (lo1 + hi1));
                *(unsigned*)(p.Xb_() + o) = (unsigned)n0 | ((unsigned)n1 << 16);
                float sq = bf2f(n0) * bf2f(n0) + bf2f(n1) * bf2f(n1);
                sq += __shfl_xor(sq, 1); sq += __shfl_xor(sq, 2); sq += __shfl_xor(sq, 4); sq += __shfl_xor(sq, 8);
                if ((tid & 15) == 0) atomicAdd(ssn + rbase + rr, ss_fix(sq));
            }
        }
        __syncthreads();
    }
}

__device__ __forceinline__ void sample_gemm2(const Params& p, const bf16_t* W2t, int wg, int nwg) {
    const int tid = opaque_tid(), lane = tid & 63, w = tid >> 6, g = lane >> 4, lr = lane & 15;
    for (int j = wg; j < 128; j += nwg) {
        const int rbase = MP + 16 * (j & 7), cbase = 128 * (j >> 3) + 16 * w, head = cbase >> 9;
        const bf16_t* A = p.CM_() + (size_t)(rbase + lr) * WM + head * 256 + 8 * g;
        const bf16_t* B = W2t + (size_t)(cbase + lr) * 256 + 8 * g;
        bf16x8 af[8], bf[8];
#pragma unroll
        for (int i = 0; i < 8; ++i) { af[i] = *(const bf16x8*)(A + 32 * i); bf[i] = *(const bf16x8*)(B + 32 * i); }
        f32x4 acc = (f32x4){0.f, 0.f, 0.f, 0.f};
#pragma unroll
        for (int i = 0; i < 8; ++i) acc = __builtin_amdgcn_mfma_f32_16x16x32_bf16(af[i], bf[i], acc, 0, 0, 0);
#pragma unroll
        for (int r = 0; r < 4; ++r) p.QK_()[(size_t)(rbase + 4 * g + r) * 2048 + cbase + lr] = f2bf(acc[r]);
    }
}

__device__ __forceinline__ void phaseA(const Params& p, int layer, int wg, int nwg, LAS unsigned char* lds) {
    for (int it = wg; it < 256; it += nwg) {
        const int pi = (it & 7) * 4 + (it >> 6), sl = (it >> 3) & 7, bh = pi & 15;
        if (pi < 16) chunk_state_item<0>(p, layer, bh >> 2, bh & 3, sl, lds); else chunk_state_item<1>(p, layer, bh >> 2, bh & 3, sl, lds);
    }
    {
        const int tid = opaque_tid(), lane = tid & 63, wid = __builtin_amdgcn_readfirstlane(tid >> 6);
        int s = wg, k = 0;
        if (s < 1024) {
            f32x4 cc[8], cx[8];
            { const char* sb = sample_state(p, layer, s) + (size_t)wid * 1024 + (unsigned)lane * 16u;
#pragma unroll
              for (int j = 0; j < 8; ++j) cc[j] = __builtin_nontemporal_load((const f32x4*)(sb + (size_t)j * 8192)); }
            for (;; ++k) {
                const int sn = s + nwg;
                const char* nsrc = sn < 1024 ? sample_state(p, layer, sn) : nullptr;
                LAS float* base = (LAS float*)lds + (k & 1) * 4352;
                const int b = (s >> 2) & 127, h = s & 3;
                if (s < 512) sample_item<0>(p, layer, b, h, base, cc, cx, nsrc); else sample_item<1>(p, layer, b, h, base, cc, cx, nsrc);
                if (sn >= 1024) break;
#pragma unroll
                for (int j = 0; j < 8; ++j) cc[j] = cx[j];
                s = sn;
            }
        }
        __syncthreads();
    }
}
__device__ __forceinline__ void phaseScan(const Params& p, int layer, int wg, int nwg, LAS unsigned char* lds) {
    for (int it = wg; it < 256; it += nwg) scan_item(p, layer, it >> 3, it & 7, lds);
}
__device__ __forceinline__ void phaseC(const Params& p, int layer, int wg, int nwg, LAS unsigned char* lds) {
    for (int it = wg; it < 512; it += nwg) {
        const int br = it >> 8, rest = it & 255, b = rest >> 6, h = (rest >> 4) & 3, c = rest & 15;
        if (br == 0) chunk_passC<0>(p, layer, b, h, c, lds); else chunk_passC<1>(p, layer, b, h, c, lds);
    }
}

template <int ONLY>
__device__ __forceinline__ void run_phases(const Params& p_in, int ph_lo, int ph_hi) {
    extern __shared__ __attribute__((aligned(16))) unsigned char smem_raw[];
    LAS unsigned char* lds = (LAS unsigned char*)smem_raw;
    volatile LAS unsigned* xbw = (volatile LAS unsigned*)(lds + LDS_BYTES - 16);
    const int wg_in = blockIdx.x, nwg = gridDim.x;
    const bool multi = (ph_hi - ph_lo) > 1;
    XcdBarrier bar; bar.bar = p_in.bar_(); bar.x = 0; bar.st = xbw;
    if (multi) {
        if (threadIdx.x == 0) { xbw[0] = 0u; xbw[1] = 0u; xbw[2] = 0u; xbw[3] = 0u; }
        __syncthreads();
        bar = xcd_barrier_post(p_in.bar_(), xbw);
    }
    int ph = 0;
#define PHASE(KIND, ...) { if constexpr (ONLY < 0 || ONLY == KIND) { if (ph >= ph_lo && ph < ph_hi) { \
    Params p = p_in; int wg = wg_in; { size_t z_ = 0; asm volatile("" : "+s"(z_), "+s"(wg)); p.ws = p_in.ws + z_; p.out = p_in.out + z_; }     \
    __VA_ARGS__; if (ph + 1 < ph_hi) xcd_barrier(bar); } } ++ph; }
    PHASE(0, prep_phase(p, wg, nwg, lds))
    for (int layer = 0; layer < DEPTH; ++layer) {
        PHASE(2, { int nw_ = nwg; asm volatile("" : "+s"(nw_)); pg8::BalOrder S; S.init(MPAD, N1, nw_, wg); pg8::Gemm g{p.Xb_(), p.W_() + (size_t)layer * WL + W1_OFF, D, D, D, 31, 0, 0};
                pg8::EpiG1 E{p.P_(), p.b_gate + (size_t)layer * 4096, p.RT_(), p.GRS_(), p.ROPE_(), p.SS_() + (size_t)layer * MPAD, p.SSP_(), p.IF_()}; pg8::gemm_phase<false>(lds, g, S, E);
                { int nid_; const int ii_ = S.idle_index(nid_); if (ii_ >= 0) { __syncthreads(); const int t0_ = layer + 1 < DEPTH ? (layer + 1) * 7808 : layer * 7808 + 5632; tr_run(p, ii_ * 8 + (opaque_tid() >> 6), nid_ * 8, tr_def(nw_), lds, [=](int j) { return t0_ + j; }); } } })
        PHASE(3, conv_phase(p, layer, wg, nwg, lds))
        PHASE(4, { pg8::StaticOrder S; S.init(MP, 2048, nwg, wg); pg8::Gemm g{p.CM_(), p.W_() + (size_t)layer * WL + W2_OFF, 256, WM, 256, 1, 512, 0};
                pg8::EpiBf16 E{p.QK_(), 2048}; pg8::gemm_phase<false>(lds, g, S, E); sample_gemm2(p, p.W_() + (size_t)layer * WL + W2_OFF, wg, nwg); })
        PHASE(5, phaseA(p, layer, wg, nwg, lds))
        PHASE(7, phaseC(p, layer, wg, nwg, lds))
        PHASE(8, { pg8::StaticOrder S; S.init(MP, 2048, nwg, wg); pg8::Gemm g{p.OC_(), p.W_() + (size_t)layer * WL + W3_OFF, 2048, 2048, 2048, 31, 0, 16};
                pg8::EpiMerged E{p.MG_(), p.RT_(), p.GRS_()}; pg8::gemm_phase<true>(lds, g, S, E); sample_gemm<0>(p, p.W_() + (size_t)layer * WL, wg, nwg, lds, nullptr); })
        PHASE(10, { pg8::StaticOrder S; S.init(MP, 2048, nwg, wg); pg8::Gemm g{p.MG_(), p.W_() + (size_t)layer * WL + W4_OFF, 2048, 2048, 2048, 31, 0, 0};
                pg8::EpiResidual E{p.Xb_(), p.SSP_(), (LAS float*)(lds + pg8::STAGE_BYTES)}; pg8::gemm_phase<false>(lds, g, S, E); sample_gemm<1>(p, p.W_() + (size_t)layer * WL, wg, nwg, lds, p.SS_() + (size_t)(layer + 1) * MPAD); })
    }
    PHASE(11, final_phase(p, wg, nwg))
#undef PHASE
}
__global__ void __launch_bounds__(512, 2) mega(Params p, int ph_lo, int ph_hi) { run_phases<-1>(p, ph_lo, ph_hi); }
#ifdef DIAG
template <int K> __global__ void __launch_bounds__(512, 2) mega_k(Params p, int ph_lo, int ph_hi) { run_phases<K>(p, ph_lo, ph_hi); }
template __global__ void mega_k<0>(Params, int, int); template __global__ void mega_k<2>(Params, int, int);
template __global__ void mega_k<3>(Params, int, int); template __global__ void mega_k<4>(Params, int, int); template __global__ void mega_k<5>(Params, int, int);
template __global__ void mega_k<7>(Params, int, int); template __global__ void mega_k<8>(Params, int, int);
template __global__ void mega_k<10>(Params, int, int); template __global__ void mega_k<11>(Params, int, int);
#endif
constexpr int N_PHASES = 2 + DEPTH * 7;

extern "C" void kernel_launch(void* const* d_in, const int* in_sizes, int n_in, void* d_out, int out_size, void* d_ws, size_t ws_size, hipStream_t stream) {
    (void)in_sizes; (void)n_in; (void)out_size; (void)ws_size;
    static int grid = 0;
    if (grid == 0) {
        int dev = 0, cus = 0;
        hipGetDevice(&dev);
        hipDeviceGetAttribute(&cus, hipDeviceAttributeMultiprocessorCount, dev);
        if (hipFuncSetAttribute((const void*)mega, hipFuncAttributeMaxDynamicSharedMemorySize, LDS_BYTES) != hipSuccess) fprintf(stderr, "hipFuncSetAttribute failed\n");
        (void)hipGetLastError();
        grid = cus > 0 ? cus : 256;
    }
    Params p{};
    const float** in = (const float**)&p;
    for (int i = 0; i < 24; ++i) in[i] = (const float*)d_in[i];
    p.out = (float*)d_out;
    p.ws = (unsigned char*)d_ws;
    if (ws_size < WS_END) { fprintf(stderr, "workspace too small: %zu < %zu\n", ws_size, (size_t)WS_END); return; }
    hipMemsetAsync(d_ws, 0, 16384, stream);
#if MK_SINGLE
    hipLaunchKernelGGL(mega, dim3(grid), dim3(512), LDS_BYTES, stream, p, 0, N_PHASES);
#else
    for (int ph = 0; ph < N_PHASES; ++ph) hipLaunchKernelGGL(mega, dim3(grid), dim3(512), LDS_BYTES, stream, p, ph, ph + 1);
#endif
}
```

```cpp
#include <hip/hip_runtime.h>
#include <stdint.h>
#include <stdio.h>

#ifndef MK_SINGLE
#define MK_SINGLE 1
#endif

#define LAS __attribute__((address_space(3)))
typedef unsigned short bf16_t;
typedef short bf16x8 __attribute__((ext_vector_type(8)));
typedef float f32x4 __attribute__((ext_vector_type(4)));
typedef unsigned u32x4 __attribute__((ext_vector_type(4)));
typedef unsigned u32x2 __attribute__((ext_vector_type(2)));
typedef float f32x2_t __attribute__((ext_vector_type(2)));

constexpr int D = 2048, SEQ = 2048, BP = 4, BS = 128, DEPTH = 4, HM = 4, DH = 256, WM = 1024, NIN = 7176;
constexpr int MP = BP * SEQ, MT = MP + BS, MPAD = 8448;
constexpr int NP = 7168;
constexpr int N1 = 11520;
constexpr int C_U = 0, C_VM = 1024, C_ZM = 2048, C_QR = 3072, C_KR = 4096, C_VR = 5120, C_ZR = 6144, C_GM = 7168, C_GR = 9216;
constexpr float EPS = 1e-6f;
constexpr size_t SZ = 65536;
constexpr size_t O_YP = 0, O_YS = O_YP + 16777216, O_CP = O_YS + 262144, O_NP = O_CP + 4194304, O_MP = O_NP + 16384, O_CVP = O_MP + 64,
                 O_SP = O_CVP + 49152, O_CS = O_SP + 4194304, O_NS = O_CS + 134217728, O_MS = O_NS + 524288, O_CVS = O_MS + 2048, O_SS = O_CVS + 1572864;
constexpr size_t W1_OFF = 0, W2_OFF = W1_OFF + (size_t)N1 * D, W3_OFF = W2_OFF + (size_t)2048 * 256, W4_OFF = W3_OFF + (size_t)D * D, WL = W4_OFF + (size_t)D * D;
constexpr int LDS_BYTES = 147456;

constexpr size_t al256(size_t x) { return (x + 255) & ~(size_t)255; }
constexpr size_t OFF_BAR = 0, OFF_SS = OFF_BAR + 16384, OFF_SSP = OFF_SS + al256((size_t)5 * MPAD * 8), OFF_XB = OFF_SSP + al256((size_t)8 * MP * 4),
    OFF_P = OFF_XB + al256((size_t)MPAD * D * 2), OFF_IF = OFF_P + al256((size_t)MPAD * NP * 2), OFF_CM = OFF_IF + al256((size_t)MPAD * 8 * 4),
    OFF_QK = OFF_CM + al256((size_t)MPAD * WM * 2), OFF_OC = OFF_QK + al256((size_t)MPAD * 2048 * 2), OFF_MG = OFF_OC + al256((size_t)MPAD * 2048 * 2),
    OFF_U = OFF_MG + al256((size_t)MPAD * 2048 * 2), OFF_CS = OFF_U + al256((size_t)32 * 16 * SZ * 2), OFF_NU = OFF_CS + al256((size_t)32 * 16 * SZ * 2),
    OFF_NS = OFF_NU + al256((size_t)16 * 16 * 256 * 4), OFF_W = OFF_NS + al256((size_t)16 * 16 * 256 * 4), OFF_ROPE = OFF_W + al256((size_t)DEPTH * WL * 2),
    OFF_RT = OFF_ROPE + al256((size_t)2049 * 128 * 2 * 4), OFF_GRS = OFF_RT + al256((size_t)MPAD * 2048 * 2), OFF_GT = OFF_GRS + al256((size_t)MPAD * 2048 * 2),
    WS_END = OFF_GT + al256((size_t)16 * 6208 * 4);

struct Params {
    const float *x_prompt, *x_sample, *st_C, *st_n, *st_m, *st_conv, *st_S, *norm_g, *w_in, *conv_w, *conv_b, *w_qm, *w_km, *b_i, *b_f,
                *hn_m_g, *skip_m, *hn_r_g, *w_pm, *w_pr, *w_gate, *b_gate, *w_o, *final_g;
    float* out;
    unsigned char* ws;
#define WSF(name, type, off) __device__ __forceinline__ type* name##_() const { return (type*)(ws + (off)); }
    WSF(bar, unsigned, OFF_BAR) WSF(SS, unsigned long long, OFF_SS) WSF(SSP, float, OFF_SSP) WSF(Xb, bf16_t, OFF_XB) WSF(P, bf16_t, OFF_P) WSF(IF, float, OFF_IF)
    WSF(CM, bf16_t, OFF_CM) WSF(QK, bf16_t, OFF_QK) WSF(OC, bf16_t, OFF_OC) WSF(MG, bf16_t, OFF_MG) WSF(U, bf16_t, OFF_U) WSF(CS, bf16_t, OFF_CS)
    WSF(NU, float, OFF_NU) WSF(NS, float, OFF_NS) WSF(W, bf16_t, OFF_W) WSF(ROPE, float, OFF_ROPE) WSF(RT, bf16_t, OFF_RT) WSF(GRS, bf16_t, OFF_GRS) WSF(GT, float, OFF_GT)
#undef WSF
};


__device__ __forceinline__ unsigned long long ss_fix(float v) { return (unsigned long long)(v * 1048576.0f + 0.5f); }
__device__ __forceinline__ float ss_val(unsigned long long v) { return (float)v * (1.0f / 1048576.0f); }
__device__ __forceinline__ float row_ss(const float* ssp, const unsigned long long* ss, int row) {
    if (row < 8192) { const f32x4 a = *(const f32x4*)(ssp + (size_t)row * 8), b = *(const f32x4*)(ssp + (size_t)row * 8 + 4);
        return ((a[0] + a[1]) + (a[2] + a[3])) + ((b[0] + b[1]) + (b[2] + b[3])); }
    return ss_val(ss[row]);
}
__device__ __forceinline__ int opaque_tid() { int t = threadIdx.x; asm volatile("" : "+v"(t)); return t; }
__device__ __forceinline__ float bf2f(bf16_t v) { return __uint_as_float((unsigned)v << 16); }
__device__ __forceinline__ bf16_t f2bf(float f) { unsigned u = __float_as_uint(f); u += 0x7fffu + ((u >> 16) & 1u); return (bf16_t)(u >> 16); }
__device__ __forceinline__ unsigned pk2(float lo, float hi) { return (unsigned)f2bf(lo) | ((unsigned)f2bf(hi) << 16); }
__device__ __forceinline__ float wave_sum(float v) {
#pragma unroll
    for (int o = 32; o >= 1; o >>= 1) v += __shfl_xor(v, o);
    return v;
}
__device__ __forceinline__ float wave_max(float v) {
#pragma unroll
    for (int o = 32; o >= 1; o >>= 1) v = fmaxf(v, __shfl_xor(v, o));
    return v;
}
__device__ __forceinline__ float sigmoidf_(float x) { return __builtin_amdgcn_rcpf(1.0f + __expf(-x)); }
__device__ __forceinline__ float siluf_(float x) { return x * __builtin_amdgcn_rcpf(1.0f + __expf(-x)); }
__device__ __forceinline__ float logsigf_(float x) { return x < 0.f ? x - log1pf(expf(x)) : -log1pf(expf(-x)); }
__device__ __forceinline__ void block_sum2(float& a, float& b, LAS float* red) {
    a = wave_sum(a); b = wave_sum(b);
    __syncthreads();
    if ((threadIdx.x & 63) == 0) { red[threadIdx.x >> 6] = a; red[8 + (threadIdx.x >> 6)] = b; }
    __syncthreads();
    float sa = 0.f, sb = 0.f;
#pragma unroll
    for (int i = 0; i < 8; ++i) { sa += red[i]; sb += red[8 + i]; }
    a = sa; b = sb;
}

#define XB_TMO      128
#define XB_XCNT(j)  (256  + 64 * (j))
#define XB_XSUB(j)  (1280 + 64 * (j))
#define XB_XGEN(j)  (2304 + 64 * (j))
#define XB_TOP      3328
#define XB_TOPGEN   3392
#define XCD_BAR_WORDS 3456
#define XB_SPIN_CAP (1u << 22)

__device__ __forceinline__ unsigned xb_ld(unsigned* p)              { return __hip_atomic_load(p, __ATOMIC_RELAXED, __HIP_MEMORY_SCOPE_AGENT); }
__device__ __forceinline__ unsigned xb_add(unsigned* p, unsigned v) { return __hip_atomic_fetch_add(p, v, __ATOMIC_RELAXED, __HIP_MEMORY_SCOPE_AGENT); }
__device__ __forceinline__ unsigned xb_xcc_id() { return (unsigned)__builtin_amdgcn_s_getreg((3 << 11) | 20) & 0xFu; }
#define XB_SPIN(cond, bar) do { unsigned _sp = 0; while (cond) { __builtin_amdgcn_s_sleep(1); \
    if ((++_sp & 255u) == 0u) { if (xb_ld(&(bar)[XB_TMO])) break; if (_sp > XB_SPIN_CAP) { atomicAdd(&(bar)[XB_TMO], 1u); break; } } } } while (0)

struct XcdBarrier { unsigned* bar; unsigned x; volatile LAS unsigned* st; };

__device__ __forceinline__ XcdBarrier xcd_barrier_post(unsigned* bar, volatile LAS unsigned* st) {
    XcdBarrier b; b.bar = bar; b.x = xb_xcc_id(); b.st = st;
    if (threadIdx.x == 0) (void)xb_add(&bar[XB_XCNT(b.x)], 1u);
    return b;
}
__device__ __forceinline__ void xcd_barrier_complete(unsigned* bar, unsigned x, unsigned& nloc, unsigned& nx) {
    const unsigned G = gridDim.x * gridDim.y * gridDim.z;
    unsigned sum, cnt, mine, sp = 0u;
    for (;;) {
        sum = 0u; cnt = 0u;
#pragma unroll 1
        for (unsigned j = 0; j < 16; ++j) { const unsigned c = xb_ld(&bar[XB_XCNT(j)]); sum += c; cnt += (c > 0u) ? 1u : 0u; }
        if (sum == G) break;
        __builtin_amdgcn_s_sleep(1);
        if ((++sp & 255u) == 0u) { if (xb_ld(&bar[XB_TMO])) break; if (sp > XB_SPIN_CAP) { atomicAdd(&bar[XB_TMO], 1u); break; } }
    }
    mine = xb_ld(&bar[XB_XCNT(x)]);
    nloc = mine > 0u ? mine : 1u; nx = cnt > 0u ? cnt : 1u;
}
__device__ __forceinline__ void xcd_barrier(const XcdBarrier& b) {
    asm volatile("s_waitcnt vmcnt(0)" ::: "memory");
    __syncthreads();
    if (threadIdx.x == 0) {
        unsigned* bar = b.bar;
        __builtin_amdgcn_s_waitcnt(0);
        unsigned nloc = b.st[0], nx = b.st[1];
        if (nloc == 0u) { xcd_barrier_complete(bar, b.x, nloc, nx); b.st[0] = nloc; b.st[1] = nx; }
        const unsigned old = xb_add(&bar[XB_XSUB(b.x)], 1u);
        const unsigned gen = old / nloc;
        if (old + 1u == (gen + 1u) * nloc) {
            __builtin_amdgcn_fence(__ATOMIC_RELEASE, "agent");
            asm volatile("s_waitcnt vmcnt(0)" ::: "memory");
            const unsigned og = xb_add(&bar[XB_TOP], 1u);
            const unsigned tg = og / nx;
            if (og + 1u == (tg + 1u) * nx) xb_add(&bar[XB_TOPGEN], 1u);
            else XB_SPIN(xb_ld(&bar[XB_TOPGEN]) == tg, bar);
            __builtin_amdgcn_fence(__ATOMIC_ACQUIRE, "agent");
            xb_add(&bar[XB_XGEN(b.x)], 1u);
            asm volatile("s_waitcnt vmcnt(0)" ::: "memory");
        } else {
            XB_SPIN(xb_ld(&bar[XB_XGEN(b.x)]) == gen, bar);
            __builtin_amdgcn_fence(__ATOMIC_ACQUIRE, "agent");
            asm volatile("s_waitcnt vmcnt(0)" ::: "memory");
        }
    }
    __syncthreads();
}

namespace pg8 {
constexpr int BM = 256, BK = 64, HALF = 128, HTB = HALF * BK * 2, STAGE_BYTES = 8 * HTB, NXCD = 8, WGM = 8;
__host__ __device__ __forceinline__ int lds_byte(int r, int c) { const int st = (r >> 4) * 2 + (c >> 5), rr = r & 15, cc = c & 31, ob = rr * 64 + cc * 2; return st * 1024 + (ob ^ (((ob >> 9) & 1) << 5)); }
__host__ __device__ __forceinline__ void stage_rc(int b, int& R, int& C) { const int st = b / 1024, sb = b % 1024, swz = sb ^ (((sb >> 9) & 1) << 5); R = (st >> 1) * 16 + swz / 64; C = (st & 1) * 32 + (swz % 64) / 2; }
__host__ __device__ __forceinline__ int perm32(int rho) { const int n = rho >> 4, i = rho & 15; return 8 * (i >> 2) + 4 * n + (i & 3); }

struct Unit { int pm, pn; };
struct Gemm { const bf16_t* A; const bf16_t* Bt; int K, lda, ldb, a_pn_shift, a_pn_stride, mid_t; };

struct StaticOrder {
    int nM, nN, nwg, G, c;
    __device__ void init(int M, int N, int G_, int c_) { nM = M / BM; nN = N / BM; nwg = nM * nN; G = G_; c = c_; }
    __device__ bool next(int i, Unit& u) const {
        const long L = (long)i * G + c; if (L >= nwg) return false;
        int wgid = (int)L; { const int q = nwg / NXCD, r = nwg % NXCD, xcd = wgid % NXCD, off = wgid / NXCD; wgid = (xcd < r ? xcd * (q + 1) : r * (q + 1) + (xcd - r) * q) + off; }
        const int nig = WGM * nN, gid = wgid / nig, fm = gid * WGM, gsz = (nM - fm) < WGM ? (nM - fm) : WGM;
        u.pm = fm + ((wgid % nig) % gsz); u.pn = (wgid % nig) / gsz; return true;
    }
};
struct BalOrder : StaticOrder {
    __device__ bool next(int i, Unit& u) const {
        if (G != 256 || nM != 33 || nN != 45) return StaticOrder::next(i, u);
        if (i > 5) return false;
        const int x = c & 7, off = c >> 3, rg = x >> 1, odd = x & 1;
        if (!odd || i < 5) { u.pm = rg * 8 + (off & 7); u.pn = 4 * (2 * i + odd) + (off >> 3); return true; }
        if (off < 8) { u.pm = rg * 8 + off; u.pn = 44; return true; }
        const int su = rg * 12 + off - 8;
        if (off < 20 && su < 45) { u.pm = 32; u.pn = su; return true; }
        return false;
    }
    __device__ int idle_index(int& n) const {
        if (G != 256 || nM != 33 || nN != 45) { const int r = nwg % G; n = r ? G - r : 0; return (r && c >= r) ? c - r : -1; }
        n = 51;
        const int x = c & 7, off = c >> 3, rg = x >> 1;
        if (!(x & 1)) return -1;
        if (off >= 20) return rg * 12 + off - 20;
        if (rg == 3 && off >= 17) return 48 + off - 17;
        return -1;
    }
};
__device__ __forceinline__ unsigned cvt_pk_bf16(float lo, float hi) { unsigned r; asm volatile("v_cvt_pk_bf16_f32 %0, %1, %2" : "=v"(r) : "v"(lo), "v"(hi)); return r; }

struct EpiBf16 {
    static constexpr bool PERM = true;
    bf16_t* O; int ldc;
    __device__ __forceinline__ void operator()(const f32x4 (&acc)[2][2][4][2], const Unit& u, int wr, int wc, int fr, int fq) const {
        const int row0 = u.pm * BM + wr * 64 + fr, col0 = u.pn * BM + wc * 32 + 8 * fq;
#pragma unroll
        for (int ai = 0; ai < 2; ++ai)
#pragma unroll
            for (int m = 0; m < 4; ++m) { bf16_t* rowp = O + (size_t)(row0 + ai * HALF + m * 16) * ldc + col0;
#pragma unroll
                for (int bj = 0; bj < 2; ++bj) { const f32x4 v0 = acc[ai][bj][m][0], v1 = acc[ai][bj][m][1];
                    u32x4 w; w.x = cvt_pk_bf16(v0[0], v0[1]); w.y = cvt_pk_bf16(v0[2], v0[3]); w.z = cvt_pk_bf16(v1[0], v1[1]); w.w = cvt_pk_bf16(v1[2], v1[3]);
                    *(u32x4*)(rowp + bj * HALF) = w; } }
    }
};
struct EpiG1 {
    static constexpr bool PERM = true;
    bf16_t* P; const float* bg; bf16_t* RT; bf16_t* GRS; const float* rope; const unsigned long long* ss; const float* ssp; float* IFo;
    __device__ __forceinline__ void operator()(f32x4 (&acc)[2][2][4][2], const Unit& u, int wr, int wc, int fr, int fq) const {
        const int row0 = u.pm * BM + wr * 64 + fr, cw = wc * 32 + 8 * fq;
#pragma unroll
        for (int ai = 0; ai < 2; ++ai) {
            float sq[4];
            if (u.pm < 32) {
                f32x4 a[4], b[4];
#pragma unroll
                for (int m = 0; m < 4; ++m) { const float* q = ssp + (size_t)(row0 + ai * HALF + m * 16) * 8; a[m] = *(const f32x4*)q; b[m] = *(const f32x4*)(q + 4); }
#pragma unroll
                for (int m = 0; m < 4; ++m) sq[m] = ((a[m][0] + a[m][1]) + (a[m][2] + a[m][3])) + ((b[m][0] + b[m][1]) + (b[m][2] + b[m][3]));
            } else {
                unsigned long long v[4];
#pragma unroll
                for (int m = 0; m < 4; ++m) v[m] = ss[row0 + ai * HALF + m * 16];
#pragma unroll
                for (int m = 0; m < 4; ++m) sq[m] = ss_val(v[m]);
            }
#pragma unroll
            for (int m = 0; m < 4; ++m) { const float rstd = rsqrtf(sq[m] * (1.0f / 2048.0f) + 1e-6f);
#pragma unroll
                for (int bj = 0; bj < 2; ++bj) { acc[ai][bj][m][0] *= rstd; acc[ai][bj][m][1] *= rstd; } }
            __builtin_amdgcn_sched_barrier(0);
        }
        if (u.pn == 44) {
            if (wc == 0 && fq == 0) {
#pragma unroll
                for (int ai = 0; ai < 2; ++ai)
#pragma unroll
                    for (int m = 0; m < 4; ++m) { float* o = IFo + (size_t)(row0 + ai * HALF + m * 16) * 8; *(f32x4*)o = acc[ai][0][m][0]; *(f32x4*)(o + 4) = acc[ai][0][m][1]; }
            }
        } else if (u.pn >= 28) {
            const int ch = 128 * (u.pn - 28) + cw;
            const f32x4 bm0 = *(const f32x4*)(bg + ch), bm1 = *(const f32x4*)(bg + ch + 4), br0 = *(const f32x4*)(bg + 2048 + ch), br1 = *(const f32x4*)(bg + 2048 + ch + 4);
#pragma unroll
            for (int ai = 0; ai < 2; ++ai)
#pragma unroll
                for (int m = 0; m < 4; ++m) { const size_t row = (size_t)(row0 + ai * HALF + m * 16);
                    const f32x4 vm0 = acc[ai][0][m][0] + bm0, vm1 = acc[ai][0][m][1] + bm1, vr0 = acc[ai][1][m][0] + br0, vr1 = acc[ai][1][m][1] + br1;
                    float rt[8], gr[8];
#pragma unroll
                    for (int j = 0; j < 4; ++j) {
                        const float er0 = 1.0f + __expf(-vr0[j]), er1 = 1.0f + __expf(-vr1[j]);
                        rt[j] = er0 * __builtin_amdgcn_rcpf(1.0f + __expf(-vm0[j])); rt[4 + j] = er1 * __builtin_amdgcn_rcpf(1.0f + __expf(-vm1[j]));
                        gr[j] = __builtin_amdgcn_rcpf(er0); gr[4 + j] = __builtin_amdgcn_rcpf(er1); }
                    u32x4 w; w.x = cvt_pk_bf16(rt[0], rt[1]); w.y = cvt_pk_bf16(rt[2], rt[3]); w.z = cvt_pk_bf16(rt[4], rt[5]); w.w = cvt_pk_bf16(rt[6], rt[7]);
                    *(u32x4*)(RT + row * 2048 + ch) = w;
                    w.x = cvt_pk_bf16(gr[0], gr[1]); w.y = cvt_pk_bf16(gr[2], gr[3]); w.z = cvt_pk_bf16(gr[4], gr[5]); w.w = cvt_pk_bf16(gr[6], gr[7]);
                    *(u32x4*)(GRS + row * 2048 + ch) = w; }
        } else if (u.pn >= 12 && u.pn < 20) {
            const float sc = u.pn >= 16 ? 0.0625f : 1.0f;
#pragma unroll
            for (int ai = 0; ai < 2; ++ai)
#pragma unroll
                for (int m = 0; m < 4; ++m) { const int row = row0 + ai * HALF + m * 16;
                    const int pi = row < MP ? (row & (SEQ - 1)) : 2048;
                    const f32x4* cs = (const f32x4*)(rope + ((size_t)pi * 128 + cw) * 2);
                    const f32x4 t0 = cs[0], t1 = cs[1], t2 = cs[2], t3 = cs[3];
                    const f32x4 a0 = acc[ai][0][m][0], a1 = acc[ai][0][m][1], b0 = acc[ai][1][m][0], b1 = acc[ai][1][m][1];
                    const float c[8] = {t0[0], t0[2], t1[0], t1[2], t2[0], t2[2], t3[0], t3[2]}, sn[8] = {t0[1], t0[3], t1[1], t1[3], t2[1], t2[3], t3[1], t3[3]};
                    const float x1[8] = {a0[0], a0[1], a0[2], a0[3], a1[0], a1[1], a1[2], a1[3]}, x2[8] = {b0[0], b0[1], b0[2], b0[3], b1[0], b1[1], b1[2], b1[3]};
                    float o1[8], o2[8];
#pragma unroll
                    for (int j = 0; j < 8; ++j) { o1[j] = (x1[j] * c[j] - x2[j] * sn[j]) * sc; o2[j] = (x1[j] * sn[j] + x2[j] * c[j]) * sc; }
                    bf16_t* rowp = P + (size_t)row * NP + u.pn * BM + cw;
                    u32x4 w; w.x = cvt_pk_bf16(o1[0], o1[1]); w.y = cvt_pk_bf16(o1[2], o1[3]); w.z = cvt_pk_bf16(o1[4], o1[5]); w.w = cvt_pk_bf16(o1[6], o1[7]);
                    *(u32x4*)rowp = w;
                    w.x = cvt_pk_bf16(o2[0], o2[1]); w.y = cvt_pk_bf16(o2[2], o2[3]); w.z = cvt_pk_bf16(o2[4], o2[5]); w.w = cvt_pk_bf16(o2[6], o2[7]);
                    *(u32x4*)(rowp + HALF) = w; }
        } else {
#pragma unroll
            for (int ai = 0; ai < 2; ++ai)
#pragma unroll
                for (int m = 0; m < 4; ++m) { bf16_t* rowp = P + (size_t)(row0 + ai * HALF + m * 16) * NP + u.pn * BM + cw;
#pragma unroll
                    for (int bj = 0; bj < 2; ++bj) { const f32x4 v0 = acc[ai][bj][m][0], v1 = acc[ai][bj][m][1];
                        u32x4 w; w.x = cvt_pk_bf16(v0[0], v0[1]); w.y = cvt_pk_bf16(v0[2], v0[3]); w.z = cvt_pk_bf16(v1[0], v1[1]); w.w = cvt_pk_bf16(v1[2], v1[3]);
                        *(u32x4*)(rowp + bj * HALF) = w; } }
        }
    }
};
struct EpiMerged {
    static constexpr bool PERM = true;
    bf16_t* O; const bf16_t* RT; const bf16_t* GRS;
    __device__ __forceinline__ void scale(f32x4 (&acc)[2][2][4][2], const bf16_t* S, const Unit& u, int wr, int wc, int fr, int fq) const {
        asm volatile("" : "+v"(fr), "+v"(fq));
        const int row0 = u.pm * BM + wr * 64 + fr, col0 = u.pn * BM + wc * 32 + 8 * fq;
#pragma unroll
        for (int ai = 0; ai < 2; ++ai) {
            u32x4 sv[4][2];
#pragma unroll
            for (int m = 0; m < 4; ++m)
#pragma unroll
                for (int bj = 0; bj < 2; ++bj) sv[m][bj] = *(const u32x4*)(S + (size_t)(row0 + ai * HALF + m * 16) * 2048 + col0 + bj * HALF);
#pragma unroll
            for (int m = 0; m < 4; ++m)
#pragma unroll
                for (int bj = 0; bj < 2; ++bj) { const u32x4 a = sv[m][bj];
                    acc[ai][bj][m][0][0] *= __uint_as_float(a.x << 16); acc[ai][bj][m][0][1] *= __uint_as_float(a.x & 0xffff0000u);
                    acc[ai][bj][m][0][2] *= __uint_as_float(a.y << 16); acc[ai][bj][m][0][3] *= __uint_as_float(a.y & 0xffff0000u);
                    acc[ai][bj][m][1][0] *= __uint_as_float(a.z << 16); acc[ai][bj][m][1][1] *= __uint_as_float(a.z & 0xffff0000u);
                    acc[ai][bj][m][1][2] *= __uint_as_float(a.w << 16); acc[ai][bj][m][1][3] *= __uint_as_float(a.w & 0xffff0000u); }
        }
    }
    __device__ __forceinline__ void mid(f32x4 (&acc)[2][2][4][2], const Unit& u, int wr, int wc, int fr, int fq) const { scale(acc, RT, u, wr, wc, fr, fq); }
    __device__ __forceinline__ void operator()(f32x4 (&acc)[2][2][4][2], const Unit& u, int wr, int wc, int fr, int fq) const {
        scale(acc, GRS, u, wr, wc, fr, fq);
        const int row0 = u.pm * BM + wr * 64 + fr, col0 = u.pn * BM + wc * 32 + 8 * fq;
#pragma unroll
        for (int ai = 0; ai < 2; ++ai)
#pragma unroll
            for (int m = 0; m < 4; ++m) { bf16_t* rowp = O + (size_t)(row0 + ai * HALF + m * 16) * 2048 + col0;
#pragma unroll
                for (int bj = 0; bj < 2; ++bj) { const f32x4 v0 = acc[ai][bj][m][0], v1 = acc[ai][bj][m][1];
                    u32x4 w; w.x = cvt_pk_bf16(v0[0], v0[1]); w.y = cvt_pk_bf16(v0[2], v0[3]); w.z = cvt_pk_bf16(v1[0], v1[1]); w.w = cvt_pk_bf16(v1[2], v1[3]);
                    *(u32x4*)(rowp + bj * HALF) = w; } }
    }
};
struct EpiResidual {
    static constexpr bool PERM = true;
    bf16_t* Xb; float* ssp; LAS float* red;
    __device__ __forceinline__ void operator()(f32x4 (&acc)[2][2][4][2], const Unit& u, int wr, int wc, int fr, int fq) const {
        const int row0 = u.pm * BM + wr * 64 + fr, col0 = u.pn * BM + wc * 32 + 8 * fq;
#pragma unroll
        for (int ai = 0; ai < 2; ++ai) {
            u32x4 xv[4][2];
#pragma unroll
            for (int m = 0; m < 4; ++m)
#pragma unroll
                for (int bj = 0; bj < 2; ++bj) xv[m][bj] = *(const u32x4*)(Xb + (size_t)(row0 + ai * HALF + m * 16) * 2048 + col0 + bj * HALF);
#pragma unroll
            for (int m = 0; m < 4; ++m) { float sq = 0.f;
#pragma unroll
                for (int bj = 0; bj < 2; ++bj) { const u32x4 a = xv[m][bj]; const f32x4 v0 = acc[ai][bj][m][0], v1 = acc[ai][bj][m][1];
                    u32x4 w;
                    w.x = cvt_pk_bf16(v0[0] + __uint_as_float(a.x << 16), v0[1] + __uint_as_float(a.x & 0xffff0000u)); w.y = cvt_pk_bf16(v0[2] + __uint_as_float(a.y << 16), v0[3] + __uint_as_float(a.y & 0xffff0000u));
                    w.z = cvt_pk_bf16(v1[0] + __uint_as_float(a.z << 16), v1[1] + __uint_as_float(a.z & 0xffff0000u)); w.w = cvt_pk_bf16(v1[2] + __uint_as_float(a.w << 16), v1[3] + __uint_as_float(a.w & 0xffff0000u));
                    *(u32x4*)(Xb + (size_t)(row0 + ai * HALF + m * 16) * 2048 + col0 + bj * HALF) = w;
                    const unsigned ww[4] = {w.x, w.y, w.z, w.w};
#pragma unroll
                    for (int q = 0; q < 4; ++q) { const float lo = __uint_as_float(ww[q] << 16), hi = __uint_as_float(ww[q] & 0xffff0000u); sq += lo * lo + hi * hi; } }
                sq += __shfl_xor(sq, 16); sq += __shfl_xor(sq, 32);
                if (fq == 0) red[(wr * 64 + fr + ai * HALF + m * 16) * 4 + wc] = sq; }
        }
        asm volatile("s_waitcnt lgkmcnt(0)" ::: "memory"); __builtin_amdgcn_s_barrier(); asm volatile("" ::: "memory");
        int t = threadIdx.x; asm volatile("" : "+v"(t));
        if (t < 256) { const f32x4 q = *(LAS const f32x4*)(red + 4 * t); ssp[(size_t)(u.pm * BM + t) * 8 + u.pn] = (q[0] + q[1]) + (q[2] + q[3]); }
        asm volatile("s_waitcnt lgkmcnt(0)" ::: "memory"); __builtin_amdgcn_s_barrier(); asm volatile("" ::: "memory");
    }
};

template <bool MID, class Epi, class Sched, bool ALIGN_EPI = true>
__device__ __forceinline__ void gemm_phase(LAS unsigned char* lds, const Gemm g, const Sched& S, const Epi& E) {
    const int tid = opaque_tid(), wid = __builtin_amdgcn_readfirstlane(tid >> 6), lane = tid & 63, wr = wid >> 2, wc = wid & 3, fr = lane & 15, fq = lane >> 4;
    const int K = g.K, nt = K / BK;
    unsigned voffA[2], voffB[2];
#pragma unroll
    for (int i = 0; i < 2; ++i) { int R, C; stage_rc(tid * 16 + i * 8192, R, C); const int Rb = Epi::PERM ? ((R & ~31) + perm32(R & 31)) : R;
        voffA[i] = (unsigned)(R * g.lda + C) * 2u; voffB[i] = (unsigned)(Rb * g.ldb + C) * 2u; }
    const size_t kstep = (size_t)(BK * 2);
    const size_t hstepA = (size_t)HALF * g.lda * 2, hstepB = (size_t)HALF * g.ldb * 2;
    const size_t tstepA = 2 * hstepA, tstepB = 2 * hstepB;
    const unsigned ldsw = (unsigned)wid * 1024u;
    const int aoff = lds_byte(wr * 64 + fr, fq * 8), boff = lds_byte(wc * 32 + fr, fq * 8);
#define PG8_SA(b, h) (((b) * 2 + (h)) * HTB)
#define PG8_SB(b, h) ((4 + (b) * 2 + (h)) * HTB)
#define PG8_STAGE(bufoff, gbase, voff) do { _Pragma("unroll") for (int _i = 0; _i < 2; ++_i) \
        __builtin_amdgcn_global_load_lds((const unsigned*)((const char*)(gbase) + (voff)[_i]), (LAS unsigned*)(lds + (bufoff) + ldsw + _i * 8192), 16, 0, 0); } while (0)
#define PG8_LDA(dst, b, h) do { _Pragma("unroll") for (int m = 0; m < 4; ++m) _Pragma("unroll") for (int k = 0; k < 2; ++k) dst[m][k] = *(const LAS bf16x8*)(lds + PG8_SA(b, h) + aoff + m * 2048 + k * 1024); } while (0)
#define PG8_LDB(dst, b, h) do { _Pragma("unroll") for (int n = 0; n < 2; ++n) _Pragma("unroll") for (int k = 0; k < 2; ++k) dst[n][k] = *(const LAS bf16x8*)(lds + PG8_SB(b, h) + boff + n * 2048 + k * 1024); } while (0)
#define PG8_MMA(ai, bj, At, Bt) do { __builtin_amdgcn_s_setprio(1); _Pragma("unroll") for (int m = 0; m < 4; ++m) _Pragma("unroll") for (int n = 0; n < 2; ++n) _Pragma("unroll") for (int k = 0; k < 2; ++k) \
        acc[ai][bj][m][n] = __builtin_amdgcn_mfma_f32_16x16x32_bf16(Bt[n][k], At[m][k], acc[ai][bj][m][n], 0, 0, 0); __builtin_amdgcn_s_setprio(0); } while (0)
#define PG8_WAIT_V(n) asm volatile("s_waitcnt vmcnt(" #n ")" ::: "memory")
#define PG8_WAIT_L(n) asm volatile("s_waitcnt lgkmcnt(" #n ")" ::: "memory")
#define PG8_BAR __builtin_amdgcn_s_barrier()
#define PG8_SCHED __builtin_amdgcn_sched_barrier(0)
#define PG8_APTR(u) ((const char*)g.A + (size_t)(u).pm * tstepA + (size_t)((u).pn >> g.a_pn_shift) * (size_t)g.a_pn_stride)
    Unit cur, nxt; int ui = 0;
    if (!S.next(0, cur)) return;
    f32x4 acc[2][2][4][2];
#pragma unroll
    for (int a = 0; a < 2; ++a)
#pragma unroll
        for (int b = 0; b < 2; ++b)
#pragma unroll
            for (int m = 0; m < 4; ++m)
#pragma unroll
                for (int n = 0; n < 2; ++n) acc[a][b][m][n] = (f32x4){0.f, 0.f, 0.f, 0.f};
    bf16x8 At[4][2], B0[2][2], B1[2][2];
    const char* cA = PG8_APTR(cur); const char* cB = (const char*)g.Bt + (size_t)cur.pn * tstepB;
    PG8_STAGE(PG8_SB(0, 0), cB, voffB); PG8_STAGE(PG8_SB(0, 1), cB + hstepB, voffB); PG8_STAGE(PG8_SA(0, 0), cA, voffA); PG8_STAGE(PG8_SA(0, 1), cA + hstepA, voffA);
    if (wr == 1) PG8_BAR;
    PG8_WAIT_V(2); PG8_BAR;
    PG8_STAGE(PG8_SB(1, 0), cB + kstep, voffB); PG8_STAGE(PG8_SA(1, 0), cA + kstep, voffA); PG8_STAGE(PG8_SB(1, 1), cB + hstepB + kstep, voffB);
    PG8_WAIT_V(6); PG8_BAR;
    for (;;) {
        const bool has_next = S.next(ui + 1, nxt);
        const char* nA = has_next ? PG8_APTR(nxt) : cA; const char* nB = has_next ? (const char*)g.Bt + (size_t)nxt.pn * tstepB : cB;
#pragma unroll 1
        for (int t = 0; t < nt; t += 2) {
            const bool last = (t == nt - 2);
            const char* a1 = cA + (size_t)(t + 1) * kstep;
            const char* a2 = last ? nA : cA + (size_t)(t + 2) * kstep; const char* b2 = last ? nB : cB + (size_t)(t + 2) * kstep;
            const char* a3 = a2 + kstep; const char* b3 = b2 + kstep;
            if constexpr (MID) { if (t == g.mid_t) E.mid(acc, cur, wr, wc, fr, fq); }
            PG8_LDB(B0, 0, 0); PG8_LDB(B1, 0, 1); PG8_SCHED; PG8_LDA(At, 0, 0); PG8_STAGE(PG8_SA(1, 1), a1 + hstepA, voffA);
            PG8_WAIT_V(8); PG8_WAIT_L(0); PG8_BAR; PG8_MMA(0, 0, At, B0); PG8_MMA(0, 1, At, B1); PG8_BAR; PG8_SCHED;
            PG8_LDA(At, 0, 1); PG8_STAGE(PG8_SB(0, 0), b2, voffB); PG8_STAGE(PG8_SB(0, 1), b2 + hstepB, voffB); PG8_STAGE(PG8_SA(0, 0), a2, voffA);
            PG8_WAIT_V(8); PG8_WAIT_L(0); PG8_BAR; PG8_MMA(1, 0, At, B0); PG8_MMA(1, 1, At, B1); PG8_BAR; PG8_SCHED;
            PG8_LDB(B0, 1, 0); PG8_LDB(B1, 1, 1); PG8_SCHED; PG8_LDA(At, 1, 0); PG8_STAGE(PG8_SA(0, 1), a2 + hstepA, voffA);
            PG8_WAIT_V(8); PG8_WAIT_L(0); PG8_BAR; PG8_MMA(0, 0, At, B0); PG8_MMA(0, 1, At, B1); PG8_BAR; PG8_SCHED;
            PG8_LDA(At, 1, 1); PG8_STAGE(PG8_SB(1, 0), b3, voffB); PG8_STAGE(PG8_SB(1, 1), b3 + hstepB, voffB); PG8_STAGE(PG8_SA(1, 0), a3, voffA);
            PG8_WAIT_V(8); PG8_WAIT_L(0); PG8_BAR; PG8_MMA(1, 0, At, B0); PG8_MMA(1, 1, At, B1); PG8_BAR; PG8_SCHED;
        }
        if constexpr (ALIGN_EPI) { if (wr == 0) PG8_BAR; }
        E(acc, cur, wr, wc, fr, fq);
        if (!has_next) break;
#pragma unroll
        for (int a = 0; a < 2; ++a)
#pragma unroll
            for (int b = 0; b < 2; ++b)
#pragma unroll
                for (int m = 0; m < 4; ++m)
#pragma unroll
                    for (int n = 0; n < 2; ++n) acc[a][b][m][n] = (f32x4){0.f, 0.f, 0.f, 0.f};
        cur = nxt; cA = nA; cB = nB; ++ui;
        if constexpr (ALIGN_EPI) { if (wr == 1) PG8_BAR; }
    }
    PG8_WAIT_V(0);
    if constexpr (!ALIGN_EPI) { if (wr == 0) PG8_BAR; }
    PG8_BAR;
#undef PG8_SA
#undef PG8_SB
#undef PG8_STAGE
#undef PG8_LDA
#undef PG8_LDB
#undef PG8_MMA
#undef PG8_WAIT_V
#undef PG8_WAIT_L
#undef PG8_BAR
#undef PG8_SCHED
#undef PG8_APTR
}
}

struct TrDesc { const float* src; bf16_t* dst; const float* ks; int ldsrc, ldd; float scale; };
__device__ __forceinline__ TrDesc tr_desc(const Params& p, int it) {
    constexpr int T0 = 1536, T1 = T0 + 2048, T2 = T1 + 2048, T3 = T2 + 512, T4 = T3 + 512, T5 = T4 + 1024, T6 = T5 + 64, T7 = T6 + 64;
    const int l = it / T7, r = it % T7;
    bf16_t* Wl = p.W_() + (size_t)l * WL;
    TrDesc d; d.scale = 1.f; d.ks = nullptr;
    int k0, c0, r0, kd0; const float* src; bf16_t* dst;
    if (r < T0)      { const int q = r;      src = p.w_in + (size_t)l * D * NIN; d.ldsrc = NIN; k0 = (q & 31) * 64; c0 = (q >> 5) * 64; dst = Wl + W1_OFF; d.ldd = D; r0 = (q >> 5) * 64; kd0 = k0; d.ks = p.norm_g + (size_t)l * D; }
    else if (r < T1) { const int q = r - T0; src = p.w_in + (size_t)l * D * NIN; d.ldsrc = NIN; k0 = (q & 31) * 64; c0 = 3080 + (q >> 5) * 64; dst = Wl + W1_OFF; d.ldd = D; r0 = 3072 + (q >> 5) * 64; kd0 = k0; d.ks = p.norm_g + (size_t)l * D; }
    else if (r < T2) { const int q = r - T1, ct = q >> 5;
                       src = p.w_gate + (size_t)l * D * 4096; d.ldsrc = 4096; k0 = (q & 31) * 64; c0 = (((ct & 3) < 2) ? 0 : 2048) + 128 * (ct >> 2) + (ct & 1) * 64; dst = Wl + W1_OFF; d.ldd = D; r0 = C_GM + ct * 64; kd0 = k0; d.ks = p.norm_g + (size_t)l * D; }
    else if (r < T3) { const int q = r - T2; src = p.w_pm + (size_t)l * WM * D; d.ldsrc = D; k0 = (q & 15) * 64; c0 = (q >> 4) * 64; dst = Wl + W3_OFF; d.ldd = D; r0 = c0; kd0 = k0; }
    else if (r < T4) { const int q = r - T3; src = p.w_pr + (size_t)l * WM * D; d.ldsrc = D; k0 = (q & 15) * 64; c0 = (q >> 4) * 64; dst = Wl + W3_OFF; d.ldd = D; r0 = c0; kd0 = 1024 + k0; }
    else if (r < T5) { const int q = r - T4; src = p.w_o + (size_t)l * D * D; d.ldsrc = D; k0 = (q & 31) * 64; c0 = (q >> 5) * 64; dst = Wl + W4_OFF; d.ldd = D; r0 = c0; kd0 = k0; }
    else if (r < T6) { const int q = r - T5, h = q >> 4, qq = q & 15; src = p.w_qm + ((size_t)l * HM + h) * SZ; d.ldsrc = DH; k0 = (qq & 3) * 64; c0 = (qq >> 2) * 64; dst = Wl + W2_OFF; d.ldd = DH; r0 = h * 512 + c0; kd0 = k0; d.scale = 0.0625f; }
    else             { const int q = r - T6, h = q >> 4, qq = q & 15; src = p.w_km + ((size_t)l * HM + h) * SZ; d.ldsrc = DH; k0 = (qq & 3) * 64; c0 = (qq >> 2) * 64; dst = Wl + W2_OFF; d.ldd = DH; r0 = h * 512 + 256 + c0; kd0 = k0; }
    d.src = src + (size_t)k0 * d.ldsrc + c0; d.dst = dst + (size_t)r0 * d.ldd + kd0; if (d.ks) d.ks += k0;
    return d;
}
__device__ __forceinline__ void tr_load(const TrDesc& d, f32x4 (&v)[16], f32x4 (&ks)[2], int lane) {
#pragma unroll
    for (int i = 0; i < 16; ++i) v[i] = __builtin_nontemporal_load((const f32x4*)(d.src + (size_t)((lane >> 4) + 4 * i) * d.ldsrc + 4 * (lane & 15)));
    if (d.ks) { ks[0] = *(const f32x4*)(d.ks + 8 * (lane & 7)); ks[1] = *(const f32x4*)(d.ks + 8 * (lane & 7) + 4); }
    else { ks[0] = (f32x4){1.f, 1.f, 1.f, 1.f}; ks[1] = ks[0]; }
}
__device__ __forceinline__ void tr_store(const TrDesc& d, const f32x4 (&v)[16], const f32x4 (&ks)[2], LAS float* t, int lane) {
#pragma unroll
    for (int i = 0; i < 16; ++i)
#pragma unroll
        for (int j = 0; j < 4; ++j) t[((lane >> 4) + 4 * i) * 65 + 4 * (lane & 15) + j] = v[i][j];
    const int c = lane & 7;
    const f32x4 s0 = ks[0] * d.scale, s1 = ks[1] * d.scale;
#pragma unroll
    for (int j = 0; j < 8; ++j) { const int n = (lane >> 3) + 8 * j; const LAS float* q = t + (8 * c) * 65 + n;
        u32x4 o; o.x = pk2(s0[0] * q[0], s0[1] * q[65]); o.y = pk2(s0[2] * q[130], s0[3] * q[195]); o.z = pk2(s1[0] * q[260], s1[1] * q[325]); o.w = pk2(s1[2] * q[390], s1[3] * q[455]);
        *(u32x4*)(d.dst + (size_t)n * d.ldd + 8 * c) = o; }
}
template <class Map>
__device__ __forceinline__ void tr_run(const Params& p, int j, const int step, const int nj, LAS unsigned char* lds, Map map) {
    const int tid = opaque_tid();
    const int lane = tid & 63, wid = tid >> 6;
    LAS float* t = (LAS float*)lds + wid * (64 * 65);
    if (j < nj) {
        TrDesc d = tr_desc(p, map(j));
        f32x4 v[16], ks[2];
        tr_load(d, v, ks, lane);
        for (;;) {
            const int j2 = j + step;
            const bool has = j2 < nj;
            TrDesc d2 = d; f32x4 v2[16], ks2[2];
            if (has) { d2 = tr_desc(p, map(j2)); tr_load(d2, v2, ks2, lane); }
            tr_store(d, v, ks, t, lane);
            if (!has) break;
#pragma unroll
            for (int i = 0; i < 16; ++i) v[i] = v2[i];
            ks[0] = ks2[0]; ks[1] = ks2[1]; d = d2; j = j2;
        }
    }
}
constexpr int G1_UNITS = (MPAD / 256) * (N1 / 256), TR_DEF_PER_WAVE = 6;
__device__ __forceinline__ int g1_rem(int nwg) { return G1_UNITS % nwg; }
__device__ __forceinline__ int tr_def(int nwg) { const int r = g1_rem(nwg); const int d = r ? (nwg - r) * 8 * TR_DEF_PER_WAVE : 0; return d < 2048 ? d : 2048; }
__device__ __forceinline__ void prep_phase(const Params& p, int wg, int nwg, LAS unsigned char* lds) {
    const int tid = opaque_tid();
    {
        const int lane = tid & 63, wid = tid >> 6;
        for (int row = wg * 8 + wid; row < MPAD; row += nwg * 8) {
            u32x2* hrow = (u32x2*)(p.Xb_() + (size_t)row * D);
            float ss = 0.f;
            if (row < MT) {
                const f32x4* xr = (const f32x4*)(row < MP ? p.x_prompt + (size_t)row * D : p.x_sample + (size_t)(row - MP) * D);
#pragma unroll
                for (int i = 0; i < 8; ++i) { const f32x4 v = xr[lane + 64 * i]; ss += (v[0] * v[0] + v[1] * v[1]) + (v[2] * v[2] + v[3] * v[3]); hrow[lane + 64 * i] = (u32x2){pk2(v[0], v[1]), pk2(v[2], v[3])}; }
                ss = wave_sum(ss);
            } else {
#pragma unroll
                for (int i = 0; i < 8; ++i) hrow[lane + 64 * i] = (u32x2){0u, 0u};
            }
            if (lane < 5) p.SS_()[(size_t)lane * MPAD + row] = lane == 0 ? ss_fix(ss) : 0ull;
            if (row < MP && lane < 8) p.SSP_()[(size_t)row * 8 + lane] = lane == 0 ? ss : 0.f;
        }
    }
    for (int i = wg * 512 + tid; i < 2049 * 128; i += nwg * 512) {
        const int pi = i >> 7, j = i & 127;
        const float pos = pi < 2048 ? (float)pi : 16384.0f;
        const float inv = powf(10000.0f, -((float)j / 128.0f));
        const float ang = pos * inv;
        p.ROPE_()[2 * i] = (float)cos((double)ang); p.ROPE_()[2 * i + 1] = (float)sin((double)ang);
    }
    for (int i = wg * 512 + tid; i < DEPTH * 256 * D; i += nwg * 512) {
        const int l = i / (256 * D), r = i % (256 * D), j = r / D, k = r % D;
        p.W_()[(size_t)l * WL + W1_OFF + (size_t)(11264 + j) * D + k] = j < 8 ? f2bf(p.w_in[((size_t)l * D + k) * NIN + 3072 + j] * p.norm_g[(size_t)l * D + k]) : (bf16_t)0;
    }
    const int def = tr_def(nwg), rest = 7808 - def;
    tr_run(p, wg * 8 + (tid >> 6), nwg * 8, 7808 + (DEPTH - 1) * rest - def, lds, [=](int j) { if (j < 7808) return j; const int q = j - 7808, l = q / rest; int r = def + (q - l * rest); if (l == DEPTH - 2 && r >= 5632) r += def; return (l + 1) * 7808 + r; });
}

__device__ __forceinline__ void final_phase(const Params& p, int wg, int nwg) {
    const int tid_ = opaque_tid(), lane = tid_ & 63, wid = tid_ >> 6;
    const f32x4* g4 = (const f32x4*)p.final_g;
    for (int row = wg * 8 + wid; row < MT; row += nwg * 8) {
        const u32x2* xr = (const u32x2*)(p.Xb_() + (size_t)row * D);
        f32x4* yr = (f32x4*)(p.out + (row < MP ? O_YP + (size_t)row * D : O_YS + (size_t)(row - MP) * D));
        const float rstd = rsqrtf(row_ss(p.SSP_(), p.SS_() + (size_t)4 * MPAD, row) * (1.0f / D) + EPS);
#pragma unroll
        for (int i = 0; i < 8; ++i) { const u32x2 xb = xr[lane + 64 * i];
            const f32x4 v = (f32x4){__uint_as_float(xb.x << 16), __uint_as_float(xb.x & 0xffff0000u), __uint_as_float(xb.y << 16), __uint_as_float(xb.y & 0xffff0000u)};
            yr[lane + 64 * i] = v * rstd * g4[lane + 64 * i]; }
    }
}

__device__ __forceinline__ void unpack8(const u32x4 v, float (&f)[8]) {
    f[0] = __uint_as_float(v.x << 16); f[1] = __uint_as_float(v.x & 0xffff0000u); f[2] = __uint_as_float(v.y << 16); f[3] = __uint_as_float(v.y & 0xffff0000u);
    f[4] = __uint_as_float(v.z << 16); f[5] = __uint_as_float(v.z & 0xffff0000u); f[6] = __uint_as_float(v.w << 16); f[7] = __uint_as_float(v.w & 0xffff0000u);
}
__device__ __forceinline__ u32x4 pack8(const float (&f)[8]) { u32x4 w; w.x = pk2(f[0], f[1]); w.y = pk2(f[2], f[3]); w.z = pk2(f[4], f[5]); w.w = pk2(f[6], f[7]); return w; }

__device__ __forceinline__ void gate_all(const Params& p, int layer, int bh, LAS float* G);
__device__ __forceinline__ void conv_phase(const Params& p, int layer, int wg, int nwg, LAS unsigned char* lds) {
    const int tid = opaque_tid();
    for (int bh = wg; bh < 16; bh += nwg) gate_all(p, layer, bh, (LAS float*)lds);
    const float* cw = p.conv_w + (size_t)layer * 4 * WM;
    const float* cb = p.conv_b + (size_t)layer * WM;
    const int cwg = nwg > 32 ? wg - 16 : wg, cnw = nwg > 32 ? nwg - 16 : nwg;
    if (cwg >= 0) {
        constexpr int CR = 2;
        const int ch = (tid & 127) * 8;
        float w[4][8], bs[8];
#pragma unroll
        for (int i = 0; i < 4; ++i) { const f32x4 a = *(const f32x4*)(cw + i * WM + ch), c = *(const f32x4*)(cw + i * WM + ch + 4);
            w[i][0] = a[0]; w[i][1] = a[1]; w[i][2] = a[2]; w[i][3] = a[3]; w[i][4] = c[0]; w[i][5] = c[1]; w[i][6] = c[2]; w[i][7] = c[3]; }
        { const f32x4 a = *(const f32x4*)(cb + ch), c = *(const f32x4*)(cb + ch + 4); bs[0] = a[0]; bs[1] = a[1]; bs[2] = a[2]; bs[3] = a[3]; bs[4] = c[0]; bs[5] = c[1]; bs[6] = c[2]; bs[7] = c[3]; }
#pragma unroll 1
        for (int blk = cwg * 4 + (tid >> 7); blk < MP / CR; blk += cnw * 4) {
            const int row = blk * CR, t = row & (SEQ - 1);
            float up[CR + 3][8];
#pragma unroll
            for (int i = 0; i < CR + 3; ++i) {
                if (t - 3 + i >= 0) unpack8(*(const u32x4*)(p.P_() + (size_t)(row - 3 + i) * NP + C_U + ch), up[i]);
                else {
#pragma unroll
                    for (int j = 0; j < 8; ++j) up[i][j] = 0.f;
                }
            }
#pragma unroll
            for (int r = 0; r < CR; ++r) {
                if (t + r >= SEQ - 3) {
                    float* o = p.out + O_CVP + (((size_t)layer * BP + (row >> 11)) * 3 + (t + r - (SEQ - 3))) * WM + ch;
                    *(f32x4*)o = (f32x4){up[r + 3][0], up[r + 3][1], up[r + 3][2], up[r + 3][3]}; *(f32x4*)(o + 4) = (f32x4){up[r + 3][4], up[r + 3][5], up[r + 3][6], up[r + 3][7]};
                }
                float q[8];
#pragma unroll
                for (int j = 0; j < 8; ++j) q[j] = bs[j];
#pragma unroll
                for (int i = 0; i < 4; ++i)
#pragma unroll
                    for (int j = 0; j < 8; ++j) q[j] += up[r + i][j] * w[i][j];
#pragma unroll
                for (int j = 0; j < 8; ++j) q[j] = siluf_(q[j]);
                *(u32x4*)(p.CM_() + (size_t)(row + r) * WM + ch) = pack8(q);
            }
        }
        for (int it = (cnw - 1 - cwg) * 512 + tid; it < BS * 128; it += cnw * 512) {
            const int b = it >> 7, row = MP + b;
            float up[4][8];
            const float* hist = p.st_conv + ((size_t)layer * BS + b) * 3 * WM + ch;
#pragma unroll
            for (int i = 0; i < 3; ++i) { const f32x4 a = *(const f32x4*)(hist + (size_t)i * WM), c = *(const f32x4*)(hist + (size_t)i * WM + 4);
                up[i][0] = a[0]; up[i][1] = a[1]; up[i][2] = a[2]; up[i][3] = a[3]; up[i][4] = c[0]; up[i][5] = c[1]; up[i][6] = c[2]; up[i][7] = c[3]; }
            unpack8(*(const u32x4*)(p.P_() + (size_t)row * NP + C_U + ch), up[3]);
            float* o = p.out + O_CVS + ((size_t)layer * BS + b) * 3 * WM + ch;
#pragma unroll
            for (int i = 0; i < 3; ++i) { *(f32x4*)(o + (size_t)i * WM) = (f32x4){up[i + 1][0], up[i + 1][1], up[i + 1][2], up[i + 1][3]};
                *(f32x4*)(o + (size_t)i * WM + 4) = (f32x4){up[i + 1][4], up[i + 1][5], up[i + 1][6], up[i + 1][7]}; }
            float q[8];
#pragma unroll
            for (int j = 0; j < 8; ++j) q[j] = bs[j];
#pragma unroll
            for (int i = 0; i < 4; ++i)
#pragma unroll
                for (int j = 0; j < 8; ++j) q[j] += up[i][j] * w[i][j];
#pragma unroll
            for (int j = 0; j < 8; ++j) q[j] = siluf_(q[j]);
            *(u32x4*)(p.CM_() + (size_t)row * WM + ch) = pack8(q);
        }
    }
}

__device__ __forceinline__ void gate_all(const Params& p, int layer, int bh, LAS float* G) {
    const int tid = opaque_tid(), lane = tid & 63, wid = tid >> 6, b = bh >> 2, h = bh & 3;
    const float bi = p.b_i[layer * HM + h], bfv = p.b_f[layer * HM + h];
    float* gt = p.GT_() + (size_t)bh * 6208;
    float tb0[2], tb1[2], tg0[2], tg1[2], rm0[2], rm1[2];
#pragma unroll
    for (int q = 0; q < 2; ++q) {
        const int cc = wid + 8 * q;
        const size_t r0 = (size_t)b * SEQ + cc * 128 + 2 * lane;
        const float i0 = p.IF_()[r0 * 8 + h] + bi, i1 = p.IF_()[(r0 + 1) * 8 + h] + bi;
        const float l0 = logsigf_(p.IF_()[r0 * 8 + 4 + h] + bfv), l1 = logsigf_(p.IF_()[(r0 + 1) * 8 + 4 + h] + bfv);
        float inc = l0 + l1;
#pragma unroll
        for (int o = 1; o < 64; o <<= 1) { const float t = __shfl_up(inc, o); if (lane >= o) inc += t; }
        const float exc = inc - (l0 + l1);
        tb0[q] = exc + l0; tb1[q] = inc;
        tg0[q] = i0 - tb0[q]; tg1[q] = i1 - tb1[q];
        const float gm = wave_max(fmaxf(tg0[q], tg1[q]));
        const float Bc = __shfl(inc, 63);
        if (lane == 0) { G[cc] = Bc; G[16 + cc] = gm; }
        float rm = fmaxf(tg0[q], tg1[q]);
#pragma unroll
        for (int o = 1; o < 64; o <<= 1) { const float t = __shfl_up(rm, o); if (lane >= o) rm = fmaxf(rm, t); }
        float ex = __shfl_up(rm, 1); if (lane == 0) ex = -3.0e38f;
        rm0[q] = fmaxf(ex, tg0[q]); rm1[q] = fmaxf(rm0[q], tg1[q]);
    }
    __syncthreads();
    if (tid == 0) { float m = -1e30f;
#pragma unroll 1
        for (int cc = 0; cc < 16; ++cc) { G[32 + cc] = m; m = G[cc] + fmaxf(m, G[16 + cc]); } G[48] = m; }
    __syncthreads();
#pragma unroll
    for (int q = 0; q < 2; ++q) {
        const int cc = wid + 8 * q, t0 = cc * 128 + 2 * lane;
        const float mc = G[32 + cc];
        *(f32x2_t*)(gt + t0) = (f32x2_t){tb0[q], tb1[q]}; *(f32x2_t*)(gt + 2048 + t0) = (f32x2_t){tg0[q], tg1[q]};
        *(f32x2_t*)(gt + 4096 + t0) = (f32x2_t){fmaxf(rm0[q], mc), fmaxf(rm1[q], mc)};
    }
    if (tid < 16) { gt[6144 + tid] = G[tid]; gt[6160 + tid] = G[16 + tid]; }
    if (tid < 17) gt[6176 + tid] = G[32 + tid];
    __syncthreads();
}
__device__ __forceinline__ void gate_load(const Params& p, int bh, int c, LAS float* G, int tid) {
    const float* gt = p.GT_() + (size_t)bh * 6208;
    if (tid < 128) { G[64 + tid] = gt[c * 128 + tid]; G[192 + tid] = gt[2048 + c * 128 + tid]; G[320 + tid] = gt[4096 + c * 128 + tid]; }
    if (tid == 0) G[32 + c] = gt[6176 + c];
    __syncthreads();
}

template <int I> struct IC { static constexpr int value = I; };
template <int I, int N, class F> __device__ __forceinline__ void sfor(F&& f) { if constexpr (I < N) { f(IC<I>{}); sfor<I + 1, N>(f); } }

template <int CPR>
__device__ __forceinline__ void tile_load(u32x4 (&r)[8], const bf16_t* src, int ld_src, int tid) {
#pragma unroll
    for (int i = 0; i < 8; ++i) { const int id = tid + 512 * i, row = id / CPR, ch = id % CPR; r[i] = *(const u32x4*)(src + (size_t)row * ld_src + ch * 8); }
}
template <int CPR, int LDB>
__device__ __forceinline__ void tile_store(LAS unsigned char* dst, const u32x4 (&r)[8], int tid) {
#pragma unroll
    for (int i = 0; i < 8; ++i) { const int id = tid + 512 * i, row = id / CPR, ch = id % CPR; *(LAS u32x4*)(dst + row * LDB + ch * 16) = r[i]; }
}
__device__ __forceinline__ void tile_store_w(LAS unsigned char* dst, const u32x4 (&r)[8], LAS const float* w, int tid) {
#pragma unroll
    for (int i = 0; i < 8; ++i) { const int id = tid + 512 * i, row = id >> 5, ch = id & 31; float f[8]; unpack8(r[i], f); const float ww = w[row];
#pragma unroll
        for (int j = 0; j < 8; ++j) f[j] *= ww;
        *(LAS u32x4*)(dst + row * 544 + ch * 16) = pack8(f); }
}
template <int OFF, int HS>
__device__ __forceinline__ bf16x8 tr_frag1(unsigned base) {
    u32x2 l0, h0;
    asm volatile("ds_read_b64_tr_b16 %0, %2 offset:%3\n\tds_read_b64_tr_b16 %1, %2 offset:%4\n\ts_waitcnt lgkmcnt(0)"
                 : "=&v"(l0), "=&v"(h0) : "v"(base), "i"(OFF), "i"(OFF + HS) : "memory");
    const u32x4 v = (u32x4){l0.x, l0.y, h0.x, h0.y};
    return __builtin_bit_cast(bf16x8, v);
}
template <int OFF, int HS, int TS>
__device__ __forceinline__ void tr_frag2(unsigned base, bf16x8& f0, bf16x8& f1) {
    u32x2 l0, l1, h0, h1;
    asm volatile("ds_read_b64_tr_b16 %0, %4 offset:%5\n\tds_read_b64_tr_b16 %2, %4 offset:%6\n\t"
                 "ds_read_b64_tr_b16 %1, %4 offset:%7\n\tds_read_b64_tr_b16 %3, %4 offset:%8\n\t"
                 "s_waitcnt lgkmcnt(0)"
                 : "=&v"(l0), "=&v"(l1), "=&v"(h0), "=&v"(h1)
                 : "v"(base), "i"(OFF), "i"(OFF + HS), "i"(OFF + TS), "i"(OFF + TS + HS)
                 : "memory");
    f0 = __builtin_bit_cast(bf16x8, (u32x4){l0.x, l0.y, h0.x, h0.y}); f1 = __builtin_bit_cast(bf16x8, (u32x4){l1.x, l1.y, h1.x, h1.y});
}
template <int OFF, int HS, int TS>
__device__ __forceinline__ void tr_frag4(unsigned base, bf16x8 (&f)[4]) {
    u32x2 l0, l1, l2, l3, h0, h1, h2, h3;
    asm volatile("ds_read_b64_tr_b16 %0, %8 offset:%9\n\tds_read_b64_tr_b16 %4, %8 offset:%10\n\t"
                 "ds_read_b64_tr_b16 %1, %8 offset:%11\n\tds_read_b64_tr_b16 %5, %8 offset:%12\n\t"
                 "ds_read_b64_tr_b16 %2, %8 offset:%13\n\tds_read_b64_tr_b16 %6, %8 offset:%14\n\t"
                 "ds_read_b64_tr_b16 %3, %8 offset:%15\n\tds_read_b64_tr_b16 %7, %8 offset:%16\n\t"
                 "s_waitcnt lgkmcnt(0)"
                 : "=&v"(l0), "=&v"(l1), "=&v"(l2), "=&v"(l3), "=&v"(h0), "=&v"(h1), "=&v"(h2), "=&v"(h3)
                 : "v"(base), "i"(OFF), "i"(OFF + HS), "i"(OFF + TS), "i"(OFF + TS + HS), "i"(OFF + 2 * TS), "i"(OFF + 2 * TS + HS), "i"(OFF + 3 * TS), "i"(OFF + 3 * TS + HS)
                 : "memory");
    f[0] = __builtin_bit_cast(bf16x8, (u32x4){l0.x, l0.y, h0.x, h0.y}); f[1] = __builtin_bit_cast(bf16x8, (u32x4){l1.x, l1.y, h1.x, h1.y});
    f[2] = __builtin_bit_cast(bf16x8, (u32x4){l2.x, l2.y, h2.x, h2.y}); f[3] = __builtin_bit_cast(bf16x8, (u32x4){l3.x, l3.y, h3.x, h3.y});
}
__device__ __forceinline__ unsigned lds_addr(LAS const void* p) { return (unsigned)(size_t)p; }

template <int NR, int NC, bool WEIGHT>
__device__ __forceinline__ void stage_T(LAS unsigned char* dst, int ldd_bytes, const bf16_t* src, int ld_src, LAS const float* w) {
    const int tid_ = opaque_tid(), lane = tid_ & 63, wid = tid_ >> 6;
    constexpr int PB = NR / 128, CG = NC / 8;
#pragma unroll 1
    for (int task = wid; task < PB * CG; task += 8) {
        const int pb = task % PB, cg = task / PB, r = pb * 128 + 2 * lane;
        float a[8], c[8];
        unpack8(*(const u32x4*)(src + (size_t)r * ld_src + cg * 8), a); unpack8(*(const u32x4*)(src + (size_t)(r + 1) * ld_src + cg * 8), c);
        float w0 = 1.f, w1 = 1.f; if (WEIGHT) { w0 = w[r]; w1 = w[r + 1]; }
#pragma unroll
        for (int j = 0; j < 8; ++j) *(LAS unsigned*)(dst + (cg * 8 + j) * ldd_bytes + r * 2) = pk2(a[j] * w0, c[j] * w1);
    }
}
__device__ __forceinline__ void stage_rows(LAS unsigned char* dst, const bf16_t* src, int ld_src) {
    const int tid_ = opaque_tid();
#pragma unroll
    for (int i = 0; i < 8; ++i) { const int id = tid_ + 512 * i, row = id >> 5, ch = id & 31;
        *(LAS u32x4*)(dst + row * 528 + ch * 16) = *(const u32x4*)(src + (size_t)row * ld_src + ch * 8); }
}
__device__ __forceinline__ bf16x8 lds_frag(LAS const unsigned char* base, int row, int ld_bytes, int kbyte) { return *(LAS const bf16x8*)(base + row * ld_bytes + kbyte); }
__device__ __forceinline__ float ret_lg(int h) { return logf(1.0f - exp2f(-5.0f - (float)h)); }

template <int BR>
__device__ __forceinline__ void chunk_passA(const Params& p, int layer, int b, int h, int c, LAS unsigned char* lds) {
    LAS unsigned char* Xt = lds; LAS unsigned char* Yt = lds + 69632; LAS float* G = (LAS float*)(lds + 139264); LAS float* wk = G + 512;
    const int tid = opaque_tid(), lane = tid & 63, w = __builtin_amdgcn_readfirstlane(tid >> 6), g = lane >> 4, lr = lane & 15;
    const size_t row0 = (size_t)b * SEQ + c * 128;
    const int pi = BR * 16 + b * 4 + h;
    const bf16_t* Xp = BR == 0 ? p.QK_() + row0 * 2048 + h * 512 + 256 : p.P_() + row0 * NP + C_VR + h * 256;
    const bf16_t* Yp = BR == 0 ? p.P_() + row0 * NP + C_VM + h * 256 : p.P_() + row0 * NP + C_KR + h * 256;
    u32x4 xr[8], yr[8];
    tile_load<32>(xr, Xp, BR == 0 ? 2048 : NP, tid); tile_load<32>(yr, Yp, NP, tid);
    if (BR == 0) { gate_load(p, b * 4 + h, c, G, tid); if (tid < 128) wk[tid] = expf(G[192 + tid] - G[320 + 127]); }
    else { if (tid < 128) wk[tid] = expf((float)(127 - tid) * ret_lg(h)); }
    __syncthreads();
    tile_store<32, 544>(Xt, xr, tid); tile_store_w(Yt, yr, wk, tid);
    __syncthreads();
    const unsigned lpart = (unsigned)(((8 * g + (lr >> 2)) * 272 + 4 * (lr & 3)) * 2);
    const unsigned baseX = lds_addr(Xt) + lpart + (unsigned)(32 * w * 2), baseY = lds_addr(Yt) + lpart;
    bf16_t* Uo = p.U_() + ((size_t)pi * 16 + c) * SZ;
    sfor<0, 2>([&](auto rt_) {
        constexpr int rt = decltype(rt_)::value;
        f32x4 acc[16];
#pragma unroll
        for (int j = 0; j < 16; ++j) acc[j] = (f32x4){0.f, 0.f, 0.f, 0.f};
        sfor<0, 4>([&](auto ks_) {
            constexpr int ks = decltype(ks_)::value;
            const bf16x8 fa = tr_frag1<ks * 32 * 544 + rt * 32, 4 * 544>(baseX);
            sfor<0, 4>([&](auto cq_) {
                constexpr int cq = decltype(cq_)::value;
                bf16x8 fb[4];
                tr_frag4<ks * 32 * 544 + cq * 128, 4 * 544, 32>(baseY, fb);
#pragma unroll
                for (int i = 0; i < 4; ++i) acc[4 * cq + i] = __builtin_amdgcn_mfma_f32_16x16x32_bf16(fa, fb[i], acc[4 * cq + i], 0, 0, 0);
            });
        });
#pragma unroll
        for (int ct = 0; ct < 16; ++ct)
            *(u32x2*)(Uo + (size_t)(16 * ct + lr) * 256 + 32 * w + 16 * rt + 4 * g) = (u32x2){pk2(acc[ct][0], acc[ct][1]), pk2(acc[ct][2], acc[ct][3])};
    });
    if (BR == 0 && tid < 256) {
        float sacc = 0.f;
        for (int ss = 0; ss < 128; ++ss) sacc += wk[ss] * bf2f(*(LAS const bf16_t*)(Xt + ss * 544 + tid * 2));
        p.NU_()[((size_t)(b * 4 + h) * 16 + c) * 256 + tid] = sacc;
    }
    __syncthreads();
}

template <int BR>
__device__ __forceinline__ void chunk_state_item(const Params& p, int layer, int b, int h, int sl, LAS unsigned char* lds) {
    LAS unsigned char* Xt = lds;
    LAS unsigned char* Ys = lds + 69632;
    LAS float* wka = (LAS float*)(lds + 79872);
    LAS float* dec = wka + 2048;
    const int tid = opaque_tid(), lane = tid & 63, w = __builtin_amdgcn_readfirstlane(tid >> 6), g = lane >> 4, lr = lane & 15;
    const int bh = b * 4 + h, pi = BR * 16 + bh;
    const float* gt = p.GT_() + (size_t)bh * 6208;
    if (BR == 0) {
#pragma unroll
        for (int i = 0; i < 4; ++i) { const int t = tid + 512 * i; wka[t] = expf(gt[2048 + t] - gt[4096 + (t | 127)]); }
        if (tid < 16) { const float mc = gt[6176 + tid]; dec[tid] = expf(mc - fmaxf(mc, gt[6160 + tid])); }
    } else {
        const float lg = ret_lg(h);
#pragma unroll
        for (int i = 0; i < 4; ++i) { const int t = tid + 512 * i; wka[t] = expf((float)(127 - (t & 127)) * lg); }
        if (tid < 16) dec[tid] = expf(128.0f * lg);
    }
    const size_t rowb = (size_t)b * SEQ;
    const bf16_t* Xp = BR == 0 ? p.QK_() + rowb * 2048 + h * 512 + 256 : p.P_() + rowb * NP + C_VR + h * 256;
    const int ldX = BR == 0 ? 2048 : NP;
    const bf16_t* Yp = (BR == 0 ? p.P_() + rowb * NP + C_VM + h * 256 : p.P_() + rowb * NP + C_KR + h * 256) + 32 * sl;
    const unsigned yoff = (unsigned)((tid >> 2) * NP + (tid & 3) * 8) * 2u;
    u32x4 xa[8], xb[8], ya, yb;
    tile_load<32>(xa, Xp, ldX, tid); ya = *(const u32x4*)((const char*)Yp + yoff);
    tile_load<32>(xb, Xp + (size_t)128 * ldX, ldX, tid); yb = *(const u32x4*)((const char*)(Yp + (size_t)128 * NP) + yoff);
    f32x4 st[2][2], nst[2];
#pragma unroll
    for (int i = 0; i < 2; ++i) { nst[i] = (f32x4){0.f, 0.f, 0.f, 0.f};
#pragma unroll
        for (int j = 0; j < 2; ++j) st[i][j] = (f32x4){0.f, 0.f, 0.f, 0.f}; }
    const unsigned lpart = (unsigned)(((8 * g + (lr >> 2)) * 272 + 4 * (lr & 3)) * 2), lparty = (unsigned)(((8 * g + (lr >> 2)) * 40 + 4 * (lr & 3)) * 2);
    const unsigned baseX = lds_addr(Xt) + lpart + (unsigned)(32 * w * 2), baseY = lds_addr(Ys) + lparty;
    bf16_t* CSp = p.CS_() + (size_t)pi * 16 * SZ + (size_t)(32 * sl + lr) * 256 + 32 * w + 4 * g;
    float* NSp = p.NS_() + (size_t)bh * 16 * 256 + 32 * w + 4 * g;
    const bool nown = (BR == 0) && (sl == 0) && (lr == 0);
    __syncthreads();
    auto step = [&](int c, u32x4 (&xr)[8], u32x4& yr) {
#pragma unroll
        for (int rt = 0; rt < 2; ++rt) {
#pragma unroll
            for (int ct = 0; ct < 2; ++ct) *(u32x2*)(CSp + (size_t)c * SZ + (size_t)(16 * ct) * 256 + 16 * rt) = (u32x2){pk2(st[rt][ct][0], st[rt][ct][1]), pk2(st[rt][ct][2], st[rt][ct][3])};
            if (nown) *(f32x4*)(NSp + (size_t)c * 256 + 16 * rt) = nst[rt];
        }
        tile_store<32, 544>(Xt, xr, tid);
        { float f[8]; unpack8(yr, f); const float ww = wka[c * 128 + (tid >> 2)];
#pragma unroll
          for (int j = 0; j < 8; ++j) f[j] *= ww;
          *(LAS u32x4*)(Ys + (tid >> 2) * 80 + (tid & 3) * 16) = pack8(f); }
        __syncthreads();
        if (c + 2 < 16) {
            tile_load<32>(xr, Xp + (size_t)(c + 2) * 128 * ldX, ldX, tid);
            yr = *(const u32x4*)((const char*)(Yp + (size_t)(c + 2) * 128 * NP) + yoff);
        }
        f32x4 u[2][2], un[2];
#pragma unroll
        for (int i = 0; i < 2; ++i) { un[i] = (f32x4){0.f, 0.f, 0.f, 0.f};
#pragma unroll
            for (int j = 0; j < 2; ++j) u[i][j] = (f32x4){0.f, 0.f, 0.f, 0.f}; }
        sfor<0, 4>([&](auto ks_) {
            constexpr int ks = decltype(ks_)::value;
            bf16x8 fa0, fa1, fb0, fb1;
            tr_frag2<ks * 32 * 544, 4 * 544, 32>(baseX, fa0, fa1);
            tr_frag2<ks * 32 * 80, 4 * 80, 32>(baseY, fb0, fb1);
            u[0][0] = __builtin_amdgcn_mfma_f32_16x16x32_bf16(fa0, fb0, u[0][0], 0, 0, 0); u[0][1] = __builtin_amdgcn_mfma_f32_16x16x32_bf16(fa0, fb1, u[0][1], 0, 0, 0);
            u[1][0] = __builtin_amdgcn_mfma_f32_16x16x32_bf16(fa1, fb0, u[1][0], 0, 0, 0); u[1][1] = __builtin_amdgcn_mfma_f32_16x16x32_bf16(fa1, fb1, u[1][1], 0, 0, 0);
            if (BR == 0) {
                const f32x4 w0 = *(LAS const f32x4*)(wka + c * 128 + 32 * ks + 8 * g), w1 = *(LAS const f32x4*)(wka + c * 128 + 32 * ks + 8 * g + 4);
                u32x4 wv = (u32x4){pk2(w0[0], w0[1]), pk2(w0[2], w0[3]), pk2(w1[0], w1[1]), pk2(w1[2], w1[3])};
                if (lr != 0) wv = (u32x4){0u, 0u, 0u, 0u};
                const bf16x8 wf = __builtin_bit_cast(bf16x8, wv);
                un[0] = __builtin_amdgcn_mfma_f32_16x16x32_bf16(fa0, wf, un[0], 0, 0, 0); un[1] = __builtin_amdgcn_mfma_f32_16x16x32_bf16(fa1, wf, un[1], 0, 0, 0);
            }
        });
        const float dc = dec[c];
#pragma unroll
        for (int i = 0; i < 2; ++i) { nst[i] = nst[i] * dc + un[i];
#pragma unroll
            for (int j = 0; j < 2; ++j) st[i][j] = st[i][j] * dc + u[i][j]; }
        __syncthreads();
    };
#pragma unroll 1
    for (int c = 0; c < 16; c += 2) { step(c, xa, ya); step(c + 1, xb, yb); }
    float* fo = p.out + (BR == 0 ? O_CP : O_SP) + (((size_t)layer * BP + b) * HM + h) * SZ + (size_t)(32 * sl + lr) * 256 + 32 * w + 4 * g;
#pragma unroll
    for (int rt = 0; rt < 2; ++rt) {
#pragma unroll
        for (int ct = 0; ct < 2; ++ct) *(f32x4*)(fo + (size_t)(16 * ct) * 256 + 16 * rt) = st[rt][ct];
        if (nown) *(f32x4*)(p.out + O_NP + (((size_t)layer * BP + b) * HM + h) * 256 + 32 * w + 4 * g + 16 * rt) = nst[rt];
    }
    if (BR == 0 && sl == 0 && tid == 0) p.out[O_MP + ((size_t)layer * BP + b) * HM + h] = gt[6192];
    __syncthreads();
}

__device__ __forceinline__ void scan_item(const Params& p, int layer, int pi, int slice, LAS unsigned char* lds) {
    LAS float* G = (LAS float*)lds; LAS float* dec = G + 512;
    const int tid = opaque_tid(), br = pi >> 4, bh = pi & 15, b = bh >> 2, h = bh & 3;
    if (br == 0) { const float* gt = p.GT_() + (size_t)bh * 6208; if (tid < 16) { const float mc = gt[6176 + tid]; dec[tid] = expf(mc - fmaxf(mc, gt[6160 + tid])); } if (tid == 0) G[48] = gt[6192]; }
    else if (tid < 16) dec[tid] = expf(128.0f * ret_lg(h));
    __syncthreads();
    float st[2][8];
#pragma unroll
    for (int j = 0; j < 2; ++j)
#pragma unroll
        for (int k = 0; k < 8; ++k) st[j][k] = 0.f;
    for (int c = 0; c < 16; ++c) {
        const float dc = dec[c];
#pragma unroll
        for (int j = 0; j < 2; ++j) { const size_t idx = (size_t)slice * 8192 + j * 4096 + tid * 8;
            float u[8]; unpack8(*(const u32x4*)(p.U_() + ((size_t)pi * 16 + c) * SZ + idx), u);
            *(u32x4*)(p.CS_() + ((size_t)pi * 16 + c) * SZ + idx) = pack8(st[j]);
#pragma unroll
            for (int k = 0; k < 8; ++k) st[j][k] = st[j][k] * dc + u[k]; }
    }
    float* fo = p.out + (br == 0 ? O_CP : O_SP) + (((size_t)layer * BP + b) * HM + h) * SZ;
#pragma unroll
    for (int j = 0; j < 2; ++j) { float* q = fo + (size_t)slice * 8192 + j * 4096 + tid * 8;
        *(f32x4*)q = (f32x4){st[j][0], st[j][1], st[j][2], st[j][3]}; *(f32x4*)(q + 4) = (f32x4){st[j][4], st[j][5], st[j][6], st[j][7]}; }
    if (br == 0 && slice == 0) {
        if (tid < 256) { float n = 0.f;
            for (int c = 0; c < 16; ++c) { p.NS_()[((size_t)bh * 16 + c) * 256 + tid] = n; n = dec[c] * n + p.NU_()[((size_t)bh * 16 + c) * 256 + tid]; }
            p.out[O_NP + (((size_t)layer * BP + b) * HM + h) * 256 + tid] = n; }
        if (tid == 0) p.out[O_MP + ((size_t)layer * BP + b) * HM + h] = G[48];
    }
    __syncthreads();
}

template <int BR>
__device__ __forceinline__ void chunk_passC(const Params& p, int layer, int b, int h, int c, LAS unsigned char* lds) {
    LAS unsigned char* BufB = lds; LAS unsigned char* Sw = lds + 69632; LAS float* G = (LAS float*)(lds + 104448);
    LAS float* av = G + 512; LAS float* fl = G + 640; LAS bf16_t* nbf = (LAS bf16_t*)(G + 768);
    const int tid = opaque_tid(), lane = tid & 63, w = __builtin_amdgcn_readfirstlane(tid >> 6), g = lane >> 4, lr = lane & 15;
    const size_t row0 = (size_t)b * SEQ + c * 128;
    const int pi = BR * 16 + b * 4 + h, l = 16 * w + lr;
    const float lg = ret_lg(h);
    u32x4 tr[8];
    tile_load<32>(tr, BR == 0 ? p.QK_() + row0 * 2048 + h * 512 + 256 : p.P_() + row0 * NP + C_KR + h * 256, BR == 0 ? 2048 : NP, tid);
    if (tid < 256) { G[1024 + tid] = ((BR == 0 ? p.hn_m_g : p.hn_r_g) + (size_t)layer * WM + h * 256)[tid]; if (BR == 0) G[1280 + tid] = (p.skip_m + (size_t)layer * WM + h * 256)[tid]; }
    if (BR == 0) {
        gate_load(p, b * 4 + h, c, G, tid);
        if (tid < 128) { av[tid] = expf(G[32 + c] - G[320 + tid]); fl[tid] = expf(-(G[64 + tid] + G[320 + tid])); }
        if (tid < 256) nbf[tid] = f2bf(p.NS_()[((size_t)(b * 4 + h) * 16 + c) * 256 + tid]);
    } else { if (tid < 128) av[tid] = expf((float)(tid + 1) * lg); }
    const bf16_t* Qp = BR == 0 ? p.QK_() + (row0 + l) * 2048 + h * 512 : p.P_() + (row0 + l) * NP + C_QR + h * 256;
    bf16x8 qf[8];
#pragma unroll
    for (int ks = 0; ks < 8; ++ks) qf[ks] = *(const bf16x8*)(Qp + 32 * ks + 8 * g);
    tile_store<32, 544>(BufB, tr, tid);
    __syncthreads();
    const bf16_t* CSp = p.CS_() + ((size_t)pi * 16 + c) * SZ;
    if (BR == 0) tile_load<32>(tr, CSp, 256, tid); else tile_load<16>(tr, CSp, 256, tid);
    float rs = 0.f;
    const float Gl = BR == 0 ? G[320 + l] : 0.f;
#pragma unroll
    for (int j = 0; j < 8; ++j) {
        f32x4 a = (f32x4){0.f, 0.f, 0.f, 0.f};
        if (j <= w) {
#pragma unroll
            for (int ks = 0; ks < 8; ++ks) a = __builtin_amdgcn_mfma_f32_16x16x32_bf16(lds_frag(BufB, 16 * j + lr, 544, (32 * ks + 8 * g) * 2), qf[ks], a, 0, 0, 0);
        }
        float v[4];
#pragma unroll
        for (int r = 0; r < 4; ++r) {
            const int sidx = 16 * j + 4 * g + r;
            float d = 0.f;
            if (sidx <= l) d = BR == 0 ? expf(G[192 + sidx] - Gl) : expf((float)(l - sidx) * lg);
            v[r] = a[r] * d; rs += v[r];
        }
        *(LAS u32x2*)(Sw + l * 272 + (16 * j + 4 * g) * 2) = (u32x2){pk2(v[0], v[1]), pk2(v[2], v[3])};
        __builtin_amdgcn_sched_barrier(0);
    }
    rs += __shfl_xor(rs, 16); rs += __shfl_xor(rs, 32);
    __syncthreads();
    f32x4 accN[16];
#pragma unroll
    for (int t = 0; t < 16; ++t) accN[t] = (f32x4){0.f, 0.f, 0.f, 0.f};
    const unsigned lq = (unsigned)(8 * g + (lr >> 2)), lp4 = (unsigned)(4 * (lr & 3));
    sfor<0, 2>([&](auto half_) {
        constexpr int half = decltype(half_)::value;
        if (BR == 0) tile_store<32, 544>(BufB, tr, tid); else tile_store<16, 272>(BufB, tr, tid);
        __syncthreads();
        if (half == 0) { if (BR == 0) tile_load<32>(tr, CSp + 128 * 256, 256, tid); else tile_load<16>(tr, CSp + 128, 256, tid); }
        else tile_load<32>(tr, p.P_() + row0 * NP + (BR == 0 ? C_VM : C_VR) + h * 256, NP, tid);
        if (BR == 0) {
#pragma unroll
            for (int t = 0; t < 8; ++t) {
#pragma unroll
                for (int ks = 0; ks < 8; ++ks)
                    accN[half * 8 + t] = __builtin_amdgcn_mfma_f32_16x16x32_bf16(lds_frag(BufB, 16 * t + lr, 544, (32 * ks + 8 * g) * 2), qf[ks], accN[half * 8 + t], 0, 0, 0);
                __builtin_amdgcn_sched_barrier(0); }
        } else {
            const unsigned base = lds_addr(BufB) + (lq * 136 + lp4) * 2;
            sfor<0, 8>([&](auto ks_) {
                constexpr int ks = decltype(ks_)::value;
                sfor<0, 2>([&](auto tq_) {
                    constexpr int tq = decltype(tq_)::value;
                    bf16x8 f[4];
                    tr_frag4<ks * 32 * 272 + tq * 128, 4 * 272, 32>(base, f);
#pragma unroll
                    for (int i = 0; i < 4; ++i) accN[half * 8 + 4 * tq + i] = __builtin_amdgcn_mfma_f32_16x16x32_bf16(f[i], qf[ks], accN[half * 8 + 4 * tq + i], 0, 0, 0);
                });
            });
        }
        __syncthreads();
    });
    float nq = 0.f;
    if (BR == 0) {
        f32x4 ad = (f32x4){0.f, 0.f, 0.f, 0.f};
#pragma unroll
        for (int ks = 0; ks < 8; ++ks) {
            bf16x8 nf = *(LAS const bf16x8*)(nbf + 32 * ks + 8 * g);
            if (lr != 0) nf = (bf16x8){0, 0, 0, 0, 0, 0, 0, 0};
            ad = __builtin_amdgcn_mfma_f32_16x16x32_bf16(nf, qf[ks], ad, 0, 0, 0);
        }
        nq = __shfl(ad[0], lr);
    }
    const float al = av[l];
#pragma unroll
    for (int t = 0; t < 16; ++t) accN[t] *= al;
    tile_store<32, 544>(BufB, tr, tid);
    __syncthreads();
    {
        const unsigned base = lds_addr(BufB) + (lq * 272 + lp4) * 2;
        sfor<0, 4>([&](auto ks_) {
            constexpr int ks = decltype(ks_)::value;
            const bf16x8 bfr = lds_frag(Sw, l, 272, (32 * ks + 8 * g) * 2);
            sfor<0, 4>([&](auto tq_) {
                constexpr int tq = decltype(tq_)::value;
                bf16x8 f[4];
                tr_frag4<ks * 32 * 544 + tq * 128, 4 * 544, 32>(base, f);
#pragma unroll
                for (int i = 0; i < 4; ++i) accN[4 * tq + i] = __builtin_amdgcn_mfma_f32_16x16x32_bf16(f[i], bfr, accN[4 * tq + i], 0, 0, 0);
            });
        });
    }
    float inv = 1.0f;
    if (BR == 0) inv = 1.0f / fmaxf(fabsf(rs + al * nq), fl[l]);
    float sm = 0.f;
#pragma unroll
    for (int t = 0; t < 16; ++t) { accN[t] *= inv; sm += (accN[t][0] + accN[t][1]) + (accN[t][2] + accN[t][3]); }
    sm += __shfl_xor(sm, 16); sm += __shfl_xor(sm, 32);
    const float mu = sm * (1.0f / 256.0f);
    float qv = 0.f;
#pragma unroll
    for (int t = 0; t < 16; ++t) { const f32x4 d = accN[t] - mu; qv += (d[0] * d[0] + d[1] * d[1]) + (d[2] * d[2] + d[3] * d[3]); }
    qv += __shfl_xor(qv, 16); qv += __shfl_xor(qv, 32);
    const float rstd = rsqrtf(qv * (1.0f / 256.0f) + EPS);
    const int odd = g & 1, gp = 4 * (g & 2);
    const size_t row = row0 + l;
    const bf16_t* zp = p.P_() + row * NP + (BR == 0 ? C_ZM : C_ZR) + h * 256 + gp;
    const bf16_t* cp = p.CM_() + row * WM + h * 256 + gp;
    bf16_t* op = p.OC_() + row * 2048 + BR * 1024 + h * 256 + gp;
    LAS const float* gs = G + 1024 + gp; LAS const float* sks = G + 1280 + gp;
#pragma unroll
    for (int k = 0; k < 8; ++k) {
        f32x4 X = (accN[2 * k] - mu) * rstd, Y = (accN[2 * k + 1] - mu) * rstd;
        const f32x4 snd = odd ? X : Y; f32x4 rcv;
#pragma unroll
        for (int c2 = 0; c2 < 4; ++c2) rcv[c2] = __shfl_xor(snd[c2], 16);
        if (odd) X = rcv; else Y = rcv;
        const int ch = 16 * (2 * k + odd);
        const u32x4 zb = *(const u32x4*)(zp + ch);
        X *= *(LAS const f32x4*)(gs + ch); Y *= *(LAS const f32x4*)(gs + ch + 4);
        if (BR == 0) { const f32x4 s0 = *(LAS const f32x4*)(sks + ch), s1 = *(LAS const f32x4*)(sks + ch + 4); const u32x4 cb = *(const u32x4*)(cp + ch);
            X[0] += s0[0] * __uint_as_float(cb.x << 16); X[1] += s0[1] * __uint_as_float(cb.x & 0xffff0000u); X[2] += s0[2] * __uint_as_float(cb.y << 16); X[3] += s0[3] * __uint_as_float(cb.y & 0xffff0000u);
            Y[0] += s1[0] * __uint_as_float(cb.z << 16); Y[1] += s1[1] * __uint_as_float(cb.z & 0xffff0000u); Y[2] += s1[2] * __uint_as_float(cb.w << 16); Y[3] += s1[3] * __uint_as_float(cb.w & 0xffff0000u); }
        const float z0 = __uint_as_float(zb.x << 16), z1 = __uint_as_float(zb.x & 0xffff0000u), z2 = __uint_as_float(zb.y << 16), z3 = __uint_as_float(zb.y & 0xffff0000u);
        const float z4 = __uint_as_float(zb.z << 16), z5 = __uint_as_float(zb.z & 0xffff0000u), z6 = __uint_as_float(zb.w << 16), z7 = __uint_as_float(zb.w & 0xffff0000u);
        *(u32x4*)(op + ch) = (u32x4){pk2(X[0] * siluf_(z0), X[1] * siluf_(z1)), pk2(X[2] * siluf_(z2), X[3] * siluf_(z3)), pk2(Y[0] * siluf_(z4), Y[1] * siluf_(z5)), pk2(Y[2] * siluf_(z6), Y[3] * siluf_(z7))};
    }
    __syncthreads();
}

__device__ __forceinline__ f32x4 bf4_to_f32(u32x2 v) { return (f32x4){__uint_as_float(v.x << 16), __uint_as_float(v.x & 0xffff0000u), __uint_as_float(v.y << 16), __uint_as_float(v.y & 0xffff0000u)}; }
__device__ __forceinline__ const char* sample_state(const Params& p, int layer, int s) {
    const int br = s >> 9, b = (s >> 2) & 127, h = s & 3;
    return (const char*)((br == 0 ? p.st_C : p.st_S) + (((size_t)layer * BS + b) * HM + h) * SZ);
}
template <int BR>
__device__ __forceinline__ void sample_item(const Params& p, int layer, int b, int h, LAS float* base, const f32x4 (&cin)[8], f32x4 (&cnx)[8], const char* nsrc) {
    LAS float* sq = base; LAS float* sk = sq + 256; LAS float* sv = sk + 256; LAS float* sr = sv + 256; LAS float* part = sr + 256;
    const int tid = opaque_tid(), lane = tid & 63, wid = __builtin_amdgcn_readfirstlane(tid >> 6), e0 = 4 * lane;
    const size_t R = (size_t)MP + b;
    const size_t sidx = ((size_t)layer * BS + b) * HM + h;
    const bf16_t* qg = BR == 0 ? p.QK_() + R * 2048 + h * 512 : p.P_() + R * NP + C_QR + h * 256;
    const bf16_t* kg = BR == 0 ? p.QK_() + R * 2048 + h * 512 + 256 : p.P_() + R * NP + C_KR + h * 256;
    const bf16_t* vg = p.P_() + R * NP + (BR == 0 ? C_VM : C_VR) + h * 256;
    if (tid < 256) { sq[tid] = bf2f(qg[tid]); sk[tid] = bf2f(kg[tid]); sv[tid] = bf2f(vg[tid]); }
    const f32x4 q4 = bf4_to_f32(*(const u32x2*)(qg + e0)), k4 = bf4_to_f32(*(const u32x2*)(kg + e0)), v4 = bf4_to_f32(*(const u32x2*)(vg + e0));
    float wgt = 1.f, a = 1.0f - exp2f(-5.0f - (float)h), mt = 0.f;
    if (BR == 0) {
        const float ig = p.IF_()[R * 8 + h] + p.b_i[layer * HM + h];
        const float lf = logsigf_(p.IF_()[R * 8 + 4 + h] + p.b_f[layer * HM + h]);
        const float inter = lf + p.st_m[sidx];
        mt = fmaxf(inter, ig); wgt = expf(ig - mt); a = expf(inter - mt);
    }
    const char* sb = sample_state(p, layer, (BR << 9) | (b << 2) | h) + (size_t)wid * 1024 + (unsigned)lane * 16u;
    char* ob = (char*)(p.out + (BR == 0 ? O_CS : O_SS) + sidx * SZ) + (size_t)wid * 1024 + (unsigned)lane * 16u;
    __syncthreads();
    f32x4 cc[8], cn[8];
#pragma unroll
    for (int j = 0; j < 8; ++j) cc[j] = cin[j];
    f32x4 ac = (f32x4){0.f, 0.f, 0.f, 0.f};
#pragma unroll
    for (int i0 = 0; i0 < 32; i0 += 8) {
        if (i0 + 8 < 32) {
#pragma unroll
            for (int j = 0; j < 8; ++j) cn[j] = __builtin_nontemporal_load((const f32x4*)(sb + (size_t)(i0 + 8 + j) * 8192));
        } else if (nsrc) {
            const char* nb = nsrc + (size_t)wid * 1024 + (unsigned)lane * 16u;
#pragma unroll
            for (int j = 0; j < 8; ++j) cnx[j] = __builtin_nontemporal_load((const f32x4*)(nb + (size_t)j * 8192));
        }
#pragma unroll
        for (int j = 0; j < 8; ++j) { const int e = wid + 8 * (i0 + j);
            if (BR == 0) {
                float pt = (cc[j][0] * q4[0] + cc[j][1] * q4[1]) + (cc[j][2] * q4[2] + cc[j][3] * q4[3]);
                __builtin_nontemporal_store(cc[j] * a + k4 * (wgt * sv[e]), (f32x4*)(ob + (size_t)(i0 + j) * 8192));
                pt = wave_sum(pt);
                if (lane == 0) sr[e] = pt;
            } else {
                ac = ac + cc[j] * sq[e];
                __builtin_nontemporal_store(cc[j] * a + v4 * sk[e], (f32x4*)(ob + (size_t)(i0 + j) * 8192));
            }
        }
        if (i0 + 8 < 32) {
#pragma unroll
            for (int j = 0; j < 8; ++j) cc[j] = cn[j];
        }
    }
    if (BR == 1) *(LAS f32x4*)(part + wid * 256 + e0) = ac;
    __syncthreads();
    if (wid == 0) {
        f32x4 hv;
        if (BR == 0) {
            const f32x4 n4 = *(const f32x4*)(p.st_n + sidx * 256 + e0);
            const f32x4 cq = *(LAS const f32x4*)(sr + e0);
            const float qk = wave_sum((q4[0] * k4[0] + q4[1] * k4[1]) + (q4[2] * k4[2] + q4[3] * k4[3]));
            const float nq = wave_sum((n4[0] * q4[0] + n4[1] * q4[1]) + (n4[2] * q4[2] + n4[3] * q4[3]));
            const float ws = wgt * qk, inv = 1.0f / fmaxf(fabsf(ws + a * nq), expf(-mt));
            hv = (v4 * ws + cq * a) * inv;
            *(f32x4*)(p.out + O_NS + sidx * 256 + e0) = n4 * a + k4 * wgt;
            if (lane == 0) p.out[O_MS + sidx] = mt;
        } else {
            f32x4 oi = (f32x4){0.f, 0.f, 0.f, 0.f};
#pragma unroll
            for (int i = 0; i < 8; ++i) oi = oi + *(LAS const f32x4*)(part + i * 256 + e0);
            const float qk = wave_sum((q4[0] * k4[0] + q4[1] * k4[1]) + (q4[2] * k4[2] + q4[3] * k4[3]));
            hv = v4 * qk + oi * a;
        }
        const float mean = wave_sum((hv[0] + hv[1]) + (hv[2] + hv[3])) * (1.0f / 256.0f);
        const f32x4 dv = hv - mean;
        const float rstd = rsqrtf(wave_sum((dv[0] * dv[0] + dv[1] * dv[1]) + (dv[2] * dv[2] + dv[3] * dv[3])) * (1.0f / 256.0f) + EPS);
        const f32x4 ge = *(const f32x4*)((BR == 0 ? p.hn_m_g : p.hn_r_g) + (size_t)layer * WM + h * 256 + e0);
        f32x4 v = dv * rstd * ge;
        const f32x4 z = bf4_to_f32(*(const u32x2*)(p.P_() + R * NP + (BR == 0 ? C_ZM : C_ZR) + h * 256 + e0));
        if (BR == 0) v = v + *(const f32x4*)(p.skip_m + (size_t)layer * WM + h * 256 + e0) * bf4_to_f32(*(const u32x2*)(p.CM_() + R * WM + h * 256 + e0));
        *(u32x2*)(p.OC_() + R * 2048 + BR * 1024 + h * 256 + e0) = (u32x2){pk2(v[0] * siluf_(z[0]), v[1] * siluf_(z[1])), pk2(v[2] * siluf_(z[2]), v[3] * siluf_(z[3]))};
    }
    __syncthreads();
}

template <int MODE>
__device__ __forceinline__ void sample_gemm(const Params& p, const bf16_t* Wl, int wg, int nwg, LAS unsigned char* lds, unsigned long long* ssn) {
    const int tid = opaque_tid(), lane = tid & 63, w = tid >> 6, g = lane >> 4, lr = lane & 15;
    LAS float* part = (LAS float*)lds;
#pragma unroll 1
    for (int j = wg; j < 256; j += nwg) {
        const int rbase = MP + 32 * ((j >> 3) & 3), cbase = 32 * ((j & 7) + 8 * (j >> 5));
        const size_t o = (size_t)(rbase + (tid >> 4)) * 2048 + cbase + (tid & 15) * 2;
        const unsigned e0 = *(const unsigned*)((MODE == 0 ? p.RT_() : p.Xb_()) + o), e1 = MODE == 0 ? *(const unsigned*)(p.GRS_() + o) : 0u;
        const bf16_t* A = (MODE == 0 ? p.OC_() : p.MG_()) + (size_t)(rbase + lr) * 2048 + w * 256 + 8 * g;
        const bf16_t* B = Wl + (MODE == 0 ? W3_OFF : W4_OFF) + (size_t)(cbase + lr) * 2048 + w * 256 + 8 * g;
        bf16x8 af[2][8], bf[2][8];
#pragma unroll
        for (int t = 0; t < 2; ++t)
#pragma unroll
            for (int i = 0; i < 8; ++i) { af[t][i] = *(const bf16x8*)(A + (size_t)t * 16 * 2048 + 32 * i); bf[t][i] = *(const bf16x8*)(B + (size_t)t * 16 * 2048 + 32 * i); }
#pragma unroll
        for (int rt = 0; rt < 2; ++rt)
#pragma unroll
            for (int ct = 0; ct < 2; ++ct) {
                f32x4 acc = (f32x4){0.f, 0.f, 0.f, 0.f};
#pragma unroll
                for (int i = 0; i < 8; ++i) acc = __builtin_amdgcn_mfma_f32_16x16x32_bf16(af[rt][i], bf[ct][i], acc, 0, 0, 0);
#pragma unroll
                for (int r = 0; r < 4; ++r) part[((w * 2 + rt) * 2 + ct) * 256 + (4 * g + r) * 16 + lr] = acc[r];
            }
        __syncthreads();
        {
            const int rr = tid >> 4, cc = (tid & 15) * 2;
            const LAS float* q = part + (((rr >> 4) * 2 + (cc >> 4)) * 256 + (rr & 15) * 16 + (cc & 15));
            float lo0 = 0.f, lo1 = 0.f, hi0 = 0.f, hi1 = 0.f;
#pragma unroll
            for (int ww = 0; ww < 4; ++ww) { lo0 += q[ww * 1024]; lo1 += q[ww * 1024 + 1]; hi0 += q[(ww + 4) * 1024]; hi1 += q[(ww + 4) * 1024 + 1]; }
            if (MODE == 0) {
                const unsigned rt2 = e0, gr2 = e1;
                const float m0 = bf2f((bf16_t)(gr2 & 0xffffu)) * (bf2f((bf16_t)(rt2 & 0xffffu)) * lo0 + hi0), m1 = bf2f((bf16_t)(gr2 >> 16)) * (bf2f((bf16_t)(rt2 >> 16)) * lo1 + hi1);
                *(unsigned*)(p.MG_() + o) = (unsigned)f2bf(m0) | ((unsigned)f2bf(m1) << 16);
            } else {
                const unsigned x2 = e0;
                const bf16_t n0 = f2bf(bf2f((bf16_t)(x2 & 0xffffu)) + (lo0 + hi0)), n1 = f2bf(bf2f((bf16_t)(x2 >> 16)) + (lo1 + hi1));
                *(unsigned*)(p.Xb_() + o) = (unsigned)n0 | ((unsigned)n1 << 16);
                float sq = bf2f(n0) * bf2f(n0) + bf2f(n1) * bf2f(n1);
                sq += __shfl_xor(sq, 1); sq += __shfl_xor(sq, 2); sq += __shfl_xor(sq, 4); sq += __shfl_xor(sq, 8);
                if ((tid & 15) == 0) atomicAdd(ssn + rbase + rr, ss_fix(sq));
            }
        }
        __syncthreads();
    }
}

__device__ __forceinline__ void sample_gemm2(const Params& p, const bf16_t* W2t, int wg, int nwg) {
    const int tid = opaque_tid(), lane = tid & 63, w = tid >> 6, g = lane >> 4, lr = lane & 15;
    for (int j = wg; j < 128; j += nwg) {
        const int rbase = MP + 16 * (j & 7), cbase = 128 * (j >> 3) + 16 * w, head = cbase >> 9;
        const bf16_t* A = p.CM_() + (size_t)(rbase + lr) * WM + head * 256 + 8 * g;
        const bf16_t* B = W2t + (size_t)(cbase + lr) * 256 + 8 * g;
        bf16x8 af[8], bf[8];
#pragma unroll
        for (int i = 0; i < 8; ++i) { af[i] = *(const bf16x8*)(A + 32 * i); bf[i] = *(const bf16x8*)(B + 32 * i); }
        f32x4 acc = (f32x4){0.f, 0.f, 0.f, 0.f};
#pragma unroll
        for (int i = 0; i < 8; ++i) acc = __builtin_amdgcn_mfma_f32_16x16x32_bf16(af[i], bf[i], acc, 0, 0, 0);
#pragma unroll
        for (int r = 0; r < 4; ++r) p.QK_()[(size_t)(rbase + 4 * g + r) * 2048 + cbase + lr] = f2bf(acc[r]);
    }
}

__device__ __forceinline__ void phaseA(const Params& p, int layer, int wg, int nwg, LAS unsigned char* lds) {
    for (int it = wg; it < 256; it += nwg) {
        const int pi = (it & 7) * 4 + (it >> 6), sl = (it >> 3) & 7, bh = pi & 15;
        if (pi < 16) chunk_state_item<0>(p, layer, bh >> 2, bh & 3, sl, lds); else chunk_state_item<1>(p, layer, bh >> 2, bh & 3, sl, lds);
    }
    {
        const int tid = opaque_tid(), lane = tid & 63, wid = __builtin_amdgcn_readfirstlane(tid >> 6);
        int s = wg, k = 0;
        if (s < 1024) {
            f32x4 cc[8], cx[8];
            { const char* sb = sample_state(p, layer, s) + (size_t)wid * 1024 + (unsigned)lane * 16u;
#pragma unroll
              for (int j = 0; j < 8; ++j) cc[j] = __builtin_nontemporal_load((const f32x4*)(sb + (size_t)j * 8192)); }
            for (;; ++k) {
                const int sn = s + nwg;
                const char* nsrc = sn < 1024 ? sample_state(p, layer, sn) : nullptr;
                LAS float* base = (LAS float*)lds + (k & 1) * 3072;
                const int b = (s >> 2) & 127, h = s & 3;
                if (s < 512) sample_item<0>(p, layer, b, h, base, cc, cx, nsrc); else sample_item<1>(p, layer, b, h, base, cc, cx, nsrc);
                if (sn >= 1024) break;
#pragma unroll
                for (int j = 0; j < 8; ++j) cc[j] = cx[j];
                s = sn;
            }
        }
        __syncthreads();
    }
}
__device__ __forceinline__ void phaseScan(const Params& p, int layer, int wg, int nwg, LAS unsigned char* lds) {
    for (int it = wg; it < 256; it += nwg) scan_item(p, layer, it >> 3, it & 7, lds);
}
__device__ __forceinline__ void phaseC(const Params& p, int layer, int wg, int nwg, LAS unsigned char* lds) {
    for (int it = wg; it < 512; it += nwg) {
        const int br = it >> 8, rest = it & 255, b = rest >> 6, h = (rest >> 4) & 3, c = rest & 15;
        if (br == 0) chunk_passC<0>(p, layer, b, h, c, lds); else chunk_passC<1>(p, layer, b, h, c, lds);
    }
}

template <int ONLY>
__device__ __forceinline__ void run_phases(const Params& p_in, int ph_lo, int ph_hi) {
    extern __shared__ __attribute__((aligned(16))) unsigned char smem_raw[];
    LAS unsigned char* lds = (LAS unsigned char*)smem_raw;
    volatile LAS unsigned* xbw = (volatile LAS unsigned*)(lds + LDS_BYTES - 16);
    const int wg_in = blockIdx.x, nwg = gridDim.x;
    const bool multi = (ph_hi - ph_lo) > 1;
    XcdBarrier bar; bar.bar = p_in.bar_(); bar.x = 0; bar.st = xbw;
    if (multi) {
        if (threadIdx.x == 0) { xbw[0] = 0u; xbw[1] = 0u; xbw[2] = 0u; xbw[3] = 0u; }
        __syncthreads();
        bar = xcd_barrier_post(p_in.bar_(), xbw);
    }
    int ph = 0;
#define PHASE(KIND, ...) { if constexpr (ONLY < 0 || ONLY == KIND) { if (ph >= ph_lo && ph < ph_hi) { \
    Params p = p_in; int wg = wg_in; { size_t z_ = 0; asm volatile("" : "+s"(z_), "+s"(wg)); p.ws = p_in.ws + z_; p.out = p_in.out + z_; }     \
    __VA_ARGS__; if (ph + 1 < ph_hi) xcd_barrier(bar); } } ++ph; }
    PHASE(0, prep_phase(p, wg, nwg, lds))
    for (int layer = 0; layer < DEPTH; ++layer) {
        PHASE(2, { int nw_ = nwg; asm volatile("" : "+s"(nw_)); pg8::BalOrder S; S.init(MPAD, N1, nw_, wg); pg8::Gemm g{p.Xb_(), p.W_() + (size_t)layer * WL + W1_OFF, D, D, D, 31, 0, 0};
                pg8::EpiG1 E{p.P_(), p.b_gate + (size_t)layer * 4096, p.RT_(), p.GRS_(), p.ROPE_(), p.SS_() + (size_t)layer * MPAD, p.SSP_(), p.IF_()}; pg8::gemm_phase<false>(lds, g, S, E);
                { int nid_; const int ii_ = S.idle_index(nid_); if (ii_ >= 0) { __syncthreads(); const int t0_ = layer + 1 < DEPTH ? (layer + 1) * 7808 : layer * 7808 + 5632; tr_run(p, ii_ * 8 + (opaque_tid() >> 6), nid_ * 8, tr_def(nw_), lds, [=](int j) { return t0_ + j; }); } } })
        PHASE(3, conv_phase(p, layer, wg, nwg, lds))
        PHASE(4, { pg8::StaticOrder S; S.init(MP, 2048, nwg, wg); pg8::Gemm g{p.CM_(), p.W_() + (size_t)layer * WL + W2_OFF, 256, WM, 256, 1, 512, 0};
                pg8::EpiBf16 E{p.QK_(), 2048}; pg8::gemm_phase<false>(lds, g, S, E); sample_gemm2(p, p.W_() + (size_t)layer * WL + W2_OFF, wg, nwg); })
        PHASE(5, phaseA(p, layer, wg, nwg, lds))
        PHASE(7, phaseC(p, layer, wg, nwg, lds))
        PHASE(8, { pg8::StaticOrder S; S.init(MP, 2048, nwg, wg); pg8::Gemm g{p.OC_(), p.W_() + (size_t)layer * WL + W3_OFF, 2048, 2048, 2048, 31, 0, 16};
                pg8::EpiMerged E{p.MG_(), p.RT_(), p.GRS_()}; pg8::gemm_phase<true>(lds, g, S, E); sample_gemm<0>(p, p.W_() + (size_t)layer * WL, wg, nwg, lds, nullptr); })
        PHASE(10, { pg8::StaticOrder S; S.init(MP, 2048, nwg, wg); pg8::Gemm g{p.MG_(), p.W_() + (size_t)layer * WL + W4_OFF, 2048, 2048, 2048, 31, 0, 0};
                pg8::EpiResidual E{p.Xb_(), p.SSP_(), (LAS float*)(lds + pg8::STAGE_BYTES)}; pg8::gemm_phase<false>(lds, g, S, E); sample_gemm<1>(p, p.W_() + (size_t)layer * WL, wg, nwg, lds, p.SS_() + (size_t)(layer + 1) * MPAD); })
    }
    PHASE(11, final_phase(p, wg, nwg))
#undef PHASE
}
__global__ void __launch_bounds__(512, 2) mega(Params p, int ph_lo, int ph_hi) { run_phases<-1>(p, ph_lo, ph_hi); }
#ifdef DIAG
template <int K> __global__ void __launch_bounds__(512, 2) mega_k(Params p, int ph_lo, int ph_hi) { run_phases<K>(p, ph_lo, ph_hi); }
template __global__ void mega_k<0>(Params, int, int); template __global__ void mega_k<2>(Params, int, int);
template __global__ void mega_k<3>(Params, int, int); template __global__ void mega_k<4>(Params, int, int); template __global__ void mega_k<5>(Params, int, int);
template __global__ void mega_k<7>(Params, int, int); template __global__ void mega_k<8>(Params, int, int);
template __global__ void mega_k<10>(Params, int, int); template __global__ void mega_k<11>(Params, int, int);
#endif
constexpr int N_PHASES = 2 + DEPTH * 7;

extern "C" void kernel_launch(void* const* d_in, const int* in_sizes, int n_in, void* d_out, int out_size, void* d_ws, size_t ws_size, hipStream_t stream) {
    (void)in_sizes; (void)n_in; (void)out_size; (void)ws_size;
    static int grid = 0;
    if (grid == 0) {
        int dev = 0, cus = 0;
        hipGetDevice(&dev);
        hipDeviceGetAttribute(&cus, hipDeviceAttributeMultiprocessorCount, dev);
        if (hipFuncSetAttribute((const void*)mega, hipFuncAttributeMaxDynamicSharedMemorySize, LDS_BYTES) != hipSuccess) fprintf(stderr, "hipFuncSetAttribute failed\n");
        (void)hipGetLastError();
        grid = cus > 0 ? cus : 256;
    }
    Params p{};
    const float** in = (const float**)&p;
    for (int i = 0; i < 24; ++i) in[i] = (const float*)d_in[i];
    p.out = (float*)d_out;
    p.ws = (unsigned char*)d_ws;
    if (ws_size < WS_END) { fprintf(stderr, "workspace too small: %zu < %zu\n", ws_size, (size_t)WS_END); return; }
    hipMemsetAsync(d_ws, 0, 16384, stream);
#if MK_SINGLE
    hipLaunchKernelGGL(mega, dim3(grid), dim3(512), LDS_BYTES, stream, p, 0, N_PHASES);
#else
    for (int ph = 0; ph < N_PHASES; ++ph) hipLaunchKernelGGL(mega, dim3(grid), dim3(512), LDS_BYTES, stream, p, ph, ph + 1);
#endif
}
```
